# Optimizing an MI355X kernel written in HIP

```python
import math
import jax, jax.numpy as jnp
from jax import lax
import numpy as np

D_MODEL = 1024
BATCH = 16
SEQ = 4096
DEPTH = 2

N_MIXERS = 2
N_CONV_LAYERS = (DEPTH + 1) // 2
N_ATTN_LAYERS = DEPTH // 2
CONV_WIDTH = 3
DILATED_GROUPS = ((128, 1), (512, 4), (2048, 16))
N_DIL_GROUPS = len(DILATED_GROUPS)
ATTN_HEADS = 8
HEAD_DIM = 64
ATTN_OUT_DIM = ATTN_HEADS * HEAD_DIM
ATTN_IN_DIM = N_DIL_GROUPS * 3 * ATTN_OUT_DIM
ROT_DIM = HEAD_DIM // 4
ROPE_THETA = 500000.0
N_GROUPS = 4
EXPERTS_PER_GROUP = 8
N_EXPERTS = N_GROUPS * EXPERTS_PER_GROUP
TOP_K_EXPERTS = 2
D_EXPERT = 512
MOE_BLOCK = 512
NORM_EPS = 1e-6

kernel_name = "hybrid_shortconv_dilatedattn_hmoe_adaln"


def rms_norm(x, g):
    xf = x.astype(jnp.float32)
    y = xf * lax.rsqrt(jnp.mean(xf * xf, axis=-1, keepdims=True) + NORM_EPS)
    return (y * g.astype(jnp.float32)).astype(x.dtype)


def modulate(h, shift, scale):
    return h * (1.0 + scale[:, None, :]) + shift[:, None, :]


def short_conv_mixer(h, w_in, w_conv, w_out):
    d = h.shape[-1]
    b_gate, c_gate, u = jnp.split(h @ w_in, 3, axis=-1)
    z = c_gate * u
    zc = lax.conv_general_dilated(
        z, w_conv[:, None, :], window_strides=(1,), padding=[(CONV_WIDTH - 1, 0)],
        dimension_numbers=("NWC", "WIO", "NWC"), feature_group_count=d)
    return (b_gate * zc) @ w_out


def rotary_tables(seq):
    pos = jnp.arange(seq, dtype=jnp.float32)
    inv_freq = jnp.power(jnp.float32(ROPE_THETA),
                         -jnp.arange(0, ROT_DIM, 2, dtype=jnp.float32) / ROT_DIM)
    ang = pos[:, None] * inv_freq[None, :]
    return jnp.cos(ang)[None, :, None, :], jnp.sin(ang)[None, :, None, :]


def apply_partial_rope(t, cos, sin):
    half = ROT_DIM // 2
    rot = t[..., :ROT_DIM].astype(jnp.float32)
    x1, x2 = rot[..., :half], rot[..., half:]
    r = jnp.concatenate([x1 * cos - x2 * sin, x2 * cos + x1 * sin], axis=-1)
    return jnp.concatenate([r.astype(t.dtype), t[..., ROT_DIM:]], axis=-1)


def dilated_window_attention(q, k, v, dil, span):
    b, s, h, e = q.shape
    L = s // dil
    blk = span
    nb = -(-L // blk)
    pad = nb * blk - L

    def split(t):
        t = t.reshape(b, L, dil, h, e)
        t = jnp.pad(t, ((0, 0), (0, pad), (0, 0), (0, 0), (0, 0)))
        return t.reshape(b, nb, blk, dil, h, e)

    def banded(t):
        t_ext = jnp.pad(t, ((0, 0), (1, 0), (0, 0), (0, 0), (0, 0), (0, 0)))
        return jnp.concatenate([t_ext[:, :-1], t_ext[:, 1:]], axis=2)

    qb = split(q)
    kw = banded(split(k))
    vw = banded(split(v))
    scores = jnp.einsum("bnqrhe,bnkrhe->bnrhqk", qb, kw).astype(jnp.float32) * (HEAD_DIM ** -0.5)
    qi = jnp.arange(blk)[:, None]
    kj = jnp.arange(2 * blk)[None, :]
    dist = qi + blk - kj
    band = (dist >= 0) & (dist <= span)
    valid_start = (jnp.arange(nb)[:, None, None] > 0) | (kj[None] >= blk)
    mask = (band[None] & valid_start)[None, :, None, None]
    scores = jnp.where(mask, scores, -jnp.inf)
    m = jnp.max(scores, axis=-1, keepdims=True)
    p = jnp.exp(scores - m)
    den = jnp.sum(p, axis=-1, keepdims=True)
    lse = (m + jnp.log(den))[..., 0]
    out = jnp.einsum("bnrhqk,bnkrhe->bnqrhe", p / den, vw.astype(jnp.float32))
    out = out.reshape(b, nb * blk, dil, h, e)[:, :L].reshape(b, s, h, e)
    lse = jnp.transpose(lse, (0, 1, 4, 2, 3)).reshape(b, nb * blk, dil, h)[:, :L].reshape(b, s, h)
    return out, lse


def dilated_attention_mixer(h, w_in, w_out):
    b, s, _ = h.shape
    qkv = (h @ w_in).reshape(b, s, N_DIL_GROUPS, 3, ATTN_HEADS, HEAD_DIM)
    cos, sin = rotary_tables(s)
    outs, lses = [], []
    for g, (window, dil) in enumerate(DILATED_GROUPS):
        q = apply_partial_rope(qkv[:, :, g, 0], cos, sin)
        k = apply_partial_rope(qkv[:, :, g, 1], cos, sin)
        o, lse = dilated_window_attention(q, k, qkv[:, :, g, 2], dil, window // dil)
        outs.append(o)
        lses.append(lse)
    wts = jax.nn.softmax(jnp.stack(lses, axis=0), axis=0)
    o = jnp.einsum("gbshe,gbsh->bshe", jnp.stack(outs, axis=0), wts)
    return o.astype(h.dtype).reshape(b, s, ATTN_OUT_DIM) @ w_out


def expert_dispatch(hf, eid, wts, w_gate, w_up, w_down):
    t, d = hf.shape
    k = eid.shape[1]
    tk = t * k
    n_blocks = -(-tk // MOE_BLOCK) + N_EXPERTS
    rows = n_blocks * MOE_BLOCK
    flat_e = eid.reshape(-1)
    flat_tok = jnp.repeat(jnp.arange(t, dtype=jnp.int32), k)
    flat_w = wts.reshape(-1)
    order = jnp.argsort(flat_e)
    se, stok, sw = flat_e[order], flat_tok[order], flat_w[order]
    counts = jnp.bincount(flat_e, length=N_EXPERTS)
    starts = jnp.cumsum(counts) - counts
    pcounts = (counts + MOE_BLOCK - 1) // MOE_BLOCK * MOE_BLOCK
    pends = jnp.cumsum(pcounts)
    pstarts = pends - pcounts
    dest = pstarts[se] + (jnp.arange(tk) - starts[se])
    row_tok = jnp.full((rows,), t, dtype=jnp.int32).at[dest].set(stok)
    row_w = jnp.zeros((rows,), jnp.float32).at[dest].set(sw)
    block_e = jnp.clip(jnp.searchsorted(pends, jnp.arange(n_blocks) * MOE_BLOCK, side="right"),
                       0, N_EXPERTS - 1)
    hf_pad = jnp.concatenate([hf, jnp.zeros((1, d), hf.dtype)], axis=0)
    xs = hf_pad[row_tok].reshape(n_blocks, MOE_BLOCK, d)

    def expert_block(args):
        xb, e = args
        return (jax.nn.silu(xb @ w_gate[e]) * (xb @ w_up[e])) @ w_down[e]

    ys = lax.map(expert_block, (xs, block_e)).reshape(rows, d)
    out = jnp.zeros((t + 1, d), ys.dtype).at[row_tok].add(row_w[:, None].astype(ys.dtype) * ys)
    return out[:t]


def hierarchical_moe(h, w_grp, b_grp, w_exp_r, b_exp_r, w_gate, w_up, w_down):
    b, s, d = h.shape
    hf = h.reshape(b * s, d)
    hf32 = hf.astype(jnp.float32)
    grp_prob = jax.nn.softmax(hf32 @ w_grp.astype(jnp.float32) + b_grp.astype(jnp.float32), axis=-1)
    grp_p, grp_idx = lax.top_k(grp_prob, 1)
    exp_logits = jnp.einsum("td,gde->tge", hf32, w_exp_r.astype(jnp.float32)) \
        + b_exp_r.astype(jnp.float32)[None]
    sel = jnp.take_along_axis(exp_logits, grp_idx[:, :, None], axis=1)[:, 0]
    top_p, top_i = lax.top_k(jax.nn.softmax(sel, axis=-1), TOP_K_EXPERTS)
    wts = grp_p * top_p / jnp.sum(top_p, axis=-1, keepdims=True)
    eid = grp_idx * EXPERTS_PER_GROUP + top_i
    return expert_dispatch(hf, eid, wts, w_gate, w_up, w_down).reshape(b, s, d)


def setup_inputs(seed: int = 0) -> dict:
    key = jax.random.key(seed)
    ks = jax.random.split(key, 20)
    d = D_MODEL
    nrm = lambda k, shape, scale: jax.random.normal(k, shape, jnp.float32) * scale
    return {
        "x": nrm(ks[0], (BATCH, SEQ, d), 1.0),
        "c": nrm(ks[1], (BATCH, d), 1.0),
        "norm_mix_g": 1.0 + nrm(ks[2], (DEPTH, d), 0.02),
        "norm_ffn_g": 1.0 + nrm(ks[3], (DEPTH, d), 0.02),
        "ada_w": nrm(ks[4], (DEPTH, d, 6 * d), 0.5 * d ** -0.5),
        "ada_b": nrm(ks[5], (DEPTH, 6 * d), 0.02),
        "conv_in_w": nrm(ks[6], (N_CONV_LAYERS, d, 3 * d), d ** -0.5),
        "conv_w": nrm(ks[7], (N_CONV_LAYERS, CONV_WIDTH, d), CONV_WIDTH ** -0.5),
        "conv_out_w": nrm(ks[8], (N_CONV_LAYERS, d, d), d ** -0.5),
        "attn_in_w": nrm(ks[9], (N_ATTN_LAYERS, d, ATTN_IN_DIM), d ** -0.5),
        "attn_out_w": nrm(ks[10], (N_ATTN_LAYERS, ATTN_OUT_DIM, d), ATTN_OUT_DIM ** -0.5),
        "router_grp_w": nrm(ks[11], (DEPTH, d, N_GROUPS), d ** -0.5),
        "router_grp_b": nrm(ks[12], (DEPTH, N_GROUPS), 0.01),
        "router_exp_w": nrm(ks[13], (DEPTH, N_GROUPS, d, EXPERTS_PER_GROUP), d ** -0.5),
        "router_exp_b": nrm(ks[14], (DEPTH, N_GROUPS, EXPERTS_PER_GROUP), 0.01),
        "exp_gate_w": nrm(ks[15], (DEPTH, N_EXPERTS, d, D_EXPERT), d ** -0.5),
        "exp_up_w": nrm(ks[16], (DEPTH, N_EXPERTS, d, D_EXPERT), d ** -0.5),
        "exp_down_w": nrm(ks[17], (DEPTH, N_EXPERTS, D_EXPERT, d), D_EXPERT ** -0.5),
        "final_norm_g": 1.0 + nrm(ks[18], (d,), 0.02),
    }


def reference(x, c, norm_mix_g, norm_ffn_g, ada_w, ada_b, conv_in_w, conv_w, conv_out_w,
              attn_in_w, attn_out_w, router_grp_w, router_grp_b, router_exp_w, router_exp_b,
              exp_gate_w, exp_up_w, exp_down_w, final_norm_g):
    c_act = jax.nn.silu(c)
    for i in range(DEPTH):
        mod = c_act @ ada_w[i] + ada_b[i]
        sh1, sc1, g1, sh2, sc2, g2 = jnp.split(mod, 6, axis=-1)
        h = modulate(rms_norm(x, norm_mix_g[i]), sh1, sc1)
        j = i // N_MIXERS
        if i % N_MIXERS == 0:
            y = short_conv_mixer(h, conv_in_w[j], conv_w[j], conv_out_w[j])
        else:
            y = dilated_attention_mixer(h, attn_in_w[j], attn_out_w[j])
        x = x + g1[:, None, :] * y
        h = modulate(rms_norm(x, norm_ffn_g[i]), sh2, sc2)
        x = x + g2[:, None, :] * hierarchical_moe(
            h, router_grp_w[i], router_grp_b[i], router_exp_w[i], router_exp_b[i],
            exp_gate_w[i], exp_up_w[i], exp_down_w[i])
    return rms_norm(x, final_norm_g)
```

```cpp
#include <hip/hip_runtime.h>
#include <stdint.h>
#include <math.h>

typedef unsigned short bf16_t;
typedef float f32x4 __attribute__((ext_vector_type(4)));
typedef unsigned u32x2 __attribute__((ext_vector_type(2)));
typedef unsigned u32x4 __attribute__((ext_vector_type(4)));

constexpr int D = 1024, BATCH = 16, SEQ = 4096, T = BATCH * SEQ;
constexpr int NEXP = 32, DEXP = 512, EPG = 8, NGRP = 4;
constexpr int QKVW = 4608;
constexpr int LISTCAP = 65536;
constexpr int PADROWS = 139264;
constexpr float EPS = 1e-6f;
constexpr float QSCALE = 0.125f * 1.4426950408889634f;

constexpr size_t MiB = 1u << 20;
constexpr size_t WS_CTL = 0;
constexpr size_t CTL_BYTES = 1 * MiB;
constexpr size_t WS_MOD = 1 * MiB;
constexpr size_t WS_ROPE = 3 * MiB;
constexpr size_t WS_LTOK = 4 * MiB;
constexpr size_t WS_LW = 12 * MiB;
constexpr size_t WS_TSLOT = 20 * MiB;
constexpr size_t WS_LSE = 24 * MiB;
constexpr size_t WS_WBF = 32 * MiB;
constexpr size_t WS_XN = 256 * MiB;
constexpr size_t WS_BIG = 384 * MiB;
constexpr size_t WS_Z = WS_BIG, WS_YPRE = WS_BIG + 128 * MiB;
constexpr size_t WS_ACT = WS_BIG, WS_YW = WS_BIG + 136 * MiB;
constexpr size_t WS_QKV = WS_BIG;
constexpr size_t WS_END = WS_BIG + 576 * MiB;

__device__ __forceinline__ unsigned f2bf(float f) { unsigned u = __float_as_uint(f); return (u + 0x7fffu + ((u >> 16) & 1u)) >> 16; }
__device__ __forceinline__ unsigned pk2(float lo, float hi) { return f2bf(lo) | (f2bf(hi) << 16); }
__device__ __forceinline__ float bf2f(unsigned h) { return __uint_as_float(h << 16); }
__device__ __forceinline__ float bflo(unsigned w) { return __uint_as_float(w << 16); }
__device__ __forceinline__ float bfhi(unsigned w) { return __uint_as_float(w & 0xffff0000u); }
__device__ __forceinline__ float wave_sum(float v) {
#pragma unroll
    for (int o = 1; o < 64; o <<= 1) v += __shfl_xor(v, o);
    return v;
}

__global__ void __launch_bounds__(256) k_prep(const float* __restrict__ c, const float* __restrict__ ada_w, const float* __restrict__ ada_b, float* __restrict__ mod, float* __restrict__ rope) {
    __shared__ float cact[16 * 1024];
    __shared__ float red[4 * 16 * 64];
    const int tid = threadIdx.x;
    if (blockIdx.x < 192) {
        const int item = blockIdx.x, l = item / 96, n0 = (item % 96) * 64;
        for (int i = tid; i < 16 * 1024; i += 256) { const float v = c[i]; cact[i] = v / (1.f + expf(-v)); }
        __syncthreads();
        const int kg = tid >> 6, n = tid & 63;
        float acc[16];
#pragma unroll
        for (int b = 0; b < 16; ++b) acc[b] = 0.f;
        const float* w = ada_w + (size_t)l * 1024 * 6144 + n0 + n;
        for (int k = kg * 256; k < kg * 256 + 256; ++k) {
            const float wv = w[(size_t)k * 6144];
#pragma unroll
            for (int b = 0; b < 16; ++b) acc[b] += cact[b * 1024 + k] * wv;
        }
#pragma unroll
        for (int b = 0; b < 16; ++b) red[(kg * 16 + b) * 64 + n] = acc[b];
        __syncthreads();
        for (int i = tid; i < 1024; i += 256) {
            const int b = i >> 6, nn = i & 63;
            const float s = (red[(0 * 16 + b) * 64 + nn] + red[(1 * 16 + b) * 64 + nn]) + (red[(2 * 16 + b) * 64 + nn] + red[(3 * 16 + b) * 64 + nn]);
            mod[((size_t)l * 16 + b) * 6144 + n0 + nn] = s + ada_b[l * 6144 + n0 + nn];
        }
    } else {
        const int nb = gridDim.x - 192, bi = blockIdx.x - 192;
        for (int i = bi * 256 + tid; i < 4096 * 8; i += nb * 256) {
            const int t = i >> 3, f = i & 7;
            const float inv = powf(500000.0f, -(float)(2 * f) / 16.0f);
            const float ang = (float)t * inv;
            rope[i] = (float)cos((double)ang);
            rope[4096 * 8 + i] = (float)sin((double)ang);
        }
    }
}

struct RowV { f32x4 v[4]; };
__device__ __forceinline__ void row_load(RowV& r, const float* row, int lane) {
#pragma unroll
    for (int j = 0; j < 4; ++j) r.v[j] = *(const f32x4*)(row + 4 * lane + 256 * j);
}
__device__ __forceinline__ float row_rstd(const RowV& r) {
    float s = 0.f;
#pragma unroll
    for (int j = 0; j < 4; ++j) s += (r.v[j].x * r.v[j].x + r.v[j].y * r.v[j].y) + (r.v[j].z * r.v[j].z + r.v[j].w * r.v[j].w);
    s = wave_sum(s);
    return 1.0f / sqrtf(s * (1.0f / 1024.0f) + EPS);
}
__device__ __forceinline__ void row_modulate(RowV& r, float rstd, const float* g, const float* sh, const float* sc, int lane) {
#pragma unroll
    for (int j = 0; j < 4; ++j) {
        const int o = 4 * lane + 256 * j;
        const f32x4 gg = *(const f32x4*)(g + o), s = *(const f32x4*)(sc + o), h = *(const f32x4*)(sh + o);
        r.v[j] = (r.v[j] * rstd * gg) * (s + 1.0f) + h;
    }
}
__device__ __forceinline__ void row_store_bf16(const RowV& r, bf16_t* out, int lane) {
#pragma unroll
    for (int j = 0; j < 4; ++j) { u32x2 w; w.x = pk2(r.v[j].x, r.v[j].y); w.y = pk2(r.v[j].z, r.v[j].w); *(u32x2*)(out + 4 * lane + 256 * j) = w; }
}
__device__ __forceinline__ void row_store_f32(const RowV& r, float* out, int lane) {
#pragma unroll
    for (int j = 0; j < 4; ++j) *(f32x4*)(out + 4 * lane + 256 * j) = r.v[j];
}

__global__ void __launch_bounds__(512) k_r0(const float* __restrict__ x, const float* __restrict__ g, const float* __restrict__ mod  , bf16_t* __restrict__ xn) {
    const int lane = threadIdx.x & 63, wave = threadIdx.x >> 6;
    for (int row = blockIdx.x * 8 + wave; row < T; row += gridDim.x * 8) {
        const int b = row >> 12;
        RowV r; row_load(r, x + (size_t)row * D, lane);
        const float rstd = row_rstd(r);
        const float* mb = mod + (size_t)b * 6144;
        row_modulate(r, rstd, g, mb + 0, mb + 1024, lane);
        row_store_bf16(r, xn + (size_t)row * D, lane);
    }
}

__global__ void __launch_bounds__(512) k_r1(const float* __restrict__ xres, const float* __restrict__ g, const float* __restrict__ mod,
                                            const float* __restrict__ wg, const float* __restrict__ bg, const float* __restrict__ we, const float* __restrict__ be,
                                            bf16_t* __restrict__ xn, int* __restrict__ cnt, int* __restrict__ ltok, float* __restrict__ lw, int* __restrict__ tslot) {
    __shared__ int rec_e[512]; __shared__ float rec_w[512]; __shared__ int rec_rank[512];
    __shared__ int hist[32]; __shared__ int base[32];
    const int tid = threadIdx.x, lane = tid & 63, wave = tid >> 6;
    for (int blk = blockIdx.x; blk < T / 256; blk += gridDim.x) {
        if (tid < 32) hist[tid] = 0;
        __syncthreads();
        for (int i = 0; i < 32; ++i) {
            const int rl = wave * 32 + i, row = blk * 256 + rl, b = row >> 12;
            RowV r; row_load(r, xres + (size_t)row * D, lane);
            const float rstd = row_rstd(r);
            const float* mb = mod + (size_t)b * 6144;
            row_modulate(r, rstd, g, mb + 3072, mb + 4096, lane);
            row_store_bf16(r, xn + (size_t)row * D, lane);
            float pg[4] = {0.f, 0.f, 0.f, 0.f};
#pragma unroll
            for (int j = 0; j < 4; ++j) {
#pragma unroll
                for (int cc = 0; cc < 4; ++cc) {
                    const int k = 4 * lane + 256 * j + cc; const f32x4 w = *(const f32x4*)(wg + (size_t)k * 4); const float hv = r.v[j][cc];
                    pg[0] += hv * w.x; pg[1] += hv * w.y; pg[2] += hv * w.z; pg[3] += hv * w.w;
                }
            }
#pragma unroll
            for (int o = 0; o < 4; ++o) pg[o] = wave_sum(pg[o]) + bg[o];
            int gi = 0; float gm = pg[0];
#pragma unroll
            for (int o = 1; o < 4; ++o) if (pg[o] > gm) { gm = pg[o]; gi = o; }
            float gden = 0.f;
#pragma unroll
            for (int o = 0; o < 4; ++o) gden += expf(pg[o] - gm);
            const float grp_p = 1.0f / gden;
            float pe[8] = {0.f, 0.f, 0.f, 0.f, 0.f, 0.f, 0.f, 0.f};
            const float* wex = we + (size_t)gi * 1024 * 8;
#pragma unroll
            for (int j = 0; j < 4; ++j) {
#pragma unroll
                for (int cc = 0; cc < 4; ++cc) {
                    const int k = 4 * lane + 256 * j + cc; const f32x4 w0 = *(const f32x4*)(wex + (size_t)k * 8), w1 = *(const f32x4*)(wex + (size_t)k * 8 + 4); const float hv = r.v[j][cc];
                    pe[0] += hv * w0.x; pe[1] += hv * w0.y; pe[2] += hv * w0.z; pe[3] += hv * w0.w;
                    pe[4] += hv * w1.x; pe[5] += hv * w1.y; pe[6] += hv * w1.z; pe[7] += hv * w1.w;
                }
            }
#pragma unroll
            for (int o = 0; o < 8; ++o) pe[o] = wave_sum(pe[o]) + be[gi * 8 + o];
            int i0 = 0; float m0 = pe[0];
#pragma unroll
            for (int o = 1; o < 8; ++o) if (pe[o] > m0) { m0 = pe[o]; i0 = o; }
            int i1 = -1; float m1 = -INFINITY;
#pragma unroll
            for (int o = 0; o < 8; ++o) if (o != i0 && pe[o] > m1) { m1 = pe[o]; i1 = o; }
            const float p1 = expf(m1 - m0);
            const float w0 = grp_p / (1.0f + p1), w1 = grp_p * p1 / (1.0f + p1);
            if (lane == 0) { rec_e[rl * 2] = gi * 8 + i0; rec_e[rl * 2 + 1] = gi * 8 + i1; rec_w[rl * 2] = w0; rec_w[rl * 2 + 1] = w1; }
        }
        __syncthreads();
        { const int e = rec_e[tid]; rec_rank[tid] = atomicAdd(&hist[e], 1); }
        __syncthreads();
        if (tid < 32) { const int h = hist[tid]; base[tid] = h ? atomicAdd(&cnt[tid], h) : 0; }
        __syncthreads();
        { const int e = rec_e[tid], pos = base[e] + rec_rank[tid], tok = blk * 256 + (tid >> 1);
          ltok[(size_t)e * LISTCAP + pos] = tok; lw[(size_t)e * LISTCAP + pos] = rec_w[tid]; tslot[tok * 2 + (tid & 1)] = (e << 16) | pos; }
        __syncthreads();
    }
}

__device__ __forceinline__ void compute_rowbase(const int* cnt, int* rb  ) {
    if (threadIdx.x == 0) { int s = 0; for (int e = 0; e < 32; ++e) { rb[e] = s; s += (cnt[e] + 255) & ~255; } rb[32] = s; }
    __syncthreads();
}

template <bool FINAL>
__global__ void __launch_bounds__(512) k_r2(float* __restrict__ xres, const bf16_t* __restrict__ yw, const int* __restrict__ cnt, const int* __restrict__ tslot,
                                            const float* __restrict__ mod_cur, const float* __restrict__ gnext, const float* __restrict__ mod_next, bf16_t* __restrict__ xn) {
    __shared__ int rb[33];
    compute_rowbase(cnt, rb);
    const int lane = threadIdx.x & 63, wave = threadIdx.x >> 6;
    for (int row = blockIdx.x * 8 + wave; row < T; row += gridDim.x * 8) {
        const int b = row >> 12;
        const int s0 = tslot[row * 2], s1 = tslot[row * 2 + 1];
        const size_t r0 = (size_t)(rb[s0 >> 16] + (s0 & 0xffff)), r1 = (size_t)(rb[s1 >> 16] + (s1 & 0xffff));
        RowV r; row_load(r, xres + (size_t)row * D, lane);
        const float* g2 = mod_cur + (size_t)b * 6144 + 5120;
#pragma unroll
        for (int j = 0; j < 4; ++j) {
            const int o = 4 * lane + 256 * j;
            const u32x2 a = *(const u32x2*)(yw + r0 * D + o), c = *(const u32x2*)(yw + r1 * D + o);
            const f32x4 gg = *(const f32x4*)(g2 + o);
            f32x4 y; y.x = bflo(a.x) + bflo(c.x); y.y = bfhi(a.x) + bfhi(c.x); y.z = bflo(a.y) + bflo(c.y); y.w = bfhi(a.y) + bfhi(c.y);
            r.v[j] = r.v[j] + gg * y;
        }
        const float rstd = row_rstd(r);
        if (FINAL) {
#pragma unroll
            for (int j = 0; j < 4; ++j) { const f32x4 gg = *(const f32x4*)(gnext + 4 * lane + 256 * j); r.v[j] = r.v[j] * rstd * gg; }
            row_store_f32(r, xres + (size_t)row * D, lane);
        } else {
            row_store_f32(r, xres + (size_t)row * D, lane);
            const float* mb = mod_next + (size_t)b * 6144;
            row_modulate(r, rstd, gnext, mb + 0, mb + 1024, lane);
            row_store_bf16(r, xn + (size_t)row * D, lane);
        }
    }
}

enum { G_Z = 0, G_YPRE = 1, G_RES = 2, G_QKV = 3, G_E1 = 4, G_E2 = 5 };
struct GP {
    const bf16_t* A; int lda; const float* W1; const float* W2; int ldb; int K; int N;
    bf16_t* outb; int ldo; float* outf; const float* resin; const float* modg;
    const bf16_t* z; const float* convw;
    const int* cnt; const int* ltok; const float* lw;
    size_t wstride;
};
__device__ __forceinline__ float silu_f(float x) { return x / (1.0f + expf(-x)); }

template <int MODE>
__global__ void __launch_bounds__(256) k_gemm(GP p) {
    constexpr bool DUAL = (MODE == G_Z || MODE == G_E1);
    __shared__ float As[16][68];
    __shared__ float Bs[16][68];
    __shared__ float Bs2[DUAL ? 16 : 1][68];
    __shared__ int arow[64];
    __shared__ int rb[33];
    const int tid = threadIdx.x, tx = tid & 15, ty = tid >> 4;
    const int n0 = blockIdx.y * 64;
    int r0 = blockIdx.x * 64;
    const float* W1 = p.W1; const float* W2 = p.W2;
    int e = 0, local0 = 0, cnte = 0;
    if (MODE == G_E1 || MODE == G_E2) {
        compute_rowbase(p.cnt, rb);
        if (r0 >= rb[32]) return;
        while (rb[e + 1] <= r0) ++e;
        local0 = r0 - rb[e]; cnte = p.cnt[e];
        if (local0 >= cnte) return;
        W1 += (size_t)e * p.wstride; if (DUAL) W2 += (size_t)e * p.wstride;
        if (tid < 64) { const int l = local0 + tid; arow[tid] = (MODE == G_E1) ? (l < cnte ? p.ltok[(size_t)e * LISTCAP + l] : 0) : (r0 + tid); }
    } else {
        if (tid < 64) arow[tid] = r0 + tid;
    }
    __syncthreads();
    float acc[4][4], acc2[DUAL ? 4 : 1][4];
#pragma unroll
    for (int i = 0; i < 4; ++i)
#pragma unroll
        for (int j = 0; j < 4; ++j) { acc[i][j] = 0.f; if (DUAL) acc2[i][j] = 0.f; }
    const int la_row = tid >> 2, la_k = (tid & 3) * 4;
    const bf16_t* aptr = p.A + (size_t)arow[la_row] * p.lda + la_k;
    const int lb_k = tid >> 4, lb_n = (tid & 15) * 4;
    for (int k0 = 0; k0 < p.K; k0 += 16) {
        { const u32x2 a = *(const u32x2*)(aptr + k0);
          As[la_k + 0][la_row] = bflo(a.x); As[la_k + 1][la_row] = bfhi(a.x); As[la_k + 2][la_row] = bflo(a.y); As[la_k + 3][la_row] = bfhi(a.y); }
        { const f32x4 b = *(const f32x4*)(W1 + (size_t)(k0 + lb_k) * p.ldb + n0 + lb_n); *(f32x4*)&Bs[lb_k][lb_n] = b; }
        if (DUAL) { const f32x4 b = *(const f32x4*)(W2 + (size_t)(k0 + lb_k) * p.ldb + n0 + lb_n); *(f32x4*)&Bs2[lb_k][lb_n] = b; }
        __syncthreads();
#pragma unroll
        for (int k = 0; k < 16; ++k) {
            const f32x4 a = *(const f32x4*)&As[k][ty * 4], b = *(const f32x4*)&Bs[k][tx * 4];
            f32x4 b2; if (DUAL) b2 = *(const f32x4*)&Bs2[k][tx * 4];
#pragma unroll
            for (int i = 0; i < 4; ++i)
#pragma unroll
                for (int j = 0; j < 4; ++j) { acc[i][j] += a[i] * b[j]; if (DUAL) acc2[i][j] += a[i] * b2[j]; }
        }
        __syncthreads();
    }
#pragma unroll
    for (int i = 0; i < 4; ++i) {
        const int row = r0 + ty * 4 + i;
#pragma unroll
        for (int j = 0; j < 4; ++j) {
            const int col = n0 + tx * 4 + j; const float a1 = acc[i][j];
            if (MODE == G_Z) p.outb[(size_t)row * p.ldo + col] = (bf16_t)f2bf(a1 * acc2[i][j]);
            else if (MODE == G_YPRE) {
                const int t = row & (SEQ - 1);
                float zc = p.convw[2 * D + col] * bf2f(p.z[(size_t)row * D + col]);
                if (t >= 1) zc += p.convw[1 * D + col] * bf2f(p.z[(size_t)(row - 1) * D + col]);
                if (t >= 2) zc += p.convw[0 * D + col] * bf2f(p.z[(size_t)(row - 2) * D + col]);
                p.outb[(size_t)row * p.ldo + col] = (bf16_t)f2bf(a1 * zc);
            } else if (MODE == G_RES) {
                const int b = row >> 12;
                p.outf[(size_t)row * D + col] = p.resin[(size_t)row * D + col] + p.modg[(size_t)b * 6144 + col] * a1;
            } else if (MODE == G_QKV) p.outb[(size_t)row * p.ldo + col] = (bf16_t)f2bf(a1);
            else if (MODE == G_E1) { if (local0 + ty * 4 + i < cnte) p.outb[(size_t)row * p.ldo + col] = (bf16_t)f2bf(silu_f(a1) * acc2[i][j]); }
            else if (MODE == G_E2) { const int l = local0 + ty * 4 + i; if (l < cnte) p.outb[(size_t)row * p.ldo + col] = (bf16_t)f2bf(a1 * p.lw[(size_t)e * LISTCAP + l]); }
        }
    }
}

__global__ void __launch_bounds__(256) k_rope(bf16_t* __restrict__ qkv, const float* __restrict__ rope) {
    const size_t n = (size_t)T * 48;
    for (size_t i = (size_t)blockIdx.x * 256 + threadIdx.x; i < n; i += (size_t)gridDim.x * 256) {
        const int t = (int)(i / 48), r = (int)(i % 48), g = r / 16, typ = (r % 16) / 8, h = r % 8;
        bf16_t* p = qkv + (size_t)t * QKVW + g * 1536 + typ * 512 + h * 64;
        const int pos = t & (SEQ - 1);
        const float sc = typ == 0 ? QSCALE : 1.0f;
        float v[64];
#pragma unroll
        for (int c8 = 0; c8 < 8; ++c8) { const u32x4 w = *(const u32x4*)(p + c8 * 8);
#pragma unroll
            for (int k = 0; k < 4; ++k) { v[c8 * 8 + 2 * k] = bflo(w[k]); v[c8 * 8 + 2 * k + 1] = bfhi(w[k]); } }
#pragma unroll
        for (int f = 0; f < 8; ++f) {
            const float cs = rope[pos * 8 + f], sn = rope[4096 * 8 + pos * 8 + f];
            const float x1 = v[f], x2 = v[f + 8];
            v[f] = x1 * cs - x2 * sn; v[f + 8] = x2 * cs + x1 * sn;
        }
#pragma unroll
        for (int c8 = 0; c8 < 8; ++c8) { u32x4 w;
#pragma unroll
            for (int k = 0; k < 4; ++k) w[k] = pk2(v[c8 * 8 + 2 * k] * sc, v[c8 * 8 + 2 * k + 1] * sc);
            *(u32x4*)(p + c8 * 8) = w; }
    }
}
__global__ void __launch_bounds__(256) k_attn(bf16_t* __restrict__ qkv, float* __restrict__ lse) {
    const size_t n = (size_t)T * 24;
    for (size_t i = (size_t)blockIdx.x * 256 + threadIdx.x; i < n; i += (size_t)gridDim.x * 256) {
        const int t = (int)(i / 24), gh = (int)(i % 24), g = gh / 8, h = gh % 8;
        const int dil = g == 0 ? 1 : (g == 1 ? 4 : 16);
        const int pos = t & (SEQ - 1);
        bf16_t* qp = qkv + (size_t)t * QKVW + g * 1536 + h * 64;
        float q[64], o[64];
#pragma unroll
        for (int c8 = 0; c8 < 8; ++c8) { const u32x4 w = *(const u32x4*)(qp + c8 * 8);
#pragma unroll
            for (int k = 0; k < 4; ++k) { q[c8 * 8 + 2 * k] = bflo(w[k]); q[c8 * 8 + 2 * k + 1] = bfhi(w[k]); o[c8 * 8 + 2 * k] = 0.f; o[c8 * 8 + 2 * k + 1] = 0.f; } }
        float m = -INFINITY, l = 0.f;
        for (int j = 0; j <= 128; ++j) {
            const int kp = pos - j * dil; if (kp < 0) break;
            const bf16_t* kr = qkv + (size_t)(t - j * dil) * QKVW + g * 1536 + 512 + h * 64;
            const bf16_t* vr = kr + 512;
            float s = 0.f;
#pragma unroll
            for (int c8 = 0; c8 < 8; ++c8) { const u32x4 w = *(const u32x4*)(kr + c8 * 8);
#pragma unroll
                for (int k = 0; k < 4; ++k) s += q[c8 * 8 + 2 * k] * bflo(w[k]) + q[c8 * 8 + 2 * k + 1] * bfhi(w[k]); }
            const float mn = fmaxf(m, s), a = exp2f(m - mn), pv = exp2f(s - mn);
            l = l * a + pv;
#pragma unroll
            for (int c8 = 0; c8 < 8; ++c8) { const u32x4 w = *(const u32x4*)(vr + c8 * 8);
#pragma unroll
                for (int k = 0; k < 4; ++k) { o[c8 * 8 + 2 * k] = o[c8 * 8 + 2 * k] * a + pv * bflo(w[k]); o[c8 * 8 + 2 * k + 1] = o[c8 * 8 + 2 * k + 1] * a + pv * bfhi(w[k]); } }
            m = mn;
        }
        const float inv = 1.0f / l;
#pragma unroll
        for (int c8 = 0; c8 < 8; ++c8) { u32x4 w;
#pragma unroll
            for (int k = 0; k < 4; ++k) w[k] = pk2(o[c8 * 8 + 2 * k] * inv, o[c8 * 8 + 2 * k + 1] * inv);
            *(u32x4*)(qp + c8 * 8) = w; }
        lse[(size_t)t * 24 + gh] = m + log2f(l);
    }
}
__global__ void __launch_bounds__(256) k_attn_comb(const bf16_t* __restrict__ qkv, const float* __restrict__ lse, bf16_t* __restrict__ o) {
    const size_t n = (size_t)T * 64;
    for (size_t i = (size_t)blockIdx.x * 256 + threadIdx.x; i < n; i += (size_t)gridDim.x * 256) {
        const int t = (int)(i >> 6), r = (int)(i & 63), h = r >> 3, c = r & 7;
        const float l0 = lse[(size_t)t * 24 + h], l1 = lse[(size_t)t * 24 + 8 + h], l2 = lse[(size_t)t * 24 + 16 + h];
        const float mx = fmaxf(l0, fmaxf(l1, l2));
        float w0 = exp2f(l0 - mx), w1 = exp2f(l1 - mx), w2 = exp2f(l2 - mx);
        const float inv = 1.0f / (w0 + w1 + w2); w0 *= inv; w1 *= inv; w2 *= inv;
        const bf16_t* base = qkv + (size_t)t * QKVW + h * 64 + c * 8;
        const u32x4 a = *(const u32x4*)(base), b = *(const u32x4*)(base + 1536), cc = *(const u32x4*)(base + 3072);
        u32x4 out;
#pragma unroll
        for (int k = 0; k < 4; ++k) {
            const float lo = w0 * bflo(a[k]) + w1 * bflo(b[k]) + w2 * bflo(cc[k]);
            const float hi = w0 * bfhi(a[k]) + w1 * bfhi(b[k]) + w2 * bfhi(cc[k]);
            out[k] = pk2(lo, hi);
        }
        *(u32x4*)(o + (size_t)t * 512 + h * 64 + c * 8) = out;
    }
}

extern "C" void kernel_launch(void* const* d_in, const int* in_sizes, int n_in, void* d_out, int out_size, void* d_ws, size_t ws_size, hipStream_t stream) {
    const float* x = (const float*)d_in[0]; const float* c = (const float*)d_in[1];
    const float* norm_mix_g = (const float*)d_in[2]; const float* norm_ffn_g = (const float*)d_in[3];
    const float* ada_w = (const float*)d_in[4]; const float* ada_b = (const float*)d_in[5];
    const float* conv_in_w = (const float*)d_in[6]; const float* conv_w = (const float*)d_in[7]; const float* conv_out_w = (const float*)d_in[8];
    const float* attn_in_w = (const float*)d_in[9]; const float* attn_out_w = (const float*)d_in[10];
    const float* rgw = (const float*)d_in[11]; const float* rgb = (const float*)d_in[12]; const float* rew = (const float*)d_in[13]; const float* reb = (const float*)d_in[14];
    const float* gate_w = (const float*)d_in[15]; const float* up_w = (const float*)d_in[16]; const float* down_w = (const float*)d_in[17];
    const float* final_g = (const float*)d_in[18];
    unsigned char* ws = (unsigned char*)d_ws; float* xres = (float*)d_out;
    if (ws_size < WS_END) return;
    int* cnt = (int*)(ws + WS_CTL); float* mod = (float*)(ws + WS_MOD); float* rope = (float*)(ws + WS_ROPE);
    int* ltok = (int*)(ws + WS_LTOK); float* lw = (float*)(ws + WS_LW); int* tslot = (int*)(ws + WS_TSLOT); float* lse = (float*)(ws + WS_LSE);
    bf16_t* xn = (bf16_t*)(ws + WS_XN); bf16_t* zb = (bf16_t*)(ws + WS_Z); bf16_t* ypre = (bf16_t*)(ws + WS_YPRE);
    bf16_t* act = (bf16_t*)(ws + WS_ACT); bf16_t* yw = (bf16_t*)(ws + WS_YW); bf16_t* qkv = (bf16_t*)(ws + WS_QKV);
    bf16_t* ob = xn;

    hipMemsetAsync(ws + WS_CTL, 0, CTL_BYTES, stream);
    hipLaunchKernelGGL(k_prep, dim3(192 + 32), dim3(256), 0, stream, c, ada_w, ada_b, mod, rope);
    hipLaunchKernelGGL(k_r0, dim3(2048), dim3(512), 0, stream, x, norm_mix_g, mod, xn);
    { GP p{}; p.A = xn; p.lda = D; p.W1 = conv_in_w + 1024; p.W2 = conv_in_w + 2048; p.ldb = 3072; p.K = D; p.N = D; p.outb = zb; p.ldo = D;
      hipLaunchKernelGGL(k_gemm<G_Z>, dim3(T / 64, D / 64), dim3(256), 0, stream, p); }
    { GP p{}; p.A = xn; p.lda = D; p.W1 = conv_in_w; p.ldb = 3072; p.K = D; p.N = D; p.outb = ypre; p.ldo = D; p.z = zb; p.convw = conv_w;
      hipLaunchKernelGGL(k_gemm<G_YPRE>, dim3(T / 64, D / 64), dim3(256), 0, stream, p); }
    { GP p{}; p.A = ypre; p.lda = D; p.W1 = conv_out_w; p.ldb = D; p.K = D; p.N = D; p.outf = xres; p.resin = x; p.modg = mod + 2048;
      hipLaunchKernelGGL(k_gemm<G_RES>, dim3(T / 64, D / 64), dim3(256), 0, stream, p); }
    for (int l = 0; l < 2; ++l) {
        const float* modl = mod + (size_t)l * 16 * 6144;
        if (l == 1) {
            { GP p{}; p.A = xn; p.lda = D; p.W1 = attn_in_w; p.ldb = QKVW; p.K = D; p.N = QKVW; p.outb = qkv; p.ldo = QKVW;
              hipLaunchKernelGGL(k_gemm<G_QKV>, dim3(T / 64, QKVW / 64), dim3(256), 0, stream, p); }
            hipLaunchKernelGGL(k_rope, dim3(4096), dim3(256), 0, stream, qkv, rope);
            hipLaunchKernelGGL(k_attn, dim3(6144), dim3(256), 0, stream, qkv, lse);
            hipLaunchKernelGGL(k_attn_comb, dim3(4096), dim3(256), 0, stream, qkv, lse, ob);
            { GP p{}; p.A = ob; p.lda = 512; p.W1 = attn_out_w; p.ldb = D; p.K = 512; p.N = D; p.outf = xres; p.resin = xres; p.modg = modl + 2048;
              hipLaunchKernelGGL(k_gemm<G_RES>, dim3(T / 64, D / 64), dim3(256), 0, stream, p); }
        }
        int* cntl = cnt + 64 * l;
        hipLaunchKernelGGL(k_r1, dim3(256), dim3(512), 0, stream, xres, norm_ffn_g + l * D, modl, rgw + (size_t)l * D * 4, rgb + l * 4, rew + (size_t)l * 4 * D * 8, reb + l * 32,
                           xn, cntl, ltok, lw, tslot);
        { GP p{}; p.A = xn; p.lda = D; p.W1 = gate_w + (size_t)l * NEXP * D * DEXP; p.W2 = up_w + (size_t)l * NEXP * D * DEXP; p.ldb = DEXP; p.K = D; p.N = DEXP; p.outb = act; p.ldo = DEXP;
          p.cnt = cntl; p.ltok = ltok; p.lw = lw; p.wstride = (size_t)D * DEXP;
          hipLaunchKernelGGL(k_gemm<G_E1>, dim3(PADROWS / 64, DEXP / 64), dim3(256), 0, stream, p); }
        { GP p{}; p.A = act; p.lda = DEXP; p.W1 = down_w + (size_t)l * NEXP * DEXP * D; p.ldb = D; p.K = DEXP; p.N = D; p.outb = yw; p.ldo = D;
          p.cnt = cntl; p.ltok = ltok; p.lw = lw; p.wstride = (size_t)DEXP * D;
          hipLaunchKernelGGL(k_gemm<G_E2>, dim3(PADROWS / 64, D / 64), dim3(256), 0, stream, p); }
        if (l == 0) hipLaunchKernelGGL(k_r2<false>, dim3(2048), dim3(512), 0, stream, xres, yw, cntl, tslot, modl, norm_mix_g + D, mod + (size_t)16 * 6144, xn);
        else hipLaunchKernelGGL(k_r2<true>, dim3(2048), dim3(512), 0, stream, xres, yw, cntl, tslot, modl, final_g, modl, xn);
    }
}
```

```cpp
#include <hip/hip_runtime.h>
#include <stdint.h>
#include <math.h>
#include <cstdio>

#ifndef MK_ONE_LAUNCH
#define MK_ONE_LAUNCH 1
#endif

typedef unsigned short bf16_t;
typedef float f32x4 __attribute__((ext_vector_type(4)));
typedef unsigned u32x2 __attribute__((ext_vector_type(2)));
typedef unsigned u32x4 __attribute__((ext_vector_type(4)));
#define GAS __attribute__((address_space(1)))
#define LAS __attribute__((address_space(3)))
typedef GAS unsigned gu32;
#define RLX_AGENT __ATOMIC_RELAXED, __HIP_MEMORY_SCOPE_AGENT

constexpr int D = 1024, BATCH = 16, SEQ = 4096, T = BATCH * SEQ;
constexpr int NEXP = 32, DEXP = 512, EPG = 8, NGRP = 4;
constexpr int QKVW = 4608;
constexpr int LISTCAP = 65536;
constexpr int PADROWS = 139264;
constexpr float EPS = 1e-6f;
constexpr float QSCALE = 0.125f * 1.4426950408889634f;
constexpr int NWAVES = 8;

constexpr size_t MiB = 1u << 20;
constexpr size_t WS_CTL = 0;
constexpr size_t CTL_BYTES = 1 * MiB;
constexpr int CW_BAR = 4096;
constexpr size_t WS_MOD = 1 * MiB;
constexpr size_t WS_ROPE = 3 * MiB;
constexpr size_t WS_LTOK = 4 * MiB;
constexpr size_t WS_LW = 12 * MiB;
constexpr size_t WS_TSLOT = 20 * MiB;
constexpr size_t WS_LSE = 24 * MiB;
constexpr size_t WS_WZ = 32 * MiB;
constexpr size_t WS_WB = 36 * MiB;
constexpr size_t WS_WCO = 38 * MiB;
constexpr size_t WS_WAI = 40 * MiB;
constexpr size_t WS_WAO = 49 * MiB;
constexpr size_t WS_WGU = 64 * MiB;
constexpr size_t WS_WDN = 192 * MiB;
constexpr size_t WS_XN = 256 * MiB;
constexpr size_t WS_BIG = 384 * MiB;
constexpr size_t WS_Z = WS_BIG, WS_YPRE = WS_BIG + 128 * MiB;
constexpr size_t WS_ACT = WS_BIG, WS_YW = WS_BIG + 136 * MiB;
constexpr size_t WS_QKV = WS_BIG;
constexpr size_t WS_END = WS_BIG + 576 * MiB;

constexpr int RING_BYTES = 133120;
constexpr int MISC_OFF = RING_BYTES;
constexpr int LDS_BYTES = RING_BYTES + 1024;

__device__ __forceinline__ unsigned f2bf(float f) { unsigned u = __float_as_uint(f); return (u + 0x7fffu + ((u >> 16) & 1u)) >> 16; }
__device__ __forceinline__ unsigned pk2(float lo, float hi) { return f2bf(lo) | (f2bf(hi) << 16); }
__device__ __forceinline__ float bf2f(unsigned h) { return __uint_as_float(h << 16); }
__device__ __forceinline__ float bflo(unsigned w) { return __uint_as_float(w << 16); }
__device__ __forceinline__ float bfhi(unsigned w) { return __uint_as_float(w & 0xffff0000u); }
__device__ __forceinline__ float wave_sum(float v) {
#pragma unroll
    for (int o = 1; o < 64; o <<= 1) v += __shfl_xor(v, o);
    return v;
}
__device__ __forceinline__ float silu_f(float x) { return x / (1.0f + __expf(-x)); }
#define LDS_WAIT() asm volatile("s_waitcnt lgkmcnt(0)" ::: "memory")
__device__ __forceinline__ int lane_id() { int l; asm volatile("v_mbcnt_lo_u32_b32 %0, -1, 0\n\tv_mbcnt_hi_u32_b32 %0, -1, %0" : "=v"(l)); return l; }

namespace pg8 {
#define PG8_LAS __attribute__((address_space(3)))
typedef unsigned short bf16_t;
typedef short bf16x8 __attribute__((ext_vector_type(8)));
typedef float f32x4 __attribute__((ext_vector_type(4)));
typedef unsigned u32x4 __attribute__((ext_vector_type(4)));
constexpr int BM = 256, BK = 64, HALF = 128, HTB = HALF * BK * 2  , STAGE_BYTES = 8 * HTB, NXCD = 8, WGM = 8;

__host__ __device__ __forceinline__ int lds_byte(int r, int c) { const int st = (r >> 4) * 2 + (c >> 5), rr = r & 15, cc = c & 31, ob = rr * 64 + cc * 2; return st * 1024 + (ob ^ (((ob >> 9) & 1) << 5)); }
__host__ __device__ __forceinline__ void stage_rc(int b, int& R, int& C) { const int st = b / 1024, sb = b % 1024, swz = sb ^ (((sb >> 9) & 1) << 5); R = (st >> 1) * 16 + swz / 64; C = (st & 1) * 32 + (swz % 64) / 2; }
__host__ __device__ __forceinline__ int perm32(int rho) { const int n = rho >> 4, i = rho & 15; return 8 * (i >> 2) + 4 * n + (i & 3); }

struct Unit { int pm, pn, pb; };
struct Gemm { const bf16_t* A; const bf16_t* Bt; int M, N, K; };

struct StaticOrder {
    int nM, nN, nwg, G, c;
    __host__ __device__ void init(int M, int N, int G_, int c_) { nM = M / BM; nN = N / BM; nwg = nM * nN; G = G_; c = c_; }
    __host__ __device__ bool next(int i, Unit& u) const {
        const long L = (long)i * G + c; if (L >= nwg) return false;
        int wgid = (int)L; { const int q = nwg / NXCD, r = nwg % NXCD, xcd = wgid % NXCD, off = wgid / NXCD; wgid = (xcd < r ? xcd * (q + 1) : r * (q + 1) + (xcd - r) * q) + off; }
        const int nig = WGM * nN, gid = wgid / nig, fm = gid * WGM, gsz = (nM - fm) < WGM ? (nM - fm) : WGM;
        u.pm = fm + ((wgid % nig) % gsz); u.pn = (wgid % nig) / gsz; u.pb = u.pn; return true;
    }
    __device__ __forceinline__ void a_ready(const Unit&) const {}
    __device__ __forceinline__ void done(const Unit&) const {}
};


__device__ __forceinline__ unsigned cvt_pk_bf16(float lo, float hi) { unsigned r; asm volatile("v_cvt_pk_bf16_f32 %0, %1, %2" : "=v"(r) : "v"(lo), "v"(hi)); return r; }
typedef float f32x2 __attribute__((ext_vector_type(2)));

template <class Epi, class Sched, class AM, bool ALIGN_EPI = false, bool SP2 = false>
__device__ __forceinline__ void gemm_phase(PG8_LAS unsigned char* lds, const Gemm g, const Sched& S, const Epi& E, const AM& am, const int wid) {
    const int lane = lane_id(), tid = wid * 64 + lane, wr = wid >> 2, wc = wid & 3, fr = lane & 15, fq = lane >> 4;
    const int K = g.K, nt = K / BK;
    unsigned voffA[2], voffB[2]; int stR[2], stC[2];
#pragma unroll
    for (int i = 0; i < 2; ++i) { int R, C; stage_rc(tid * 16 + i * 8192, R, C); const int Rb = Epi::PERM ? ((R & ~31) + perm32(R & 31)) : R;
        stR[i] = R; stC[i] = C; voffA[i] = (unsigned)(R * K + C) * 2u; voffB[i] = (unsigned)(Rb * K + C) * 2u; }
    const size_t kstep = (size_t)(BK * 2);
    const size_t hstep = (size_t)HALF * K * 2;
    const size_t tstep = 2 * hstep;
    const unsigned ldsw = (unsigned)wid * 1024u;
    const int aoff = lds_byte(wr * 64 + fr, fq * 8), boff = lds_byte(wc * 32 + fr, fq * 8);
#define PG8_SA(b, h) (((b) * 2 + (h)) * HTB)
#define PG8_SB(b, h) ((4 + (b) * 2 + (h)) * HTB)
#define PG8_STAGE(bufoff, gbase, voff) do { _Pragma("unroll") for (int _i = 0; _i < 2; ++_i) \
        __builtin_amdgcn_global_load_lds((const unsigned*)((const char*)(gbase) + (voff)[_i]), (PG8_LAS unsigned*)(lds + (bufoff) + ldsw + _i * 8192), 16, 0, 0); } while (0)
#define PG8_STAGE_A(b, h, gbase, NX) do { if constexpr (AM::GATHER) { const unsigned so_[2] = {(NX) ? gno[h][0] : gao[h][0], (NX) ? gno[h][1] : gao[h][1]}; PG8_STAGE(PG8_SA(b, h), gbase, so_); } \
        else { PG8_STAGE(PG8_SA(b, h), (gbase) + (h) * hstep, voffA); } } while (0)
#define PG8_LDA(dst, b, h) do { _Pragma("unroll") for (int m = 0; m < 4; ++m) _Pragma("unroll") for (int k = 0; k < 2; ++k) dst[m][k] = *(const PG8_LAS bf16x8*)(lds + PG8_SA(b, h) + aoff + m * 2048 + k * 1024); } while (0)
#define PG8_LDB(dst, b, h) do { _Pragma("unroll") for (int n = 0; n < 2; ++n) _Pragma("unroll") for (int k = 0; k < 2; ++k) dst[n][k] = *(const PG8_LAS bf16x8*)(lds + PG8_SB(b, h) + boff + n * 2048 + k * 1024); } while (0)
#define PG8_MMA(ai, bj, At, Bt) do { __builtin_amdgcn_s_setprio(1); _Pragma("unroll") for (int m = 0; m < 4; ++m) _Pragma("unroll") for (int n = 0; n < 2; ++n) _Pragma("unroll") for (int k = 0; k < 2; ++k) \
        acc[ai][bj][m][n] = __builtin_amdgcn_mfma_f32_16x16x32_bf16(Bt[n][k], At[m][k], acc[ai][bj][m][n], 0, 0, 0); __builtin_amdgcn_s_setprio(0); } while (0)
#define PG8_WAIT_V(n) asm volatile("s_waitcnt vmcnt(" #n ")" ::: "memory")
#define PG8_WAIT_L(n) asm volatile("s_waitcnt lgkmcnt(" #n ")" ::: "memory")
#define PG8_BAR __builtin_amdgcn_s_barrier()
#define PG8_SCHED __builtin_amdgcn_sched_barrier(0)
    Unit cur, nxt; int ui = 0;
    if (!S.next(0, cur)) return;
    f32x4 acc[2][2][4][2];
#pragma unroll
    for (int a = 0; a < 2; ++a)
#pragma unroll
        for (int b = 0; b < 2; ++b)
#pragma unroll
            for (int m = 0; m < 4; ++m)
#pragma unroll
                for (int n = 0; n < 2; ++n) acc[a][b][m][n] = (f32x4){0.f, 0.f, 0.f, 0.f};
    bf16x8 At[4][2], B0[2][2], B1[2][2];
    const char* cA = (const char*)g.A + (AM::GATHER ? (size_t)0 : (size_t)cur.pm * tstep); const char* cB = (const char*)g.Bt + (size_t)cur.pb * tstep;
    unsigned gao[2][2], gno[2][2];
    if constexpr (AM::GATHER) { _Pragma("unroll") for (int h = 0; h < 2; ++h) _Pragma("unroll") for (int i = 0; i < 2; ++i) { gao[h][i] = (unsigned)(am.arow(cur, h * HALF + stR[i]) * K + stC[i]) * 2u; gno[h][i] = gao[h][i]; } }
    else { _Pragma("unroll") for (int h = 0; h < 2; ++h) _Pragma("unroll") for (int i = 0; i < 2; ++i) { gao[h][i] = 0u; gno[h][i] = 0u; } }
    S.a_ready(cur);
    if constexpr (SP2) {
        PG8_STAGE(PG8_SB(0, 0), cB, voffB); PG8_STAGE(PG8_SB(0, 1), cB + hstep, voffB); PG8_STAGE_A(0, 0, cA, false); PG8_STAGE_A(0, 1, cA, false);
        if (wr == 1) PG8_BAR;
        PG8_WAIT_V(2); PG8_BAR;
        PG8_STAGE(PG8_SB(1, 0), cB + kstep, voffB); PG8_STAGE_A(1, 0, cA + kstep, false); PG8_STAGE(PG8_SB(1, 1), cB + hstep + kstep, voffB);
        PG8_WAIT_V(6); PG8_BAR;
    } else {
        PG8_STAGE(PG8_SB(0, 0), cB, voffB); PG8_STAGE_A(0, 0, cA, false); PG8_STAGE(PG8_SB(0, 1), cB + hstep, voffB); PG8_STAGE_A(0, 1, cA, false);
        if (wr == 1) PG8_BAR;
        PG8_WAIT_V(4); PG8_BAR;
        PG8_STAGE(PG8_SB(1, 0), cB + kstep, voffB); PG8_STAGE_A(1, 0, cA + kstep, false); PG8_STAGE(PG8_SB(1, 1), cB + hstep + kstep, voffB);
        PG8_WAIT_V(6); PG8_BAR;
    }
    for (;;) {
        const bool has_next = S.next(ui + 1, nxt);
        const char* nA = has_next ? (const char*)g.A + (AM::GATHER ? (size_t)0 : (size_t)nxt.pm * tstep) : cA; const char* nB = has_next ? (const char*)g.Bt + (size_t)nxt.pb * tstep : cB;
        if constexpr (AM::GATHER) { if (has_next) { _Pragma("unroll") for (int h = 0; h < 2; ++h) _Pragma("unroll") for (int i = 0; i < 2; ++i) gno[h][i] = (unsigned)(am.arow(nxt, h * HALF + stR[i]) * K + stC[i]) * 2u; } }
        for (int t = 0; t < nt; t += 2) {
            const bool last = (t == nt - 2);
            const char* a1 = cA + (size_t)(t + 1) * kstep;
            const char* a2 = last ? nA : cA + (size_t)(t + 2) * kstep; const char* b2 = last ? nB : cB + (size_t)(t + 2) * kstep;
            const char* a3 = a2 + kstep; const char* b3 = b2 + kstep;
            if (last && has_next) S.a_ready(nxt);
            if constexpr (SP2) {
            PG8_LDB(B0, 0, 0); PG8_LDB(B1, 0, 1); PG8_SCHED; PG8_LDA(At, 0, 0); PG8_STAGE_A(1, 1, a1, false);
            PG8_WAIT_V(8); PG8_WAIT_L(0); PG8_BAR; PG8_MMA(0, 0, At, B0); PG8_MMA(0, 1, At, B1); PG8_BAR; PG8_SCHED;
            PG8_LDA(At, 0, 1); PG8_STAGE(PG8_SB(0, 0), b2, voffB); PG8_STAGE(PG8_SB(0, 1), b2 + hstep, voffB); PG8_STAGE_A(0, 0, a2, last);
            PG8_WAIT_V(8); PG8_WAIT_L(0); PG8_BAR; PG8_MMA(1, 0, At, B0); PG8_MMA(1, 1, At, B1); PG8_BAR; PG8_SCHED;
            PG8_LDB(B0, 1, 0); PG8_LDB(B1, 1, 1); PG8_SCHED; PG8_LDA(At, 1, 0); PG8_STAGE_A(0, 1, a2, last);
            PG8_WAIT_V(8); PG8_WAIT_L(0); PG8_BAR; PG8_MMA(0, 0, At, B0); PG8_MMA(0, 1, At, B1); PG8_BAR; PG8_SCHED;
            PG8_LDA(At, 1, 1); PG8_STAGE(PG8_SB(1, 0), b3, voffB); PG8_STAGE(PG8_SB(1, 1), b3 + hstep, voffB); PG8_STAGE_A(1, 0, a3, last);
            PG8_WAIT_V(8); PG8_WAIT_L(0); PG8_BAR; PG8_MMA(1, 0, At, B0); PG8_MMA(1, 1, At, B1); PG8_BAR; PG8_SCHED;
            } else {
            PG8_LDB(B0, 0, 0); PG8_SCHED; PG8_LDA(At, 0, 0); PG8_STAGE_A(1, 1, a1, false);
            PG8_WAIT_L(8); PG8_BAR; PG8_WAIT_L(0); PG8_MMA(0, 0, At, B0); PG8_BAR; PG8_SCHED;
            PG8_LDB(B1, 0, 1); PG8_STAGE(PG8_SB(0, 0), b2, voffB);
            PG8_BAR; PG8_WAIT_L(0); PG8_MMA(0, 1, At, B1); PG8_BAR;
            PG8_LDA(At, 0, 1); PG8_STAGE_A(0, 0, a2, last);
            PG8_BAR; PG8_WAIT_L(0); PG8_MMA(1, 0, At, B0); PG8_BAR; PG8_SCHED;
            PG8_STAGE(PG8_SB(0, 1), b2 + hstep, voffB);
            PG8_WAIT_V(6); PG8_BAR; PG8_MMA(1, 1, At, B1); PG8_BAR;
            PG8_LDB(B0, 1, 0); PG8_SCHED; PG8_LDA(At, 1, 0); PG8_STAGE_A(0, 1, a2, last);
            PG8_WAIT_L(8); PG8_BAR; PG8_WAIT_L(0); PG8_MMA(0, 0, At, B0); PG8_BAR; PG8_SCHED;
            PG8_LDB(B1, 1, 1); PG8_STAGE(PG8_SB(1, 0), b3, voffB);
            PG8_BAR; PG8_WAIT_L(0); PG8_MMA(0, 1, At, B1); PG8_BAR;
            PG8_LDA(At, 1, 1); PG8_STAGE_A(1, 0, a3, last);
            PG8_BAR; PG8_WAIT_L(0); PG8_MMA(1, 0, At, B0); PG8_BAR; PG8_SCHED;
            PG8_STAGE(PG8_SB(1, 1), b3 + hstep, voffB);
            PG8_WAIT_V(6); PG8_BAR; PG8_MMA(1, 1, At, B1); PG8_BAR;
            }
        }
        if constexpr (ALIGN_EPI) { if (wr == 0) PG8_BAR; }
        if constexpr (!Epi::AFTER_DRAIN) { E(acc, cur, wr, wc, fr, fq); S.done(cur); }
        if (!has_next) break;
#pragma unroll
        for (int a = 0; a < 2; ++a)
#pragma unroll
            for (int b = 0; b < 2; ++b)
#pragma unroll
                for (int m = 0; m < 4; ++m)
#pragma unroll
                    for (int n = 0; n < 2; ++n) acc[a][b][m][n] = (f32x4){0.f, 0.f, 0.f, 0.f};
        cur = nxt; cA = nA; cB = nB; ++ui;
        if constexpr (AM::GATHER) { _Pragma("unroll") for (int h = 0; h < 2; ++h) _Pragma("unroll") for (int i = 0; i < 2; ++i) gao[h][i] = gno[h][i]; }
        if constexpr (ALIGN_EPI) { if (wr == 1) PG8_BAR; }
    }
    PG8_WAIT_V(0);
    if constexpr (!ALIGN_EPI) { if (wr == 0) PG8_BAR; }
    PG8_BAR;
    if constexpr (Epi::AFTER_DRAIN) { E.fused(acc, cur, wr, wc, fr, fq, lds, wid, lane); S.done(cur); }
#undef PG8_SA
#undef PG8_SB
#undef PG8_STAGE
#undef PG8_STAGE_A
#undef PG8_LDA
#undef PG8_LDB
#undef PG8_MMA
#undef PG8_WAIT_V
#undef PG8_WAIT_L
#undef PG8_BAR
#undef PG8_SCHED
}

__device__ __forceinline__ u32x4 pack8(const f32x4 v0, const f32x4 v1) { u32x4 w; w.x = cvt_pk_bf16(v0[0], v0[1]); w.y = cvt_pk_bf16(v0[2], v0[3]); w.z = cvt_pk_bf16(v1[0], v1[1]); w.w = cvt_pk_bf16(v1[2], v1[3]); return w; }
__device__ __forceinline__ float silu1(float x) { return x * __builtin_amdgcn_rcpf(1.0f + __builtin_amdgcn_exp2f(-1.4426950408889634f * x)); }
template <bool SILU> struct EpiPair {
    static constexpr bool PERM = true, AFTER_DRAIN = false;
    bf16_t* O; int ldc;
    __device__ __forceinline__ void operator()(const f32x4 (&acc)[2][2][4][2], const Unit& u, int wr, int wc, int fr, int fq) const {
        const int row0 = u.pm * BM + wr * 64 + fr, ch0 = u.pn * HALF + wc * 32 + 8 * fq;
#pragma unroll
        for (int ai = 0; ai < 2; ++ai)
#pragma unroll
            for (int m = 0; m < 4; ++m) {
                f32x4 a0 = acc[ai][0][m][0], a1 = acc[ai][0][m][1];
                if (SILU) {
#pragma unroll
                    for (int c = 0; c < 4; ++c) { a0[c] = silu1(a0[c]); a1[c] = silu1(a1[c]); }
                }
                *(u32x4*)(O + (size_t)(row0 + ai * HALF + m * 16) * ldc + ch0) = pack8(a0 * acc[ai][1][m][0], a1 * acc[ai][1][m][1]);
            }
    }
};
struct EpiYpre {
    static constexpr bool PERM = true, AFTER_DRAIN = false;
    bf16_t* O; const bf16_t* Z; const float* cw;
    __device__ __forceinline__ void operator()(const f32x4 (&acc)[2][2][4][2], const Unit& u, int wr, int wc, int fr, int fq) const {
        const int row0 = u.pm * BM + wr * 64 + fr;
#pragma unroll
        for (int bj = 0; bj < 2; ++bj) {
            const int col0 = u.pn * BM + bj * HALF + wc * 32 + 8 * fq;
            f32x4 w0[2], w1[2], w2[2];
#pragma unroll
            for (int n = 0; n < 2; ++n) { w0[n] = *(const f32x4*)(cw + col0 + 4 * n); w1[n] = *(const f32x4*)(cw + D + col0 + 4 * n); w2[n] = *(const f32x4*)(cw + 2 * D + col0 + 4 * n); }
#pragma unroll
            for (int ai = 0; ai < 2; ++ai)
#pragma unroll
                for (int m = 0; m < 4; ++m) {
                    const int row = row0 + ai * HALF + m * 16, t = row & (SEQ - 1);
                    const bf16_t* zp = Z + (size_t)row * D + col0;
                    const u32x4 z0 = *(const u32x4*)zp;
                    u32x4 z1 = {0u, 0u, 0u, 0u}, z2 = {0u, 0u, 0u, 0u};
                    if (t >= 1) z1 = *(const u32x4*)(zp - D);
                    if (t >= 2) z2 = *(const u32x4*)(zp - 2 * D);
                    f32x4 v[2];
#pragma unroll
                    for (int n = 0; n < 2; ++n) {
                        f32x4 a, b, c;
                        a[0] = __uint_as_float(z0[2 * n] << 16); a[1] = __uint_as_float(z0[2 * n] & 0xffff0000u); a[2] = __uint_as_float(z0[2 * n + 1] << 16); a[3] = __uint_as_float(z0[2 * n + 1] & 0xffff0000u);
                        b[0] = __uint_as_float(z1[2 * n] << 16); b[1] = __uint_as_float(z1[2 * n] & 0xffff0000u); b[2] = __uint_as_float(z1[2 * n + 1] << 16); b[3] = __uint_as_float(z1[2 * n + 1] & 0xffff0000u);
                        c[0] = __uint_as_float(z2[2 * n] << 16); c[1] = __uint_as_float(z2[2 * n] & 0xffff0000u); c[2] = __uint_as_float(z2[2 * n + 1] << 16); c[3] = __uint_as_float(z2[2 * n + 1] & 0xffff0000u);
                        v[n] = acc[ai][bj][m][n] * (w2[n] * a + w1[n] * b + w0[n] * c);
                    }
                    *(u32x4*)(O + (size_t)row * D + col0) = pack8(v[0], v[1]);
                    if (m & 1) asm volatile("" ::: "memory");
                }
        }
    }
};
struct EpiRes {
    static constexpr bool PERM = false, AFTER_DRAIN = false;
    float* out; const float* resin; const float* modg;
    __device__ __forceinline__ void operator()(const f32x4 (&acc)[2][2][4][2], const Unit& u, int wr, int wc, int fr, int fq) const {
        const int row0 = u.pm * BM + wr * 64 + fr, col0 = u.pn * BM + wc * 32 + 4 * fq;
        const float* gb = modg + (size_t)((u.pm * BM) >> 12) * 6144;
        f32x4 gv[2][2];
#pragma unroll
        for (int bj = 0; bj < 2; ++bj)
#pragma unroll
            for (int n = 0; n < 2; ++n) gv[bj][n] = *(const f32x4*)(gb + col0 + bj * HALF + n * 16);
#pragma unroll
        for (int ai = 0; ai < 2; ++ai)
#pragma unroll
            for (int m = 0; m < 4; ++m) { const size_t off = (size_t)(row0 + ai * HALF + m * 16) * D + col0;
#pragma unroll
                for (int bj = 0; bj < 2; ++bj)
#pragma unroll
                    for (int n = 0; n < 2; ++n) { const f32x4 r = *(const f32x4*)(resin + off + bj * HALF + n * 16); *(f32x4*)(out + off + bj * HALF + n * 16) = r + gv[bj][n] * acc[ai][bj][m][n]; }
                if (m & 1) asm volatile("" ::: "memory"); }
    }
};
struct EpiQKV {
    static constexpr bool PERM = true, AFTER_DRAIN = false;
    bf16_t* O; const float* rope;
    __device__ __forceinline__ void operator()(const f32x4 (&acc)[2][2][4][2], const Unit& u, int wr, int wc, int fr, int fq) const {
        const int row0 = u.pm * BM + wr * 64 + fr, col0 = u.pn * BM + wc * 32 + 8 * fq;
        const int typ = (u.pn % 6) >> 1;
        const bool rl = (typ < 2) && ((wc & 1) == 0) && (fq < 2);
        const float sc = (typ == 0) ? QSCALE : 1.0f;
#pragma unroll
        for (int ai = 0; ai < 2; ++ai)
#pragma unroll
            for (int m = 0; m < 4; ++m) {
                const int row = row0 + ai * HALF + m * 16, pos = row & (SEQ - 1);
                f32x4 cs = {1.f, 1.f, 1.f, 1.f}, sn = {0.f, 0.f, 0.f, 0.f};
                { const f32x4 c_ = *(const f32x4*)(rope + pos * 8 + 4 * (fq & 1)), s_ = *(const f32x4*)(rope + 4096 * 8 + pos * 8 + 4 * (fq & 1));
                  if (rl) { cs = c_; sn = s_; } }
#pragma unroll
                for (int bj = 0; bj < 2; ++bj) {
                    const f32x4 x1 = acc[ai][bj][m][0], x2 = acc[ai][bj][m][1];
                    const f32x4 r1 = (x1 * cs - x2 * sn) * sc, r2 = (x2 * cs + x1 * sn) * sc;
                    *(u32x4*)(O + (size_t)row * QKVW + col0 + bj * HALF) = pack8(r1, r2);
                }
                if (m & 1) asm volatile("" ::: "memory");
            }
    }
};
struct EpiDown {
    static constexpr bool PERM = true, AFTER_DRAIN = false;
    bf16_t* O; const float* lw; const PG8_LAS int* rb;
    __device__ __forceinline__ void operator()(const f32x4 (&acc)[2][2][4][2], const Unit& u, int wr, int wc, int fr, int fq) const {
        const int row0 = u.pm * BM + wr * 64 + fr, col0 = u.pn * BM + wc * 32 + 8 * fq;
        const int e = u.pb >> 2; const float* wrow = lw + (size_t)e * LISTCAP - rb[e];
#pragma unroll
        for (int ai = 0; ai < 2; ++ai)
#pragma unroll
            for (int m = 0; m < 4; ++m) {
                const int row = row0 + ai * HALF + m * 16; const float w = wrow[row];
#pragma unroll
                for (int bj = 0; bj < 2; ++bj) *(u32x4*)(O + (size_t)row * D + col0 + bj * HALF) = pack8(acc[ai][bj][m][0] * w, acc[ai][bj][m][1] * w);
            }
    }
};
struct MoeOrder {
    int nM, nN, nwg, G, c; const PG8_LAS int* rb;
    __device__ void init(int nRT, int G_, int c_, const PG8_LAS int* rb_) { nM = nRT; nN = 4; nwg = nM * nN; G = G_; c = c_; rb = rb_; }
    __device__ bool next(int i, Unit& u) const {
        const long L = (long)i * G + c; if (L >= nwg) return false;
        int wgid = (int)L; { const int q = nwg / NXCD, r = nwg % NXCD, xcd = wgid % NXCD, off = wgid / NXCD; wgid = (xcd < r ? xcd * (q + 1) : r * (q + 1) + (xcd - r) * q) + off; }
        const int nig = WGM * nN, gid = wgid / nig, fm = gid * WGM, gsz = (nM - fm) < WGM ? (nM - fm) : WGM;
        u.pm = fm + ((wgid % nig) % gsz); u.pn = (wgid % nig) / gsz;
        int e = 0; const int r0 = u.pm * BM; while (e < 31 && rb[e + 1] <= r0) ++e;
        u.pb = e * 4 + u.pn; return true;
    }
    __device__ __forceinline__ void a_ready(const Unit&) const {}
    __device__ __forceinline__ void done(const Unit&) const {}
};
struct APlain { static constexpr bool GATHER = false; __device__ __forceinline__ int arow(const Unit&, int) const { return 0; } };
struct AGather {
    static constexpr bool GATHER = true;
    const int* ltok; const int* cnt; const PG8_LAS int* rb;
    __device__ __forceinline__ int arow(const Unit& u, int r) const { const int e = u.pb >> 2, l = u.pm * BM - rb[e] + r; return (l < cnt[e]) ? ltok[(size_t)e * LISTCAP + l] : 0; }
};
}

#define XB_TMO      128
#define XB_XCNT(j)  (256  + 64 * (j))
#define XB_XSUB(j)  (1280 + 64 * (j))
#define XB_XGEN(j)  (2304 + 64 * (j))
#define XB_TOP      3328
#define XB_TOPGEN   3392
#define XCD_BAR_WORDS 3456
#define XB_SPIN_CAP (1u << 18)

__device__ __forceinline__ unsigned xb_ld(unsigned* p)              { return __hip_atomic_load(p, __ATOMIC_RELAXED, __HIP_MEMORY_SCOPE_AGENT); }
__device__ __forceinline__ unsigned xb_add(unsigned* p, unsigned v) { return __hip_atomic_fetch_add(p, v, __ATOMIC_RELAXED, __HIP_MEMORY_SCOPE_AGENT); }
__device__ __forceinline__ unsigned xb_xcc_id() { return (unsigned)__builtin_amdgcn_s_getreg((3 << 11) | 20) & 0xFu; }
#define XB_SPIN(cond, bar) do { unsigned _sp = 0; while (cond) { __builtin_amdgcn_s_sleep(1); \
    if ((++_sp & 255u) == 0u) { if (xb_ld(&(bar)[XB_TMO])) break; if (_sp > XB_SPIN_CAP) { atomicAdd(&(bar)[XB_TMO], 1u); break; } } } } while (0)

struct XcdBarrier {
    unsigned* bar; unsigned x;
    volatile LAS unsigned* st;
};

__device__ __forceinline__ XcdBarrier xcd_barrier_post(unsigned* bar, volatile LAS unsigned* st, int wave) {
    XcdBarrier b; b.bar = bar; b.x = xb_xcc_id(); b.st = st;
    if (wave == 0 && lane_id() == 0) (void)xb_add(&bar[XB_XCNT(b.x)], 1u);
    return b;
}
__device__ __forceinline__ void xcd_barrier_complete(unsigned* bar, unsigned x, unsigned& nloc, unsigned& nx) {
    const unsigned G = gridDim.x * gridDim.y * gridDim.z;
    unsigned sum, cnt, mine, sp = 0u;
    for (;;) {
        sum = 0u; cnt = 0u; mine = 0u;
#pragma unroll
        for (unsigned j = 0; j < 16; ++j) { const unsigned c = xb_ld(&bar[XB_XCNT(j)]); sum += c; cnt += (c > 0u) ? 1u : 0u; mine = (j == x) ? c : mine; }
        if (sum == G) break;
        __builtin_amdgcn_s_sleep(1);
        if ((++sp & 255u) == 0u) { if (xb_ld(&bar[XB_TMO])) break; if (sp > XB_SPIN_CAP) { atomicAdd(&bar[XB_TMO], 1u); break; } }
    }
    nloc = mine > 0u ? mine : 1u; nx = cnt > 0u ? cnt : 1u;
}

__device__ __forceinline__ void xcd_barrier(const XcdBarrier& b, int wave) {
    asm volatile("s_waitcnt vmcnt(0)" ::: "memory");
    __syncthreads();
    if (wave == 0 && lane_id() == 0) {
        unsigned* bar = b.bar;
        __builtin_amdgcn_s_waitcnt(0);
        unsigned nloc = b.st[0], nx = b.st[1];
        if (nloc == 0u) { xcd_barrier_complete(bar, b.x, nloc, nx); b.st[0] = nloc; b.st[1] = nx; }
        const unsigned old = xb_add(&bar[XB_XSUB(b.x)], 1u);
        const unsigned gen = old / nloc;
        if (old + 1u == (gen + 1u) * nloc) {
            __builtin_amdgcn_fence(__ATOMIC_RELEASE, "agent");
            asm volatile("s_waitcnt vmcnt(0)" ::: "memory");
            const unsigned og = xb_add(&bar[XB_TOP], 1u);
            const unsigned tg = og / nx;
            if (og + 1u == (tg + 1u) * nx) xb_add(&bar[XB_TOPGEN], 1u);
            else XB_SPIN(xb_ld(&bar[XB_TOPGEN]) == tg, bar);
            __builtin_amdgcn_fence(__ATOMIC_ACQUIRE, "agent");
            xb_add(&bar[XB_XGEN(b.x)], 1u);
            asm volatile("s_waitcnt vmcnt(0)" ::: "memory");
        } else {
            XB_SPIN(xb_ld(&bar[XB_XGEN(b.x)]) == gen, bar);
            __builtin_amdgcn_fence(__ATOMIC_ACQUIRE, "agent");
            asm volatile("s_waitcnt vmcnt(0)" ::: "memory");
        }
    }
    __syncthreads();
}

struct RowV { f32x4 v[4]; };
__device__ __forceinline__ void row_load(RowV& r, const float* row, int lane) {
#pragma unroll
    for (int j = 0; j < 4; ++j) r.v[j] = *(const f32x4*)(row + 4 * lane + 256 * j);
}
__device__ __forceinline__ float row_rstd(const RowV& r) {
    float s = 0.f;
#pragma unroll
    for (int j = 0; j < 4; ++j) s += (r.v[j].x * r.v[j].x + r.v[j].y * r.v[j].y) + (r.v[j].z * r.v[j].z + r.v[j].w * r.v[j].w);
    s = wave_sum(s);
    return 1.0f / sqrtf(s * (1.0f / 1024.0f) + EPS);
}
__device__ __forceinline__ void row_modulate(RowV& r, float rstd, const float* g, const float* sh, const float* sc, int lane) {
#pragma unroll
    for (int j = 0; j < 4; ++j) {
        const int o = 4 * lane + 256 * j;
        const f32x4 gg = *(const f32x4*)(g + o), s = *(const f32x4*)(sc + o), h = *(const f32x4*)(sh + o);
        r.v[j] = (r.v[j] * rstd * gg) * (s + 1.0f) + h;
    }
}
__device__ __forceinline__ void row_store_bf16(const RowV& r, bf16_t* out, int lane) {
#pragma unroll
    for (int j = 0; j < 4; ++j) { u32x2 w; w.x = pk2(r.v[j].x, r.v[j].y); w.y = pk2(r.v[j].z, r.v[j].w); *(u32x2*)(out + 4 * lane + 256 * j) = w; }
}
__device__ __forceinline__ void row_store_f32(const RowV& r, float* out, int lane) {
#pragma unroll
    for (int j = 0; j < 4; ++j) *(f32x4*)(out + 4 * lane + 256 * j) = r.v[j];
}

__device__ __forceinline__ int wmap(int code, int n) {
    if (code == 1) { const int isU = n >> 10, ch = n & 1023; return (ch >> 7) * 256 + isU * 128 + (ch & 127); }
    if (code == 2) { const int typ = (n % 1536) / 512, d = n & 63; return (typ < 2 && d >= 4 && d < 12) ? (d < 8 ? n + 4 : n - 4) : n; }
    if (code == 3) return (n >> 7) * 256 + (n & 127);
    if (code == 4) return (n >> 7) * 256 + 128 + (n & 127);
    return n;
}
__device__ __forceinline__ void conv_item(const float* W, int ldw, int ncol0, bf16_t* WT, int K, int code, LAS float* scr, int kb, int nb, int lane) {
    const int k0 = 64 * kb, n0 = 64 * nb;
    const float* src = W + (size_t)k0 * ldw + ncol0 + n0 + (lane & 15) * 4;
#pragma unroll 4
    for (int i = 0; i < 16; ++i) { const int kk = 4 * i + (lane >> 4); const f32x4 v = *(const f32x4*)(src + (size_t)kk * ldw);
        LAS float* d = scr + kk * 65 + (lane & 15) * 4; d[0] = v.x; d[1] = v.y; d[2] = v.z; d[3] = v.w; }
    LDS_WAIT();
    const int c = lane & 7;
#pragma unroll
    for (int j = 0; j < 8; ++j) { const int n = (lane >> 3) + 8 * j; const LAS float* s = scr + (8 * c) * 65 + n;
        u32x4 o; o.x = pk2(s[0 * 65], s[1 * 65]); o.y = pk2(s[2 * 65], s[3 * 65]); o.z = pk2(s[4 * 65], s[5 * 65]); o.w = pk2(s[6 * 65], s[7 * 65]);
        *(u32x4*)(WT + (size_t)wmap(code, n0 + n) * K + k0 + 8 * c) = o; }
    LDS_WAIT();
}
constexpr int NCONV_ITEMS = 512 + 256 + 256 + 1152 + 128 + 64 * 384;

__device__ __forceinline__ void attn_naive(bf16_t* qkv, float* lse, int bid, int G, int tid) {
    const size_t n = (size_t)T * 24;
    for (size_t i = (size_t)bid * 512 + tid; i < n; i += (size_t)G * 512) {
        const int t = (int)(i / 24), gh = (int)(i % 24), g = gh / 8, h = gh % 8;
        const int dil = g == 0 ? 1 : (g == 1 ? 4 : 16);
        const int pos = t & (SEQ - 1);
        bf16_t* qp = qkv + (size_t)t * QKVW + g * 1536 + h * 64;
        float q[64], o[64];
#pragma unroll
        for (int c8 = 0; c8 < 8; ++c8) { const u32x4 w = *(const u32x4*)(qp + c8 * 8);
#pragma unroll
            for (int k = 0; k < 4; ++k) { q[c8 * 8 + 2 * k] = bflo(w[k]); q[c8 * 8 + 2 * k + 1] = bfhi(w[k]); o[c8 * 8 + 2 * k] = 0.f; o[c8 * 8 + 2 * k + 1] = 0.f; } }
        float m = -INFINITY, l = 0.f;
        for (int j = 0; j <= 128; ++j) {
            const int kp = pos - j * dil; if (kp < 0) break;
            const bf16_t* kr = qkv + (size_t)(t - j * dil) * QKVW + g * 1536 + 512 + h * 64;
            const bf16_t* vr = kr + 512;
            float s = 0.f;
#pragma unroll
            for (int c8 = 0; c8 < 8; ++c8) { const u32x4 w = *(const u32x4*)(kr + c8 * 8);
#pragma unroll
                for (int k = 0; k < 4; ++k) s += q[c8 * 8 + 2 * k] * bflo(w[k]) + q[c8 * 8 + 2 * k + 1] * bfhi(w[k]); }
            const float mn = fmaxf(m, s), a = exp2f(m - mn), pv = exp2f(s - mn);
            l = l * a + pv;
#pragma unroll
            for (int c8 = 0; c8 < 8; ++c8) { const u32x4 w = *(const u32x4*)(vr + c8 * 8);
#pragma unroll
                for (int k = 0; k < 4; ++k) { o[c8 * 8 + 2 * k] = o[c8 * 8 + 2 * k] * a + pv * bflo(w[k]); o[c8 * 8 + 2 * k + 1] = o[c8 * 8 + 2 * k + 1] * a + pv * bfhi(w[k]); } }
            m = mn;
        }
        const float inv = 1.0f / l;
#pragma unroll
        for (int c8 = 0; c8 < 8; ++c8) { u32x4 w;
#pragma unroll
            for (int k = 0; k < 4; ++k) w[k] = pk2(o[c8 * 8 + 2 * k] * inv, o[c8 * 8 + 2 * k + 1] * inv);
            *(u32x4*)(qp + c8 * 8) = w; }
        lse[(size_t)t * 24 + gh] = m + log2f(l);
    }
}
__device__ __forceinline__ void attn_comb(const bf16_t* qkv, const float* lse, bf16_t* o, int bid, int G, int tid) {
    const size_t n = (size_t)T * 64;
    for (size_t i = (size_t)bid * 512 + tid; i < n; i += (size_t)G * 512) {
        const int t = (int)(i >> 6), r = (int)(i & 63), h = r >> 3, c = r & 7;
        const float l0 = lse[(size_t)t * 24 + h], l1 = lse[(size_t)t * 24 + 8 + h], l2 = lse[(size_t)t * 24 + 16 + h];
        const float mx = fmaxf(l0, fmaxf(l1, l2));
        float w0 = exp2f(l0 - mx), w1 = exp2f(l1 - mx), w2 = exp2f(l2 - mx);
        const float inv = 1.0f / (w0 + w1 + w2); w0 *= inv; w1 *= inv; w2 *= inv;
        const bf16_t* base = qkv + (size_t)t * QKVW + h * 64 + c * 8;
        const u32x4 a = *(const u32x4*)(base), b = *(const u32x4*)(base + 1536), cc = *(const u32x4*)(base + 3072);
        u32x4 out;
#pragma unroll
        for (int k = 0; k < 4; ++k) {
            const float lo = w0 * bflo(a[k]) + w1 * bflo(b[k]) + w2 * bflo(cc[k]);
            const float hi = w0 * bfhi(a[k]) + w1 * bfhi(b[k]) + w2 * bfhi(cc[k]);
            out[k] = pk2(lo, hi);
        }
        *(u32x4*)(o + (size_t)t * 512 + h * 64 + c * 8) = out;
    }
}

typedef const __attribute__((address_space(4))) unsigned long long* kargp_t;
__device__ __forceinline__ kargp_t karg() { kargp_t p = (kargp_t)__builtin_amdgcn_kernarg_segment_ptr(); asm volatile("" : "+s"(p)); return p; }
#define KIN(i) ((const float*)karg()[i])
#define KOUT() ((float*)karg()[19])
#define KWS() ((unsigned char*)karg()[20])
#define WSP(type, off) ((type*)(KWS() + (off)))
struct Args { const float* in[19]; float* out; unsigned char* ws; int ph_lo, ph_hi; };
constexpr int NPHASE = 17;

__global__ void __launch_bounds__(NWAVES * 64, 2) mk_fwd(Args args) {
    extern __shared__ __attribute__((aligned(16))) unsigned char lds_raw[];
    LAS unsigned char* lds = (LAS unsigned char*)lds_raw;
    volatile LAS unsigned* MISC = (volatile LAS unsigned*)(lds + MISC_OFF);
    LAS int* rb = (LAS int*)(lds + MISC_OFF);
    const int wave = __builtin_amdgcn_readfirstlane((int)threadIdx.x >> 6);
#define IDS() const int lane = lane_id(), tid = wave * 64 + lane; (void)tid; (void)lane
    const int G = gridDim.x, bid = blockIdx.x;
    for (int u = threadIdx.x; u < (LDS_BYTES - MISC_OFF) / 4; u += NWAVES * 64) MISC[u] = 0u;
    __syncthreads();
#if MK_ONE_LAUNCH
    XcdBarrier bar = xcd_barrier_post((unsigned*)(KWS() + WS_CTL) + CW_BAR, MISC + 40, wave);
#define GRID_BAR() xcd_barrier(bar, wave)
#else
#define GRID_BAR() do { } while (0)
#endif
    const int lo = args.ph_lo, hi = args.ph_hi;
#ifndef PHMASK
#define PHMASK 0xFFFFFFFFu
#endif
#define IN(k) ((((PHMASK) >> (k)) & 1u) && lo <= (k) && (k) < hi)
#define SEAM(k) do { if (IN(k) && IN((k) + 1)) GRID_BAR(); } while (0)

    if (IN(0)) { IDS();
        const float* cin = KIN(1); const float* ada_w = KIN(4); const float* ada_b = KIN(5); float* mod = WSP(float, WS_MOD); float* rope = WSP(float, WS_ROPE);
        LAS float* cact = (LAS float*)lds; LAS float* red = cact + 16384;
        if (bid < 192) for (int i = tid; i < 16 * 1024; i += 512) { const float v = cin[i]; cact[i] = v / (1.f + expf(-v)); }
        __syncthreads();
        for (int item = bid; item < 192; item += G) {
            const int l = item / 96, n0 = (item % 96) * 64, kg = tid >> 6, n = tid & 63;
            float acc[16];
#pragma unroll
            for (int b = 0; b < 16; ++b) acc[b] = 0.f;
            const float* w = ada_w + (size_t)l * 1024 * 6144 + n0 + n;
            for (int k = kg * 128; k < kg * 128 + 128; ++k) {
                const float wv = w[(size_t)k * 6144];
#pragma unroll
                for (int b = 0; b < 16; ++b) acc[b] += cact[b * 1024 + k] * wv;
            }
#pragma unroll
            for (int b = 0; b < 16; ++b) red[(kg * 16 + b) * 64 + n] = acc[b];
            __syncthreads();
            for (int i = tid; i < 1024; i += 512) {
                const int b = i >> 6, nn = i & 63; float s = 0.f;
#pragma unroll
                for (int q = 0; q < 8; ++q) s += red[(q * 16 + b) * 64 + nn];
                mod[((size_t)l * 16 + b) * 6144 + n0 + nn] = s + ada_b[l * 6144 + n0 + nn];
            }
            __syncthreads();
        }
        for (int i = bid * 512 + tid; i < 4096 * 8; i += G * 512) {
            const int t = i >> 3, f = i & 7;
            const float inv = powf(500000.0f, -(float)(2 * f) / 16.0f);
            const float ang = (float)t * inv;
            rope[i] = (float)cos((double)ang);
            rope[4096 * 8 + i] = (float)sin((double)ang);
        }
        __syncthreads();
        LAS float* scr = (LAS float*)(lds + wave * 16640);
        const float* conv_in_w = KIN(6); const float* conv_out_w = KIN(8); const float* attn_in_w = KIN(9); const float* attn_out_w = KIN(10);
        const float* gate_w = KIN(15); const float* up_w = KIN(16); const float* down_w = KIN(17);
        bf16_t* WZ = WSP(bf16_t, WS_WZ); bf16_t* WB = WSP(bf16_t, WS_WB); bf16_t* WCO = WSP(bf16_t, WS_WCO); bf16_t* WAI = WSP(bf16_t, WS_WAI); bf16_t* WAO = WSP(bf16_t, WS_WAO);
        bf16_t* WGU = WSP(bf16_t, WS_WGU); bf16_t* WDN = WSP(bf16_t, WS_WDN);
        for (int it0 = bid * NWAVES + wave; it0 < NCONV_ITEMS; it0 += G * NWAVES) {
            int it = it0;
            if (it < 512) { conv_item(conv_in_w, 3072, 1024, WZ, 1024, 1, scr, it / 32, it % 32, lane); continue; } it -= 512;
            if (it < 256) { conv_item(conv_in_w, 3072, 0, WB, 1024, 0, scr, it / 16, it % 16, lane); continue; } it -= 256;
            if (it < 256) { conv_item(conv_out_w, 1024, 0, WCO, 1024, 0, scr, it / 16, it % 16, lane); continue; } it -= 256;
            if (it < 1152) { conv_item(attn_in_w, QKVW, 0, WAI, 1024, 2, scr, it / 72, it % 72, lane); continue; } it -= 1152;
            if (it < 128) { conv_item(attn_out_w, 1024, 0, WAO, 512, 0, scr, it / 16, it % 16, lane); continue; } it -= 128;
            const int le = it / 384, r = it % 384;
            if (r < 128) conv_item(gate_w + (size_t)le * D * DEXP, DEXP, 0, WGU + (size_t)le * 1024 * 1024, 1024, 3, scr, r / 8, r % 8, lane);
            else if (r < 256) conv_item(up_w + (size_t)le * D * DEXP, DEXP, 0, WGU + (size_t)le * 1024 * 1024, 1024, 4, scr, (r - 128) / 8, (r - 128) % 8, lane);
            else conv_item(down_w + (size_t)le * DEXP * D, D, 0, WDN + (size_t)le * 1024 * 512, 512, 0, scr, (r - 256) / 16, (r - 256) % 16, lane);
        }
    }
    SEAM(0);
    if (IN(1)) { IDS();
        const float* x = KIN(0); const float* norm_mix_g = KIN(2); const float* mod = WSP(float, WS_MOD); bf16_t* xn = WSP(bf16_t, WS_XN);
        for (int row = bid * 8 + wave; row < T; row += G * 8) {
            RowV r; row_load(r, x + (size_t)row * D, lane);
            const float rstd = row_rstd(r);
            const float* mb = mod + (size_t)(row >> 12) * 6144;
            row_modulate(r, rstd, norm_mix_g, mb + 0, mb + 1024, lane);
            row_store_bf16(r, xn + (size_t)row * D, lane);
        }
    }
    SEAM(1);
    if (IN(2)) { bf16_t* xn = WSP(bf16_t, WS_XN); bf16_t* WZ = WSP(bf16_t, WS_WZ); bf16_t* zb = WSP(bf16_t, WS_Z);
        pg8::Gemm g{xn, WZ, T, 2048, 1024}; pg8::StaticOrder S; S.init(T, 2048, G, bid); pg8::EpiPair<false> E{zb, D};
        pg8::gemm_phase<pg8::EpiPair<false>, pg8::StaticOrder, pg8::APlain, true, true>(lds, g, S, E, pg8::APlain{}, wave); }
    SEAM(2);
    if (IN(3)) { bf16_t* xn = WSP(bf16_t, WS_XN); bf16_t* WB = WSP(bf16_t, WS_WB); bf16_t* zb = WSP(bf16_t, WS_Z); bf16_t* ypre = WSP(bf16_t, WS_YPRE); const float* conv_w = KIN(7);
        pg8::Gemm g{xn, WB, T, 1024, 1024}; pg8::StaticOrder S; S.init(T, 1024, G, bid); pg8::EpiYpre E{ypre, zb, conv_w};
        pg8::gemm_phase<pg8::EpiYpre, pg8::StaticOrder, pg8::APlain, true, true>(lds, g, S, E, pg8::APlain{}, wave); }
    SEAM(3);
    if (IN(4)) { bf16_t* ypre = WSP(bf16_t, WS_YPRE); bf16_t* WCO = WSP(bf16_t, WS_WCO); float* xres = KOUT(); const float* x = KIN(0); const float* mod = WSP(float, WS_MOD);
        pg8::Gemm g{ypre, WCO, T, 1024, 1024}; pg8::StaticOrder S; S.init(T, 1024, G, bid); pg8::EpiRes E{xres, x, mod + 2048};
        pg8::gemm_phase<pg8::EpiRes, pg8::StaticOrder, pg8::APlain, true, true>(lds, g, S, E, pg8::APlain{}, wave); }
    SEAM(4);
#pragma unroll 1
    for (int l = 0; l < 2; ++l) {
        const int pb0 = (l == 0) ? 5 : 13;
#define MODL() (WSP(float, WS_MOD) + (size_t)l * 16 * 6144)
#define CNTL() (WSP(int, WS_CTL) + 64 * l)
        if (l == 1) {
            if (IN(9)) { bf16_t* xn = WSP(bf16_t, WS_XN); bf16_t* WAI = WSP(bf16_t, WS_WAI); bf16_t* qkv = WSP(bf16_t, WS_QKV); const float* rope = WSP(float, WS_ROPE);
                pg8::Gemm g{xn, WAI, T, QKVW, 1024}; pg8::StaticOrder S; S.init(T, QKVW, G, bid); pg8::EpiQKV E{qkv, rope};
                pg8::gemm_phase<pg8::EpiQKV, pg8::StaticOrder, pg8::APlain, true, true>(lds, g, S, E, pg8::APlain{}, wave); }
            SEAM(9);
            if (IN(10)) { IDS(); attn_naive(WSP(bf16_t, WS_QKV), WSP(float, WS_LSE), bid, G, tid); }
            SEAM(10);
            if (IN(11)) { IDS(); attn_comb(WSP(bf16_t, WS_QKV), WSP(float, WS_LSE), WSP(bf16_t, WS_XN), bid, G, tid); }
            SEAM(11);
            if (IN(12)) { bf16_t* ob = WSP(bf16_t, WS_XN); bf16_t* WAO = WSP(bf16_t, WS_WAO); float* xres = KOUT();
                pg8::Gemm g{ob, WAO, T, 1024, 512}; pg8::StaticOrder S; S.init(T, 1024, G, bid); pg8::EpiRes E{xres, xres, MODL() + 2048};
                pg8::gemm_phase<pg8::EpiRes, pg8::StaticOrder, pg8::APlain, true, true>(lds, g, S, E, pg8::APlain{}, wave); }
            SEAM(12);
        }
        if (IN(pb0)) { IDS();
            LAS int* rec_e = (LAS int*)lds; LAS float* rec_w = (LAS float*)(lds + 2048); LAS int* rec_rank = (LAS int*)(lds + 4096); LAS int* hist = (LAS int*)(lds + 6144); LAS int* base = (LAS int*)(lds + 6144 + 128);
            const float* gff = KIN(3) + l * D; const float* wg = KIN(11) + (size_t)l * D * 4; const float* bg = KIN(12) + l * 4; const float* we = KIN(13) + (size_t)l * 4 * D * 8; const float* be = KIN(14) + l * 32;
            const float* xres = KOUT(); const float* modl = MODL(); int* cntl = CNTL(); bf16_t* xn = WSP(bf16_t, WS_XN); int* ltok = WSP(int, WS_LTOK); float* lw = WSP(float, WS_LW); int* tslot = WSP(int, WS_TSLOT);
            for (int blk = bid; blk < T / 256; blk += G) {
                if (tid < 32) hist[tid] = 0;
                __syncthreads();
#pragma unroll 1
                for (int i = 0; i < 32; ++i) {
                    const int rl = wave * 32 + i, row = blk * 256 + rl;
                    RowV r; row_load(r, xres + (size_t)row * D, lane);
                    const float rstd = row_rstd(r);
                    const float* mb = modl + (size_t)(row >> 12) * 6144;
                    row_modulate(r, rstd, gff, mb + 3072, mb + 4096, lane);
                    row_store_bf16(r, xn + (size_t)row * D, lane);
                    float pg[4] = {0.f, 0.f, 0.f, 0.f};
#pragma unroll
                    for (int j = 0; j < 4; ++j)
#pragma unroll
                        for (int cc = 0; cc < 4; ++cc) {
                            const int k = 4 * lane + 256 * j + cc; const f32x4 w = *(const f32x4*)(wg + (size_t)k * 4); const float hv = r.v[j][cc];
                            pg[0] += hv * w.x; pg[1] += hv * w.y; pg[2] += hv * w.z; pg[3] += hv * w.w;
                        }
#pragma unroll
                    for (int o = 0; o < 4; ++o) pg[o] = wave_sum(pg[o]) + bg[o];
                    int gi = 0; float gm = pg[0];
#pragma unroll
                    for (int o = 1; o < 4; ++o) if (pg[o] > gm) { gm = pg[o]; gi = o; }
                    float gden = 0.f;
#pragma unroll
                    for (int o = 0; o < 4; ++o) gden += expf(pg[o] - gm);
                    const float grp_p = 1.0f / gden;
                    float pe[8] = {0.f, 0.f, 0.f, 0.f, 0.f, 0.f, 0.f, 0.f};
                    const float* wex = we + (size_t)gi * 1024 * 8;
#pragma unroll
                    for (int j = 0; j < 4; ++j)
#pragma unroll
                        for (int cc = 0; cc < 4; ++cc) {
                            const int k = 4 * lane + 256 * j + cc; const f32x4 w0 = *(const f32x4*)(wex + (size_t)k * 8), w1 = *(const f32x4*)(wex + (size_t)k * 8 + 4); const float hv = r.v[j][cc];
                            pe[0] += hv * w0.x; pe[1] += hv * w0.y; pe[2] += hv * w0.z; pe[3] += hv * w0.w;
                            pe[4] += hv * w1.x; pe[5] += hv * w1.y; pe[6] += hv * w1.z; pe[7] += hv * w1.w;
                        }
#pragma unroll
                    for (int o = 0; o < 8; ++o) pe[o] = wave_sum(pe[o]) + be[gi * 8 + o];
                    int i0 = 0; float m0 = pe[0];
#pragma unroll
                    for (int o = 1; o < 8; ++o) if (pe[o] > m0) { m0 = pe[o]; i0 = o; }
                    int i1 = -1; float m1 = -INFINITY;
#pragma unroll
                    for (int o = 0; o < 8; ++o) if (o != i0 && pe[o] > m1) { m1 = pe[o]; i1 = o; }
                    const float p1 = expf(m1 - m0);
                    if (lane == 0) { rec_e[rl * 2] = gi * 8 + i0; rec_e[rl * 2 + 1] = gi * 8 + i1; rec_w[rl * 2] = grp_p / (1.0f + p1); rec_w[rl * 2 + 1] = grp_p * p1 / (1.0f + p1); }
                }
                __syncthreads();
                { const int e = rec_e[tid]; rec_rank[tid] = atomicAdd((int*)&hist[e], 1); }
                __syncthreads();
                if (tid < 32) { const int h = hist[tid]; base[tid] = h ? atomicAdd(&cntl[tid], h) : 0; }
                __syncthreads();
                { const int e = rec_e[tid], pos = base[e] + rec_rank[tid], tok = blk * 256 + (tid >> 1);
                  ltok[(size_t)e * LISTCAP + pos] = tok; lw[(size_t)e * LISTCAP + pos] = rec_w[tid]; tslot[tok * 2 + (tid & 1)] = (e << 16) | pos; }
                __syncthreads();
            }
        }
        SEAM(pb0);
        if (IN(pb0 + 1) || IN(pb0 + 2) || IN(pb0 + 3)) {
            __syncthreads();
            if (wave == 0 && lane_id() == 0) { const int* cntl = CNTL(); int s = 0; for (int e = 0; e < 32; ++e) { rb[e] = s; s += (__hip_atomic_load(&cntl[e], RLX_AGENT) + 255) & ~255; } rb[32] = s; }
            __syncthreads();
        }
        if (IN(pb0 + 1)) { bf16_t* xn = WSP(bf16_t, WS_XN); bf16_t* WGU = WSP(bf16_t, WS_WGU); bf16_t* act = WSP(bf16_t, WS_ACT); const int* ltok = WSP(int, WS_LTOK); const int* cntl = CNTL();
            pg8::Gemm g{xn, WGU + (size_t)l * 32 * 1024 * 1024, 0, 0, 1024}; pg8::MoeOrder S; S.init(rb[32] / 256, G, bid, rb); pg8::EpiPair<true> E{act, DEXP}; pg8::AGather am{ltok, cntl, rb};
            pg8::gemm_phase<pg8::EpiPair<true>, pg8::MoeOrder, pg8::AGather, true, true>(lds, g, S, E, am, wave); }
        SEAM(pb0 + 1);
        if (IN(pb0 + 2)) { bf16_t* act = WSP(bf16_t, WS_ACT); bf16_t* WDN = WSP(bf16_t, WS_WDN); bf16_t* yw = WSP(bf16_t, WS_YW); const float* lw = WSP(float, WS_LW);
            pg8::Gemm g{act, WDN + (size_t)l * 32 * 1024 * 512, 0, 0, 512}; pg8::MoeOrder S; S.init(rb[32] / 256, G, bid, rb); pg8::EpiDown E{yw, lw, rb};
            pg8::gemm_phase<pg8::EpiDown, pg8::MoeOrder, pg8::APlain, true, true>(lds, g, S, E, pg8::APlain{}, wave); }
        SEAM(pb0 + 2);
        if (IN(pb0 + 3)) { IDS();
            const float* gnext = (l == 0) ? KIN(2) + D : KIN(18);
            const float* modn = WSP(float, WS_MOD) + (size_t)16 * 6144; const float* modl = MODL();
            float* xres = KOUT(); const bf16_t* yw = WSP(bf16_t, WS_YW); const int* tslot = WSP(int, WS_TSLOT); bf16_t* xn = WSP(bf16_t, WS_XN);
            for (int row = bid * 8 + wave; row < T; row += G * 8) {
                const int b = row >> 12;
                const int s0 = tslot[row * 2], s1 = tslot[row * 2 + 1];
                const size_t r0 = (size_t)(rb[s0 >> 16] + (s0 & 0xffff)), r1 = (size_t)(rb[s1 >> 16] + (s1 & 0xffff));
                RowV r; row_load(r, xres + (size_t)row * D, lane);
                const float* g2 = modl + (size_t)b * 6144 + 5120;
#pragma unroll
                for (int j = 0; j < 4; ++j) {
                    const int o = 4 * lane + 256 * j;
                    const u32x2 a = *(const u32x2*)(yw + r0 * D + o), c = *(const u32x2*)(yw + r1 * D + o);
                    const f32x4 gg = *(const f32x4*)(g2 + o);
                    f32x4 y; y.x = bflo(a.x) + bflo(c.x); y.y = bfhi(a.x) + bfhi(c.x); y.z = bflo(a.y) + bflo(c.y); y.w = bfhi(a.y) + bfhi(c.y);
                    r.v[j] = r.v[j] + gg * y;
                }
                const float rstd = row_rstd(r);
                if (l == 1) {
#pragma unroll
                    for (int j = 0; j < 4; ++j) { const f32x4 gg = *(const f32x4*)(gnext + 4 * lane + 256 * j); r.v[j] = r.v[j] * rstd * gg; }
                    row_store_f32(r, xres + (size_t)row * D, lane);
                } else {
                    row_store_f32(r, xres + (size_t)row * D, lane);
                    const float* mb = modn + (size_t)b * 6144;
                    row_modulate(r, rstd, gnext, mb + 0, mb + 1024, lane);
                    row_store_bf16(r, xn + (size_t)row * D, lane);
                }
            }
        }
        SEAM(pb0 + 3);
    }
#undef IDS
#undef MODL
#undef CNTL
#undef IN
#undef SEAM
#undef GRID_BAR
}

extern "C" void kernel_launch(void* const* d_in, const int* in_sizes, int n_in, void* d_out, int out_size, void* d_ws, size_t ws_size, hipStream_t stream) {
    static int grid = 0;
    if (grid == 0) {
        if (n_in != 19 || out_size != T * D || ws_size < WS_END) { fprintf(stderr, "kernel_launch: unexpected shapes (n_in %d out %d ws %zu)\n", n_in, out_size, ws_size); grid = -1; return; }
        int dev = 0, cus = 0;
        if (hipGetDevice(&dev) != hipSuccess || hipDeviceGetAttribute(&cus, hipDeviceAttributeMultiprocessorCount, dev) != hipSuccess) { grid = -1; return; }
        if (hipFuncSetAttribute((const void*)mk_fwd, hipFuncAttributeMaxDynamicSharedMemorySize, LDS_BYTES) != hipSuccess) { fprintf(stderr, "kernel_launch: hipFuncSetAttribute failed\n"); grid = -1; return; }
        int per_cu = 0;
        if (hipOccupancyMaxActiveBlocksPerMultiprocessor(&per_cu, (const void*)mk_fwd, NWAVES * 64, LDS_BYTES) != hipSuccess || per_cu < 1) fprintf(stderr, "kernel_launch: occupancy query says %d\n", per_cu);
        (void)hipGetLastError();
        grid = cus;
    }
    if (grid < 0) return;
    (void)hipMemsetAsync((char*)d_ws + WS_CTL, 0, CTL_BYTES, stream);
    Args a{};
    for (int i = 0; i < 19; ++i) a.in[i] = (const float*)d_in[i];
    a.out = (float*)d_out; a.ws = (unsigned char*)d_ws;
#if MK_ONE_LAUNCH
    a.ph_lo = 0; a.ph_hi = NPHASE;
    hipLaunchKernelGGL(mk_fwd, dim3(grid), dim3(NWAVES * 64), LDS_BYTES, stream, a);
#else
    for (int p = 0; p < NPHASE; ++p) { a.ph_lo = p; a.ph_hi = p + 1; hipLaunchKernelGGL(mk_fwd, dim3(grid), dim3(NWAVES * 64), LDS_BYTES, stream, a); }
#endif
}
```

```cpp
#include <hip/hip_runtime.h>
#include <stdint.h>
#include <math.h>
#include <cstdio>

#ifndef MK_ONE_LAUNCH
#define MK_ONE_LAUNCH 1
#endif

typedef unsigned short bf16_t;
typedef float f32x4 __attribute__((ext_vector_type(4)));
typedef unsigned u32x2 __attribute__((ext_vector_type(2)));
typedef unsigned u32x4 __attribute__((ext_vector_type(4)));
#define GAS __attribute__((address_space(1)))
#define LAS __attribute__((address_space(3)))
typedef GAS unsigned gu32;
#define RLX_AGENT __ATOMIC_RELAXED, __HIP_MEMORY_SCOPE_AGENT

constexpr int D = 1024, BATCH = 16, SEQ = 4096, T = BATCH * SEQ;
constexpr int NEXP = 32, DEXP = 512, EPG = 8, NGRP = 4;
constexpr int QKVW = 4608;
constexpr int LISTCAP = 65536;
constexpr int PADROWS = 139264;
constexpr float EPS = 1e-6f;
constexpr float QSCALE = 0.125f * 1.4426950408889634f;
constexpr int NWAVES = 8;

constexpr size_t MiB = 1u << 20;
constexpr size_t WS_CTL = 0;
constexpr size_t CTL_BYTES = 1 * MiB;
constexpr int CW_BAR = 4096;
constexpr size_t WS_MOD = 1 * MiB;
constexpr size_t WS_ROPE = 3 * MiB;
constexpr size_t WS_LTOK = 4 * MiB;
constexpr size_t WS_LW = 12 * MiB;
constexpr size_t WS_TSLOT = 20 * MiB;
constexpr size_t WS_LSE = 24 * MiB;
constexpr size_t WS_WZ = 32 * MiB;
constexpr size_t WS_WB = 36 * MiB;
constexpr size_t WS_WCO = 38 * MiB;
constexpr size_t WS_WAI = 40 * MiB;
constexpr size_t WS_WAO = 49 * MiB;
constexpr size_t WS_WGU = 64 * MiB;
constexpr size_t WS_WDN = 192 * MiB;
constexpr size_t WS_XN = 256 * MiB;
constexpr size_t WS_BIG = 384 * MiB;
constexpr size_t WS_Z = WS_BIG, WS_YPRE = WS_BIG + 128 * MiB;
constexpr size_t WS_ACT = WS_BIG, WS_YW = WS_BIG + 136 * MiB;
constexpr size_t WS_QKV = WS_BIG;
constexpr size_t WS_END = WS_BIG + 576 * MiB;

constexpr int RING_BYTES = 133120;
constexpr int MISC_OFF = RING_BYTES;
constexpr int LDS_BYTES = RING_BYTES + 1024;

__device__ __forceinline__ unsigned f2bf(float f) { unsigned u = __float_as_uint(f); return (u + 0x7fffu + ((u >> 16) & 1u)) >> 16; }
__device__ __forceinline__ unsigned pk2(float lo, float hi) { return f2bf(lo) | (f2bf(hi) << 16); }
__device__ __forceinline__ float bf2f(unsigned h) { return __uint_as_float(h << 16); }
__device__ __forceinline__ float bflo(unsigned w) { return __uint_as_float(w << 16); }
__device__ __forceinline__ float bfhi(unsigned w) { return __uint_as_float(w & 0xffff0000u); }
__device__ __forceinline__ float wave_sum(float v) {
#pragma unroll
    for (int o = 1; o < 64; o <<= 1) v += __shfl_xor(v, o);
    return v;
}
__device__ __forceinline__ float silu_f(float x) { return x / (1.0f + __expf(-x)); }
#define LDS_WAIT() asm volatile("s_waitcnt lgkmcnt(0)" ::: "memory")
__device__ __forceinline__ int lane_id() { int l; asm volatile("v_mbcnt_lo_u32_b32 %0, -1, 0\n\tv_mbcnt_hi_u32_b32 %0, -1, %0" : "=v"(l)); return l; }

namespace pg8 {
#define PG8_LAS __attribute__((address_space(3)))
typedef unsigned short bf16_t;
typedef short bf16x8 __attribute__((ext_vector_type(8)));
typedef float f32x4 __attribute__((ext_vector_type(4)));
typedef unsigned u32x4 __attribute__((ext_vector_type(4)));
constexpr int BM = 256, BK = 64, HALF = 128, HTB = HALF * BK * 2  , STAGE_BYTES = 8 * HTB, NXCD = 8, WGM = 8;

__host__ __device__ __forceinline__ int lds_byte(int r, int c) { const int st = (r >> 4) * 2 + (c >> 5), rr = r & 15, cc = c & 31, ob = rr * 64 + cc * 2; return st * 1024 + (ob ^ (((ob >> 9) & 1) << 5)); }
__host__ __device__ __forceinline__ void stage_rc(int b, int& R, int& C) { const int st = b / 1024, sb = b % 1024, swz = sb ^ (((sb >> 9) & 1) << 5); R = (st >> 1) * 16 + swz / 64; C = (st & 1) * 32 + (swz % 64) / 2; }
__host__ __device__ __forceinline__ int perm32(int rho) { const int n = rho >> 4, i = rho & 15; return 8 * (i >> 2) + 4 * n + (i & 3); }

struct Unit { int pm, pn, pb; };
struct Gemm { const bf16_t* A; const bf16_t* Bt; int M, N, K; };

struct StaticOrder {
    int nM, nN, nwg, G, c;
    __host__ __device__ void init(int M, int N, int G_, int c_) { nM = M / BM; nN = N / BM; nwg = nM * nN; G = G_; c = c_; }
    __host__ __device__ bool next(int i, Unit& u) const {
        const long L = (long)i * G + c; if (L >= nwg) return false;
        int wgid = (int)L; { const int q = nwg / NXCD, r = nwg % NXCD, xcd = wgid % NXCD, off = wgid / NXCD; wgid = (xcd < r ? xcd * (q + 1) : r * (q + 1) + (xcd - r) * q) + off; }
        const int nig = WGM * nN, gid = wgid / nig, fm = gid * WGM, gsz = (nM - fm) < WGM ? (nM - fm) : WGM;
        u.pm = fm + ((wgid % nig) % gsz); u.pn = (wgid % nig) / gsz; u.pb = u.pn; return true;
    }
    __device__ __forceinline__ void a_ready(const Unit&) const {}
    __device__ __forceinline__ void done(const Unit&) const {}
};


__device__ __forceinline__ unsigned cvt_pk_bf16(float lo, float hi) { unsigned r; asm volatile("v_cvt_pk_bf16_f32 %0, %1, %2" : "=v"(r) : "v"(lo), "v"(hi)); return r; }
typedef float f32x2 __attribute__((ext_vector_type(2)));

template <class Epi, class Sched, class AM, bool ALIGN_EPI = false, bool SP2 = false>
__device__ __forceinline__ void gemm_phase(PG8_LAS unsigned char* lds, const Gemm g, const Sched& S, const Epi& E, const AM& am, const int wid) {
    const int lane = lane_id(), tid = wid * 64 + lane, wr = wid >> 2, wc = wid & 3, fr = lane & 15, fq = lane >> 4;
    const int K = g.K, nt = K / BK;
    unsigned voffA[2], voffB[2]; int stR[2], stC[2];
#pragma unroll
    for (int i = 0; i < 2; ++i) { int R, C; stage_rc(tid * 16 + i * 8192, R, C); const int Rb = Epi::PERM ? ((R & ~31) + perm32(R & 31)) : R;
        stR[i] = R; stC[i] = C; voffA[i] = (unsigned)(R * K + C) * 2u; voffB[i] = (unsigned)(Rb * K + C) * 2u; }
    const size_t kstep = (size_t)(BK * 2);
    const size_t hstep = (size_t)HALF * K * 2;
    const size_t tstep = 2 * hstep;
    const unsigned ldsw = (unsigned)wid * 1024u;
    const int aoff = lds_byte(wr * 64 + fr, fq * 8), boff = lds_byte(wc * 32 + fr, fq * 8);
#define PG8_SA(b, h) (((b) * 2 + (h)) * HTB)
#define PG8_SB(b, h) ((4 + (b) * 2 + (h)) * HTB)
#define PG8_STAGE(bufoff, gbase, voff) do { _Pragma("unroll") for (int _i = 0; _i < 2; ++_i) \
        __builtin_amdgcn_global_load_lds((const unsigned*)((const char*)(gbase) + (voff)[_i]), (PG8_LAS unsigned*)(lds + (bufoff) + ldsw + _i * 8192), 16, 0, 0); } while (0)
#define PG8_STAGE_A(b, h, gbase, NX) do { if constexpr (AM::GATHER) { const unsigned so_[2] = {(NX) ? gno[h][0] : gao[h][0], (NX) ? gno[h][1] : gao[h][1]}; PG8_STAGE(PG8_SA(b, h), gbase, so_); } \
        else { PG8_STAGE(PG8_SA(b, h), (gbase) + (h) * hstep, voffA); } } while (0)
#define PG8_LDA(dst, b, h) do { _Pragma("unroll") for (int m = 0; m < 4; ++m) _Pragma("unroll") for (int k = 0; k < 2; ++k) dst[m][k] = *(const PG8_LAS bf16x8*)(lds + PG8_SA(b, h) + aoff + m * 2048 + k * 1024); } while (0)
#define PG8_LDB(dst, b, h) do { _Pragma("unroll") for (int n = 0; n < 2; ++n) _Pragma("unroll") for (int k = 0; k < 2; ++k) dst[n][k] = *(const PG8_LAS bf16x8*)(lds + PG8_SB(b, h) + boff + n * 2048 + k * 1024); } while (0)
#define PG8_MMA(ai, bj, At, Bt) do { __builtin_amdgcn_s_setprio(1); _Pragma("unroll") for (int m = 0; m < 4; ++m) _Pragma("unroll") for (int n = 0; n < 2; ++n) _Pragma("unroll") for (int k = 0; k < 2; ++k) \
        acc[ai][bj][m][n] = __builtin_amdgcn_mfma_f32_16x16x32_bf16(Bt[n][k], At[m][k], acc[ai][bj][m][n], 0, 0, 0); __builtin_amdgcn_s_setprio(0); } while (0)
#define PG8_WAIT_V(n) asm volatile("s_waitcnt vmcnt(" #n ")" ::: "memory")
#define PG8_WAIT_L(n) asm volatile("s_waitcnt lgkmcnt(" #n ")" ::: "memory")
#define PG8_BAR __builtin_amdgcn_s_barrier()
#define PG8_SCHED __builtin_amdgcn_sched_barrier(0)
    Unit cur, nxt; int ui = 0;
    if (!S.next(0, cur)) return;
    f32x4 acc[2][2][4][2];
#pragma unroll
    for (int a = 0; a < 2; ++a)
#pragma unroll
        for (int b = 0; b < 2; ++b)
#pragma unroll
            for (int m = 0; m < 4; ++m)
#pragma unroll
                for (int n = 0; n < 2; ++n) acc[a][b][m][n] = (f32x4){0.f, 0.f, 0.f, 0.f};
    bf16x8 At[4][2], B0[2][2], B1[2][2];
    const char* cA = (const char*)g.A + (AM::GATHER ? (size_t)0 : (size_t)cur.pm * tstep); const char* cB = (const char*)g.Bt + (size_t)cur.pb * tstep;
    unsigned gao[2][2], gno[2][2];
    if constexpr (AM::GATHER) { _Pragma("unroll") for (int h = 0; h < 2; ++h) _Pragma("unroll") for (int i = 0; i < 2; ++i) { gao[h][i] = (unsigned)(am.arow(cur, h * HALF + stR[i]) * K + stC[i]) * 2u; gno[h][i] = gao[h][i]; } }
    else { _Pragma("unroll") for (int h = 0; h < 2; ++h) _Pragma("unroll") for (int i = 0; i < 2; ++i) { gao[h][i] = 0u; gno[h][i] = 0u; } }
    S.a_ready(cur);
    if constexpr (SP2) {
        PG8_STAGE(PG8_SB(0, 0), cB, voffB); PG8_STAGE(PG8_SB(0, 1), cB + hstep, voffB); PG8_STAGE_A(0, 0, cA, false); PG8_STAGE_A(0, 1, cA, false);
        if (wr == 1) PG8_BAR;
        PG8_WAIT_V(2); PG8_BAR;
        PG8_STAGE(PG8_SB(1, 0), cB + kstep, voffB); PG8_STAGE_A(1, 0, cA + kstep, false); PG8_STAGE(PG8_SB(1, 1), cB + hstep + kstep, voffB);
        PG8_WAIT_V(6); PG8_BAR;
    } else {
        PG8_STAGE(PG8_SB(0, 0), cB, voffB); PG8_STAGE_A(0, 0, cA, false); PG8_STAGE(PG8_SB(0, 1), cB + hstep, voffB); PG8_STAGE_A(0, 1, cA, false);
        if (wr == 1) PG8_BAR;
        PG8_WAIT_V(4); PG8_BAR;
        PG8_STAGE(PG8_SB(1, 0), cB + kstep, voffB); PG8_STAGE_A(1, 0, cA + kstep, false); PG8_STAGE(PG8_SB(1, 1), cB + hstep + kstep, voffB);
        PG8_WAIT_V(6); PG8_BAR;
    }
    for (;;) {
        const bool has_next = S.next(ui + 1, nxt);
        const char* nA = has_next ? (const char*)g.A + (AM::GATHER ? (size_t)0 : (size_t)nxt.pm * tstep) : cA; const char* nB = has_next ? (const char*)g.Bt + (size_t)nxt.pb * tstep : cB;
        if constexpr (AM::GATHER) { if (has_next) { _Pragma("unroll") for (int h = 0; h < 2; ++h) _Pragma("unroll") for (int i = 0; i < 2; ++i) gno[h][i] = (unsigned)(am.arow(nxt, h * HALF + stR[i]) * K + stC[i]) * 2u; } }
        for (int t = 0; t < nt; t += 2) {
            const bool last = (t == nt - 2);
            const char* a1 = cA + (size_t)(t + 1) * kstep;
            const char* a2 = last ? nA : cA + (size_t)(t + 2) * kstep; const char* b2 = last ? nB : cB + (size_t)(t + 2) * kstep;
            const char* a3 = a2 + kstep; const char* b3 = b2 + kstep;
            if (last && has_next) S.a_ready(nxt);
            if constexpr (SP2) {
            PG8_LDB(B0, 0, 0); PG8_LDB(B1, 0, 1); PG8_SCHED; PG8_LDA(At, 0, 0); PG8_STAGE_A(1, 1, a1, false);
            PG8_WAIT_V(8); PG8_WAIT_L(0); PG8_BAR; PG8_MMA(0, 0, At, B0); PG8_MMA(0, 1, At, B1); PG8_BAR; PG8_SCHED;
            PG8_LDA(At, 0, 1); PG8_STAGE(PG8_SB(0, 0), b2, voffB); PG8_STAGE(PG8_SB(0, 1), b2 + hstep, voffB); PG8_STAGE_A(0, 0, a2, last);
            PG8_WAIT_V(8); PG8_WAIT_L(0); PG8_BAR; PG8_MMA(1, 0, At, B0); PG8_MMA(1, 1, At, B1); PG8_BAR; PG8_SCHED;
            PG8_LDB(B0, 1, 0); PG8_LDB(B1, 1, 1); PG8_SCHED; PG8_LDA(At, 1, 0); PG8_STAGE_A(0, 1, a2, last);
            PG8_WAIT_V(8); PG8_WAIT_L(0); PG8_BAR; PG8_MMA(0, 0, At, B0); PG8_MMA(0, 1, At, B1); PG8_BAR; PG8_SCHED;
            PG8_LDA(At, 1, 1); PG8_STAGE(PG8_SB(1, 0), b3, voffB); PG8_STAGE(PG8_SB(1, 1), b3 + hstep, voffB); PG8_STAGE_A(1, 0, a3, last);
            PG8_WAIT_V(8); PG8_WAIT_L(0); PG8_BAR; PG8_MMA(1, 0, At, B0); PG8_MMA(1, 1, At, B1); PG8_BAR; PG8_SCHED;
            } else {
            PG8_LDB(B0, 0, 0); PG8_SCHED; PG8_LDA(At, 0, 0); PG8_STAGE_A(1, 1, a1, false);
            PG8_WAIT_L(8); PG8_BAR; PG8_WAIT_L(0); PG8_MMA(0, 0, At, B0); PG8_BAR; PG8_SCHED;
            PG8_LDB(B1, 0, 1); PG8_STAGE(PG8_SB(0, 0), b2, voffB);
            PG8_BAR; PG8_WAIT_L(0); PG8_MMA(0, 1, At, B1); PG8_BAR;
            PG8_LDA(At, 0, 1); PG8_STAGE_A(0, 0, a2, last);
            PG8_BAR; PG8_WAIT_L(0); PG8_MMA(1, 0, At, B0); PG8_BAR; PG8_SCHED;
            PG8_STAGE(PG8_SB(0, 1), b2 + hstep, voffB);
            PG8_WAIT_V(6); PG8_BAR; PG8_MMA(1, 1, At, B1); PG8_BAR;
            PG8_LDB(B0, 1, 0); PG8_SCHED; PG8_LDA(At, 1, 0); PG8_STAGE_A(0, 1, a2, last);
            PG8_WAIT_L(8); PG8_BAR; PG8_WAIT_L(0); PG8_MMA(0, 0, At, B0); PG8_BAR; PG8_SCHED;
            PG8_LDB(B1, 1, 1); PG8_STAGE(PG8_SB(1, 0), b3, voffB);
            PG8_BAR; PG8_WAIT_L(0); PG8_MMA(0, 1, At, B1); PG8_BAR;
            PG8_LDA(At, 1, 1); PG8_STAGE_A(1, 0, a3, last);
            PG8_BAR; PG8_WAIT_L(0); PG8_MMA(1, 0, At, B0); PG8_BAR; PG8_SCHED;
            PG8_STAGE(PG8_SB(1, 1), b3 + hstep, voffB);
            PG8_WAIT_V(6); PG8_BAR; PG8_MMA(1, 1, At, B1); PG8_BAR;
            }
        }
        if constexpr (ALIGN_EPI) { if (wr == 0) PG8_BAR; }
        if constexpr (!Epi::AFTER_DRAIN) { E(acc, cur, wr, wc, fr, fq); S.done(cur); }
        if (!has_next) break;
#pragma unroll
        for (int a = 0; a < 2; ++a)
#pragma unroll
            for (int b = 0; b < 2; ++b)
#pragma unroll
                for (int m = 0; m < 4; ++m)
#pragma unroll
                    for (int n = 0; n < 2; ++n) acc[a][b][m][n] = (f32x4){0.f, 0.f, 0.f, 0.f};
        cur = nxt; cA = nA; cB = nB; ++ui;
        if constexpr (AM::GATHER) { _Pragma("unroll") for (int h = 0; h < 2; ++h) _Pragma("unroll") for (int i = 0; i < 2; ++i) gao[h][i] = gno[h][i]; }
        if constexpr (ALIGN_EPI) { if (wr == 1) PG8_BAR; }
    }
    PG8_WAIT_V(0);
    if constexpr (!ALIGN_EPI) { if (wr == 0) PG8_BAR; }
    PG8_BAR;
    if constexpr (Epi::AFTER_DRAIN) { E.fused(acc, cur, wr, wc, fr, fq, lds, wid, lane); S.done(cur); }
#undef PG8_SA
#undef PG8_SB
#undef PG8_STAGE
#undef PG8_STAGE_A
#undef PG8_LDA
#undef PG8_LDB
#undef PG8_MMA
#undef PG8_WAIT_V
#undef PG8_WAIT_L
#undef PG8_BAR
#undef PG8_SCHED
}

__device__ __forceinline__ u32x4 pack8(const f32x4 v0, const f32x4 v1) { u32x4 w; w.x = cvt_pk_bf16(v0[0], v0[1]); w.y = cvt_pk_bf16(v0[2], v0[3]); w.z = cvt_pk_bf16(v1[0], v1[1]); w.w = cvt_pk_bf16(v1[2], v1[3]); return w; }
__device__ __forceinline__ float silu1(float x) { return x * __builtin_amdgcn_rcpf(1.0f + __builtin_amdgcn_exp2f(-1.4426950408889634f * x)); }
template <bool SILU> struct EpiPair {
    static constexpr bool PERM = true, AFTER_DRAIN = false;
    bf16_t* O; int ldc;
    __device__ __forceinline__ void operator()(const f32x4 (&acc)[2][2][4][2], const Unit& u, int wr, int wc, int fr, int fq) const {
        const int row0 = u.pm * BM + wr * 64 + fr, ch0 = u.pn * HALF + wc * 32 + 8 * fq;
#pragma unroll
        for (int ai = 0; ai < 2; ++ai)
#pragma unroll
            for (int m = 0; m < 4; ++m) {
                f32x4 a0 = acc[ai][0][m][0], a1 = acc[ai][0][m][1];
                if (SILU) {
#pragma unroll
                    for (int c = 0; c < 4; ++c) { a0[c] = silu1(a0[c]); a1[c] = silu1(a1[c]); }
                }
                *(u32x4*)(O + (size_t)(row0 + ai * HALF + m * 16) * ldc + ch0) = pack8(a0 * acc[ai][1][m][0], a1 * acc[ai][1][m][1]);
            }
    }
};
struct EpiYpre {
    static constexpr bool PERM = true, AFTER_DRAIN = false;
    bf16_t* O; const bf16_t* Z; const float* cw;
    __device__ __forceinline__ void operator()(const f32x4 (&acc)[2][2][4][2], const Unit& u, int wr, int wc, int fr, int fq) const {
        const int row0 = u.pm * BM + wr * 64 + fr;
#pragma unroll
        for (int bj = 0; bj < 2; ++bj) {
            const int col0 = u.pn * BM + bj * HALF + wc * 32 + 8 * fq;
            f32x4 w0[2], w1[2], w2[2];
#pragma unroll
            for (int n = 0; n < 2; ++n) { w0[n] = *(const f32x4*)(cw + col0 + 4 * n); w1[n] = *(const f32x4*)(cw + D + col0 + 4 * n); w2[n] = *(const f32x4*)(cw + 2 * D + col0 + 4 * n); }
#pragma unroll
            for (int ai = 0; ai < 2; ++ai)
#pragma unroll
                for (int m = 0; m < 4; ++m) {
                    const int row = row0 + ai * HALF + m * 16, t = row & (SEQ - 1);
                    const bf16_t* zp = Z + (size_t)row * D + col0;
                    const u32x4 z0 = *(const u32x4*)zp;
                    u32x4 z1 = {0u, 0u, 0u, 0u}, z2 = {0u, 0u, 0u, 0u};
                    if (t >= 1) z1 = *(const u32x4*)(zp - D);
                    if (t >= 2) z2 = *(const u32x4*)(zp - 2 * D);
                    f32x4 v[2];
#pragma unroll
                    for (int n = 0; n < 2; ++n) {
                        f32x4 a, b, c;
                        a[0] = __uint_as_float(z0[2 * n] << 16); a[1] = __uint_as_float(z0[2 * n] & 0xffff0000u); a[2] = __uint_as_float(z0[2 * n + 1] << 16); a[3] = __uint_as_float(z0[2 * n + 1] & 0xffff0000u);
                        b[0] = __uint_as_float(z1[2 * n] << 16); b[1] = __uint_as_float(z1[2 * n] & 0xffff0000u); b[2] = __uint_as_float(z1[2 * n + 1] << 16); b[3] = __uint_as_float(z1[2 * n + 1] & 0xffff0000u);
                        c[0] = __uint_as_float(z2[2 * n] << 16); c[1] = __uint_as_float(z2[2 * n] & 0xffff0000u); c[2] = __uint_as_float(z2[2 * n + 1] << 16); c[3] = __uint_as_float(z2[2 * n + 1] & 0xffff0000u);
                        v[n] = acc[ai][bj][m][n] * (w2[n] * a + w1[n] * b + w0[n] * c);
                    }
                    *(u32x4*)(O + (size_t)row * D + col0) = pack8(v[0], v[1]);
                    if (m & 1) asm volatile("" ::: "memory");
                }
        }
    }
};
struct EpiRes {
    static constexpr bool PERM = false, AFTER_DRAIN = false;
    float* out; const float* resin; const float* modg;
    __device__ __forceinline__ void operator()(const f32x4 (&acc)[2][2][4][2], const Unit& u, int wr, int wc, int fr, int fq) const {
        const int row0 = u.pm * BM + wr * 64 + fr, col0 = u.pn * BM + wc * 32 + 4 * fq;
        const float* gb = modg + (size_t)((u.pm * BM) >> 12) * 6144;
        f32x4 gv[2][2];
#pragma unroll
        for (int bj = 0; bj < 2; ++bj)
#pragma unroll
            for (int n = 0; n < 2; ++n) gv[bj][n] = *(const f32x4*)(gb + col0 + bj * HALF + n * 16);
#pragma unroll
        for (int ai = 0; ai < 2; ++ai)
#pragma unroll
            for (int m = 0; m < 4; ++m) { const size_t off = (size_t)(row0 + ai * HALF + m * 16) * D + col0;
#pragma unroll
                for (int bj = 0; bj < 2; ++bj)
#pragma unroll
                    for (int n = 0; n < 2; ++n) { const f32x4 r = *(const f32x4*)(resin + off + bj * HALF + n * 16); *(f32x4*)(out + off + bj * HALF + n * 16) = r + gv[bj][n] * acc[ai][bj][m][n]; }
                if (m & 1) asm volatile("" ::: "memory"); }
    }
};
struct EpiQKV {
    static constexpr bool PERM = true, AFTER_DRAIN = false;
    bf16_t* O; const float* rope;
    __device__ __forceinline__ void operator()(const f32x4 (&acc)[2][2][4][2], const Unit& u, int wr, int wc, int fr, int fq) const {
        const int row0 = u.pm * BM + wr * 64 + fr, col0 = u.pn * BM + wc * 32 + 8 * fq;
        const int typ = (u.pn % 6) >> 1;
        const bool rl = (typ < 2) && ((wc & 1) == 0) && (fq < 2);
        const float sc = (typ == 0) ? QSCALE : 1.0f;
#pragma unroll
        for (int ai = 0; ai < 2; ++ai)
#pragma unroll
            for (int m = 0; m < 4; ++m) {
                const int row = row0 + ai * HALF + m * 16, pos = row & (SEQ - 1);
                f32x4 cs = {1.f, 1.f, 1.f, 1.f}, sn = {0.f, 0.f, 0.f, 0.f};
                { const f32x4 c_ = *(const f32x4*)(rope + pos * 8 + 4 * (fq & 1)), s_ = *(const f32x4*)(rope + 4096 * 8 + pos * 8 + 4 * (fq & 1));
                  if (rl) { cs = c_; sn = s_; } }
#pragma unroll
                for (int bj = 0; bj < 2; ++bj) {
                    const f32x4 x1 = acc[ai][bj][m][0], x2 = acc[ai][bj][m][1];
                    const f32x4 r1 = (x1 * cs - x2 * sn) * sc, r2 = (x2 * cs + x1 * sn) * sc;
                    *(u32x4*)(O + (size_t)row * QKVW + col0 + bj * HALF) = pack8(r1, r2);
                }
                if (m & 1) asm volatile("" ::: "memory");
            }
    }
};
struct EpiDown {
    static constexpr bool PERM = true, AFTER_DRAIN = false;
    bf16_t* O; const float* lw; const PG8_LAS int* rb;
    __device__ __forceinline__ void operator()(const f32x4 (&acc)[2][2][4][2], const Unit& u, int wr, int wc, int fr, int fq) const {
        const int row0 = u.pm * BM + wr * 64 + fr, col0 = u.pn * BM + wc * 32 + 8 * fq;
        const int e = u.pb >> 2; const float* wrow = lw + (size_t)e * LISTCAP - rb[e];
#pragma unroll
        for (int ai = 0; ai < 2; ++ai)
#pragma unroll
            for (int m = 0; m < 4; ++m) {
                const int row = row0 + ai * HALF + m * 16; const float w = wrow[row];
#pragma unroll
                for (int bj = 0; bj < 2; ++bj) *(u32x4*)(O + (size_t)row * D + col0 + bj * HALF) = pack8(acc[ai][bj][m][0] * w, acc[ai][bj][m][1] * w);
            }
    }
};
struct MoeOrder {
    int nM, nN, nwg, G, c; const PG8_LAS int* rb;
    __device__ void init(int nRT, int G_, int c_, const PG8_LAS int* rb_) { nM = nRT; nN = 4; nwg = nM * nN; G = G_; c = c_; rb = rb_; }
    __device__ bool next(int i, Unit& u) const {
        const long L = (long)i * G + c; if (L >= nwg) return false;
        int wgid = (int)L; { const int q = nwg / NXCD, r = nwg % NXCD, xcd = wgid % NXCD, off = wgid / NXCD; wgid = (xcd < r ? xcd * (q + 1) : r * (q + 1) + (xcd - r) * q) + off; }
        const int nig = WGM * nN, gid = wgid / nig, fm = gid * WGM, gsz = (nM - fm) < WGM ? (nM - fm) : WGM;
        u.pm = fm + ((wgid % nig) % gsz); u.pn = (wgid % nig) / gsz;
        int e = 0; const int r0 = u.pm * BM; while (e < 31 && rb[e + 1] <= r0) ++e;
        u.pb = e * 4 + u.pn; return true;
    }
    __device__ __forceinline__ void a_ready(const Unit&) const {}
    __device__ __forceinline__ void done(const Unit&) const {}
};
struct APlain { static constexpr bool GATHER = false; __device__ __forceinline__ int arow(const Unit&, int) const { return 0; } };
struct AGather {
    static constexpr bool GATHER = true;
    const int* ltok; const int* cnt; const PG8_LAS int* rb;
    __device__ __forceinline__ int arow(const Unit& u, int r) const { const int e = u.pb >> 2, l = u.pm * BM - rb[e] + r; return (l < cnt[e]) ? ltok[(size_t)e * LISTCAP + l] : 0; }
};
}

#define XB_TMO      128
#define XB_XCNT(j)  (256  + 64 * (j))
#define XB_XSUB(j)  (1280 + 64 * (j))
#define XB_XGEN(j)  (2304 + 64 * (j))
#define XB_TOP      3328
#define XB_TOPGEN   3392
#define XCD_BAR_WORDS 3456
#define XB_SPIN_CAP (1u << 18)

__device__ __forceinline__ unsigned xb_ld(unsigned* p)              { return __hip_atomic_load(p, __ATOMIC_RELAXED, __HIP_MEMORY_SCOPE_AGENT); }
__device__ __forceinline__ unsigned xb_add(unsigned* p, unsigned v) { return __hip_atomic_fetch_add(p, v, __ATOMIC_RELAXED, __HIP_MEMORY_SCOPE_AGENT); }
__device__ __forceinline__ unsigned xb_xcc_id() { return (unsigned)__builtin_amdgcn_s_getreg((3 << 11) | 20) & 0xFu; }
#define XB_SPIN(cond, bar) do { unsigned _sp = 0; while (cond) { __builtin_amdgcn_s_sleep(1); \
    if ((++_sp & 255u) == 0u) { if (xb_ld(&(bar)[XB_TMO])) break; if (_sp > XB_SPIN_CAP) { atomicAdd(&(bar)[XB_TMO], 1u); break; } } } } while (0)

struct XcdBarrier {
    unsigned* bar; unsigned x;
    volatile LAS unsigned* st;
};

__device__ __forceinline__ XcdBarrier xcd_barrier_post(unsigned* bar, volatile LAS unsigned* st, int wave) {
    XcdBarrier b; b.bar = bar; b.x = xb_xcc_id(); b.st = st;
    if (wave == 0 && lane_id() == 0) (void)xb_add(&bar[XB_XCNT(b.x)], 1u);
    return b;
}
__device__ __forceinline__ void xcd_barrier_complete(unsigned* bar, unsigned x, unsigned& nloc, unsigned& nx) {
    const unsigned G = gridDim.x * gridDim.y * gridDim.z;
    unsigned sum, cnt, mine, sp = 0u;
    for (;;) {
        sum = 0u; cnt = 0u; mine = 0u;
#pragma unroll
        for (unsigned j = 0; j < 16; ++j) { const unsigned c = xb_ld(&bar[XB_XCNT(j)]); sum += c; cnt += (c > 0u) ? 1u : 0u; mine = (j == x) ? c : mine; }
        if (sum == G) break;
        __builtin_amdgcn_s_sleep(1);
        if ((++sp & 255u) == 0u) { if (xb_ld(&bar[XB_TMO])) break; if (sp > XB_SPIN_CAP) { atomicAdd(&bar[XB_TMO], 1u); break; } }
    }
    nloc = mine > 0u ? mine : 1u; nx = cnt > 0u ? cnt : 1u;
}

__device__ __forceinline__ void xcd_barrier(const XcdBarrier& b, int wave) {
    asm volatile("s_waitcnt vmcnt(0)" ::: "memory");
    __syncthreads();
    if (wave == 0 && lane_id() == 0) {
        unsigned* bar = b.bar;
        __builtin_amdgcn_s_waitcnt(0);
        unsigned nloc = b.st[0], nx = b.st[1];
        if (nloc == 0u) { xcd_barrier_complete(bar, b.x, nloc, nx); b.st[0] = nloc; b.st[1] = nx; }
        const unsigned old = xb_add(&bar[XB_XSUB(b.x)], 1u);
        const unsigned gen = old / nloc;
        if (old + 1u == (gen + 1u) * nloc) {
            __builtin_amdgcn_fence(__ATOMIC_RELEASE, "agent");
            asm volatile("s_waitcnt vmcnt(0)" ::: "memory");
            const unsigned og = xb_add(&bar[XB_TOP], 1u);
            const unsigned tg = og / nx;
            if (og + 1u == (tg + 1u) * nx) xb_add(&bar[XB_TOPGEN], 1u);
            else XB_SPIN(xb_ld(&bar[XB_TOPGEN]) == tg, bar);
            __builtin_amdgcn_fence(__ATOMIC_ACQUIRE, "agent");
            xb_add(&bar[XB_XGEN(b.x)], 1u);
            asm volatile("s_waitcnt vmcnt(0)" ::: "memory");
        } else {
            XB_SPIN(xb_ld(&bar[XB_XGEN(b.x)]) == gen, bar);
            __builtin_amdgcn_fence(__ATOMIC_ACQUIRE, "agent");
            asm volatile("s_waitcnt vmcnt(0)" ::: "memory");
        }
    }
    __syncthreads();
}

struct RowV { f32x4 v[4]; };
__device__ __forceinline__ void row_load(RowV& r, const float* row, int lane) {
#pragma unroll
    for (int j = 0; j < 4; ++j) r.v[j] = *(const f32x4*)(row + 4 * lane + 256 * j);
}
__device__ __forceinline__ float row_rstd(const RowV& r) {
    float s = 0.f;
#pragma unroll
    for (int j = 0; j < 4; ++j) s += (r.v[j].x * r.v[j].x + r.v[j].y * r.v[j].y) + (r.v[j].z * r.v[j].z + r.v[j].w * r.v[j].w);
    s = wave_sum(s);
    return 1.0f / sqrtf(s * (1.0f / 1024.0f) + EPS);
}
__device__ __forceinline__ void row_modulate(RowV& r, float rstd, const float* g, const float* sh, const float* sc, int lane) {
#pragma unroll
    for (int j = 0; j < 4; ++j) {
        const int o = 4 * lane + 256 * j;
        const f32x4 gg = *(const f32x4*)(g + o), s = *(const f32x4*)(sc + o), h = *(const f32x4*)(sh + o);
        r.v[j] = (r.v[j] * rstd * gg) * (s + 1.0f) + h;
    }
}
__device__ __forceinline__ void row_store_bf16(const RowV& r, bf16_t* out, int lane) {
#pragma unroll
    for (int j = 0; j < 4; ++j) { u32x2 w; w.x = pk2(r.v[j].x, r.v[j].y); w.y = pk2(r.v[j].z, r.v[j].w); *(u32x2*)(out + 4 * lane + 256 * j) = w; }
}
__device__ __forceinline__ void row_store_f32(const RowV& r, float* out, int lane) {
#pragma unroll
    for (int j = 0; j < 4; ++j) *(f32x4*)(out + 4 * lane + 256 * j) = r.v[j];
}

__device__ __forceinline__ int wmap(int code, int n) {
    if (code == 1) { const int isU = n >> 10, ch = n & 1023; return (ch >> 7) * 256 + isU * 128 + (ch & 127); }
    if (code == 2) { const int typ = (n % 1536) / 512, d = n & 63; return (typ < 2 && d >= 4 && d < 12) ? (d < 8 ? n + 4 : n - 4) : n; }
    if (code == 3) return (n >> 7) * 256 + (n & 127);
    if (code == 4) return (n >> 7) * 256 + 128 + (n & 127);
    return n;
}
__device__ __forceinline__ void conv_item(const float* W, int ldw, int ncol0, bf16_t* WT, int K, int code, LAS float* scr, int kb, int nb, int lane) {
    const int k0 = 64 * kb, n0 = 64 * nb;
    const float* src = W + (size_t)k0 * ldw + ncol0 + n0 + (lane & 15) * 4;
#pragma unroll 4
    for (int i = 0; i < 16; ++i) { const int kk = 4 * i + (lane >> 4); const f32x4 v = *(const f32x4*)(src + (size_t)kk * ldw);
        LAS float* d = scr + kk * 65 + (lane & 15) * 4; d[0] = v.x; d[1] = v.y; d[2] = v.z; d[3] = v.w; }
    LDS_WAIT();
    const int c = lane & 7;
#pragma unroll
    for (int j = 0; j < 8; ++j) { const int n = (lane >> 3) + 8 * j; const LAS float* s = scr + (8 * c) * 65 + n;
        u32x4 o; o.x = pk2(s[0 * 65], s[1 * 65]); o.y = pk2(s[2 * 65], s[3 * 65]); o.z = pk2(s[4 * 65], s[5 * 65]); o.w = pk2(s[6 * 65], s[7 * 65]);
        *(u32x4*)(WT + (size_t)wmap(code, n0 + n) * K + k0 + 8 * c) = o; }
    LDS_WAIT();
}
constexpr int NCONV_ITEMS = 512 + 256 + 256 + 1152 + 128 + 64 * 384;

__device__ __forceinline__ void attn_naive(bf16_t* qkv, float* lse, int bid, int G, int tid) {
    const size_t n = (size_t)T * 24;
    for (size_t i = (size_t)bid * 512 + tid; i < n; i += (size_t)G * 512) {
        const int t = (int)(i / 24), gh = (int)(i % 24), g = gh / 8, h = gh % 8;
        const int dil = g == 0 ? 1 : (g == 1 ? 4 : 16);
        const int pos = t & (SEQ - 1);
        bf16_t* qp = qkv + (size_t)t * QKVW + g * 1536 + h * 64;
        float q[64], o[64];
#pragma unroll
        for (int c8 = 0; c8 < 8; ++c8) { const u32x4 w = *(const u32x4*)(qp + c8 * 8);
#pragma unroll
            for (int k = 0; k < 4; ++k) { q[c8 * 8 + 2 * k] = bflo(w[k]); q[c8 * 8 + 2 * k + 1] = bfhi(w[k]); o[c8 * 8 + 2 * k] = 0.f; o[c8 * 8 + 2 * k + 1] = 0.f; } }
        float m = -INFINITY, l = 0.f;
        for (int j = 0; j <= 128; ++j) {
            const int kp = pos - j * dil; if (kp < 0) break;
            const bf16_t* kr = qkv + (size_t)(t - j * dil) * QKVW + g * 1536 + 512 + h * 64;
            const bf16_t* vr = kr + 512;
            float s = 0.f;
#pragma unroll
            for (int c8 = 0; c8 < 8; ++c8) { const u32x4 w = *(const u32x4*)(kr + c8 * 8);
#pragma unroll
                for (int k = 0; k < 4; ++k) s += q[c8 * 8 + 2 * k] * bflo(w[k]) + q[c8 * 8 + 2 * k + 1] * bfhi(w[k]); }
            const float mn = fmaxf(m, s), a = exp2f(m - mn), pv = exp2f(s - mn);
            l = l * a + pv;
#pragma unroll
            for (int c8 = 0; c8 < 8; ++c8) { const u32x4 w = *(const u32x4*)(vr + c8 * 8);
#pragma unroll
                for (int k = 0; k < 4; ++k) { o[c8 * 8 + 2 * k] = o[c8 * 8 + 2 * k] * a + pv * bflo(w[k]); o[c8 * 8 + 2 * k + 1] = o[c8 * 8 + 2 * k + 1] * a + pv * bfhi(w[k]); } }
            m = mn;
        }
        const float inv = 1.0f / l;
#pragma unroll
        for (int c8 = 0; c8 < 8; ++c8) { u32x4 w;
#pragma unroll
            for (int k = 0; k < 4; ++k) w[k] = pk2(o[c8 * 8 + 2 * k] * inv, o[c8 * 8 + 2 * k + 1] * inv);
            *(u32x4*)(qp + c8 * 8) = w; }
        lse[(size_t)t * 24 + gh] = m + log2f(l);
    }
}
__device__ __forceinline__ void attn_comb(const bf16_t* qkv, const float* lse, bf16_t* o, int bid, int G, int tid) {
    const size_t n = (size_t)T * 64;
    for (size_t i = (size_t)bid * 512 + tid; i < n; i += (size_t)G * 512) {
        const int t = (int)(i >> 6), r = (int)(i & 63), h = r >> 3, c = r & 7;
        const float l0 = lse[(size_t)t * 24 + h], l1 = lse[(size_t)t * 24 + 8 + h], l2 = lse[(size_t)t * 24 + 16 + h];
        const float mx = fmaxf(l0, fmaxf(l1, l2));
        float w0 = exp2f(l0 - mx), w1 = exp2f(l1 - mx), w2 = exp2f(l2 - mx);
        const float inv = 1.0f / (w0 + w1 + w2); w0 *= inv; w1 *= inv; w2 *= inv;
        const bf16_t* base = qkv + (size_t)t * QKVW + h * 64 + c * 8;
        const u32x4 a = *(const u32x4*)(base), b = *(const u32x4*)(base + 1536), cc = *(const u32x4*)(base + 3072);
        u32x4 out;
#pragma unroll
        for (int k = 0; k < 4; ++k) {
            const float lo = w0 * bflo(a[k]) + w1 * bflo(b[k]) + w2 * bflo(cc[k]);
            const float hi = w0 * bfhi(a[k]) + w1 * bfhi(b[k]) + w2 * bfhi(cc[k]);
            out[k] = pk2(lo, hi);
        }
        *(u32x4*)(o + (size_t)t * 512 + h * 64 + c * 8) = out;
    }
}

namespace att {
typedef short bf16x8 __attribute__((ext_vector_type(8)));
typedef short s16x4 __attribute__((ext_vector_type(4)));
typedef float f32x16 __attribute__((ext_vector_type(16)));
constexpr int KOFF = 0, VOFF = 65536, NUNITS = 16 * 3 * 32 * 4;
__device__ __forceinline__ int crow(int r, int hi) { return (r & 3) + 8 * (r >> 2) + 4 * hi; }
__device__ __forceinline__ s16x4 vtr(const LAS unsigned char* p) { return __builtin_bit_cast(s16x4, __builtin_amdgcn_ds_read_tr16_b64_v4i16((LAS s16x4*)p)); }
__device__ __forceinline__ float xhalf_max(float m) { auto rr = __builtin_amdgcn_permlane32_swap(__float_as_uint(m), __float_as_uint(m), false, false); return fmaxf(__uint_as_float(rr[0]), __uint_as_float(rr[1])); }
__device__ __forceinline__ float xhalf_sum(float m) { auto rr = __builtin_amdgcn_permlane32_swap(__float_as_uint(m), __float_as_uint(m), false, false); return __uint_as_float(rr[0]) + __uint_as_float(rr[1]); }

__device__ __forceinline__ void attn_phase(LAS unsigned char* lds, bf16_t* qkv, float* lse, int bid, int G, int wave) {
    const int per = (NUNITS + G - 1) / G;
    const int u_lo = bid * per, u_hi = (u_lo + per < NUNITS) ? u_lo + per : NUNITS;
    for (int idx = u_lo; idx < u_hi; ++idx) {
        const int lane = lane_id(), r32 = lane & 31, hi = lane >> 5;
        const int hp = idx & 3, rest = idx >> 2, sb = rest & 31, bg = rest >> 5, b = bg / 3, g = bg - 3 * b;
        const int dsh = 2 * g, dil = 1 << dsh;
        const int bps = 32 >> dsh;
        const int r = sb / bps, l0 = (sb - r * bps) * 128;
        const size_t tb = (size_t)b * SEQ + r;
        const bf16_t* gq = qkv + g * 1536;
#pragma unroll
        for (int i = 0; i < 8; ++i) {
            const int id = wave * 8 + i, hd = id >> 5, ch = (id >> 2) & 7, kq = id & 3;
            int sp = l0 - 128 + kq * 64 + lane; sp = sp < 0 ? 0 : sp;
            const bf16_t* src = gq + (tb + (size_t)sp * dil) * QKVW + 512 + (hp * 2 + hd) * 64 + ch * 8;
            __builtin_amdgcn_global_load_lds((const unsigned*)src, (LAS unsigned*)(lds + KOFF + hd * 32768 + ch * 4096 + kq * 1024), 16, 0, 0);
        }
#pragma unroll
        for (int i = 0; i < 8; ++i) {
            const int id = wave * 8 + i, hd = id >> 5, dh = (id >> 4) & 1, kg = id & 15;
            int sp = l0 - 128 + kg * 16 + (lane >> 2); sp = sp < 0 ? 0 : sp;
            const bf16_t* src = gq + (tb + (size_t)sp * dil) * QKVW + 1024 + (hp * 2 + hd) * 64 + dh * 32 + (lane & 3) * 8;
            __builtin_amdgcn_global_load_lds((const unsigned*)src, (LAS unsigned*)(lds + VOFF + hd * 32768 + dh * 16384 + kg * 1024), 16, 0, 0);
        }
        const int hd = wave >> 2, qt = wave & 3, head = hp * 2 + hd;
        const size_t tq = tb + (size_t)(l0 + 32 * qt + r32) * dil;
        bf16_t* qrow = qkv + tq * QKVW + g * 1536 + head * 64;
        bf16x8 qf[4];
#pragma unroll
        for (int d0 = 0; d0 < 4; ++d0) qf[d0] = *(const bf16x8*)(qrow + d0 * 16 + hi * 8);
        asm volatile("s_waitcnt vmcnt(0)" ::: "memory");
        __syncthreads();
        f32x16 p[5];
        const LAS unsigned char* kb = lds + KOFF + hd * 32768 + hi * 4096 + (qt * 32 + r32) * 16;
#pragma unroll
        for (int j = 0; j < 5; ++j) {
#pragma unroll
            for (int rr = 0; rr < 16; ++rr) p[j][rr] = 0.f;
#pragma unroll
            for (int d0 = 0; d0 < 4; ++d0) {
                const bf16x8 kf = *(const LAS bf16x8*)(kb + j * 512 + d0 * 8192);
                p[j] = __builtin_amdgcn_mfma_f32_32x32x16_bf16(kf, qf[d0], p[j], 0, 0, 0);
            }
        }
#pragma unroll
        for (int rr = 0; rr < 16; ++rr) { const int c = crow(rr, hi); if (c < r32) p[0][rr] = -INFINITY; if (c > r32) p[4][rr] = -INFINITY; }
        if (l0 == 0) {
#pragma unroll
            for (int j = 0; j < 5; ++j)
#pragma unroll
                for (int rr = 0; rr < 16; ++rr) if (32 * (qt + j) + crow(rr, hi) < 128) p[j][rr] = -INFINITY;
        }
        float m = p[0][0];
#pragma unroll
        for (int j = 0; j < 5; ++j)
#pragma unroll
            for (int rr = 0; rr < 16; ++rr) m = fmaxf(m, p[j][rr]);
        m = xhalf_max(m);
        float l = 0.f;
#pragma unroll
        for (int j = 0; j < 5; ++j)
#pragma unroll
            for (int rr = 0; rr < 16; ++rr) { const float e = __builtin_amdgcn_exp2f(p[j][rr] - m); p[j][rr] = e; l += e; }
        l = xhalf_sum(l);
        f32x16 o[2];
#pragma unroll
        for (int rr = 0; rr < 16; ++rr) { o[0][rr] = 0.f; o[1][rr] = 0.f; }
        const LAS unsigned char* vb = lds + VOFF + hd * 32768 + ((lane >> 4) & 1) * 32 + (lane & 3) * 8 + (4 * hi + ((lane & 15) >> 2)) * 64 + qt * 2048;
#pragma unroll
        for (int j = 0; j < 5; ++j)
#pragma unroll
            for (int s = 0; s < 2; ++s) {
                u32x4 pw; pw.x = pg8::cvt_pk_bf16(p[j][8 * s + 0], p[j][8 * s + 1]); pw.y = pg8::cvt_pk_bf16(p[j][8 * s + 2], p[j][8 * s + 3]);
                pw.z = pg8::cvt_pk_bf16(p[j][8 * s + 4], p[j][8 * s + 5]); pw.w = pg8::cvt_pk_bf16(p[j][8 * s + 6], p[j][8 * s + 7]);
                const bf16x8 pf = __builtin_bit_cast(bf16x8, pw);
#pragma unroll
                for (int d0 = 0; d0 < 2; ++d0) {
                    const s16x4 vlo = vtr(vb + d0 * 16384 + (2 * j + s) * 1024), vhi = vtr(vb + d0 * 16384 + (2 * j + s) * 1024 + 512);
                    const bf16x8 vf = {vlo[0], vlo[1], vlo[2], vlo[3], vhi[0], vhi[1], vhi[2], vhi[3]};
                    o[d0] = __builtin_amdgcn_mfma_f32_32x32x16_bf16(vf, pf, o[d0], 0, 0, 0);
                }
            }
        const float inv = 1.0f / l;
#pragma unroll
        for (int d0 = 0; d0 < 2; ++d0)
#pragma unroll
            for (int rg = 0; rg < 4; ++rg) {
                u32x2 w; w.x = pg8::cvt_pk_bf16(o[d0][4 * rg] * inv, o[d0][4 * rg + 1] * inv); w.y = pg8::cvt_pk_bf16(o[d0][4 * rg + 2] * inv, o[d0][4 * rg + 3] * inv);
                *(u32x2*)(qrow + d0 * 32 + 8 * rg + 4 * hi) = w;
            }
        if (hi == 0) lse[tq * 24 + g * 8 + head] = m + __builtin_amdgcn_logf(l);
        __syncthreads();
    }
}
}

typedef const __attribute__((address_space(4))) unsigned long long* kargp_t;
__device__ __forceinline__ kargp_t karg() { kargp_t p = (kargp_t)__builtin_amdgcn_kernarg_segment_ptr(); asm volatile("" : "+s"(p)); return p; }
#define KIN(i) ((const float*)karg()[i])
#define KOUT() ((float*)karg()[19])
#define KWS() ((unsigned char*)karg()[20])
#define WSP(type, off) ((type*)(KWS() + (off)))
struct Args { const float* in[19]; float* out; unsigned char* ws; int ph_lo, ph_hi; };
constexpr int NPHASE = 17;

__global__ void __launch_bounds__(NWAVES * 64, 2) mk_fwd(Args args) {
    extern __shared__ __attribute__((aligned(16))) unsigned char lds_raw[];
    LAS unsigned char* lds = (LAS unsigned char*)lds_raw;
    volatile LAS unsigned* MISC = (volatile LAS unsigned*)(lds + MISC_OFF);
    LAS int* rb = (LAS int*)(lds + MISC_OFF);
    const int wave = __builtin_amdgcn_readfirstlane((int)threadIdx.x >> 6);
#define IDS() const int lane = lane_id(), tid = wave * 64 + lane; (void)tid; (void)lane
    const int G = gridDim.x, bid = blockIdx.x;
    for (int u = threadIdx.x; u < (LDS_BYTES - MISC_OFF) / 4; u += NWAVES * 64) MISC[u] = 0u;
    __syncthreads();
#if MK_ONE_LAUNCH
    XcdBarrier bar = xcd_barrier_post((unsigned*)(KWS() + WS_CTL) + CW_BAR, MISC + 40, wave);
#define GRID_BAR() xcd_barrier(bar, wave)
#else
#define GRID_BAR() do { } while (0)
#endif
    const int lo = args.ph_lo, hi = args.ph_hi;
#ifndef PHMASK
#define PHMASK 0xFFFFFFFFu
#endif
#define IN(k) ((((PHMASK) >> (k)) & 1u) && lo <= (k) && (k) < hi)
#define SEAM(k) do { if (IN(k) && IN((k) + 1)) GRID_BAR(); } while (0)

    if (IN(0)) { IDS();
        const float* cin = KIN(1); const float* ada_w = KIN(4); const float* ada_b = KIN(5); float* mod = WSP(float, WS_MOD); float* rope = WSP(float, WS_ROPE);
        LAS float* cact = (LAS float*)lds; LAS float* red = cact + 16384;
        if (bid < 192) for (int i = tid; i < 16 * 1024; i += 512) { const float v = cin[i]; cact[i] = v / (1.f + expf(-v)); }
        __syncthreads();
        for (int item = bid; item < 192; item += G) {
            const int l = item / 96, n0 = (item % 96) * 64, kg = tid >> 6, n = tid & 63;
            float acc[16];
#pragma unroll
            for (int b = 0; b < 16; ++b) acc[b] = 0.f;
            const float* w = ada_w + (size_t)l * 1024 * 6144 + n0 + n;
            for (int k = kg * 128; k < kg * 128 + 128; ++k) {
                const float wv = w[(size_t)k * 6144];
#pragma unroll
                for (int b = 0; b < 16; ++b) acc[b] += cact[b * 1024 + k] * wv;
            }
#pragma unroll
            for (int b = 0; b < 16; ++b) red[(kg * 16 + b) * 64 + n] = acc[b];
            __syncthreads();
            for (int i = tid; i < 1024; i += 512) {
                const int b = i >> 6, nn = i & 63; float s = 0.f;
#pragma unroll
                for (int q = 0; q < 8; ++q) s += red[(q * 16 + b) * 64 + nn];
                mod[((size_t)l * 16 + b) * 6144 + n0 + nn] = s + ada_b[l * 6144 + n0 + nn];
            }
            __syncthreads();
        }
        for (int i = bid * 512 + tid; i < 4096 * 8; i += G * 512) {
            const int t = i >> 3, f = i & 7;
            const float inv = powf(500000.0f, -(float)(2 * f) / 16.0f);
            const float ang = (float)t * inv;
            rope[i] = (float)cos((double)ang);
            rope[4096 * 8 + i] = (float)sin((double)ang);
        }
        __syncthreads();
        LAS float* scr = (LAS float*)(lds + wave * 16640);
        const float* conv_in_w = KIN(6); const float* conv_out_w = KIN(8); const float* attn_in_w = KIN(9); const float* attn_out_w = KIN(10);
        const float* gate_w = KIN(15); const float* up_w = KIN(16); const float* down_w = KIN(17);
        bf16_t* WZ = WSP(bf16_t, WS_WZ); bf16_t* WB = WSP(bf16_t, WS_WB); bf16_t* WCO = WSP(bf16_t, WS_WCO); bf16_t* WAI = WSP(bf16_t, WS_WAI); bf16_t* WAO = WSP(bf16_t, WS_WAO);
        bf16_t* WGU = WSP(bf16_t, WS_WGU); bf16_t* WDN = WSP(bf16_t, WS_WDN);
        for (int it0 = bid * NWAVES + wave; it0 < NCONV_ITEMS; it0 += G * NWAVES) {
            int it = it0;
            if (it < 512) { conv_item(conv_in_w, 3072, 1024, WZ, 1024, 1, scr, it / 32, it % 32, lane); continue; } it -= 512;
            if (it < 256) { conv_item(conv_in_w, 3072, 0, WB, 1024, 0, scr, it / 16, it % 16, lane); continue; } it -= 256;
            if (it < 256) { conv_item(conv_out_w, 1024, 0, WCO, 1024, 0, scr, it / 16, it % 16, lane); continue; } it -= 256;
            if (it < 1152) { conv_item(attn_in_w, QKVW, 0, WAI, 1024, 2, scr, it / 72, it % 72, lane); continue; } it -= 1152;
            if (it < 128) { conv_item(attn_out_w, 1024, 0, WAO, 512, 0, scr, it / 16, it % 16, lane); continue; } it -= 128;
            const int le = it / 384, r = it % 384;
            if (r < 128) conv_item(gate_w + (size_t)le * D * DEXP, DEXP, 0, WGU + (size_t)le * 1024 * 1024, 1024, 3, scr, r / 8, r % 8, lane);
            else if (r < 256) conv_item(up_w + (size_t)le * D * DEXP, DEXP, 0, WGU + (size_t)le * 1024 * 1024, 1024, 4, scr, (r - 128) / 8, (r - 128) % 8, lane);
            else conv_item(down_w + (size_t)le * DEXP * D, D, 0, WDN + (size_t)le * 1024 * 512, 512, 0, scr, (r - 256) / 16, (r - 256) % 16, lane);
        }
    }
    SEAM(0);
    if (IN(1)) { IDS();
        const float* x = KIN(0); const float* norm_mix_g = KIN(2); const float* mod = WSP(float, WS_MOD); bf16_t* xn = WSP(bf16_t, WS_XN);
        for (int row = bid * 8 + wave; row < T; row += G * 8) {
            RowV r; row_load(r, x + (size_t)row * D, lane);
            const float rstd = row_rstd(r);
            const float* mb = mod + (size_t)(row >> 12) * 6144;
            row_modulate(r, rstd, norm_mix_g, mb + 0, mb + 1024, lane);
            row_store_bf16(r, xn + (size_t)row * D, lane);
        }
    }
    SEAM(1);
    if (IN(2)) { bf16_t* xn = WSP(bf16_t, WS_XN); bf16_t* WZ = WSP(bf16_t, WS_WZ); bf16_t* zb = WSP(bf16_t, WS_Z);
        pg8::Gemm g{xn, WZ, T, 2048, 1024}; pg8::StaticOrder S; S.init(T, 2048, G, bid); pg8::EpiPair<false> E{zb, D};
        pg8::gemm_phase<pg8::EpiPair<false>, pg8::StaticOrder, pg8::APlain, true, true>(lds, g, S, E, pg8::APlain{}, wave); }
    SEAM(2);
    if (IN(3)) { bf16_t* xn = WSP(bf16_t, WS_XN); bf16_t* WB = WSP(bf16_t, WS_WB); bf16_t* zb = WSP(bf16_t, WS_Z); bf16_t* ypre = WSP(bf16_t, WS_YPRE); const float* conv_w = KIN(7);
        pg8::Gemm g{xn, WB, T, 1024, 1024}; pg8::StaticOrder S; S.init(T, 1024, G, bid); pg8::EpiYpre E{ypre, zb, conv_w};
        pg8::gemm_phase<pg8::EpiYpre, pg8::StaticOrder, pg8::APlain, true, true>(lds, g, S, E, pg8::APlain{}, wave); }
    SEAM(3);
    if (IN(4)) { bf16_t* ypre = WSP(bf16_t, WS_YPRE); bf16_t* WCO = WSP(bf16_t, WS_WCO); float* xres = KOUT(); const float* x = KIN(0); const float* mod = WSP(float, WS_MOD);
        pg8::Gemm g{ypre, WCO, T, 1024, 1024}; pg8::StaticOrder S; S.init(T, 1024, G, bid); pg8::EpiRes E{xres, x, mod + 2048};
        pg8::gemm_phase<pg8::EpiRes, pg8::StaticOrder, pg8::APlain, true, true>(lds, g, S, E, pg8::APlain{}, wave); }
    SEAM(4);
#pragma unroll 1
    for (int l = 0; l < 2; ++l) {
        const int pb0 = (l == 0) ? 5 : 13;
#define MODL() (WSP(float, WS_MOD) + (size_t)l * 16 * 6144)
#define CNTL() (WSP(int, WS_CTL) + 64 * l)
        if (l == 1) {
            if (IN(9)) { bf16_t* xn = WSP(bf16_t, WS_XN); bf16_t* WAI = WSP(bf16_t, WS_WAI); bf16_t* qkv = WSP(bf16_t, WS_QKV); const float* rope = WSP(float, WS_ROPE);
                pg8::Gemm g{xn, WAI, T, QKVW, 1024}; pg8::StaticOrder S; S.init(T, QKVW, G, bid); pg8::EpiQKV E{qkv, rope};
                pg8::gemm_phase<pg8::EpiQKV, pg8::StaticOrder, pg8::APlain, true, true>(lds, g, S, E, pg8::APlain{}, wave); }
            SEAM(9);
            if (IN(10)) att::attn_phase(lds, WSP(bf16_t, WS_QKV), WSP(float, WS_LSE), bid, G, wave);
            SEAM(10);
            if (IN(11)) { IDS(); attn_comb(WSP(bf16_t, WS_QKV), WSP(float, WS_LSE), WSP(bf16_t, WS_XN), bid, G, tid); }
            SEAM(11);
            if (IN(12)) { bf16_t* ob = WSP(bf16_t, WS_XN); bf16_t* WAO = WSP(bf16_t, WS_WAO); float* xres = KOUT();
                pg8::Gemm g{ob, WAO, T, 1024, 512}; pg8::StaticOrder S; S.init(T, 1024, G, bid); pg8::EpiRes E{xres, xres, MODL() + 2048};
                pg8::gemm_phase<pg8::EpiRes, pg8::StaticOrder, pg8::APlain, true, true>(lds, g, S, E, pg8::APlain{}, wave); }
            SEAM(12);
        }
        if (IN(pb0)) { IDS();
            LAS int* rec_e = (LAS int*)lds; LAS float* rec_w = (LAS float*)(lds + 2048); LAS int* rec_rank = (LAS int*)(lds + 4096); LAS int* hist = (LAS int*)(lds + 6144); LAS int* base = (LAS int*)(lds + 6144 + 128);
            const float* gff = KIN(3) + l * D; const float* wg = KIN(11) + (size_t)l * D * 4; const float* bg = KIN(12) + l * 4; const float* we = KIN(13) + (size_t)l * 4 * D * 8; const float* be = KIN(14) + l * 32;
            const float* xres = KOUT(); const float* modl = MODL(); int* cntl = CNTL(); bf16_t* xn = WSP(bf16_t, WS_XN); int* ltok = WSP(int, WS_LTOK); float* lw = WSP(float, WS_LW); int* tslot = WSP(int, WS_TSLOT);
            for (int blk = bid; blk < T / 256; blk += G) {
                if (tid < 32) hist[tid] = 0;
                __syncthreads();
#pragma unroll 1
                for (int i = 0; i < 32; ++i) {
                    const int rl = wave * 32 + i, row = blk * 256 + rl;
                    RowV r; row_load(r, xres + (size_t)row * D, lane);
                    const float rstd = row_rstd(r);
                    const float* mb = modl + (size_t)(row >> 12) * 6144;
                    row_modulate(r, rstd, gff, mb + 3072, mb + 4096, lane);
                    row_store_bf16(r, xn + (size_t)row * D, lane);
                    float pg[4] = {0.f, 0.f, 0.f, 0.f};
#pragma unroll
                    for (int j = 0; j < 4; ++j)
#pragma unroll
                        for (int cc = 0; cc < 4; ++cc) {
                            const int k = 4 * lane + 256 * j + cc; const f32x4 w = *(const f32x4*)(wg + (size_t)k * 4); const float hv = r.v[j][cc];
                            pg[0] += hv * w.x; pg[1] += hv * w.y; pg[2] += hv * w.z; pg[3] += hv * w.w;
                        }
#pragma unroll
                    for (int o = 0; o < 4; ++o) pg[o] = wave_sum(pg[o]) + bg[o];
                    int gi = 0; float gm = pg[0];
#pragma unroll
                    for (int o = 1; o < 4; ++o) if (pg[o] > gm) { gm = pg[o]; gi = o; }
                    float gden = 0.f;
#pragma unroll
                    for (int o = 0; o < 4; ++o) gden += expf(pg[o] - gm);
                    const float grp_p = 1.0f / gden;
                    float pe[8] = {0.f, 0.f, 0.f, 0.f, 0.f, 0.f, 0.f, 0.f};
                    const float* wex = we + (size_t)gi * 1024 * 8;
#pragma unroll
                    for (int j = 0; j < 4; ++j)
#pragma unroll
                        for (int cc = 0; cc < 4; ++cc) {
                            const int k = 4 * lane + 256 * j + cc; const f32x4 w0 = *(const f32x4*)(wex + (size_t)k * 8), w1 = *(const f32x4*)(wex + (size_t)k * 8 + 4); const float hv = r.v[j][cc];
                            pe[0] += hv * w0.x; pe[1] += hv * w0.y; pe[2] += hv * w0.z; pe[3] += hv * w0.w;
                            pe[4] += hv * w1.x; pe[5] += hv * w1.y; pe[6] += hv * w1.z; pe[7] += hv * w1.w;
                        }
#pragma unroll
                    for (int o = 0; o < 8; ++o) pe[o] = wave_sum(pe[o]) + be[gi * 8 + o];
                    int i0 = 0; float m0 = pe[0];
#pragma unroll
                    for (int o = 1; o < 8; ++o) if (pe[o] > m0) { m0 = pe[o]; i0 = o; }
                    int i1 = -1; float m1 = -INFINITY;
#pragma unroll
                    for (int o = 0; o < 8; ++o) if (o != i0 && pe[o] > m1) { m1 = pe[o]; i1 = o; }
                    const float p1 = expf(m1 - m0);
                    if (lane == 0) { rec_e[rl * 2] = gi * 8 + i0; rec_e[rl * 2 + 1] = gi * 8 + i1; rec_w[rl * 2] = grp_p / (1.0f + p1); rec_w[rl * 2 + 1] = grp_p * p1 / (1.0f + p1); }
                }
                __syncthreads();
                { const int e = rec_e[tid]; rec_rank[tid] = atomicAdd((int*)&hist[e], 1); }
                __syncthreads();
                if (tid < 32) { const int h = hist[tid]; base[tid] = h ? atomicAdd(&cntl[tid], h) : 0; }
                __syncthreads();
                { const int e = rec_e[tid], pos = base[e] + rec_rank[tid], tok = blk * 256 + (tid >> 1);
                  ltok[(size_t)e * LISTCAP + pos] = tok; lw[(size_t)e * LISTCAP + pos] = rec_w[tid]; tslot[tok * 2 + (tid & 1)] = (e << 16) | pos; }
                __syncthreads();
            }
        }
        SEAM(pb0);
        if (IN(pb0 + 1) || IN(pb0 + 2) || IN(pb0 + 3)) {
            __syncthreads();
            if (wave == 0 && lane_id() == 0) { const int* cntl = CNTL(); int s = 0; for (int e = 0; e < 32; ++e) { rb[e] = s; s += (__hip_atomic_load(&cntl[e], RLX_AGENT) + 255) & ~255; } rb[32] = s; }
            __syncthreads();
        }
        if (IN(pb0 + 1)) { bf16_t* xn = WSP(bf16_t, WS_XN); bf16_t* WGU = WSP(bf16_t, WS_WGU); bf16_t* act = WSP(bf16_t, WS_ACT); const int* ltok = WSP(int, WS_LTOK); const int* cntl = CNTL();
            pg8::Gemm g{xn, WGU + (size_t)l * 32 * 1024 * 1024, 0, 0, 1024}; pg8::MoeOrder S; S.init(rb[32] / 256, G, bid, rb); pg8::EpiPair<true> E{act, DEXP}; pg8::AGather am{ltok, cntl, rb};
            pg8::gemm_phase<pg8::EpiPair<true>, pg8::MoeOrder, pg8::AGather, true, true>(lds, g, S, E, am, wave); }
        SEAM(pb0 + 1);
        if (IN(pb0 + 2)) { bf16_t* act = WSP(bf16_t, WS_ACT); bf16_t* WDN = WSP(bf16_t, WS_WDN); bf16_t* yw = WSP(bf16_t, WS_YW); const float* lw = WSP(float, WS_LW);
            pg8::Gemm g{act, WDN + (size_t)l * 32 * 1024 * 512, 0, 0, 512}; pg8::MoeOrder S; S.init(rb[32] / 256, G, bid, rb); pg8::EpiDown E{yw, lw, rb};
            pg8::gemm_phase<pg8::EpiDown, pg8::MoeOrder, pg8::APlain, true, true>(lds, g, S, E, pg8::APlain{}, wave); }
        SEAM(pb0 + 2);
        if (IN(pb0 + 3)) { IDS();
            const float* gnext = (l == 0) ? KIN(2) + D : KIN(18);
            const float* modn = WSP(float, WS_MOD) + (size_t)16 * 6144; const float* modl = MODL();
            float* xres = KOUT(); const bf16_t* yw = WSP(bf16_t, WS_YW); const int* tslot = WSP(int, WS_TSLOT); bf16_t* xn = WSP(bf16_t, WS_XN);
            for (int row = bid * 8 + wave; row < T; row += G * 8) {
                const int b = row >> 12;
                const int s0 = tslot[row * 2], s1 = tslot[row * 2 + 1];
                const size_t r0 = (size_t)(rb[s0 >> 16] + (s0 & 0xffff)), r1 = (size_t)(rb[s1 >> 16] + (s1 & 0xffff));
                RowV r; row_load(r, xres + (size_t)row * D, lane);
                const float* g2 = modl + (size_t)b * 6144 + 5120;
#pragma unroll
                for (int j = 0; j < 4; ++j) {
                    const int o = 4 * lane + 256 * j;
                    const u32x2 a = *(const u32x2*)(yw + r0 * D + o), c = *(const u32x2*)(yw + r1 * D + o);
                    const f32x4 gg = *(const f32x4*)(g2 + o);
                    f32x4 y; y.x = bflo(a.x) + bflo(c.x); y.y = bfhi(a.x) + bfhi(c.x); y.z = bflo(a.y) + bflo(c.y); y.w = bfhi(a.y) + bfhi(c.y);
                    r.v[j] = r.v[j] + gg * y;
                }
                const float rstd = row_rstd(r);
                if (l == 1) {
#pragma unroll
                    for (int j = 0; j < 4; ++j) { const f32x4 gg = *(const f32x4*)(gnext + 4 * lane + 256 * j); r.v[j] = r.v[j] * rstd * gg; }
                    row_store_f32(r, xres + (size_t)row * D, lane);
                } else {
                    row_store_f32(r, xres + (size_t)row * D, lane);
                    const float* mb = modn + (size_t)b * 6144;
                    row_modulate(r, rstd, gnext, mb + 0, mb + 1024, lane);
                    row_store_bf16(r, xn + (size_t)row * D, lane);
                }
            }
        }
        SEAM(pb0 + 3);
    }
#undef IDS
#undef MODL
#undef CNTL
#undef IN
#undef SEAM
#undef GRID_BAR
}

extern "C" void kernel_launch(void* const* d_in, const int* in_sizes, int n_in, void* d_out, int out_size, void* d_ws, size_t ws_size, hipStream_t stream) {
    static int grid = 0;
    if (grid == 0) {
        if (n_in != 19 || out_size != T * D || ws_size < WS_END) { fprintf(stderr, "kernel_launch: unexpected shapes (n_in %d out %d ws %zu)\n", n_in, out_size, ws_size); grid = -1; return; }
        int dev = 0, cus = 0;
        if (hipGetDevice(&dev) != hipSuccess || hipDeviceGetAttribute(&cus, hipDeviceAttributeMultiprocessorCount, dev) != hipSuccess) { grid = -1; return; }
        if (hipFuncSetAttribute((const void*)mk_fwd, hipFuncAttributeMaxDynamicSharedMemorySize, LDS_BYTES) != hipSuccess) { fprintf(stderr, "kernel_launch: hipFuncSetAttribute failed\n"); grid = -1; return; }
        int per_cu = 0;
        if (hipOccupancyMaxActiveBlocksPerMultiprocessor(&per_cu, (const void*)mk_fwd, NWAVES * 64, LDS_BYTES) != hipSuccess || per_cu < 1) fprintf(stderr, "kernel_launch: occupancy query says %d\n", per_cu);
        (void)hipGetLastError();
        grid = cus;
    }
    if (grid < 0) return;
    (void)hipMemsetAsync((char*)d_ws + WS_CTL, 0, CTL_BYTES, stream);
    Args a{};
    for (int i = 0; i < 19; ++i) a.in[i] = (const float*)d_in[i];
    a.out = (float*)d_out; a.ws = (unsigned char*)d_ws;
#if MK_ONE_LAUNCH
    a.ph_lo = 0; a.ph_hi = NPHASE;
    hipLaunchKernelGGL(mk_fwd, dim3(grid), dim3(NWAVES * 64), LDS_BYTES, stream, a);
#else
    for (int p = 0; p < NPHASE; ++p) { a.ph_lo = p; a.ph_hi = p + 1; hipLaunchKernelGGL(mk_fwd, dim3(grid), dim3(NWAVES * 64), LDS_BYTES, stream, a); }
#endif
}
```

```cpp
#include <hip/hip_runtime.h>
#include <stdint.h>
#include <math.h>
#include <cstdio>

#ifndef MK_ONE_LAUNCH
#define MK_ONE_LAUNCH 1
#endif

typedef unsigned short bf16_t;
typedef float f32x4 __attribute__((ext_vector_type(4)));
typedef unsigned u32x2 __attribute__((ext_vector_type(2)));
typedef unsigned u32x4 __attribute__((ext_vector_type(4)));
#define GAS __attribute__((address_space(1)))
#define LAS __attribute__((address_space(3)))
typedef GAS unsigned gu32;
#define RLX_AGENT __ATOMIC_RELAXED, __HIP_MEMORY_SCOPE_AGENT

constexpr int D = 1024, BATCH = 16, SEQ = 4096, T = BATCH * SEQ;
constexpr int NEXP = 32, DEXP = 512, EPG = 8, NGRP = 4;
constexpr int QKVW = 4608;
constexpr int LISTCAP = 65536;
constexpr int PADROWS = 139264;
constexpr float EPS = 1e-6f;
constexpr float QSCALE = 0.125f * 1.4426950408889634f;
constexpr int NWAVES = 8;

constexpr size_t MiB = 1u << 20;
constexpr size_t WS_CTL = 0;
constexpr size_t CTL_BYTES = 1 * MiB;
constexpr int CW_BAR = 4096;
constexpr size_t WS_MOD = 1 * MiB;
constexpr size_t WS_ROPE = 3 * MiB;
constexpr size_t WS_LTOK = 4 * MiB;
constexpr size_t WS_LW = 12 * MiB;
constexpr size_t WS_TSLOT = 20 * MiB;
constexpr size_t WS_LSE = 24 * MiB;
constexpr size_t WS_WZ = 32 * MiB;
constexpr size_t WS_WB = 36 * MiB;
constexpr size_t WS_WCO = 38 * MiB;
constexpr size_t WS_WAI = 40 * MiB;
constexpr size_t WS_WAO = 49 * MiB;
constexpr size_t WS_WGU = 64 * MiB;
constexpr size_t WS_WDN = 192 * MiB;
constexpr size_t WS_XN = 256 * MiB;
constexpr size_t WS_BIG = 384 * MiB;
constexpr size_t WS_Z = WS_BIG, WS_YPRE = WS_BIG + 128 * MiB;
constexpr size_t WS_ACT = WS_BIG, WS_YW = WS_BIG + 136 * MiB;
constexpr size_t WS_QKV = WS_BIG;
constexpr size_t WS_END = WS_BIG + 576 * MiB;

constexpr int RING_BYTES = 162816;
constexpr int MISC_OFF = RING_BYTES;
constexpr int LDS_BYTES = RING_BYTES + 1024;

__device__ __forceinline__ unsigned f2bf(float f) { unsigned u = __float_as_uint(f); return (u + 0x7fffu + ((u >> 16) & 1u)) >> 16; }
__device__ __forceinline__ unsigned pk2(float lo, float hi) { return f2bf(lo) | (f2bf(hi) << 16); }
__device__ __forceinline__ float bf2f(unsigned h) { return __uint_as_float(h << 16); }
__device__ __forceinline__ float bflo(unsigned w) { return __uint_as_float(w << 16); }
__device__ __forceinline__ float bfhi(unsigned w) { return __uint_as_float(w & 0xffff0000u); }
__device__ __forceinline__ float wave_sum(float v) {
#pragma unroll
    for (int o = 1; o < 64; o <<= 1) v += __shfl_xor(v, o);
    return v;
}
__device__ __forceinline__ float silu_f(float x) { return x / (1.0f + __expf(-x)); }
#define LDS_WAIT() asm volatile("s_waitcnt lgkmcnt(0)" ::: "memory")
__device__ __forceinline__ int lane_id() { int l; asm volatile("v_mbcnt_lo_u32_b32 %0, -1, 0\n\tv_mbcnt_hi_u32_b32 %0, -1, %0" : "=v"(l)); return l; }

namespace pg8 {
#define PG8_LAS __attribute__((address_space(3)))
typedef unsigned short bf16_t;
typedef short bf16x8 __attribute__((ext_vector_type(8)));
typedef float f32x4 __attribute__((ext_vector_type(4)));
typedef unsigned u32x4 __attribute__((ext_vector_type(4)));
constexpr int BM = 256, BK = 64, HALF = 128, HTB = HALF * BK * 2  , STAGE_BYTES = 8 * HTB, NXCD = 8, WGM = 8;

__host__ __device__ __forceinline__ int lds_byte(int r, int c) { const int st = (r >> 4) * 2 + (c >> 5), rr = r & 15, cc = c & 31, ob = rr * 64 + cc * 2; return st * 1024 + (ob ^ (((ob >> 9) & 1) << 5)); }
__host__ __device__ __forceinline__ void stage_rc(int b, int& R, int& C) { const int st = b / 1024, sb = b % 1024, swz = sb ^ (((sb >> 9) & 1) << 5); R = (st >> 1) * 16 + swz / 64; C = (st & 1) * 32 + (swz % 64) / 2; }
__host__ __device__ __forceinline__ int perm32(int rho) { const int n = rho >> 4, i = rho & 15; return 8 * (i >> 2) + 4 * n + (i & 3); }

struct Unit { int pm, pn, pb; };
struct Gemm { const bf16_t* A; const bf16_t* Bt; int M, N, K; };

struct StaticOrder {
    int nM, nN, nwg, G, c;
    __host__ __device__ void init(int M, int N, int G_, int c_) { nM = M / BM; nN = N / BM; nwg = nM * nN; G = G_; c = c_; }
    __host__ __device__ bool next(int i, Unit& u) const {
        const long L = (long)i * G + c; if (L >= nwg) return false;
        int wgid = (int)L; { const int q = nwg / NXCD, r = nwg % NXCD, xcd = wgid % NXCD, off = wgid / NXCD; wgid = (xcd < r ? xcd * (q + 1) : r * (q + 1) + (xcd - r) * q) + off; }
        const int nig = WGM * nN, gid = wgid / nig, fm = gid * WGM, gsz = (nM - fm) < WGM ? (nM - fm) : WGM;
        u.pm = fm + ((wgid % nig) % gsz); u.pn = (wgid % nig) / gsz; u.pb = u.pn; return true;
    }
    __device__ __forceinline__ void a_ready(const Unit&) const {}
    __device__ __forceinline__ void done(const Unit&) const {}
};


__device__ __forceinline__ unsigned cvt_pk_bf16(float lo, float hi) { unsigned r; asm volatile("v_cvt_pk_bf16_f32 %0, %1, %2" : "=v"(r) : "v"(lo), "v"(hi)); return r; }
typedef float f32x2 __attribute__((ext_vector_type(2)));

template <class Epi, class Sched, class AM, bool ALIGN_EPI = false, bool SP2 = false>
__device__ __forceinline__ void gemm_phase(PG8_LAS unsigned char* lds, const Gemm g, const Sched& S, const Epi& E, const AM& am, const int wid) {
    const int lane = lane_id(), tid = wid * 64 + lane, wr = wid >> 2, wc = wid & 3, fr = lane & 15, fq = lane >> 4;
    const int K = g.K, nt = K / BK;
    unsigned voffA[2], voffB[2]; int stR[2], stC[2];
#pragma unroll
    for (int i = 0; i < 2; ++i) { int R, C; stage_rc(tid * 16 + i * 8192, R, C); const int Rb = Epi::PERM ? ((R & ~31) + perm32(R & 31)) : R;
        stR[i] = R; stC[i] = C; voffA[i] = (unsigned)(R * K + C) * 2u; voffB[i] = (unsigned)(Rb * K + C) * 2u; }
    const size_t kstep = (size_t)(BK * 2);
    const size_t hstep = (size_t)HALF * K * 2;
    const size_t tstep = 2 * hstep;
    const unsigned ldsw = (unsigned)wid * 1024u;
    const int aoff = lds_byte(wr * 64 + fr, fq * 8), boff = lds_byte(wc * 32 + fr, fq * 8);
#define PG8_SA(b, h) (((b) * 2 + (h)) * HTB)
#define PG8_SB(b, h) ((4 + (b) * 2 + (h)) * HTB)
#define PG8_STAGE(bufoff, gbase, voff) do { _Pragma("unroll") for (int _i = 0; _i < 2; ++_i) \
        __builtin_amdgcn_global_load_lds((const unsigned*)((const char*)(gbase) + (voff)[_i]), (PG8_LAS unsigned*)(lds + (bufoff) + ldsw + _i * 8192), 16, 0, 0); } while (0)
#define PG8_STAGE_A(b, h, gbase, NX) do { if constexpr (AM::GATHER) { const unsigned so_[2] = {(NX) ? gno[h][0] : gao[h][0], (NX) ? gno[h][1] : gao[h][1]}; PG8_STAGE(PG8_SA(b, h), gbase, so_); } \
        else { PG8_STAGE(PG8_SA(b, h), (gbase) + (h) * hstep, voffA); } } while (0)
#define PG8_LDA(dst, b, h) do { _Pragma("unroll") for (int m = 0; m < 4; ++m) _Pragma("unroll") for (int k = 0; k < 2; ++k) dst[m][k] = *(const PG8_LAS bf16x8*)(lds + PG8_SA(b, h) + aoff + m * 2048 + k * 1024); } while (0)
#define PG8_LDB(dst, b, h) do { _Pragma("unroll") for (int n = 0; n < 2; ++n) _Pragma("unroll") for (int k = 0; k < 2; ++k) dst[n][k] = *(const PG8_LAS bf16x8*)(lds + PG8_SB(b, h) + boff + n * 2048 + k * 1024); } while (0)
#define PG8_MMA(ai, bj, At, Bt) do { __builtin_amdgcn_s_setprio(1); _Pragma("unroll") for (int m = 0; m < 4; ++m) _Pragma("unroll") for (int n = 0; n < 2; ++n) _Pragma("unroll") for (int k = 0; k < 2; ++k) \
        acc[ai][bj][m][n] = __builtin_amdgcn_mfma_f32_16x16x32_bf16(Bt[n][k], At[m][k], acc[ai][bj][m][n], 0, 0, 0); __builtin_amdgcn_s_setprio(0); } while (0)
#define PG8_WAIT_V(n) asm volatile("s_waitcnt vmcnt(" #n ")" ::: "memory")
#define PG8_WAIT_L(n) asm volatile("s_waitcnt lgkmcnt(" #n ")" ::: "memory")
#define PG8_BAR __builtin_amdgcn_s_barrier()
#define PG8_SCHED __builtin_amdgcn_sched_barrier(0)
    Unit cur, nxt; int ui = 0;
    if (!S.next(0, cur)) return;
    f32x4 acc[2][2][4][2];
#pragma unroll
    for (int a = 0; a < 2; ++a)
#pragma unroll
        for (int b = 0; b < 2; ++b)
#pragma unroll
            for (int m = 0; m < 4; ++m)
#pragma unroll
                for (int n = 0; n < 2; ++n) acc[a][b][m][n] = (f32x4){0.f, 0.f, 0.f, 0.f};
    bf16x8 At[4][2], B0[2][2], B1[2][2];
    const char* cA = (const char*)g.A + (AM::GATHER ? (size_t)0 : (size_t)cur.pm * tstep); const char* cB = (const char*)g.Bt + (size_t)cur.pb * tstep;
    unsigned gao[2][2], gno[2][2];
    if constexpr (AM::GATHER) { _Pragma("unroll") for (int h = 0; h < 2; ++h) _Pragma("unroll") for (int i = 0; i < 2; ++i) { gao[h][i] = (unsigned)(am.arow(cur, h * HALF + stR[i]) * K + stC[i]) * 2u; gno[h][i] = gao[h][i]; } }
    else { _Pragma("unroll") for (int h = 0; h < 2; ++h) _Pragma("unroll") for (int i = 0; i < 2; ++i) { gao[h][i] = 0u; gno[h][i] = 0u; } }
    S.a_ready(cur);
    if constexpr (SP2) {
        PG8_STAGE(PG8_SB(0, 0), cB, voffB); PG8_STAGE(PG8_SB(0, 1), cB + hstep, voffB); PG8_STAGE_A(0, 0, cA, false); PG8_STAGE_A(0, 1, cA, false);
        if (wr == 1) PG8_BAR;
        PG8_WAIT_V(2); PG8_BAR;
        PG8_STAGE(PG8_SB(1, 0), cB + kstep, voffB); PG8_STAGE_A(1, 0, cA + kstep, false); PG8_STAGE(PG8_SB(1, 1), cB + hstep + kstep, voffB);
        PG8_WAIT_V(6); PG8_BAR;
    } else {
        PG8_STAGE(PG8_SB(0, 0), cB, voffB); PG8_STAGE_A(0, 0, cA, false); PG8_STAGE(PG8_SB(0, 1), cB + hstep, voffB); PG8_STAGE_A(0, 1, cA, false);
        if (wr == 1) PG8_BAR;
        PG8_WAIT_V(4); PG8_BAR;
        PG8_STAGE(PG8_SB(1, 0), cB + kstep, voffB); PG8_STAGE_A(1, 0, cA + kstep, false); PG8_STAGE(PG8_SB(1, 1), cB + hstep + kstep, voffB);
        PG8_WAIT_V(6); PG8_BAR;
    }
    for (;;) {
        const bool has_next = S.next(ui + 1, nxt);
        const char* nA = has_next ? (const char*)g.A + (AM::GATHER ? (size_t)0 : (size_t)nxt.pm * tstep) : cA; const char* nB = has_next ? (const char*)g.Bt + (size_t)nxt.pb * tstep : cB;
        if constexpr (AM::GATHER) { if (has_next) { _Pragma("unroll") for (int h = 0; h < 2; ++h) _Pragma("unroll") for (int i = 0; i < 2; ++i) gno[h][i] = (unsigned)(am.arow(nxt, h * HALF + stR[i]) * K + stC[i]) * 2u; } }
        for (int t = 0; t < nt; t += 2) {
            const bool last = (t == nt - 2);
            const char* a1 = cA + (size_t)(t + 1) * kstep;
            const char* a2 = last ? nA : cA + (size_t)(t + 2) * kstep; const char* b2 = last ? nB : cB + (size_t)(t + 2) * kstep;
            const char* a3 = a2 + kstep; const char* b3 = b2 + kstep;
            if (last && has_next) S.a_ready(nxt);
            if constexpr (SP2) {
            PG8_LDB(B0, 0, 0); PG8_LDB(B1, 0, 1); PG8_SCHED; PG8_LDA(At, 0, 0); PG8_STAGE_A(1, 1, a1, false);
            PG8_WAIT_V(8); PG8_WAIT_L(0); PG8_BAR; PG8_MMA(0, 0, At, B0); PG8_MMA(0, 1, At, B1); PG8_BAR; PG8_SCHED;
            PG8_LDA(At, 0, 1); PG8_STAGE(PG8_SB(0, 0), b2, voffB); PG8_STAGE(PG8_SB(0, 1), b2 + hstep, voffB); PG8_STAGE_A(0, 0, a2, last);
            PG8_WAIT_V(8); PG8_WAIT_L(0); PG8_BAR; PG8_MMA(1, 0, At, B0); PG8_MMA(1, 1, At, B1); PG8_BAR; PG8_SCHED;
            PG8_LDB(B0, 1, 0); PG8_LDB(B1, 1, 1); PG8_SCHED; PG8_LDA(At, 1, 0); PG8_STAGE_A(0, 1, a2, last);
            PG8_WAIT_V(8); PG8_WAIT_L(0); PG8_BAR; PG8_MMA(0, 0, At, B0); PG8_MMA(0, 1, At, B1); PG8_BAR; PG8_SCHED;
            PG8_LDA(At, 1, 1); PG8_STAGE(PG8_SB(1, 0), b3, voffB); PG8_STAGE(PG8_SB(1, 1), b3 + hstep, voffB); PG8_STAGE_A(1, 0, a3, last);
            PG8_WAIT_V(8); PG8_WAIT_L(0); PG8_BAR; PG8_MMA(1, 0, At, B0); PG8_MMA(1, 1, At, B1); PG8_BAR; PG8_SCHED;
            } else {
            PG8_LDB(B0, 0, 0); PG8_SCHED; PG8_LDA(At, 0, 0); PG8_STAGE_A(1, 1, a1, false);
            PG8_WAIT_L(8); PG8_BAR; PG8_WAIT_L(0); PG8_MMA(0, 0, At, B0); PG8_BAR; PG8_SCHED;
            PG8_LDB(B1, 0, 1); PG8_STAGE(PG8_SB(0, 0), b2, voffB);
            PG8_BAR; PG8_WAIT_L(0); PG8_MMA(0, 1, At, B1); PG8_BAR;
            PG8_LDA(At, 0, 1); PG8_STAGE_A(0, 0, a2, last);
            PG8_BAR; PG8_WAIT_L(0); PG8_MMA(1, 0, At, B0); PG8_BAR; PG8_SCHED;
            PG8_STAGE(PG8_SB(0, 1), b2 + hstep, voffB);
            PG8_WAIT_V(6); PG8_BAR; PG8_MMA(1, 1, At, B1); PG8_BAR;
            PG8_LDB(B0, 1, 0); PG8_SCHED; PG8_LDA(At, 1, 0); PG8_STAGE_A(0, 1, a2, last);
            PG8_WAIT_L(8); PG8_BAR; PG8_WAIT_L(0); PG8_MMA(0, 0, At, B0); PG8_BAR; PG8_SCHED;
            PG8_LDB(B1, 1, 1); PG8_STAGE(PG8_SB(1, 0), b3, voffB);
            PG8_BAR; PG8_WAIT_L(0); PG8_MMA(0, 1, At, B1); PG8_BAR;
            PG8_LDA(At, 1, 1); PG8_STAGE_A(1, 0, a3, last);
            PG8_BAR; PG8_WAIT_L(0); PG8_MMA(1, 0, At, B0); PG8_BAR; PG8_SCHED;
            PG8_STAGE(PG8_SB(1, 1), b3 + hstep, voffB);
            PG8_WAIT_V(6); PG8_BAR; PG8_MMA(1, 1, At, B1); PG8_BAR;
            }
        }
        if constexpr (ALIGN_EPI) { if (wr == 0) PG8_BAR; }
        if constexpr (!Epi::AFTER_DRAIN) { E(acc, cur, wr, wc, fr, fq); S.done(cur); }
        if (!has_next) break;
#pragma unroll
        for (int a = 0; a < 2; ++a)
#pragma unroll
            for (int b = 0; b < 2; ++b)
#pragma unroll
                for (int m = 0; m < 4; ++m)
#pragma unroll
                    for (int n = 0; n < 2; ++n) acc[a][b][m][n] = (f32x4){0.f, 0.f, 0.f, 0.f};
        cur = nxt; cA = nA; cB = nB; ++ui;
        if constexpr (AM::GATHER) { _Pragma("unroll") for (int h = 0; h < 2; ++h) _Pragma("unroll") for (int i = 0; i < 2; ++i) gao[h][i] = gno[h][i]; }
        if constexpr (ALIGN_EPI) { if (wr == 1) PG8_BAR; }
    }
    PG8_WAIT_V(0);
    if constexpr (!ALIGN_EPI) { if (wr == 0) PG8_BAR; }
    PG8_BAR;
    if constexpr (Epi::AFTER_DRAIN) { E.fused(acc, cur, wr, wc, fr, fq, lds, wid, lane); S.done(cur); }
#undef PG8_SA
#undef PG8_SB
#undef PG8_STAGE
#undef PG8_STAGE_A
#undef PG8_LDA
#undef PG8_LDB
#undef PG8_MMA
#undef PG8_WAIT_V
#undef PG8_WAIT_L
#undef PG8_BAR
#undef PG8_SCHED
}

__device__ __forceinline__ u32x4 pack8(const f32x4 v0, const f32x4 v1) { u32x4 w; w.x = cvt_pk_bf16(v0[0], v0[1]); w.y = cvt_pk_bf16(v0[2], v0[3]); w.z = cvt_pk_bf16(v1[0], v1[1]); w.w = cvt_pk_bf16(v1[2], v1[3]); return w; }
__device__ __forceinline__ float silu1(float x) { return x * __builtin_amdgcn_rcpf(1.0f + __builtin_amdgcn_exp2f(-1.4426950408889634f * x)); }
template <bool SILU> struct EpiPair {
    static constexpr bool PERM = true, AFTER_DRAIN = false;
    bf16_t* O; int ldc;
    __device__ __forceinline__ void operator()(const f32x4 (&acc)[2][2][4][2], const Unit& u, int wr, int wc, int fr, int fq) const {
        const int row0 = u.pm * BM + wr * 64 + fr, ch0 = u.pn * HALF + wc * 32 + 8 * fq;
#pragma unroll
        for (int ai = 0; ai < 2; ++ai)
#pragma unroll
            for (int m = 0; m < 4; ++m) {
                f32x4 a0 = acc[ai][0][m][0], a1 = acc[ai][0][m][1];
                if (SILU) {
#pragma unroll
                    for (int c = 0; c < 4; ++c) { a0[c] = silu1(a0[c]); a1[c] = silu1(a1[c]); }
                }
                *(u32x4*)(O + (size_t)(row0 + ai * HALF + m * 16) * ldc + ch0) = pack8(a0 * acc[ai][1][m][0], a1 * acc[ai][1][m][1]);
            }
    }
};
struct EpiYpre {
    static constexpr bool PERM = true, AFTER_DRAIN = false;
    bf16_t* O; const bf16_t* Z; const float* cw;
    __device__ __forceinline__ void operator()(const f32x4 (&acc)[2][2][4][2], const Unit& u, int wr, int wc, int fr, int fq) const {
        const int row0 = u.pm * BM + wr * 64 + fr;
#pragma unroll
        for (int bj = 0; bj < 2; ++bj) {
            const int col0 = u.pn * BM + bj * HALF + wc * 32 + 8 * fq;
            f32x4 w0[2], w1[2], w2[2];
#pragma unroll
            for (int n = 0; n < 2; ++n) { w0[n] = *(const f32x4*)(cw + col0 + 4 * n); w1[n] = *(const f32x4*)(cw + D + col0 + 4 * n); w2[n] = *(const f32x4*)(cw + 2 * D + col0 + 4 * n); }
#pragma unroll
            for (int ai = 0; ai < 2; ++ai)
#pragma unroll
                for (int m = 0; m < 4; ++m) {
                    const int row = row0 + ai * HALF + m * 16, t = row & (SEQ - 1);
                    const bf16_t* zp = Z + (size_t)row * D + col0;
                    const u32x4 z0 = *(const u32x4*)zp;
                    u32x4 z1 = {0u, 0u, 0u, 0u}, z2 = {0u, 0u, 0u, 0u};
                    if (t >= 1) z1 = *(const u32x4*)(zp - D);
                    if (t >= 2) z2 = *(const u32x4*)(zp - 2 * D);
                    f32x4 v[2];
#pragma unroll
                    for (int n = 0; n < 2; ++n) {
                        f32x4 a, b, c;
                        a[0] = __uint_as_float(z0[2 * n] << 16); a[1] = __uint_as_float(z0[2 * n] & 0xffff0000u); a[2] = __uint_as_float(z0[2 * n + 1] << 16); a[3] = __uint_as_float(z0[2 * n + 1] & 0xffff0000u);
                        b[0] = __uint_as_float(z1[2 * n] << 16); b[1] = __uint_as_float(z1[2 * n] & 0xffff0000u); b[2] = __uint_as_float(z1[2 * n + 1] << 16); b[3] = __uint_as_float(z1[2 * n + 1] & 0xffff0000u);
                        c[0] = __uint_as_float(z2[2 * n] << 16); c[1] = __uint_as_float(z2[2 * n] & 0xffff0000u); c[2] = __uint_as_float(z2[2 * n + 1] << 16); c[3] = __uint_as_float(z2[2 * n + 1] & 0xffff0000u);
                        v[n] = acc[ai][bj][m][n] * (w2[n] * a + w1[n] * b + w0[n] * c);
                    }
                    *(u32x4*)(O + (size_t)row * D + col0) = pack8(v[0], v[1]);
                    if (m & 1) asm volatile("" ::: "memory");
                }
        }
    }
};
struct EpiRes {
    static constexpr bool PERM = false, AFTER_DRAIN = false;
    float* out; const float* resin; const float* modg;
    __device__ __forceinline__ void operator()(const f32x4 (&acc)[2][2][4][2], const Unit& u, int wr, int wc, int fr, int fq) const {
        const int row0 = u.pm * BM + wr * 64 + fr, col0 = u.pn * BM + wc * 32 + 4 * fq;
        const float* gb = modg + (size_t)((u.pm * BM) >> 12) * 6144;
        f32x4 gv[2][2];
#pragma unroll
        for (int bj = 0; bj < 2; ++bj)
#pragma unroll
            for (int n = 0; n < 2; ++n) gv[bj][n] = *(const f32x4*)(gb + col0 + bj * HALF + n * 16);
#pragma unroll
        for (int ai = 0; ai < 2; ++ai)
#pragma unroll
            for (int m = 0; m < 4; ++m) { const size_t off = (size_t)(row0 + ai * HALF + m * 16) * D + col0;
#pragma unroll
                for (int bj = 0; bj < 2; ++bj)
#pragma unroll
                    for (int n = 0; n < 2; ++n) { const f32x4 r = *(const f32x4*)(resin + off + bj * HALF + n * 16); *(f32x4*)(out + off + bj * HALF + n * 16) = r + gv[bj][n] * acc[ai][bj][m][n]; }
                if (m & 1) asm volatile("" ::: "memory"); }
    }
};
struct EpiQKV {
    static constexpr bool PERM = true, AFTER_DRAIN = false;
    bf16_t* O; const float* rope;
    __device__ __forceinline__ void operator()(const f32x4 (&acc)[2][2][4][2], const Unit& u, int wr, int wc, int fr, int fq) const {
        const int row0 = u.pm * BM + wr * 64 + fr, col0 = u.pn * BM + wc * 32 + 8 * fq;
        const int typ = (u.pn % 6) >> 1;
        const bool rl = (typ < 2) && ((wc & 1) == 0) && (fq < 2);
        const float sc = (typ == 0) ? QSCALE : 1.0f;
#pragma unroll
        for (int ai = 0; ai < 2; ++ai)
#pragma unroll
            for (int m = 0; m < 4; ++m) {
                const int row = row0 + ai * HALF + m * 16, pos = row & (SEQ - 1);
                f32x4 cs = {1.f, 1.f, 1.f, 1.f}, sn = {0.f, 0.f, 0.f, 0.f};
                { const f32x4 c_ = *(const f32x4*)(rope + pos * 8 + 4 * (fq & 1)), s_ = *(const f32x4*)(rope + 4096 * 8 + pos * 8 + 4 * (fq & 1));
                  if (rl) { cs = c_; sn = s_; } }
#pragma unroll
                for (int bj = 0; bj < 2; ++bj) {
                    const f32x4 x1 = acc[ai][bj][m][0], x2 = acc[ai][bj][m][1];
                    const f32x4 r1 = (x1 * cs - x2 * sn) * sc, r2 = (x2 * cs + x1 * sn) * sc;
                    *(u32x4*)(O + (size_t)row * QKVW + col0 + bj * HALF) = pack8(r1, r2);
                }
                if (m & 1) asm volatile("" ::: "memory");
            }
    }
};
struct EpiDown {
    static constexpr bool PERM = true, AFTER_DRAIN = false;
    bf16_t* O; const float* lw; const PG8_LAS int* rb;
    __device__ __forceinline__ void operator()(const f32x4 (&acc)[2][2][4][2], const Unit& u, int wr, int wc, int fr, int fq) const {
        const int row0 = u.pm * BM + wr * 64 + fr, col0 = u.pn * BM + wc * 32 + 8 * fq;
        const int e = u.pb >> 2; const float* wrow = lw + (size_t)e * LISTCAP - rb[e];
#pragma unroll
        for (int ai = 0; ai < 2; ++ai)
#pragma unroll
            for (int m = 0; m < 4; ++m) {
                const int row = row0 + ai * HALF + m * 16; const float w = wrow[row];
#pragma unroll
                for (int bj = 0; bj < 2; ++bj) *(u32x4*)(O + (size_t)row * D + col0 + bj * HALF) = pack8(acc[ai][bj][m][0] * w, acc[ai][bj][m][1] * w);
            }
    }
};
struct MoeOrder {
    int nM, nN, nwg, G, c; const PG8_LAS int* rb;
    __device__ void init(int nRT, int G_, int c_, const PG8_LAS int* rb_) { nM = nRT; nN = 4; nwg = nM * nN; G = G_; c = c_; rb = rb_; }
    __device__ bool next(int i, Unit& u) const {
        const long L = (long)i * G + c; if (L >= nwg) return false;
        int wgid = (int)L; { const int q = nwg / NXCD, r = nwg % NXCD, xcd = wgid % NXCD, off = wgid / NXCD; wgid = (xcd < r ? xcd * (q + 1) : r * (q + 1) + (xcd - r) * q) + off; }
        const int nig = WGM * nN, gid = wgid / nig, fm = gid * WGM, gsz = (nM - fm) < WGM ? (nM - fm) : WGM;
        u.pm = fm + ((wgid % nig) % gsz); u.pn = (wgid % nig) / gsz;
        int e = 0; const int r0 = u.pm * BM; while (e < 31 && rb[e + 1] <= r0) ++e;
        u.pb = e * 4 + u.pn; return true;
    }
    __device__ __forceinline__ void a_ready(const Unit&) const {}
    __device__ __forceinline__ void done(const Unit&) const {}
};
struct APlain { static constexpr bool GATHER = false; __device__ __forceinline__ int arow(const Unit&, int) const { return 0; } };
struct AGather {
    static constexpr bool GATHER = true;
    const int* ltok; const int* cnt; const PG8_LAS int* rb;
    __device__ __forceinline__ int arow(const Unit& u, int r) const { const int e = u.pb >> 2, l = u.pm * BM - rb[e] + r; return (l < cnt[e]) ? ltok[(size_t)e * LISTCAP + l] : 0; }
};
}

#define XB_TMO      128
#define XB_XCNT(j)  (256  + 64 * (j))
#define XB_XSUB(j)  (1280 + 64 * (j))
#define XB_XGEN(j)  (2304 + 64 * (j))
#define XB_TOP      3328
#define XB_TOPGEN   3392
#define XCD_BAR_WORDS 3456
#define XB_SPIN_CAP (1u << 18)

__device__ __forceinline__ unsigned xb_ld(unsigned* p)              { return __hip_atomic_load(p, __ATOMIC_RELAXED, __HIP_MEMORY_SCOPE_AGENT); }
__device__ __forceinline__ unsigned xb_add(unsigned* p, unsigned v) { return __hip_atomic_fetch_add(p, v, __ATOMIC_RELAXED, __HIP_MEMORY_SCOPE_AGENT); }
__device__ __forceinline__ unsigned xb_xcc_id() { return (unsigned)__builtin_amdgcn_s_getreg((3 << 11) | 20) & 0xFu; }
#define XB_SPIN(cond, bar) do { unsigned _sp = 0; while (cond) { __builtin_amdgcn_s_sleep(1); \
    if ((++_sp & 255u) == 0u) { if (xb_ld(&(bar)[XB_TMO])) break; if (_sp > XB_SPIN_CAP) { atomicAdd(&(bar)[XB_TMO], 1u); break; } } } } while (0)

struct XcdBarrier {
    unsigned* bar; unsigned x;
    volatile LAS unsigned* st;
};

__device__ __forceinline__ XcdBarrier xcd_barrier_post(unsigned* bar, volatile LAS unsigned* st, int wave) {
    XcdBarrier b; b.bar = bar; b.x = xb_xcc_id(); b.st = st;
    if (wave == 0 && lane_id() == 0) (void)xb_add(&bar[XB_XCNT(b.x)], 1u);
    return b;
}
__device__ __forceinline__ void xcd_barrier_complete(unsigned* bar, unsigned x, unsigned& nloc, unsigned& nx) {
    const unsigned G = gridDim.x * gridDim.y * gridDim.z;
    unsigned sum, cnt, mine, sp = 0u;
    for (;;) {
        sum = 0u; cnt = 0u; mine = 0u;
#pragma unroll
        for (unsigned j = 0; j < 16; ++j) { const unsigned c = xb_ld(&bar[XB_XCNT(j)]); sum += c; cnt += (c > 0u) ? 1u : 0u; mine = (j == x) ? c : mine; }
        if (sum == G) break;
        __builtin_amdgcn_s_sleep(1);
        if ((++sp & 255u) == 0u) { if (xb_ld(&bar[XB_TMO])) break; if (sp > XB_SPIN_CAP) { atomicAdd(&bar[XB_TMO], 1u); break; } }
    }
    nloc = mine > 0u ? mine : 1u; nx = cnt > 0u ? cnt : 1u;
}

__device__ __forceinline__ void xcd_barrier(const XcdBarrier& b, int wave) {
    asm volatile("s_waitcnt vmcnt(0)" ::: "memory");
    __syncthreads();
    if (wave == 0 && lane_id() == 0) {
        unsigned* bar = b.bar;
        __builtin_amdgcn_s_waitcnt(0);
        unsigned nloc = b.st[0], nx = b.st[1];
        if (nloc == 0u) { xcd_barrier_complete(bar, b.x, nloc, nx); b.st[0] = nloc; b.st[1] = nx; }
        const unsigned old = xb_add(&bar[XB_XSUB(b.x)], 1u);
        const unsigned gen = old / nloc;
        if (old + 1u == (gen + 1u) * nloc) {
            __builtin_amdgcn_fence(__ATOMIC_RELEASE, "agent");
            asm volatile("s_waitcnt vmcnt(0)" ::: "memory");
            const unsigned og = xb_add(&bar[XB_TOP], 1u);
            const unsigned tg = og / nx;
            if (og + 1u == (tg + 1u) * nx) xb_add(&bar[XB_TOPGEN], 1u);
            else XB_SPIN(xb_ld(&bar[XB_TOPGEN]) == tg, bar);
            __builtin_amdgcn_fence(__ATOMIC_ACQUIRE, "agent");
            xb_add(&bar[XB_XGEN(b.x)], 1u);
            asm volatile("s_waitcnt vmcnt(0)" ::: "memory");
        } else {
            XB_SPIN(xb_ld(&bar[XB_XGEN(b.x)]) == gen, bar);
            __builtin_amdgcn_fence(__ATOMIC_ACQUIRE, "agent");
            asm volatile("s_waitcnt vmcnt(0)" ::: "memory");
        }
    }
    __syncthreads();
}

struct RowV { f32x4 v[4]; };
__device__ __forceinline__ void row_load(RowV& r, const float* row, int lane) {
#pragma unroll
    for (int j = 0; j < 4; ++j) r.v[j] = *(const f32x4*)(row + 4 * lane + 256 * j);
}
__device__ __forceinline__ float row_rstd(const RowV& r) {
    float s = 0.f;
#pragma unroll
    for (int j = 0; j < 4; ++j) s += (r.v[j].x * r.v[j].x + r.v[j].y * r.v[j].y) + (r.v[j].z * r.v[j].z + r.v[j].w * r.v[j].w);
    s = wave_sum(s);
    return 1.0f / sqrtf(s * (1.0f / 1024.0f) + EPS);
}
__device__ __forceinline__ void row_modulate(RowV& r, float rstd, const float* g, const float* sh, const float* sc, int lane) {
#pragma unroll
    for (int j = 0; j < 4; ++j) {
        const int o = 4 * lane + 256 * j;
        const f32x4 gg = *(const f32x4*)(g + o), s = *(const f32x4*)(sc + o), h = *(const f32x4*)(sh + o);
        r.v[j] = (r.v[j] * rstd * gg) * (s + 1.0f) + h;
    }
}
struct ModV { f32x4 gp[4], sh[4]; };
__device__ __forceinline__ void mod_load(ModV& m, const float* g, const float* sh, const float* sc, int lane) {
#pragma unroll
    for (int j = 0; j < 4; ++j) { const int o = 4 * lane + 256 * j; m.gp[j] = *(const f32x4*)(g + o) * (*(const f32x4*)(sc + o) + 1.0f); m.sh[j] = *(const f32x4*)(sh + o); }
}
__device__ __forceinline__ void row_apply(RowV& r, float rstd, const ModV& m) {
#pragma unroll
    for (int j = 0; j < 4; ++j) r.v[j] = (r.v[j] * rstd) * m.gp[j] + m.sh[j];
}
__device__ __forceinline__ void row_store_bf16(const RowV& r, bf16_t* out, int lane) {
#pragma unroll
    for (int j = 0; j < 4; ++j) { u32x2 w; w.x = pg8::cvt_pk_bf16(r.v[j].x, r.v[j].y); w.y = pg8::cvt_pk_bf16(r.v[j].z, r.v[j].w); *(u32x2*)(out + 4 * lane + 256 * j) = w; }
}
__device__ __forceinline__ void row_store_f32(const RowV& r, float* out, int lane) {
#pragma unroll
    for (int j = 0; j < 4; ++j) *(f32x4*)(out + 4 * lane + 256 * j) = r.v[j];
}

__device__ __forceinline__ int wmap(int code, int n) {
    if (code == 1) { const int isU = n >> 10, ch = n & 1023; return (ch >> 7) * 256 + isU * 128 + (ch & 127); }
    if (code == 2) { const int typ = (n % 1536) / 512, d = n & 63; return (typ < 2 && d >= 4 && d < 12) ? (d < 8 ? n + 4 : n - 4) : n; }
    if (code == 3) return (n >> 7) * 256 + (n & 127);
    if (code == 4) return (n >> 7) * 256 + 128 + (n & 127);
    return n;
}
__device__ __forceinline__ void conv_item(const float* W, int ldw, int ncol0, bf16_t* WT, int K, int code, LAS float* scr, int kb, int nb, int lane) {
    const int k0 = 64 * kb, n0 = 64 * nb;
    const float* src = W + (size_t)k0 * ldw + ncol0 + n0 + (lane & 15) * 4;
#pragma unroll 4
    for (int i = 0; i < 16; ++i) { const int kk = 4 * i + (lane >> 4); const f32x4 v = *(const f32x4*)(src + (size_t)kk * ldw);
        LAS float* d = scr + kk * 65 + (lane & 15) * 4; d[0] = v.x; d[1] = v.y; d[2] = v.z; d[3] = v.w; }
    LDS_WAIT();
    const int c = lane & 7;
#pragma unroll
    for (int j = 0; j < 8; ++j) { const int n = (lane >> 3) + 8 * j; const LAS float* s = scr + (8 * c) * 65 + n;
        u32x4 o; o.x = pk2(s[0 * 65], s[1 * 65]); o.y = pk2(s[2 * 65], s[3 * 65]); o.z = pk2(s[4 * 65], s[5 * 65]); o.w = pk2(s[6 * 65], s[7 * 65]);
        *(u32x4*)(WT + (size_t)wmap(code, n0 + n) * K + k0 + 8 * c) = o; }
    LDS_WAIT();
}
constexpr int NCONV_ITEMS = 512 + 256 + 256 + 1152 + 128 + 64 * 384;

__device__ __forceinline__ void attn_naive(bf16_t* qkv, float* lse, int bid, int G, int tid) {
    const size_t n = (size_t)T * 24;
    for (size_t i = (size_t)bid * 512 + tid; i < n; i += (size_t)G * 512) {
        const int t = (int)(i / 24), gh = (int)(i % 24), g = gh / 8, h = gh % 8;
        const int dil = g == 0 ? 1 : (g == 1 ? 4 : 16);
        const int pos = t & (SEQ - 1);
        bf16_t* qp = qkv + (size_t)t * QKVW + g * 1536 + h * 64;
        float q[64], o[64];
#pragma unroll
        for (int c8 = 0; c8 < 8; ++c8) { const u32x4 w = *(const u32x4*)(qp + c8 * 8);
#pragma unroll
            for (int k = 0; k < 4; ++k) { q[c8 * 8 + 2 * k] = bflo(w[k]); q[c8 * 8 + 2 * k + 1] = bfhi(w[k]); o[c8 * 8 + 2 * k] = 0.f; o[c8 * 8 + 2 * k + 1] = 0.f; } }
        float m = -INFINITY, l = 0.f;
        for (int j = 0; j <= 128; ++j) {
            const int kp = pos - j * dil; if (kp < 0) break;
            const bf16_t* kr = qkv + (size_t)(t - j * dil) * QKVW + g * 1536 + 512 + h * 64;
            const bf16_t* vr = kr + 512;
            float s = 0.f;
#pragma unroll
            for (int c8 = 0; c8 < 8; ++c8) { const u32x4 w = *(const u32x4*)(kr + c8 * 8);
#pragma unroll
                for (int k = 0; k < 4; ++k) s += q[c8 * 8 + 2 * k] * bflo(w[k]) + q[c8 * 8 + 2 * k + 1] * bfhi(w[k]); }
            const float mn = fmaxf(m, s), a = exp2f(m - mn), pv = exp2f(s - mn);
            l = l * a + pv;
#pragma unroll
            for (int c8 = 0; c8 < 8; ++c8) { const u32x4 w = *(const u32x4*)(vr + c8 * 8);
#pragma unroll
                for (int k = 0; k < 4; ++k) { o[c8 * 8 + 2 * k] = o[c8 * 8 + 2 * k] * a + pv * bflo(w[k]); o[c8 * 8 + 2 * k + 1] = o[c8 * 8 + 2 * k + 1] * a + pv * bfhi(w[k]); } }
            m = mn;
        }
        const float inv = 1.0f / l;
#pragma unroll
        for (int c8 = 0; c8 < 8; ++c8) { u32x4 w;
#pragma unroll
            for (int k = 0; k < 4; ++k) w[k] = pk2(o[c8 * 8 + 2 * k] * inv, o[c8 * 8 + 2 * k + 1] * inv);
            *(u32x4*)(qp + c8 * 8) = w; }
        lse[(size_t)t * 24 + gh] = m + log2f(l);
    }
}
__device__ __forceinline__ void attn_comb(const bf16_t* qkv, const float* lse, bf16_t* o, int bid, int G, int tid) {
    const size_t n = (size_t)T * 64;
    for (size_t i = (size_t)bid * 512 + tid; i < n; i += (size_t)G * 512) {
        const int t = (int)(i >> 6), r = (int)(i & 63), h = r >> 3, c = r & 7;
        const float l0 = lse[(size_t)t * 24 + h], l1 = lse[(size_t)t * 24 + 8 + h], l2 = lse[(size_t)t * 24 + 16 + h];
        const float mx = fmaxf(l0, fmaxf(l1, l2));
        float w0 = exp2f(l0 - mx), w1 = exp2f(l1 - mx), w2 = exp2f(l2 - mx);
        const float inv = 1.0f / (w0 + w1 + w2); w0 *= inv; w1 *= inv; w2 *= inv;
        const bf16_t* base = qkv + (size_t)t * QKVW + h * 64 + c * 8;
        const u32x4 a = *(const u32x4*)(base), b = *(const u32x4*)(base + 1536), cc = *(const u32x4*)(base + 3072);
        u32x4 out;
#pragma unroll
        for (int k = 0; k < 4; ++k) {
            const float lo = w0 * bflo(a[k]) + w1 * bflo(b[k]) + w2 * bflo(cc[k]);
            const float hi = w0 * bfhi(a[k]) + w1 * bfhi(b[k]) + w2 * bfhi(cc[k]);
            out[k] = pk2(lo, hi);
        }
        *(u32x4*)(o + (size_t)t * 512 + h * 64 + c * 8) = out;
    }
}

namespace att {
typedef short bf16x8 __attribute__((ext_vector_type(8)));
typedef short s16x4 __attribute__((ext_vector_type(4)));
typedef float f32x16 __attribute__((ext_vector_type(16)));
constexpr int KOFF = 0, VOFF = 65536, NUNITS = 16 * 3 * 32 * 4;
__device__ __forceinline__ int crow(int r, int hi) { return (r & 3) + 8 * (r >> 2) + 4 * hi; }
__device__ __forceinline__ s16x4 vtr(const LAS unsigned char* p) { return __builtin_bit_cast(s16x4, __builtin_amdgcn_ds_read_tr16_b64_v4i16((LAS s16x4*)p)); }
__device__ __forceinline__ float xhalf_max(float m) { auto rr = __builtin_amdgcn_permlane32_swap(__float_as_uint(m), __float_as_uint(m), false, false); return fmaxf(__uint_as_float(rr[0]), __uint_as_float(rr[1])); }
__device__ __forceinline__ float xhalf_sum(float m) { auto rr = __builtin_amdgcn_permlane32_swap(__float_as_uint(m), __float_as_uint(m), false, false); return __uint_as_float(rr[0]) + __uint_as_float(rr[1]); }

__device__ __forceinline__ void attn_phase(LAS unsigned char* lds, bf16_t* qkv, float* lse, int bid, int G, int wave, bool dry = false) {
    const int per = (NUNITS + G - 1) / G;
    const int u_lo = bid * per, u_hi = (u_lo + per < NUNITS) ? u_lo + per : NUNITS;
    for (int idx = u_lo; idx < u_hi; ++idx) {
        const int lane = lane_id(), r32 = lane & 31, hi = lane >> 5;
        const int hp = idx & 3, rest = idx >> 2, sb = rest & 31, bg = rest >> 5, b = bg / 3, g = bg - 3 * b;
        const int dsh = 2 * g, dil = 1 << dsh;
        const int bps = 32 >> dsh;
        const int r = sb / bps, l0 = (sb - r * bps) * 128;
        const size_t tb = (size_t)b * SEQ + r;
        const bf16_t* gq = qkv + g * 1536;
#pragma unroll
        for (int i = 0; i < 8; ++i) {
            const int id = wave * 8 + i, hd = id >> 5, ch = (id >> 2) & 7, kq = id & 3;
            int sp = l0 - 128 + kq * 64 + lane; sp = sp < 0 ? 0 : sp;
            const bf16_t* src = gq + (tb + (size_t)sp * dil) * QKVW + 512 + (hp * 2 + hd) * 64 + ch * 8;
            __builtin_amdgcn_global_load_lds((const unsigned*)src, (LAS unsigned*)(lds + KOFF + hd * 32768 + ch * 4096 + kq * 1024), 16, 0, 0);
        }
#pragma unroll
        for (int i = 0; i < 8; ++i) {
            const int id = wave * 8 + i, hd = id >> 5, dh = (id >> 4) & 1, kg = id & 15;
            int sp = l0 - 128 + kg * 16 + (lane >> 2); sp = sp < 0 ? 0 : sp;
            const bf16_t* src = gq + (tb + (size_t)sp * dil) * QKVW + 1024 + (hp * 2 + hd) * 64 + dh * 32 + (lane & 3) * 8;
            __builtin_amdgcn_global_load_lds((const unsigned*)src, (LAS unsigned*)(lds + VOFF + hd * 32768 + dh * 16384 + kg * 1024), 16, 0, 0);
        }
        const int hd = wave >> 2, qt = wave & 3, head = hp * 2 + hd;
        const size_t tq = tb + (size_t)(l0 + 32 * qt + r32) * dil;
        bf16_t* qrow = qkv + tq * QKVW + g * 1536 + head * 64;
        bf16x8 qf[4];
#pragma unroll
        for (int d0 = 0; d0 < 4; ++d0) qf[d0] = *(const bf16x8*)(qrow + d0 * 16 + hi * 8);
        asm volatile("s_waitcnt vmcnt(0)" ::: "memory");
        __syncthreads();
        f32x16 p[5];
        const LAS unsigned char* kb = lds + KOFF + hd * 32768 + hi * 4096 + (qt * 32 + r32) * 16;
#pragma unroll
        for (int j = 0; j < 5; ++j) {
#pragma unroll
            for (int rr = 0; rr < 16; ++rr) p[j][rr] = 0.f;
#pragma unroll
            for (int d0 = 0; d0 < 4; ++d0) {
                const bf16x8 kf = *(const LAS bf16x8*)(kb + j * 512 + d0 * 8192);
                p[j] = __builtin_amdgcn_mfma_f32_32x32x16_bf16(kf, qf[d0], p[j], 0, 0, 0);
            }
        }
#pragma unroll
        for (int rr = 0; rr < 16; ++rr) { const int c = crow(rr, hi); if (c < r32) p[0][rr] = -INFINITY; if (c > r32) p[4][rr] = -INFINITY; }
        if (l0 == 0) {
#pragma unroll
            for (int j = 0; j < 5; ++j)
#pragma unroll
                for (int rr = 0; rr < 16; ++rr) if (32 * (qt + j) + crow(rr, hi) < 128) p[j][rr] = -INFINITY;
        }
        float m = p[0][0];
#pragma unroll
        for (int j = 0; j < 5; ++j)
#pragma unroll
            for (int rr = 0; rr < 16; ++rr) m = fmaxf(m, p[j][rr]);
        m = xhalf_max(m);
        float l = 0.f;
#pragma unroll
        for (int j = 0; j < 5; ++j)
#pragma unroll
            for (int rr = 0; rr < 16; ++rr) { const float e = __builtin_amdgcn_exp2f(p[j][rr] - m); p[j][rr] = e; l += e; }
        l = xhalf_sum(l);
        f32x16 o[2];
#pragma unroll
        for (int rr = 0; rr < 16; ++rr) { o[0][rr] = 0.f; o[1][rr] = 0.f; }
        const LAS unsigned char* vb = lds + VOFF + hd * 32768 + ((lane >> 4) & 1) * 32 + (lane & 3) * 8 + (4 * hi + ((lane & 15) >> 2)) * 64 + qt * 2048;
#pragma unroll
        for (int j = 0; j < 5; ++j)
#pragma unroll
            for (int s = 0; s < 2; ++s) {
                u32x4 pw; pw.x = pg8::cvt_pk_bf16(p[j][8 * s + 0], p[j][8 * s + 1]); pw.y = pg8::cvt_pk_bf16(p[j][8 * s + 2], p[j][8 * s + 3]);
                pw.z = pg8::cvt_pk_bf16(p[j][8 * s + 4], p[j][8 * s + 5]); pw.w = pg8::cvt_pk_bf16(p[j][8 * s + 6], p[j][8 * s + 7]);
                const bf16x8 pf = __builtin_bit_cast(bf16x8, pw);
#pragma unroll
                for (int d0 = 0; d0 < 2; ++d0) {
                    const s16x4 vlo = vtr(vb + d0 * 16384 + (2 * j + s) * 1024), vhi = vtr(vb + d0 * 16384 + (2 * j + s) * 1024 + 512);
                    const bf16x8 vf = {vlo[0], vlo[1], vlo[2], vlo[3], vhi[0], vhi[1], vhi[2], vhi[3]};
                    o[d0] = __builtin_amdgcn_mfma_f32_32x32x16_bf16(vf, pf, o[d0], 0, 0, 0);
                }
            }
        const float inv = 1.0f / l;
#pragma unroll
        for (int d0 = 0; d0 < 2; ++d0)
#pragma unroll
            for (int rg = 0; rg < 4; ++rg) {
                u32x2 w; w.x = pg8::cvt_pk_bf16(o[d0][4 * rg] * inv, o[d0][4 * rg + 1] * inv); w.y = pg8::cvt_pk_bf16(o[d0][4 * rg + 2] * inv, o[d0][4 * rg + 3] * inv);
                if (!dry) *(u32x2*)(qrow + d0 * 32 + 8 * rg + 4 * hi) = w; else asm volatile("" :: "v"(w.x), "v"(w.y));
            }
        if (hi == 0 && !dry) lse[tq * 24 + g * 8 + head] = m + __builtin_amdgcn_logf(l);
        __syncthreads();
    }
}
}

typedef const __attribute__((address_space(4))) unsigned long long* kargp_t;
__device__ __forceinline__ kargp_t karg() { kargp_t p = (kargp_t)__builtin_amdgcn_kernarg_segment_ptr(); asm volatile("" : "+s"(p)); return p; }
#define KIN(i) ((const float*)karg()[i])
#define KOUT() ((float*)karg()[19])
#define KWS() ((unsigned char*)karg()[20])
#define WSP(type, off) ((type*)(KWS() + (off)))
struct Args { const float* in[19]; float* out; unsigned char* ws; int ph_lo, ph_hi; };
constexpr int NPHASE = 17;

__global__ void __launch_bounds__(NWAVES * 64, 2) mk_fwd(Args args) {
    extern __shared__ __attribute__((aligned(16))) unsigned char lds_raw[];
    LAS unsigned char* lds = (LAS unsigned char*)lds_raw;
    volatile LAS unsigned* MISC = (volatile LAS unsigned*)(lds + MISC_OFF);
    LAS int* rb = (LAS int*)(lds + MISC_OFF);
    const int wave = __builtin_amdgcn_readfirstlane((int)threadIdx.x >> 6);
#define IDS() const int lane = lane_id(), tid = wave * 64 + lane; (void)tid; (void)lane
    const int G = gridDim.x, bid = blockIdx.x;
    for (int u = threadIdx.x; u < (LDS_BYTES - MISC_OFF) / 4; u += NWAVES * 64) MISC[u] = 0u;
    __syncthreads();
#if MK_ONE_LAUNCH
    XcdBarrier bar = xcd_barrier_post((unsigned*)(KWS() + WS_CTL) + CW_BAR, MISC + 40, wave);
#define GRID_BAR() xcd_barrier(bar, wave)
#else
#define GRID_BAR() do { } while (0)
#endif
    const int lo = args.ph_lo, hi = args.ph_hi;
#ifndef PHMASK
#define PHMASK 0xFFFFFFFFu
#endif
#define IN(k) ((((PHMASK) >> (k)) & 1u) && lo <= (k) && (k) < hi)
#ifndef REPMASK
#define REPMASK 0u
#endif
#define REPS(k) ((((REPMASK) >> (k)) & 1u) ? 2 : 1)
#define SEAM(k) do { if (IN(k) && IN((k) + 1)) GRID_BAR(); } while (0)

    for (int rep_ = 0; rep_ < REPS(0); ++rep_) if (IN(0)) { IDS();
        const float* cin = KIN(1); const float* ada_w = KIN(4); const float* ada_b = KIN(5); float* mod = WSP(float, WS_MOD); float* rope = WSP(float, WS_ROPE);
        LAS float* cact = (LAS float*)lds; LAS float* red = cact + 16384;
        if (bid < 192) for (int i = tid; i < 16 * 1024; i += 512) { const float v = cin[i]; cact[i] = v / (1.f + expf(-v)); }
        __syncthreads();
        for (int item = bid; item < 192; item += G) {
            const int l = item / 96, n0 = (item % 96) * 64, kg = tid >> 6, n = tid & 63;
            float acc[16];
#pragma unroll
            for (int b = 0; b < 16; ++b) acc[b] = 0.f;
            const float* w = ada_w + (size_t)l * 1024 * 6144 + n0 + n;
            for (int k = kg * 128; k < kg * 128 + 128; ++k) {
                const float wv = w[(size_t)k * 6144];
#pragma unroll
                for (int b = 0; b < 16; ++b) acc[b] += cact[b * 1024 + k] * wv;
            }
#pragma unroll
            for (int b = 0; b < 16; ++b) red[(kg * 16 + b) * 64 + n] = acc[b];
            __syncthreads();
            for (int i = tid; i < 1024; i += 512) {
                const int b = i >> 6, nn = i & 63; float s = 0.f;
#pragma unroll
                for (int q = 0; q < 8; ++q) s += red[(q * 16 + b) * 64 + nn];
                mod[((size_t)l * 16 + b) * 6144 + n0 + nn] = s + ada_b[l * 6144 + n0 + nn];
            }
            __syncthreads();
        }
        for (int i = bid * 512 + tid; i < 4096 * 8; i += G * 512) {
            const int t = i >> 3, f = i & 7;
            const float inv = powf(500000.0f, -(float)(2 * f) / 16.0f);
            const float ang = (float)t * inv;
            rope[i] = (float)cos((double)ang);
            rope[4096 * 8 + i] = (float)sin((double)ang);
        }
        __syncthreads();
        LAS float* scr = (LAS float*)(lds + wave * 16640);
        const float* conv_in_w = KIN(6); const float* conv_out_w = KIN(8); const float* attn_in_w = KIN(9); const float* attn_out_w = KIN(10);
        const float* gate_w = KIN(15); const float* up_w = KIN(16); const float* down_w = KIN(17);
        bf16_t* WZ = WSP(bf16_t, WS_WZ); bf16_t* WB = WSP(bf16_t, WS_WB); bf16_t* WCO = WSP(bf16_t, WS_WCO); bf16_t* WAI = WSP(bf16_t, WS_WAI); bf16_t* WAO = WSP(bf16_t, WS_WAO);
        bf16_t* WGU = WSP(bf16_t, WS_WGU); bf16_t* WDN = WSP(bf16_t, WS_WDN);
        for (int it0 = bid * NWAVES + wave; it0 < NCONV_ITEMS; it0 += G * NWAVES) {
            int it = it0;
            if (it < 512) { conv_item(conv_in_w, 3072, 1024, WZ, 1024, 1, scr, it / 32, it % 32, lane); continue; } it -= 512;
            if (it < 256) { conv_item(conv_in_w, 3072, 0, WB, 1024, 0, scr, it / 16, it % 16, lane); continue; } it -= 256;
            if (it < 256) { conv_item(conv_out_w, 1024, 0, WCO, 1024, 0, scr, it / 16, it % 16, lane); continue; } it -= 256;
            if (it < 1152) { conv_item(attn_in_w, QKVW, 0, WAI, 1024, 2, scr, it / 72, it % 72, lane); continue; } it -= 1152;
            if (it < 128) { conv_item(attn_out_w, 1024, 0, WAO, 512, 0, scr, it / 16, it % 16, lane); continue; } it -= 128;
            const int le = it / 384, r = it % 384;
            if (r < 128) conv_item(gate_w + (size_t)le * D * DEXP, DEXP, 0, WGU + (size_t)le * 1024 * 1024, 1024, 3, scr, r / 8, r % 8, lane);
            else if (r < 256) conv_item(up_w + (size_t)le * D * DEXP, DEXP, 0, WGU + (size_t)le * 1024 * 1024, 1024, 4, scr, (r - 128) / 8, (r - 128) % 8, lane);
            else conv_item(down_w + (size_t)le * DEXP * D, D, 0, WDN + (size_t)le * 1024 * 512, 512, 0, scr, (r - 256) / 16, (r - 256) % 16, lane);
        }
    }
    SEAM(0);
    for (int rep_ = 0; rep_ < REPS(1); ++rep_) if (IN(1)) { IDS();
        const float* x = KIN(0); const float* norm_mix_g = KIN(2); const float* mod = WSP(float, WS_MOD); bf16_t* xn = WSP(bf16_t, WS_XN);
        for (int w0 = (bid * 8 + wave) * 32; w0 < T; w0 += G * 8 * 32) {
            const float* mb = mod + (size_t)(w0 >> 12) * 6144;
            ModV mv; mod_load(mv, norm_mix_g, mb + 0, mb + 1024, lane);
            RowV r; row_load(r, x + (size_t)w0 * D, lane);
#pragma unroll 1
            for (int i = 0; i < 32; ++i) {
                const int row = w0 + i;
                RowV nx; if (i < 31) row_load(nx, x + (size_t)(row + 1) * D, lane); else nx = r;
                const float rstd = row_rstd(r);
                row_apply(r, rstd, mv);
                row_store_bf16(r, xn + (size_t)row * D, lane);
                r = nx;
            }
        }
    }
    SEAM(1);
    for (int rep_ = 0; rep_ < REPS(2); ++rep_) if (IN(2)) { bf16_t* xn = WSP(bf16_t, WS_XN); bf16_t* WZ = WSP(bf16_t, WS_WZ); bf16_t* zb = WSP(bf16_t, WS_Z);
        pg8::Gemm g{xn, WZ, T, 2048, 1024}; pg8::StaticOrder S; S.init(T, 2048, G, bid); pg8::EpiPair<false> E{zb, D};
        pg8::gemm_phase<pg8::EpiPair<false>, pg8::StaticOrder, pg8::APlain, true, true>(lds, g, S, E, pg8::APlain{}, wave); }
    SEAM(2);
    for (int rep_ = 0; rep_ < REPS(3); ++rep_) if (IN(3)) { bf16_t* xn = WSP(bf16_t, WS_XN); bf16_t* WB = WSP(bf16_t, WS_WB); bf16_t* zb = WSP(bf16_t, WS_Z); bf16_t* ypre = WSP(bf16_t, WS_YPRE); const float* conv_w = KIN(7);
        pg8::Gemm g{xn, WB, T, 1024, 1024}; pg8::StaticOrder S; S.init(T, 1024, G, bid); pg8::EpiYpre E{ypre, zb, conv_w};
        pg8::gemm_phase<pg8::EpiYpre, pg8::StaticOrder, pg8::APlain, true, true>(lds, g, S, E, pg8::APlain{}, wave); }
    SEAM(3);
    for (int rep_ = 0; rep_ < REPS(4); ++rep_) if (IN(4)) { bf16_t* ypre = WSP(bf16_t, WS_YPRE); bf16_t* WCO = WSP(bf16_t, WS_WCO); float* xres = KOUT(); const float* x = KIN(0); const float* mod = WSP(float, WS_MOD);
        pg8::Gemm g{ypre, WCO, T, 1024, 1024}; pg8::StaticOrder S; S.init(T, 1024, G, bid); pg8::EpiRes E{xres, x, mod + 2048};
        pg8::gemm_phase<pg8::EpiRes, pg8::StaticOrder, pg8::APlain, true, true>(lds, g, S, E, pg8::APlain{}, wave); }
    SEAM(4);
#pragma unroll 1
    for (int l = 0; l < 2; ++l) {
        const int pb0 = (l == 0) ? 5 : 13;
#define MODL() (WSP(float, WS_MOD) + (size_t)l * 16 * 6144)
#define CNTL() (WSP(int, WS_CTL) + 64 * l)
        if (l == 1) {
            for (int rep_ = 0; rep_ < REPS(9); ++rep_) if (IN(9)) { bf16_t* xn = WSP(bf16_t, WS_XN); bf16_t* WAI = WSP(bf16_t, WS_WAI); bf16_t* qkv = WSP(bf16_t, WS_QKV); const float* rope = WSP(float, WS_ROPE);
                pg8::Gemm g{xn, WAI, T, QKVW, 1024}; pg8::StaticOrder S; S.init(T, QKVW, G, bid); pg8::EpiQKV E{qkv, rope};
                pg8::gemm_phase<pg8::EpiQKV, pg8::StaticOrder, pg8::APlain, true, true>(lds, g, S, E, pg8::APlain{}, wave); }
            SEAM(9);
            for (int rep_ = 0; rep_ < REPS(10); ++rep_) if (IN(10)) att::attn_phase(lds, WSP(bf16_t, WS_QKV), WSP(float, WS_LSE), bid, G, wave, rep_ + 1 < REPS(10));
            SEAM(10);
            for (int rep_ = 0; rep_ < REPS(11); ++rep_) if (IN(11)) { IDS(); attn_comb(WSP(bf16_t, WS_QKV), WSP(float, WS_LSE), WSP(bf16_t, WS_XN), bid, G, tid); }
            SEAM(11);
            if (IN(12)) { bf16_t* ob = WSP(bf16_t, WS_XN); bf16_t* WAO = WSP(bf16_t, WS_WAO); float* xres = KOUT();
                pg8::Gemm g{ob, WAO, T, 1024, 512}; pg8::StaticOrder S; S.init(T, 1024, G, bid); pg8::EpiRes E{xres, xres, MODL() + 2048};
                pg8::gemm_phase<pg8::EpiRes, pg8::StaticOrder, pg8::APlain, true, true>(lds, g, S, E, pg8::APlain{}, wave); }
            SEAM(12);
        }
        for (int rep_ = 0; rep_ < REPS(5); ++rep_) if (IN(pb0)) { IDS(); const bool dry = rep_ + 1 < REPS(5);
            LAS f32x4* TG = (LAS f32x4*)lds; LAS f32x4* TE = (LAS f32x4*)(lds + 16384);
            LAS int* rec_e = (LAS int*)(lds + 147456); LAS float* rec_w = (LAS float*)(lds + 147456 + 2048); LAS int* rec_rank = (LAS int*)(lds + 147456 + 4096);
            LAS int* hist = (LAS int*)(lds + 147456 + 6144); LAS int* base = (LAS int*)(lds + 147456 + 6144 + 128);
            const float* gff = KIN(3) + l * D; const float* wg = KIN(11) + (size_t)l * D * 4; const float* bg = KIN(12) + l * 4; const float* we = KIN(13) + (size_t)l * 4 * D * 8; const float* be = KIN(14) + l * 32;
            const float* xres = KOUT(); const float* modl = MODL(); int* cntl = CNTL(); bf16_t* xn = WSP(bf16_t, WS_XN); int* ltok = WSP(int, WS_LTOK); float* lw = WSP(float, WS_LW); int* tslot = WSP(int, WS_TSLOT);
            for (int i = tid; i < 1024; i += 512) { const int ln = i & 63, jc = i >> 6, k = 4 * ln + 256 * (jc >> 2) + (jc & 3); TG[i] = *(const f32x4*)(wg + (size_t)k * 4); }
            for (int i = tid; i < 8192; i += 512) { const int ln = i & 63, jc = (i >> 6) & 15, half = (i >> 10) & 1, gi = i >> 11, k = 4 * ln + 256 * (jc >> 2) + (jc & 3);
                TE[i] = *(const f32x4*)(we + ((size_t)gi * 1024 + k) * 8 + half * 4); }
            __syncthreads();
            const bool h5 = (lane & 32) != 0, h4 = (lane & 16) != 0, h3 = (lane & 8) != 0;
            for (int blk = bid; blk < T / 256; blk += G) {
                if (tid < 32) hist[tid] = 0;
                __syncthreads();
                ModV mv; { const float* mb = modl + (size_t)((blk * 256) >> 12) * 6144; mod_load(mv, gff, mb + 3072, mb + 4096, lane); }
                RowV r; row_load(r, xres + (size_t)(blk * 256 + wave * 32) * D, lane);
#pragma unroll 1
                for (int i = 0; i < 32; ++i) {
                    const int rl = wave * 32 + i, row = blk * 256 + rl;
                    RowV nx; if (i < 31) row_load(nx, xres + (size_t)(row + 1) * D, lane); else nx = r;
                    const float rstd = row_rstd(r);
                    row_apply(r, rstd, mv);
                    row_store_bf16(r, xn + (size_t)row * D, lane);
                    f32x4 pg = {0.f, 0.f, 0.f, 0.f};
#pragma unroll
                    for (int jc = 0; jc < 16; ++jc) pg += TG[jc * 64 + lane] * r.v[jc >> 2][jc & 3];
                    float gl[4];
                    { float b0 = (h5 ? pg.z : pg.x) + __shfl_xor(h5 ? pg.x : pg.z, 32), b1 = (h5 ? pg.w : pg.y) + __shfl_xor(h5 ? pg.y : pg.w, 32);
                      float c = (h4 ? b1 : b0) + __shfl_xor(h4 ? b0 : b1, 16);
                      c += __shfl_xor(c, 8); c += __shfl_xor(c, 4); c += __shfl_xor(c, 2); c += __shfl_xor(c, 1);
#pragma unroll
                      for (int o = 0; o < 4; ++o) gl[o] = __int_as_float(__builtin_amdgcn_readlane(__float_as_int(c), 16 * o)) + bg[o]; }
                    int gi = 0; float gm = gl[0];
#pragma unroll
                    for (int o = 1; o < 4; ++o) if (gl[o] > gm) { gm = gl[o]; gi = o; }
                    float gden = 0.f;
#pragma unroll
                    for (int o = 0; o < 4; ++o) gden += expf(gl[o] - gm);
                    const float grp_p = 1.0f / gden;
                    f32x4 pa = {0.f, 0.f, 0.f, 0.f}, pb = {0.f, 0.f, 0.f, 0.f};
                    const LAS f32x4* te = TE + gi * 2048 + lane;
#pragma unroll
                    for (int jc = 0; jc < 16; ++jc) { const float hv = r.v[jc >> 2][jc & 3]; pa += te[jc * 64] * hv; pb += te[1024 + jc * 64] * hv; }
                    float el[8];
                    { const f32x4 keep = h5 ? pb : pa, send = h5 ? pa : pb;
                      f32x4 q; q.x = keep.x + __shfl_xor(send.x, 32); q.y = keep.y + __shfl_xor(send.y, 32); q.z = keep.z + __shfl_xor(send.z, 32); q.w = keep.w + __shfl_xor(send.w, 32);
                      const float b0 = (h4 ? q.z : q.x) + __shfl_xor(h4 ? q.x : q.z, 16), b1 = (h4 ? q.w : q.y) + __shfl_xor(h4 ? q.y : q.w, 16);
                      float c = (h3 ? b1 : b0) + __shfl_xor(h3 ? b0 : b1, 8);
                      c += __shfl_xor(c, 4); c += __shfl_xor(c, 2); c += __shfl_xor(c, 1);
#pragma unroll
                      for (int o = 0; o < 8; ++o) el[o] = __int_as_float(__builtin_amdgcn_readlane(__float_as_int(c), 8 * o)) + be[gi * 8 + o]; }
                    int i0 = 0; float m0 = el[0];
#pragma unroll
                    for (int o = 1; o < 8; ++o) if (el[o] > m0) { m0 = el[o]; i0 = o; }
                    int i1 = -1; float m1 = -INFINITY;
#pragma unroll
                    for (int o = 0; o < 8; ++o) if (o != i0 && el[o] > m1) { m1 = el[o]; i1 = o; }
                    const float p1 = expf(m1 - m0);
                    if (lane == 0) { rec_e[rl * 2] = gi * 8 + i0; rec_e[rl * 2 + 1] = gi * 8 + i1; rec_w[rl * 2] = grp_p / (1.0f + p1); rec_w[rl * 2 + 1] = grp_p * p1 / (1.0f + p1); }
                    r = nx;
                }
                __syncthreads();
                { const int e = rec_e[tid]; rec_rank[tid] = atomicAdd((int*)&hist[e], 1); }
                __syncthreads();
                if (tid < 32) { const int h = hist[tid]; base[tid] = (h && !dry) ? atomicAdd(&cntl[tid], h) : 0; }
                __syncthreads();
                { const int e = rec_e[tid], pos = base[e] + rec_rank[tid], tok = blk * 256 + (tid >> 1);
                  if (!dry) { ltok[(size_t)e * LISTCAP + pos] = tok; lw[(size_t)e * LISTCAP + pos] = rec_w[tid]; tslot[tok * 2 + (tid & 1)] = (e << 16) | pos; } }
                __syncthreads();
            }
        }
        SEAM(pb0);
        if (IN(pb0 + 1) || IN(pb0 + 2) || IN(pb0 + 3)) {
            __syncthreads();
            if (wave == 0 && lane_id() == 0) { const int* cntl = CNTL(); int s = 0; for (int e = 0; e < 32; ++e) { rb[e] = s; s += (__hip_atomic_load(&cntl[e], RLX_AGENT) + 255) & ~255; } rb[32] = s; }
            __syncthreads();
        }
        for (int rep_ = 0; rep_ < REPS(6); ++rep_) if (IN(pb0 + 1)) { bf16_t* xn = WSP(bf16_t, WS_XN); bf16_t* WGU = WSP(bf16_t, WS_WGU); bf16_t* act = WSP(bf16_t, WS_ACT); const int* ltok = WSP(int, WS_LTOK); const int* cntl = CNTL();
            pg8::Gemm g{xn, WGU + (size_t)l * 32 * 1024 * 1024, 0, 0, 1024}; pg8::MoeOrder S; S.init(rb[32] / 256, G, bid, rb); pg8::EpiPair<true> E{act, DEXP}; pg8::AGather am{ltok, cntl, rb};
            pg8::gemm_phase<pg8::EpiPair<true>, pg8::MoeOrder, pg8::AGather, true, true>(lds, g, S, E, am, wave); }
        SEAM(pb0 + 1);
        for (int rep_ = 0; rep_ < REPS(7); ++rep_) if (IN(pb0 + 2)) { bf16_t* act = WSP(bf16_t, WS_ACT); bf16_t* WDN = WSP(bf16_t, WS_WDN); bf16_t* yw = WSP(bf16_t, WS_YW); const float* lw = WSP(float, WS_LW);
            pg8::Gemm g{act, WDN + (size_t)l * 32 * 1024 * 512, 0, 0, 512}; pg8::MoeOrder S; S.init(rb[32] / 256, G, bid, rb); pg8::EpiDown E{yw, lw, rb};
            pg8::gemm_phase<pg8::EpiDown, pg8::MoeOrder, pg8::APlain, true, true>(lds, g, S, E, pg8::APlain{}, wave); }
        SEAM(pb0 + 2);
        for (int rep_ = 0; rep_ < REPS(8); ++rep_) if (IN(pb0 + 3)) { IDS(); const bool dry = rep_ + 1 < REPS(8);
            const float* gnext = (l == 0) ? KIN(2) + D : KIN(18);
            const float* modn = WSP(float, WS_MOD) + (size_t)16 * 6144; const float* modl = MODL();
            float* xres = KOUT(); const bf16_t* yw = WSP(bf16_t, WS_YW); const int* tslot = WSP(int, WS_TSLOT); bf16_t* xn = WSP(bf16_t, WS_XN);
            for (int w0 = (bid * 8 + wave) * 32; w0 < T; w0 += G * 8 * 32) {
                const int b = w0 >> 12;
                f32x4 g2v[4];
#pragma unroll
                for (int j = 0; j < 4; ++j) g2v[j] = *(const f32x4*)(modl + (size_t)b * 6144 + 5120 + 4 * lane + 256 * j);
                ModV mv;
                if (l == 0) { const float* mb = modn + (size_t)b * 6144; mod_load(mv, gnext, mb + 0, mb + 1024, lane); }
                else {
#pragma unroll
                    for (int j = 0; j < 4; ++j) { mv.gp[j] = *(const f32x4*)(gnext + 4 * lane + 256 * j); mv.sh[j] = (f32x4){0.f, 0.f, 0.f, 0.f}; }
                }
                RowV r; u32x2 ya[4], yb[4];
#define R2_LOAD(R_, YA_, YB_, ROW_) do { const int s0_ = tslot[(ROW_) * 2], s1_ = tslot[(ROW_) * 2 + 1]; \
                    const size_t r0_ = (size_t)(rb[s0_ >> 16] + (s0_ & 0xffff)), r1_ = (size_t)(rb[s1_ >> 16] + (s1_ & 0xffff)); \
                    row_load(R_, xres + (size_t)(ROW_) * D, lane); \
                    _Pragma("unroll") for (int j = 0; j < 4; ++j) { YA_[j] = *(const u32x2*)(yw + r0_ * D + 4 * lane + 256 * j); YB_[j] = *(const u32x2*)(yw + r1_ * D + 4 * lane + 256 * j); } } while (0)
                R2_LOAD(r, ya, yb, w0);
#pragma unroll 1
                for (int i = 0; i < 32; ++i) {
                    const int row = w0 + i;
                    RowV nx; u32x2 na[4], nb[4];
                    if (i < 31) { R2_LOAD(nx, na, nb, row + 1); } else { nx = r;
#pragma unroll
                        for (int j = 0; j < 4; ++j) { na[j] = ya[j]; nb[j] = yb[j]; } }
#pragma unroll
                    for (int j = 0; j < 4; ++j) {
                        f32x4 y; y.x = bflo(ya[j].x) + bflo(yb[j].x); y.y = bfhi(ya[j].x) + bfhi(yb[j].x); y.z = bflo(ya[j].y) + bflo(yb[j].y); y.w = bfhi(ya[j].y) + bfhi(yb[j].y);
                        r.v[j] = r.v[j] + g2v[j] * y;
                    }
                    const float rstd = row_rstd(r);
                    if (dry) { asm volatile("" :: "v"(rstd), "v"(r.v[0].x), "v"(r.v[1].y), "v"(r.v[2].z), "v"(r.v[3].w)); }
                    else if (l == 1) { row_apply(r, rstd, mv); row_store_f32(r, xres + (size_t)row * D, lane); }
                    else { row_store_f32(r, xres + (size_t)row * D, lane); row_apply(r, rstd, mv); row_store_bf16(r, xn + (size_t)row * D, lane); }
                    r = nx;
#pragma unroll
                    for (int j = 0; j < 4; ++j) { ya[j] = na[j]; yb[j] = nb[j]; }
                }
#undef R2_LOAD
            }
        }
        SEAM(pb0 + 3);
    }
#undef IDS
#undef MODL
#undef CNTL
#undef IN
#undef SEAM
#undef GRID_BAR
}

extern "C" void kernel_launch(void* const* d_in, const int* in_sizes, int n_in, void* d_out, int out_size, void* d_ws, size_t ws_size, hipStream_t stream) {
    static int grid = 0;
    if (grid == 0) {
        if (n_in != 19 || out_size != T * D || ws_size < WS_END) { fprintf(stderr, "kernel_launch: unexpected shapes (n_in %d out %d ws %zu)\n", n_in, out_size, ws_size); grid = -1; return; }
        int dev = 0, cus = 0;
        if (hipGetDevice(&dev) != hipSuccess || hipDeviceGetAttribute(&cus, hipDeviceAttributeMultiprocessorCount, dev) != hipSuccess) { grid = -1; return; }
        if (hipFuncSetAttribute((const void*)mk_fwd, hipFuncAttributeMaxDynamicSharedMemorySize, LDS_BYTES) != hipSuccess) { fprintf(stderr, "kernel_launch: hipFuncSetAttribute failed\n"); grid = -1; return; }
        int per_cu = 0;
        if (hipOccupancyMaxActiveBlocksPerMultiprocessor(&per_cu, (const void*)mk_fwd, NWAVES * 64, LDS_BYTES) != hipSuccess || per_cu < 1) fprintf(stderr, "kernel_launch: occupancy query says %d\n", per_cu);
        (void)hipGetLastError();
        grid = cus;
    }
    if (grid < 0) return;
    (void)hipMemsetAsync((char*)d_ws + WS_CTL, 0, CTL_BYTES, stream);
    Args a{};
    for (int i = 0; i < 19; ++i) a.in[i] = (const float*)d_in[i];
    a.out = (float*)d_out; a.ws = (unsigned char*)d_ws;
#if MK_ONE_LAUNCH
    a.ph_lo = 0; a.ph_hi = NPHASE;
    hipLaunchKernelGGL(mk_fwd, dim3(grid), dim3(NWAVES * 64), LDS_BYTES, stream, a);
#else
    for (int p = 0; p < NPHASE; ++p) { a.ph_lo = p; a.ph_hi = p + 1; hipLaunchKernelGGL(mk_fwd, dim3(grid), dim3(NWAVES * 64), LDS_BYTES, stream, a); }
#endif
}
```

```cpp
#include <hip/hip_runtime.h>
#include <stdint.h>
#include <math.h>
#include <cstdio>

#ifndef MK_ONE_LAUNCH
#define MK_ONE_LAUNCH 1
#endif

typedef unsigned short bf16_t;
typedef float f32x4 __attribute__((ext_vector_type(4)));
typedef unsigned u32x2 __attribute__((ext_vector_type(2)));
typedef unsigned u32x4 __attribute__((ext_vector_type(4)));
#define GAS __attribute__((address_space(1)))
#define LAS __attribute__((address_space(3)))
typedef GAS unsigned gu32;
#define RLX_AGENT __ATOMIC_RELAXED, __HIP_MEMORY_SCOPE_AGENT

constexpr int D = 1024, BATCH = 16, SEQ = 4096, T = BATCH * SEQ;
constexpr int NEXP = 32, DEXP = 512, EPG = 8, NGRP = 4;
constexpr int QKVW = 4608;
constexpr int LISTCAP = 65536;
constexpr int PADROWS = 139264;
constexpr float EPS = 1e-6f;
constexpr float QSCALE = 0.125f * 1.4426950408889634f;
constexpr int NWAVES = 8;
constexpr int XRP = 2048;

constexpr size_t MiB = 1u << 20;
constexpr size_t WS_CTL = 0;
constexpr size_t CTL_BYTES = 1 * MiB;
constexpr int CW_BAR = 4096;
constexpr size_t WS_MOD = 1 * MiB;
constexpr size_t WS_ROPE = 3 * MiB;
constexpr size_t WS_LTOK = 4 * MiB;
constexpr size_t WS_LW = 12 * MiB;
constexpr size_t WS_TSLOT = 20 * MiB;
constexpr size_t WS_LSE = 24 * MiB;
constexpr size_t WS_WZ = 32 * MiB;
constexpr size_t WS_WB = 36 * MiB;
constexpr size_t WS_WCO = 38 * MiB;
constexpr size_t WS_WAI = 40 * MiB;
constexpr size_t WS_WAO = 49 * MiB;
constexpr size_t WS_WGU = 64 * MiB;
constexpr size_t WS_WDN = 192 * MiB;
constexpr size_t WS_XN = 256 * MiB;
constexpr size_t WS_BIG = 384 * MiB;
constexpr size_t WS_Z = WS_BIG, WS_YPRE = WS_BIG + 128 * MiB;
constexpr size_t WS_ACT = WS_BIG, WS_YW = WS_BIG + 136 * MiB;
constexpr size_t WS_QKV = WS_BIG;
constexpr size_t WS_END = WS_BIG + 576 * MiB;

constexpr int RING_BYTES = 162816;
constexpr int MISC_OFF = RING_BYTES;
constexpr int LDS_BYTES = RING_BYTES + 1024;

__device__ __forceinline__ unsigned f2bf(float f) { unsigned u = __float_as_uint(f); return (u + 0x7fffu + ((u >> 16) & 1u)) >> 16; }
__device__ __forceinline__ unsigned pk2(float lo, float hi) { return f2bf(lo) | (f2bf(hi) << 16); }
__device__ __forceinline__ float bf2f(unsigned h) { return __uint_as_float(h << 16); }
__device__ __forceinline__ float bflo(unsigned w) { return __uint_as_float(w << 16); }
__device__ __forceinline__ float bfhi(unsigned w) { return __uint_as_float(w & 0xffff0000u); }
__device__ __forceinline__ float wave_sum(float v) {
#pragma unroll
    for (int o = 1; o < 64; o <<= 1) v += __shfl_xor(v, o);
    return v;
}
__device__ __forceinline__ float silu_f(float x) { return x / (1.0f + __expf(-x)); }
#define LDS_WAIT() asm volatile("s_waitcnt lgkmcnt(0)" ::: "memory")
__device__ __forceinline__ int lane_id() { int l; asm volatile("v_mbcnt_lo_u32_b32 %0, -1, 0\n\tv_mbcnt_hi_u32_b32 %0, -1, %0" : "=v"(l)); return l; }

namespace pg8 {
#define PG8_LAS __attribute__((address_space(3)))
typedef unsigned short bf16_t;
typedef short bf16x8 __attribute__((ext_vector_type(8)));
typedef float f32x4 __attribute__((ext_vector_type(4)));
typedef unsigned u32x4 __attribute__((ext_vector_type(4)));
constexpr int BM = 256, BK = 64, HALF = 128, HTB = HALF * BK * 2  , STAGE_BYTES = 8 * HTB, NXCD = 8, WGM = 8;

__host__ __device__ __forceinline__ int lds_byte(int r, int c) { const int st = (r >> 4) * 2 + (c >> 5), rr = r & 15, cc = c & 31, ob = rr * 64 + cc * 2; return st * 1024 + (ob ^ (((ob >> 9) & 1) << 5)); }
__host__ __device__ __forceinline__ void stage_rc(int b, int& R, int& C) { const int st = b / 1024, sb = b % 1024, swz = sb ^ (((sb >> 9) & 1) << 5); R = (st >> 1) * 16 + swz / 64; C = (st & 1) * 32 + (swz % 64) / 2; }
__host__ __device__ __forceinline__ int perm32(int rho) { const int n = rho >> 4, i = rho & 15; return 8 * (i >> 2) + 4 * n + (i & 3); }

struct Unit { int pm, pn, pb; };
struct Gemm { const bf16_t* A; const bf16_t* Bt; int M, N, K; };

struct StaticOrder {
    int nM, nN, nwg, G, c;
    __host__ __device__ void init(int M, int N, int G_, int c_) { nM = M / BM; nN = N / BM; nwg = nM * nN; G = G_; c = c_; }
    __host__ __device__ bool next(int i, Unit& u) const {
        const long L = (long)i * G + c; if (L >= nwg) return false;
        int wgid = (int)L; { const int q = nwg / NXCD, r = nwg % NXCD, xcd = wgid % NXCD, off = wgid / NXCD; wgid = (xcd < r ? xcd * (q + 1) : r * (q + 1) + (xcd - r) * q) + off; }
        const int nig = WGM * nN, gid = wgid / nig, fm = gid * WGM, gsz = (nM - fm) < WGM ? (nM - fm) : WGM;
        u.pm = fm + ((wgid % nig) % gsz); u.pn = (wgid % nig) / gsz; u.pb = u.pn; return true;
    }
    __device__ __forceinline__ void a_ready(const Unit&) const {}
    __device__ __forceinline__ void done(const Unit&) const {}
};


__device__ __forceinline__ unsigned cvt_pk_bf16(float lo, float hi) { unsigned r; asm volatile("v_cvt_pk_bf16_f32 %0, %1, %2" : "=v"(r) : "v"(lo), "v"(hi)); return r; }
typedef float f32x2 __attribute__((ext_vector_type(2)));

template <class Epi, class Sched, class AM, bool ALIGN_EPI = false, bool SP2 = false>
__device__ __forceinline__ void gemm_phase(PG8_LAS unsigned char* lds, const Gemm g, const Sched& S, const Epi& E, const AM& am, const int wid_in) {
    int wid = wid_in; asm volatile("" : "+s"(wid));
    const int lane = lane_id(), tid = wid * 64 + lane, wr = wid >> 2, wc = wid & 3, fr = lane & 15, fq = lane >> 4;
    const int K = g.K, nt = K / BK;
    unsigned voffA[2], voffB[2]; int stR[2], stC[2];
#pragma unroll
    for (int i = 0; i < 2; ++i) { int R, C; stage_rc(tid * 16 + i * 8192, R, C); const int Rb = Epi::PERM ? ((R & ~31) + perm32(R & 31)) : R;
        stR[i] = R; stC[i] = C; voffA[i] = (unsigned)(R * K + C) * 2u; voffB[i] = (unsigned)(Rb * K + C) * 2u; }
    const size_t kstep = (size_t)(BK * 2);
    const size_t hstep = (size_t)HALF * K * 2;
    const size_t tstep = 2 * hstep;
    const unsigned ldsw = (unsigned)wid * 1024u;
    const int aoff = lds_byte(wr * 64 + fr, fq * 8), boff = lds_byte(wc * 32 + fr, fq * 8);
#define PG8_SA(b, h) (((b) * 2 + (h)) * HTB)
#define PG8_SB(b, h) ((4 + (b) * 2 + (h)) * HTB)
#define PG8_STAGE(bufoff, gbase, voff) do { _Pragma("unroll") for (int _i = 0; _i < 2; ++_i) \
        __builtin_amdgcn_global_load_lds((const unsigned*)((const char*)(gbase) + (voff)[_i]), (PG8_LAS unsigned*)(lds + (bufoff) + ldsw + _i * 8192), 16, 0, 0); } while (0)
#define PG8_STAGE_A(b, h, gbase, NX) do { if constexpr (AM::GATHER) { const unsigned so_[2] = {(NX) ? gno[h][0] : gao[h][0], (NX) ? gno[h][1] : gao[h][1]}; PG8_STAGE(PG8_SA(b, h), gbase, so_); } \
        else { PG8_STAGE(PG8_SA(b, h), (gbase) + (h) * hstep, voffA); } } while (0)
#define PG8_LDA(dst, b, h) do { _Pragma("unroll") for (int m = 0; m < 4; ++m) _Pragma("unroll") for (int k = 0; k < 2; ++k) dst[m][k] = *(const PG8_LAS bf16x8*)(lds + PG8_SA(b, h) + aoff + m * 2048 + k * 1024); } while (0)
#define PG8_LDB(dst, b, h) do { _Pragma("unroll") for (int n = 0; n < 2; ++n) _Pragma("unroll") for (int k = 0; k < 2; ++k) dst[n][k] = *(const PG8_LAS bf16x8*)(lds + PG8_SB(b, h) + boff + n * 2048 + k * 1024); } while (0)
#define PG8_MMA(ai, bj, At, Bt) do { __builtin_amdgcn_s_setprio(1); _Pragma("unroll") for (int m = 0; m < 4; ++m) _Pragma("unroll") for (int n = 0; n < 2; ++n) _Pragma("unroll") for (int k = 0; k < 2; ++k) \
        acc[ai][bj][m][n] = __builtin_amdgcn_mfma_f32_16x16x32_bf16(Bt[n][k], At[m][k], acc[ai][bj][m][n], 0, 0, 0); __builtin_amdgcn_s_setprio(0); } while (0)
#define PG8_WAIT_V(n) asm volatile("s_waitcnt vmcnt(" #n ")" ::: "memory")
#define PG8_WAIT_L(n) asm volatile("s_waitcnt lgkmcnt(" #n ")" ::: "memory")
#define PG8_BAR __builtin_amdgcn_s_barrier()
#define PG8_SCHED __builtin_amdgcn_sched_barrier(0)
    Unit cur, nxt; int ui = 0;
    if (!S.next(0, cur)) return;
    f32x4 acc[2][2][4][2];
#pragma unroll
    for (int a = 0; a < 2; ++a)
#pragma unroll
        for (int b = 0; b < 2; ++b)
#pragma unroll
            for (int m = 0; m < 4; ++m)
#pragma unroll
                for (int n = 0; n < 2; ++n) acc[a][b][m][n] = (f32x4){0.f, 0.f, 0.f, 0.f};
    bf16x8 At[4][2], B0[2][2], B1[2][2];
    const char* cA = (const char*)g.A + (AM::GATHER ? (size_t)0 : (size_t)cur.pm * tstep); const char* cB = (const char*)g.Bt + (size_t)cur.pb * tstep;
    unsigned gao[2][2], gno[2][2];
    if constexpr (AM::GATHER) { _Pragma("unroll") for (int h = 0; h < 2; ++h) _Pragma("unroll") for (int i = 0; i < 2; ++i) { gao[h][i] = (unsigned)(am.arow(cur, h * HALF + stR[i]) * K + stC[i]) * 2u; gno[h][i] = gao[h][i]; } }
    else { _Pragma("unroll") for (int h = 0; h < 2; ++h) _Pragma("unroll") for (int i = 0; i < 2; ++i) { gao[h][i] = 0u; gno[h][i] = 0u; } }
    S.a_ready(cur);
    if constexpr (SP2) {
        PG8_STAGE(PG8_SB(0, 0), cB, voffB); PG8_STAGE(PG8_SB(0, 1), cB + hstep, voffB); PG8_STAGE_A(0, 0, cA, false); PG8_STAGE_A(0, 1, cA, false);
        if (wr == 1) PG8_BAR;
        PG8_WAIT_V(2); PG8_BAR;
        PG8_STAGE(PG8_SB(1, 0), cB + kstep, voffB); PG8_STAGE_A(1, 0, cA + kstep, false); PG8_STAGE(PG8_SB(1, 1), cB + hstep + kstep, voffB);
        PG8_WAIT_V(6); PG8_BAR;
    } else {
        PG8_STAGE(PG8_SB(0, 0), cB, voffB); PG8_STAGE_A(0, 0, cA, false); PG8_STAGE(PG8_SB(0, 1), cB + hstep, voffB); PG8_STAGE_A(0, 1, cA, false);
        if (wr == 1) PG8_BAR;
        PG8_WAIT_V(4); PG8_BAR;
        PG8_STAGE(PG8_SB(1, 0), cB + kstep, voffB); PG8_STAGE_A(1, 0, cA + kstep, false); PG8_STAGE(PG8_SB(1, 1), cB + hstep + kstep, voffB);
        PG8_WAIT_V(6); PG8_BAR;
    }
    for (;;) {
        const bool has_next = S.next(ui + 1, nxt);
        const char* nA = has_next ? (const char*)g.A + (AM::GATHER ? (size_t)0 : (size_t)nxt.pm * tstep) : cA; const char* nB = has_next ? (const char*)g.Bt + (size_t)nxt.pb * tstep : cB;
        if constexpr (AM::GATHER) { if (has_next) { _Pragma("unroll") for (int h = 0; h < 2; ++h) _Pragma("unroll") for (int i = 0; i < 2; ++i) gno[h][i] = (unsigned)(am.arow(nxt, h * HALF + stR[i]) * K + stC[i]) * 2u; } }
        for (int t = 0; t < nt; t += 2) {
            const bool last = (t == nt - 2);
            const char* a1 = cA + (size_t)(t + 1) * kstep;
            const char* a2 = last ? nA : cA + (size_t)(t + 2) * kstep; const char* b2 = last ? nB : cB + (size_t)(t + 2) * kstep;
            const char* a3 = a2 + kstep; const char* b3 = b2 + kstep;
            if (last && has_next) S.a_ready(nxt);
            if (false) E.prefetch(cur, tid, (PG8_LAS unsigned*)(lds + 162816 + 512));
            if constexpr (SP2) {
            PG8_LDB(B0, 0, 0); PG8_LDB(B1, 0, 1); PG8_SCHED; PG8_LDA(At, 0, 0); PG8_STAGE_A(1, 1, a1, false);
            PG8_WAIT_V(8); PG8_WAIT_L(0); PG8_BAR; PG8_MMA(0, 0, At, B0); PG8_MMA(0, 1, At, B1); PG8_BAR; PG8_SCHED;
            PG8_LDA(At, 0, 1); PG8_STAGE(PG8_SB(0, 0), b2, voffB); PG8_STAGE(PG8_SB(0, 1), b2 + hstep, voffB); PG8_STAGE_A(0, 0, a2, last);
            PG8_WAIT_V(8); PG8_WAIT_L(0); PG8_BAR; PG8_MMA(1, 0, At, B0); PG8_MMA(1, 1, At, B1); PG8_BAR; PG8_SCHED;
            PG8_LDB(B0, 1, 0); PG8_LDB(B1, 1, 1); PG8_SCHED; PG8_LDA(At, 1, 0); PG8_STAGE_A(0, 1, a2, last);
            PG8_WAIT_V(8); PG8_WAIT_L(0); PG8_BAR; PG8_MMA(0, 0, At, B0); PG8_MMA(0, 1, At, B1); PG8_BAR; PG8_SCHED;
            PG8_LDA(At, 1, 1); PG8_STAGE(PG8_SB(1, 0), b3, voffB); PG8_STAGE(PG8_SB(1, 1), b3 + hstep, voffB); PG8_STAGE_A(1, 0, a3, last);
            PG8_WAIT_V(8); PG8_WAIT_L(0); PG8_BAR; PG8_MMA(1, 0, At, B0); PG8_MMA(1, 1, At, B1); PG8_BAR; PG8_SCHED;
            } else {
            PG8_LDB(B0, 0, 0); PG8_SCHED; PG8_LDA(At, 0, 0); PG8_STAGE_A(1, 1, a1, false);
            PG8_WAIT_L(8); PG8_BAR; PG8_WAIT_L(0); PG8_MMA(0, 0, At, B0); PG8_BAR; PG8_SCHED;
            PG8_LDB(B1, 0, 1); PG8_STAGE(PG8_SB(0, 0), b2, voffB);
            PG8_BAR; PG8_WAIT_L(0); PG8_MMA(0, 1, At, B1); PG8_BAR;
            PG8_LDA(At, 0, 1); PG8_STAGE_A(0, 0, a2, last);
            PG8_BAR; PG8_WAIT_L(0); PG8_MMA(1, 0, At, B0); PG8_BAR; PG8_SCHED;
            PG8_STAGE(PG8_SB(0, 1), b2 + hstep, voffB);
            PG8_WAIT_V(6); PG8_BAR; PG8_MMA(1, 1, At, B1); PG8_BAR;
            PG8_LDB(B0, 1, 0); PG8_SCHED; PG8_LDA(At, 1, 0); PG8_STAGE_A(0, 1, a2, last);
            PG8_WAIT_L(8); PG8_BAR; PG8_WAIT_L(0); PG8_MMA(0, 0, At, B0); PG8_BAR; PG8_SCHED;
            PG8_LDB(B1, 1, 1); PG8_STAGE(PG8_SB(1, 0), b3, voffB);
            PG8_BAR; PG8_WAIT_L(0); PG8_MMA(0, 1, At, B1); PG8_BAR;
            PG8_LDA(At, 1, 1); PG8_STAGE_A(1, 0, a3, last);
            PG8_BAR; PG8_WAIT_L(0); PG8_MMA(1, 0, At, B0); PG8_BAR; PG8_SCHED;
            PG8_STAGE(PG8_SB(1, 1), b3 + hstep, voffB);
            PG8_WAIT_V(6); PG8_BAR; PG8_MMA(1, 1, At, B1); PG8_BAR;
            }
        }
        if constexpr (ALIGN_EPI) { if (wr == 0) PG8_BAR; }
        if constexpr (!Epi::AFTER_DRAIN) { E(acc, cur, wr, wc, fr, fq); S.done(cur); }
        if (!has_next) break;
#pragma unroll
        for (int a = 0; a < 2; ++a)
#pragma unroll
            for (int b = 0; b < 2; ++b)
#pragma unroll
                for (int m = 0; m < 4; ++m)
#pragma unroll
                    for (int n = 0; n < 2; ++n) acc[a][b][m][n] = (f32x4){0.f, 0.f, 0.f, 0.f};
        cur = nxt; cA = nA; cB = nB; ++ui;
        if constexpr (AM::GATHER) { _Pragma("unroll") for (int h = 0; h < 2; ++h) _Pragma("unroll") for (int i = 0; i < 2; ++i) gao[h][i] = gno[h][i]; }
        if constexpr (ALIGN_EPI) { if (wr == 1) PG8_BAR; }
    }
    PG8_WAIT_V(0);
    if constexpr (!ALIGN_EPI) { if (wr == 0) PG8_BAR; }
    PG8_BAR;
    if constexpr (Epi::AFTER_DRAIN) { E.fused(acc, cur, wr, wc, fr, fq, lds, wid, lane); S.done(cur); }
#undef PG8_SA
#undef PG8_SB
#undef PG8_STAGE
#undef PG8_STAGE_A
#undef PG8_LDA
#undef PG8_LDB
#undef PG8_MMA
#undef PG8_WAIT_V
#undef PG8_WAIT_L
#undef PG8_BAR
#undef PG8_SCHED
}

__device__ __forceinline__ u32x4 pack8(const f32x4 v0, const f32x4 v1) { u32x4 w; w.x = cvt_pk_bf16(v0[0], v0[1]); w.y = cvt_pk_bf16(v0[2], v0[3]); w.z = cvt_pk_bf16(v1[0], v1[1]); w.w = cvt_pk_bf16(v1[2], v1[3]); return w; }
__device__ __forceinline__ float silu1(float x) { return x * __builtin_amdgcn_rcpf(1.0f + __builtin_amdgcn_exp2f(-1.4426950408889634f * x)); }
template <bool SILU> struct EpiPair {
    static constexpr bool PERM = true, AFTER_DRAIN = false;
    bf16_t* O; int ldc;
    __device__ __forceinline__ void prefetch(const Unit&, int, PG8_LAS unsigned*) const {}
    __device__ __forceinline__ void operator()(const f32x4 (&acc)[2][2][4][2], const Unit& u, int wr, int wc, int fr, int fq) const {
        const int row0 = u.pm * BM + wr * 64 + fr, ch0 = u.pn * HALF + wc * 32 + 8 * fq;
#pragma unroll
        for (int ai = 0; ai < 2; ++ai)
#pragma unroll
            for (int m = 0; m < 4; ++m) {
                f32x4 a0 = acc[ai][0][m][0], a1 = acc[ai][0][m][1];
                if (SILU) {
#pragma unroll
                    for (int c = 0; c < 4; ++c) { a0[c] = silu1(a0[c]); a1[c] = silu1(a1[c]); }
                }
                *(u32x4*)(O + (size_t)(row0 + ai * HALF + m * 16) * ldc + ch0) = pack8(a0 * acc[ai][1][m][0], a1 * acc[ai][1][m][1]);
            }
    }
};
struct EpiYpre {
    static constexpr bool PERM = true, AFTER_DRAIN = false;
    bf16_t* O; const bf16_t* Z; const float* cw;
    __device__ __forceinline__ void prefetch(const Unit& u, int tid, PG8_LAS unsigned* dummy) const {
#pragma unroll
        for (int i = 0; i < 2; ++i) { const int line = tid + 512 * i, row = line >> 2, seg = line & 3;
            __builtin_amdgcn_global_load_lds((const unsigned*)(Z + (size_t)(u.pm * BM + row) * D + u.pn * BM + seg * 64), dummy, 4, 0, 0); }
    }
    __device__ __forceinline__ void operator()(const f32x4 (&acc)[2][2][4][2], const Unit& u, int wr, int wc, int fr, int fq) const {
        const int row0 = u.pm * BM + wr * 64 + fr;
#pragma unroll
        for (int bj = 0; bj < 2; ++bj) {
            const int col0 = u.pn * BM + bj * HALF + wc * 32 + 8 * fq;
            f32x4 w0[2], w1[2], w2[2];
#pragma unroll
            for (int n = 0; n < 2; ++n) { w0[n] = *(const f32x4*)(cw + col0 + 4 * n); w1[n] = *(const f32x4*)(cw + D + col0 + 4 * n); w2[n] = *(const f32x4*)(cw + 2 * D + col0 + 4 * n); }
#pragma unroll
            for (int ai = 0; ai < 2; ++ai) {
                u32x4 zz[4][3];
#pragma unroll
                for (int m = 0; m < 4; ++m) {
                    const int row = row0 + ai * HALF + m * 16, t = row & (SEQ - 1);
                    const bf16_t* zp = Z + (size_t)row * D + col0;
                    zz[m][0] = *(const u32x4*)zp; zz[m][1] = (u32x4){0u, 0u, 0u, 0u}; zz[m][2] = (u32x4){0u, 0u, 0u, 0u};
                    if (t >= 1) zz[m][1] = *(const u32x4*)(zp - D);
                    if (t >= 2) zz[m][2] = *(const u32x4*)(zp - 2 * D);
                }
#pragma unroll
                for (int m = 0; m < 4; ++m) {
                    const int row = row0 + ai * HALF + m * 16;
                    const u32x4 z0 = zz[m][0], z1 = zz[m][1], z2 = zz[m][2];
                    f32x4 v[2];
#pragma unroll
                    for (int n = 0; n < 2; ++n) {
                        f32x4 a, b, c;
                        a[0] = __uint_as_float(z0[2 * n] << 16); a[1] = __uint_as_float(z0[2 * n] & 0xffff0000u); a[2] = __uint_as_float(z0[2 * n + 1] << 16); a[3] = __uint_as_float(z0[2 * n + 1] & 0xffff0000u);
                        b[0] = __uint_as_float(z1[2 * n] << 16); b[1] = __uint_as_float(z1[2 * n] & 0xffff0000u); b[2] = __uint_as_float(z1[2 * n + 1] << 16); b[3] = __uint_as_float(z1[2 * n + 1] & 0xffff0000u);
                        c[0] = __uint_as_float(z2[2 * n] << 16); c[1] = __uint_as_float(z2[2 * n] & 0xffff0000u); c[2] = __uint_as_float(z2[2 * n + 1] << 16); c[3] = __uint_as_float(z2[2 * n + 1] & 0xffff0000u);
                        v[n] = acc[ai][bj][m][n] * (w2[n] * a + w1[n] * b + w0[n] * c);
                    }
                    *(u32x4*)(O + (size_t)row * D + col0) = pack8(v[0], v[1]);
                }
                asm volatile("" ::: "memory");
            }
        }
    }
};

template <bool RES_F32> struct EpiRes {
    static constexpr bool PERM = true, AFTER_DRAIN = false;
    bf16_t* xr; const float* xin; const float* modg;
    __device__ __forceinline__ void prefetch(const Unit&, int, PG8_LAS unsigned*) const {}
    __device__ __forceinline__ void operator()(const f32x4 (&acc)[2][2][4][2], const Unit& u, int wr, int wc, int fr, int fq) const {
        const int row0 = u.pm * BM + wr * 64 + fr, col0 = u.pn * BM + wc * 32 + 8 * fq;
        const float* gb = modg + (size_t)((u.pm * BM) >> 12) * 6144;
        f32x4 gv[2][2];
#pragma unroll
        for (int bj = 0; bj < 2; ++bj)
#pragma unroll
            for (int n = 0; n < 2; ++n) gv[bj][n] = *(const f32x4*)(gb + col0 + bj * HALF + n * 4);
#pragma unroll
        for (int ai = 0; ai < 2; ++ai) {
            f32x4 rv[4][2][2];
#pragma unroll
            for (int m = 0; m < 4; ++m) { const int row = row0 + ai * HALF + m * 16;
#pragma unroll
                for (int bj = 0; bj < 2; ++bj) {
                    if (RES_F32) { rv[m][bj][0] = *(const f32x4*)(xin + (size_t)row * D + col0 + bj * HALF); rv[m][bj][1] = *(const f32x4*)(xin + (size_t)row * D + col0 + bj * HALF + 4); }
                    else { const u32x4 w = *(const u32x4*)(xr + (size_t)row * XRP + col0 + bj * HALF);
                        rv[m][bj][0] = (f32x4){__uint_as_float(w.x << 16), __uint_as_float(w.x & 0xffff0000u), __uint_as_float(w.y << 16), __uint_as_float(w.y & 0xffff0000u)};
                        rv[m][bj][1] = (f32x4){__uint_as_float(w.z << 16), __uint_as_float(w.z & 0xffff0000u), __uint_as_float(w.w << 16), __uint_as_float(w.w & 0xffff0000u)}; }
                } }
#pragma unroll
            for (int m = 0; m < 4; ++m) { const int row = row0 + ai * HALF + m * 16;
#pragma unroll
                for (int bj = 0; bj < 2; ++bj)
                    *(u32x4*)(xr + (size_t)row * XRP + col0 + bj * HALF) = pack8(rv[m][bj][0] + gv[bj][0] * acc[ai][bj][m][0], rv[m][bj][1] + gv[bj][1] * acc[ai][bj][m][1]); }
            asm volatile("" ::: "memory");
        }
    }
};
struct EpiQKV {
    static constexpr bool PERM = true, AFTER_DRAIN = false;
    bf16_t* O; const float* rope;
    __device__ __forceinline__ void prefetch(const Unit&, int, PG8_LAS unsigned*) const {}
    __device__ __forceinline__ void operator()(const f32x4 (&acc)[2][2][4][2], const Unit& u, int wr, int wc, int fr, int fq) const {
        const int row0 = u.pm * BM + wr * 64 + fr, col0 = u.pn * BM + wc * 32 + 8 * fq;
        const int typ = (u.pn % 6) >> 1;
        const bool rl = (typ < 2) && ((wc & 1) == 0) && (fq < 2);
        const float sc = (typ == 0) ? QSCALE : 1.0f;
#pragma unroll
        for (int ai = 0; ai < 2; ++ai) {
            f32x4 csv[4], snv[4];
#pragma unroll
            for (int m = 0; m < 4; ++m) { const int pos = (row0 + ai * HALF + m * 16) & (SEQ - 1);
                csv[m] = *(const f32x4*)(rope + pos * 8 + 4 * (fq & 1)); snv[m] = *(const f32x4*)(rope + 4096 * 8 + pos * 8 + 4 * (fq & 1)); }
#pragma unroll
            for (int m = 0; m < 4; ++m) {
                const int row = row0 + ai * HALF + m * 16;
                f32x4 cs = {1.f, 1.f, 1.f, 1.f}, sn = {0.f, 0.f, 0.f, 0.f};
                if (rl) { cs = csv[m]; sn = snv[m]; }
#pragma unroll
                for (int bj = 0; bj < 2; ++bj) {
                    const f32x4 x1 = acc[ai][bj][m][0], x2 = acc[ai][bj][m][1];
                    const f32x4 r1 = (x1 * cs - x2 * sn) * sc, r2 = (x2 * cs + x1 * sn) * sc;
                    *(u32x4*)(O + (size_t)row * QKVW + col0 + bj * HALF) = pack8(r1, r2);
                }
            }
            asm volatile("" ::: "memory");
        }
    }
};
struct EpiDown {
    static constexpr bool PERM = true, AFTER_DRAIN = false;
    bf16_t* O; const float* lw; const PG8_LAS int* rb;
    __device__ __forceinline__ void prefetch(const Unit&, int, PG8_LAS unsigned*) const {}
    __device__ __forceinline__ void operator()(const f32x4 (&acc)[2][2][4][2], const Unit& u, int wr, int wc, int fr, int fq) const {
        const int row0 = u.pm * BM + wr * 64 + fr, col0 = u.pn * BM + wc * 32 + 8 * fq;
        const int e = u.pb >> 2; const float* wrow = lw + (size_t)e * LISTCAP - rb[e];
        float wv[2][4];
#pragma unroll
        for (int ai = 0; ai < 2; ++ai)
#pragma unroll
            for (int m = 0; m < 4; ++m) wv[ai][m] = wrow[row0 + ai * HALF + m * 16];
#pragma unroll
        for (int ai = 0; ai < 2; ++ai)
#pragma unroll
            for (int m = 0; m < 4; ++m) {
                const int row = row0 + ai * HALF + m * 16; const float w = wv[ai][m];
#pragma unroll
                for (int bj = 0; bj < 2; ++bj) *(u32x4*)(O + (size_t)row * D + col0 + bj * HALF) = pack8(acc[ai][bj][m][0] * w, acc[ai][bj][m][1] * w);
            }
    }
};
struct MoeOrder {
    int nM, nN, nwg, G, c; const PG8_LAS int* rb;
    __device__ void init(int nRT, int G_, int c_, const PG8_LAS int* rb_) { nM = nRT; nN = 4; nwg = nM * nN; G = G_; c = c_; rb = rb_; }
    __device__ bool next(int i, Unit& u) const {
        const long L = (long)i * G + c; if (L >= nwg) return false;
        int wgid = (int)L; { const int q = nwg / NXCD, r = nwg % NXCD, xcd = wgid % NXCD, off = wgid / NXCD; wgid = (xcd < r ? xcd * (q + 1) : r * (q + 1) + (xcd - r) * q) + off; }
        const int nig = WGM * nN, gid = wgid / nig, fm = gid * WGM, gsz = (nM - fm) < WGM ? (nM - fm) : WGM;
        u.pm = fm + ((wgid % nig) % gsz); u.pn = (wgid % nig) / gsz;
        int e = 0; const int r0 = u.pm * BM;
#pragma unroll 1
        while (e < 31 && rb[e + 1] <= r0) ++e;
        u.pb = e * 4 + u.pn; return true;
    }
    __device__ __forceinline__ void a_ready(const Unit&) const {}
    __device__ __forceinline__ void done(const Unit&) const {}
};
struct APlain { static constexpr bool GATHER = false; __device__ __forceinline__ int arow(const Unit&, int) const { return 0; } };
struct AGather {
    static constexpr bool GATHER = true;
    const int* ltok; const int* cnt; const PG8_LAS int* rb;
    __device__ __forceinline__ int arow(const Unit& u, int r) const { const int e = u.pb >> 2, l = u.pm * BM - rb[e] + r; return (l < cnt[e]) ? ltok[(size_t)e * LISTCAP + l] : 0; }
};
}

#define XB_TMO      128
#define XB_XCNT(j)  (256  + 64 * (j))
#define XB_XSUB(j)  (1280 + 64 * (j))
#define XB_XGEN(j)  (2304 + 64 * (j))
#define XB_TOP      3328
#define XB_TOPGEN   3392
#define XCD_BAR_WORDS 3456
#define XB_SPIN_CAP (1u << 18)

__device__ __forceinline__ unsigned xb_ld(unsigned* p)              { return __hip_atomic_load(p, __ATOMIC_RELAXED, __HIP_MEMORY_SCOPE_AGENT); }
__device__ __forceinline__ unsigned xb_add(unsigned* p, unsigned v) { return __hip_atomic_fetch_add(p, v, __ATOMIC_RELAXED, __HIP_MEMORY_SCOPE_AGENT); }
__device__ __forceinline__ unsigned xb_xcc_id() { return (unsigned)__builtin_amdgcn_s_getreg((3 << 11) | 20) & 0xFu; }
#define XB_SPIN(cond, bar) do { unsigned _sp = 0; while (cond) { __builtin_amdgcn_s_sleep(1); \
    if ((++_sp & 255u) == 0u) { if (xb_ld(&(bar)[XB_TMO])) break; if (_sp > XB_SPIN_CAP) { atomicAdd(&(bar)[XB_TMO], 1u); break; } } } } while (0)

struct XcdBarrier {
    unsigned* bar; unsigned x;
    volatile LAS unsigned* st;
};

__device__ __forceinline__ XcdBarrier xcd_barrier_post(unsigned* bar, volatile LAS unsigned* st, int wave) {
    XcdBarrier b; b.bar = bar; b.x = xb_xcc_id(); b.st = st;
    if (wave == 0 && lane_id() == 0) (void)xb_add(&bar[XB_XCNT(b.x)], 1u);
    return b;
}
__device__ __forceinline__ void xcd_barrier_complete(unsigned* bar, unsigned x, unsigned& nloc, unsigned& nx) {
    const unsigned G = gridDim.x * gridDim.y * gridDim.z;
    unsigned sum, cnt, mine, sp = 0u;
    for (;;) {
        sum = 0u; cnt = 0u; mine = 0u;
#pragma unroll
        for (unsigned j = 0; j < 16; ++j) { const unsigned c = xb_ld(&bar[XB_XCNT(j)]); sum += c; cnt += (c > 0u) ? 1u : 0u; mine = (j == x) ? c : mine; }
        if (sum == G) break;
        __builtin_amdgcn_s_sleep(1);
        if ((++sp & 255u) == 0u) { if (xb_ld(&bar[XB_TMO])) break; if (sp > XB_SPIN_CAP) { atomicAdd(&bar[XB_TMO], 1u); break; } }
    }
    nloc = mine > 0u ? mine : 1u; nx = cnt > 0u ? cnt : 1u;
}

__device__ __forceinline__ void xcd_barrier(const XcdBarrier& b, int wave) {
    asm volatile("s_waitcnt vmcnt(0)" ::: "memory");
    __syncthreads();
    if (wave == 0 && lane_id() == 0) {
        unsigned* bar = b.bar;
        __builtin_amdgcn_s_waitcnt(0);
        unsigned nloc = b.st[0], nx = b.st[1];
        if (nloc == 0u) { xcd_barrier_complete(bar, b.x, nloc, nx); b.st[0] = nloc; b.st[1] = nx; }
        const unsigned old = xb_add(&bar[XB_XSUB(b.x)], 1u);
        const unsigned gen = old / nloc;
        if (old + 1u == (gen + 1u) * nloc) {
            __builtin_amdgcn_fence(__ATOMIC_RELEASE, "agent");
            asm volatile("s_waitcnt vmcnt(0)" ::: "memory");
            const unsigned og = xb_add(&bar[XB_TOP], 1u);
            const unsigned tg = og / nx;
            if (og + 1u == (tg + 1u) * nx) xb_add(&bar[XB_TOPGEN], 1u);
            else XB_SPIN(xb_ld(&bar[XB_TOPGEN]) == tg, bar);
            __builtin_amdgcn_fence(__ATOMIC_ACQUIRE, "agent");
            xb_add(&bar[XB_XGEN(b.x)], 1u);
            asm volatile("s_waitcnt vmcnt(0)" ::: "memory");
        } else {
            XB_SPIN(xb_ld(&bar[XB_XGEN(b.x)]) == gen, bar);
            __builtin_amdgcn_fence(__ATOMIC_ACQUIRE, "agent");
            asm volatile("s_waitcnt vmcnt(0)" ::: "memory");
        }
    }
    __syncthreads();
}

struct RowV { f32x4 v[4]; };
__device__ __forceinline__ void row_load(RowV& r, const float* row, int lane) {
#pragma unroll
    for (int j = 0; j < 4; ++j) r.v[j] = *(const f32x4*)(row + 4 * lane + 256 * j);
}
__device__ __forceinline__ void row_load_bf16(RowV& r, const bf16_t* row, int lane) {
#pragma unroll
    for (int j = 0; j < 4; ++j) { const u32x2 w = *(const u32x2*)(row + 4 * lane + 256 * j); r.v[j] = (f32x4){bflo(w.x), bfhi(w.x), bflo(w.y), bfhi(w.y)}; }
}
__device__ __forceinline__ float row_rstd(const RowV& r) {
    float s = 0.f;
#pragma unroll
    for (int j = 0; j < 4; ++j) s += (r.v[j].x * r.v[j].x + r.v[j].y * r.v[j].y) + (r.v[j].z * r.v[j].z + r.v[j].w * r.v[j].w);
    s = wave_sum(s);
    return 1.0f / sqrtf(s * (1.0f / 1024.0f) + EPS);
}
__device__ __forceinline__ void row_modulate(RowV& r, float rstd, const float* g, const float* sh, const float* sc, int lane) {
#pragma unroll
    for (int j = 0; j < 4; ++j) {
        const int o = 4 * lane + 256 * j;
        const f32x4 gg = *(const f32x4*)(g + o), s = *(const f32x4*)(sc + o), h = *(const f32x4*)(sh + o);
        r.v[j] = (r.v[j] * rstd * gg) * (s + 1.0f) + h;
    }
}
struct ModV { f32x4 gp[4], sh[4]; };
__device__ __forceinline__ void mod_load(ModV& m, const float* g, const float* sh, const float* sc, int lane) {
#pragma unroll
    for (int j = 0; j < 4; ++j) { const int o = 4 * lane + 256 * j; m.gp[j] = *(const f32x4*)(g + o) * (*(const f32x4*)(sc + o) + 1.0f); m.sh[j] = *(const f32x4*)(sh + o); }
}
__device__ __forceinline__ void row_apply(RowV& r, float rstd, const ModV& m) {
#pragma unroll
    for (int j = 0; j < 4; ++j) r.v[j] = (r.v[j] * rstd) * m.gp[j] + m.sh[j];
}
__device__ __forceinline__ void row_store_bf16(const RowV& r, bf16_t* out, int lane) {
#pragma unroll
    for (int j = 0; j < 4; ++j) { u32x2 w; w.x = pg8::cvt_pk_bf16(r.v[j].x, r.v[j].y); w.y = pg8::cvt_pk_bf16(r.v[j].z, r.v[j].w); *(u32x2*)(out + 4 * lane + 256 * j) = w; }
}
__device__ __forceinline__ void row_store_f32(const RowV& r, float* out, int lane) {
#pragma unroll
    for (int j = 0; j < 4; ++j) *(f32x4*)(out + 4 * lane + 256 * j) = r.v[j];
}

__device__ __forceinline__ int wmap(int code, int n) {
    if (code == 1) { const int isU = n >> 10, ch = n & 1023; return (ch >> 7) * 256 + isU * 128 + (ch & 127); }
    if (code == 2) { const int typ = (n % 1536) / 512, d = n & 63; return (typ < 2 && d >= 4 && d < 12) ? (d < 8 ? n + 4 : n - 4) : n; }
    if (code == 3) return (n >> 7) * 256 + (n & 127);
    if (code == 4) return (n >> 7) * 256 + 128 + (n & 127);
    return n;
}
struct ConvDesc { const float* src; bf16_t* dst; int ldw, K, code, nloc; };
__device__ __forceinline__ void conv_desc(ConvDesc& d, const float* W, int ldw, int ncol0, bf16_t* WT, int K, int code, int kb, int nb) {
    d.src = W + (size_t)(64 * kb) * ldw + ncol0 + 64 * nb; d.dst = WT + 64 * kb; d.ldw = ldw; d.K = K; d.code = code; d.nloc = 64 * nb;
}
__device__ __forceinline__ void conv_load(f32x4 (&v)[16], const ConvDesc& d, int lane) {
    const float* src = d.src + (size_t)(lane >> 4) * d.ldw + (lane & 15) * 4;
#pragma unroll
    for (int i = 0; i < 16; ++i) v[i] = *(const f32x4*)(src + (size_t)(4 * i) * d.ldw);
}
__device__ __forceinline__ void conv_process(const f32x4 (&v)[16], const ConvDesc& d, LAS float* scr, int lane) {
#pragma unroll
    for (int i = 0; i < 16; ++i) { LAS float* p = scr + (4 * i + (lane >> 4)) * 65 + (lane & 15) * 4; p[0] = v[i].x; p[1] = v[i].y; p[2] = v[i].z; p[3] = v[i].w; }
    LDS_WAIT();
    const int c = lane & 7;
#pragma unroll
    for (int j = 0; j < 8; ++j) { const int n = (lane >> 3) + 8 * j; const LAS float* sp = scr + (8 * c) * 65 + n;
        u32x4 o; o.x = pg8::cvt_pk_bf16(sp[0 * 65], sp[1 * 65]); o.y = pg8::cvt_pk_bf16(sp[2 * 65], sp[3 * 65]); o.z = pg8::cvt_pk_bf16(sp[4 * 65], sp[5 * 65]); o.w = pg8::cvt_pk_bf16(sp[6 * 65], sp[7 * 65]);
        *(u32x4*)(d.dst + (size_t)wmap(d.code, d.nloc + n) * d.K + 8 * c) = o; }
    LDS_WAIT();
}
constexpr int NCONV_ITEMS = 512 + 256 + 256 + 1152 + 128 + 64 * 384;

__device__ __forceinline__ void attn_naive(bf16_t* qkv, float* lse, int bid, int G, int tid) {
    const size_t n = (size_t)T * 24;
    for (size_t i = (size_t)bid * 512 + tid; i < n; i += (size_t)G * 512) {
        const int t = (int)(i / 24), gh = (int)(i % 24), g = gh / 8, h = gh % 8;
        const int dil = g == 0 ? 1 : (g == 1 ? 4 : 16);
        const int pos = t & (SEQ - 1);
        bf16_t* qp = qkv + (size_t)t * QKVW + g * 1536 + h * 64;
        float q[64], o[64];
#pragma unroll
        for (int c8 = 0; c8 < 8; ++c8) { const u32x4 w = *(const u32x4*)(qp + c8 * 8);
#pragma unroll
            for (int k = 0; k < 4; ++k) { q[c8 * 8 + 2 * k] = bflo(w[k]); q[c8 * 8 + 2 * k + 1] = bfhi(w[k]); o[c8 * 8 + 2 * k] = 0.f; o[c8 * 8 + 2 * k + 1] = 0.f; } }
        float m = -INFINITY, l = 0.f;
        for (int j = 0; j <= 128; ++j) {
            const int kp = pos - j * dil; if (kp < 0) break;
            const bf16_t* kr = qkv + (size_t)(t - j * dil) * QKVW + g * 1536 + 512 + h * 64;
            const bf16_t* vr = kr + 512;
            float s = 0.f;
#pragma unroll
            for (int c8 = 0; c8 < 8; ++c8) { const u32x4 w = *(const u32x4*)(kr + c8 * 8);
#pragma unroll
                for (int k = 0; k < 4; ++k) s += q[c8 * 8 + 2 * k] * bflo(w[k]) + q[c8 * 8 + 2 * k + 1] * bfhi(w[k]); }
            const float mn = fmaxf(m, s), a = exp2f(m - mn), pv = exp2f(s - mn);
            l = l * a + pv;
#pragma unroll
            for (int c8 = 0; c8 < 8; ++c8) { const u32x4 w = *(const u32x4*)(vr + c8 * 8);
#pragma unroll
                for (int k = 0; k < 4; ++k) { o[c8 * 8 + 2 * k] = o[c8 * 8 + 2 * k] * a + pv * bflo(w[k]); o[c8 * 8 + 2 * k + 1] = o[c8 * 8 + 2 * k + 1] * a + pv * bfhi(w[k]); } }
            m = mn;
        }
        const float inv = 1.0f / l;
#pragma unroll
        for (int c8 = 0; c8 < 8; ++c8) { u32x4 w;
#pragma unroll
            for (int k = 0; k < 4; ++k) w[k] = pk2(o[c8 * 8 + 2 * k] * inv, o[c8 * 8 + 2 * k + 1] * inv);
            *(u32x4*)(qp + c8 * 8) = w; }
        lse[(size_t)t * 24 + gh] = m + log2f(l);
    }
}
__device__ __forceinline__ void attn_comb(const bf16_t* qkv, const float* lse, bf16_t* o, int bid, int G, int tid) {
    const size_t n = (size_t)T * 64;
    for (size_t i = (size_t)bid * 512 + tid; i < n; i += (size_t)G * 512) {
        const int t = (int)(i >> 6), r = (int)(i & 63), h = r >> 3, c = r & 7;
        const float l0 = lse[(size_t)t * 24 + h], l1 = lse[(size_t)t * 24 + 8 + h], l2 = lse[(size_t)t * 24 + 16 + h];
        const float mx = fmaxf(l0, fmaxf(l1, l2));
        float w0 = exp2f(l0 - mx), w1 = exp2f(l1 - mx), w2 = exp2f(l2 - mx);
        const float inv = 1.0f / (w0 + w1 + w2); w0 *= inv; w1 *= inv; w2 *= inv;
        const bf16_t* base = qkv + (size_t)t * QKVW + h * 64 + c * 8;
        const u32x4 a = *(const u32x4*)(base), b = *(const u32x4*)(base + 1536), cc = *(const u32x4*)(base + 3072);
        u32x4 out;
#pragma unroll
        for (int k = 0; k < 4; ++k) {
            const float lo = w0 * bflo(a[k]) + w1 * bflo(b[k]) + w2 * bflo(cc[k]);
            const float hi = w0 * bfhi(a[k]) + w1 * bfhi(b[k]) + w2 * bfhi(cc[k]);
            out[k] = pk2(lo, hi);
        }
        *(u32x4*)(o + (size_t)t * 512 + h * 64 + c * 8) = out;
    }
}

namespace att {
typedef short bf16x8 __attribute__((ext_vector_type(8)));
typedef short s16x4 __attribute__((ext_vector_type(4)));
typedef float f32x16 __attribute__((ext_vector_type(16)));
constexpr int KOFF = 0, KCH = 4112  , KHD = 8 * KCH, VOFF = 2 * KHD, VDH = 16384 + 64  , VHD = 2 * VDH, NUNITS = 16 * 3 * 32 * 4;
__device__ __forceinline__ int crow(int r, int hi) { return (r & 3) + 8 * (r >> 2) + 4 * hi; }
__device__ __forceinline__ s16x4 vtr(const LAS unsigned char* p) { return __builtin_bit_cast(s16x4, __builtin_amdgcn_ds_read_tr16_b64_v4i16((LAS s16x4*)p)); }
__device__ __forceinline__ float xhalf_max(float m) { auto rr = __builtin_amdgcn_permlane32_swap(__float_as_uint(m), __float_as_uint(m), false, false); return fmaxf(__uint_as_float(rr[0]), __uint_as_float(rr[1])); }
__device__ __forceinline__ float xhalf_sum(float m) { auto rr = __builtin_amdgcn_permlane32_swap(__float_as_uint(m), __float_as_uint(m), false, false); return __uint_as_float(rr[0]) + __uint_as_float(rr[1]); }

struct AUnit { int hp, g, dil, l0; size_t tb; };
__device__ __forceinline__ void adecode(AUnit& u, int idx) {
    const int rest = idx >> 2, sb = rest & 31, bg = rest >> 5, b = bg / 3;
    u.hp = idx & 3; u.g = bg - 3 * b; const int dsh = 2 * u.g; u.dil = 1 << dsh;
    const int bps = 32 >> dsh, r = sb / bps; u.l0 = (sb - r * bps) * 128; u.tb = (size_t)b * SEQ + r;
}
__device__ __forceinline__ void aload_kv(u32x4 (&kv)[16], const AUnit& u, const bf16_t* qkv, int wave, int lane) {
    const bf16_t* gq = qkv + u.g * 1536;
#pragma unroll
    for (int i = 0; i < 8; ++i) {
        int sp = u.l0 - 128 + 64 * (wave & 3) + 8 * i + (lane >> 3); sp = sp < 0 ? 0 : sp;
        kv[i] = *(const u32x4*)(gq + (u.tb + (size_t)sp * u.dil) * QKVW + 512 + (u.hp * 2 + (wave >> 2)) * 64 + (lane & 7) * 8);
    }
#pragma unroll
    for (int i = 0; i < 8; ++i) {
        int sp = u.l0 - 128 + 64 * (wave & 3) + 8 * i + (lane >> 3); sp = sp < 0 ? 0 : sp;
        kv[8 + i] = *(const u32x4*)(gq + (u.tb + (size_t)sp * u.dil) * QKVW + 1024 + (u.hp * 2 + (wave >> 2)) * 64 + (lane & 7) * 8);
    }
}
__device__ __forceinline__ void astore_kv(const u32x4 (&kv)[16], LAS unsigned char* lds, int wave, int lane) {
#pragma unroll
    for (int i = 0; i < 8; ++i) *(LAS u32x4*)(lds + KOFF + (wave >> 2) * KHD + (lane & 7) * KCH + (64 * (wave & 3) + 8 * i + (lane >> 3)) * 16) = kv[i];
#pragma unroll
    for (int i = 0; i < 8; ++i) { const int key = 64 * (wave & 3) + 8 * i + (lane >> 3); *(LAS u32x4*)(lds + VOFF + (wave >> 2) * VHD + ((lane & 7) >> 2) * VDH + (key >> 4) * 1024 + (key & 15) * 64 + (lane & 3) * 16) = kv[8 + i]; }
}
__device__ __forceinline__ bf16_t* aqrow(const AUnit& u, bf16_t* qkv, int wave, int r32) {
    const int hd = wave >> 2, qt = wave & 3;
    return qkv + (u.tb + (size_t)(u.l0 + 32 * qt + r32) * u.dil) * QKVW + u.g * 1536 + (u.hp * 2 + hd) * 64;
}

__device__ __forceinline__ void attn_phase(LAS unsigned char* lds, bf16_t* qkv, float* lse, int bid, int G, int wave, bool dry = false) {
    const int per = (NUNITS + G - 1) / G;
    const int u_lo = bid * per, u_hi = (u_lo + per < NUNITS) ? u_lo + per : NUNITS;
    asm volatile("" : "+s"(wave));
    const int lane = lane_id(), r32 = lane & 31, hi = lane >> 5;
    const int hd = wave >> 2, qt = wave & 3;
    u32x4 kv[16]; bf16x8 qn[4];
    AUnit un;
    if (u_lo < u_hi) { adecode(un, u_lo); aload_kv(kv, un, qkv, wave, lane); const bf16_t* q = aqrow(un, qkv, wave, r32);
#pragma unroll
        for (int d0 = 0; d0 < 4; ++d0) qn[d0] = *(const bf16x8*)(q + d0 * 16 + hi * 8); }
#pragma unroll 1
    for (int idx = u_lo; idx < u_hi; ++idx) {
        const AUnit u = un;
        const int g = u.g, l0 = u.l0, head = u.hp * 2 + hd;
        bf16_t* qrow = aqrow(u, qkv, wave, r32);
        const size_t tq = u.tb + (size_t)(l0 + 32 * qt + r32) * u.dil;
        astore_kv(kv, lds, wave, lane);
        bf16x8 qf[4];
#pragma unroll
        for (int d0 = 0; d0 < 4; ++d0) qf[d0] = qn[d0];
        __syncthreads();
        if (idx + 1 < u_hi) { adecode(un, idx + 1); aload_kv(kv, un, qkv, wave, lane); const bf16_t* q = aqrow(un, qkv, wave, r32);
#pragma unroll
            for (int d0 = 0; d0 < 4; ++d0) qn[d0] = *(const bf16x8*)(q + d0 * 16 + hi * 8); }
        f32x16 p[5];
        const LAS unsigned char* kb = lds + KOFF + hd * KHD + hi * KCH + (qt * 32 + r32) * 16;
#pragma unroll
        for (int j = 0; j < 5; ++j) {
#pragma unroll
            for (int rr = 0; rr < 16; ++rr) p[j][rr] = 0.f;
#pragma unroll
            for (int d0 = 0; d0 < 4; ++d0) {
                const bf16x8 kf = *(const LAS bf16x8*)(kb + j * 512 + d0 * 2 * KCH);
                p[j] = __builtin_amdgcn_mfma_f32_32x32x16_bf16(kf, qf[d0], p[j], 0, 0, 0);
            }
        }
#pragma unroll
        for (int rr = 0; rr < 16; ++rr) { const int c = crow(rr, hi); if (c < r32) p[0][rr] = -INFINITY; if (c > r32) p[4][rr] = -INFINITY; }
        if (l0 == 0) {
#pragma unroll
            for (int j = 0; j < 5; ++j)
#pragma unroll
                for (int rr = 0; rr < 16; ++rr) if (32 * (qt + j) + crow(rr, hi) < 128) p[j][rr] = -INFINITY;
        }
        float m = p[0][0];
#pragma unroll
        for (int j = 0; j < 5; ++j)
#pragma unroll
            for (int rr = 0; rr < 16; ++rr) m = fmaxf(m, p[j][rr]);
        m = xhalf_max(m);
        float l = 0.f;
#pragma unroll
        for (int j = 0; j < 5; ++j)
#pragma unroll
            for (int rr = 0; rr < 16; ++rr) { const float e = __builtin_amdgcn_exp2f(p[j][rr] - m); p[j][rr] = e; l += e; }
        l = xhalf_sum(l);
        f32x16 o[2];
#pragma unroll
        for (int rr = 0; rr < 16; ++rr) { o[0][rr] = 0.f; o[1][rr] = 0.f; }
        const LAS unsigned char* vb = lds + VOFF + hd * VHD + ((lane >> 4) & 1) * 32 + (lane & 3) * 8 + (4 * hi + ((lane & 15) >> 2)) * 64 + qt * 2048;
#pragma unroll
        for (int j = 0; j < 5; ++j)
#pragma unroll
            for (int s = 0; s < 2; ++s) {
                u32x4 pw; pw.x = pg8::cvt_pk_bf16(p[j][8 * s + 0], p[j][8 * s + 1]); pw.y = pg8::cvt_pk_bf16(p[j][8 * s + 2], p[j][8 * s + 3]);
                pw.z = pg8::cvt_pk_bf16(p[j][8 * s + 4], p[j][8 * s + 5]); pw.w = pg8::cvt_pk_bf16(p[j][8 * s + 6], p[j][8 * s + 7]);
                const bf16x8 pf = __builtin_bit_cast(bf16x8, pw);
#pragma unroll
                for (int d0 = 0; d0 < 2; ++d0) {
                    const s16x4 vlo = vtr(vb + d0 * VDH + (2 * j + s) * 1024), vhi = vtr(vb + d0 * VDH + (2 * j + s) * 1024 + 512);
                    const bf16x8 vf = {vlo[0], vlo[1], vlo[2], vlo[3], vhi[0], vhi[1], vhi[2], vhi[3]};
                    o[d0] = __builtin_amdgcn_mfma_f32_32x32x16_bf16(vf, pf, o[d0], 0, 0, 0);
                }
            }
        const float inv = 1.0f / l;
#pragma unroll
        for (int d0 = 0; d0 < 2; ++d0)
#pragma unroll
            for (int rg = 0; rg < 4; ++rg) {
                u32x2 w; w.x = pg8::cvt_pk_bf16(o[d0][4 * rg] * inv, o[d0][4 * rg + 1] * inv); w.y = pg8::cvt_pk_bf16(o[d0][4 * rg + 2] * inv, o[d0][4 * rg + 3] * inv);
                if (!dry) *(u32x2*)(qrow + d0 * 32 + 8 * rg + 4 * hi) = w; else asm volatile("" :: "v"(w.x), "v"(w.y));
            }
        if (hi == 0 && !dry) lse[tq * 24 + g * 8 + head] = m + __builtin_amdgcn_logf(l);
        __syncthreads();
    }
}
}

typedef const __attribute__((address_space(4))) unsigned long long* kargp_t;
__device__ __forceinline__ kargp_t karg() { kargp_t p = (kargp_t)__builtin_amdgcn_kernarg_segment_ptr(); asm volatile("" : "+s"(p)); return p; }
#define KIN(i) ((const float*)(GAS const float*)karg()[i])
#define KOUT() ((float*)(GAS float*)karg()[19])
#define KWS() ((unsigned char*)(GAS unsigned char*)karg()[20])
#define WSP(type, off) ((type*)(KWS() + (off)))
struct Args { const float* in[19]; float* out; unsigned char* ws; int ph_lo, ph_hi; };
constexpr int NPHASE = 17;

__global__ void __launch_bounds__(NWAVES * 64, 2) mk_fwd(Args args) {
    extern __shared__ __attribute__((aligned(16))) unsigned char lds_raw[];
    LAS unsigned char* lds = (LAS unsigned char*)lds_raw;
    volatile LAS unsigned* MISC = (volatile LAS unsigned*)(lds + MISC_OFF);
    LAS int* rb = (LAS int*)(lds + MISC_OFF);
    const int wave = __builtin_amdgcn_readfirstlane((int)threadIdx.x >> 6);
#define IDS() const int lane = lane_id(), tid = wave * 64 + lane; (void)tid; (void)lane
    const int G = gridDim.x, bid = blockIdx.x;
    for (int u = threadIdx.x; u < (LDS_BYTES - MISC_OFF) / 4; u += NWAVES * 64) MISC[u] = 0u;
    __syncthreads();
#if MK_ONE_LAUNCH
    XcdBarrier bar = xcd_barrier_post((unsigned*)(KWS() + WS_CTL) + CW_BAR, MISC + 40, wave);
#define GRID_BAR() xcd_barrier(bar, wave)
#else
#define GRID_BAR() do { } while (0)
#endif
    const int lo = args.ph_lo, hi = args.ph_hi;
#ifndef PHMASK
#define PHMASK 0xFFFFFFFFu
#endif
#define IN(k) ((((PHMASK) >> (k)) & 1u) && lo <= (k) && (k) < hi)
#ifndef REPMASK
#define REPMASK 0u
#endif
#define REPS(k) ((((REPMASK) >> (k)) & 1u) ? 2 : 1)
#define SEAM(k) do { if (IN(k) && IN((k) + 1)) GRID_BAR(); } while (0)

    for (int rep_ = 0; rep_ < REPS(0); ++rep_) if (IN(0)) { IDS();
        const float* cin = KIN(1); const float* ada_w = KIN(4); const float* ada_b = KIN(5); float* mod = WSP(float, WS_MOD); float* rope = WSP(float, WS_ROPE);
        LAS float* cact = (LAS float*)lds; LAS float* red = cact + 16384;
        if (bid < 192) for (int i = tid; i < 16 * 1024; i += 512) { const float v = cin[i]; cact[i] = v / (1.f + expf(-v)); }
        __syncthreads();
        for (int item = bid; item < 192; item += G) {
            const int l = item / 96, n0 = (item % 96) * 64, kg = tid >> 6, n = tid & 63;
            float acc[16];
#pragma unroll
            for (int b = 0; b < 16; ++b) acc[b] = 0.f;
            const float* w = ada_w + (size_t)l * 1024 * 6144 + n0 + n;
#pragma unroll 1
            for (int k = kg * 128; k < kg * 128 + 128; k += 16) {
                float wv[16];
#pragma unroll
                for (int u = 0; u < 16; ++u) wv[u] = w[(size_t)(k + u) * 6144];
#pragma unroll
                for (int u = 0; u < 16; ++u)
#pragma unroll
                    for (int b = 0; b < 16; ++b) acc[b] += cact[b * 1024 + k + u] * wv[u];
            }
#pragma unroll
            for (int b = 0; b < 16; ++b) red[(kg * 16 + b) * 64 + n] = acc[b];
            __syncthreads();
            for (int i = tid; i < 1024; i += 512) {
                const int b = i >> 6, nn = i & 63; float s = 0.f;
#pragma unroll
                for (int q = 0; q < 8; ++q) s += red[(q * 16 + b) * 64 + nn];
                mod[((size_t)l * 16 + b) * 6144 + n0 + nn] = s + ada_b[l * 6144 + n0 + nn];
            }
            __syncthreads();
        }
        for (int i = bid * 512 + tid; i < 4096 * 8; i += G * 512) {
            const int t = i >> 3, f = i & 7;
            const float inv = powf(500000.0f, -(float)(2 * f) / 16.0f);
            const float ang = (float)t * inv;
            rope[i] = (float)cos((double)ang);
            rope[4096 * 8 + i] = (float)sin((double)ang);
        }
        __syncthreads();
        LAS float* scr = (LAS float*)(lds + wave * 16640);
        const float* conv_in_w = KIN(6); const float* conv_out_w = KIN(8); const float* attn_in_w = KIN(9); const float* attn_out_w = KIN(10);
        const float* gate_w = KIN(15); const float* up_w = KIN(16); const float* down_w = KIN(17);
        bf16_t* WZ = WSP(bf16_t, WS_WZ); bf16_t* WB = WSP(bf16_t, WS_WB); bf16_t* WCO = WSP(bf16_t, WS_WCO); bf16_t* WAI = WSP(bf16_t, WS_WAI); bf16_t* WAO = WSP(bf16_t, WS_WAO);
        bf16_t* WGU = WSP(bf16_t, WS_WGU); bf16_t* WDN = WSP(bf16_t, WS_WDN);
#define CONV_DECODE(DD, IT) do { int it = (IT); \
            if (it < 512) { conv_desc(DD, conv_in_w, 3072, 1024, WZ, 1024, 1, it / 32, it % 32); break; } it -= 512; \
            if (it < 256) { conv_desc(DD, conv_in_w, 3072, 0, WB, 1024, 0, it / 16, it % 16); break; } it -= 256; \
            if (it < 256) { conv_desc(DD, conv_out_w, 1024, 0, WCO, 1024, 0, it / 16, it % 16); break; } it -= 256; \
            if (it < 1152) { conv_desc(DD, attn_in_w, QKVW, 0, WAI, 1024, 2, it / 72, it % 72); break; } it -= 1152; \
            if (it < 128) { conv_desc(DD, attn_out_w, 1024, 0, WAO, 512, 0, it / 16, it % 16); break; } it -= 128; \
            const int le = it / 384, r = it % 384; \
            if (r < 128) conv_desc(DD, gate_w + (size_t)le * D * DEXP, DEXP, 0, WGU + (size_t)le * 1024 * 1024, 1024, 3, r / 8, r % 8); \
            else if (r < 256) conv_desc(DD, up_w + (size_t)le * D * DEXP, DEXP, 0, WGU + (size_t)le * 1024 * 1024, 1024, 4, (r - 128) / 8, (r - 128) % 8); \
            else conv_desc(DD, down_w + (size_t)le * DEXP * D, D, 0, WDN + (size_t)le * 1024 * 512, 512, 0, (r - 256) / 16, (r - 256) % 16); } while (0)
        {
            const int step = G * NWAVES; int it0 = bid * NWAVES + wave;
            ConvDesc dA, dB; f32x4 vA[16], vB[16];
            if (it0 < NCONV_ITEMS) { CONV_DECODE(dA, it0); conv_load(vA, dA, lane); }
#pragma unroll 1
            for (; it0 < NCONV_ITEMS; it0 += 2 * step) {
                const bool hasB = it0 + step < NCONV_ITEMS, hasA2 = it0 + 2 * step < NCONV_ITEMS;
                if (hasB) { CONV_DECODE(dB, it0 + step); conv_load(vB, dB, lane); }
                conv_process(vA, dA, scr, lane);
                if (hasA2) { CONV_DECODE(dA, it0 + 2 * step); conv_load(vA, dA, lane); }
                if (hasB) conv_process(vB, dB, scr, lane);
            }
        }
#undef CONV_DECODE
    }
    SEAM(0);
    for (int rep_ = 0; rep_ < REPS(1); ++rep_) if (IN(1)) { IDS();
        const float* x = KIN(0); const float* norm_mix_g = KIN(2); const float* mod = WSP(float, WS_MOD); bf16_t* xn = WSP(bf16_t, WS_XN);
        for (int w0 = (bid * 8 + wave) * 32; w0 < T; w0 += G * 8 * 32) {
            const float* mb = mod + (size_t)(w0 >> 12) * 6144;
            ModV mv; mod_load(mv, norm_mix_g, mb + 0, mb + 1024, lane);
            RowV r; row_load(r, x + (size_t)w0 * D, lane);
#pragma unroll 1
            for (int i = 0; i < 32; ++i) {
                const int row = w0 + i;
                RowV nx; if (i < 31) row_load(nx, x + (size_t)(row + 1) * D, lane); else nx = r;
                const float rstd = row_rstd(r);
                row_apply(r, rstd, mv);
                row_store_bf16(r, xn + (size_t)row * D, lane);
                r = nx;
            }
        }
    }
    SEAM(1);
    for (int rep_ = 0; rep_ < REPS(2); ++rep_) if (IN(2)) { bf16_t* xn = WSP(bf16_t, WS_XN); bf16_t* WZ = WSP(bf16_t, WS_WZ); bf16_t* zb = WSP(bf16_t, WS_Z);
        pg8::Gemm g{xn, WZ, T, 2048, 1024}; pg8::StaticOrder S; S.init(T, 2048, G, bid); pg8::EpiPair<false> E{zb, D};
        pg8::gemm_phase<pg8::EpiPair<false>, pg8::StaticOrder, pg8::APlain, true, true>(lds, g, S, E, pg8::APlain{}, wave); }
    SEAM(2);
    for (int rep_ = 0; rep_ < REPS(3); ++rep_) if (IN(3)) { bf16_t* xn = WSP(bf16_t, WS_XN); bf16_t* WB = WSP(bf16_t, WS_WB); bf16_t* zb = WSP(bf16_t, WS_Z); bf16_t* ypre = WSP(bf16_t, WS_YPRE); const float* conv_w = KIN(7);
        pg8::Gemm g{xn, WB, T, 1024, 1024}; pg8::StaticOrder S; S.init(T, 1024, G, bid); pg8::EpiYpre E{ypre, zb, conv_w};
        pg8::gemm_phase<pg8::EpiYpre, pg8::StaticOrder, pg8::APlain, true, true>(lds, g, S, E, pg8::APlain{}, wave); }
    SEAM(3);
    for (int rep_ = 0; rep_ < REPS(4); ++rep_) if (IN(4)) { bf16_t* ypre = WSP(bf16_t, WS_YPRE); bf16_t* WCO = WSP(bf16_t, WS_WCO); bf16_t* xr = (bf16_t*)KOUT(); const float* x = KIN(0); const float* mod = WSP(float, WS_MOD);
        pg8::Gemm g{ypre, WCO, T, 1024, 1024}; pg8::StaticOrder S; S.init(T, 1024, G, bid); pg8::EpiRes<true> E{xr, x, mod + 2048};
        pg8::gemm_phase<pg8::EpiRes<true>, pg8::StaticOrder, pg8::APlain, true, true>(lds, g, S, E, pg8::APlain{}, wave); }
    SEAM(4);
#pragma unroll 1
    for (int l = 0; l < 2; ++l) {
        const int pb0 = (l == 0) ? 5 : 13;
#define MODL() (WSP(float, WS_MOD) + (size_t)l * 16 * 6144)
#define CNTL() (WSP(int, WS_CTL) + 64 * l)
        if (l == 1) {
            for (int rep_ = 0; rep_ < REPS(9); ++rep_) if (IN(9)) { bf16_t* xn = WSP(bf16_t, WS_XN); bf16_t* WAI = WSP(bf16_t, WS_WAI); bf16_t* qkv = WSP(bf16_t, WS_QKV); const float* rope = WSP(float, WS_ROPE);
                pg8::Gemm g{xn, WAI, T, QKVW, 1024}; pg8::StaticOrder S; S.init(T, QKVW, G, bid); pg8::EpiQKV E{qkv, rope};
                pg8::gemm_phase<pg8::EpiQKV, pg8::StaticOrder, pg8::APlain, true, true>(lds, g, S, E, pg8::APlain{}, wave); }
            SEAM(9);
            for (int rep_ = 0; rep_ < REPS(10); ++rep_) if (IN(10)) att::attn_phase(lds, WSP(bf16_t, WS_QKV), WSP(float, WS_LSE), bid, G, wave, rep_ + 1 < REPS(10));
            SEAM(10);
            for (int rep_ = 0; rep_ < REPS(11); ++rep_) if (IN(11)) { IDS(); attn_comb(WSP(bf16_t, WS_QKV), WSP(float, WS_LSE), WSP(bf16_t, WS_XN), bid, G, tid); }
            SEAM(11);
            if (IN(12)) { bf16_t* ob = WSP(bf16_t, WS_XN); bf16_t* WAO = WSP(bf16_t, WS_WAO); bf16_t* xr = (bf16_t*)KOUT();
                pg8::Gemm g{ob, WAO, T, 1024, 512}; pg8::StaticOrder S; S.init(T, 1024, G, bid); pg8::EpiRes<false> E{xr, nullptr, MODL() + 2048};
                pg8::gemm_phase<pg8::EpiRes<false>, pg8::StaticOrder, pg8::APlain, true, true>(lds, g, S, E, pg8::APlain{}, wave); }
            SEAM(12);
        }
        for (int rep_ = 0; rep_ < REPS(5); ++rep_) if (IN(pb0)) { IDS(); const bool dry = rep_ + 1 < REPS(5);
            LAS f32x4* TG = (LAS f32x4*)lds; LAS f32x4* TE = (LAS f32x4*)(lds + 16384);
            LAS int* rec_e = (LAS int*)(lds + 147456); LAS float* rec_w = (LAS float*)(lds + 147456 + 2048); LAS int* rec_rank = (LAS int*)(lds + 147456 + 4096);
            LAS int* hist = (LAS int*)(lds + 147456 + 6144); LAS int* base = (LAS int*)(lds + 147456 + 6144 + 128);
            const float* gff = KIN(3) + l * D; const float* wg = KIN(11) + (size_t)l * D * 4; const float* bg = KIN(12) + l * 4; const float* we = KIN(13) + (size_t)l * 4 * D * 8; const float* be = KIN(14) + l * 32;
            const bf16_t* xr = (const bf16_t*)KOUT(); const float* modl = MODL(); int* cntl = CNTL(); bf16_t* xn = WSP(bf16_t, WS_XN); int* ltok = WSP(int, WS_LTOK); float* lw = WSP(float, WS_LW); int* tslot = WSP(int, WS_TSLOT);
            for (int i = tid; i < 1024; i += 512) { const int ln = i & 63, jc = i >> 6, k = 4 * ln + 256 * (jc >> 2) + (jc & 3); TG[i] = *(const f32x4*)(wg + (size_t)k * 4); }
            for (int i = tid; i < 8192; i += 512) { const int ln = i & 63, jc = (i >> 6) & 15, half = (i >> 10) & 1, gi = i >> 11, k = 4 * ln + 256 * (jc >> 2) + (jc & 3);
                TE[i] = *(const f32x4*)(we + ((size_t)gi * 1024 + k) * 8 + half * 4); }
            __syncthreads();
            const bool h5 = (lane & 32) != 0, h4 = (lane & 16) != 0, h3 = (lane & 8) != 0;
            for (int blk = bid; blk < T / 256; blk += G) {
                if (tid < 32) hist[tid] = 0;
                __syncthreads();
                ModV mv; { const float* mb = modl + (size_t)((blk * 256) >> 12) * 6144; mod_load(mv, gff, mb + 3072, mb + 4096, lane); }
                RowV r; row_load_bf16(r, xr + (size_t)(blk * 256 + wave * 32) * XRP, lane);
#pragma unroll 1
                for (int i = 0; i < 32; ++i) {
                    const int rl = wave * 32 + i, row = blk * 256 + rl;
                    RowV nx; if (i < 31) row_load_bf16(nx, xr + (size_t)(row + 1) * XRP, lane); else nx = r;
                    const float rstd = row_rstd(r);
                    row_apply(r, rstd, mv);
                    row_store_bf16(r, xn + (size_t)row * D, lane);
                    f32x4 pg = {0.f, 0.f, 0.f, 0.f};
#pragma unroll
                    for (int jc = 0; jc < 16; ++jc) pg += TG[jc * 64 + lane] * r.v[jc >> 2][jc & 3];
                    float gl[4];
                    { float b0 = (h5 ? pg.z : pg.x) + __shfl_xor(h5 ? pg.x : pg.z, 32), b1 = (h5 ? pg.w : pg.y) + __shfl_xor(h5 ? pg.y : pg.w, 32);
                      float c = (h4 ? b1 : b0) + __shfl_xor(h4 ? b0 : b1, 16);
                      c += __shfl_xor(c, 8); c += __shfl_xor(c, 4); c += __shfl_xor(c, 2); c += __shfl_xor(c, 1);
#pragma unroll
                      for (int o = 0; o < 4; ++o) gl[o] = __int_as_float(__builtin_amdgcn_readlane(__float_as_int(c), 16 * o)) + bg[o]; }
                    int gi = 0; float gm = gl[0];
#pragma unroll
                    for (int o = 1; o < 4; ++o) if (gl[o] > gm) { gm = gl[o]; gi = o; }
                    float gden = 0.f;
#pragma unroll
                    for (int o = 0; o < 4; ++o) gden += expf(gl[o] - gm);
                    const float grp_p = 1.0f / gden;
                    f32x4 pa = {0.f, 0.f, 0.f, 0.f}, pb = {0.f, 0.f, 0.f, 0.f};
                    const LAS f32x4* te = TE + gi * 2048 + lane;
#pragma unroll
                    for (int jc = 0; jc < 16; ++jc) { const float hv = r.v[jc >> 2][jc & 3]; pa += te[jc * 64] * hv; pb += te[1024 + jc * 64] * hv; }
                    float el[8];
                    { const f32x4 keep = h5 ? pb : pa, send = h5 ? pa : pb;
                      f32x4 q; q.x = keep.x + __shfl_xor(send.x, 32); q.y = keep.y + __shfl_xor(send.y, 32); q.z = keep.z + __shfl_xor(send.z, 32); q.w = keep.w + __shfl_xor(send.w, 32);
                      const float b0 = (h4 ? q.z : q.x) + __shfl_xor(h4 ? q.x : q.z, 16), b1 = (h4 ? q.w : q.y) + __shfl_xor(h4 ? q.y : q.w, 16);
                      float c = (h3 ? b1 : b0) + __shfl_xor(h3 ? b0 : b1, 8);
                      c += __shfl_xor(c, 4); c += __shfl_xor(c, 2); c += __shfl_xor(c, 1);
#pragma unroll
                      for (int o = 0; o < 8; ++o) el[o] = __int_as_float(__builtin_amdgcn_readlane(__float_as_int(c), 8 * o)) + be[gi * 8 + o]; }
                    int i0 = 0; float m0 = el[0];
#pragma unroll
                    for (int o = 1; o < 8; ++o) if (el[o] > m0) { m0 = el[o]; i0 = o; }
                    int i1 = -1; float m1 = -INFINITY;
#pragma unroll
                    for (int o = 0; o < 8; ++o) if (o != i0 && el[o] > m1) { m1 = el[o]; i1 = o; }
                    const float p1 = expf(m1 - m0);
                    if (lane == 0) { rec_e[rl * 2] = gi * 8 + i0; rec_e[rl * 2 + 1] = gi * 8 + i1; rec_w[rl * 2] = grp_p / (1.0f + p1); rec_w[rl * 2 + 1] = grp_p * p1 / (1.0f + p1); }
                    r = nx;
                }
                __syncthreads();
                { const int e = rec_e[tid]; rec_rank[tid] = atomicAdd((int*)&hist[e], 1); }
                __syncthreads();
                if (tid < 32) { const int h = hist[tid]; base[tid] = (h && !dry) ? atomicAdd(&cntl[tid], h) : 0; }
                __syncthreads();
                { const int e = rec_e[tid], pos = base[e] + rec_rank[tid], tok = blk * 256 + (tid >> 1);
                  if (!dry) { ltok[(size_t)e * LISTCAP + pos] = tok; lw[(size_t)e * LISTCAP + pos] = rec_w[tid]; tslot[tok * 2 + (tid & 1)] = (e << 16) | pos; } }
                __syncthreads();
            }
        }
        SEAM(pb0);
        if (IN(pb0 + 1) || IN(pb0 + 2) || IN(pb0 + 3)) {
            __syncthreads();
            if (wave == 0 && lane_id() == 0) { const int* cntl = CNTL(); int s = 0;
#pragma unroll 1
                for (int e = 0; e < 32; ++e) { rb[e] = s; s += (__hip_atomic_load(&cntl[e], RLX_AGENT) + 255) & ~255; }
                rb[32] = s; }
            __syncthreads();
        }
        for (int rep_ = 0; rep_ < REPS(6); ++rep_) if (IN(pb0 + 1)) { bf16_t* xn = WSP(bf16_t, WS_XN); bf16_t* WGU = WSP(bf16_t, WS_WGU); bf16_t* act = WSP(bf16_t, WS_ACT); const int* ltok = WSP(int, WS_LTOK); const int* cntl = CNTL();
            pg8::Gemm g{xn, WGU + (size_t)l * 32 * 1024 * 1024, 0, 0, 1024}; pg8::MoeOrder S; S.init(rb[32] / 256, G, bid, rb); pg8::EpiPair<true> E{act, DEXP}; pg8::AGather am{ltok, cntl, rb};
            pg8::gemm_phase<pg8::EpiPair<true>, pg8::MoeOrder, pg8::AGather, true, true>(lds, g, S, E, am, wave); }
        SEAM(pb0 + 1);
        for (int rep_ = 0; rep_ < REPS(7); ++rep_) if (IN(pb0 + 2)) { bf16_t* act = WSP(bf16_t, WS_ACT); bf16_t* WDN = WSP(bf16_t, WS_WDN); bf16_t* yw = WSP(bf16_t, WS_YW); const float* lw = WSP(float, WS_LW);
            pg8::Gemm g{act, WDN + (size_t)l * 32 * 1024 * 512, 0, 0, 512}; pg8::MoeOrder S; S.init(rb[32] / 256, G, bid, rb); pg8::EpiDown E{yw, lw, rb};
            pg8::gemm_phase<pg8::EpiDown, pg8::MoeOrder, pg8::APlain, true, true>(lds, g, S, E, pg8::APlain{}, wave); }
        SEAM(pb0 + 2);
        for (int rep_ = 0; rep_ < REPS(8); ++rep_) if (IN(pb0 + 3)) { IDS(); const bool dry = rep_ + 1 < REPS(8);
            const float* gnext = (l == 0) ? KIN(2) + D : KIN(18);
            const float* modn = WSP(float, WS_MOD) + (size_t)16 * 6144; const float* modl = MODL();
            float* outf = KOUT(); bf16_t* xr = (bf16_t*)KOUT(); const bf16_t* yw = WSP(bf16_t, WS_YW); const int* tslot = WSP(int, WS_TSLOT); bf16_t* xn = WSP(bf16_t, WS_XN);
            for (int w0 = (bid * 8 + wave) * 32; w0 < T; w0 += G * 8 * 32) {
                const int b = w0 >> 12;
                f32x4 g2v[4];
#pragma unroll
                for (int j = 0; j < 4; ++j) g2v[j] = *(const f32x4*)(modl + (size_t)b * 6144 + 5120 + 4 * lane + 256 * j);
                ModV mv;
                if (l == 0) { const float* mb = modn + (size_t)b * 6144; mod_load(mv, gnext, mb + 0, mb + 1024, lane); }
                else {
#pragma unroll
                    for (int j = 0; j < 4; ++j) { mv.gp[j] = *(const f32x4*)(gnext + 4 * lane + 256 * j); mv.sh[j] = (f32x4){0.f, 0.f, 0.f, 0.f}; }
                }
                RowV r; u32x2 ya[4], yb[4];
#define R2_LOAD(R_, YA_, YB_, ROW_) do { const int s0_ = tslot[(ROW_) * 2], s1_ = tslot[(ROW_) * 2 + 1]; \
                    const size_t r0_ = (size_t)(rb[s0_ >> 16] + (s0_ & 0xffff)), r1_ = (size_t)(rb[s1_ >> 16] + (s1_ & 0xffff)); \
                    row_load_bf16(R_, xr + (size_t)(ROW_) * XRP, lane); \
                    _Pragma("unroll") for (int j = 0; j < 4; ++j) { YA_[j] = *(const u32x2*)(yw + r0_ * D + 4 * lane + 256 * j); YB_[j] = *(const u32x2*)(yw + r1_ * D + 4 * lane + 256 * j); } } while (0)
                R2_LOAD(r, ya, yb, w0);
#pragma unroll 1
                for (int i = 0; i < 32; ++i) {
                    const int row = w0 + i;
                    RowV nx; u32x2 na[4], nb[4];
                    if (i < 31) { R2_LOAD(nx, na, nb, row + 1); } else { nx = r;
#pragma unroll
                        for (int j = 0; j < 4; ++j) { na[j] = ya[j]; nb[j] = yb[j]; } }
#pragma unroll
                    for (int j = 0; j < 4; ++j) {
                        f32x4 y; y.x = bflo(ya[j].x) + bflo(yb[j].x); y.y = bfhi(ya[j].x) + bfhi(yb[j].x); y.z = bflo(ya[j].y) + bflo(yb[j].y); y.w = bfhi(ya[j].y) + bfhi(yb[j].y);
                        r.v[j] = r.v[j] + g2v[j] * y;
                    }
                    const float rstd = row_rstd(r);
                    if (dry) { asm volatile("" :: "v"(rstd), "v"(r.v[0].x), "v"(r.v[1].y), "v"(r.v[2].z), "v"(r.v[3].w)); }
                    else if (l == 1) { row_apply(r, rstd, mv); row_store_f32(r, outf + (size_t)row * D, lane); }
                    else { row_store_bf16(r, xr + (size_t)row * XRP, lane); row_apply(r, rstd, mv); row_store_bf16(r, xn + (size_t)row * D, lane); }
                    r = nx;
#pragma unroll
                    for (int j = 0; j < 4; ++j) { ya[j] = na[j]; yb[j] = nb[j]; }
                }
#undef R2_LOAD
            }
        }
        SEAM(pb0 + 3);
    }
#undef IDS
#undef MODL
#undef CNTL
#undef IN
#undef SEAM
#undef GRID_BAR
}

extern "C" void kernel_launch(void* const* d_in, const int* in_sizes, int n_in, void* d_out, int out_size, void* d_ws, size_t ws_size, hipStream_t stream) {
    static int grid = 0;
    if (grid == 0) {
        if (n_in != 19 || out_size != T * D || ws_size < WS_END) { fprintf(stderr, "kernel_launch: unexpected shapes (n_in %d out %d ws %zu)\n", n_in, out_size, ws_size); grid = -1; return; }
        int dev = 0, cus = 0;
        if (hipGetDevice(&dev) != hipSuccess || hipDeviceGetAttribute(&cus, hipDeviceAttributeMultiprocessorCount, dev) != hipSuccess) { grid = -1; return; }
        if (hipFuncSetAttribute((const void*)mk_fwd, hipFuncAttributeMaxDynamicSharedMemorySize, LDS_BYTES) != hipSuccess) { fprintf(stderr, "kernel_launch: hipFuncSetAttribute failed\n"); grid = -1; return; }
        int per_cu = 0;
        if (hipOccupancyMaxActiveBlocksPerMultiprocessor(&per_cu, (const void*)mk_fwd, NWAVES * 64, LDS_BYTES) != hipSuccess || per_cu < 1) fprintf(stderr, "kernel_launch: occupancy query says %d\n", per_cu);
        (void)hipGetLastError();
        grid = cus;
    }
    if (grid < 0) return;
    (void)hipMemsetAsync((char*)d_ws + WS_CTL, 0, CTL_BYTES, stream);
    Args a{};
    for (int i = 0; i < 19; ++i) a.in[i] = (const float*)d_in[i];
    a.out = (float*)d_out; a.ws = (unsigned char*)d_ws;
#if MK_ONE_LAUNCH
    a.ph_lo = 0; a.ph_hi = NPHASE;
    hipLaunchKernelGGL(mk_fwd, dim3(grid), dim3(NWAVES * 64), LDS_BYTES, stream, a);
#else
    for (int p = 0; p < NPHASE; ++p) { a.ph_lo = p; a.ph_hi = p + 1; hipLaunchKernelGGL(mk_fwd, dim3(grid), dim3(NWAVES * 64), LDS_BYTES, stream, a); }
#endif
}
```

```cpp
#include <hip/hip_runtime.h>
#include <stdint.h>
#include <math.h>
#include <cstdio>

#ifndef MK_ONE_LAUNCH
#define MK_ONE_LAUNCH 1
#endif

typedef unsigned short bf16_t;
typedef float f32x4 __attribute__((ext_vector_type(4)));
typedef unsigned u32x2 __attribute__((ext_vector_type(2)));
typedef unsigned u32x4 __attribute__((ext_vector_type(4)));
#define GAS __attribute__((address_space(1)))
#define LAS __attribute__((address_space(3)))
typedef GAS unsigned gu32;
#define RLX_AGENT __ATOMIC_RELAXED, __HIP_MEMORY_SCOPE_AGENT

constexpr int D = 1024, BATCH = 16, SEQ = 4096, T = BATCH * SEQ;
constexpr int NEXP = 32, DEXP = 512, EPG = 8, NGRP = 4;
constexpr int QKVW = 4608;
constexpr int LISTCAP = 65536;
constexpr int PADROWS = 139264;
constexpr float EPS = 1e-6f;
constexpr float QSCALE = 0.125f * 1.4426950408889634f;
constexpr int NWAVES = 8;
constexpr int XRP = 2048;

constexpr size_t MiB = 1u << 20;
constexpr size_t WS_CTL = 0;
constexpr size_t CTL_BYTES = 1 * MiB;
constexpr int CW_BAR = 4096;
constexpr size_t WS_MOD = 1 * MiB;
constexpr size_t WS_ROPE = 3 * MiB;
constexpr size_t WS_LTOK = 4 * MiB;
constexpr size_t WS_LW = 12 * MiB;
constexpr size_t WS_TSLOT = 20 * MiB;
constexpr size_t WS_LSE = 24 * MiB;
constexpr size_t WS_WZ = 32 * MiB;
constexpr size_t WS_WB = 36 * MiB;
constexpr size_t WS_WCO = 38 * MiB;
constexpr size_t WS_WAI = 40 * MiB;
constexpr size_t WS_WAO = 49 * MiB;
constexpr size_t WS_WGU = 64 * MiB;
constexpr size_t WS_WDN = 192 * MiB;
constexpr size_t WS_XN = 256 * MiB;
constexpr size_t WS_BIG = 384 * MiB;
constexpr size_t WS_Z = WS_BIG, WS_YPRE = WS_BIG + 128 * MiB;
constexpr size_t WS_ACT = WS_BIG, WS_YW = WS_BIG + 136 * MiB;
constexpr size_t WS_QKV = WS_BIG;
constexpr size_t WS_END = WS_BIG + 576 * MiB;

constexpr int RING_BYTES = 162816;
constexpr int MISC_OFF = RING_BYTES;
constexpr int LDS_BYTES = RING_BYTES + 1024;

__device__ __forceinline__ unsigned f2bf(float f) { unsigned u = __float_as_uint(f); return (u + 0x7fffu + ((u >> 16) & 1u)) >> 16; }
__device__ __forceinline__ unsigned pk2(float lo, float hi) { return f2bf(lo) | (f2bf(hi) << 16); }
__device__ __forceinline__ float bf2f(unsigned h) { return __uint_as_float(h << 16); }
__device__ __forceinline__ float bflo(unsigned w) { return __uint_as_float(w << 16); }
__device__ __forceinline__ float bfhi(unsigned w) { return __uint_as_float(w & 0xffff0000u); }
template <int M> __device__ __forceinline__ float xlane(float v) {
    return __int_as_float(__builtin_amdgcn_ds_swizzle(__float_as_int(v), (M << 10) | 0x1f));
}
__device__ __forceinline__ float xlane32(float v, bool hi) {
    auto rr = __builtin_amdgcn_permlane32_swap(__float_as_uint(v), __float_as_uint(v), false, false); return __uint_as_float(hi ? rr[0] : rr[1]);
}
__device__ __forceinline__ float wave_sum(float v) {
    v += xlane<1>(v); v += xlane<2>(v); v += xlane<4>(v); v += xlane<8>(v); v += xlane<16>(v);
    auto rr = __builtin_amdgcn_permlane32_swap(__float_as_uint(v), __float_as_uint(v), false, false);
    return __uint_as_float(rr[0]) + __uint_as_float(rr[1]);
}
__device__ __forceinline__ float silu_f(float x) { return x / (1.0f + __expf(-x)); }
#define LDS_WAIT() asm volatile("s_waitcnt lgkmcnt(0)" ::: "memory")
__device__ __forceinline__ int lane_id() { int l; asm volatile("v_mbcnt_lo_u32_b32 %0, -1, 0\n\tv_mbcnt_hi_u32_b32 %0, -1, %0" : "=v"(l)); return l; }

namespace pg8 {
#define PG8_LAS __attribute__((address_space(3)))
typedef unsigned short bf16_t;
typedef short bf16x8 __attribute__((ext_vector_type(8)));
typedef float f32x4 __attribute__((ext_vector_type(4)));
typedef unsigned u32x4 __attribute__((ext_vector_type(4)));
constexpr int BM = 256, BK = 64, HALF = 128, HTB = HALF * BK * 2  , STAGE_BYTES = 8 * HTB, NXCD = 8, WGM = 8;

__host__ __device__ __forceinline__ int lds_byte(int r, int c) { const int st = (r >> 4) * 2 + (c >> 5), rr = r & 15, cc = c & 31, ob = rr * 64 + cc * 2; return st * 1024 + (ob ^ (((ob >> 9) & 1) << 5)); }
__host__ __device__ __forceinline__ void stage_rc(int b, int& R, int& C) { const int st = b / 1024, sb = b % 1024, swz = sb ^ (((sb >> 9) & 1) << 5); R = (st >> 1) * 16 + swz / 64; C = (st & 1) * 32 + (swz % 64) / 2; }
__host__ __device__ __forceinline__ int perm32(int rho) { const int n = rho >> 4, i = rho & 15; return 8 * (i >> 2) + 4 * n + (i & 3); }

struct Unit { int pm, pn, pb; };
struct Gemm { const bf16_t* A; const bf16_t* Bt; int M, N, K; };

struct StaticOrder {
    int nM, nN, nwg, G, c;
    __host__ __device__ void init(int M, int N, int G_, int c_) { nM = M / BM; nN = N / BM; nwg = nM * nN; G = G_; c = c_; }
    __host__ __device__ bool next(int i, Unit& u) const {
        const long L = (long)i * G + c; if (L >= nwg) return false;
        int wgid = (int)L; { const int q = nwg / NXCD, r = nwg % NXCD, xcd = wgid % NXCD, off = wgid / NXCD; wgid = (xcd < r ? xcd * (q + 1) : r * (q + 1) + (xcd - r) * q) + off; }
        const int nig = WGM * nN, gid = wgid / nig, fm = gid * WGM, gsz = (nM - fm) < WGM ? (nM - fm) : WGM;
        u.pm = fm + ((wgid % nig) % gsz); u.pn = (wgid % nig) / gsz; u.pb = u.pn; return true;
    }
    __device__ __forceinline__ void a_ready(const Unit&) const {}
    __device__ __forceinline__ void done(const Unit&) const {}
};


__device__ __forceinline__ unsigned cvt_pk_bf16(float lo, float hi) { unsigned r; asm volatile("v_cvt_pk_bf16_f32 %0, %1, %2" : "=v"(r) : "v"(lo), "v"(hi)); return r; }
typedef float f32x2 __attribute__((ext_vector_type(2)));

template <class Epi, class Sched, class AM, bool ALIGN_EPI = false, bool SP2 = false>
__device__ __forceinline__ void gemm_phase(PG8_LAS unsigned char* lds, const Gemm g, const Sched& S, const Epi& E, const AM& am, const int wid_in) {
    int wid = wid_in; asm volatile("" : "+s"(wid));
    const int lane = lane_id(), tid = wid * 64 + lane, wr = wid >> 2, wc = wid & 3, fr = lane & 15, fq = lane >> 4;
    const int K = g.K, nt = K / BK;
    unsigned voffA[2], voffB[2]; int stR[2], stC[2];
#pragma unroll
    for (int i = 0; i < 2; ++i) { int R, C; stage_rc(tid * 16 + i * 8192, R, C); const int Rb = Epi::PERM ? ((R & ~31) + perm32(R & 31)) : R;
        stR[i] = R; stC[i] = C; voffA[i] = (unsigned)(R * K + C) * 2u; voffB[i] = (unsigned)(Rb * K + C) * 2u; }
    const size_t kstep = (size_t)(BK * 2);
    const size_t hstep = (size_t)HALF * K * 2;
    const size_t tstep = 2 * hstep;
    const unsigned ldsw = (unsigned)wid * 1024u;
    const int aoff = lds_byte(wr * 64 + fr, fq * 8), boff = lds_byte(wc * 32 + fr, fq * 8);
#define PG8_SA(b, h) (((b) * 2 + (h)) * HTB)
#define PG8_SB(b, h) ((4 + (b) * 2 + (h)) * HTB)
#define PG8_STAGE(bufoff, gbase, voff) do { _Pragma("unroll") for (int _i = 0; _i < 2; ++_i) \
        __builtin_amdgcn_global_load_lds((const unsigned*)((const char*)(gbase) + (voff)[_i]), (PG8_LAS unsigned*)(lds + (bufoff) + ldsw + _i * 8192), 16, 0, 0); } while (0)
#define PG8_STAGE_A(b, h, gbase, NX) do { if constexpr (AM::GATHER) { const unsigned so_[2] = {(NX) ? gno[h][0] : gao[h][0], (NX) ? gno[h][1] : gao[h][1]}; PG8_STAGE(PG8_SA(b, h), gbase, so_); } \
        else { PG8_STAGE(PG8_SA(b, h), (gbase) + (h) * hstep, voffA); } } while (0)
#define PG8_LDA(dst, b, h) do { _Pragma("unroll") for (int m = 0; m < 4; ++m) _Pragma("unroll") for (int k = 0; k < 2; ++k) dst[m][k] = *(const PG8_LAS bf16x8*)(lds + PG8_SA(b, h) + aoff + m * 2048 + k * 1024); } while (0)
#define PG8_LDB(dst, b, h) do { _Pragma("unroll") for (int n = 0; n < 2; ++n) _Pragma("unroll") for (int k = 0; k < 2; ++k) dst[n][k] = *(const PG8_LAS bf16x8*)(lds + PG8_SB(b, h) + boff + n * 2048 + k * 1024); } while (0)
#define PG8_MMA(ai, bj, At, Bt) do { __builtin_amdgcn_s_setprio(1); _Pragma("unroll") for (int m = 0; m < 4; ++m) _Pragma("unroll") for (int n = 0; n < 2; ++n) _Pragma("unroll") for (int k = 0; k < 2; ++k) \
        acc[ai][bj][m][n] = __builtin_amdgcn_mfma_f32_16x16x32_bf16(Bt[n][k], At[m][k], acc[ai][bj][m][n], 0, 0, 0); __builtin_amdgcn_s_setprio(0); } while (0)
#define PG8_WAIT_V(n) asm volatile("s_waitcnt vmcnt(" #n ")" ::: "memory")
#define PG8_WAIT_L(n) asm volatile("s_waitcnt lgkmcnt(" #n ")" ::: "memory")
#define PG8_BAR __builtin_amdgcn_s_barrier()
#define PG8_SCHED __builtin_amdgcn_sched_barrier(0)
    Unit cur, nxt; int ui = 0;
    if (!S.next(0, cur)) return;
    f32x4 acc[2][2][4][2];
#pragma unroll
    for (int a = 0; a < 2; ++a)
#pragma unroll
        for (int b = 0; b < 2; ++b)
#pragma unroll
            for (int m = 0; m < 4; ++m)
#pragma unroll
                for (int n = 0; n < 2; ++n) acc[a][b][m][n] = (f32x4){0.f, 0.f, 0.f, 0.f};
    bf16x8 At[4][2], B0[2][2], B1[2][2];
    const char* cA = (const char*)g.A + (AM::GATHER ? (size_t)0 : (size_t)cur.pm * tstep); const char* cB = (const char*)g.Bt + (size_t)cur.pb * tstep;
    unsigned gao[2][2], gno[2][2];
    if constexpr (AM::GATHER) { _Pragma("unroll") for (int h = 0; h < 2; ++h) _Pragma("unroll") for (int i = 0; i < 2; ++i) { gao[h][i] = (unsigned)(am.arow(cur, h * HALF + stR[i]) * K + stC[i]) * 2u; gno[h][i] = gao[h][i]; } }
    else { _Pragma("unroll") for (int h = 0; h < 2; ++h) _Pragma("unroll") for (int i = 0; i < 2; ++i) { gao[h][i] = 0u; gno[h][i] = 0u; } }
    S.a_ready(cur);
    if constexpr (SP2) {
        PG8_STAGE(PG8_SB(0, 0), cB, voffB); PG8_STAGE(PG8_SB(0, 1), cB + hstep, voffB); PG8_STAGE_A(0, 0, cA, false); PG8_STAGE_A(0, 1, cA, false);
        if (wr == 1) PG8_BAR;
        PG8_WAIT_V(2); PG8_BAR;
        PG8_STAGE(PG8_SB(1, 0), cB + kstep, voffB); PG8_STAGE_A(1, 0, cA + kstep, false); PG8_STAGE(PG8_SB(1, 1), cB + hstep + kstep, voffB);
        PG8_WAIT_V(6); PG8_BAR;
    } else {
        PG8_STAGE(PG8_SB(0, 0), cB, voffB); PG8_STAGE_A(0, 0, cA, false); PG8_STAGE(PG8_SB(0, 1), cB + hstep, voffB); PG8_STAGE_A(0, 1, cA, false);
        if (wr == 1) PG8_BAR;
        PG8_WAIT_V(4); PG8_BAR;
        PG8_STAGE(PG8_SB(1, 0), cB + kstep, voffB); PG8_STAGE_A(1, 0, cA + kstep, false); PG8_STAGE(PG8_SB(1, 1), cB + hstep + kstep, voffB);
        PG8_WAIT_V(6); PG8_BAR;
    }
    for (;;) {
        const bool has_next = S.next(ui + 1, nxt);
        const char* nA = has_next ? (const char*)g.A + (AM::GATHER ? (size_t)0 : (size_t)nxt.pm * tstep) : cA; const char* nB = has_next ? (const char*)g.Bt + (size_t)nxt.pb * tstep : cB;
        if constexpr (AM::GATHER) { if (has_next) { _Pragma("unroll") for (int h = 0; h < 2; ++h) _Pragma("unroll") for (int i = 0; i < 2; ++i) gno[h][i] = (unsigned)(am.arow(nxt, h * HALF + stR[i]) * K + stC[i]) * 2u; } }
        for (int t = 0; t < nt; t += 2) {
            const bool last = (t == nt - 2);
            const char* a1 = cA + (size_t)(t + 1) * kstep;
            const char* a2 = last ? nA : cA + (size_t)(t + 2) * kstep; const char* b2 = last ? nB : cB + (size_t)(t + 2) * kstep;
            const char* a3 = a2 + kstep; const char* b3 = b2 + kstep;
            if (last && has_next) S.a_ready(nxt);
            if (false) E.prefetch(cur, tid, (PG8_LAS unsigned*)(lds + 162816 + 512));
            if constexpr (SP2) {
            PG8_LDB(B0, 0, 0); PG8_LDB(B1, 0, 1); PG8_SCHED; PG8_LDA(At, 0, 0); PG8_STAGE_A(1, 1, a1, false);
            PG8_WAIT_V(8); PG8_WAIT_L(0); PG8_BAR; PG8_MMA(0, 0, At, B0); PG8_MMA(0, 1, At, B1); PG8_BAR; PG8_SCHED;
            PG8_LDA(At, 0, 1); PG8_STAGE(PG8_SB(0, 0), b2, voffB); PG8_STAGE(PG8_SB(0, 1), b2 + hstep, voffB); PG8_STAGE_A(0, 0, a2, last);
            PG8_WAIT_V(8); PG8_WAIT_L(0); PG8_BAR; PG8_MMA(1, 0, At, B0); PG8_MMA(1, 1, At, B1); PG8_BAR; PG8_SCHED;
            PG8_LDB(B0, 1, 0); PG8_LDB(B1, 1, 1); PG8_SCHED; PG8_LDA(At, 1, 0); PG8_STAGE_A(0, 1, a2, last);
            PG8_WAIT_V(8); PG8_WAIT_L(0); PG8_BAR; PG8_MMA(0, 0, At, B0); PG8_MMA(0, 1, At, B1); PG8_BAR; PG8_SCHED;
            PG8_LDA(At, 1, 1); PG8_STAGE(PG8_SB(1, 0), b3, voffB); PG8_STAGE(PG8_SB(1, 1), b3 + hstep, voffB); PG8_STAGE_A(1, 0, a3, last);
            PG8_WAIT_V(8); PG8_WAIT_L(0); PG8_BAR; PG8_MMA(1, 0, At, B0); PG8_MMA(1, 1, At, B1); PG8_BAR; PG8_SCHED;
            } else {
            PG8_LDB(B0, 0, 0); PG8_SCHED; PG8_LDA(At, 0, 0); PG8_STAGE_A(1, 1, a1, false);
            PG8_WAIT_L(8); PG8_BAR; PG8_WAIT_L(0); PG8_MMA(0, 0, At, B0); PG8_BAR; PG8_SCHED;
            PG8_LDB(B1, 0, 1); PG8_STAGE(PG8_SB(0, 0), b2, voffB);
            PG8_BAR; PG8_WAIT_L(0); PG8_MMA(0, 1, At, B1); PG8_BAR;
            PG8_LDA(At, 0, 1); PG8_STAGE_A(0, 0, a2, last);
            PG8_BAR; PG8_WAIT_L(0); PG8_MMA(1, 0, At, B0); PG8_BAR; PG8_SCHED;
            PG8_STAGE(PG8_SB(0, 1), b2 + hstep, voffB);
            PG8_WAIT_V(6); PG8_BAR; PG8_MMA(1, 1, At, B1); PG8_BAR;
            PG8_LDB(B0, 1, 0); PG8_SCHED; PG8_LDA(At, 1, 0); PG8_STAGE_A(0, 1, a2, last);
            PG8_WAIT_L(8); PG8_BAR; PG8_WAIT_L(0); PG8_MMA(0, 0, At, B0); PG8_BAR; PG8_SCHED;
            PG8_LDB(B1, 1, 1); PG8_STAGE(PG8_SB(1, 0), b3, voffB);
            PG8_BAR; PG8_WAIT_L(0); PG8_MMA(0, 1, At, B1); PG8_BAR;
            PG8_LDA(At, 1, 1); PG8_STAGE_A(1, 0, a3, last);
            PG8_BAR; PG8_WAIT_L(0); PG8_MMA(1, 0, At, B0); PG8_BAR; PG8_SCHED;
            PG8_STAGE(PG8_SB(1, 1), b3 + hstep, voffB);
            PG8_WAIT_V(6); PG8_BAR; PG8_MMA(1, 1, At, B1); PG8_BAR;
            }
        }
        if constexpr (ALIGN_EPI) { if (wr == 0) PG8_BAR; }
        if constexpr (!Epi::AFTER_DRAIN) { E(acc, cur, wr, wc, fr, fq); S.done(cur); }
        if (!has_next) break;
#pragma unroll
        for (int a = 0; a < 2; ++a)
#pragma unroll
            for (int b = 0; b < 2; ++b)
#pragma unroll
                for (int m = 0; m < 4; ++m)
#pragma unroll
                    for (int n = 0; n < 2; ++n) acc[a][b][m][n] = (f32x4){0.f, 0.f, 0.f, 0.f};
        cur = nxt; cA = nA; cB = nB; ++ui;
        if constexpr (AM::GATHER) { _Pragma("unroll") for (int h = 0; h < 2; ++h) _Pragma("unroll") for (int i = 0; i < 2; ++i) gao[h][i] = gno[h][i]; }
        if constexpr (ALIGN_EPI) { if (wr == 1) PG8_BAR; }
    }
    PG8_WAIT_V(0);
    if constexpr (!ALIGN_EPI) { if (wr == 0) PG8_BAR; }
    PG8_BAR;
    if constexpr (Epi::AFTER_DRAIN) { E.fused(acc, cur, wr, wc, fr, fq, lds, wid, lane); S.done(cur); }
#undef PG8_SA
#undef PG8_SB
#undef PG8_STAGE
#undef PG8_STAGE_A
#undef PG8_LDA
#undef PG8_LDB
#undef PG8_MMA
#undef PG8_WAIT_V
#undef PG8_WAIT_L
#undef PG8_BAR
#undef PG8_SCHED
}

__device__ __forceinline__ u32x4 pack8(const f32x4 v0, const f32x4 v1) { u32x4 w; w.x = cvt_pk_bf16(v0[0], v0[1]); w.y = cvt_pk_bf16(v0[2], v0[3]); w.z = cvt_pk_bf16(v1[0], v1[1]); w.w = cvt_pk_bf16(v1[2], v1[3]); return w; }
__device__ __forceinline__ u32x4 xpose4x16(const u32x4 w, int sa) {
    u32x4 r; r.x = __builtin_amdgcn_ds_bpermute(sa, w.x); r.y = __builtin_amdgcn_ds_bpermute(sa, w.y); r.z = __builtin_amdgcn_ds_bpermute(sa, w.z); r.w = __builtin_amdgcn_ds_bpermute(sa, w.w); return r;
}
#define XPOSE_IDS() const int L_ = fr + 16 * fq, tr_ = L_ >> 2, tq_ = L_ & 3, sa_ = 4 * (tr_ + 16 * tq_)
__device__ __forceinline__ float silu1(float x) { return x * __builtin_amdgcn_rcpf(1.0f + __builtin_amdgcn_exp2f(-1.4426950408889634f * x)); }
template <bool SILU> struct EpiPair {
    static constexpr bool PERM = true, AFTER_DRAIN = false;
    bf16_t* O; int ldc;
    __device__ __forceinline__ void prefetch(const Unit&, int, PG8_LAS unsigned*) const {}
    __device__ __forceinline__ void operator()(const f32x4 (&acc)[2][2][4][2], const Unit& u, int wr, int wc, int fr, int fq) const {
        XPOSE_IDS();
        const int row0 = u.pm * BM + wr * 64 + tr_, ch0 = u.pn * HALF + wc * 32 + 8 * tq_;
#pragma unroll
        for (int ai = 0; ai < 2; ++ai)
#pragma unroll
            for (int m = 0; m < 4; ++m) {
                f32x4 a0 = acc[ai][0][m][0], a1 = acc[ai][0][m][1];
                if (SILU) {
#pragma unroll
                    for (int c = 0; c < 4; ++c) { a0[c] = silu1(a0[c]); a1[c] = silu1(a1[c]); }
                }
                *(u32x4*)(O + (size_t)(row0 + ai * HALF + m * 16) * ldc + ch0) = xpose4x16(pack8(a0 * acc[ai][1][m][0], a1 * acc[ai][1][m][1]), sa_);
            }
    }
};
struct EpiYpre {
    static constexpr bool PERM = true, AFTER_DRAIN = false;
    bf16_t* O; const bf16_t* Z; const float* cw;
    __device__ __forceinline__ void prefetch(const Unit& u, int tid, PG8_LAS unsigned* dummy) const {
#pragma unroll
        for (int i = 0; i < 2; ++i) { const int line = tid + 512 * i, row = line >> 2, seg = line & 3;
            __builtin_amdgcn_global_load_lds((const unsigned*)(Z + (size_t)(u.pm * BM + row) * D + u.pn * BM + seg * 64), dummy, 4, 0, 0); }
    }
    __device__ __forceinline__ void operator()(const f32x4 (&acc)[2][2][4][2], const Unit& u, int wr, int wc, int fr, int fq) const {
        XPOSE_IDS();
        const int row0 = u.pm * BM + wr * 64 + fr;
#pragma unroll
        for (int bj = 0; bj < 2; ++bj) {
            const int col0 = u.pn * BM + bj * HALF + wc * 32 + 8 * fq;
            f32x4 w0[2], w1[2], w2[2];
#pragma unroll
            for (int n = 0; n < 2; ++n) { w0[n] = *(const f32x4*)(cw + col0 + 4 * n); w1[n] = *(const f32x4*)(cw + D + col0 + 4 * n); w2[n] = *(const f32x4*)(cw + 2 * D + col0 + 4 * n); }
#pragma unroll
            for (int ai = 0; ai < 2; ++ai) {
                u32x4 zz[4][3];
#pragma unroll
                for (int m = 0; m < 4; ++m) {
                    const int row = row0 + ai * HALF + m * 16, t = row & (SEQ - 1);
                    const bf16_t* zp = Z + (size_t)row * D + col0;
                    zz[m][0] = *(const u32x4*)zp; zz[m][1] = (u32x4){0u, 0u, 0u, 0u}; zz[m][2] = (u32x4){0u, 0u, 0u, 0u};
                    if (t >= 1) zz[m][1] = *(const u32x4*)(zp - D);
                    if (t >= 2) zz[m][2] = *(const u32x4*)(zp - 2 * D);
                }
#pragma unroll
                for (int m = 0; m < 4; ++m) {
                    const int row = row0 + ai * HALF + m * 16;
                    const u32x4 z0 = zz[m][0], z1 = zz[m][1], z2 = zz[m][2];
                    f32x4 v[2];
#pragma unroll
                    for (int n = 0; n < 2; ++n) {
                        f32x4 a, b, c;
                        a[0] = __uint_as_float(z0[2 * n] << 16); a[1] = __uint_as_float(z0[2 * n] & 0xffff0000u); a[2] = __uint_as_float(z0[2 * n + 1] << 16); a[3] = __uint_as_float(z0[2 * n + 1] & 0xffff0000u);
                        b[0] = __uint_as_float(z1[2 * n] << 16); b[1] = __uint_as_float(z1[2 * n] & 0xffff0000u); b[2] = __uint_as_float(z1[2 * n + 1] << 16); b[3] = __uint_as_float(z1[2 * n + 1] & 0xffff0000u);
                        c[0] = __uint_as_float(z2[2 * n] << 16); c[1] = __uint_as_float(z2[2 * n] & 0xffff0000u); c[2] = __uint_as_float(z2[2 * n + 1] << 16); c[3] = __uint_as_float(z2[2 * n + 1] & 0xffff0000u);
                        v[n] = acc[ai][bj][m][n] * (w2[n] * a + w1[n] * b + w0[n] * c);
                    }
                    *(u32x4*)(O + (size_t)(row - fr + tr_) * D + col0 - 8 * fq + 8 * tq_) = xpose4x16(pack8(v[0], v[1]), sa_);
                }
                asm volatile("" ::: "memory");
            }
        }
    }
};

template <bool RES_F32> struct EpiRes {
    static constexpr bool PERM = true, AFTER_DRAIN = false;
    bf16_t* xr; const float* xin; const float* modg;
    __device__ __forceinline__ void prefetch(const Unit&, int, PG8_LAS unsigned*) const {}
    __device__ __forceinline__ void operator()(const f32x4 (&acc)[2][2][4][2], const Unit& u, int wr, int wc, int fr, int fq) const {
        XPOSE_IDS();
        const int row0 = u.pm * BM + wr * 64 + fr, col0 = u.pn * BM + wc * 32 + 8 * fq;
        const float* gb = modg + (size_t)((u.pm * BM) >> 12) * 6144;
        f32x4 gv[2][2];
#pragma unroll
        for (int bj = 0; bj < 2; ++bj)
#pragma unroll
            for (int n = 0; n < 2; ++n) gv[bj][n] = *(const f32x4*)(gb + col0 + bj * HALF + n * 4);
#pragma unroll
        for (int ai = 0; ai < 2; ++ai) {
            f32x4 rv[4][2][2];
#pragma unroll
            for (int m = 0; m < 4; ++m) { const int row = row0 + ai * HALF + m * 16;
#pragma unroll
                for (int bj = 0; bj < 2; ++bj) {
                    if (RES_F32) { rv[m][bj][0] = *(const f32x4*)(xin + (size_t)row * D + col0 + bj * HALF); rv[m][bj][1] = *(const f32x4*)(xin + (size_t)row * D + col0 + bj * HALF + 4); }
                    else { const u32x4 w = *(const u32x4*)(xr + (size_t)row * XRP + col0 + bj * HALF);
                        rv[m][bj][0] = (f32x4){__uint_as_float(w.x << 16), __uint_as_float(w.x & 0xffff0000u), __uint_as_float(w.y << 16), __uint_as_float(w.y & 0xffff0000u)};
                        rv[m][bj][1] = (f32x4){__uint_as_float(w.z << 16), __uint_as_float(w.z & 0xffff0000u), __uint_as_float(w.w << 16), __uint_as_float(w.w & 0xffff0000u)}; }
                } }
#pragma unroll
            for (int m = 0; m < 4; ++m) { const int row = row0 + ai * HALF + m * 16;
#pragma unroll
                for (int bj = 0; bj < 2; ++bj)
                    *(u32x4*)(xr + (size_t)(row - fr + tr_) * XRP + col0 - 8 * fq + 8 * tq_ + bj * HALF) = xpose4x16(pack8(rv[m][bj][0] + gv[bj][0] * acc[ai][bj][m][0], rv[m][bj][1] + gv[bj][1] * acc[ai][bj][m][1]), sa_); }
            asm volatile("" ::: "memory");
        }
    }
};
struct EpiQKV {
    static constexpr bool PERM = true, AFTER_DRAIN = false;
    bf16_t* O; const float* rope;
    __device__ __forceinline__ void prefetch(const Unit&, int, PG8_LAS unsigned*) const {}
    __device__ __forceinline__ void operator()(const f32x4 (&acc)[2][2][4][2], const Unit& u, int wr, int wc, int fr, int fq) const {
        XPOSE_IDS();
        const int row0 = u.pm * BM + wr * 64 + fr, col0 = u.pn * BM + wc * 32 + 8 * fq;
        const int typ = (u.pn % 6) >> 1;
        const bool rl = (typ < 2) && ((wc & 1) == 0) && (fq < 2);
        const float sc = (typ == 0) ? QSCALE : 1.0f;
#pragma unroll
        for (int ai = 0; ai < 2; ++ai)
#pragma unroll
        for (int mp = 0; mp < 2; ++mp) {
            f32x4 csv[2], snv[2];
#pragma unroll
            for (int mm = 0; mm < 2; ++mm) { const int pos = (row0 + ai * HALF + (2 * mp + mm) * 16) & (SEQ - 1);
                csv[mm] = *(const f32x4*)(rope + pos * 8 + 4 * (fq & 1)); snv[mm] = *(const f32x4*)(rope + 4096 * 8 + pos * 8 + 4 * (fq & 1)); }
#pragma unroll
            for (int mm = 0; mm < 2; ++mm) {
                const int m = 2 * mp + mm, row = row0 + ai * HALF + m * 16;
                f32x4 cs = {1.f, 1.f, 1.f, 1.f}, sn = {0.f, 0.f, 0.f, 0.f};
                if (rl) { cs = csv[mm]; sn = snv[mm]; }
#pragma unroll
                for (int bj = 0; bj < 2; ++bj) {
                    const f32x4 x1 = acc[ai][bj][m][0], x2 = acc[ai][bj][m][1];
                    const f32x4 r1 = (x1 * cs - x2 * sn) * sc, r2 = (x2 * cs + x1 * sn) * sc;
                    *(u32x4*)(O + (size_t)(row - fr + tr_) * QKVW + col0 - 8 * fq + 8 * tq_ + bj * HALF) = xpose4x16(pack8(r1, r2), sa_);
                }
            }
            asm volatile("" ::: "memory");
        }
    }
};
struct EpiDown {
    static constexpr bool PERM = true, AFTER_DRAIN = false;
    bf16_t* O; const float* lw; const PG8_LAS int* rb;
    __device__ __forceinline__ void prefetch(const Unit&, int, PG8_LAS unsigned*) const {}
    __device__ __forceinline__ void operator()(const f32x4 (&acc)[2][2][4][2], const Unit& u, int wr, int wc, int fr, int fq) const {
        XPOSE_IDS();
        const int row0 = u.pm * BM + wr * 64 + fr, col0 = u.pn * BM + wc * 32 + 8 * fq;
        const int e = u.pb >> 2; const float* wrow = lw + (size_t)e * LISTCAP - rb[e];
        float wv[2][4];
#pragma unroll
        for (int ai = 0; ai < 2; ++ai)
#pragma unroll
            for (int m = 0; m < 4; ++m) wv[ai][m] = wrow[row0 + ai * HALF + m * 16];
#pragma unroll
        for (int ai = 0; ai < 2; ++ai)
#pragma unroll
            for (int m = 0; m < 4; ++m) {
                const int row = row0 + ai * HALF + m * 16; const float w = wv[ai][m];
#pragma unroll
                for (int bj = 0; bj < 2; ++bj) *(u32x4*)(O + (size_t)(row - fr + tr_) * D + col0 - 8 * fq + 8 * tq_ + bj * HALF) = xpose4x16(pack8(acc[ai][bj][m][0] * w, acc[ai][bj][m][1] * w), sa_);
            }
    }
};
struct MoeOrder {
    int nM, nN, nwg, G, c; const PG8_LAS int* rb;
    __device__ void init(int nRT, int G_, int c_, const PG8_LAS int* rb_) { nM = nRT; nN = 4; nwg = nM * nN; G = G_; c = c_; rb = rb_; }
    __device__ bool next(int i, Unit& u) const {
        const long L = (long)i * G + c; if (L >= nwg) return false;
        int wgid = (int)L; { const int q = nwg / NXCD, r = nwg % NXCD, xcd = wgid % NXCD, off = wgid / NXCD; wgid = (xcd < r ? xcd * (q + 1) : r * (q + 1) + (xcd - r) * q) + off; }
        const int nig = WGM * nN, gid = wgid / nig, fm = gid * WGM, gsz = (nM - fm) < WGM ? (nM - fm) : WGM;
        u.pm = fm + ((wgid % nig) % gsz); u.pn = (wgid % nig) / gsz;
        int e = 0; const int r0 = u.pm * BM;
#pragma unroll 1
        while (e < 31 && rb[e + 1] <= r0) ++e;
        u.pb = e * 4 + u.pn; return true;
    }
    __device__ __forceinline__ void a_ready(const Unit&) const {}
    __device__ __forceinline__ void done(const Unit&) const {}
};
struct APlain { static constexpr bool GATHER = false; __device__ __forceinline__ int arow(const Unit&, int) const { return 0; } };
struct AGather {
    static constexpr bool GATHER = true;
    const int* ltok; const int* cnt; const PG8_LAS int* rb;
    __device__ __forceinline__ int arow(const Unit& u, int r) const { const int e = u.pb >> 2, l = u.pm * BM - rb[e] + r; return (l < cnt[e]) ? ltok[(size_t)e * LISTCAP + l] : 0; }
};
}

#define XB_TMO      128
#define XB_XCNT(j)  (256  + 64 * (j))
#define XB_XSUB(j)  (1280 + 64 * (j))
#define XB_XGEN(j)  (2304 + 64 * (j))
#define XB_TOP      3328
#define XB_TOPGEN   3392
#define XCD_BAR_WORDS 3456
#define XB_SPIN_CAP (1u << 18)

__device__ __forceinline__ unsigned xb_ld(unsigned* p)              { return __hip_atomic_load(p, __ATOMIC_RELAXED, __HIP_MEMORY_SCOPE_AGENT); }
__device__ __forceinline__ unsigned xb_add(unsigned* p, unsigned v) { return __hip_atomic_fetch_add(p, v, __ATOMIC_RELAXED, __HIP_MEMORY_SCOPE_AGENT); }
__device__ __forceinline__ unsigned xb_xcc_id() { return (unsigned)__builtin_amdgcn_s_getreg((3 << 11) | 20) & 0xFu; }
#define XB_SPIN(cond, bar) do { unsigned _sp = 0; while (cond) { __builtin_amdgcn_s_sleep(1); \
    if ((++_sp & 255u) == 0u) { if (xb_ld(&(bar)[XB_TMO])) break; if (_sp > XB_SPIN_CAP) { atomicAdd(&(bar)[XB_TMO], 1u); break; } } } } while (0)

struct XcdBarrier {
    unsigned* bar; unsigned x;
    volatile LAS unsigned* st;
};

__device__ __forceinline__ XcdBarrier xcd_barrier_post(unsigned* bar, volatile LAS unsigned* st, int wave) {
    XcdBarrier b; b.bar = bar; b.x = xb_xcc_id(); b.st = st;
    if (wave == 0 && lane_id() == 0) (void)xb_add(&bar[XB_XCNT(b.x)], 1u);
    return b;
}
__device__ __forceinline__ void xcd_barrier_complete(unsigned* bar, unsigned x, unsigned& nloc, unsigned& nx) {
    const unsigned G = gridDim.x * gridDim.y * gridDim.z;
    unsigned sum, cnt, mine, sp = 0u;
    for (;;) {
        sum = 0u; cnt = 0u; mine = 0u;
#pragma unroll
        for (unsigned j = 0; j < 16; ++j) { const unsigned c = xb_ld(&bar[XB_XCNT(j)]); sum += c; cnt += (c > 0u) ? 1u : 0u; mine = (j == x) ? c : mine; }
        if (sum == G) break;
        __builtin_amdgcn_s_sleep(1);
        if ((++sp & 255u) == 0u) { if (xb_ld(&bar[XB_TMO])) break; if (sp > XB_SPIN_CAP) { atomicAdd(&bar[XB_TMO], 1u); break; } }
    }
    nloc = mine > 0u ? mine : 1u; nx = cnt > 0u ? cnt : 1u;
}

__device__ __forceinline__ void xcd_barrier(const XcdBarrier& b, int wave) {
    asm volatile("s_waitcnt vmcnt(0)" ::: "memory");
    __syncthreads();
    if (wave == 0 && lane_id() == 0) {
        unsigned* bar = b.bar;
        __builtin_amdgcn_s_waitcnt(0);
        unsigned nloc = b.st[0], nx = b.st[1];
        if (nloc == 0u) { xcd_barrier_complete(bar, b.x, nloc, nx); b.st[0] = nloc; b.st[1] = nx; }
        const unsigned old = xb_add(&bar[XB_XSUB(b.x)], 1u);
        const unsigned gen = old / nloc;
        if (old + 1u == (gen + 1u) * nloc) {
            __builtin_amdgcn_fence(__ATOMIC_RELEASE, "agent");
            asm volatile("s_waitcnt vmcnt(0)" ::: "memory");
            const unsigned og = xb_add(&bar[XB_TOP], 1u);
            const unsigned tg = og / nx;
            if (og + 1u == (tg + 1u) * nx) xb_add(&bar[XB_TOPGEN], 1u);
            else XB_SPIN(xb_ld(&bar[XB_TOPGEN]) == tg, bar);
            __builtin_amdgcn_fence(__ATOMIC_ACQUIRE, "agent");
            xb_add(&bar[XB_XGEN(b.x)], 1u);
            asm volatile("s_waitcnt vmcnt(0)" ::: "memory");
        } else {
            XB_SPIN(xb_ld(&bar[XB_XGEN(b.x)]) == gen, bar);
            __builtin_amdgcn_fence(__ATOMIC_ACQUIRE, "agent");
            asm volatile("s_waitcnt vmcnt(0)" ::: "memory");
        }
    }
    __syncthreads();
}

struct RowV { f32x4 v[4]; };
__device__ __forceinline__ void row_load(RowV& r, const float* row, int lane) {
#pragma unroll
    for (int j = 0; j < 4; ++j) r.v[j] = *(const f32x4*)(row + 4 * lane + 256 * j);
}
__device__ __forceinline__ void row_load_bf16(RowV& r, const bf16_t* row, int lane) {
#pragma unroll
    for (int j = 0; j < 4; ++j) { const u32x2 w = *(const u32x2*)(row + 4 * lane + 256 * j); r.v[j] = (f32x4){bflo(w.x), bfhi(w.x), bflo(w.y), bfhi(w.y)}; }
}
__device__ __forceinline__ float row_rstd(const RowV& r) {
    float s = 0.f;
#pragma unroll
    for (int j = 0; j < 4; ++j) s += (r.v[j].x * r.v[j].x + r.v[j].y * r.v[j].y) + (r.v[j].z * r.v[j].z + r.v[j].w * r.v[j].w);
    s = wave_sum(s);
    return 1.0f / sqrtf(s * (1.0f / 1024.0f) + EPS);
}
__device__ __forceinline__ void row_modulate(RowV& r, float rstd, const float* g, const float* sh, const float* sc, int lane) {
#pragma unroll
    for (int j = 0; j < 4; ++j) {
        const int o = 4 * lane + 256 * j;
        const f32x4 gg = *(const f32x4*)(g + o), s = *(const f32x4*)(sc + o), h = *(const f32x4*)(sh + o);
        r.v[j] = (r.v[j] * rstd * gg) * (s + 1.0f) + h;
    }
}
struct ModV { f32x4 gp[4], sh[4]; };
__device__ __forceinline__ void mod_load(ModV& m, const float* g, const float* sh, const float* sc, int lane) {
#pragma unroll
    for (int j = 0; j < 4; ++j) { const int o = 4 * lane + 256 * j; m.gp[j] = *(const f32x4*)(g + o) * (*(const f32x4*)(sc + o) + 1.0f); m.sh[j] = *(const f32x4*)(sh + o); }
}
__device__ __forceinline__ void row_apply(RowV& r, float rstd, const ModV& m) {
#pragma unroll
    for (int j = 0; j < 4; ++j) r.v[j] = (r.v[j] * rstd) * m.gp[j] + m.sh[j];
}
__device__ __forceinline__ void row_store_bf16(const RowV& r, bf16_t* out, int lane) {
#pragma unroll
    for (int j = 0; j < 4; ++j) { u32x2 w; w.x = pg8::cvt_pk_bf16(r.v[j].x, r.v[j].y); w.y = pg8::cvt_pk_bf16(r.v[j].z, r.v[j].w); *(u32x2*)(out + 4 * lane + 256 * j) = w; }
}
__device__ __forceinline__ void row_store_f32(const RowV& r, float* out, int lane) {
#pragma unroll
    for (int j = 0; j < 4; ++j) *(f32x4*)(out + 4 * lane + 256 * j) = r.v[j];
}

__device__ __forceinline__ int wmap(int code, int n) {
    if (code == 1) { const int isU = n >> 10, ch = n & 1023; return (ch >> 7) * 256 + isU * 128 + (ch & 127); }
    if (code == 2) { const int typ = (n % 1536) / 512, d = n & 63; return (typ < 2 && d >= 4 && d < 12) ? (d < 8 ? n + 4 : n - 4) : n; }
    if (code == 3) return (n >> 7) * 256 + (n & 127);
    if (code == 4) return (n >> 7) * 256 + 128 + (n & 127);
    return n;
}
struct ConvDesc { const float* src; bf16_t* dst; int ldw, K, code, nloc; };
__device__ __forceinline__ void conv_desc(ConvDesc& d, const float* W, int ldw, int ncol0, bf16_t* WT, int K, int code, int kb, int nb) {
    d.src = W + (size_t)(64 * kb) * ldw + ncol0 + 64 * nb; d.dst = WT + 64 * kb; d.ldw = ldw; d.K = K; d.code = code; d.nloc = 64 * nb;
}
__device__ __forceinline__ void conv_load(f32x4 (&v)[16], const ConvDesc& d, int lane) {
    const float* src = d.src + (size_t)(lane >> 4) * d.ldw + (lane & 15) * 4;
#pragma unroll
    for (int i = 0; i < 16; ++i) v[i] = *(const f32x4*)(src + (size_t)(4 * i) * d.ldw);
}
__device__ __forceinline__ void conv_process(const f32x4 (&v)[16], const ConvDesc& d, LAS float* scr, int lane) {
#pragma unroll
    for (int i = 0; i < 16; ++i) { LAS float* p = scr + (4 * i + (lane >> 4)) * 65 + (lane & 15) * 4; p[0] = v[i].x; p[1] = v[i].y; p[2] = v[i].z; p[3] = v[i].w; }
    LDS_WAIT();
    const int c = lane & 7;
#pragma unroll
    for (int j = 0; j < 8; ++j) { const int n = (lane >> 3) + 8 * j; const LAS float* sp = scr + (8 * c) * 65 + n;
        u32x4 o; o.x = pg8::cvt_pk_bf16(sp[0 * 65], sp[1 * 65]); o.y = pg8::cvt_pk_bf16(sp[2 * 65], sp[3 * 65]); o.z = pg8::cvt_pk_bf16(sp[4 * 65], sp[5 * 65]); o.w = pg8::cvt_pk_bf16(sp[6 * 65], sp[7 * 65]);
        *(u32x4*)(d.dst + (size_t)wmap(d.code, d.nloc + n) * d.K + 8 * c) = o; }
    LDS_WAIT();
}
constexpr int NCONV_ITEMS = 512 + 256 + 256 + 1152 + 128 + 64 * 384;

__device__ __forceinline__ void attn_naive(bf16_t* qkv, float* lse, int bid, int G, int tid) {
    const size_t n = (size_t)T * 24;
    for (size_t i = (size_t)bid * 512 + tid; i < n; i += (size_t)G * 512) {
        const int t = (int)(i / 24), gh = (int)(i % 24), g = gh / 8, h = gh % 8;
        const int dil = g == 0 ? 1 : (g == 1 ? 4 : 16);
        const int pos = t & (SEQ - 1);
        bf16_t* qp = qkv + (size_t)t * QKVW + g * 1536 + h * 64;
        float q[64], o[64];
#pragma unroll
        for (int c8 = 0; c8 < 8; ++c8) { const u32x4 w = *(const u32x4*)(qp + c8 * 8);
#pragma unroll
            for (int k = 0; k < 4; ++k) { q[c8 * 8 + 2 * k] = bflo(w[k]); q[c8 * 8 + 2 * k + 1] = bfhi(w[k]); o[c8 * 8 + 2 * k] = 0.f; o[c8 * 8 + 2 * k + 1] = 0.f; } }
        float m = -INFINITY, l = 0.f;
        for (int j = 0; j <= 128; ++j) {
            const int kp = pos - j * dil; if (kp < 0) break;
            const bf16_t* kr = qkv + (size_t)(t - j * dil) * QKVW + g * 1536 + 512 + h * 64;
            const bf16_t* vr = kr + 512;
            float s = 0.f;
#pragma unroll
            for (int c8 = 0; c8 < 8; ++c8) { const u32x4 w = *(const u32x4*)(kr + c8 * 8);
#pragma unroll
                for (int k = 0; k < 4; ++k) s += q[c8 * 8 + 2 * k] * bflo(w[k]) + q[c8 * 8 + 2 * k + 1] * bfhi(w[k]); }
            const float mn = fmaxf(m, s), a = exp2f(m - mn), pv = exp2f(s - mn);
            l = l * a + pv;
#pragma unroll
            for (int c8 = 0; c8 < 8; ++c8) { const u32x4 w = *(const u32x4*)(vr + c8 * 8);
#pragma unroll
                for (int k = 0; k < 4; ++k) { o[c8 * 8 + 2 * k] = o[c8 * 8 + 2 * k] * a + pv * bflo(w[k]); o[c8 * 8 + 2 * k + 1] = o[c8 * 8 + 2 * k + 1] * a + pv * bfhi(w[k]); } }
            m = mn;
        }
        const float inv = 1.0f / l;
#pragma unroll
        for (int c8 = 0; c8 < 8; ++c8) { u32x4 w;
#pragma unroll
            for (int k = 0; k < 4; ++k) w[k] = pk2(o[c8 * 8 + 2 * k] * inv, o[c8 * 8 + 2 * k + 1] * inv);
            *(u32x4*)(qp + c8 * 8) = w; }
        lse[(size_t)t * 24 + gh] = m + log2f(l);
    }
}
__device__ __forceinline__ void attn_comb(const bf16_t* qkv, const float* lse, bf16_t* o, int bid, int G, int tid) {
    const size_t n = (size_t)T * 64;
    for (size_t i = (size_t)bid * 512 + tid; i < n; i += (size_t)G * 512) {
        const int t = (int)(i >> 6), r = (int)(i & 63), h = r >> 3, c = r & 7;
        const float l0 = lse[(size_t)t * 24 + h], l1 = lse[(size_t)t * 24 + 8 + h], l2 = lse[(size_t)t * 24 + 16 + h];
        const float mx = fmaxf(l0, fmaxf(l1, l2));
        float w0 = exp2f(l0 - mx), w1 = exp2f(l1 - mx), w2 = exp2f(l2 - mx);
        const float inv = 1.0f / (w0 + w1 + w2); w0 *= inv; w1 *= inv; w2 *= inv;
        const bf16_t* base = qkv + (size_t)t * QKVW + h * 64 + c * 8;
        const u32x4 a = *(const u32x4*)(base), b = *(const u32x4*)(base + 1536), cc = *(const u32x4*)(base + 3072);
        u32x4 out;
#pragma unroll
        for (int k = 0; k < 4; ++k) {
            const float lo = w0 * bflo(a[k]) + w1 * bflo(b[k]) + w2 * bflo(cc[k]);
            const float hi = w0 * bfhi(a[k]) + w1 * bfhi(b[k]) + w2 * bfhi(cc[k]);
            out[k] = pk2(lo, hi);
        }
        *(u32x4*)(o + (size_t)t * 512 + h * 64 + c * 8) = out;
    }
}

namespace att {
typedef short bf16x8 __attribute__((ext_vector_type(8)));
typedef short s16x4 __attribute__((ext_vector_type(4)));
typedef float f32x16 __attribute__((ext_vector_type(16)));
constexpr int NKEY = 384, KOFF = 0, KCH = NKEY * 16 + 16  , VOFF = 8 * KCH, VDH = (NKEY / 16) * 1024 + 64  , NUNITS = 16 * 3 * 16 * 8;
__device__ __forceinline__ int crow(int r, int hi) { return (r & 3) + 8 * (r >> 2) + 4 * hi; }
__device__ __forceinline__ s16x4 vtr(const LAS unsigned char* p) { return __builtin_bit_cast(s16x4, __builtin_amdgcn_ds_read_tr16_b64_v4i16((LAS s16x4*)p)); }
__device__ __forceinline__ float xhalf_max(float m) { auto rr = __builtin_amdgcn_permlane32_swap(__float_as_uint(m), __float_as_uint(m), false, false); return fmaxf(__uint_as_float(rr[0]), __uint_as_float(rr[1])); }
__device__ __forceinline__ float xhalf_sum(float m) { auto rr = __builtin_amdgcn_permlane32_swap(__float_as_uint(m), __float_as_uint(m), false, false); return __uint_as_float(rr[0]) + __uint_as_float(rr[1]); }

struct AUnit { int h, g, dil, l0; size_t tb; };
template <bool MERGE> __device__ __forceinline__ void adecode(AUnit& u, int idx) {
    const int sb = (idx >> 3) & 15, bg = idx >> 7, b = MERGE ? bg : (bg >> 1);
    u.h = idx & 7; u.g = MERGE ? 2 : (bg & 1); const int dsh = 2 * u.g; u.dil = 1 << dsh;
    const int bps = 16 >> dsh, r = sb / bps; u.l0 = (sb - r * bps) * 256; u.tb = (size_t)b * SEQ + r;
}
__device__ __forceinline__ void aload_kv(u32x4 (&kv)[12], const AUnit& u, const bf16_t* qkv, int wave, int lane) {
    const bf16_t* gq = qkv + u.g * 1536 + u.h * 64 + (lane & 7) * 8;
#pragma unroll
    for (int i = 0; i < 6; ++i) {
        int sp = u.l0 - 128 + 48 * wave + 8 * i + (lane >> 3); sp = sp < 0 ? 0 : sp;
        const bf16_t* row = gq + (u.tb + (size_t)sp * u.dil) * QKVW;
        kv[i] = *(const u32x4*)(row + 512); kv[6 + i] = *(const u32x4*)(row + 1024);
    }
}
__device__ __forceinline__ void astore_kv(const u32x4 (&kv)[12], LAS unsigned char* lds, int wave, int lane) {
#pragma unroll
    for (int i = 0; i < 6; ++i) { const int key = 48 * wave + 8 * i + (lane >> 3);
        *(LAS u32x4*)(lds + KOFF + (lane & 7) * KCH + key * 16) = kv[i];
        *(LAS u32x4*)(lds + VOFF + ((lane & 7) >> 2) * VDH + (key >> 4) * 1024 + (key & 15) * 64 + (lane & 3) * 16) = kv[6 + i]; }
}
__device__ __forceinline__ bf16_t* aqrow(const AUnit& u, bf16_t* qkv, int wave, int r32) {
    return qkv + (u.tb + (size_t)(u.l0 + 32 * wave + r32) * u.dil) * QKVW + u.g * 1536 + u.h * 64;
}

template <bool MERGE> __device__ __forceinline__ void attn_phase(LAS unsigned char* lds, bf16_t* qkv, float* lse, bf16_t* ob, int bid, int G, int wave, bool dry = false) {
    constexpr int NU = MERGE ? NUNITS / 3 : 2 * NUNITS / 3;
    const int per = (NU + G - 1) / G;
    const int u_lo = bid * per, u_hi = (u_lo + per < NU) ? u_lo + per : NU;
    asm volatile("" : "+s"(wave));
    const int lane = lane_id(), r32 = lane & 31, hi = lane >> 5;
    const int qt = wave;
    u32x4 kv[12]; bf16x8 qn[4];
    AUnit un;
    if (u_lo < u_hi) { adecode<MERGE>(un, u_lo); aload_kv(kv, un, qkv, wave, lane);
        { const bf16_t* q = aqrow(un, qkv, wave, r32);
#pragma unroll
            for (int d0 = 0; d0 < 4; ++d0) qn[d0] = *(const bf16x8*)(q + d0 * 16 + hi * 8); } }
#pragma unroll 1
    for (int idx = u_lo; idx < u_hi; ++idx) {
        const AUnit u = un;
        const int g = u.g, l0 = u.l0, head = u.h;
        bf16_t* qrow = aqrow(u, qkv, wave, r32);
        const size_t tq = u.tb + (size_t)(l0 + 32 * qt + r32) * u.dil;
        bf16x8 qf[4];
        astore_kv(kv, lds, wave, lane);
#pragma unroll
        for (int d0 = 0; d0 < 4; ++d0) qf[d0] = qn[d0];
        __syncthreads();
        if (idx + 1 < u_hi) { adecode<MERGE>(un, idx + 1); aload_kv(kv, un, qkv, wave, lane);
            { const bf16_t* q = aqrow(un, qkv, wave, r32);
#pragma unroll
                for (int d0 = 0; d0 < 4; ++d0) qn[d0] = *(const bf16x8*)(q + d0 * 16 + hi * 8); } }
        u32x2 og[MERGE ? 2 : 1][2][4]; float lg0 = 0.f, lg1 = 0.f;
        if constexpr (MERGE) {
            const bf16_t* o0 = qkv + tq * QKVW + head * 64 + 4 * hi;
#pragma unroll
            for (int gg = 0; gg < 2; ++gg)
#pragma unroll
                for (int d0 = 0; d0 < 2; ++d0)
#pragma unroll
                    for (int rg = 0; rg < 4; ++rg) og[gg][d0][rg] = *(const u32x2*)(o0 + gg * 1536 + d0 * 32 + 8 * rg);
            lg0 = lse[tq * 24 + head]; lg1 = lse[tq * 24 + 8 + head];
        }
        f32x16 p[5];
        const LAS unsigned char* kb = lds + KOFF + hi * KCH + (qt * 32 + r32) * 16;
#pragma unroll
        for (int j = 0; j < 5; ++j) {
#pragma unroll
            for (int rr = 0; rr < 16; ++rr) p[j][rr] = 0.f;
#pragma unroll
            for (int d0 = 0; d0 < 4; ++d0) {
                const bf16x8 kf = *(const LAS bf16x8*)(kb + j * 512 + d0 * 2 * KCH);
                p[j] = __builtin_amdgcn_mfma_f32_32x32x16_bf16(kf, qf[d0], p[j], 0, 0, 0);
            }
        }
#pragma unroll
        for (int rr = 0; rr < 16; ++rr) { const int c = crow(rr, hi); if (c < r32) p[0][rr] = -INFINITY; if (c > r32) p[4][rr] = -INFINITY; }
        if (l0 == 0) {
#pragma unroll
            for (int j = 0; j < 5; ++j)
#pragma unroll
                for (int rr = 0; rr < 16; ++rr) if (32 * (qt + j) + crow(rr, hi) < 128) p[j][rr] = -INFINITY;
        }
        float m = p[0][0];
#pragma unroll
        for (int j = 0; j < 5; ++j)
#pragma unroll
            for (int rr = 0; rr < 16; ++rr) m = fmaxf(m, p[j][rr]);
        m = xhalf_max(m);
        float l = 0.f;
#pragma unroll
        for (int j = 0; j < 5; ++j)
#pragma unroll
            for (int rr = 0; rr < 16; ++rr) { const float e = __builtin_amdgcn_exp2f(p[j][rr] - m); p[j][rr] = e; l += e; }
        l = xhalf_sum(l);
        f32x16 o[2];
#pragma unroll
        for (int rr = 0; rr < 16; ++rr) { o[0][rr] = 0.f; o[1][rr] = 0.f; }
        const LAS unsigned char* vb = lds + VOFF + ((lane >> 4) & 1) * 32 + (lane & 3) * 8 + (4 * hi + ((lane & 15) >> 2)) * 64 + qt * 2048;
#pragma unroll
        for (int j = 0; j < 5; ++j)
#pragma unroll
            for (int s = 0; s < 2; ++s) {
                u32x4 pw; pw.x = pg8::cvt_pk_bf16(p[j][8 * s + 0], p[j][8 * s + 1]); pw.y = pg8::cvt_pk_bf16(p[j][8 * s + 2], p[j][8 * s + 3]);
                pw.z = pg8::cvt_pk_bf16(p[j][8 * s + 4], p[j][8 * s + 5]); pw.w = pg8::cvt_pk_bf16(p[j][8 * s + 6], p[j][8 * s + 7]);
                const bf16x8 pf = __builtin_bit_cast(bf16x8, pw);
#pragma unroll
                for (int d0 = 0; d0 < 2; ++d0) {
                    const s16x4 vlo = vtr(vb + d0 * VDH + (2 * j + s) * 1024), vhi = vtr(vb + d0 * VDH + (2 * j + s) * 1024 + 512);
                    const bf16x8 vf = {vlo[0], vlo[1], vlo[2], vlo[3], vhi[0], vhi[1], vhi[2], vhi[3]};
                    o[d0] = __builtin_amdgcn_mfma_f32_32x32x16_bf16(vf, pf, o[d0], 0, 0, 0);
                }
            }
        if constexpr (!MERGE) {
            const float inv = 1.0f / l;
#pragma unroll
            for (int d0 = 0; d0 < 2; ++d0)
#pragma unroll
                for (int rg = 0; rg < 4; ++rg) {
                    u32x2 w; w.x = pg8::cvt_pk_bf16(o[d0][4 * rg] * inv, o[d0][4 * rg + 1] * inv); w.y = pg8::cvt_pk_bf16(o[d0][4 * rg + 2] * inv, o[d0][4 * rg + 3] * inv);
                    if (!dry) *(u32x2*)(qrow + d0 * 32 + 8 * rg + 4 * hi) = w; else asm volatile("" :: "v"(w.x), "v"(w.y));
                }
            if (hi == 0 && !dry) lse[tq * 24 + g * 8 + head] = m + __builtin_amdgcn_logf(l);
        } else {
            const float lg2 = m + __builtin_amdgcn_logf(l), mx = fmaxf(lg2, fmaxf(lg0, lg1));
            const float w0 = __builtin_amdgcn_exp2f(lg0 - mx), w1 = __builtin_amdgcn_exp2f(lg1 - mx), w2 = __builtin_amdgcn_exp2f(lg2 - mx);
            const float iw = 1.0f / (w0 + w1 + w2), c0 = w0 * iw, c1 = w1 * iw, c2 = w2 * iw / l;
            bf16_t* orow = ob + tq * 512 + head * 64 + 4 * hi;
#pragma unroll
            for (int d0 = 0; d0 < 2; ++d0)
#pragma unroll
                for (int rg = 0; rg < 4; ++rg) {
                    const u32x2 a = og[0][d0][rg], b = og[1][d0][rg];
                    u32x2 w; w.x = pg8::cvt_pk_bf16(c0 * bflo(a.x) + c1 * bflo(b.x) + c2 * o[d0][4 * rg], c0 * bfhi(a.x) + c1 * bfhi(b.x) + c2 * o[d0][4 * rg + 1]);
                    w.y = pg8::cvt_pk_bf16(c0 * bflo(a.y) + c1 * bflo(b.y) + c2 * o[d0][4 * rg + 2], c0 * bfhi(a.y) + c1 * bfhi(b.y) + c2 * o[d0][4 * rg + 3]);
                    if (!dry) *(u32x2*)(orow + d0 * 32 + 8 * rg) = w; else asm volatile("" :: "v"(w.x), "v"(w.y));
                }
        }
        __syncthreads();
    }
}
}

typedef const __attribute__((address_space(4))) unsigned long long* kargp_t;
__device__ __forceinline__ kargp_t karg() { kargp_t p = (kargp_t)__builtin_amdgcn_kernarg_segment_ptr(); asm volatile("" : "+s"(p)); return p; }
#define KIN(i) ((const float*)(GAS const float*)karg()[i])
#define KOUT() ((float*)(GAS float*)karg()[19])
#define KWS() ((unsigned char*)(GAS unsigned char*)karg()[20])
#define WSP(type, off) ((type*)(KWS() + (off)))
struct Args { const float* in[19]; float* out; unsigned char* ws; int ph_lo, ph_hi; };
constexpr int NPHASE = 17;

__global__ void __launch_bounds__(NWAVES * 64, 2) mk_fwd(Args args) {
    extern __shared__ __attribute__((aligned(16))) unsigned char lds_raw[];
    LAS unsigned char* lds = (LAS unsigned char*)lds_raw;
    volatile LAS unsigned* MISC = (volatile LAS unsigned*)(lds + MISC_OFF);
    LAS int* rb = (LAS int*)(lds + MISC_OFF);
    const int wave = __builtin_amdgcn_readfirstlane((int)threadIdx.x >> 6);
#define IDS() const int lane = lane_id(), tid = wave * 64 + lane; (void)tid; (void)lane
    const int G = gridDim.x, bid = blockIdx.x;
    for (int u = threadIdx.x; u < (LDS_BYTES - MISC_OFF) / 4; u += NWAVES * 64) MISC[u] = 0u;
    __syncthreads();
#if MK_ONE_LAUNCH
    XcdBarrier bar = xcd_barrier_post((unsigned*)(KWS() + WS_CTL) + CW_BAR, MISC + 40, wave);
#define GRID_BAR() xcd_barrier(bar, wave)
#else
#define GRID_BAR() do { } while (0)
#endif
    const int lo = args.ph_lo, hi = args.ph_hi;
#ifndef PHMASK
#define PHMASK 0xFFFFFFFFu
#endif
#define IN(k) ((((PHMASK) >> (k)) & 1u) && lo <= (k) && (k) < hi)
#ifndef REPMASK
#define REPMASK 0u
#endif
#define REPS(k) ((((REPMASK) >> (k)) & 1u) ? 2 : 1)
#define SEAM(k) do { if (IN(k) && IN((k) + 1)) GRID_BAR(); } while (0)

    for (int rep_ = 0; rep_ < REPS(0); ++rep_) if (IN(0)) { IDS();
        const float* cin = KIN(1); const float* ada_w = KIN(4); const float* ada_b = KIN(5); float* mod = WSP(float, WS_MOD); float* rope = WSP(float, WS_ROPE);
        LAS float* cact = (LAS float*)lds; LAS float* red = cact + 16384;
        if (bid < 192) for (int i = tid; i < 16 * 1024; i += 512) { const float v = cin[i]; cact[i] = v / (1.f + expf(-v)); }
        __syncthreads();
        for (int item = bid; item < 192; item += G) {
            const int l = item / 96, n0 = (item % 96) * 64, kg = tid >> 6, n = tid & 63;
            float acc[16];
#pragma unroll
            for (int b = 0; b < 16; ++b) acc[b] = 0.f;
            const float* w = ada_w + (size_t)l * 1024 * 6144 + n0 + n;
#pragma unroll 1
            for (int k = kg * 128; k < kg * 128 + 128; k += 16) {
                float wv[16];
#pragma unroll
                for (int u = 0; u < 16; ++u) wv[u] = w[(size_t)(k + u) * 6144];
#pragma unroll
                for (int u4 = 0; u4 < 4; ++u4)
#pragma unroll
                    for (int b = 0; b < 16; ++b) { const f32x4 cv = *(const LAS f32x4*)(cact + b * 1024 + k + 4 * u4);
                        acc[b] += cv.x * wv[4 * u4] + cv.y * wv[4 * u4 + 1] + cv.z * wv[4 * u4 + 2] + cv.w * wv[4 * u4 + 3]; }
            }
#pragma unroll
            for (int b = 0; b < 16; ++b) red[(kg * 16 + b) * 64 + n] = acc[b];
            __syncthreads();
            for (int i = tid; i < 1024; i += 512) {
                const int b = i >> 6, nn = i & 63; float s = 0.f;
#pragma unroll
                for (int q = 0; q < 8; ++q) s += red[(q * 16 + b) * 64 + nn];
                mod[((size_t)l * 16 + b) * 6144 + n0 + nn] = s + ada_b[l * 6144 + n0 + nn];
            }
            __syncthreads();
        }
        for (int i = bid * 512 + tid; i < 4096 * 8; i += G * 512) {
            const int t = i >> 3, f = i & 7;
            const float inv = powf(500000.0f, -(float)(2 * f) / 16.0f);
            const float ang = (float)t * inv;
            rope[i] = (float)cos((double)ang);
            rope[4096 * 8 + i] = (float)sin((double)ang);
        }
        __syncthreads();
        LAS float* scr = (LAS float*)(lds + wave * 16640);
        const float* conv_in_w = KIN(6); const float* conv_out_w = KIN(8); const float* attn_in_w = KIN(9); const float* attn_out_w = KIN(10);
        const float* gate_w = KIN(15); const float* up_w = KIN(16); const float* down_w = KIN(17);
        bf16_t* WZ = WSP(bf16_t, WS_WZ); bf16_t* WB = WSP(bf16_t, WS_WB); bf16_t* WCO = WSP(bf16_t, WS_WCO); bf16_t* WAI = WSP(bf16_t, WS_WAI); bf16_t* WAO = WSP(bf16_t, WS_WAO);
        bf16_t* WGU = WSP(bf16_t, WS_WGU); bf16_t* WDN = WSP(bf16_t, WS_WDN);
#define CONV_DECODE(DD, IT) do { int it = (IT); \
            if (it < 512) { conv_desc(DD, conv_in_w, 3072, 1024, WZ, 1024, 1, it / 32, it % 32); break; } it -= 512; \
            if (it < 256) { conv_desc(DD, conv_in_w, 3072, 0, WB, 1024, 0, it / 16, it % 16); break; } it -= 256; \
            if (it < 256) { conv_desc(DD, conv_out_w, 1024, 0, WCO, 1024, 0, it / 16, it % 16); break; } it -= 256; \
            if (it < 1152) { conv_desc(DD, attn_in_w, QKVW, 0, WAI, 1024, 2, it / 72, it % 72); break; } it -= 1152; \
            if (it < 128) { conv_desc(DD, attn_out_w, 1024, 0, WAO, 512, 0, it / 16, it % 16); break; } it -= 128; \
            const int le = it / 384, r = it % 384; \
            if (r < 128) conv_desc(DD, gate_w + (size_t)le * D * DEXP, DEXP, 0, WGU + (size_t)le * 1024 * 1024, 1024, 3, r / 8, r % 8); \
            else if (r < 256) conv_desc(DD, up_w + (size_t)le * D * DEXP, DEXP, 0, WGU + (size_t)le * 1024 * 1024, 1024, 4, (r - 128) / 8, (r - 128) % 8); \
            else conv_desc(DD, down_w + (size_t)le * DEXP * D, D, 0, WDN + (size_t)le * 1024 * 512, 512, 0, (r - 256) / 16, (r - 256) % 16); } while (0)
        {
            const int step = G * NWAVES; int it0 = bid * NWAVES + wave;
            ConvDesc dA, dB; f32x4 vA[16], vB[16];
            if (it0 < NCONV_ITEMS) { CONV_DECODE(dA, it0); conv_load(vA, dA, lane); }
#pragma unroll 1
            for (; it0 < NCONV_ITEMS; it0 += 2 * step) {
                const bool hasB = it0 + step < NCONV_ITEMS, hasA2 = it0 + 2 * step < NCONV_ITEMS;
                if (hasB) { CONV_DECODE(dB, it0 + step); conv_load(vB, dB, lane); }
                conv_process(vA, dA, scr, lane);
                if (hasA2) { CONV_DECODE(dA, it0 + 2 * step); conv_load(vA, dA, lane); }
                if (hasB) conv_process(vB, dB, scr, lane);
            }
        }
#undef CONV_DECODE
    }
    SEAM(0);
    for (int rep_ = 0; rep_ < REPS(1); ++rep_) if (IN(1)) { IDS();
        const float* x = KIN(0); const float* norm_mix_g = KIN(2); const float* mod = WSP(float, WS_MOD); bf16_t* xn = WSP(bf16_t, WS_XN);
        for (int w0 = (bid * 8 + wave) * 32; w0 < T; w0 += G * 8 * 32) {
            const float* mb = mod + (size_t)(w0 >> 12) * 6144;
            ModV mv; mod_load(mv, norm_mix_g, mb + 0, mb + 1024, lane);
            RowV r; row_load(r, x + (size_t)w0 * D, lane);
#pragma unroll 1
            for (int i = 0; i < 32; ++i) {
                const int row = w0 + i;
                RowV nx; if (i < 31) row_load(nx, x + (size_t)(row + 1) * D, lane); else nx = r;
                const float rstd = row_rstd(r);
                row_apply(r, rstd, mv);
                row_store_bf16(r, xn + (size_t)row * D, lane);
                r = nx;
            }
        }
    }
    SEAM(1);
    for (int rep_ = 0; rep_ < REPS(2); ++rep_) if (IN(2)) { bf16_t* xn = WSP(bf16_t, WS_XN); bf16_t* WZ = WSP(bf16_t, WS_WZ); bf16_t* zb = WSP(bf16_t, WS_Z);
        pg8::Gemm g{xn, WZ, T, 2048, 1024}; pg8::StaticOrder S; S.init(T, 2048, G, bid); pg8::EpiPair<false> E{zb, D};
        pg8::gemm_phase<pg8::EpiPair<false>, pg8::StaticOrder, pg8::APlain, true, true>(lds, g, S, E, pg8::APlain{}, wave); }
    SEAM(2);
    for (int rep_ = 0; rep_ < REPS(3); ++rep_) if (IN(3)) { bf16_t* xn = WSP(bf16_t, WS_XN); bf16_t* WB = WSP(bf16_t, WS_WB); bf16_t* zb = WSP(bf16_t, WS_Z); bf16_t* ypre = WSP(bf16_t, WS_YPRE); const float* conv_w = KIN(7);
        pg8::Gemm g{xn, WB, T, 1024, 1024}; pg8::StaticOrder S; S.init(T, 1024, G, bid); pg8::EpiYpre E{ypre, zb, conv_w};
        pg8::gemm_phase<pg8::EpiYpre, pg8::StaticOrder, pg8::APlain, true, true>(lds, g, S, E, pg8::APlain{}, wave); }
    SEAM(3);
    for (int rep_ = 0; rep_ < REPS(4); ++rep_) if (IN(4)) { bf16_t* ypre = WSP(bf16_t, WS_YPRE); bf16_t* WCO = WSP(bf16_t, WS_WCO); bf16_t* xr = (bf16_t*)KOUT(); const float* x = KIN(0); const float* mod = WSP(float, WS_MOD);
        pg8::Gemm g{ypre, WCO, T, 1024, 1024}; pg8::StaticOrder S; S.init(T, 1024, G, bid); pg8::EpiRes<true> E{xr, x, mod + 2048};
        pg8::gemm_phase<pg8::EpiRes<true>, pg8::StaticOrder, pg8::APlain, true, true>(lds, g, S, E, pg8::APlain{}, wave); }
    SEAM(4);
    { constexpr int l = 0;
        const int pb0 = (l == 0) ? 5 : 13;
#define MODL() (WSP(float, WS_MOD) + (size_t)l * 16 * 6144)
#define CNTL() (WSP(int, WS_CTL) + 64 * l)
        if (l == 1) {
#ifdef STAGGER9
            if (IN(9)) { const unsigned long long t0_ = __builtin_amdgcn_s_memrealtime(); const unsigned long long dl_ = (unsigned long long)(((bid >> 3) & 31) * STAGGER9 / 32);
                while (__builtin_amdgcn_s_memrealtime() - t0_ < dl_) __builtin_amdgcn_s_sleep(16); }
#endif
            for (int rep_ = 0; rep_ < REPS(9); ++rep_) if (IN(9)) { bf16_t* xn = WSP(bf16_t, WS_XN); bf16_t* WAI = WSP(bf16_t, WS_WAI); bf16_t* qkv = WSP(bf16_t, WS_QKV); const float* rope = WSP(float, WS_ROPE);
                pg8::Gemm g{xn, WAI, T, QKVW, 1024}; pg8::StaticOrder S; S.init(T, QKVW, G, bid); pg8::EpiQKV E{qkv, rope};
                pg8::gemm_phase<pg8::EpiQKV, pg8::StaticOrder, pg8::APlain, true, true>(lds, g, S, E, pg8::APlain{}, wave); }
            SEAM(9);
            if (IN(10)) att::attn_phase<false>(lds, WSP(bf16_t, WS_QKV), WSP(float, WS_LSE), WSP(bf16_t, WS_XN), bid, G, wave);
            SEAM(10);
            if (IN(11)) att::attn_phase<true>(lds, WSP(bf16_t, WS_QKV), WSP(float, WS_LSE), WSP(bf16_t, WS_XN), bid, G, wave);
            SEAM(11);
            if (IN(12)) { bf16_t* ob = WSP(bf16_t, WS_XN); bf16_t* WAO = WSP(bf16_t, WS_WAO); bf16_t* xr = (bf16_t*)KOUT();
                pg8::Gemm g{ob, WAO, T, 1024, 512}; pg8::StaticOrder S; S.init(T, 1024, G, bid); pg8::EpiRes<false> E{xr, nullptr, MODL() + 2048};
                pg8::gemm_phase<pg8::EpiRes<false>, pg8::StaticOrder, pg8::APlain, true, true>(lds, g, S, E, pg8::APlain{}, wave); }
            SEAM(12);
        }
        for (int rep_ = 0; rep_ < REPS(5); ++rep_) if (IN(pb0)) { IDS(); const bool dry = rep_ + 1 < REPS(5);
            LAS f32x4* TG = (LAS f32x4*)lds; LAS f32x4* TE = (LAS f32x4*)(lds + 16384);
            LAS int* rec_e = (LAS int*)(lds + 147456); LAS float* rec_w = (LAS float*)(lds + 147456 + 2048); LAS int* rec_rank = (LAS int*)(lds + 147456 + 4096);
            LAS int* hist = (LAS int*)(lds + 147456 + 6144); LAS int* base = (LAS int*)(lds + 147456 + 6144 + 128);
            const float* gff = KIN(3) + l * D; const float* wg = KIN(11) + (size_t)l * D * 4; const float* bg = KIN(12) + l * 4; const float* we = KIN(13) + (size_t)l * 4 * D * 8; const float* be = KIN(14) + l * 32;
            const bf16_t* xr = (const bf16_t*)KOUT(); const float* modl = MODL(); int* cntl = CNTL(); bf16_t* xn = WSP(bf16_t, WS_XN); int* ltok = WSP(int, WS_LTOK); float* lw = WSP(float, WS_LW); int* tslot = WSP(int, WS_TSLOT);
            for (int i = tid; i < 1024; i += 512) { const int ln = i & 63, jc = i >> 6, k = 4 * ln + 256 * (jc >> 2) + (jc & 3); TG[i] = *(const f32x4*)(wg + (size_t)k * 4); }
            for (int i = tid; i < 8192; i += 512) { const int ln = i & 63, jc = (i >> 6) & 15, half = (i >> 10) & 1, gi = i >> 11, k = 4 * ln + 256 * (jc >> 2) + (jc & 3);
                TE[i] = *(const f32x4*)(we + ((size_t)gi * 1024 + k) * 8 + half * 4); }
            __syncthreads();
            const bool h5 = (lane & 32) != 0, h4 = (lane & 16) != 0, h3 = (lane & 8) != 0;
            for (int blk = bid; blk < T / 256; blk += G) {
                if (tid < 32) hist[tid] = 0;
                __syncthreads();
                ModV mv; { const float* mb = modl + (size_t)((blk * 256) >> 12) * 6144; mod_load(mv, gff, mb + 3072, mb + 4096, lane); }
                RowV r; row_load_bf16(r, xr + (size_t)(blk * 256 + wave * 32) * XRP, lane);
#pragma unroll 1
                for (int i = 0; i < 32; ++i) {
                    const int rl = wave * 32 + i, row = blk * 256 + rl;
                    RowV nx; if (i < 31) row_load_bf16(nx, xr + (size_t)(row + 1) * XRP, lane); else nx = r;
                    const float rstd = row_rstd(r);
                    row_apply(r, rstd, mv);
                    row_store_bf16(r, xn + (size_t)row * D, lane);
                    f32x4 pg = {0.f, 0.f, 0.f, 0.f};
#pragma unroll
                    for (int jc = 0; jc < 16; ++jc) pg += TG[jc * 64 + lane] * r.v[jc >> 2][jc & 3];
                    float gl[4];
                    { float b0 = (h5 ? pg.z : pg.x) + xlane32(h5 ? pg.x : pg.z, h5), b1 = (h5 ? pg.w : pg.y) + xlane32(h5 ? pg.y : pg.w, h5);
                      float c = (h4 ? b1 : b0) + xlane<16>(h4 ? b0 : b1);
                      c += xlane<8>(c); c += xlane<4>(c); c += xlane<2>(c); c += xlane<1>(c);
#pragma unroll
                      for (int o = 0; o < 4; ++o) gl[o] = __int_as_float(__builtin_amdgcn_readlane(__float_as_int(c), 16 * o)) + bg[o]; }
                    int gi = 0; float gm = gl[0];
#pragma unroll
                    for (int o = 1; o < 4; ++o) if (gl[o] > gm) { gm = gl[o]; gi = o; }
                    float gden = 0.f;
#pragma unroll
                    for (int o = 0; o < 4; ++o) gden += expf(gl[o] - gm);
                    const float grp_p = 1.0f / gden;
                    f32x4 pa = {0.f, 0.f, 0.f, 0.f}, pb = {0.f, 0.f, 0.f, 0.f};
                    const LAS f32x4* te = TE + gi * 2048 + lane;
#pragma unroll
                    for (int jc = 0; jc < 16; ++jc) { const float hv = r.v[jc >> 2][jc & 3]; pa += te[jc * 64] * hv; pb += te[1024 + jc * 64] * hv; }
                    float el[8];
                    { const f32x4 keep = h5 ? pb : pa, send = h5 ? pa : pb;
                      f32x4 q; q.x = keep.x + xlane32(send.x, h5); q.y = keep.y + xlane32(send.y, h5); q.z = keep.z + xlane32(send.z, h5); q.w = keep.w + xlane32(send.w, h5);
                      const float b0 = (h4 ? q.z : q.x) + xlane<16>(h4 ? q.x : q.z), b1 = (h4 ? q.w : q.y) + xlane<16>(h4 ? q.y : q.w);
                      float c = (h3 ? b1 : b0) + xlane<8>(h3 ? b0 : b1);
                      c += xlane<4>(c); c += xlane<2>(c); c += xlane<1>(c);
#pragma unroll
                      for (int o = 0; o < 8; ++o) el[o] = __int_as_float(__builtin_amdgcn_readlane(__float_as_int(c), 8 * o)) + be[gi * 8 + o]; }
                    int i0 = 0; float m0 = el[0];
#pragma unroll
                    for (int o = 1; o < 8; ++o) if (el[o] > m0) { m0 = el[o]; i0 = o; }
                    int i1 = -1; float m1 = -INFINITY;
#pragma unroll
                    for (int o = 0; o < 8; ++o) if (o != i0 && el[o] > m1) { m1 = el[o]; i1 = o; }
                    const float p1 = expf(m1 - m0);
                    if (lane == 0) { rec_e[rl * 2] = gi * 8 + i0; rec_e[rl * 2 + 1] = gi * 8 + i1; rec_w[rl * 2] = grp_p / (1.0f + p1); rec_w[rl * 2 + 1] = grp_p * p1 / (1.0f + p1); }
                    r = nx;
                }
                __syncthreads();
                { const int e = rec_e[tid]; rec_rank[tid] = atomicAdd((int*)&hist[e], 1); }
                __syncthreads();
                if (tid < 32) { const int h = hist[tid]; base[tid] = (h && !dry) ? atomicAdd(&cntl[tid], h) : 0; }
                __syncthreads();
                { const int e = rec_e[tid], pos = base[e] + rec_rank[tid], tok = blk * 256 + (tid >> 1);
                  if (!dry) { ltok[(size_t)e * LISTCAP + pos] = tok; lw[(size_t)e * LISTCAP + pos] = rec_w[tid]; tslot[tok * 2 + (tid & 1)] = (e << 16) | pos; } }
                __syncthreads();
            }
        }
        SEAM(pb0);
        if (IN(pb0 + 1) || IN(pb0 + 2) || IN(pb0 + 3)) {
            __syncthreads();
            if (wave == 0 && lane_id() == 0) { const int* cntl = CNTL(); int s = 0;
#pragma unroll 1
                for (int e = 0; e < 32; ++e) { rb[e] = s; s += (__hip_atomic_load(&cntl[e], RLX_AGENT) + 255) & ~255; }
                rb[32] = s; }
            __syncthreads();
        }
        for (int rep_ = 0; rep_ < REPS(6); ++rep_) if (IN(pb0 + 1)) { bf16_t* xn = WSP(bf16_t, WS_XN); bf16_t* WGU = WSP(bf16_t, WS_WGU); bf16_t* act = WSP(bf16_t, WS_ACT); const int* ltok = WSP(int, WS_LTOK); const int* cntl = CNTL();
            pg8::Gemm g{xn, WGU + (size_t)l * 32 * 1024 * 1024, 0, 0, 1024}; pg8::MoeOrder S; S.init(rb[32] / 256, G, bid, rb); pg8::EpiPair<true> E{act, DEXP}; pg8::AGather am{ltok, cntl, rb};
            pg8::gemm_phase<pg8::EpiPair<true>, pg8::MoeOrder, pg8::AGather, true, true>(lds, g, S, E, am, wave); }
        SEAM(pb0 + 1);
        for (int rep_ = 0; rep_ < REPS(7); ++rep_) if (IN(pb0 + 2)) { bf16_t* act = WSP(bf16_t, WS_ACT); bf16_t* WDN = WSP(bf16_t, WS_WDN); bf16_t* yw = WSP(bf16_t, WS_YW); const float* lw = WSP(float, WS_LW);
            pg8::Gemm g{act, WDN + (size_t)l * 32 * 1024 * 512, 0, 0, 512}; pg8::MoeOrder S; S.init(rb[32] / 256, G, bid, rb); pg8::EpiDown E{yw, lw, rb};
            pg8::gemm_phase<pg8::EpiDown, pg8::MoeOrder, pg8::APlain, true, true>(lds, g, S, E, pg8::APlain{}, wave); }
        SEAM(pb0 + 2);
        for (int rep_ = 0; rep_ < REPS(8); ++rep_) if (IN(pb0 + 3)) { IDS(); const bool dry = rep_ + 1 < REPS(8);
            const float* gnext = (l == 0) ? KIN(2) + D : KIN(18);
            const float* modn = WSP(float, WS_MOD) + (size_t)16 * 6144; const float* modl = MODL();
            float* outf = KOUT(); bf16_t* xr = (bf16_t*)KOUT(); const bf16_t* yw = WSP(bf16_t, WS_YW); const int* tslot = WSP(int, WS_TSLOT); bf16_t* xn = WSP(bf16_t, WS_XN);
            for (int w0 = (bid * 8 + wave) * 32; w0 < T; w0 += G * 8 * 32) {
                const int b = w0 >> 12;
                f32x4 g2v[4];
#pragma unroll
                for (int j = 0; j < 4; ++j) g2v[j] = *(const f32x4*)(modl + (size_t)b * 6144 + 5120 + 4 * lane + 256 * j);
                ModV mv;
                if (l == 0) { const float* mb = modn + (size_t)b * 6144; mod_load(mv, gnext, mb + 0, mb + 1024, lane); }
                else {
#pragma unroll
                    for (int j = 0; j < 4; ++j) { mv.gp[j] = *(const f32x4*)(gnext + 4 * lane + 256 * j); mv.sh[j] = (f32x4){0.f, 0.f, 0.f, 0.f}; }
                }
                RowV r; u32x2 ya[4], yb[4];
#define R2_LOAD(R_, YA_, YB_, ROW_) do { const int s0_ = tslot[(ROW_) * 2], s1_ = tslot[(ROW_) * 2 + 1]; \
                    const size_t r0_ = (size_t)(rb[s0_ >> 16] + (s0_ & 0xffff)), r1_ = (size_t)(rb[s1_ >> 16] + (s1_ & 0xffff)); \
                    row_load_bf16(R_, xr + (size_t)(ROW_) * XRP, lane); \
                    _Pragma("unroll") for (int j = 0; j < 4; ++j) { YA_[j] = *(const u32x2*)(yw + r0_ * D + 4 * lane + 256 * j); YB_[j] = *(const u32x2*)(yw + r1_ * D + 4 * lane + 256 * j); } } while (0)
                R2_LOAD(r, ya, yb, w0);
#pragma unroll 1
                for (int i = 0; i < 32; ++i) {
                    const int row = w0 + i;
                    RowV nx; u32x2 na[4], nb[4];
                    if (i < 31) { R2_LOAD(nx, na, nb, row + 1); } else { nx = r;
#pragma unroll
                        for (int j = 0; j < 4; ++j) { na[j] = ya[j]; nb[j] = yb[j]; } }
#pragma unroll
                    for (int j = 0; j < 4; ++j) {
                        f32x4 y; y.x = bflo(ya[j].x) + bflo(yb[j].x); y.y = bfhi(ya[j].x) + bfhi(yb[j].x); y.z = bflo(ya[j].y) + bflo(yb[j].y); y.w = bfhi(ya[j].y) + bfhi(yb[j].y);
                        r.v[j] = r.v[j] + g2v[j] * y;
                    }
                    const float rstd = row_rstd(r);
                    if (dry) { asm volatile("" :: "v"(rstd), "v"(r.v[0].x), "v"(r.v[1].y), "v"(r.v[2].z), "v"(r.v[3].w)); }
                    else if (l == 1) { row_apply(r, rstd, mv); row_store_f32(r, outf + (size_t)row * D, lane); }
                    else { row_store_bf16(r, xr + (size_t)row * XRP, lane); row_apply(r, rstd, mv); row_store_bf16(r, xn + (size_t)row * D, lane); }
                    r = nx;
#pragma unroll
                    for (int j = 0; j < 4; ++j) { ya[j] = na[j]; yb[j] = nb[j]; }
                }
#undef R2_LOAD
            }
        }
        SEAM(pb0 + 3);
    }
    { constexpr int l = 1;
        const int pb0 = (l == 0) ? 5 : 13;
#define MODL() (WSP(float, WS_MOD) + (size_t)l * 16 * 6144)
#define CNTL() (WSP(int, WS_CTL) + 64 * l)
        if (l == 1) {
#ifdef STAGGER9
            if (IN(9)) { const unsigned long long t0_ = __builtin_amdgcn_s_memrealtime(); const unsigned long long dl_ = (unsigned long long)(((bid >> 3) & 31) * STAGGER9 / 32);
                while (__builtin_amdgcn_s_memrealtime() - t0_ < dl_) __builtin_amdgcn_s_sleep(16); }
#endif
            for (int rep_ = 0; rep_ < REPS(9); ++rep_) if (IN(9)) { bf16_t* xn = WSP(bf16_t, WS_XN); bf16_t* WAI = WSP(bf16_t, WS_WAI); bf16_t* qkv = WSP(bf16_t, WS_QKV); const float* rope = WSP(float, WS_ROPE);
                pg8::Gemm g{xn, WAI, T, QKVW, 1024}; pg8::StaticOrder S; S.init(T, QKVW, G, bid); pg8::EpiQKV E{qkv, rope};
                pg8::gemm_phase<pg8::EpiQKV, pg8::StaticOrder, pg8::APlain, true, true>(lds, g, S, E, pg8::APlain{}, wave); }
            SEAM(9);
            if (IN(10)) att::attn_phase<false>(lds, WSP(bf16_t, WS_QKV), WSP(float, WS_LSE), WSP(bf16_t, WS_XN), bid, G, wave);
            SEAM(10);
            if (IN(11)) att::attn_phase<true>(lds, WSP(bf16_t, WS_QKV), WSP(float, WS_LSE), WSP(bf16_t, WS_XN), bid, G, wave);
            SEAM(11);
            if (IN(12)) { bf16_t* ob = WSP(bf16_t, WS_XN); bf16_t* WAO = WSP(bf16_t, WS_WAO); bf16_t* xr = (bf16_t*)KOUT();
                pg8::Gemm g{ob, WAO, T, 1024, 512}; pg8::StaticOrder S; S.init(T, 1024, G, bid); pg8::EpiRes<false> E{xr, nullptr, MODL() + 2048};
                pg8::gemm_phase<pg8::EpiRes<false>, pg8::StaticOrder, pg8::APlain, true, true>(lds, g, S, E, pg8::APlain{}, wave); }
            SEAM(12);
        }
        for (int rep_ = 0; rep_ < REPS(5); ++rep_) if (IN(pb0)) { IDS(); const bool dry = rep_ + 1 < REPS(5);
            LAS f32x4* TG = (LAS f32x4*)lds; LAS f32x4* TE = (LAS f32x4*)(lds + 16384);
            LAS int* rec_e = (LAS int*)(lds + 147456); LAS float* rec_w = (LAS float*)(lds + 147456 + 2048); LAS int* rec_rank = (LAS int*)(lds + 147456 + 4096);
            LAS int* hist = (LAS int*)(lds + 147456 + 6144); LAS int* base = (LAS int*)(lds + 147456 + 6144 + 128);
            const float* gff = KIN(3) + l * D; const float* wg = KIN(11) + (size_t)l * D * 4; const float* bg = KIN(12) + l * 4; const float* we = KIN(13) + (size_t)l * 4 * D * 8; const float* be = KIN(14) + l * 32;
            const bf16_t* xr = (const bf16_t*)KOUT(); const float* modl = MODL(); int* cntl = CNTL(); bf16_t* xn = WSP(bf16_t, WS_XN); int* ltok = WSP(int, WS_LTOK); float* lw = WSP(float, WS_LW); int* tslot = WSP(int, WS_TSLOT);
            for (int i = tid; i < 1024; i += 512) { const int ln = i & 63, jc = i >> 6, k = 4 * ln + 256 * (jc >> 2) + (jc & 3); TG[i] = *(const f32x4*)(wg + (size_t)k * 4); }
            for (int i = tid; i < 8192; i += 512) { const int ln = i & 63, jc = (i >> 6) & 15, half = (i >> 10) & 1, gi = i >> 11, k = 4 * ln + 256 * (jc >> 2) + (jc & 3);
                TE[i] = *(const f32x4*)(we + ((size_t)gi * 1024 + k) * 8 + half * 4); }
            __syncthreads();
            const bool h5 = (lane & 32) != 0, h4 = (lane & 16) != 0, h3 = (lane & 8) != 0;
            for (int blk = bid; blk < T / 256; blk += G) {
                if (tid < 32) hist[tid] = 0;
                __syncthreads();
                ModV mv; { const float* mb = modl + (size_t)((blk * 256) >> 12) * 6144; mod_load(mv, gff, mb + 3072, mb + 4096, lane); }
                RowV r; row_load_bf16(r, xr + (size_t)(blk * 256 + wave * 32) * XRP, lane);
#pragma unroll 1
                for (int i = 0; i < 32; ++i) {
                    const int rl = wave * 32 + i, row = blk * 256 + rl;
                    RowV nx; if (i < 31) row_load_bf16(nx, xr + (size_t)(row + 1) * XRP, lane); else nx = r;
                    const float rstd = row_rstd(r);
                    row_apply(r, rstd, mv);
                    row_store_bf16(r, xn + (size_t)row * D, lane);
                    f32x4 pg = {0.f, 0.f, 0.f, 0.f};
#pragma unroll
                    for (int jc = 0; jc < 16; ++jc) pg += TG[jc * 64 + lane] * r.v[jc >> 2][jc & 3];
                    float gl[4];
                    { float b0 = (h5 ? pg.z : pg.x) + xlane32(h5 ? pg.x : pg.z, h5), b1 = (h5 ? pg.w : pg.y) + xlane32(h5 ? pg.y : pg.w, h5);
                      float c = (h4 ? b1 : b0) + xlane<16>(h4 ? b0 : b1);
                      c += xlane<8>(c); c += xlane<4>(c); c += xlane<2>(c); c += xlane<1>(c);
#pragma unroll
                      for (int o = 0; o < 4; ++o) gl[o] = __int_as_float(__builtin_amdgcn_readlane(__float_as_int(c), 16 * o)) + bg[o]; }
                    int gi = 0; float gm = gl[0];
#pragma unroll
                    for (int o = 1; o < 4; ++o) if (gl[o] > gm) { gm = gl[o]; gi = o; }
                    float gden = 0.f;
#pragma unroll
                    for (int o = 0; o < 4; ++o) gden += expf(gl[o] - gm);
                    const float grp_p = 1.0f / gden;
                    f32x4 pa = {0.f, 0.f, 0.f, 0.f}, pb = {0.f, 0.f, 0.f, 0.f};
                    const LAS f32x4* te = TE + gi * 2048 + lane;
#pragma unroll
                    for (int jc = 0; jc < 16; ++jc) { const float hv = r.v[jc >> 2][jc & 3]; pa += te[jc * 64] * hv; pb += te[1024 + jc * 64] * hv; }
                    float el[8];
                    { const f32x4 keep = h5 ? pb : pa, send = h5 ? pa : pb;
                      f32x4 q; q.x = keep.x + xlane32(send.x, h5); q.y = keep.y + xlane32(send.y, h5); q.z = keep.z + xlane32(send.z, h5); q.w = keep.w + xlane32(send.w, h5);
                      const float b0 = (h4 ? q.z : q.x) + xlane<16>(h4 ? q.x : q.z), b1 = (h4 ? q.w : q.y) + xlane<16>(h4 ? q.y : q.w);
                      float c = (h3 ? b1 : b0) + xlane<8>(h3 ? b0 : b1);
                      c += xlane<4>(c); c += xlane<2>(c); c += xlane<1>(c);
#pragma unroll
                      for (int o = 0; o < 8; ++o) el[o] = __int_as_float(__builtin_amdgcn_readlane(__float_as_int(c), 8 * o)) + be[gi * 8 + o]; }
                    int i0 = 0; float m0 = el[0];
#pragma unroll
                    for (int o = 1; o < 8; ++o) if (el[o] > m0) { m0 = el[o]; i0 = o; }
                    int i1 = -1; float m1 = -INFINITY;
#pragma unroll
                    for (int o = 0; o < 8; ++o) if (o != i0 && el[o] > m1) { m1 = el[o]; i1 = o; }
                    const float p1 = expf(m1 - m0);
                    if (lane == 0) { rec_e[rl * 2] = gi * 8 + i0; rec_e[rl * 2 + 1] = gi * 8 + i1; rec_w[rl * 2] = grp_p / (1.0f + p1); rec_w[rl * 2 + 1] = grp_p * p1 / (1.0f + p1); }
                    r = nx;
                }
                __syncthreads();
                { const int e = rec_e[tid]; rec_rank[tid] = atomicAdd((int*)&hist[e], 1); }
                __syncthreads();
                if (tid < 32) { const int h = hist[tid]; base[tid] = (h && !dry) ? atomicAdd(&cntl[tid], h) : 0; }
                __syncthreads();
                { const int e = rec_e[tid], pos = base[e] + rec_rank[tid], tok = blk * 256 + (tid >> 1);
                  if (!dry) { ltok[(size_t)e * LISTCAP + pos] = tok; lw[(size_t)e * LISTCAP + pos] = rec_w[tid]; tslot[tok * 2 + (tid & 1)] = (e << 16) | pos; } }
                __syncthreads();
            }
        }
        SEAM(pb0);
        if (IN(pb0 + 1) || IN(pb0 + 2) || IN(pb0 + 3)) {
            __syncthreads();
            if (wave == 0 && lane_id() == 0) { const int* cntl = CNTL(); int s = 0;
#pragma unroll 1
                for (int e = 0; e < 32; ++e) { rb[e] = s; s += (__hip_atomic_load(&cntl[e], RLX_AGENT) + 255) & ~255; }
                rb[32] = s; }
            __syncthreads();
        }
        for (int rep_ = 0; rep_ < REPS(6); ++rep_) if (IN(pb0 + 1)) { bf16_t* xn = WSP(bf16_t, WS_XN); bf16_t* WGU = WSP(bf16_t, WS_WGU); bf16_t* act = WSP(bf16_t, WS_ACT); const int* ltok = WSP(int, WS_LTOK); const int* cntl = CNTL();
            pg8::Gemm g{xn, WGU + (size_t)l * 32 * 1024 * 1024, 0, 0, 1024}; pg8::MoeOrder S; S.init(rb[32] / 256, G, bid, rb); pg8::EpiPair<true> E{act, DEXP}; pg8::AGather am{ltok, cntl, rb};
            pg8::gemm_phase<pg8::EpiPair<true>, pg8::MoeOrder, pg8::AGather, true, true>(lds, g, S, E, am, wave); }
        SEAM(pb0 + 1);
        for (int rep_ = 0; rep_ < REPS(7); ++rep_) if (IN(pb0 + 2)) { bf16_t* act = WSP(bf16_t, WS_ACT); bf16_t* WDN = WSP(bf16_t, WS_WDN); bf16_t* yw = WSP(bf16_t, WS_YW); const float* lw = WSP(float, WS_LW);
            pg8::Gemm g{act, WDN + (size_t)l * 32 * 1024 * 512, 0, 0, 512}; pg8::MoeOrder S; S.init(rb[32] / 256, G, bid, rb); pg8::EpiDown E{yw, lw, rb};
            pg8::gemm_phase<pg8::EpiDown, pg8::MoeOrder, pg8::APlain, true, true>(lds, g, S, E, pg8::APlain{}, wave); }
        SEAM(pb0 + 2);
        for (int rep_ = 0; rep_ < REPS(8); ++rep_) if (IN(pb0 + 3)) { IDS(); const bool dry = rep_ + 1 < REPS(8);
            const float* gnext = (l == 0) ? KIN(2) + D : KIN(18);
            const float* modn = WSP(float, WS_MOD) + (size_t)16 * 6144; const float* modl = MODL();
            float* outf = KOUT(); bf16_t* xr = (bf16_t*)KOUT(); const bf16_t* yw = WSP(bf16_t, WS_YW); const int* tslot = WSP(int, WS_TSLOT); bf16_t* xn = WSP(bf16_t, WS_XN);
            for (int w0 = (bid * 8 + wave) * 32; w0 < T; w0 += G * 8 * 32) {
                const int b = w0 >> 12;
                f32x4 g2v[4];
#pragma unroll
                for (int j = 0; j < 4; ++j) g2v[j] = *(const f32x4*)(modl + (size_t)b * 6144 + 5120 + 4 * lane + 256 * j);
                ModV mv;
                if (l == 0) { const float* mb = modn + (size_t)b * 6144; mod_load(mv, gnext, mb + 0, mb + 1024, lane); }
                else {
#pragma unroll
                    for (int j = 0; j < 4; ++j) { mv.gp[j] = *(const f32x4*)(gnext + 4 * lane + 256 * j); mv.sh[j] = (f32x4){0.f, 0.f, 0.f, 0.f}; }
                }
                RowV r; u32x2 ya[4], yb[4];
#define R2_LOAD(R_, YA_, YB_, ROW_) do { const int s0_ = tslot[(ROW_) * 2], s1_ = tslot[(ROW_) * 2 + 1]; \
                    const size_t r0_ = (size_t)(rb[s0_ >> 16] + (s0_ & 0xffff)), r1_ = (size_t)(rb[s1_ >> 16] + (s1_ & 0xffff)); \
                    row_load_bf16(R_, xr + (size_t)(ROW_) * XRP, lane); \
                    _Pragma("unroll") for (int j = 0; j < 4; ++j) { YA_[j] = *(const u32x2*)(yw + r0_ * D + 4 * lane + 256 * j); YB_[j] = *(const u32x2*)(yw + r1_ * D + 4 * lane + 256 * j); } } while (0)
                R2_LOAD(r, ya, yb, w0);
#pragma unroll 1
                for (int i = 0; i < 32; ++i) {
                    const int row = w0 + i;
                    RowV nx; u32x2 na[4], nb[4];
                    if (i < 31) { R2_LOAD(nx, na, nb, row + 1); } else { nx = r;
#pragma unroll
                        for (int j = 0; j < 4; ++j) { na[j] = ya[j]; nb[j] = yb[j]; } }
#pragma unroll
                    for (int j = 0; j < 4; ++j) {
                        f32x4 y; y.x = bflo(ya[j].x) + bflo(yb[j].x); y.y = bfhi(ya[j].x) + bfhi(yb[j].x); y.z = bflo(ya[j].y) + bflo(yb[j].y); y.w = bfhi(ya[j].y) + bfhi(yb[j].y);
                        r.v[j] = r.v[j] + g2v[j] * y;
                    }
                    const float rstd = row_rstd(r);
                    if (dry) { asm volatile("" :: "v"(rstd), "v"(r.v[0].x), "v"(r.v[1].y), "v"(r.v[2].z), "v"(r.v[3].w)); }
                    else if (l == 1) { row_apply(r, rstd, mv); row_store_f32(r, outf + (size_t)row * D, lane); }
                    else { row_store_bf16(r, xr + (size_t)row * XRP, lane); row_apply(r, rstd, mv); row_store_bf16(r, xn + (size_t)row * D, lane); }
                    r = nx;
#pragma unroll
                    for (int j = 0; j < 4; ++j) { ya[j] = na[j]; yb[j] = nb[j]; }
                }
#undef R2_LOAD
            }
        }
        SEAM(pb0 + 3);
    }
#undef IDS
#undef MODL
#undef CNTL
#undef IN
#undef SEAM
#undef GRID_BAR
}

extern "C" void kernel_launch(void* const* d_in, const int* in_sizes, int n_in, void* d_out, int out_size, void* d_ws, size_t ws_size, hipStream_t stream) {
    static int grid = 0;
    if (grid == 0) {
        if (n_in != 19 || out_size != T * D || ws_size < WS_END) { fprintf(stderr, "kernel_launch: unexpected shapes (n_in %d out %d ws %zu)\n", n_in, out_size, ws_size); grid = -1; return; }
        int dev = 0, cus = 0;
        if (hipGetDevice(&dev) != hipSuccess || hipDeviceGetAttribute(&cus, hipDeviceAttributeMultiprocessorCount, dev) != hipSuccess) { grid = -1; return; }
        if (hipFuncSetAttribute((const void*)mk_fwd, hipFuncAttributeMaxDynamicSharedMemorySize, LDS_BYTES) != hipSuccess) { fprintf(stderr, "kernel_launch: hipFuncSetAttribute failed\n"); grid = -1; return; }
        int per_cu = 0;
        if (hipOccupancyMaxActiveBlocksPerMultiprocessor(&per_cu, (const void*)mk_fwd, NWAVES * 64, LDS_BYTES) != hipSuccess || per_cu < 1) fprintf(stderr, "kernel_launch: occupancy query says %d\n", per_cu);
        (void)hipGetLastError();
        grid = cus;
    }
    if (grid < 0) return;
    (void)hipMemsetAsync((char*)d_ws + WS_CTL, 0, CTL_BYTES, stream);
    Args a{};
    for (int i = 0; i < 19; ++i) a.in[i] = (const float*)d_in[i];
    a.out = (float*)d_out; a.ws = (unsigned char*)d_ws;
#if MK_ONE_LAUNCH
    a.ph_lo = 0; a.ph_hi = NPHASE;
    hipLaunchKernelGGL(mk_fwd, dim3(grid), dim3(NWAVES * 64), LDS_BYTES, stream, a);
#else
    for (int p = 0; p < NPHASE; ++p) { a.ph_lo = p; a.ph_hi = p + 1; hipLaunchKernelGGL(mk_fwd, dim3(grid), dim3(NWAVES * 64), LDS_BYTES, stream, a); }
#endif
}
```

```cpp
#include <hip/hip_runtime.h>
#include <stdint.h>
#include <math.h>
#include <cstdio>

#ifndef MK_ONE_LAUNCH
#define MK_ONE_LAUNCH 1
#endif

typedef unsigned short bf16_t;
typedef float f32x4 __attribute__((ext_vector_type(4)));
typedef unsigned u32x2 __attribute__((ext_vector_type(2)));
typedef unsigned u32x4 __attribute__((ext_vector_type(4)));
#define GAS __attribute__((address_space(1)))
#define LAS __attribute__((address_space(3)))
typedef GAS unsigned gu32;
#define RLX_AGENT __ATOMIC_RELAXED, __HIP_MEMORY_SCOPE_AGENT

constexpr int D = 1024, BATCH = 16, SEQ = 4096, T = BATCH * SEQ;
constexpr int NEXP = 32, DEXP = 512, EPG = 8, NGRP = 4;
constexpr int QKVW = 4608;
__host__ __device__ __forceinline__ size_t qkv_block(int typ, int g, int b, int h) { return (size_t)((((typ * 3 + g) * 16 + b) * 8 + h)) * (4096 * 64); }
__host__ __device__ __forceinline__ int qkv_row(int pos, int g) { const int dsh = 2 * g; return ((pos & ((1 << dsh) - 1)) << (12 - dsh)) + (pos >> dsh); }
constexpr int LISTCAP = 65536;
constexpr int PADROWS = 139264;
constexpr float EPS = 1e-6f;
constexpr float QSCALE = 0.125f * 1.4426950408889634f;
constexpr int NWAVES = 8;
constexpr int XRP = 2048;

constexpr size_t MiB = 1u << 20;
constexpr size_t WS_CTL = 0;
constexpr size_t CTL_BYTES = 1 * MiB;
constexpr int CW_BAR = 4096;
constexpr size_t WS_MOD = 1 * MiB;
constexpr size_t WS_ROPE = 3 * MiB;
constexpr size_t WS_LTOK = 4 * MiB;
constexpr size_t WS_LW = 12 * MiB;
constexpr size_t WS_TSLOT = 20 * MiB;
constexpr size_t WS_LSE = 24 * MiB;
constexpr size_t WS_WZ = 32 * MiB;
constexpr size_t WS_WB = 36 * MiB;
constexpr size_t WS_WCO = 38 * MiB;
constexpr size_t WS_WAI = 40 * MiB;
constexpr size_t WS_WAO = 49 * MiB;
constexpr size_t WS_WGU = 64 * MiB;
constexpr size_t WS_WDN = 192 * MiB;
constexpr size_t WS_XN = 256 * MiB;
constexpr size_t WS_BIG = 384 * MiB;
constexpr size_t WS_Z = WS_BIG, WS_YPRE = WS_BIG + 128 * MiB;
constexpr size_t WS_ACT = WS_BIG, WS_YW = WS_BIG + 136 * MiB;
constexpr size_t WS_QKV = WS_BIG;
constexpr size_t WS_END = WS_BIG + 576 * MiB;

constexpr int RING_BYTES = 162816;
constexpr int MISC_OFF = RING_BYTES;
constexpr int LDS_BYTES = RING_BYTES + 1024;

__device__ __forceinline__ unsigned f2bf(float f) { unsigned u = __float_as_uint(f); return (u + 0x7fffu + ((u >> 16) & 1u)) >> 16; }
__device__ __forceinline__ unsigned pk2(float lo, float hi) { return f2bf(lo) | (f2bf(hi) << 16); }
__device__ __forceinline__ float bf2f(unsigned h) { return __uint_as_float(h << 16); }
__device__ __forceinline__ float bflo(unsigned w) { return __uint_as_float(w << 16); }
__device__ __forceinline__ float bfhi(unsigned w) { return __uint_as_float(w & 0xffff0000u); }
template <int M> __device__ __forceinline__ float xlane(float v) {
    return __int_as_float(__builtin_amdgcn_ds_swizzle(__float_as_int(v), (M << 10) | 0x1f));
}
__device__ __forceinline__ float xlane32(float v, bool hi) {
    auto rr = __builtin_amdgcn_permlane32_swap(__float_as_uint(v), __float_as_uint(v), false, false); return __uint_as_float(hi ? rr[0] : rr[1]);
}
__device__ __forceinline__ float wave_sum(float v) {
    v += xlane<1>(v); v += xlane<2>(v); v += xlane<4>(v); v += xlane<8>(v); v += xlane<16>(v);
    auto rr = __builtin_amdgcn_permlane32_swap(__float_as_uint(v), __float_as_uint(v), false, false);
    return __uint_as_float(rr[0]) + __uint_as_float(rr[1]);
}
__device__ __forceinline__ float silu_f(float x) { return x / (1.0f + __expf(-x)); }
#define LDS_WAIT() asm volatile("s_waitcnt lgkmcnt(0)" ::: "memory")
template <class V> __device__ __forceinline__ V ntload(const V* p) { return __builtin_nontemporal_load(p); }
__device__ __forceinline__ int lane_id() { int l; asm volatile("v_mbcnt_lo_u32_b32 %0, -1, 0\n\tv_mbcnt_hi_u32_b32 %0, -1, %0" : "=v"(l)); return l; }

namespace pg8 {
#define PG8_LAS __attribute__((address_space(3)))
typedef unsigned short bf16_t;
typedef short bf16x8 __attribute__((ext_vector_type(8)));
typedef float f32x4 __attribute__((ext_vector_type(4)));
typedef unsigned u32x4 __attribute__((ext_vector_type(4)));
constexpr int BM = 256, BK = 64, HALF = 128, HTB = HALF * BK * 2  , STAGE_BYTES = 8 * HTB, NXCD = 8, WGM = 4;

__host__ __device__ __forceinline__ int lds_byte(int r, int c) { const int st = (r >> 4) * 2 + (c >> 5), rr = r & 15, cc = c & 31, ob = rr * 64 + cc * 2; return st * 1024 + (ob ^ (((ob >> 9) & 1) << 5)); }
__host__ __device__ __forceinline__ void stage_rc(int b, int& R, int& C) { const int st = b / 1024, sb = b % 1024, swz = sb ^ (((sb >> 9) & 1) << 5); R = (st >> 1) * 16 + swz / 64; C = (st & 1) * 32 + (swz % 64) / 2; }
__host__ __device__ __forceinline__ int perm32(int rho) { const int n = rho >> 4, i = rho & 15; return 8 * (i >> 2) + 4 * n + (i & 3); }

struct Unit { int pm, pn, pb; };
struct Gemm { const bf16_t* A; const bf16_t* Bt; int M, N, K; };

struct StaticOrder {
    int nM, nN, nwg, G, c;
    __host__ __device__ void init(int M, int N, int G_, int c_) { nM = M / BM; nN = N / BM; nwg = nM * nN; G = G_; c = c_; }
    __host__ __device__ bool next(int i, Unit& u) const {
        const long L = (long)i * G + c; if (L >= nwg) return false;
        int wgid = (int)L; { const int q = nwg / NXCD, r = nwg % NXCD, xcd = wgid % NXCD, off = wgid / NXCD; wgid = (xcd < r ? xcd * (q + 1) : r * (q + 1) + (xcd - r) * q) + off; }
        const int nig = WGM * nN, gid = wgid / nig, fm = gid * WGM, gsz = (nM - fm) < WGM ? (nM - fm) : WGM;
        u.pm = fm + ((wgid % nig) % gsz); u.pn = (wgid % nig) / gsz; u.pb = u.pn; return true;
    }
    __device__ __forceinline__ void a_ready(const Unit&) const {}
    __device__ __forceinline__ void done(const Unit&) const {}
};


__device__ __forceinline__ unsigned cvt_pk_bf16(float lo, float hi) { unsigned r; asm volatile("v_cvt_pk_bf16_f32 %0, %1, %2" : "=v"(r) : "v"(lo), "v"(hi)); return r; }
typedef float f32x2 __attribute__((ext_vector_type(2)));

template <class Epi, class Sched, class AM, bool ALIGN_EPI = false, bool SP2 = false>
__device__ __forceinline__ void gemm_phase(PG8_LAS unsigned char* lds, const Gemm g, const Sched& S, const Epi& E, const AM& am, const int wid_in) {
    int wid = wid_in; asm volatile("" : "+s"(wid));
    const int lane = lane_id(), tid = wid * 64 + lane, wr = wid >> 2, wc = wid & 3, fr = lane & 15, fq = lane >> 4;
    const int K = g.K, nt = K / BK;
    unsigned voffA[2], voffB[2]; int stR[2], stC[2];
#pragma unroll
    for (int i = 0; i < 2; ++i) { int R, C; stage_rc(tid * 16 + i * 8192, R, C); const int Rb = Epi::PERM ? ((R & ~31) + perm32(R & 31)) : R;
        stR[i] = R; stC[i] = C; voffA[i] = (unsigned)(R * K + C) * 2u; voffB[i] = (unsigned)(Rb * K + C) * 2u; }
    const size_t kstep = (size_t)(BK * 2);
    const size_t hstep = (size_t)HALF * K * 2;
    const size_t tstep = 2 * hstep;
    const unsigned ldsw = (unsigned)wid * 1024u;
    const int aoff = lds_byte(wr * 64 + fr, fq * 8), boff = lds_byte(wc * 32 + fr, fq * 8);
#define PG8_SA(b, h) (((b) * 2 + (h)) * HTB)
#define PG8_SB(b, h) ((4 + (b) * 2 + (h)) * HTB)
#define PG8_STAGE(bufoff, gbase, voff) do { _Pragma("unroll") for (int _i = 0; _i < 2; ++_i) \
        __builtin_amdgcn_global_load_lds((const unsigned*)((const char*)(gbase) + (voff)[_i]), (PG8_LAS unsigned*)(lds + (bufoff) + ldsw + _i * 8192), 16, 0, 0); } while (0)
#define PG8_STAGE_A(b, h, gbase, NX) do { if constexpr (AM::GATHER) { const unsigned so_[2] = {(NX) ? gno[h][0] : gao[h][0], (NX) ? gno[h][1] : gao[h][1]}; PG8_STAGE(PG8_SA(b, h), gbase, so_); } \
        else { PG8_STAGE(PG8_SA(b, h), (gbase) + (h) * hstep, voffA); } } while (0)
#define PG8_LDA(dst, b, h) do { _Pragma("unroll") for (int m = 0; m < 4; ++m) _Pragma("unroll") for (int k = 0; k < 2; ++k) dst[m][k] = *(const PG8_LAS bf16x8*)(lds + PG8_SA(b, h) + aoff + m * 2048 + k * 1024); } while (0)
#define PG8_LDB(dst, b, h) do { _Pragma("unroll") for (int n = 0; n < 2; ++n) _Pragma("unroll") for (int k = 0; k < 2; ++k) dst[n][k] = *(const PG8_LAS bf16x8*)(lds + PG8_SB(b, h) + boff + n * 2048 + k * 1024); } while (0)
#define PG8_MMA(ai, bj, At, Bt) do { __builtin_amdgcn_s_setprio(1); _Pragma("unroll") for (int m = 0; m < 4; ++m) _Pragma("unroll") for (int n = 0; n < 2; ++n) _Pragma("unroll") for (int k = 0; k < 2; ++k) \
        acc[ai][bj][m][n] = __builtin_amdgcn_mfma_f32_16x16x32_bf16(Bt[n][k], At[m][k], acc[ai][bj][m][n], 0, 0, 0); __builtin_amdgcn_s_setprio(0); } while (0)
#define PG8_WAIT_V(n) asm volatile("s_waitcnt vmcnt(" #n ")" ::: "memory")
#define PG8_WAIT_L(n) asm volatile("s_waitcnt lgkmcnt(" #n ")" ::: "memory")
#define PG8_BAR __builtin_amdgcn_s_barrier()
#define PG8_SCHED __builtin_amdgcn_sched_barrier(0)
    Unit cur, nxt; int ui = 0;
    if (!S.next(0, cur)) return;
    f32x4 acc[2][2][4][2];
#pragma unroll
    for (int a = 0; a < 2; ++a)
#pragma unroll
        for (int b = 0; b < 2; ++b)
#pragma unroll
            for (int m = 0; m < 4; ++m)
#pragma unroll
                for (int n = 0; n < 2; ++n) acc[a][b][m][n] = (f32x4){0.f, 0.f, 0.f, 0.f};
    bf16x8 At[4][2], B0[2][2], B1[2][2];
    const char* cA = (const char*)g.A + (AM::GATHER ? (size_t)0 : (size_t)cur.pm * tstep); const char* cB = (const char*)g.Bt + (size_t)cur.pb * tstep;
    unsigned gao[2][2], gno[2][2];
    if constexpr (AM::GATHER) { _Pragma("unroll") for (int h = 0; h < 2; ++h) _Pragma("unroll") for (int i = 0; i < 2; ++i) { gao[h][i] = (unsigned)(am.arow(cur, h * HALF + stR[i]) * K + stC[i]) * 2u; gno[h][i] = gao[h][i]; } }
    else { _Pragma("unroll") for (int h = 0; h < 2; ++h) _Pragma("unroll") for (int i = 0; i < 2; ++i) { gao[h][i] = 0u; gno[h][i] = 0u; } }
    S.a_ready(cur);
    if constexpr (SP2) {
        PG8_STAGE(PG8_SB(0, 0), cB, voffB); PG8_STAGE(PG8_SB(0, 1), cB + hstep, voffB); PG8_STAGE_A(0, 0, cA, false); PG8_STAGE_A(0, 1, cA, false);
        if (wr == 1) PG8_BAR;
        PG8_WAIT_V(2); PG8_BAR;
        PG8_STAGE(PG8_SB(1, 0), cB + kstep, voffB); PG8_STAGE_A(1, 0, cA + kstep, false); PG8_STAGE(PG8_SB(1, 1), cB + hstep + kstep, voffB);
        PG8_WAIT_V(6); PG8_BAR;
    } else {
        PG8_STAGE(PG8_SB(0, 0), cB, voffB); PG8_STAGE_A(0, 0, cA, false); PG8_STAGE(PG8_SB(0, 1), cB + hstep, voffB); PG8_STAGE_A(0, 1, cA, false);
        if (wr == 1) PG8_BAR;
        PG8_WAIT_V(4); PG8_BAR;
        PG8_STAGE(PG8_SB(1, 0), cB + kstep, voffB); PG8_STAGE_A(1, 0, cA + kstep, false); PG8_STAGE(PG8_SB(1, 1), cB + hstep + kstep, voffB);
        PG8_WAIT_V(6); PG8_BAR;
    }
    for (;;) {
        const bool has_next = S.next(ui + 1, nxt);
        const char* nA = has_next ? (const char*)g.A + (AM::GATHER ? (size_t)0 : (size_t)nxt.pm * tstep) : cA; const char* nB = has_next ? (const char*)g.Bt + (size_t)nxt.pb * tstep : cB;
        if constexpr (AM::GATHER) { if (has_next) { _Pragma("unroll") for (int h = 0; h < 2; ++h) _Pragma("unroll") for (int i = 0; i < 2; ++i) gno[h][i] = (unsigned)(am.arow(nxt, h * HALF + stR[i]) * K + stC[i]) * 2u; } }
        for (int t = 0; t < nt; t += 2) {
            const bool last = (t == nt - 2);
            const char* a1 = cA + (size_t)(t + 1) * kstep;
            const char* a2 = last ? nA : cA + (size_t)(t + 2) * kstep; const char* b2 = last ? nB : cB + (size_t)(t + 2) * kstep;
            const char* a3 = a2 + kstep; const char* b3 = b2 + kstep;
            if (last && has_next) S.a_ready(nxt);
            if (false) E.prefetch(cur, tid, (PG8_LAS unsigned*)(lds + 162816 + 512));
            if constexpr (SP2) {
            PG8_LDB(B0, 0, 0); PG8_LDB(B1, 0, 1); PG8_SCHED; PG8_LDA(At, 0, 0); PG8_STAGE_A(1, 1, a1, false);
            PG8_WAIT_V(8); PG8_WAIT_L(0); PG8_BAR; PG8_MMA(0, 0, At, B0); PG8_MMA(0, 1, At, B1); PG8_BAR; PG8_SCHED;
            PG8_LDA(At, 0, 1); PG8_STAGE(PG8_SB(0, 0), b2, voffB); PG8_STAGE(PG8_SB(0, 1), b2 + hstep, voffB); PG8_STAGE_A(0, 0, a2, last);
            PG8_WAIT_V(8); PG8_WAIT_L(0); PG8_BAR; PG8_MMA(1, 0, At, B0); PG8_MMA(1, 1, At, B1); PG8_BAR; PG8_SCHED;
            PG8_LDB(B0, 1, 0); PG8_LDB(B1, 1, 1); PG8_SCHED; PG8_LDA(At, 1, 0); PG8_STAGE_A(0, 1, a2, last);
            PG8_WAIT_V(8); PG8_WAIT_L(0); PG8_BAR; PG8_MMA(0, 0, At, B0); PG8_MMA(0, 1, At, B1); PG8_BAR; PG8_SCHED;
            PG8_LDA(At, 1, 1); PG8_STAGE(PG8_SB(1, 0), b3, voffB); PG8_STAGE(PG8_SB(1, 1), b3 + hstep, voffB); PG8_STAGE_A(1, 0, a3, last);
            PG8_WAIT_V(8); PG8_WAIT_L(0); PG8_BAR; PG8_MMA(1, 0, At, B0); PG8_MMA(1, 1, At, B1); PG8_BAR; PG8_SCHED;
            } else {
            PG8_LDB(B0, 0, 0); PG8_SCHED; PG8_LDA(At, 0, 0); PG8_STAGE_A(1, 1, a1, false);
            PG8_WAIT_L(8); PG8_BAR; PG8_WAIT_L(0); PG8_MMA(0, 0, At, B0); PG8_BAR; PG8_SCHED;
            PG8_LDB(B1, 0, 1); PG8_STAGE(PG8_SB(0, 0), b2, voffB);
            PG8_BAR; PG8_WAIT_L(0); PG8_MMA(0, 1, At, B1); PG8_BAR;
            PG8_LDA(At, 0, 1); PG8_STAGE_A(0, 0, a2, last);
            PG8_BAR; PG8_WAIT_L(0); PG8_MMA(1, 0, At, B0); PG8_BAR; PG8_SCHED;
            PG8_STAGE(PG8_SB(0, 1), b2 + hstep, voffB);
            PG8_WAIT_V(6); PG8_BAR; PG8_MMA(1, 1, At, B1); PG8_BAR;
            PG8_LDB(B0, 1, 0); PG8_SCHED; PG8_LDA(At, 1, 0); PG8_STAGE_A(0, 1, a2, last);
            PG8_WAIT_L(8); PG8_BAR; PG8_WAIT_L(0); PG8_MMA(0, 0, At, B0); PG8_BAR; PG8_SCHED;
            PG8_LDB(B1, 1, 1); PG8_STAGE(PG8_SB(1, 0), b3, voffB);
            PG8_BAR; PG8_WAIT_L(0); PG8_MMA(0, 1, At, B1); PG8_BAR;
            PG8_LDA(At, 1, 1); PG8_STAGE_A(1, 0, a3, last);
            PG8_BAR; PG8_WAIT_L(0); PG8_MMA(1, 0, At, B0); PG8_BAR; PG8_SCHED;
            PG8_STAGE(PG8_SB(1, 1), b3 + hstep, voffB);
            PG8_WAIT_V(6); PG8_BAR; PG8_MMA(1, 1, At, B1); PG8_BAR;
            }
        }
        if constexpr (ALIGN_EPI) { if (wr == 0) PG8_BAR; }
        if constexpr (!Epi::AFTER_DRAIN) { E(acc, cur, wr, wc, fr, fq); S.done(cur); }
        if (!has_next) break;
#pragma unroll
        for (int a = 0; a < 2; ++a)
#pragma unroll
            for (int b = 0; b < 2; ++b)
#pragma unroll
                for (int m = 0; m < 4; ++m)
#pragma unroll
                    for (int n = 0; n < 2; ++n) acc[a][b][m][n] = (f32x4){0.f, 0.f, 0.f, 0.f};
        cur = nxt; cA = nA; cB = nB; ++ui;
        if constexpr (AM::GATHER) { _Pragma("unroll") for (int h = 0; h < 2; ++h) _Pragma("unroll") for (int i = 0; i < 2; ++i) gao[h][i] = gno[h][i]; }
        if constexpr (ALIGN_EPI) { if (wr == 1) PG8_BAR; }
    }
    PG8_WAIT_V(0);
    if constexpr (!ALIGN_EPI) { if (wr == 0) PG8_BAR; }
    PG8_BAR;
    if constexpr (Epi::AFTER_DRAIN) { E.fused(acc, cur, wr, wc, fr, fq, lds, wid, lane); S.done(cur); }
#undef PG8_SA
#undef PG8_SB
#undef PG8_STAGE
#undef PG8_STAGE_A
#undef PG8_LDA
#undef PG8_LDB
#undef PG8_MMA
#undef PG8_WAIT_V
#undef PG8_WAIT_L
#undef PG8_BAR
#undef PG8_SCHED
}

__device__ __forceinline__ u32x4 pack8(const f32x4 v0, const f32x4 v1) { u32x4 w; w.x = cvt_pk_bf16(v0[0], v0[1]); w.y = cvt_pk_bf16(v0[2], v0[3]); w.z = cvt_pk_bf16(v1[0], v1[1]); w.w = cvt_pk_bf16(v1[2], v1[3]); return w; }
__device__ __forceinline__ u32x4 xpose4x16(const u32x4 w, int sa) {
    u32x4 r; r.x = __builtin_amdgcn_ds_bpermute(sa, w.x); r.y = __builtin_amdgcn_ds_bpermute(sa, w.y); r.z = __builtin_amdgcn_ds_bpermute(sa, w.z); r.w = __builtin_amdgcn_ds_bpermute(sa, w.w); return r;
}
#define XPOSE_IDS() const int L_ = fr + 16 * fq, tr_ = L_ >> 2, tq_ = L_ & 3, sa_ = 4 * (tr_ + 16 * tq_)
__device__ __forceinline__ float silu1(float x) { return x * __builtin_amdgcn_rcpf(1.0f + __builtin_amdgcn_exp2f(-1.4426950408889634f * x)); }
template <bool SILU> struct EpiPair {
    static constexpr bool PERM = true, AFTER_DRAIN = false;
    bf16_t* O; int ldc;
    __device__ __forceinline__ void prefetch(const Unit&, int, PG8_LAS unsigned*) const {}
    __device__ __forceinline__ void operator()(const f32x4 (&acc)[2][2][4][2], const Unit& u, int wr, int wc, int fr, int fq) const {
        XPOSE_IDS();
        const int row0 = u.pm * BM + wr * 64 + tr_, ch0 = u.pn * HALF + wc * 32 + 8 * tq_;
#pragma unroll
        for (int ai = 0; ai < 2; ++ai)
#pragma unroll
            for (int m = 0; m < 4; ++m) {
                f32x4 a0 = acc[ai][0][m][0], a1 = acc[ai][0][m][1];
                if (SILU) {
#pragma unroll
                    for (int c = 0; c < 4; ++c) { a0[c] = silu1(a0[c]); a1[c] = silu1(a1[c]); }
                }
                *(u32x4*)(O + (size_t)(row0 + ai * HALF + m * 16) * ldc + ch0) = xpose4x16(pack8(a0 * acc[ai][1][m][0], a1 * acc[ai][1][m][1]), sa_);
            }
    }
};
struct EpiYpre {
    static constexpr bool PERM = true, AFTER_DRAIN = false;
    bf16_t* O; const bf16_t* Z; const float* cw;
    __device__ __forceinline__ void prefetch(const Unit& u, int tid, PG8_LAS unsigned* dummy) const {
#pragma unroll
        for (int i = 0; i < 2; ++i) { const int line = tid + 512 * i, row = line >> 2, seg = line & 3;
            __builtin_amdgcn_global_load_lds((const unsigned*)(Z + (size_t)(u.pm * BM + row) * D + u.pn * BM + seg * 64), dummy, 4, 0, 0); }
    }
    __device__ __forceinline__ void operator()(const f32x4 (&acc)[2][2][4][2], const Unit& u, int wr, int wc, int fr, int fq) const {
        XPOSE_IDS();
        const int row0 = u.pm * BM + wr * 64 + fr;
#pragma unroll
        for (int bj = 0; bj < 2; ++bj) {
            const int col0 = u.pn * BM + bj * HALF + wc * 32 + 8 * fq;
            f32x4 w0[2], w1[2], w2[2];
#pragma unroll
            for (int n = 0; n < 2; ++n) { w0[n] = *(const f32x4*)(cw + col0 + 4 * n); w1[n] = *(const f32x4*)(cw + D + col0 + 4 * n); w2[n] = *(const f32x4*)(cw + 2 * D + col0 + 4 * n); }
#pragma unroll
            for (int ai = 0; ai < 2; ++ai) {
                u32x4 zz[4][3];
#pragma unroll
                for (int m = 0; m < 4; ++m) {
                    const int row = row0 + ai * HALF + m * 16, t = row & (SEQ - 1);
                    const bf16_t* zp = Z + (size_t)row * D + col0;
                    zz[m][0] = *(const u32x4*)zp; zz[m][1] = (u32x4){0u, 0u, 0u, 0u}; zz[m][2] = (u32x4){0u, 0u, 0u, 0u};
                    if (t >= 1) zz[m][1] = *(const u32x4*)(zp - D);
                    if (t >= 2) zz[m][2] = *(const u32x4*)(zp - 2 * D);
                }
#pragma unroll
                for (int m = 0; m < 4; ++m) {
                    const int row = row0 + ai * HALF + m * 16;
                    const u32x4 z0 = zz[m][0], z1 = zz[m][1], z2 = zz[m][2];
                    f32x4 v[2];
#pragma unroll
                    for (int n = 0; n < 2; ++n) {
                        f32x4 a, b, c;
                        a[0] = __uint_as_float(z0[2 * n] << 16); a[1] = __uint_as_float(z0[2 * n] & 0xffff0000u); a[2] = __uint_as_float(z0[2 * n + 1] << 16); a[3] = __uint_as_float(z0[2 * n + 1] & 0xffff0000u);
                        b[0] = __uint_as_float(z1[2 * n] << 16); b[1] = __uint_as_float(z1[2 * n] & 0xffff0000u); b[2] = __uint_as_float(z1[2 * n + 1] << 16); b[3] = __uint_as_float(z1[2 * n + 1] & 0xffff0000u);
                        c[0] = __uint_as_float(z2[2 * n] << 16); c[1] = __uint_as_float(z2[2 * n] & 0xffff0000u); c[2] = __uint_as_float(z2[2 * n + 1] << 16); c[3] = __uint_as_float(z2[2 * n + 1] & 0xffff0000u);
                        v[n] = acc[ai][bj][m][n] * (w2[n] * a + w1[n] * b + w0[n] * c);
                    }
                    *(u32x4*)(O + (size_t)(row - fr + tr_) * D + col0 - 8 * fq + 8 * tq_) = xpose4x16(pack8(v[0], v[1]), sa_);
                }
                asm volatile("" ::: "memory");
            }
        }
    }
};

template <bool RES_F32> struct EpiRes {
    static constexpr bool PERM = true, AFTER_DRAIN = false;
    bf16_t* xr; const float* xin; const float* modg;
    __device__ __forceinline__ void prefetch(const Unit&, int, PG8_LAS unsigned*) const {}
    __device__ __forceinline__ void operator()(const f32x4 (&acc)[2][2][4][2], const Unit& u, int wr, int wc, int fr, int fq) const {
        XPOSE_IDS();
        const int row0 = u.pm * BM + wr * 64 + fr, col0 = u.pn * BM + wc * 32 + 8 * fq;
        const float* gb = modg + (size_t)((u.pm * BM) >> 12) * 6144;
        f32x4 gv[2][2];
#pragma unroll
        for (int bj = 0; bj < 2; ++bj)
#pragma unroll
            for (int n = 0; n < 2; ++n) gv[bj][n] = *(const f32x4*)(gb + col0 + bj * HALF + n * 4);
        if constexpr (!RES_F32) {
            u32x4 rw[2][4][2];
#pragma unroll
            for (int ai = 0; ai < 2; ++ai)
#pragma unroll
                for (int m = 0; m < 4; ++m)
#pragma unroll
                    for (int bj = 0; bj < 2; ++bj) rw[ai][m][bj] = *(const u32x4*)(xr + (size_t)(row0 + ai * HALF + m * 16) * XRP + col0 + bj * HALF);
            asm volatile("" ::: "memory");
#pragma unroll
            for (int ai = 0; ai < 2; ++ai)
#pragma unroll
                for (int m = 0; m < 4; ++m) { const int row = row0 + ai * HALF + m * 16;
#pragma unroll
                    for (int bj = 0; bj < 2; ++bj) { const u32x4 w = rw[ai][m][bj];
                        const f32x4 r0 = {__uint_as_float(w.x << 16), __uint_as_float(w.x & 0xffff0000u), __uint_as_float(w.y << 16), __uint_as_float(w.y & 0xffff0000u)};
                        const f32x4 r1 = {__uint_as_float(w.z << 16), __uint_as_float(w.z & 0xffff0000u), __uint_as_float(w.w << 16), __uint_as_float(w.w & 0xffff0000u)};
                        *(u32x4*)(xr + (size_t)(row - fr + tr_) * XRP + col0 - 8 * fq + 8 * tq_ + bj * HALF) = xpose4x16(pack8(r0 + gv[bj][0] * acc[ai][bj][m][0], r1 + gv[bj][1] * acc[ai][bj][m][1]), sa_); } }
        } else {
#pragma unroll
        for (int ai = 0; ai < 2; ++ai) {
            f32x4 rv[4][2][2];
#pragma unroll
            for (int m = 0; m < 4; ++m) { const int row = row0 + ai * HALF + m * 16;
#pragma unroll
                for (int bj = 0; bj < 2; ++bj) { rv[m][bj][0] = ntload((const f32x4*)(xin + (size_t)row * D + col0 + bj * HALF)); rv[m][bj][1] = ntload((const f32x4*)(xin + (size_t)row * D + col0 + bj * HALF + 4)); } }
#pragma unroll
            for (int m = 0; m < 4; ++m) { const int row = row0 + ai * HALF + m * 16;
#pragma unroll
                for (int bj = 0; bj < 2; ++bj)
                    *(u32x4*)(xr + (size_t)(row - fr + tr_) * XRP + col0 - 8 * fq + 8 * tq_ + bj * HALF) = xpose4x16(pack8(rv[m][bj][0] + gv[bj][0] * acc[ai][bj][m][0], rv[m][bj][1] + gv[bj][1] * acc[ai][bj][m][1]), sa_); }
            asm volatile("" ::: "memory");
        }
        }
    }
};
struct EpiQKV {
    static constexpr bool PERM = true, AFTER_DRAIN = false;
    bf16_t* O; const float* rope; int row_off;
    __device__ __forceinline__ void prefetch(const Unit&, int, PG8_LAS unsigned*) const {}
    __device__ __forceinline__ void operator()(const f32x4 (&acc)[2][2][4][2], const Unit& u, int wr, int wc, int fr, int fq) const {
        XPOSE_IDS();
        const int row0 = u.pm * BM + wr * 64 + fr, col0 = u.pn * BM + wc * 32 + 8 * fq;
        const int typ = (u.pn % 6) >> 1, gq_ = u.pn / 6;
        const bool rl = (typ < 2) && ((wc & 1) == 0) && (fq < 2);
        const float sc = (typ == 0) ? QSCALE : 1.0f;
#pragma unroll
        for (int ai = 0; ai < 2; ++ai)
#pragma unroll
        for (int mp = 0; mp < 2; ++mp) {
            f32x4 csv[2], snv[2];
#pragma unroll
            for (int mm = 0; mm < 2; ++mm) { const int pos = (row0 + ai * HALF + (2 * mp + mm) * 16) & (SEQ - 1);
                csv[mm] = *(const f32x4*)(rope + pos * 8 + 4 * (fq & 1)); snv[mm] = *(const f32x4*)(rope + 4096 * 8 + pos * 8 + 4 * (fq & 1)); }
#pragma unroll
            for (int mm = 0; mm < 2; ++mm) {
                const int m = 2 * mp + mm, row = row0 + ai * HALF + m * 16;
                f32x4 cs = {1.f, 1.f, 1.f, 1.f}, sn = {0.f, 0.f, 0.f, 0.f};
                if (rl) { cs = csv[mm]; sn = snv[mm]; }
#pragma unroll
                for (int bj = 0; bj < 2; ++bj) {
                    const f32x4 x1 = acc[ai][bj][m][0], x2 = acc[ai][bj][m][1];
                    const f32x4 r1 = (x1 * cs - x2 * sn) * sc, r2 = (x2 * cs + x1 * sn) * sc;
                    { const int tok = row_off + row - fr + tr_, hh = 4 * (u.pn & 1) + 2 * bj + (wc >> 1);
                      *(u32x4*)(O + qkv_block(typ, gq_, tok >> 12, hh) + (size_t)qkv_row(tok & (SEQ - 1), gq_) * 64 + 32 * (wc & 1) + 8 * tq_) = xpose4x16(pack8(r1, r2), sa_); }
                }
            }
            asm volatile("" ::: "memory");
        }
    }
};
struct EpiDown {
    static constexpr bool PERM = true, AFTER_DRAIN = false;
    bf16_t* O; const float* lw; const PG8_LAS int* rb;
    __device__ __forceinline__ void prefetch(const Unit&, int, PG8_LAS unsigned*) const {}
    __device__ __forceinline__ void operator()(const f32x4 (&acc)[2][2][4][2], const Unit& u, int wr, int wc, int fr, int fq) const {
        XPOSE_IDS();
        const int row0 = u.pm * BM + wr * 64 + fr, col0 = u.pn * BM + wc * 32 + 8 * fq;
        const int e = u.pb >> 2; const float* wrow = lw + (size_t)e * LISTCAP - rb[e];
        float wv[2][4];
#pragma unroll
        for (int ai = 0; ai < 2; ++ai)
#pragma unroll
            for (int m = 0; m < 4; ++m) wv[ai][m] = wrow[row0 + ai * HALF + m * 16];
#pragma unroll
        for (int ai = 0; ai < 2; ++ai)
#pragma unroll
            for (int m = 0; m < 4; ++m) {
                const int row = row0 + ai * HALF + m * 16; const float w = wv[ai][m];
#pragma unroll
                for (int bj = 0; bj < 2; ++bj) *(u32x4*)(O + (size_t)(row - fr + tr_) * D + col0 - 8 * fq + 8 * tq_ + bj * HALF) = xpose4x16(pack8(acc[ai][bj][m][0] * w, acc[ai][bj][m][1] * w), sa_);
            }
    }
};
struct MoeOrder {
    int nM, nN, nwg, G, c; const PG8_LAS int* rb;
    __device__ void init(int nRT, int G_, int c_, const PG8_LAS int* rb_) { nM = nRT; nN = 4; nwg = nM * nN; G = G_; c = c_; rb = rb_; }
    __device__ bool next(int i, Unit& u) const {
        const long L = (long)i * G + c; if (L >= nwg) return false;
        int wgid = (int)L; { const int q = nwg / NXCD, r = nwg % NXCD, xcd = wgid % NXCD, off = wgid / NXCD; wgid = (xcd < r ? xcd * (q + 1) : r * (q + 1) + (xcd - r) * q) + off; }
        const int nig = WGM * nN, gid = wgid / nig, fm = gid * WGM, gsz = (nM - fm) < WGM ? (nM - fm) : WGM;
        u.pm = fm + ((wgid % nig) % gsz); u.pn = (wgid % nig) / gsz;
        int e = 0; const int r0 = u.pm * BM;
#pragma unroll 1
        while (e < 31 && rb[e + 1] <= r0) ++e;
        u.pb = e * 4 + u.pn; return true;
    }
    __device__ __forceinline__ void a_ready(const Unit&) const {}
    __device__ __forceinline__ void done(const Unit&) const {}
};
struct APlain { static constexpr bool GATHER = false; __device__ __forceinline__ int arow(const Unit&, int) const { return 0; } };
struct AGather {
    static constexpr bool GATHER = true;
    const int* ltok; const int* cnt; const PG8_LAS int* rb;
    __device__ __forceinline__ int arow(const Unit& u, int r) const { const int e = u.pb >> 2, l = u.pm * BM - rb[e] + r; return (l < cnt[e]) ? ltok[(size_t)e * LISTCAP + l] : 0; }
};
}

#define XB_TMO      128
#define XB_XCNT(j)  (256  + 64 * (j))
#define XB_XSUB(j)  (1280 + 64 * (j))
#define XB_XGEN(j)  (2304 + 64 * (j))
#define XB_TOP      3328
#define XB_TOPGEN   3392
#define XCD_BAR_WORDS 3456
#define XB_SPIN_CAP (1u << 18)

__device__ __forceinline__ unsigned xb_ld(unsigned* p)              { return __hip_atomic_load(p, __ATOMIC_RELAXED, __HIP_MEMORY_SCOPE_AGENT); }
__device__ __forceinline__ unsigned xb_add(unsigned* p, unsigned v) { return __hip_atomic_fetch_add(p, v, __ATOMIC_RELAXED, __HIP_MEMORY_SCOPE_AGENT); }
__device__ __forceinline__ unsigned xb_xcc_id() { return (unsigned)__builtin_amdgcn_s_getreg((3 << 11) | 20) & 0xFu; }
#define XB_SPIN(cond, bar) do { unsigned _sp = 0; while (cond) { __builtin_amdgcn_s_sleep(1); \
    if ((++_sp & 255u) == 0u) { if (xb_ld(&(bar)[XB_TMO])) break; if (_sp > XB_SPIN_CAP) { atomicAdd(&(bar)[XB_TMO], 1u); break; } } } } while (0)

struct XcdBarrier {
    unsigned* bar; unsigned x;
    volatile LAS unsigned* st;
};

__device__ __forceinline__ XcdBarrier xcd_barrier_post(unsigned* bar, volatile LAS unsigned* st, int wave) {
    XcdBarrier b; b.bar = bar; b.x = xb_xcc_id(); b.st = st;
    if (wave == 0 && lane_id() == 0) (void)xb_add(&bar[XB_XCNT(b.x)], 1u);
    return b;
}
__device__ __forceinline__ void xcd_barrier_complete(unsigned* bar, unsigned x, unsigned& nloc, unsigned& nx) {
    const unsigned G = gridDim.x * gridDim.y * gridDim.z;
    unsigned sum, cnt, mine, sp = 0u;
    for (;;) {
        sum = 0u; cnt = 0u; mine = 0u;
#pragma unroll
        for (unsigned j = 0; j < 16; ++j) { const unsigned c = xb_ld(&bar[XB_XCNT(j)]); sum += c; cnt += (c > 0u) ? 1u : 0u; mine = (j == x) ? c : mine; }
        if (sum == G) break;
        __builtin_amdgcn_s_sleep(1);
        if ((++sp & 255u) == 0u) { if (xb_ld(&bar[XB_TMO])) break; if (sp > XB_SPIN_CAP) { atomicAdd(&bar[XB_TMO], 1u); break; } }
    }
    nloc = mine > 0u ? mine : 1u; nx = cnt > 0u ? cnt : 1u;
}

__device__ __forceinline__ void xcd_barrier(const XcdBarrier& b, int wave) {
    asm volatile("s_waitcnt vmcnt(0)" ::: "memory");
    __syncthreads();
    if (wave == 0 && lane_id() == 0) {
        unsigned* bar = b.bar;
        __builtin_amdgcn_s_waitcnt(0);
        unsigned nloc = b.st[0], nx = b.st[1];
        if (nloc == 0u) { xcd_barrier_complete(bar, b.x, nloc, nx); b.st[0] = nloc; b.st[1] = nx; }
        const unsigned old = xb_add(&bar[XB_XSUB(b.x)], 1u);
        const unsigned gen = old / nloc;
        if (old + 1u == (gen + 1u) * nloc) {
            __builtin_amdgcn_fence(__ATOMIC_RELEASE, "agent");
            asm volatile("s_waitcnt vmcnt(0)" ::: "memory");
            const unsigned og = xb_add(&bar[XB_TOP], 1u);
            const unsigned tg = og / nx;
            if (og + 1u == (tg + 1u) * nx) xb_add(&bar[XB_TOPGEN], 1u);
            else XB_SPIN(xb_ld(&bar[XB_TOPGEN]) == tg, bar);
            __builtin_amdgcn_fence(__ATOMIC_ACQUIRE, "agent");
            xb_add(&bar[XB_XGEN(b.x)], 1u);
            asm volatile("s_waitcnt vmcnt(0)" ::: "memory");
        } else {
            XB_SPIN(xb_ld(&bar[XB_XGEN(b.x)]) == gen, bar);
            __builtin_amdgcn_fence(__ATOMIC_ACQUIRE, "agent");
            asm volatile("s_waitcnt vmcnt(0)" ::: "memory");
        }
    }
    __syncthreads();
}

struct RowV { f32x4 v[4]; };
__device__ __forceinline__ void row_load(RowV& r, const float* row, int lane) {
#pragma unroll
    for (int j = 0; j < 4; ++j) r.v[j] = ntload((const f32x4*)(row + 4 * lane + 256 * j));
}
__device__ __forceinline__ void row_load_bf16(RowV& r, const bf16_t* row, int lane) {
#pragma unroll
    for (int j = 0; j < 4; ++j) { const u32x2 w = *(const u32x2*)(row + 4 * lane + 256 * j); r.v[j] = (f32x4){bflo(w.x), bfhi(w.x), bflo(w.y), bfhi(w.y)}; }
}
__device__ __forceinline__ float row_rstd(const RowV& r) {
    float s = 0.f;
#pragma unroll
    for (int j = 0; j < 4; ++j) s += (r.v[j].x * r.v[j].x + r.v[j].y * r.v[j].y) + (r.v[j].z * r.v[j].z + r.v[j].w * r.v[j].w);
    s = wave_sum(s);
    return __builtin_amdgcn_rsqf(s * (1.0f / 1024.0f) + EPS);
}
__device__ __forceinline__ void row_modulate(RowV& r, float rstd, const float* g, const float* sh, const float* sc, int lane) {
#pragma unroll
    for (int j = 0; j < 4; ++j) {
        const int o = 4 * lane + 256 * j;
        const f32x4 gg = *(const f32x4*)(g + o), s = *(const f32x4*)(sc + o), h = *(const f32x4*)(sh + o);
        r.v[j] = (r.v[j] * rstd * gg) * (s + 1.0f) + h;
    }
}
struct ModV { f32x4 gp[4], sh[4]; };
__device__ __forceinline__ void mod_load(ModV& m, const float* g, const float* sh, const float* sc, int lane) {
#pragma unroll
    for (int j = 0; j < 4; ++j) { const int o = 4 * lane + 256 * j; m.gp[j] = *(const f32x4*)(g + o) * (*(const f32x4*)(sc + o) + 1.0f); m.sh[j] = *(const f32x4*)(sh + o); }
}
__device__ __forceinline__ void row_apply(RowV& r, float rstd, const ModV& m) {
#pragma unroll
    for (int j = 0; j < 4; ++j) r.v[j] = (r.v[j] * rstd) * m.gp[j] + m.sh[j];
}
__device__ __forceinline__ void row_store_bf16(const RowV& r, bf16_t* out, int lane) {
#pragma unroll
    for (int j = 0; j < 4; ++j) { u32x2 w; w.x = pg8::cvt_pk_bf16(r.v[j].x, r.v[j].y); w.y = pg8::cvt_pk_bf16(r.v[j].z, r.v[j].w); *(u32x2*)(out + 4 * lane + 256 * j) = w; }
}
__device__ __forceinline__ void row_store_f32(const RowV& r, float* out, int lane) {
#pragma unroll
    for (int j = 0; j < 4; ++j) *(f32x4*)(out + 4 * lane + 256 * j) = r.v[j];
}

__device__ __forceinline__ int wmap(int code, int n) {
    if (code == 1) { const int isU = n >> 10, ch = n & 1023; return (ch >> 7) * 256 + isU * 128 + (ch & 127); }
    if (code == 2) { const int typ = (n % 1536) / 512, d = n & 63; return (typ < 2 && d >= 4 && d < 12) ? (d < 8 ? n + 4 : n - 4) : n; }
    if (code == 3) return (n >> 7) * 256 + (n & 127);
    if (code == 4) return (n >> 7) * 256 + 128 + (n & 127);
    return n;
}
struct ConvDesc { const float* src; bf16_t* dst; int ldw, K, code, nloc; };
__device__ __forceinline__ void conv_desc(ConvDesc& d, const float* W, int ldw, int ncol0, bf16_t* WT, int K, int code, int kb, int nb) {
    d.src = W + (size_t)(64 * kb) * ldw + ncol0 + 64 * nb; d.dst = WT + 64 * kb; d.ldw = ldw; d.K = K; d.code = code; d.nloc = 64 * nb;
}
__device__ __forceinline__ void conv_load(f32x4 (&v)[16], const ConvDesc& d, int lane) {
    const float* src = d.src + (size_t)(lane >> 4) * d.ldw + (lane & 15) * 4;
#pragma unroll
    for (int i = 0; i < 16; ++i) v[i] = ntload((const f32x4*)(src + (size_t)(4 * i) * d.ldw));
}
__device__ __forceinline__ void conv_process(const f32x4 (&v)[16], const ConvDesc& d, LAS float* scr, int lane) {
#pragma unroll
    for (int i = 0; i < 16; ++i) { LAS float* p = scr + (4 * i + (lane >> 4)) * 65 + (lane & 15) * 4; p[0] = v[i].x; p[1] = v[i].y; p[2] = v[i].z; p[3] = v[i].w; }
    LDS_WAIT();
    const int c = lane & 7;
#pragma unroll
    for (int j = 0; j < 8; ++j) { const int n = (lane >> 3) + 8 * j; const LAS float* sp = scr + (8 * c) * 65 + n;
        u32x4 o; o.x = pg8::cvt_pk_bf16(sp[0 * 65], sp[1 * 65]); o.y = pg8::cvt_pk_bf16(sp[2 * 65], sp[3 * 65]); o.z = pg8::cvt_pk_bf16(sp[4 * 65], sp[5 * 65]); o.w = pg8::cvt_pk_bf16(sp[6 * 65], sp[7 * 65]);
        *(u32x4*)(d.dst + (size_t)wmap(d.code, d.nloc + n) * d.K + 8 * c) = o; }
    LDS_WAIT();
}
constexpr int NCONV_ITEMS = 512 + 256 + 256 + 1152 + 128 + 64 * 384;

namespace att {
typedef short bf16x8 __attribute__((ext_vector_type(8)));
typedef short s16x4 __attribute__((ext_vector_type(4)));
typedef float f32x16 __attribute__((ext_vector_type(16)));
constexpr int NKEY = 384, KOFF = 0, KCH = NKEY * 16 + 16  , VOFF = 8 * KCH, VDH = (NKEY / 16) * 1024 + 64  , NUNITS = 16 * 3 * 16 * 8;
__device__ __forceinline__ int crow(int r, int hi) { return (r & 3) + 8 * (r >> 2) + 4 * hi; }
__device__ __forceinline__ s16x4 vtr(const LAS unsigned char* p) { return __builtin_bit_cast(s16x4, __builtin_amdgcn_ds_read_tr16_b64_v4i16((LAS s16x4*)p)); }
__device__ __forceinline__ float xhalf_max(float m) { auto rr = __builtin_amdgcn_permlane32_swap(__float_as_uint(m), __float_as_uint(m), false, false); return fmaxf(__uint_as_float(rr[0]), __uint_as_float(rr[1])); }
__device__ __forceinline__ float xhalf_sum(float m) { auto rr = __builtin_amdgcn_permlane32_swap(__float_as_uint(m), __float_as_uint(m), false, false); return __uint_as_float(rr[0]) + __uint_as_float(rr[1]); }

template <typename P> __device__ __forceinline__ P sadd(P base, unsigned off) { asm volatile("" : "+v"(off)); return base + off; }
struct AUnit { int h, g, b, dil, l0, r0; size_t tb; };
template <bool MERGE> __device__ __forceinline__ void adecode(AUnit& u, int idx) {
    const int sb = ((idx >> 4) & 7) * 2 + (idx & 1), bg = idx >> 7; u.b = MERGE ? bg : (bg >> 1);
    u.h = (idx >> 1) & 7; u.g = MERGE ? 2 : (bg & 1); const int dsh = 2 * u.g; u.dil = 1 << dsh;
    const int bps = 16 >> dsh, r = sb / bps; u.l0 = (sb - r * bps) * 256; u.r0 = r << (12 - dsh); u.tb = (size_t)u.b * SEQ + r;
}
__device__ __forceinline__ void aload_kv(u32x4 (&kv)[12], const AUnit& u, const bf16_t* qkv, int wave, int lane) {
    const char* kb = (const char*)(qkv + qkv_block(1, u.g, u.b, u.h) + (size_t)u.r0 * 64); const char* vb = kb + (qkv_block(2, 0, 0, 0) - qkv_block(1, 0, 0, 0)) * 2;
#pragma unroll
    for (int i = 0; i < 6; ++i) {
        int sp = u.l0 - 128 + 48 * wave + 8 * i + (lane >> 3); sp = sp < 0 ? 0 : sp;
        const unsigned ro = (unsigned)sp * 128u + (unsigned)(lane & 7) * 16u;
        kv[i] = *(const u32x4*)sadd(kb, ro); kv[6 + i] = *(const u32x4*)sadd(vb, ro);
    }
}
__device__ __forceinline__ void astore_kv(const u32x4 (&kv)[12], LAS unsigned char* lds, int wave, int lane) {
#pragma unroll
    for (int i = 0; i < 6; ++i) { const int key = 48 * wave + 8 * i + (lane >> 3);
        *(LAS u32x4*)(lds + KOFF + (lane & 7) * KCH + key * 16) = kv[i];
        *(LAS u32x4*)(lds + VOFF + ((lane & 7) >> 2) * VDH + (key >> 4) * 1024 + (key & 15) * 64 + (lane & 3) * 16) = kv[6 + i]; }
}
__device__ __forceinline__ char* aqrow(const AUnit& u, bf16_t* qkv, int wave) {
    return (char*)(qkv + qkv_block(0, u.g, u.b, u.h) + (size_t)(u.r0 + u.l0 + 32 * wave) * 64);
}

template <bool MERGE> __device__ __forceinline__ void attn_phase(LAS unsigned char* lds, bf16_t* qkv, float* lse, bf16_t* ob, int bid, int G, int wave, bool dry = false) {
    constexpr int NU = MERGE ? NUNITS / 3 : 2 * NUNITS / 3;
    const int per = (NU + G - 1) / G;
    const int u_lo = bid * per, u_hi = (u_lo + per < NU) ? u_lo + per : NU;
    asm volatile("" : "+s"(wave));
    const int lane = lane_id(), r32 = lane & 31, hi = lane >> 5;
    const int qt = wave;
    const unsigned qlo = (unsigned)r32 * 128u + (unsigned)hi * 16u;
    u32x4 kv[12]; bf16x8 qn[4];
    AUnit un;
    if (u_lo < u_hi) { adecode<MERGE>(un, u_lo); aload_kv(kv, un, qkv, wave, lane);
        { const char* q = aqrow(un, qkv, wave);
#pragma unroll
            for (int d0 = 0; d0 < 4; ++d0) qn[d0] = *(const bf16x8*)(sadd(q, qlo) + d0 * 32); } }
#pragma unroll 1
    for (int idx = u_lo; idx < u_hi; ++idx) {
        const AUnit u = un;
        const int g = u.g, l0 = u.l0, head = u.h;
        char* qrow = aqrow(u, qkv, wave);
        const size_t tqw = u.tb + (size_t)(l0 + 32 * qt) * u.dil;
        bf16x8 qf[4];
        astore_kv(kv, lds, wave, lane);
#pragma unroll
        for (int d0 = 0; d0 < 4; ++d0) qf[d0] = qn[d0];
        __syncthreads();
        if (idx + 1 < u_hi) { adecode<MERGE>(un, idx + 1); aload_kv(kv, un, qkv, wave, lane);
            { const char* q = aqrow(un, qkv, wave);
#pragma unroll
                for (int d0 = 0; d0 < 4; ++d0) qn[d0] = *(const bf16x8*)(sadd(q, qlo) + d0 * 32); } }
        u32x2 og[MERGE ? 2 : 1][2][4]; float lg0 = 0.f, lg1 = 0.f;
        if constexpr (MERGE) {
            const int pq = (int)(tqw & (SEQ - 1)) + r32 * u.dil; const char* oq0 = (const char*)(qkv + qkv_block(0, 0, u.b, head)); const char* oq1 = (const char*)(qkv + qkv_block(0, 1, u.b, head));
            const unsigned oo0 = (unsigned)qkv_row(pq, 0) * 128u + 8u * hi, oo1 = (unsigned)qkv_row(pq, 1) * 128u + 8u * hi;
#pragma unroll
            for (int gg = 0; gg < 2; ++gg)
#pragma unroll
                for (int d0 = 0; d0 < 2; ++d0)
#pragma unroll
                    for (int rg = 0; rg < 4; ++rg) og[gg][d0][rg] = *(const u32x2*)(sadd(gg ? oq1 : oq0, gg ? oo1 : oo0) + (d0 * 64 + 16 * rg));
            const char* lb = (const char*)(lse + tqw * 24 + head); const unsigned lo_ = (unsigned)(r32 * u.dil) * 96u;
            lg0 = *(const float*)sadd(lb, lo_); lg1 = *(const float*)(sadd(lb, lo_) + 32);
        }
        f32x16 p[5];
        const LAS unsigned char* kb = lds + KOFF + hi * KCH + (qt * 32 + r32) * 16;
#pragma unroll
        for (int j = 0; j < 5; ++j) {
#pragma unroll
            for (int rr = 0; rr < 16; ++rr) p[j][rr] = 0.f;
#pragma unroll
            for (int d0 = 0; d0 < 4; ++d0) {
                const bf16x8 kf = *(const LAS bf16x8*)(kb + j * 512 + d0 * 2 * KCH);
                p[j] = __builtin_amdgcn_mfma_f32_32x32x16_bf16(kf, qf[d0], p[j], 0, 0, 0);
            }
        }
#pragma unroll
        for (int rr = 0; rr < 16; ++rr) { const int c = crow(rr, hi); if (c < r32) p[0][rr] = -INFINITY; if (c > r32) p[4][rr] = -INFINITY; }
        if (l0 == 0) {
#pragma unroll
            for (int j = 0; j < 5; ++j)
#pragma unroll
                for (int rr = 0; rr < 16; ++rr) if (32 * (qt + j) + crow(rr, hi) < 128) p[j][rr] = -INFINITY;
        }
        float m = p[0][0];
#pragma unroll
        for (int j = 0; j < 5; ++j)
#pragma unroll
            for (int rr = 0; rr < 16; ++rr) m = fmaxf(m, p[j][rr]);
        m = xhalf_max(m);
        float l = 0.f;
#pragma unroll
        for (int j = 0; j < 5; ++j)
#pragma unroll
            for (int rr = 0; rr < 16; ++rr) { const float e = __builtin_amdgcn_exp2f(p[j][rr] - m); p[j][rr] = e; l += e; }
        l = xhalf_sum(l);
        f32x16 o[2];
#pragma unroll
        for (int rr = 0; rr < 16; ++rr) { o[0][rr] = 0.f; o[1][rr] = 0.f; }
        const LAS unsigned char* vb = lds + VOFF + ((lane >> 4) & 1) * 32 + (lane & 3) * 8 + (4 * hi + ((lane & 15) >> 2)) * 64 + qt * 2048;
#pragma unroll
        for (int j = 0; j < 5; ++j)
#pragma unroll
            for (int s = 0; s < 2; ++s) {
                u32x4 pw; pw.x = pg8::cvt_pk_bf16(p[j][8 * s + 0], p[j][8 * s + 1]); pw.y = pg8::cvt_pk_bf16(p[j][8 * s + 2], p[j][8 * s + 3]);
                pw.z = pg8::cvt_pk_bf16(p[j][8 * s + 4], p[j][8 * s + 5]); pw.w = pg8::cvt_pk_bf16(p[j][8 * s + 6], p[j][8 * s + 7]);
                const bf16x8 pf = __builtin_bit_cast(bf16x8, pw);
#pragma unroll
                for (int d0 = 0; d0 < 2; ++d0) {
                    const s16x4 vlo = vtr(vb + d0 * VDH + (2 * j + s) * 1024), vhi = vtr(vb + d0 * VDH + (2 * j + s) * 1024 + 512);
                    const bf16x8 vf = {vlo[0], vlo[1], vlo[2], vlo[3], vhi[0], vhi[1], vhi[2], vhi[3]};
                    o[d0] = __builtin_amdgcn_mfma_f32_32x32x16_bf16(vf, pf, o[d0], 0, 0, 0);
                }
            }
        if constexpr (!MERGE) {
            const float inv = 1.0f / l;
#pragma unroll
            for (int d0 = 0; d0 < 2; ++d0)
#pragma unroll
                for (int rg = 0; rg < 4; ++rg) {
                    u32x2 w; w.x = pg8::cvt_pk_bf16(o[d0][4 * rg] * inv, o[d0][4 * rg + 1] * inv); w.y = pg8::cvt_pk_bf16(o[d0][4 * rg + 2] * inv, o[d0][4 * rg + 3] * inv);
                    if (!dry) *(u32x2*)(sadd(qrow, (unsigned)r32 * 128u + 8u * hi) + (d0 * 64 + 16 * rg)) = w; else asm volatile("" :: "v"(w.x), "v"(w.y));
                }
            if (hi == 0 && !dry) *(float*)((char*)(lse + tqw * 24 + g * 8 + head) + (unsigned)(r32 * u.dil) * 96u) = m + __builtin_amdgcn_logf(l);
        } else {
            const float lg2 = m + __builtin_amdgcn_logf(l), mx = fmaxf(lg2, fmaxf(lg0, lg1));
            const float w0 = __builtin_amdgcn_exp2f(lg0 - mx), w1 = __builtin_amdgcn_exp2f(lg1 - mx), w2 = __builtin_amdgcn_exp2f(lg2 - mx);
            const float iw = 1.0f / (w0 + w1 + w2), c0 = w0 * iw, c1 = w1 * iw, c2 = w2 * iw / l;
            char* orow = (char*)(ob + tqw * 512 + head * 64); const unsigned oro = (unsigned)(r32 * u.dil) * 1024u + 8u * hi;
#pragma unroll
            for (int d0 = 0; d0 < 2; ++d0)
#pragma unroll
                for (int rg = 0; rg < 4; ++rg) {
                    const u32x2 a = og[0][d0][rg], b = og[1][d0][rg];
                    u32x2 w; w.x = pg8::cvt_pk_bf16(c0 * bflo(a.x) + c1 * bflo(b.x) + c2 * o[d0][4 * rg], c0 * bfhi(a.x) + c1 * bfhi(b.x) + c2 * o[d0][4 * rg + 1]);
                    w.y = pg8::cvt_pk_bf16(c0 * bflo(a.y) + c1 * bflo(b.y) + c2 * o[d0][4 * rg + 2], c0 * bfhi(a.y) + c1 * bfhi(b.y) + c2 * o[d0][4 * rg + 3]);
                    if (!dry) *(u32x2*)(sadd(orow, oro) + (d0 * 64 + 16 * rg)) = w; else asm volatile("" :: "v"(w.x), "v"(w.y));
                }
        }
        __syncthreads();
    }
}
}

typedef const __attribute__((address_space(4))) unsigned long long* kargp_t;
__device__ __forceinline__ kargp_t karg() { kargp_t p = (kargp_t)__builtin_amdgcn_kernarg_segment_ptr(); asm volatile("" : "+s"(p)); return p; }
#define KIN(i) ((const float*)(GAS const float*)karg()[i])
#define KOUT() ((float*)(GAS float*)karg()[19])
#define KWS() ((unsigned char*)(GAS unsigned char*)karg()[20])
#define WSP(type, off) ((type*)(KWS() + (off)))
struct Args { const float* in[19]; float* out; unsigned char* ws; int ph_lo, ph_hi; };
constexpr int NPHASE = 17;

__global__ void __launch_bounds__(NWAVES * 64, 2) mk_fwd(Args args) {
    extern __shared__ __attribute__((aligned(16))) unsigned char lds_raw[];
    LAS unsigned char* lds = (LAS unsigned char*)lds_raw;
    volatile LAS unsigned* MISC = (volatile LAS unsigned*)(lds + MISC_OFF);
    LAS int* rb = (LAS int*)(lds + MISC_OFF);
    const int wave = __builtin_amdgcn_readfirstlane((int)threadIdx.x >> 6);
#define IDS() const int lane = lane_id(), tid = wave * 64 + lane; (void)tid; (void)lane
    const int G = gridDim.x, bid = blockIdx.x;
    for (int u = threadIdx.x; u < (LDS_BYTES - MISC_OFF) / 4; u += NWAVES * 64) MISC[u] = 0u;
    __syncthreads();
#if MK_ONE_LAUNCH
    XcdBarrier bar = xcd_barrier_post((unsigned*)(KWS() + WS_CTL) + CW_BAR, MISC + 40, wave);
#define GRID_BAR() xcd_barrier(bar, wave)
#else
#define GRID_BAR() do { } while (0)
#endif
#if MK_ONE_LAUNCH
    constexpr int lo = 0, hi = NPHASE; (void)args;
#else
    const int lo = args.ph_lo, hi = args.ph_hi;
#endif
#ifndef PHMASK
#define PHMASK 0xFFFFFFFFu
#endif
#define IN(k) ((((PHMASK) >> (k)) & 1u) && lo <= (k) && (k) < hi)
#ifndef REPMASK
#define REPMASK 0u
#endif
#define REPS(k) ((((REPMASK) >> (k)) & 1u) ? 2 : 1)
#define SEAM(k) do { if (IN(k) && IN((k) + 1)) GRID_BAR(); } while (0)

    for (int rep_ = 0; rep_ < REPS(0); ++rep_) if (IN(0)) { IDS();
        const float* cin = KIN(1); const float* ada_w = KIN(4); const float* ada_b = KIN(5); float* mod = WSP(float, WS_MOD); float* rope = WSP(float, WS_ROPE);
        LAS float* cact = (LAS float*)lds; LAS float* red = cact + 16384;
        if (bid < 192) for (int i = tid; i < 16 * 1024; i += 512) { const float v = cin[i]; cact[i] = v / (1.f + expf(-v)); }
        __syncthreads();
        for (int item = bid; item < 192; item += G) {
            const int l = item / 96, n0 = (item % 96) * 64, kk = lane >> 4, n4 = lane & 15;
            f32x4 acc[16];
#pragma unroll
            for (int b = 0; b < 16; ++b) acc[b] = (f32x4){0.f, 0.f, 0.f, 0.f};
            const float* w = ada_w + (size_t)l * 1024 * 6144 + n0 + n4 * 4;
#pragma unroll 1
            for (int kb = 0; kb < 2; ++kb) {
                const int k0 = wave * 128 + kb * 64 + kk;
                f32x4 wv[16];
#pragma unroll
                for (int u = 0; u < 16; ++u) wv[u] = *(const f32x4*)(w + (size_t)(k0 + 4 * u) * 6144);
#pragma unroll
                for (int u = 0; u < 16; ++u)
#pragma unroll
                    for (int b = 0; b < 16; ++b) acc[b] += wv[u] * cact[b * 1024 + k0 + 4 * u];
            }
            const bool h5 = (lane & 32) != 0;
#pragma unroll
            for (int b = 0; b < 16; ++b)
#pragma unroll
                for (int c = 0; c < 4; ++c) { float v = acc[b][c]; v += xlane<16>(v); v += xlane32(v, h5); acc[b][c] = v; }
            if (lane < 16) {
#pragma unroll
                for (int b = 0; b < 16; ++b) *(LAS f32x4*)(red + (wave * 16 + b) * 64 + n4 * 4) = acc[b];
            }
            __syncthreads();
            for (int i = tid; i < 1024; i += 512) {
                const int b = i >> 6, nn = i & 63; float s = 0.f;
#pragma unroll
                for (int q = 0; q < 8; ++q) s += red[(q * 16 + b) * 64 + nn];
                mod[((size_t)l * 16 + b) * 6144 + n0 + nn] = s + ada_b[l * 6144 + n0 + nn];
            }
            __syncthreads();
        }
        for (int i = bid * 512 + tid; i < 4096 * 8; i += G * 512) {
            const int t = i >> 3, f = i & 7;
            const float inv = powf(500000.0f, -(float)(2 * f) / 16.0f);
            const float ang = (float)t * inv;
            rope[i] = (float)cos((double)ang);
            rope[4096 * 8 + i] = (float)sin((double)ang);
        }
    }
    SEAM(0);
    for (int rep_ = 0; rep_ < REPS(1); ++rep_) if (IN(1)) { IDS();
        {
        LAS float* scr = (LAS float*)(lds + wave * 16640);
        const float* conv_in_w = KIN(6); const float* conv_out_w = KIN(8); const float* attn_in_w = KIN(9); const float* attn_out_w = KIN(10);
        const float* gate_w = KIN(15); const float* up_w = KIN(16); const float* down_w = KIN(17);
        bf16_t* WZ = WSP(bf16_t, WS_WZ); bf16_t* WB = WSP(bf16_t, WS_WB); bf16_t* WCO = WSP(bf16_t, WS_WCO); bf16_t* WAI = WSP(bf16_t, WS_WAI); bf16_t* WAO = WSP(bf16_t, WS_WAO);
        bf16_t* WGU = WSP(bf16_t, WS_WGU); bf16_t* WDN = WSP(bf16_t, WS_WDN);
#define CONV_DECODE(DD, IT) do { int it = (IT); \
            if (it < 512) { conv_desc(DD, conv_in_w, 3072, 1024, WZ, 1024, 1, it / 32, it % 32); break; } it -= 512; \
            if (it < 256) { conv_desc(DD, conv_in_w, 3072, 0, WB, 1024, 0, it / 16, it % 16); break; } it -= 256; \
            if (it < 256) { conv_desc(DD, conv_out_w, 1024, 0, WCO, 1024, 0, it / 16, it % 16); break; } it -= 256; \
            if (it < 1152) { conv_desc(DD, attn_in_w, QKVW, 0, WAI, 1024, 2, it / 72, it % 72); break; } it -= 1152; \
            if (it < 128) { conv_desc(DD, attn_out_w, 1024, 0, WAO, 512, 0, it / 16, it % 16); break; } it -= 128; \
            const int le = it / 384, r = it % 384; \
            if (r < 128) conv_desc(DD, gate_w + (size_t)le * D * DEXP, DEXP, 0, WGU + (size_t)le * 1024 * 1024, 1024, 3, r / 8, r % 8); \
            else if (r < 256) conv_desc(DD, up_w + (size_t)le * D * DEXP, DEXP, 0, WGU + (size_t)le * 1024 * 1024, 1024, 4, (r - 128) / 8, (r - 128) % 8); \
            else conv_desc(DD, down_w + (size_t)le * DEXP * D, D, 0, WDN + (size_t)le * 1024 * 512, 512, 0, (r - 256) / 16, (r - 256) % 16); } while (0)
        {
            const int step = G * NWAVES; int it0 = bid * NWAVES + wave;
            ConvDesc dA, dB; f32x4 vA[16], vB[16];
            if (it0 < NCONV_ITEMS) { CONV_DECODE(dA, it0); conv_load(vA, dA, lane); }
#pragma unroll 1
            for (; it0 < NCONV_ITEMS; it0 += 2 * step) {
                const bool hasB = it0 + step < NCONV_ITEMS, hasA2 = it0 + 2 * step < NCONV_ITEMS;
                if (hasB) { CONV_DECODE(dB, it0 + step); conv_load(vB, dB, lane); }
                conv_process(vA, dA, scr, lane);
                if (hasA2) { CONV_DECODE(dA, it0 + 2 * step); conv_load(vA, dA, lane); }
                if (hasB) conv_process(vB, dB, scr, lane);
            }
        }
#undef CONV_DECODE
        }
        const float* x = KIN(0); const float* norm_mix_g = KIN(2); const float* mod = WSP(float, WS_MOD); bf16_t* xn = WSP(bf16_t, WS_XN); bf16_t* xr = (bf16_t*)KOUT();
        for (int w0 = (bid * 8 + wave) * 32; w0 < T; w0 += G * 8 * 32) {
            const float* mb = mod + (size_t)(w0 >> 12) * 6144;
            ModV mv; mod_load(mv, norm_mix_g, mb + 0, mb + 1024, lane);
            RowV ring[4];
#pragma unroll
            for (int d = 0; d < 4; ++d) row_load(ring[d], x + (size_t)(w0 + d) * D, lane);
#pragma unroll 1
            for (int i = 0; i < 32; i += 4) {
#pragma unroll
                for (int d = 0; d < 4; ++d) {
                    const int row = w0 + i + d;
                    RowV r = ring[d];
                    if (i < 28) row_load(ring[d], x + (size_t)(row + 4) * D, lane);
                    const float rstd = row_rstd(r);
                    row_store_bf16(r, xr + (size_t)row * XRP, lane);
                    row_apply(r, rstd, mv);
                    row_store_bf16(r, xn + (size_t)row * D, lane);
                }
            }
        }
    }
    SEAM(1);
    for (int rep_ = 0; rep_ < REPS(2); ++rep_) if (IN(2)) { bf16_t* xn = WSP(bf16_t, WS_XN); bf16_t* WZ = WSP(bf16_t, WS_WZ); bf16_t* zb = WSP(bf16_t, WS_Z);
        pg8::Gemm g{xn, WZ, T, 2048, 1024}; pg8::StaticOrder S; S.init(T, 2048, G, bid); pg8::EpiPair<false> E{zb, D};
        pg8::gemm_phase<pg8::EpiPair<false>, pg8::StaticOrder, pg8::APlain, true, true>(lds, g, S, E, pg8::APlain{}, wave); }
    SEAM(2);
    for (int rep_ = 0; rep_ < REPS(3); ++rep_) if (IN(3)) { bf16_t* xn = WSP(bf16_t, WS_XN); bf16_t* WB = WSP(bf16_t, WS_WB); bf16_t* zb = WSP(bf16_t, WS_Z); bf16_t* ypre = WSP(bf16_t, WS_YPRE); const float* conv_w = KIN(7);
        pg8::Gemm g{xn, WB, T, 1024, 1024}; pg8::StaticOrder S; S.init(T, 1024, G, bid); pg8::EpiYpre E{ypre, zb, conv_w};
        pg8::gemm_phase<pg8::EpiYpre, pg8::StaticOrder, pg8::APlain, true, true>(lds, g, S, E, pg8::APlain{}, wave); }
    SEAM(3);
    for (int rep_ = 0; rep_ < REPS(4); ++rep_) if (IN(4)) { bf16_t* ypre = WSP(bf16_t, WS_YPRE); bf16_t* WCO = WSP(bf16_t, WS_WCO); bf16_t* xr = (bf16_t*)KOUT(); const float* mod = WSP(float, WS_MOD);
        pg8::Gemm g{ypre, WCO, T, 1024, 1024}; pg8::StaticOrder S; S.init(T, 1024, G, bid); pg8::EpiRes<false> E{xr, nullptr, mod + 2048};
        pg8::gemm_phase<pg8::EpiRes<false>, pg8::StaticOrder, pg8::APlain, true, true>(lds, g, S, E, pg8::APlain{}, wave); }
    SEAM(4);
    { constexpr int l = 0;
        const int pb0 = (l == 0) ? 5 : 13;
#define MODL() (WSP(float, WS_MOD) + (size_t)l * 16 * 6144)
#define CNTL() (WSP(int, WS_CTL) + 64 * l)
        if (l == 1) {
#ifdef STAGGER9
            if (IN(9)) { const unsigned long long t0_ = __builtin_amdgcn_s_memrealtime(); const unsigned long long dl_ = (unsigned long long)(((bid >> 3) & 31) * STAGGER9 / 32);
                while (__builtin_amdgcn_s_memrealtime() - t0_ < dl_) __builtin_amdgcn_s_sleep(16); }
#endif
            for (int rep_ = 0; rep_ < REPS(9); ++rep_) if (IN(9)) { bf16_t* xn = WSP(bf16_t, WS_XN); bf16_t* WAI = WSP(bf16_t, WS_WAI); bf16_t* qkv = WSP(bf16_t, WS_QKV); const float* rope = WSP(float, WS_ROPE);
                pg8::Gemm g{xn, WAI, T, QKVW, 1024}; pg8::StaticOrder S; S.init(T, QKVW, G, bid); pg8::EpiQKV E{qkv, rope, 0};
                pg8::gemm_phase<pg8::EpiQKV, pg8::StaticOrder, pg8::APlain, true, true>(lds, g, S, E, pg8::APlain{}, wave); }
            SEAM(9);
            if (IN(10)) att::attn_phase<false>(lds, WSP(bf16_t, WS_QKV), WSP(float, WS_LSE), WSP(bf16_t, WS_XN), bid, G, wave);
            SEAM(10);
            if (IN(11)) att::attn_phase<true>(lds, WSP(bf16_t, WS_QKV), WSP(float, WS_LSE), WSP(bf16_t, WS_XN), bid, G, wave);
            SEAM(11);
            if (IN(12)) { bf16_t* ob = WSP(bf16_t, WS_XN); bf16_t* WAO = WSP(bf16_t, WS_WAO); bf16_t* xr = (bf16_t*)KOUT();
                pg8::Gemm g{ob, WAO, T, 1024, 512}; pg8::StaticOrder S; S.init(T, 1024, G, bid); pg8::EpiRes<false> E{xr, nullptr, MODL() + 2048};
                pg8::gemm_phase<pg8::EpiRes<false>, pg8::StaticOrder, pg8::APlain, true, true>(lds, g, S, E, pg8::APlain{}, wave); }
            SEAM(12);
        }
        for (int rep_ = 0; rep_ < REPS(5); ++rep_) if (IN(pb0)) { IDS(); const bool dry = rep_ + 1 < REPS(5);
            LAS f32x4* TG = (LAS f32x4*)lds; LAS f32x4* TE = (LAS f32x4*)(lds + 16384);
            LAS int* rec_e = (LAS int*)(lds + 147456); LAS float* rec_w = (LAS float*)(lds + 147456 + 2048); LAS int* rec_rank = (LAS int*)(lds + 147456 + 4096);
            LAS int* hist = (LAS int*)(lds + 147456 + 6144); LAS int* base = (LAS int*)(lds + 147456 + 6144 + 128);
            const float* gff = KIN(3) + l * D; const float* wg = KIN(11) + (size_t)l * D * 4; const float* bg = KIN(12) + l * 4; const float* we = KIN(13) + (size_t)l * 4 * D * 8; const float* be = KIN(14) + l * 32;
            const bf16_t* xr = (const bf16_t*)KOUT(); const float* modl = MODL(); int* cntl = CNTL(); bf16_t* xn = WSP(bf16_t, WS_XN); int* ltok = WSP(int, WS_LTOK); float* lw = WSP(float, WS_LW); int* tslot = WSP(int, WS_TSLOT);
            for (int i = tid; i < 1024; i += 512) { const int ln = i & 63, jc = i >> 6, k = 4 * ln + 256 * (jc >> 2) + (jc & 3); TG[i] = *(const f32x4*)(wg + (size_t)k * 4); }
            for (int i = tid; i < 8192; i += 512) { const int ln = i & 63, jc = (i >> 6) & 15, half = (i >> 10) & 1, gi = i >> 11, k = 4 * ln + 256 * (jc >> 2) + (jc & 3);
                TE[i] = *(const f32x4*)(we + ((size_t)gi * 1024 + k) * 8 + half * 4); }
            __syncthreads();
            const bool h5 = (lane & 32) != 0, h4 = (lane & 16) != 0, h3 = (lane & 8) != 0;
            for (int blk = bid; blk < T / 256; blk += G) {
                if (tid < 32) hist[tid] = 0;
                __syncthreads();
                ModV mv; { const float* mb = modl + (size_t)((blk * 256) >> 12) * 6144; mod_load(mv, gff, mb + 3072, mb + 4096, lane); }
                u32x2 ring[4][4];
#pragma unroll
                for (int d = 0; d < 4; ++d)
#pragma unroll
                    for (int j = 0; j < 4; ++j) ring[d][j] = *(const u32x2*)(xr + (size_t)(blk * 256 + wave * 32 + d) * XRP + 4 * lane + 256 * j);
#pragma unroll 1
                for (int i4 = 0; i4 < 32; i4 += 4)
#pragma unroll
                for (int d = 0; d < 4; ++d) {
                    const int i = i4 + d, rl = wave * 32 + i, row = blk * 256 + rl;
                    RowV r;
#pragma unroll
                    for (int j = 0; j < 4; ++j) { const u32x2 w = ring[d][j]; r.v[j] = (f32x4){bflo(w.x), bfhi(w.x), bflo(w.y), bfhi(w.y)}; }
                    if (i4 < 28) {
#pragma unroll
                        for (int j = 0; j < 4; ++j) ring[d][j] = *(const u32x2*)(xr + (size_t)(row + 4) * XRP + 4 * lane + 256 * j); }
                    const float rstd = row_rstd(r);
                    row_apply(r, rstd, mv);
                    row_store_bf16(r, xn + (size_t)row * D, lane);
                    f32x4 pg = {0.f, 0.f, 0.f, 0.f};
#pragma unroll
                    for (int jc = 0; jc < 16; ++jc) pg += TG[jc * 64 + lane] * r.v[jc >> 2][jc & 3];
                    float gl[4];
                    { float b0 = (h5 ? pg.z : pg.x) + xlane32(h5 ? pg.x : pg.z, h5), b1 = (h5 ? pg.w : pg.y) + xlane32(h5 ? pg.y : pg.w, h5);
                      float c = (h4 ? b1 : b0) + xlane<16>(h4 ? b0 : b1);
                      c += xlane<8>(c); c += xlane<4>(c); c += xlane<2>(c); c += xlane<1>(c);
#pragma unroll
                      for (int o = 0; o < 4; ++o) gl[o] = __int_as_float(__builtin_amdgcn_readlane(__float_as_int(c), 16 * o)) + bg[o]; }
                    int gi = 0; float gm = gl[0];
#pragma unroll
                    for (int o = 1; o < 4; ++o) if (gl[o] > gm) { gm = gl[o]; gi = o; }
                    float gden = 0.f;
#pragma unroll
                    for (int o = 0; o < 4; ++o) gden += __builtin_amdgcn_exp2f((gl[o] - gm) * 1.4426950408889634f);
                    const float grp_p = __builtin_amdgcn_rcpf(gden);
                    f32x4 pa = {0.f, 0.f, 0.f, 0.f}, pb = {0.f, 0.f, 0.f, 0.f};
                    const LAS f32x4* te = TE + gi * 2048 + lane;
#pragma unroll
                    for (int jc = 0; jc < 16; ++jc) { const float hv = r.v[jc >> 2][jc & 3]; pa += te[jc * 64] * hv; pb += te[1024 + jc * 64] * hv; }
                    float el[8];
                    { const f32x4 keep = h5 ? pb : pa, send = h5 ? pa : pb;
                      f32x4 q; q.x = keep.x + xlane32(send.x, h5); q.y = keep.y + xlane32(send.y, h5); q.z = keep.z + xlane32(send.z, h5); q.w = keep.w + xlane32(send.w, h5);
                      const float b0 = (h4 ? q.z : q.x) + xlane<16>(h4 ? q.x : q.z), b1 = (h4 ? q.w : q.y) + xlane<16>(h4 ? q.y : q.w);
                      float c = (h3 ? b1 : b0) + xlane<8>(h3 ? b0 : b1);
                      c += xlane<4>(c); c += xlane<2>(c); c += xlane<1>(c);
#pragma unroll
                      for (int o = 0; o < 8; ++o) el[o] = __int_as_float(__builtin_amdgcn_readlane(__float_as_int(c), 8 * o)) + be[gi * 8 + o]; }
                    int i0 = 0; float m0 = el[0];
#pragma unroll
                    for (int o = 1; o < 8; ++o) if (el[o] > m0) { m0 = el[o]; i0 = o; }
                    int i1 = -1; float m1 = -INFINITY;
#pragma unroll
                    for (int o = 0; o < 8; ++o) if (o != i0 && el[o] > m1) { m1 = el[o]; i1 = o; }
                    const float p1 = __builtin_amdgcn_exp2f((m1 - m0) * 1.4426950408889634f), w0_ = grp_p * __builtin_amdgcn_rcpf(1.0f + p1);
                    if (lane == 0) { rec_e[rl * 2] = gi * 8 + i0; rec_e[rl * 2 + 1] = gi * 8 + i1; rec_w[rl * 2] = w0_; rec_w[rl * 2 + 1] = w0_ * p1; }
                }
                __syncthreads();
                { const int e = rec_e[tid]; rec_rank[tid] = atomicAdd((int*)&hist[e], 1); }
                __syncthreads();
                if (tid < 32) { const int h = hist[tid]; base[tid] = (h && !dry) ? atomicAdd(&cntl[tid], h) : 0; }
                __syncthreads();
                { const int e = rec_e[tid], pos = base[e] + rec_rank[tid], tok = blk * 256 + (tid >> 1);
                  if (!dry) { ltok[(size_t)e * LISTCAP + pos] = tok; lw[(size_t)e * LISTCAP + pos] = rec_w[tid]; tslot[tok * 2 + (tid & 1)] = (e << 16) | pos; } }
                __syncthreads();
            }
        }
        SEAM(pb0);
        if (IN(pb0 + 1) || IN(pb0 + 2) || IN(pb0 + 3)) {
            __syncthreads();
            if (wave == 0 && lane_id() == 0) { const int* cntl = CNTL(); int s = 0;
#pragma unroll 1
                for (int e = 0; e < 32; ++e) { rb[e] = s; s += (__hip_atomic_load(&cntl[e], RLX_AGENT) + 255) & ~255; }
                rb[32] = s; }
            __syncthreads();
        }
        for (int rep_ = 0; rep_ < REPS(6); ++rep_) if (IN(pb0 + 1)) { bf16_t* xn = WSP(bf16_t, WS_XN); bf16_t* WGU = WSP(bf16_t, WS_WGU); bf16_t* act = WSP(bf16_t, WS_ACT); const int* ltok = WSP(int, WS_LTOK); const int* cntl = CNTL();
            pg8::Gemm g{xn, WGU + (size_t)l * 32 * 1024 * 1024, 0, 0, 1024}; pg8::MoeOrder S; S.init(rb[32] / 256, G, bid, rb); pg8::EpiPair<true> E{act, DEXP}; pg8::AGather am{ltok, cntl, rb};
            pg8::gemm_phase<pg8::EpiPair<true>, pg8::MoeOrder, pg8::AGather, true, true>(lds, g, S, E, am, wave); }
        SEAM(pb0 + 1);
        for (int rep_ = 0; rep_ < REPS(7); ++rep_) if (IN(pb0 + 2)) { bf16_t* act = WSP(bf16_t, WS_ACT); bf16_t* WDN = WSP(bf16_t, WS_WDN); bf16_t* yw = WSP(bf16_t, WS_YW); const float* lw = WSP(float, WS_LW);
            pg8::Gemm g{act, WDN + (size_t)l * 32 * 1024 * 512, 0, 0, 512}; pg8::MoeOrder S; S.init(rb[32] / 256, G, bid, rb); pg8::EpiDown E{yw, lw, rb};
            pg8::gemm_phase<pg8::EpiDown, pg8::MoeOrder, pg8::APlain, true, true>(lds, g, S, E, pg8::APlain{}, wave); }
        SEAM(pb0 + 2);
        for (int rep_ = 0; rep_ < REPS(8); ++rep_) if (IN(pb0 + 3)) { IDS(); const bool dry = rep_ + 1 < REPS(8);
            const float* gnext = (l == 0) ? KIN(2) + D : KIN(18);
            const float* modn = WSP(float, WS_MOD) + (size_t)16 * 6144; const float* modl = MODL();
            float* outf = KOUT(); bf16_t* xr = (bf16_t*)KOUT(); const bf16_t* yw = WSP(bf16_t, WS_YW); const int* tslot = WSP(int, WS_TSLOT); bf16_t* xn = WSP(bf16_t, WS_XN);
            for (int w0 = (bid * 8 + wave) * 32; w0 < T; w0 += G * 8 * 32) {
                const int b = w0 >> 12;
                f32x4 g2v[4];
#pragma unroll
                for (int j = 0; j < 4; ++j) g2v[j] = *(const f32x4*)(modl + (size_t)b * 6144 + 5120 + 4 * lane + 256 * j);
                ModV mv;
                if (l == 0) { const float* mb = modn + (size_t)b * 6144; mod_load(mv, gnext, mb + 0, mb + 1024, lane); }
                else {
#pragma unroll
                    for (int j = 0; j < 4; ++j) { mv.gp[j] = *(const f32x4*)(gnext + 4 * lane + 256 * j); mv.sh[j] = (f32x4){0.f, 0.f, 0.f, 0.f}; }
                }
                const int slw = tslot[(size_t)w0 * 2 + lane];
                u32x2 xb[4][4], ya[4][4], yb[4][4];
#define R2_LOAD(D_, I_) do { const int s0_ = __builtin_amdgcn_readlane(slw, 2 * (I_)), s1_ = __builtin_amdgcn_readlane(slw, 2 * (I_) + 1); \
                    const size_t r0_ = (size_t)(rb[s0_ >> 16] + (s0_ & 0xffff)), r1_ = (size_t)(rb[s1_ >> 16] + (s1_ & 0xffff)); \
                    _Pragma("unroll") for (int j = 0; j < 4; ++j) { xb[D_][j] = *(const u32x2*)(xr + (size_t)(w0 + (I_)) * XRP + 4 * lane + 256 * j); \
                        ya[D_][j] = ntload((const u32x2*)(yw + r0_ * D + 4 * lane + 256 * j)); yb[D_][j] = ntload((const u32x2*)(yw + r1_ * D + 4 * lane + 256 * j)); } } while (0)
#pragma unroll
                for (int d = 0; d < 4; ++d) R2_LOAD(d, d);
#pragma unroll 1
                for (int i4 = 0; i4 < 32; i4 += 4)
#pragma unroll
                for (int d = 0; d < 4; ++d) {
                    const int i = i4 + d, row = w0 + i;
                    RowV r;
#pragma unroll
                    for (int j = 0; j < 4; ++j) {
                        const u32x2 xw = xb[d][j], a = ya[d][j], c = yb[d][j];
                        f32x4 y; y.x = bflo(a.x) + bflo(c.x); y.y = bfhi(a.x) + bfhi(c.x); y.z = bflo(a.y) + bflo(c.y); y.w = bfhi(a.y) + bfhi(c.y);
                        r.v[j] = (f32x4){bflo(xw.x), bfhi(xw.x), bflo(xw.y), bfhi(xw.y)} + g2v[j] * y;
                    }
                    if (i4 < 28) R2_LOAD(d, i + 4);
                    const float rstd = row_rstd(r);
                    if (dry) { asm volatile("" :: "v"(rstd), "v"(r.v[0].x), "v"(r.v[1].y), "v"(r.v[2].z), "v"(r.v[3].w)); }
                    else if (l == 1) { row_apply(r, rstd, mv); row_store_f32(r, outf + (size_t)row * D, lane); }
                    else { row_store_bf16(r, xr + (size_t)row * XRP, lane); row_apply(r, rstd, mv); row_store_bf16(r, xn + (size_t)row * D, lane); }
                }
#undef R2_LOAD
            }
        }
        SEAM(pb0 + 3);
    }
    { constexpr int l = 1;
        const int pb0 = (l == 0) ? 5 : 13;
#define MODL() (WSP(float, WS_MOD) + (size_t)l * 16 * 6144)
#define CNTL() (WSP(int, WS_CTL) + 64 * l)
        if (l == 1) {
#ifdef STAGGER9
            if (IN(9)) { const unsigned long long t0_ = __builtin_amdgcn_s_memrealtime(); const unsigned long long dl_ = (unsigned long long)(((bid >> 3) & 31) * STAGGER9 / 32);
                while (__builtin_amdgcn_s_memrealtime() - t0_ < dl_) __builtin_amdgcn_s_sleep(16); }
#endif
            for (int rep_ = 0; rep_ < REPS(9); ++rep_) if (IN(9)) { bf16_t* xn = WSP(bf16_t, WS_XN); bf16_t* WAI = WSP(bf16_t, WS_WAI); bf16_t* qkv = WSP(bf16_t, WS_QKV); const float* rope = WSP(float, WS_ROPE);
                pg8::Gemm g{xn, WAI, T, QKVW, 1024}; pg8::StaticOrder S; S.init(T, QKVW, G, bid); pg8::EpiQKV E{qkv, rope, 0};
                pg8::gemm_phase<pg8::EpiQKV, pg8::StaticOrder, pg8::APlain, true, true>(lds, g, S, E, pg8::APlain{}, wave); }
            SEAM(9);
            if (IN(10)) att::attn_phase<false>(lds, WSP(bf16_t, WS_QKV), WSP(float, WS_LSE), WSP(bf16_t, WS_XN), bid, G, wave);
            SEAM(10);
            if (IN(11)) att::attn_phase<true>(lds, WSP(bf16_t, WS_QKV), WSP(float, WS_LSE), WSP(bf16_t, WS_XN), bid, G, wave);
            SEAM(11);
            if (IN(12)) { bf16_t* ob = WSP(bf16_t, WS_XN); bf16_t* WAO = WSP(bf16_t, WS_WAO); bf16_t* xr = (bf16_t*)KOUT();
                pg8::Gemm g{ob, WAO, T, 1024, 512}; pg8::StaticOrder S; S.init(T, 1024, G, bid); pg8::EpiRes<false> E{xr, nullptr, MODL() + 2048};
                pg8::gemm_phase<pg8::EpiRes<false>, pg8::StaticOrder, pg8::APlain, true, true>(lds, g, S, E, pg8::APlain{}, wave); }
            SEAM(12);
        }
        for (int rep_ = 0; rep_ < REPS(5); ++rep_) if (IN(pb0)) { IDS(); const bool dry = rep_ + 1 < REPS(5);
            LAS f32x4* TG = (LAS f32x4*)lds; LAS f32x4* TE = (LAS f32x4*)(lds + 16384);
            LAS int* rec_e = (LAS int*)(lds + 147456); LAS float* rec_w = (LAS float*)(lds + 147456 + 2048); LAS int* rec_rank = (LAS int*)(lds + 147456 + 4096);
            LAS int* hist = (LAS int*)(lds + 147456 + 6144); LAS int* base = (LAS int*)(lds + 147456 + 6144 + 128);
            const float* gff = KIN(3) + l * D; const float* wg = KIN(11) + (size_t)l * D * 4; const float* bg = KIN(12) + l * 4; const float* we = KIN(13) + (size_t)l * 4 * D * 8; const float* be = KIN(14) + l * 32;
            const bf16_t* xr = (const bf16_t*)KOUT(); const float* modl = MODL(); int* cntl = CNTL(); bf16_t* xn = WSP(bf16_t, WS_XN); int* ltok = WSP(int, WS_LTOK); float* lw = WSP(float, WS_LW); int* tslot = WSP(int, WS_TSLOT);
            for (int i = tid; i < 1024; i += 512) { const int ln = i & 63, jc = i >> 6, k = 4 * ln + 256 * (jc >> 2) + (jc & 3); TG[i] = *(const f32x4*)(wg + (size_t)k * 4); }
            for (int i = tid; i < 8192; i += 512) { const int ln = i & 63, jc = (i >> 6) & 15, half = (i >> 10) & 1, gi = i >> 11, k = 4 * ln + 256 * (jc >> 2) + (jc & 3);
                TE[i] = *(const f32x4*)(we + ((size_t)gi * 1024 + k) * 8 + half * 4); }
            __syncthreads();
            const bool h5 = (lane & 32) != 0, h4 = (lane & 16) != 0, h3 = (lane & 8) != 0;
            for (int blk = bid; blk < T / 256; blk += G) {
                if (tid < 32) hist[tid] = 0;
                __syncthreads();
                ModV mv; { const float* mb = modl + (size_t)((blk * 256) >> 12) * 6144; mod_load(mv, gff, mb + 3072, mb + 4096, lane); }
                u32x2 ring[4][4];
#pragma unroll
                for (int d = 0; d < 4; ++d)
#pragma unroll
                    for (int j = 0; j < 4; ++j) ring[d][j] = *(const u32x2*)(xr + (size_t)(blk * 256 + wave * 32 + d) * XRP + 4 * lane + 256 * j);
#pragma unroll 1
                for (int i4 = 0; i4 < 32; i4 += 4)
#pragma unroll
                for (int d = 0; d < 4; ++d) {
                    const int i = i4 + d, rl = wave * 32 + i, row = blk * 256 + rl;
                    RowV r;
#pragma unroll
                    for (int j = 0; j < 4; ++j) { const u32x2 w = ring[d][j]; r.v[j] = (f32x4){bflo(w.x), bfhi(w.x), bflo(w.y), bfhi(w.y)}; }
                    if (i4 < 28) {
#pragma unroll
                        for (int j = 0; j < 4; ++j) ring[d][j] = *(const u32x2*)(xr + (size_t)(row + 4) * XRP + 4 * lane + 256 * j); }
                    const float rstd = row_rstd(r);
                    row_apply(r, rstd, mv);
                    row_store_bf16(r, xn + (size_t)row * D, lane);
                    f32x4 pg = {0.f, 0.f, 0.f, 0.f};
#pragma unroll
                    for (int jc = 0; jc < 16; ++jc) pg += TG[jc * 64 + lane] * r.v[jc >> 2][jc & 3];
                    float gl[4];
                    { float b0 = (h5 ? pg.z : pg.x) + xlane32(h5 ? pg.x : pg.z, h5), b1 = (h5 ? pg.w : pg.y) + xlane32(h5 ? pg.y : pg.w, h5);
                      float c = (h4 ? b1 : b0) + xlane<16>(h4 ? b0 : b1);
                      c += xlane<8>(c); c += xlane<4>(c); c += xlane<2>(c); c += xlane<1>(c);
#pragma unroll
                      for (int o = 0; o < 4; ++o) gl[o] = __int_as_float(__builtin_amdgcn_readlane(__float_as_int(c), 16 * o)) + bg[o]; }
                    int gi = 0; float gm = gl[0];
#pragma unroll
                    for (int o = 1; o < 4; ++o) if (gl[o] > gm) { gm = gl[o]; gi = o; }
                    float gden = 0.f;
#pragma unroll
                    for (int o = 0; o < 4; ++o) gden += __builtin_amdgcn_exp2f((gl[o] - gm) * 1.4426950408889634f);
                    const float grp_p = __builtin_amdgcn_rcpf(gden);
                    f32x4 pa = {0.f, 0.f, 0.f, 0.f}, pb = {0.f, 0.f, 0.f, 0.f};
                    const LAS f32x4* te = TE + gi * 2048 + lane;
#pragma unroll
                    for (int jc = 0; jc < 16; ++jc) { const float hv = r.v[jc >> 2][jc & 3]; pa += te[jc * 64] * hv; pb += te[1024 + jc * 64] * hv; }
                    float el[8];
                    { const f32x4 keep = h5 ? pb : pa, send = h5 ? pa : pb;
                      f32x4 q; q.x = keep.x + xlane32(send.x, h5); q.y = keep.y + xlane32(send.y, h5); q.z = keep.z + xlane32(send.z, h5); q.w = keep.w + xlane32(send.w, h5);
                      const float b0 = (h4 ? q.z : q.x) + xlane<16>(h4 ? q.x : q.z), b1 = (h4 ? q.w : q.y) + xlane<16>(h4 ? q.y : q.w);
                      float c = (h3 ? b1 : b0) + xlane<8>(h3 ? b0 : b1);
                      c += xlane<4>(c); c += xlane<2>(c); c += xlane<1>(c);
#pragma unroll
                      for (int o = 0; o < 8; ++o) el[o] = __int_as_float(__builtin_amdgcn_readlane(__float_as_int(c), 8 * o)) + be[gi * 8 + o]; }
                    int i0 = 0; float m0 = el[0];
#pragma unroll
                    for (int o = 1; o < 8; ++o) if (el[o] > m0) { m0 = el[o]; i0 = o; }
                    int i1 = -1; float m1 = -INFINITY;
#pragma unroll
                    for (int o = 0; o < 8; ++o) if (o != i0 && el[o] > m1) { m1 = el[o]; i1 = o; }
                    const float p1 = __builtin_amdgcn_exp2f((m1 - m0) * 1.4426950408889634f), w0_ = grp_p * __builtin_amdgcn_rcpf(1.0f + p1);
                    if (lane == 0) { rec_e[rl * 2] = gi * 8 + i0; rec_e[rl * 2 + 1] = gi * 8 + i1; rec_w[rl * 2] = w0_; rec_w[rl * 2 + 1] = w0_ * p1; }
                }
                __syncthreads();
                { const int e = rec_e[tid]; rec_rank[tid] = atomicAdd((int*)&hist[e], 1); }
                __syncthreads();
                if (tid < 32) { const int h = hist[tid]; base[tid] = (h && !dry) ? atomicAdd(&cntl[tid], h) : 0; }
                __syncthreads();
                { const int e = rec_e[tid], pos = base[e] + rec_rank[tid], tok = blk * 256 + (tid >> 1);
                  if (!dry) { ltok[(size_t)e * LISTCAP + pos] = tok; lw[(size_t)e * LISTCAP + pos] = rec_w[tid]; tslot[tok * 2 + (tid & 1)] = (e << 16) | pos; } }
                __syncthreads();
            }
        }
        SEAM(pb0);
        if (IN(pb0 + 1) || IN(pb0 + 2) || IN(pb0 + 3)) {
            __syncthreads();
            if (wave == 0 && lane_id() == 0) { const int* cntl = CNTL(); int s = 0;
#pragma unroll 1
                for (int e = 0; e < 32; ++e) { rb[e] = s; s += (__hip_atomic_load(&cntl[e], RLX_AGENT) + 255) & ~255; }
                rb[32] = s; }
            __syncthreads();
        }
        for (int rep_ = 0; rep_ < REPS(6); ++rep_) if (IN(pb0 + 1)) { bf16_t* xn = WSP(bf16_t, WS_XN); bf16_t* WGU = WSP(bf16_t, WS_WGU); bf16_t* act = WSP(bf16_t, WS_ACT); const int* ltok = WSP(int, WS_LTOK); const int* cntl = CNTL();
            pg8::Gemm g{xn, WGU + (size_t)l * 32 * 1024 * 1024, 0, 0, 1024}; pg8::MoeOrder S; S.init(rb[32] / 256, G, bid, rb); pg8::EpiPair<true> E{act, DEXP}; pg8::AGather am{ltok, cntl, rb};
            pg8::gemm_phase<pg8::EpiPair<true>, pg8::MoeOrder, pg8::AGather, true, true>(lds, g, S, E, am, wave); }
        SEAM(pb0 + 1);
        for (int rep_ = 0; rep_ < REPS(7); ++rep_) if (IN(pb0 + 2)) { bf16_t* act = WSP(bf16_t, WS_ACT); bf16_t* WDN = WSP(bf16_t, WS_WDN); bf16_t* yw = WSP(bf16_t, WS_YW); const float* lw = WSP(float, WS_LW);
            pg8::Gemm g{act, WDN + (size_t)l * 32 * 1024 * 512, 0, 0, 512}; pg8::MoeOrder S; S.init(rb[32] / 256, G, bid, rb); pg8::EpiDown E{yw, lw, rb};
            pg8::gemm_phase<pg8::EpiDown, pg8::MoeOrder, pg8::APlain, true, true>(lds, g, S, E, pg8::APlain{}, wave); }
        SEAM(pb0 + 2);
        for (int rep_ = 0; rep_ < REPS(8); ++rep_) if (IN(pb0 + 3)) { IDS(); const bool dry = rep_ + 1 < REPS(8);
            const float* gnext = (l == 0) ? KIN(2) + D : KIN(18);
            const float* modn = WSP(float, WS_MOD) + (size_t)16 * 6144; const float* modl = MODL();
            float* outf = KOUT(); bf16_t* xr = (bf16_t*)KOUT(); const bf16_t* yw = WSP(bf16_t, WS_YW); const int* tslot = WSP(int, WS_TSLOT); bf16_t* xn = WSP(bf16_t, WS_XN);
            for (int w0 = (bid * 8 + wave) * 32; w0 < T; w0 += G * 8 * 32) {
                const int b = w0 >> 12;
                f32x4 g2v[4];
#pragma unroll
                for (int j = 0; j < 4; ++j) g2v[j] = *(const f32x4*)(modl + (size_t)b * 6144 + 5120 + 4 * lane + 256 * j);
                ModV mv;
                if (l == 0) { const float* mb = modn + (size_t)b * 6144; mod_load(mv, gnext, mb + 0, mb + 1024, lane); }
                else {
#pragma unroll
                    for (int j = 0; j < 4; ++j) { mv.gp[j] = *(const f32x4*)(gnext + 4 * lane + 256 * j); mv.sh[j] = (f32x4){0.f, 0.f, 0.f, 0.f}; }
                }
                const int slw = tslot[(size_t)w0 * 2 + lane];
                u32x2 xb[4][4], ya[4][4], yb[4][4];
#define R2_LOAD(D_, I_) do { const int s0_ = __builtin_amdgcn_readlane(slw, 2 * (I_)), s1_ = __builtin_amdgcn_readlane(slw, 2 * (I_) + 1); \
                    const size_t r0_ = (size_t)(rb[s0_ >> 16] + (s0_ & 0xffff)), r1_ = (size_t)(rb[s1_ >> 16] + (s1_ & 0xffff)); \
                    _Pragma("unroll") for (int j = 0; j < 4; ++j) { xb[D_][j] = *(const u32x2*)(xr + (size_t)(w0 + (I_)) * XRP + 4 * lane + 256 * j); \
                        ya[D_][j] = ntload((const u32x2*)(yw + r0_ * D + 4 * lane + 256 * j)); yb[D_][j] = ntload((const u32x2*)(yw + r1_ * D + 4 * lane + 256 * j)); } } while (0)
#pragma unroll
                for (int d = 0; d < 4; ++d) R2_LOAD(d, d);
#pragma unroll 1
                for (int i4 = 0; i4 < 32; i4 += 4)
#pragma unroll
                for (int d = 0; d < 4; ++d) {
                    const int i = i4 + d, row = w0 + i;
                    RowV r;
#pragma unroll
                    for (int j = 0; j < 4; ++j) {
                        const u32x2 xw = xb[d][j], a = ya[d][j], c = yb[d][j];
                        f32x4 y; y.x = bflo(a.x) + bflo(c.x); y.y = bfhi(a.x) + bfhi(c.x); y.z = bflo(a.y) + bflo(c.y); y.w = bfhi(a.y) + bfhi(c.y);
                        r.v[j] = (f32x4){bflo(xw.x), bfhi(xw.x), bflo(xw.y), bfhi(xw.y)} + g2v[j] * y;
                    }
                    if (i4 < 28) R2_LOAD(d, i + 4);
                    const float rstd = row_rstd(r);
                    if (dry) { asm volatile("" :: "v"(rstd), "v"(r.v[0].x), "v"(r.v[1].y), "v"(r.v[2].z), "v"(r.v[3].w)); }
                    else if (l == 1) { row_apply(r, rstd, mv); row_store_f32(r, outf + (size_t)row * D, lane); }
                    else { row_store_bf16(r, xr + (size_t)row * XRP, lane); row_apply(r, rstd, mv); row_store_bf16(r, xn + (size_t)row * D, lane); }
                }
#undef R2_LOAD
            }
        }
        SEAM(pb0 + 3);
    }
#undef IDS
#undef MODL
#undef CNTL
#undef IN
#undef SEAM
#undef GRID_BAR
}

extern "C" void kernel_launch(void* const* d_in, const int* in_sizes, int n_in, void* d_out, int out_size, void* d_ws, size_t ws_size, hipStream_t stream) {
    static int grid = 0;
    if (grid == 0) {
        if (n_in != 19 || out_size != T * D || ws_size < WS_END) { fprintf(stderr, "kernel_launch: unexpected shapes (n_in %d out %d ws %zu)\n", n_in, out_size, ws_size); grid = -1; return; }
        int dev = 0, cus = 0;
        if (hipGetDevice(&dev) != hipSuccess || hipDeviceGetAttribute(&cus, hipDeviceAttributeMultiprocessorCount, dev) != hipSuccess) { grid = -1; return; }
        if (hipFuncSetAttribute((const void*)mk_fwd, hipFuncAttributeMaxDynamicSharedMemorySize, LDS_BYTES) != hipSuccess) { fprintf(stderr, "kernel_launch: hipFuncSetAttribute failed\n"); grid = -1; return; }
        int per_cu = 0;
        if (hipOccupancyMaxActiveBlocksPerMultiprocessor(&per_cu, (const void*)mk_fwd, NWAVES * 64, LDS_BYTES) != hipSuccess || per_cu < 1) fprintf(stderr, "kernel_launch: occupancy query says %d\n", per_cu);
        (void)hipGetLastError();
        grid = cus;
    }
    if (grid < 0) return;
    (void)hipMemsetAsync((char*)d_ws + WS_CTL, 0, CTL_BYTES, stream);
    Args a{};
    for (int i = 0; i < 19; ++i) a.in[i] = (const float*)d_in[i];
    a.out = (float*)d_out; a.ws = (unsigned char*)d_ws;
#if MK_ONE_LAUNCH
    a.ph_lo = 0; a.ph_hi = NPHASE;
    hipLaunchKernelGGL(mk_fwd, dim3(grid), dim3(NWAVES * 64), LDS_BYTES, stream, a);
#else
    for (int p = 0; p < NPHASE; ++p) { a.ph_lo = p; a.ph_hi = p + 1; hipLaunchKernelGGL(mk_fwd, dim3(grid), dim3(NWAVES * 64), LDS_BYTES, stream, a); }
#endif
}
```

```cpp
#include <hip/hip_runtime.h>
#include <stdint.h>
#include <math.h>
#include <cstdio>

#ifndef MK_ONE_LAUNCH
#define MK_ONE_LAUNCH 1
#endif

typedef unsigned short bf16_t;
typedef float f32x4 __attribute__((ext_vector_type(4)));
typedef unsigned u32x2 __attribute__((ext_vector_type(2)));
typedef unsigned u32x4 __attribute__((ext_vector_type(4)));
#define GAS __attribute__((address_space(1)))
#define LAS __attribute__((address_space(3)))
typedef GAS unsigned gu32;
#define RLX_AGENT __ATOMIC_RELAXED, __HIP_MEMORY_SCOPE_AGENT

constexpr int D = 1024, BATCH = 16, SEQ = 4096, T = BATCH * SEQ;
constexpr int NEXP = 32, DEXP = 512, EPG = 8, NGRP = 4;
constexpr int QKVW = 4608;
__host__ __device__ __forceinline__ size_t qkv_block(int typ, int g, int b, int h) { return (size_t)((((typ * 3 + g) * 16 + b) * 8 + h)) * (4096 * 64); }
__host__ __device__ __forceinline__ int qkv_row(int pos, int g) { const int dsh = 2 * g; return ((pos & ((1 << dsh) - 1)) << (12 - dsh)) + (pos >> dsh); }
constexpr int LISTCAP = 65536;
constexpr int PADROWS = 139264;
constexpr float EPS = 1e-6f;
constexpr float QSCALE = 0.125f * 1.4426950408889634f;
constexpr int NWAVES = 8;
constexpr int XRP = 2048;

constexpr size_t MiB = 1u << 20;
constexpr size_t WS_CTL = 0;
constexpr size_t CTL_BYTES = 1 * MiB;
constexpr int CW_BAR = 4096;
constexpr size_t WS_MOD = 1 * MiB;
constexpr size_t WS_ROPE = 3 * MiB;
constexpr size_t WS_LTOK = 4 * MiB;
constexpr size_t WS_LW = 12 * MiB;
constexpr size_t WS_TSLOT = 20 * MiB;
constexpr size_t WS_LSE = 24 * MiB;
constexpr size_t WS_WZ = 32 * MiB;
constexpr size_t WS_WB = 36 * MiB;
constexpr size_t WS_WCO = 38 * MiB;
constexpr size_t WS_WAI = 40 * MiB;
constexpr size_t WS_WAO = 49 * MiB;
constexpr size_t WS_WGU = 64 * MiB;
constexpr size_t WS_WDN = 192 * MiB;
constexpr size_t WS_XN = 256 * MiB;
constexpr size_t WS_BIG = 384 * MiB;
constexpr size_t WS_Z = WS_BIG, WS_YPRE = WS_BIG + 128 * MiB;
constexpr size_t WS_ACT = WS_BIG, WS_YW = WS_BIG + 136 * MiB;
constexpr size_t WS_QKV = WS_BIG;
constexpr size_t WS_END = WS_BIG + 576 * MiB;

constexpr int RING_BYTES = 162816;
constexpr int MISC_OFF = RING_BYTES;
constexpr int LDS_BYTES = RING_BYTES + 1024;

__device__ __forceinline__ unsigned f2bf(float f) { unsigned u = __float_as_uint(f); return (u + 0x7fffu + ((u >> 16) & 1u)) >> 16; }
__device__ __forceinline__ unsigned pk2(float lo, float hi) { return f2bf(lo) | (f2bf(hi) << 16); }
__device__ __forceinline__ float bf2f(unsigned h) { return __uint_as_float(h << 16); }
__device__ __forceinline__ float bflo(unsigned w) { return __uint_as_float(w << 16); }
__device__ __forceinline__ float bfhi(unsigned w) { return __uint_as_float(w & 0xffff0000u); }
template <int M> __device__ __forceinline__ float xlane(float v) {
    return __int_as_float(__builtin_amdgcn_ds_swizzle(__float_as_int(v), (M << 10) | 0x1f));
}
__device__ __forceinline__ float xlane32(float v, bool hi) {
    auto rr = __builtin_amdgcn_permlane32_swap(__float_as_uint(v), __float_as_uint(v), false, false); return __uint_as_float(hi ? rr[0] : rr[1]);
}
__device__ __forceinline__ float wave_sum(float v) {
    v += xlane<1>(v); v += xlane<2>(v); v += xlane<4>(v); v += xlane<8>(v); v += xlane<16>(v);
    auto rr = __builtin_amdgcn_permlane32_swap(__float_as_uint(v), __float_as_uint(v), false, false);
    return __uint_as_float(rr[0]) + __uint_as_float(rr[1]);
}
__device__ __forceinline__ float silu_f(float x) { return x / (1.0f + __expf(-x)); }
#define LDS_WAIT() asm volatile("s_waitcnt lgkmcnt(0)" ::: "memory")
template <class V> __device__ __forceinline__ V ntload(const V* p) { return __builtin_nontemporal_load(p); }
__device__ __forceinline__ int lane_id() { int l; asm volatile("v_mbcnt_lo_u32_b32 %0, -1, 0\n\tv_mbcnt_hi_u32_b32 %0, -1, %0" : "=v"(l)); return l; }

namespace pg8 {
#define PG8_LAS __attribute__((address_space(3)))
typedef unsigned short bf16_t;
typedef short bf16x8 __attribute__((ext_vector_type(8)));
typedef float f32x4 __attribute__((ext_vector_type(4)));
typedef unsigned u32x4 __attribute__((ext_vector_type(4)));
constexpr int BM = 256, BK = 64, HALF = 128, HTB = HALF * BK * 2  , STAGE_BYTES = 8 * HTB, NXCD = 8, WGM = 4;

__host__ __device__ __forceinline__ int lds_byte(int r, int c) { const int st = (r >> 4) * 2 + (c >> 5), rr = r & 15, cc = c & 31, ob = rr * 64 + cc * 2; return st * 1024 + (ob ^ (((ob >> 9) & 1) << 5)); }
__host__ __device__ __forceinline__ void stage_rc(int b, int& R, int& C) { const int st = b / 1024, sb = b % 1024, swz = sb ^ (((sb >> 9) & 1) << 5); R = (st >> 1) * 16 + swz / 64; C = (st & 1) * 32 + (swz % 64) / 2; }
__host__ __device__ __forceinline__ int perm32(int rho) { const int n = rho >> 4, i = rho & 15; return 8 * (i >> 2) + 4 * n + (i & 3); }

struct Unit { int pm, pn, pb; };
struct Gemm { const bf16_t* A; const bf16_t* Bt; int M, N, K; };

struct StaticOrder {
    int nM, nN, nwg, G, c;
    __host__ __device__ void init(int M, int N, int G_, int c_) { nM = M / BM; nN = N / BM; nwg = nM * nN; G = G_; c = c_; }
    __host__ __device__ bool next(int i, Unit& u) const {
        const long L = (long)i * G + c; if (L >= nwg) return false;
        int wgid = (int)L; { const int q = nwg / NXCD, r = nwg % NXCD, xcd = wgid % NXCD, off = wgid / NXCD; wgid = (xcd < r ? xcd * (q + 1) : r * (q + 1) + (xcd - r) * q) + off; }
        const int nig = WGM * nN, gid = wgid / nig, fm = gid * WGM, gsz = (nM - fm) < WGM ? (nM - fm) : WGM;
        u.pm = fm + ((wgid % nig) % gsz); u.pn = (wgid % nig) / gsz; u.pb = u.pn; return true;
    }
    __device__ __forceinline__ void a_ready(const Unit&) const {}
    __device__ __forceinline__ void done(const Unit&) const {}
};


__device__ __forceinline__ unsigned cvt_pk_bf16(float lo, float hi) { unsigned r; asm volatile("v_cvt_pk_bf16_f32 %0, %1, %2" : "=v"(r) : "v"(lo), "v"(hi)); return r; }
typedef float f32x2 __attribute__((ext_vector_type(2)));

template <class Epi, class Sched, class AM, bool ALIGN_EPI = false, bool SP2 = false>
__device__ __forceinline__ void gemm_phase(PG8_LAS unsigned char* lds, const Gemm g, const Sched& S, const Epi& E, const AM& am, const int wid_in) {
    int wid = wid_in; asm volatile("" : "+s"(wid));
    const int lane = lane_id(), tid = wid * 64 + lane, wr = wid >> 2, wc = wid & 3, fr = lane & 15, fq = lane >> 4;
    const int K = g.K, nt = K / BK;
    unsigned voffA[2], voffB[2]; int stR[2], stC[2];
#pragma unroll
    for (int i = 0; i < 2; ++i) { int R, C; stage_rc(tid * 16 + i * 8192, R, C); const int Rb = Epi::PERM ? ((R & ~31) + perm32(R & 31)) : R;
        stR[i] = R; stC[i] = C; voffA[i] = (unsigned)(R * K + C) * 2u; voffB[i] = (unsigned)(Rb * K + C) * 2u; }
    const size_t kstep = (size_t)(BK * 2);
    const size_t hstep = (size_t)HALF * K * 2;
    const size_t tstep = 2 * hstep;
    const unsigned ldsw = (unsigned)wid * 1024u;
    const int aoff = lds_byte(wr * 64 + fr, fq * 8), boff = lds_byte(wc * 32 + fr, fq * 8);
#define PG8_SA(b, h) (((b) * 2 + (h)) * HTB)
#define PG8_SB(b, h) ((4 + (b) * 2 + (h)) * HTB)
#define PG8_STAGE(bufoff, gbase, voff) do { _Pragma("unroll") for (int _i = 0; _i < 2; ++_i) \
        __builtin_amdgcn_global_load_lds((const unsigned*)((const char*)(gbase) + (voff)[_i]), (PG8_LAS unsigned*)(lds + (bufoff) + ldsw + _i * 8192), 16, 0, 0); } while (0)
#define PG8_STAGE_A(b, h, gbase, NX) do { if constexpr (AM::GATHER) { const unsigned so_[2] = {(NX) ? gno[h][0] : gao[h][0], (NX) ? gno[h][1] : gao[h][1]}; PG8_STAGE(PG8_SA(b, h), gbase, so_); } \
        else { PG8_STAGE(PG8_SA(b, h), (gbase) + (h) * hstep, voffA); } } while (0)
#define PG8_LDA(dst, b, h) do { _Pragma("unroll") for (int m = 0; m < 4; ++m) _Pragma("unroll") for (int k = 0; k < 2; ++k) dst[m][k] = *(const PG8_LAS bf16x8*)(lds + PG8_SA(b, h) + aoff + m * 2048 + k * 1024); } while (0)
#define PG8_LDB(dst, b, h) do { _Pragma("unroll") for (int n = 0; n < 2; ++n) _Pragma("unroll") for (int k = 0; k < 2; ++k) dst[n][k] = *(const PG8_LAS bf16x8*)(lds + PG8_SB(b, h) + boff + n * 2048 + k * 1024); } while (0)
#define PG8_MMA(ai, bj, At, Bt) do { __builtin_amdgcn_s_setprio(1); _Pragma("unroll") for (int m = 0; m < 4; ++m) _Pragma("unroll") for (int n = 0; n < 2; ++n) _Pragma("unroll") for (int k = 0; k < 2; ++k) \
        acc[ai][bj][m][n] = __builtin_amdgcn_mfma_f32_16x16x32_bf16(Bt[n][k], At[m][k], acc[ai][bj][m][n], 0, 0, 0); __builtin_amdgcn_s_setprio(0); } while (0)
#define PG8_WAIT_V(n) asm volatile("s_waitcnt vmcnt(" #n ")" ::: "memory")
#define PG8_WAIT_L(n) asm volatile("s_waitcnt lgkmcnt(" #n ")" ::: "memory")
#define PG8_BAR __builtin_amdgcn_s_barrier()
#define PG8_SCHED __builtin_amdgcn_sched_barrier(0)
    Unit cur, nxt; int ui = 0;
    if (!S.next(0, cur)) return;
    f32x4 acc[2][2][4][2];
#pragma unroll
    for (int a = 0; a < 2; ++a)
#pragma unroll
        for (int b = 0; b < 2; ++b)
#pragma unroll
            for (int m = 0; m < 4; ++m)
#pragma unroll
                for (int n = 0; n < 2; ++n) acc[a][b][m][n] = (f32x4){0.f, 0.f, 0.f, 0.f};
    bf16x8 At[4][2], B0[2][2], B1[2][2];
    const char* cA = (const char*)g.A + (AM::GATHER ? (size_t)0 : (size_t)cur.pm * tstep); const char* cB = (const char*)g.Bt + (size_t)cur.pb * tstep;
    unsigned gao[2][2], gno[2][2];
    if constexpr (AM::GATHER) { _Pragma("unroll") for (int h = 0; h < 2; ++h) _Pragma("unroll") for (int i = 0; i < 2; ++i) { gao[h][i] = (unsigned)(am.arow(cur, h * HALF + stR[i]) * K + stC[i]) * 2u; gno[h][i] = gao[h][i]; } }
    else { _Pragma("unroll") for (int h = 0; h < 2; ++h) _Pragma("unroll") for (int i = 0; i < 2; ++i) { gao[h][i] = 0u; gno[h][i] = 0u; } }
    S.a_ready(cur);
    if constexpr (SP2) {
        PG8_STAGE(PG8_SB(0, 0), cB, voffB); PG8_STAGE(PG8_SB(0, 1), cB + hstep, voffB); PG8_STAGE_A(0, 0, cA, false); PG8_STAGE_A(0, 1, cA, false);
        if (wr == 1) PG8_BAR;
        PG8_WAIT_V(2); PG8_BAR;
        PG8_STAGE(PG8_SB(1, 0), cB + kstep, voffB); PG8_STAGE_A(1, 0, cA + kstep, false); PG8_STAGE(PG8_SB(1, 1), cB + hstep + kstep, voffB);
        PG8_WAIT_V(6); PG8_BAR;
    } else {
        PG8_STAGE(PG8_SB(0, 0), cB, voffB); PG8_STAGE_A(0, 0, cA, false); PG8_STAGE(PG8_SB(0, 1), cB + hstep, voffB); PG8_STAGE_A(0, 1, cA, false);
        if (wr == 1) PG8_BAR;
        PG8_WAIT_V(4); PG8_BAR;
        PG8_STAGE(PG8_SB(1, 0), cB + kstep, voffB); PG8_STAGE_A(1, 0, cA + kstep, false); PG8_STAGE(PG8_SB(1, 1), cB + hstep + kstep, voffB);
        PG8_WAIT_V(6); PG8_BAR;
    }
    for (;;) {
        const bool has_next = S.next(ui + 1, nxt);
        const char* nA = has_next ? (const char*)g.A + (AM::GATHER ? (size_t)0 : (size_t)nxt.pm * tstep) : cA; const char* nB = has_next ? (const char*)g.Bt + (size_t)nxt.pb * tstep : cB;
        if constexpr (AM::GATHER) { if (has_next) { _Pragma("unroll") for (int h = 0; h < 2; ++h) _Pragma("unroll") for (int i = 0; i < 2; ++i) gno[h][i] = (unsigned)(am.arow(nxt, h * HALF + stR[i]) * K + stC[i]) * 2u; } }
        for (int t = 0; t < nt; t += 2) {
            const bool last = (t == nt - 2);
            const char* a1 = cA + (size_t)(t + 1) * kstep;
            const char* a2 = last ? nA : cA + (size_t)(t + 2) * kstep; const char* b2 = last ? nB : cB + (size_t)(t + 2) * kstep;
            const char* a3 = a2 + kstep; const char* b3 = b2 + kstep;
            if (last && has_next) S.a_ready(nxt);
            if (false) E.prefetch(cur, tid, (PG8_LAS unsigned*)(lds + 162816 + 512));
            if constexpr (SP2) {
            PG8_LDB(B0, 0, 0); PG8_LDB(B1, 0, 1); PG8_SCHED; PG8_LDA(At, 0, 0); PG8_STAGE_A(1, 1, a1, false);
            PG8_WAIT_V(8); PG8_WAIT_L(0); PG8_BAR; PG8_MMA(0, 0, At, B0); PG8_MMA(0, 1, At, B1); PG8_BAR; PG8_SCHED;
            PG8_LDA(At, 0, 1); PG8_STAGE(PG8_SB(0, 0), b2, voffB); PG8_STAGE(PG8_SB(0, 1), b2 + hstep, voffB); PG8_STAGE_A(0, 0, a2, last);
            PG8_WAIT_V(8); PG8_WAIT_L(0); PG8_BAR; PG8_MMA(1, 0, At, B0); PG8_MMA(1, 1, At, B1); PG8_BAR; PG8_SCHED;
            PG8_LDB(B0, 1, 0); PG8_LDB(B1, 1, 1); PG8_SCHED; PG8_LDA(At, 1, 0); PG8_STAGE_A(0, 1, a2, last);
            PG8_WAIT_V(8); PG8_WAIT_L(0); PG8_BAR; PG8_MMA(0, 0, At, B0); PG8_MMA(0, 1, At, B1); PG8_BAR; PG8_SCHED;
            PG8_LDA(At, 1, 1); PG8_STAGE(PG8_SB(1, 0), b3, voffB); PG8_STAGE(PG8_SB(1, 1), b3 + hstep, voffB); PG8_STAGE_A(1, 0, a3, last);
            PG8_WAIT_V(8); PG8_WAIT_L(0); PG8_BAR; PG8_MMA(1, 0, At, B0); PG8_MMA(1, 1, At, B1); PG8_BAR; PG8_SCHED;
            } else {
            PG8_LDB(B0, 0, 0); PG8_SCHED; PG8_LDA(At, 0, 0); PG8_STAGE_A(1, 1, a1, false);
            PG8_WAIT_L(8); PG8_BAR; PG8_WAIT_L(0); PG8_MMA(0, 0, At, B0); PG8_BAR; PG8_SCHED;
            PG8_LDB(B1, 0, 1); PG8_STAGE(PG8_SB(0, 0), b2, voffB);
            PG8_BAR; PG8_WAIT_L(0); PG8_MMA(0, 1, At, B1); PG8_BAR;
            PG8_LDA(At, 0, 1); PG8_STAGE_A(0, 0, a2, last);
            PG8_BAR; PG8_WAIT_L(0); PG8_MMA(1, 0, At, B0); PG8_BAR; PG8_SCHED;
            PG8_STAGE(PG8_SB(0, 1), b2 + hstep, voffB);
            PG8_WAIT_V(6); PG8_BAR; PG8_MMA(1, 1, At, B1); PG8_BAR;
            PG8_LDB(B0, 1, 0); PG8_SCHED; PG8_LDA(At, 1, 0); PG8_STAGE_A(0, 1, a2, last);
            PG8_WAIT_L(8); PG8_BAR; PG8_WAIT_L(0); PG8_MMA(0, 0, At, B0); PG8_BAR; PG8_SCHED;
            PG8_LDB(B1, 1, 1); PG8_STAGE(PG8_SB(1, 0), b3, voffB);
            PG8_BAR; PG8_WAIT_L(0); PG8_MMA(0, 1, At, B1); PG8_BAR;
            PG8_LDA(At, 1, 1); PG8_STAGE_A(1, 0, a3, last);
            PG8_BAR; PG8_WAIT_L(0); PG8_MMA(1, 0, At, B0); PG8_BAR; PG8_SCHED;
            PG8_STAGE(PG8_SB(1, 1), b3 + hstep, voffB);
            PG8_WAIT_V(6); PG8_BAR; PG8_MMA(1, 1, At, B1); PG8_BAR;
            }
        }
        if constexpr (ALIGN_EPI) { if (wr == 0) PG8_BAR; }
        if constexpr (!Epi::AFTER_DRAIN) { E(acc, cur, wr, wc, fr, fq); S.done(cur); }
        if (!has_next) break;
#pragma unroll
        for (int a = 0; a < 2; ++a)
#pragma unroll
            for (int b = 0; b < 2; ++b)
#pragma unroll
                for (int m = 0; m < 4; ++m)
#pragma unroll
                    for (int n = 0; n < 2; ++n) acc[a][b][m][n] = (f32x4){0.f, 0.f, 0.f, 0.f};
        cur = nxt; cA = nA; cB = nB; ++ui;
        if constexpr (AM::GATHER) { _Pragma("unroll") for (int h = 0; h < 2; ++h) _Pragma("unroll") for (int i = 0; i < 2; ++i) gao[h][i] = gno[h][i]; }
        if constexpr (ALIGN_EPI) { if (wr == 1) PG8_BAR; }
    }
    PG8_WAIT_V(0);
    if constexpr (!ALIGN_EPI) { if (wr == 0) PG8_BAR; }
    PG8_BAR;
    if constexpr (Epi::AFTER_DRAIN) { E.fused(acc, cur, wr, wc, fr, fq, lds, wid, lane); S.done(cur); }
#undef PG8_SA
#undef PG8_SB
#undef PG8_STAGE
#undef PG8_STAGE_A
#undef PG8_LDA
#undef PG8_LDB
#undef PG8_MMA
#undef PG8_WAIT_V
#undef PG8_WAIT_L
#undef PG8_BAR
#undef PG8_SCHED
}

__device__ __forceinline__ u32x4 pack8(const f32x4 v0, const f32x4 v1) { u32x4 w; w.x = cvt_pk_bf16(v0[0], v0[1]); w.y = cvt_pk_bf16(v0[2], v0[3]); w.z = cvt_pk_bf16(v1[0], v1[1]); w.w = cvt_pk_bf16(v1[2], v1[3]); return w; }
__device__ __forceinline__ u32x4 xpose4x16(const u32x4 w, int sa) {
    u32x4 r; r.x = __builtin_amdgcn_ds_bpermute(sa, w.x); r.y = __builtin_amdgcn_ds_bpermute(sa, w.y); r.z = __builtin_amdgcn_ds_bpermute(sa, w.z); r.w = __builtin_amdgcn_ds_bpermute(sa, w.w); return r;
}
#define XPOSE_IDS() const int L_ = fr + 16 * fq, tr_ = L_ >> 2, tq_ = L_ & 3, sa_ = 4 * (tr_ + 16 * tq_)
__device__ __forceinline__ float silu1(float x) { return x * __builtin_amdgcn_rcpf(1.0f + __builtin_amdgcn_exp2f(-1.4426950408889634f * x)); }
template <bool SILU> struct EpiPair {
    static constexpr bool PERM = true, AFTER_DRAIN = false;
    bf16_t* O; int ldc;
    __device__ __forceinline__ void prefetch(const Unit&, int, PG8_LAS unsigned*) const {}
    __device__ __forceinline__ void operator()(const f32x4 (&acc)[2][2][4][2], const Unit& u, int wr, int wc, int fr, int fq) const {
        XPOSE_IDS();
        const int row0 = u.pm * BM + wr * 64 + tr_, ch0 = u.pn * HALF + wc * 32 + 8 * tq_;
#pragma unroll
        for (int ai = 0; ai < 2; ++ai)
#pragma unroll
            for (int m = 0; m < 4; ++m) {
                f32x4 a0 = acc[ai][0][m][0], a1 = acc[ai][0][m][1];
                if (SILU) {
#pragma unroll
                    for (int c = 0; c < 4; ++c) { a0[c] = silu1(a0[c]); a1[c] = silu1(a1[c]); }
                }
                *(u32x4*)(O + (size_t)(row0 + ai * HALF + m * 16) * ldc + ch0) = xpose4x16(pack8(a0 * acc[ai][1][m][0], a1 * acc[ai][1][m][1]), sa_);
            }
    }
};
struct EpiYpre {
    static constexpr bool PERM = true, AFTER_DRAIN = false;
    bf16_t* O; const bf16_t* Z; const float* cw;
    __device__ __forceinline__ void prefetch(const Unit& u, int tid, PG8_LAS unsigned* dummy) const {
#pragma unroll
        for (int i = 0; i < 2; ++i) { const int line = tid + 512 * i, row = line >> 2, seg = line & 3;
            __builtin_amdgcn_global_load_lds((const unsigned*)(Z + (size_t)(u.pm * BM + row) * D + u.pn * BM + seg * 64), dummy, 4, 0, 0); }
    }
    __device__ __forceinline__ void operator()(const f32x4 (&acc)[2][2][4][2], const Unit& u, int wr, int wc, int fr, int fq) const {
        XPOSE_IDS();
        const int row0 = u.pm * BM + wr * 64 + fr;
#pragma unroll
        for (int bj = 0; bj < 2; ++bj) {
            const int col0 = u.pn * BM + bj * HALF + wc * 32 + 8 * fq;
            f32x4 w0[2], w1[2], w2[2];
#pragma unroll
            for (int n = 0; n < 2; ++n) { w0[n] = *(const f32x4*)(cw + col0 + 4 * n); w1[n] = *(const f32x4*)(cw + D + col0 + 4 * n); w2[n] = *(const f32x4*)(cw + 2 * D + col0 + 4 * n); }
#pragma unroll
            for (int ai = 0; ai < 2; ++ai) {
                u32x4 zz[4][3];
#pragma unroll
                for (int m = 0; m < 4; ++m) {
                    const int row = row0 + ai * HALF + m * 16, t = row & (SEQ - 1);
                    const bf16_t* zp = Z + (size_t)row * D + col0;
                    zz[m][0] = *(const u32x4*)zp; zz[m][1] = (u32x4){0u, 0u, 0u, 0u}; zz[m][2] = (u32x4){0u, 0u, 0u, 0u};
                    if (t >= 1) zz[m][1] = *(const u32x4*)(zp - D);
                    if (t >= 2) zz[m][2] = *(const u32x4*)(zp - 2 * D);
                }
#pragma unroll
                for (int m = 0; m < 4; ++m) {
                    const int row = row0 + ai * HALF + m * 16;
                    const u32x4 z0 = zz[m][0], z1 = zz[m][1], z2 = zz[m][2];
                    f32x4 v[2];
#pragma unroll
                    for (int n = 0; n < 2; ++n) {
                        f32x4 a, b, c;
                        a[0] = __uint_as_float(z0[2 * n] << 16); a[1] = __uint_as_float(z0[2 * n] & 0xffff0000u); a[2] = __uint_as_float(z0[2 * n + 1] << 16); a[3] = __uint_as_float(z0[2 * n + 1] & 0xffff0000u);
                        b[0] = __uint_as_float(z1[2 * n] << 16); b[1] = __uint_as_float(z1[2 * n] & 0xffff0000u); b[2] = __uint_as_float(z1[2 * n + 1] << 16); b[3] = __uint_as_float(z1[2 * n + 1] & 0xffff0000u);
                        c[0] = __uint_as_float(z2[2 * n] << 16); c[1] = __uint_as_float(z2[2 * n] & 0xffff0000u); c[2] = __uint_as_float(z2[2 * n + 1] << 16); c[3] = __uint_as_float(z2[2 * n + 1] & 0xffff0000u);
                        v[n] = acc[ai][bj][m][n] * (w2[n] * a + w1[n] * b + w0[n] * c);
                    }
                    *(u32x4*)(O + (size_t)(row - fr + tr_) * D + col0 - 8 * fq + 8 * tq_) = xpose4x16(pack8(v[0], v[1]), sa_);
                }
                asm volatile("" ::: "memory");
            }
        }
    }
};

template <bool RES_F32> struct EpiRes {
    static constexpr bool PERM = true, AFTER_DRAIN = false;
    bf16_t* xr; const float* xin; const float* modg;
    __device__ __forceinline__ void prefetch(const Unit&, int, PG8_LAS unsigned*) const {}
    __device__ __forceinline__ void operator()(const f32x4 (&acc)[2][2][4][2], const Unit& u, int wr, int wc, int fr, int fq) const {
        XPOSE_IDS();
        const int row0 = u.pm * BM + wr * 64 + fr, col0 = u.pn * BM + wc * 32 + 8 * fq;
        const float* gb = modg + (size_t)((u.pm * BM) >> 12) * 6144;
        f32x4 gv[2][2];
#pragma unroll
        for (int bj = 0; bj < 2; ++bj)
#pragma unroll
            for (int n = 0; n < 2; ++n) gv[bj][n] = *(const f32x4*)(gb + col0 + bj * HALF + n * 4);
#pragma unroll
        for (int ai = 0; ai < 2; ++ai) {
            f32x4 rv[4][2][2];
#pragma unroll
            for (int m = 0; m < 4; ++m) { const int row = row0 + ai * HALF + m * 16;
#pragma unroll
                for (int bj = 0; bj < 2; ++bj) {
                    if (RES_F32) { rv[m][bj][0] = ntload((const f32x4*)(xin + (size_t)row * D + col0 + bj * HALF)); rv[m][bj][1] = ntload((const f32x4*)(xin + (size_t)row * D + col0 + bj * HALF + 4)); }
                    else { const u32x4 w = *(const u32x4*)(xr + (size_t)row * XRP + col0 + bj * HALF);
                        rv[m][bj][0] = (f32x4){__uint_as_float(w.x << 16), __uint_as_float(w.x & 0xffff0000u), __uint_as_float(w.y << 16), __uint_as_float(w.y & 0xffff0000u)};
                        rv[m][bj][1] = (f32x4){__uint_as_float(w.z << 16), __uint_as_float(w.z & 0xffff0000u), __uint_as_float(w.w << 16), __uint_as_float(w.w & 0xffff0000u)}; }
                } }
#pragma unroll
            for (int m = 0; m < 4; ++m) { const int row = row0 + ai * HALF + m * 16;
#pragma unroll
                for (int bj = 0; bj < 2; ++bj)
                    *(u32x4*)(xr + (size_t)(row - fr + tr_) * XRP + col0 - 8 * fq + 8 * tq_ + bj * HALF) = xpose4x16(pack8(rv[m][bj][0] + gv[bj][0] * acc[ai][bj][m][0], rv[m][bj][1] + gv[bj][1] * acc[ai][bj][m][1]), sa_); }
            asm volatile("" ::: "memory");
        }
    }
};
struct EpiQKV {
    static constexpr bool PERM = true, AFTER_DRAIN = false;
    bf16_t* O; const float* rope; int row_off;
    __device__ __forceinline__ void prefetch(const Unit&, int, PG8_LAS unsigned*) const {}
    __device__ __forceinline__ void operator()(const f32x4 (&acc)[2][2][4][2], const Unit& u, int wr, int wc, int fr, int fq) const {
        XPOSE_IDS();
        const int row0 = u.pm * BM + wr * 64 + fr;
        const int typ = (u.pn % 6) >> 1, gq_ = u.pn / 6;
        const float sc = (typ == 0) ? QSCALE : 1.0f;
        const int hb = 4 * (u.pn & 1) + (wc >> 1);
        bf16_t* ob = O + 32 * (wc & 1) + 8 * tq_;
        if ((typ < 2) && ((wc & 1) == 0)) {
            f32x4 csv[2][4], snv[2][4];
#pragma unroll
            for (int ai = 0; ai < 2; ++ai)
#pragma unroll
                for (int m = 0; m < 4; ++m) { const int pos = (row0 + ai * HALF + m * 16) & (SEQ - 1);
                    csv[ai][m] = (f32x4){1.f, 1.f, 1.f, 1.f}; snv[ai][m] = (f32x4){0.f, 0.f, 0.f, 0.f};
                    if (fq < 2) { csv[ai][m] = *(const f32x4*)(rope + pos * 8 + 4 * fq); snv[ai][m] = *(const f32x4*)(rope + 4096 * 8 + pos * 8 + 4 * fq); } }
            asm volatile("" ::: "memory");
#pragma unroll
            for (int ai = 0; ai < 2; ++ai)
#pragma unroll
                for (int m = 0; m < 4; ++m) {
                    const int tok = row_off + row0 + ai * HALF + m * 16 - fr + tr_;
                    const f32x4 cs = csv[ai][m], sn = snv[ai][m];
#pragma unroll
                    for (int bj = 0; bj < 2; ++bj) {
                        const f32x4 x1 = acc[ai][bj][m][0], x2 = acc[ai][bj][m][1];
                        const f32x4 r1 = (x1 * cs - x2 * sn) * sc, r2 = (x2 * cs + x1 * sn) * sc;
                        *(u32x4*)(ob + qkv_block(typ, gq_, tok >> 12, hb + 2 * bj) + (size_t)qkv_row(tok & (SEQ - 1), gq_) * 64) = xpose4x16(pack8(r1, r2), sa_);
                    }
                }
        } else {
#pragma unroll
            for (int ai = 0; ai < 2; ++ai)
#pragma unroll
                for (int m = 0; m < 4; ++m) {
                    const int tok = row_off + row0 + ai * HALF + m * 16 - fr + tr_;
#pragma unroll
                    for (int bj = 0; bj < 2; ++bj)
                        *(u32x4*)(ob + qkv_block(typ, gq_, tok >> 12, hb + 2 * bj) + (size_t)qkv_row(tok & (SEQ - 1), gq_) * 64) = xpose4x16(pack8(acc[ai][bj][m][0] * sc, acc[ai][bj][m][1] * sc), sa_);
                }
        }
    }
};
struct EpiDown {
    static constexpr bool PERM = true, AFTER_DRAIN = false;
    bf16_t* O; const float* lw; const PG8_LAS int* rb;
    __device__ __forceinline__ void prefetch(const Unit&, int, PG8_LAS unsigned*) const {}
    __device__ __forceinline__ void operator()(const f32x4 (&acc)[2][2][4][2], const Unit& u, int wr, int wc, int fr, int fq) const {
        XPOSE_IDS();
        const int row0 = u.pm * BM + wr * 64 + fr, col0 = u.pn * BM + wc * 32 + 8 * fq;
        const int e = u.pb >> 2; const float* wrow = lw + (size_t)e * LISTCAP - rb[e];
        float wv[2][4];
#pragma unroll
        for (int ai = 0; ai < 2; ++ai)
#pragma unroll
            for (int m = 0; m < 4; ++m) wv[ai][m] = wrow[row0 + ai * HALF + m * 16];
#pragma unroll
        for (int ai = 0; ai < 2; ++ai)
#pragma unroll
            for (int m = 0; m < 4; ++m) {
                const int row = row0 + ai * HALF + m * 16; const float w = wv[ai][m];
#pragma unroll
                for (int bj = 0; bj < 2; ++bj) *(u32x4*)(O + (size_t)(row - fr + tr_) * D + col0 - 8 * fq + 8 * tq_ + bj * HALF) = xpose4x16(pack8(acc[ai][bj][m][0] * w, acc[ai][bj][m][1] * w), sa_);
            }
    }
};
struct MoeOrder {
    int nM, nN, nwg, G, c; const PG8_LAS int* rb;
    __device__ void init(int nRT, int G_, int c_, const PG8_LAS int* rb_) { nM = nRT; nN = 4; nwg = nM * nN; G = G_; c = c_; rb = rb_; }
    __device__ bool next(int i, Unit& u) const {
        const long L = (long)i * G + c; if (L >= nwg) return false;
        int wgid = (int)L; { const int q = nwg / NXCD, r = nwg % NXCD, xcd = wgid % NXCD, off = wgid / NXCD; wgid = (xcd < r ? xcd * (q + 1) : r * (q + 1) + (xcd - r) * q) + off; }
        const int nig = WGM * nN, gid = wgid / nig, fm = gid * WGM, gsz = (nM - fm) < WGM ? (nM - fm) : WGM;
        u.pm = fm + ((wgid % nig) % gsz); u.pn = (wgid % nig) / gsz;
        int e = 0; const int r0 = u.pm * BM;
#pragma unroll 1
        while (e < 31 && rb[e + 1] <= r0) ++e;
        u.pb = e * 4 + u.pn; return true;
    }
    __device__ __forceinline__ void a_ready(const Unit&) const {}
    __device__ __forceinline__ void done(const Unit&) const {}
};
struct APlain { static constexpr bool GATHER = false; __device__ __forceinline__ int arow(const Unit&, int) const { return 0; } };
struct AGather {
    static constexpr bool GATHER = true;
    const int* ltok; const int* cnt; const PG8_LAS int* rb;
    __device__ __forceinline__ int arow(const Unit& u, int r) const { const int e = u.pb >> 2, l = u.pm * BM - rb[e] + r; return (l < cnt[e]) ? ltok[(size_t)e * LISTCAP + l] : 0; }
};
}

#define XB_TMO      128
#define XB_XCNT(j)  (256  + 64 * (j))
#define XB_XSUB(j)  (1280 + 64 * (j))
#define XB_XGEN(j)  (2304 + 64 * (j))
#define XB_TOP      3328
#define XB_TOPGEN   3392
#define XCD_BAR_WORDS 3456
#define XB_SPIN_CAP (1u << 18)

__device__ __forceinline__ unsigned xb_ld(unsigned* p)              { return __hip_atomic_load(p, __ATOMIC_RELAXED, __HIP_MEMORY_SCOPE_AGENT); }
__device__ __forceinline__ unsigned xb_add(unsigned* p, unsigned v) { return __hip_atomic_fetch_add(p, v, __ATOMIC_RELAXED, __HIP_MEMORY_SCOPE_AGENT); }
__device__ __forceinline__ unsigned xb_xcc_id() { return (unsigned)__builtin_amdgcn_s_getreg((3 << 11) | 20) & 0xFu; }
#define XB_SPIN(cond, bar) do { unsigned _sp = 0; while (cond) { __builtin_amdgcn_s_sleep(1); \
    if ((++_sp & 255u) == 0u) { if (xb_ld(&(bar)[XB_TMO])) break; if (_sp > XB_SPIN_CAP) { atomicAdd(&(bar)[XB_TMO], 1u); break; } } } } while (0)

struct XcdBarrier {
    unsigned* bar; unsigned x;
    volatile LAS unsigned* st;
};

__device__ __forceinline__ XcdBarrier xcd_barrier_post(unsigned* bar, volatile LAS unsigned* st, int wave) {
    XcdBarrier b; b.bar = bar; b.x = xb_xcc_id(); b.st = st;
    if (wave == 0 && lane_id() == 0) (void)xb_add(&bar[XB_XCNT(b.x)], 1u);
    return b;
}
__device__ __forceinline__ void xcd_barrier_complete(unsigned* bar, unsigned x, unsigned& nloc, unsigned& nx) {
    const unsigned G = gridDim.x * gridDim.y * gridDim.z;
    unsigned sum, cnt, mine, sp = 0u;
    for (;;) {
        sum = 0u; cnt = 0u; mine = 0u;
#pragma unroll
        for (unsigned j = 0; j < 16; ++j) { const unsigned c = xb_ld(&bar[XB_XCNT(j)]); sum += c; cnt += (c > 0u) ? 1u : 0u; mine = (j == x) ? c : mine; }
        if (sum == G) break;
        __builtin_amdgcn_s_sleep(1);
        if ((++sp & 255u) == 0u) { if (xb_ld(&bar[XB_TMO])) break; if (sp > XB_SPIN_CAP) { atomicAdd(&bar[XB_TMO], 1u); break; } }
    }
    nloc = mine > 0u ? mine : 1u; nx = cnt > 0u ? cnt : 1u;
}

__device__ __forceinline__ void xcd_barrier(const XcdBarrier& b, int wave) {
    asm volatile("s_waitcnt vmcnt(0)" ::: "memory");
    __syncthreads();
    if (wave == 0 && lane_id() == 0) {
        unsigned* bar = b.bar;
        __builtin_amdgcn_s_waitcnt(0);
        unsigned nloc = b.st[0], nx = b.st[1];
        if (nloc == 0u) { xcd_barrier_complete(bar, b.x, nloc, nx); b.st[0] = nloc; b.st[1] = nx; }
        const unsigned old = xb_add(&bar[XB_XSUB(b.x)], 1u);
        const unsigned gen = old / nloc;
        if (old + 1u == (gen + 1u) * nloc) {
            __builtin_amdgcn_fence(__ATOMIC_RELEASE, "agent");
            asm volatile("s_waitcnt vmcnt(0)" ::: "memory");
            const unsigned og = xb_add(&bar[XB_TOP], 1u);
            const unsigned tg = og / nx;
            if (og + 1u == (tg + 1u) * nx) xb_add(&bar[XB_TOPGEN], 1u);
            else XB_SPIN(xb_ld(&bar[XB_TOPGEN]) == tg, bar);
            __builtin_amdgcn_fence(__ATOMIC_ACQUIRE, "agent");
            xb_add(&bar[XB_XGEN(b.x)], 1u);
            asm volatile("s_waitcnt vmcnt(0)" ::: "memory");
        } else {
            XB_SPIN(xb_ld(&bar[XB_XGEN(b.x)]) == gen, bar);
            __builtin_amdgcn_fence(__ATOMIC_ACQUIRE, "agent");
            asm volatile("s_waitcnt vmcnt(0)" ::: "memory");
        }
    }
    __syncthreads();
}

struct RowV { f32x4 v[4]; };
__device__ __forceinline__ void row_load(RowV& r, const float* row, int lane) {
#pragma unroll
    for (int j = 0; j < 4; ++j) r.v[j] = ntload((const f32x4*)(row + 4 * lane + 256 * j));
}
__device__ __forceinline__ void row_load_bf16(RowV& r, const bf16_t* row, int lane) {
#pragma unroll
    for (int j = 0; j < 4; ++j) { const u32x2 w = *(const u32x2*)(row + 4 * lane + 256 * j); r.v[j] = (f32x4){bflo(w.x), bfhi(w.x), bflo(w.y), bfhi(w.y)}; }
}
__device__ __forceinline__ float row_rstd(const RowV& r) {
    float s = 0.f;
#pragma unroll
    for (int j = 0; j < 4; ++j) s += (r.v[j].x * r.v[j].x + r.v[j].y * r.v[j].y) + (r.v[j].z * r.v[j].z + r.v[j].w * r.v[j].w);
    s = wave_sum(s);
    return __builtin_amdgcn_rsqf(s * (1.0f / 1024.0f) + EPS);
}
__device__ __forceinline__ void row_modulate(RowV& r, float rstd, const float* g, const float* sh, const float* sc, int lane) {
#pragma unroll
    for (int j = 0; j < 4; ++j) {
        const int o = 4 * lane + 256 * j;
        const f32x4 gg = *(const f32x4*)(g + o), s = *(const f32x4*)(sc + o), h = *(const f32x4*)(sh + o);
        r.v[j] = (r.v[j] * rstd * gg) * (s + 1.0f) + h;
    }
}
struct ModV { f32x4 gp[4], sh[4]; };
__device__ __forceinline__ void mod_load(ModV& m, const float* g, const float* sh, const float* sc, int lane) {
#pragma unroll
    for (int j = 0; j < 4; ++j) { const int o = 4 * lane + 256 * j; m.gp[j] = *(const f32x4*)(g + o) * (*(const f32x4*)(sc + o) + 1.0f); m.sh[j] = *(const f32x4*)(sh + o); }
}
__device__ __forceinline__ void row_apply(RowV& r, float rstd, const ModV& m) {
#pragma unroll
    for (int j = 0; j < 4; ++j) r.v[j] = (r.v[j] * rstd) * m.gp[j] + m.sh[j];
}
__device__ __forceinline__ void row_store_bf16(const RowV& r, bf16_t* out, int lane) {
#pragma unroll
    for (int j = 0; j < 4; ++j) { u32x2 w; w.x = pg8::cvt_pk_bf16(r.v[j].x, r.v[j].y); w.y = pg8::cvt_pk_bf16(r.v[j].z, r.v[j].w); *(u32x2*)(out + 4 * lane + 256 * j) = w; }
}
__device__ __forceinline__ void row_store_f32(const RowV& r, float* out, int lane) {
#pragma unroll
    for (int j = 0; j < 4; ++j) *(f32x4*)(out + 4 * lane + 256 * j) = r.v[j];
}

__device__ __forceinline__ int wmap(int code, int n) {
    if (code == 1) { const int isU = n >> 10, ch = n & 1023; return (ch >> 7) * 256 + isU * 128 + (ch & 127); }
    if (code == 2) { const int typ = (n % 1536) / 512, d = n & 63; return (typ < 2 && d >= 4 && d < 12) ? (d < 8 ? n + 4 : n - 4) : n; }
    if (code == 3) return (n >> 7) * 256 + (n & 127);
    if (code == 4) return (n >> 7) * 256 + 128 + (n & 127);
    return n;
}
struct ConvDesc { const float* src; bf16_t* dst; int ldw, K, code, nloc; };
__device__ __forceinline__ void conv_desc(ConvDesc& d, const float* W, int ldw, int ncol0, bf16_t* WT, int K, int code, int kb, int nb) {
    d.src = W + (size_t)(64 * kb) * ldw + ncol0 + 64 * nb; d.dst = WT + 64 * kb; d.ldw = ldw; d.K = K; d.code = code; d.nloc = 64 * nb;
}
__device__ __forceinline__ void conv_load(f32x4 (&v)[16], const ConvDesc& d, int lane) {
    const float* src = d.src + (size_t)(lane >> 4) * d.ldw + (lane & 15) * 4;
#pragma unroll
    for (int i = 0; i < 16; ++i) v[i] = ntload((const f32x4*)(src + (size_t)(4 * i) * d.ldw));
}
__device__ __forceinline__ void conv_process(const f32x4 (&v)[16], const ConvDesc& d, LAS float* scr, int lane) {
#pragma unroll
    for (int i = 0; i < 16; ++i) { LAS float* p = scr + (4 * i + (lane >> 4)) * 65 + (lane & 15) * 4; p[0] = v[i].x; p[1] = v[i].y; p[2] = v[i].z; p[3] = v[i].w; }
    LDS_WAIT();
    const int c = lane & 7;
#pragma unroll
    for (int j = 0; j < 8; ++j) { const int n = (lane >> 3) + 8 * j; const LAS float* sp = scr + (8 * c) * 65 + n;
        u32x4 o; o.x = pg8::cvt_pk_bf16(sp[0 * 65], sp[1 * 65]); o.y = pg8::cvt_pk_bf16(sp[2 * 65], sp[3 * 65]); o.z = pg8::cvt_pk_bf16(sp[4 * 65], sp[5 * 65]); o.w = pg8::cvt_pk_bf16(sp[6 * 65], sp[7 * 65]);
        *(u32x4*)(d.dst + (size_t)wmap(d.code, d.nloc + n) * d.K + 8 * c) = o; }
    LDS_WAIT();
}
constexpr int NCONV_ITEMS = 512 + 256 + 256 + 1152 + 128 + 64 * 384;

namespace att {
typedef short bf16x8 __attribute__((ext_vector_type(8)));
typedef short s16x4 __attribute__((ext_vector_type(4)));
typedef float f32x16 __attribute__((ext_vector_type(16)));
constexpr int NKEY = 384, KOFF = 0, KCH = NKEY * 16 + 16  , VOFF = 8 * KCH, VDH = (NKEY / 16) * 1024 + 64  , NUNITS = 16 * 3 * 16 * 8;
__device__ __forceinline__ int crow(int r, int hi) { return (r & 3) + 8 * (r >> 2) + 4 * hi; }
__device__ __forceinline__ s16x4 vtr(const LAS unsigned char* p) { return __builtin_bit_cast(s16x4, __builtin_amdgcn_ds_read_tr16_b64_v4i16((LAS s16x4*)p)); }
__device__ __forceinline__ float xhalf_max(float m) { auto rr = __builtin_amdgcn_permlane32_swap(__float_as_uint(m), __float_as_uint(m), false, false); return fmaxf(__uint_as_float(rr[0]), __uint_as_float(rr[1])); }
__device__ __forceinline__ float xhalf_sum(float m) { auto rr = __builtin_amdgcn_permlane32_swap(__float_as_uint(m), __float_as_uint(m), false, false); return __uint_as_float(rr[0]) + __uint_as_float(rr[1]); }

template <typename P> __device__ __forceinline__ P sadd(P base, unsigned off) { asm volatile("" : "+v"(off)); return base + off; }
struct AUnit { int h, g, b, dil, l0, r0; size_t tb; };
template <bool MERGE> __device__ __forceinline__ void adecode(AUnit& u, int idx) {
    const int sb = ((idx >> 4) & 7) * 2 + (idx & 1), bg = idx >> 7; u.b = MERGE ? bg : (bg >> 1);
    u.h = (idx >> 1) & 7; u.g = MERGE ? 2 : (bg & 1); const int dsh = 2 * u.g; u.dil = 1 << dsh;
    const int bps = 16 >> dsh, r = sb / bps; u.l0 = (sb - r * bps) * 256; u.r0 = r << (12 - dsh); u.tb = (size_t)u.b * SEQ + r;
}
__device__ __forceinline__ void aload_kv(u32x4 (&kv)[12], const AUnit& u, const bf16_t* qkv, int wave, int lane) {
    const char* kb = (const char*)(qkv + qkv_block(1, u.g, u.b, u.h) + (size_t)u.r0 * 64); const char* vb = kb + (qkv_block(2, 0, 0, 0) - qkv_block(1, 0, 0, 0)) * 2;
#pragma unroll
    for (int i = 0; i < 6; ++i) {
        int sp = u.l0 - 128 + 48 * wave + 8 * i + (lane >> 3); sp = sp < 0 ? 0 : sp;
        const unsigned ro = (unsigned)sp * 128u + (unsigned)(lane & 7) * 16u;
        kv[i] = *(const u32x4*)sadd(kb, ro); kv[6 + i] = *(const u32x4*)sadd(vb, ro);
    }
}
__device__ __forceinline__ void astore_kv(const u32x4 (&kv)[12], LAS unsigned char* lds, int wave, int lane) {
#pragma unroll
    for (int i = 0; i < 6; ++i) { const int key = 48 * wave + 8 * i + (lane >> 3);
        *(LAS u32x4*)(lds + KOFF + (lane & 7) * KCH + key * 16) = kv[i];
        *(LAS u32x4*)(lds + VOFF + ((lane & 7) >> 2) * VDH + (key >> 4) * 1024 + (key & 15) * 64 + (lane & 3) * 16) = kv[6 + i]; }
}
__device__ __forceinline__ char* aqrow(const AUnit& u, bf16_t* qkv, int wave) {
    return (char*)(qkv + qkv_block(0, u.g, u.b, u.h) + (size_t)(u.r0 + u.l0 + 32 * wave) * 64);
}

template <bool MERGE> __device__ __forceinline__ void attn_phase(LAS unsigned char* lds, bf16_t* qkv, float* lse, bf16_t* ob, int bid, int G, int wave, bool dry = false) {
    constexpr int NU = MERGE ? NUNITS / 3 : 2 * NUNITS / 3;
    const int per = (NU + G - 1) / G;
    const int u_lo = bid * per, u_hi = (u_lo + per < NU) ? u_lo + per : NU;
    asm volatile("" : "+s"(wave));
    const int lane = lane_id(), r32 = lane & 31, hi = lane >> 5;
    const int qt = wave;
    const unsigned qlo = (unsigned)r32 * 128u + (unsigned)hi * 16u;
    u32x4 kv[12]; bf16x8 qn[4];
    AUnit un;
    if (u_lo < u_hi) { adecode<MERGE>(un, u_lo); aload_kv(kv, un, qkv, wave, lane);
        { const char* q = aqrow(un, qkv, wave);
#pragma unroll
            for (int d0 = 0; d0 < 4; ++d0) qn[d0] = *(const bf16x8*)(sadd(q, qlo) + d0 * 32); } }
#pragma unroll 1
    for (int idx = u_lo; idx < u_hi; ++idx) {
        const AUnit u = un;
        const int g = u.g, l0 = u.l0, head = u.h;
        char* qrow = aqrow(u, qkv, wave);
        const size_t tqw = u.tb + (size_t)(l0 + 32 * qt) * u.dil;
        bf16x8 qf[4];
        astore_kv(kv, lds, wave, lane);
#pragma unroll
        for (int d0 = 0; d0 < 4; ++d0) qf[d0] = qn[d0];
        __syncthreads();
        if (idx + 1 < u_hi) { adecode<MERGE>(un, idx + 1); aload_kv(kv, un, qkv, wave, lane);
            { const char* q = aqrow(un, qkv, wave);
#pragma unroll
                for (int d0 = 0; d0 < 4; ++d0) qn[d0] = *(const bf16x8*)(sadd(q, qlo) + d0 * 32); } }
        u32x2 og[MERGE ? 2 : 1][2][4]; float lg0 = 0.f, lg1 = 0.f;
        if constexpr (MERGE) {
            const int pq = (int)(tqw & (SEQ - 1)) + r32 * u.dil; const char* oq0 = (const char*)(qkv + qkv_block(0, 0, u.b, head)); const char* oq1 = (const char*)(qkv + qkv_block(0, 1, u.b, head));
            const unsigned oo0 = (unsigned)qkv_row(pq, 0) * 128u + 8u * hi, oo1 = (unsigned)qkv_row(pq, 1) * 128u + 8u * hi;
#pragma unroll
            for (int gg = 0; gg < 2; ++gg)
#pragma unroll
                for (int d0 = 0; d0 < 2; ++d0)
#pragma unroll
                    for (int rg = 0; rg < 4; ++rg) og[gg][d0][rg] = *(const u32x2*)(sadd(gg ? oq1 : oq0, gg ? oo1 : oo0) + (d0 * 64 + 16 * rg));
            const char* lb = (const char*)(lse + tqw * 24 + head); const unsigned lo_ = (unsigned)(r32 * u.dil) * 96u;
            lg0 = *(const float*)sadd(lb, lo_); lg1 = *(const float*)(sadd(lb, lo_) + 32);
        }
        f32x16 p[5];
        const LAS unsigned char* kb = lds + KOFF + hi * KCH + (qt * 32 + r32) * 16;
#pragma unroll
        for (int j = 0; j < 5; ++j) {
#pragma unroll
            for (int rr = 0; rr < 16; ++rr) p[j][rr] = 0.f;
#pragma unroll
            for (int d0 = 0; d0 < 4; ++d0) {
                const bf16x8 kf = *(const LAS bf16x8*)(kb + j * 512 + d0 * 2 * KCH);
                p[j] = __builtin_amdgcn_mfma_f32_32x32x16_bf16(kf, qf[d0], p[j], 0, 0, 0);
            }
        }
#pragma unroll
        for (int rr = 0; rr < 16; ++rr) { const int c = crow(rr, hi); if (c < r32) p[0][rr] = -INFINITY; if (c > r32) p[4][rr] = -INFINITY; }
        if (l0 == 0) {
#pragma unroll
            for (int j = 0; j < 5; ++j)
#pragma unroll
                for (int rr = 0; rr < 16; ++rr) if (32 * (qt + j) + crow(rr, hi) < 128) p[j][rr] = -INFINITY;
        }
        float m = p[0][0];
#pragma unroll
        for (int j = 0; j < 5; ++j)
#pragma unroll
            for (int rr = 0; rr < 16; ++rr) m = fmaxf(m, p[j][rr]);
        m = xhalf_max(m);
        float l = 0.f;
#pragma unroll
        for (int j = 0; j < 5; ++j)
#pragma unroll
            for (int rr = 0; rr < 16; ++rr) { const float e = __builtin_amdgcn_exp2f(p[j][rr] - m); p[j][rr] = e; l += e; }
        l = xhalf_sum(l);
        f32x16 o[2];
#pragma unroll
        for (int rr = 0; rr < 16; ++rr) { o[0][rr] = 0.f; o[1][rr] = 0.f; }
        const LAS unsigned char* vb = lds + VOFF + ((lane >> 4) & 1) * 32 + (lane & 3) * 8 + (4 * hi + ((lane & 15) >> 2)) * 64 + qt * 2048;
#pragma unroll
        for (int j = 0; j < 5; ++j)
#pragma unroll
            for (int s = 0; s < 2; ++s) {
                u32x4 pw; pw.x = pg8::cvt_pk_bf16(p[j][8 * s + 0], p[j][8 * s + 1]); pw.y = pg8::cvt_pk_bf16(p[j][8 * s + 2], p[j][8 * s + 3]);
                pw.z = pg8::cvt_pk_bf16(p[j][8 * s + 4], p[j][8 * s + 5]); pw.w = pg8::cvt_pk_bf16(p[j][8 * s + 6], p[j][8 * s + 7]);
                const bf16x8 pf = __builtin_bit_cast(bf16x8, pw);
#pragma unroll
                for (int d0 = 0; d0 < 2; ++d0) {
                    const s16x4 vlo = vtr(vb + d0 * VDH + (2 * j + s) * 1024), vhi = vtr(vb + d0 * VDH + (2 * j + s) * 1024 + 512);
                    const bf16x8 vf = {vlo[0], vlo[1], vlo[2], vlo[3], vhi[0], vhi[1], vhi[2], vhi[3]};
                    o[d0] = __builtin_amdgcn_mfma_f32_32x32x16_bf16(vf, pf, o[d0], 0, 0, 0);
                }
            }
        if constexpr (!MERGE) {
            const float inv = 1.0f / l;
#pragma unroll
            for (int d0 = 0; d0 < 2; ++d0)
#pragma unroll
                for (int rg = 0; rg < 4; ++rg) {
                    u32x2 w; w.x = pg8::cvt_pk_bf16(o[d0][4 * rg] * inv, o[d0][4 * rg + 1] * inv); w.y = pg8::cvt_pk_bf16(o[d0][4 * rg + 2] * inv, o[d0][4 * rg + 3] * inv);
                    if (!dry) *(u32x2*)(sadd(qrow, (unsigned)r32 * 128u + 8u * hi) + (d0 * 64 + 16 * rg)) = w; else asm volatile("" :: "v"(w.x), "v"(w.y));
                }
            if (hi == 0 && !dry) *(float*)((char*)(lse + tqw * 24 + g * 8 + head) + (unsigned)(r32 * u.dil) * 96u) = m + __builtin_amdgcn_logf(l);
        } else {
            const float lg2 = m + __builtin_amdgcn_logf(l), mx = fmaxf(lg2, fmaxf(lg0, lg1));
            const float w0 = __builtin_amdgcn_exp2f(lg0 - mx), w1 = __builtin_amdgcn_exp2f(lg1 - mx), w2 = __builtin_amdgcn_exp2f(lg2 - mx);
            const float iw = 1.0f / (w0 + w1 + w2), c0 = w0 * iw, c1 = w1 * iw, c2 = w2 * iw / l;
            char* orow = (char*)(ob + tqw * 512 + head * 64); const unsigned oro = (unsigned)(r32 * u.dil) * 1024u + 8u * hi;
#pragma unroll
            for (int d0 = 0; d0 < 2; ++d0)
#pragma unroll
                for (int rg = 0; rg < 4; ++rg) {
                    const u32x2 a = og[0][d0][rg], b = og[1][d0][rg];
                    u32x2 w; w.x = pg8::cvt_pk_bf16(c0 * bflo(a.x) + c1 * bflo(b.x) + c2 * o[d0][4 * rg], c0 * bfhi(a.x) + c1 * bfhi(b.x) + c2 * o[d0][4 * rg + 1]);
                    w.y = pg8::cvt_pk_bf16(c0 * bflo(a.y) + c1 * bflo(b.y) + c2 * o[d0][4 * rg + 2], c0 * bfhi(a.y) + c1 * bfhi(b.y) + c2 * o[d0][4 * rg + 3]);
                    if (!dry) *(u32x2*)(sadd(orow, oro) + (d0 * 64 + 16 * rg)) = w; else asm volatile("" :: "v"(w.x), "v"(w.y));
                }
        }
        __syncthreads();
    }
}
}

typedef const __attribute__((address_space(4))) unsigned long long* kargp_t;
__device__ __forceinline__ kargp_t karg() { kargp_t p = (kargp_t)__builtin_amdgcn_kernarg_segment_ptr(); asm volatile("" : "+s"(p)); return p; }
#define KIN(i) ((const float*)(GAS const float*)karg()[i])
#define KOUT() ((float*)(GAS float*)karg()[19])
#define KWS() ((unsigned char*)(GAS unsigned char*)karg()[20])
#define WSP(type, off) ((type*)(KWS() + (off)))
struct Args { const float* in[19]; float* out; unsigned char* ws; int ph_lo, ph_hi; };
constexpr int NPHASE = 17;

__global__ void __launch_bounds__(NWAVES * 64, 2) mk_fwd(Args args) {
    extern __shared__ __attribute__((aligned(16))) unsigned char lds_raw[];
    LAS unsigned char* lds = (LAS unsigned char*)lds_raw;
    volatile LAS unsigned* MISC = (volatile LAS unsigned*)(lds + MISC_OFF);
    LAS int* rb = (LAS int*)(lds + MISC_OFF);
    const int wave = __builtin_amdgcn_readfirstlane((int)threadIdx.x >> 6);
#define IDS() const int lane = lane_id(), tid = wave * 64 + lane; (void)tid; (void)lane
    const int G = gridDim.x, bid = blockIdx.x;
    for (int u = threadIdx.x; u < (LDS_BYTES - MISC_OFF) / 4; u += NWAVES * 64) MISC[u] = 0u;
    __syncthreads();
#if MK_ONE_LAUNCH
    XcdBarrier bar = xcd_barrier_post((unsigned*)(KWS() + WS_CTL) + CW_BAR, MISC + 40, wave);
#define GRID_BAR() xcd_barrier(bar, wave)
#else
#define GRID_BAR() do { } while (0)
#endif
#if MK_ONE_LAUNCH
    constexpr int lo = 0, hi = NPHASE; (void)args;
#else
    const int lo = args.ph_lo, hi = args.ph_hi;
#endif
#ifndef PHMASK
#define PHMASK 0xFFFFFFFFu
#endif
#define IN(k) ((((PHMASK) >> (k)) & 1u) && lo <= (k) && (k) < hi)
#ifndef REPMASK
#define REPMASK 0u
#endif
#define REPS(k) ((((REPMASK) >> (k)) & 1u) ? 2 : 1)
#define SEAM(k) do { if (IN(k) && IN((k) + 1)) GRID_BAR(); } while (0)

    for (int rep_ = 0; rep_ < REPS(0); ++rep_) if (IN(0)) { IDS();
        const float* cin = KIN(1); const float* ada_w = KIN(4); const float* ada_b = KIN(5); float* mod = WSP(float, WS_MOD); float* rope = WSP(float, WS_ROPE);
        LAS float* cact = (LAS float*)lds; LAS float* red = cact + 16384;
        if (bid < 192) for (int i = tid; i < 16 * 1024; i += 512) { const float v = cin[i]; cact[i] = v / (1.f + expf(-v)); }
        __syncthreads();
        for (int item = bid; item < 192; item += G) {
            const int l = item / 96, n0 = (item % 96) * 64, kk = lane >> 4, n4 = lane & 15;
            f32x4 acc[16];
#pragma unroll
            for (int b = 0; b < 16; ++b) acc[b] = (f32x4){0.f, 0.f, 0.f, 0.f};
            const float* w = ada_w + (size_t)l * 1024 * 6144 + n0 + n4 * 4;
#pragma unroll 1
            for (int kb = 0; kb < 2; ++kb) {
                const int k0 = wave * 128 + kb * 64 + kk;
                f32x4 wv[16];
#pragma unroll
                for (int u = 0; u < 16; ++u) wv[u] = *(const f32x4*)(w + (size_t)(k0 + 4 * u) * 6144);
#pragma unroll
                for (int u = 0; u < 16; ++u)
#pragma unroll
                    for (int b = 0; b < 16; ++b) acc[b] += wv[u] * cact[b * 1024 + k0 + 4 * u];
            }
            const bool h5 = (lane & 32) != 0;
#pragma unroll
            for (int b = 0; b < 16; ++b)
#pragma unroll
                for (int c = 0; c < 4; ++c) { float v = acc[b][c]; v += xlane<16>(v); v += xlane32(v, h5); acc[b][c] = v; }
            if (lane < 16) {
#pragma unroll
                for (int b = 0; b < 16; ++b) *(LAS f32x4*)(red + (wave * 16 + b) * 64 + n4 * 4) = acc[b];
            }
            __syncthreads();
            for (int i = tid; i < 1024; i += 512) {
                const int b = i >> 6, nn = i & 63; float s = 0.f;
#pragma unroll
                for (int q = 0; q < 8; ++q) s += red[(q * 16 + b) * 64 + nn];
                mod[((size_t)l * 16 + b) * 6144 + n0 + nn] = s + ada_b[l * 6144 + n0 + nn];
            }
            __syncthreads();
        }
        for (int i = bid * 512 + tid; i < 4096 * 8; i += G * 512) {
            const int t = i >> 3, f = i & 7;
            const float inv = powf(500000.0f, -(float)(2 * f) / 16.0f);
            const float ang = (float)t * inv;
            rope[i] = (float)cos((double)ang);
            rope[4096 * 8 + i] = (float)sin((double)ang);
        }
    }
    SEAM(0);
    for (int rep_ = 0; rep_ < REPS(1); ++rep_) if (IN(1)) { IDS();
        {
        LAS float* scr = (LAS float*)(lds + wave * 16640);
        const float* conv_in_w = KIN(6); const float* conv_out_w = KIN(8); const float* attn_in_w = KIN(9); const float* attn_out_w = KIN(10);
        const float* gate_w = KIN(15); const float* up_w = KIN(16); const float* down_w = KIN(17);
        bf16_t* WZ = WSP(bf16_t, WS_WZ); bf16_t* WB = WSP(bf16_t, WS_WB); bf16_t* WCO = WSP(bf16_t, WS_WCO); bf16_t* WAI = WSP(bf16_t, WS_WAI); bf16_t* WAO = WSP(bf16_t, WS_WAO);
        bf16_t* WGU = WSP(bf16_t, WS_WGU); bf16_t* WDN = WSP(bf16_t, WS_WDN);
#define CONV_DECODE(DD, IT) do { int it = (IT); \
            if (it < 512) { conv_desc(DD, conv_in_w, 3072, 1024, WZ, 1024, 1, it / 32, it % 32); break; } it -= 512; \
            if (it < 256) { conv_desc(DD, conv_in_w, 3072, 0, WB, 1024, 0, it / 16, it % 16); break; } it -= 256; \
            if (it < 256) { conv_desc(DD, conv_out_w, 1024, 0, WCO, 1024, 0, it / 16, it % 16); break; } it -= 256; \
            if (it < 1152) { conv_desc(DD, attn_in_w, QKVW, 0, WAI, 1024, 2, it / 72, it % 72); break; } it -= 1152; \
            if (it < 128) { conv_desc(DD, attn_out_w, 1024, 0, WAO, 512, 0, it / 16, it % 16); break; } it -= 128; \
            const int le = it / 384, r = it % 384; \
            if (r < 128) conv_desc(DD, gate_w + (size_t)le * D * DEXP, DEXP, 0, WGU + (size_t)le * 1024 * 1024, 1024, 3, r / 8, r % 8); \
            else if (r < 256) conv_desc(DD, up_w + (size_t)le * D * DEXP, DEXP, 0, WGU + (size_t)le * 1024 * 1024, 1024, 4, (r - 128) / 8, (r - 128) % 8); \
            else conv_desc(DD, down_w + (size_t)le * DEXP * D, D, 0, WDN + (size_t)le * 1024 * 512, 512, 0, (r - 256) / 16, (r - 256) % 16); } while (0)
        {
            const int step = G * NWAVES; int it0 = bid * NWAVES + wave;
            ConvDesc dA, dB; f32x4 vA[16], vB[16];
            if (it0 < NCONV_ITEMS) { CONV_DECODE(dA, it0); conv_load(vA, dA, lane); }
#pragma unroll 1
            for (; it0 < NCONV_ITEMS; it0 += 2 * step) {
                const bool hasB = it0 + step < NCONV_ITEMS, hasA2 = it0 + 2 * step < NCONV_ITEMS;
                if (hasB) { CONV_DECODE(dB, it0 + step); conv_load(vB, dB, lane); }
                conv_process(vA, dA, scr, lane);
                if (hasA2) { CONV_DECODE(dA, it0 + 2 * step); conv_load(vA, dA, lane); }
                if (hasB) conv_process(vB, dB, scr, lane);
            }
        }
#undef CONV_DECODE
        }
        const float* x = KIN(0); const float* norm_mix_g = KIN(2); const float* mod = WSP(float, WS_MOD); bf16_t* xn = WSP(bf16_t, WS_XN);
        for (int w0 = (bid * 8 + wave) * 32; w0 < T; w0 += G * 8 * 32) {
            const float* mb = mod + (size_t)(w0 >> 12) * 6144;
            ModV mv; mod_load(mv, norm_mix_g, mb + 0, mb + 1024, lane);
            RowV ring[4];
#pragma unroll
            for (int d = 0; d < 4; ++d) row_load(ring[d], x + (size_t)(w0 + d) * D, lane);
#pragma unroll 1
            for (int i = 0; i < 32; i += 4) {
#pragma unroll
                for (int d = 0; d < 4; ++d) {
                    const int row = w0 + i + d;
                    RowV r = ring[d];
                    if (i < 28) row_load(ring[d], x + (size_t)(row + 4) * D, lane);
                    const float rstd = row_rstd(r);
                    row_apply(r, rstd, mv);
                    row_store_bf16(r, xn + (size_t)row * D, lane);
                }
            }
        }
    }
    SEAM(1);
    for (int rep_ = 0; rep_ < REPS(2); ++rep_) if (IN(2)) { bf16_t* xn = WSP(bf16_t, WS_XN); bf16_t* WZ = WSP(bf16_t, WS_WZ); bf16_t* zb = WSP(bf16_t, WS_Z);
        pg8::Gemm g{xn, WZ, T, 2048, 1024}; pg8::StaticOrder S; S.init(T, 2048, G, bid); pg8::EpiPair<false> E{zb, D};
        pg8::gemm_phase<pg8::EpiPair<false>, pg8::StaticOrder, pg8::APlain, true, true>(lds, g, S, E, pg8::APlain{}, wave); }
    SEAM(2);
    for (int rep_ = 0; rep_ < REPS(3); ++rep_) if (IN(3)) { bf16_t* xn = WSP(bf16_t, WS_XN); bf16_t* WB = WSP(bf16_t, WS_WB); bf16_t* zb = WSP(bf16_t, WS_Z); bf16_t* ypre = WSP(bf16_t, WS_YPRE); const float* conv_w = KIN(7);
        pg8::Gemm g{xn, WB, T, 1024, 1024}; pg8::StaticOrder S; S.init(T, 1024, G, bid); pg8::EpiYpre E{ypre, zb, conv_w};
        pg8::gemm_phase<pg8::EpiYpre, pg8::StaticOrder, pg8::APlain, true, true>(lds, g, S, E, pg8::APlain{}, wave); }
    SEAM(3);
    for (int rep_ = 0; rep_ < REPS(4); ++rep_) if (IN(4)) { bf16_t* ypre = WSP(bf16_t, WS_YPRE); bf16_t* WCO = WSP(bf16_t, WS_WCO); bf16_t* xr = (bf16_t*)KOUT(); const float* x = KIN(0); const float* mod = WSP(float, WS_MOD);
        pg8::Gemm g{ypre, WCO, T, 1024, 1024}; pg8::StaticOrder S; S.init(T, 1024, G, bid); pg8::EpiRes<true> E{xr, x, mod + 2048};
        pg8::gemm_phase<pg8::EpiRes<true>, pg8::StaticOrder, pg8::APlain, true, true>(lds, g, S, E, pg8::APlain{}, wave); }
    SEAM(4);
    { constexpr int l = 0;
        const int pb0 = (l == 0) ? 5 : 13;
#define MODL() (WSP(float, WS_MOD) + (size_t)l * 16 * 6144)
#define CNTL() (WSP(int, WS_CTL) + 64 * l)
        if (l == 1) {
#ifdef STAGGER9
            if (IN(9)) { const unsigned long long t0_ = __builtin_amdgcn_s_memrealtime(); const unsigned long long dl_ = (unsigned long long)(((bid >> 3) & 31) * STAGGER9 / 32);
                while (__builtin_amdgcn_s_memrealtime() - t0_ < dl_) __builtin_amdgcn_s_sleep(16); }
#endif
            for (int rep_ = 0; rep_ < REPS(9); ++rep_) if (IN(9)) { bf16_t* xn = WSP(bf16_t, WS_XN); bf16_t* WAI = WSP(bf16_t, WS_WAI); bf16_t* qkv = WSP(bf16_t, WS_QKV); const float* rope = WSP(float, WS_ROPE);
                pg8::Gemm g{xn, WAI, T, QKVW, 1024}; pg8::StaticOrder S; S.init(T, QKVW, G, bid); pg8::EpiQKV E{qkv, rope, 0};
                pg8::gemm_phase<pg8::EpiQKV, pg8::StaticOrder, pg8::APlain, true, true>(lds, g, S, E, pg8::APlain{}, wave); }
            SEAM(9);
            if (IN(10)) att::attn_phase<false>(lds, WSP(bf16_t, WS_QKV), WSP(float, WS_LSE), WSP(bf16_t, WS_XN), bid, G, wave);
            SEAM(10);
            if (IN(11)) att::attn_phase<true>(lds, WSP(bf16_t, WS_QKV), WSP(float, WS_LSE), WSP(bf16_t, WS_XN), bid, G, wave);
            SEAM(11);
            if (IN(12)) { bf16_t* ob = WSP(bf16_t, WS_XN); bf16_t* WAO = WSP(bf16_t, WS_WAO); bf16_t* xr = (bf16_t*)KOUT();
                pg8::Gemm g{ob, WAO, T, 1024, 512}; pg8::StaticOrder S; S.init(T, 1024, G, bid); pg8::EpiRes<false> E{xr, nullptr, MODL() + 2048};
                pg8::gemm_phase<pg8::EpiRes<false>, pg8::StaticOrder, pg8::APlain, true, true>(lds, g, S, E, pg8::APlain{}, wave); }
            SEAM(12);
        }
        for (int rep_ = 0; rep_ < REPS(5); ++rep_) if (IN(pb0)) { IDS(); const bool dry = rep_ + 1 < REPS(5);
            LAS f32x4* TG = (LAS f32x4*)lds; LAS f32x4* TE = (LAS f32x4*)(lds + 16384);
            LAS int* rec_e = (LAS int*)(lds + 147456); LAS float* rec_w = (LAS float*)(lds + 147456 + 2048); LAS int* rec_rank = (LAS int*)(lds + 147456 + 4096);
            LAS int* hist = (LAS int*)(lds + 147456 + 6144); LAS int* base = (LAS int*)(lds + 147456 + 6144 + 128);
            const float* gff = KIN(3) + l * D; const float* wg = KIN(11) + (size_t)l * D * 4; const float* bg = KIN(12) + l * 4; const float* we = KIN(13) + (size_t)l * 4 * D * 8; const float* be = KIN(14) + l * 32;
            const bf16_t* xr = (const bf16_t*)KOUT(); const float* modl = MODL(); int* cntl = CNTL(); bf16_t* xn = WSP(bf16_t, WS_XN); int* ltok = WSP(int, WS_LTOK); float* lw = WSP(float, WS_LW); int* tslot = WSP(int, WS_TSLOT);
            for (int i = tid; i < 1024; i += 512) { const int ln = i & 63, jc = i >> 6, k = 4 * ln + 256 * (jc >> 2) + (jc & 3); TG[i] = *(const f32x4*)(wg + (size_t)k * 4); }
            for (int i = tid; i < 8192; i += 512) { const int ln = i & 63, jc = (i >> 6) & 15, half = (i >> 10) & 1, gi = i >> 11, k = 4 * ln + 256 * (jc >> 2) + (jc & 3);
                TE[i] = *(const f32x4*)(we + ((size_t)gi * 1024 + k) * 8 + half * 4); }
            __syncthreads();
            const bool h5 = (lane & 32) != 0, h4 = (lane & 16) != 0, h3 = (lane & 8) != 0;
            for (int blk = bid; blk < T / 256; blk += G) {
                if (tid < 32) hist[tid] = 0;
                __syncthreads();
                ModV mv; { const float* mb = modl + (size_t)((blk * 256) >> 12) * 6144; mod_load(mv, gff, mb + 3072, mb + 4096, lane); }
                u32x2 ring[4][4];
#pragma unroll
                for (int d = 0; d < 4; ++d)
#pragma unroll
                    for (int j = 0; j < 4; ++j) ring[d][j] = *(const u32x2*)(xr + (size_t)(blk * 256 + wave * 32 + d) * XRP + 4 * lane + 256 * j);
#pragma unroll 1
                for (int i4 = 0; i4 < 32; i4 += 4)
#pragma unroll
                for (int d = 0; d < 4; ++d) {
                    const int i = i4 + d, rl = wave * 32 + i, row = blk * 256 + rl;
                    RowV r;
#pragma unroll
                    for (int j = 0; j < 4; ++j) { const u32x2 w = ring[d][j]; r.v[j] = (f32x4){bflo(w.x), bfhi(w.x), bflo(w.y), bfhi(w.y)}; }
                    if (i4 < 28) {
#pragma unroll
                        for (int j = 0; j < 4; ++j) ring[d][j] = *(const u32x2*)(xr + (size_t)(row + 4) * XRP + 4 * lane + 256 * j); }
                    const float rstd = row_rstd(r);
                    row_apply(r, rstd, mv);
                    row_store_bf16(r, xn + (size_t)row * D, lane);
                    f32x4 pg = {0.f, 0.f, 0.f, 0.f};
#pragma unroll
                    for (int jc = 0; jc < 16; ++jc) pg += TG[jc * 64 + lane] * r.v[jc >> 2][jc & 3];
                    float gl[4];
                    { float b0 = (h5 ? pg.z : pg.x) + xlane32(h5 ? pg.x : pg.z, h5), b1 = (h5 ? pg.w : pg.y) + xlane32(h5 ? pg.y : pg.w, h5);
                      float c = (h4 ? b1 : b0) + xlane<16>(h4 ? b0 : b1);
                      c += xlane<8>(c); c += xlane<4>(c); c += xlane<2>(c); c += xlane<1>(c);
#pragma unroll
                      for (int o = 0; o < 4; ++o) gl[o] = __int_as_float(__builtin_amdgcn_readlane(__float_as_int(c), 16 * o)) + bg[o]; }
                    int gi = 0; float gm = gl[0];
#pragma unroll
                    for (int o = 1; o < 4; ++o) if (gl[o] > gm) { gm = gl[o]; gi = o; }
                    float gden = 0.f;
#pragma unroll
                    for (int o = 0; o < 4; ++o) gden += __builtin_amdgcn_exp2f((gl[o] - gm) * 1.4426950408889634f);
                    const float grp_p = __builtin_amdgcn_rcpf(gden);
                    f32x4 pa = {0.f, 0.f, 0.f, 0.f}, pb = {0.f, 0.f, 0.f, 0.f};
                    const LAS f32x4* te = TE + gi * 2048 + lane;
#pragma unroll
                    for (int jc = 0; jc < 16; ++jc) { const float hv = r.v[jc >> 2][jc & 3]; pa += te[jc * 64] * hv; pb += te[1024 + jc * 64] * hv; }
                    float el[8];
                    { const f32x4 keep = h5 ? pb : pa, send = h5 ? pa : pb;
                      f32x4 q; q.x = keep.x + xlane32(send.x, h5); q.y = keep.y + xlane32(send.y, h5); q.z = keep.z + xlane32(send.z, h5); q.w = keep.w + xlane32(send.w, h5);
                      const float b0 = (h4 ? q.z : q.x) + xlane<16>(h4 ? q.x : q.z), b1 = (h4 ? q.w : q.y) + xlane<16>(h4 ? q.y : q.w);
                      float c = (h3 ? b1 : b0) + xlane<8>(h3 ? b0 : b1);
                      c += xlane<4>(c); c += xlane<2>(c); c += xlane<1>(c);
#pragma unroll
                      for (int o = 0; o < 8; ++o) el[o] = __int_as_float(__builtin_amdgcn_readlane(__float_as_int(c), 8 * o)) + be[gi * 8 + o]; }
                    int i0 = 0; float m0 = el[0];
#pragma unroll
                    for (int o = 1; o < 8; ++o) if (el[o] > m0) { m0 = el[o]; i0 = o; }
                    int i1 = -1; float m1 = -INFINITY;
#pragma unroll
                    for (int o = 0; o < 8; ++o) if (o != i0 && el[o] > m1) { m1 = el[o]; i1 = o; }
                    const float p1 = __builtin_amdgcn_exp2f((m1 - m0) * 1.4426950408889634f), w0_ = grp_p * __builtin_amdgcn_rcpf(1.0f + p1);
                    if (lane == 0) { rec_e[rl * 2] = gi * 8 + i0; rec_e[rl * 2 + 1] = gi * 8 + i1; rec_w[rl * 2] = w0_; rec_w[rl * 2 + 1] = w0_ * p1; }
                }
                __syncthreads();
                { const int e = rec_e[tid]; rec_rank[tid] = atomicAdd((int*)&hist[e], 1); }
                __syncthreads();
                if (tid < 32) { const int h = hist[tid]; base[tid] = (h && !dry) ? atomicAdd(&cntl[tid], h) : 0; }
                __syncthreads();
                { const int e = rec_e[tid], pos = base[e] + rec_rank[tid], tok = blk * 256 + (tid >> 1);
                  if (!dry) { ltok[(size_t)e * LISTCAP + pos] = tok; lw[(size_t)e * LISTCAP + pos] = rec_w[tid]; tslot[tok * 2 + (tid & 1)] = (e << 16) | pos; } }
                __syncthreads();
            }
        }
        SEAM(pb0);
        if (IN(pb0 + 1) || IN(pb0 + 2) || IN(pb0 + 3)) {
            __syncthreads();
            if (wave == 0 && lane_id() == 0) { const int* cntl = CNTL(); int s = 0;
#pragma unroll 1
                for (int e = 0; e < 32; ++e) { rb[e] = s; s += (__hip_atomic_load(&cntl[e], RLX_AGENT) + 255) & ~255; }
                rb[32] = s; }
            __syncthreads();
        }
        for (int rep_ = 0; rep_ < REPS(6); ++rep_) if (IN(pb0 + 1)) { bf16_t* xn = WSP(bf16_t, WS_XN); bf16_t* WGU = WSP(bf16_t, WS_WGU); bf16_t* act = WSP(bf16_t, WS_ACT); const int* ltok = WSP(int, WS_LTOK); const int* cntl = CNTL();
            pg8::Gemm g{xn, WGU + (size_t)l * 32 * 1024 * 1024, 0, 0, 1024}; pg8::MoeOrder S; S.init(rb[32] / 256, G, bid, rb); pg8::EpiPair<true> E{act, DEXP}; pg8::AGather am{ltok, cntl, rb};
            pg8::gemm_phase<pg8::EpiPair<true>, pg8::MoeOrder, pg8::AGather, true, true>(lds, g, S, E, am, wave); }
        SEAM(pb0 + 1);
        for (int rep_ = 0; rep_ < REPS(7); ++rep_) if (IN(pb0 + 2)) { bf16_t* act = WSP(bf16_t, WS_ACT); bf16_t* WDN = WSP(bf16_t, WS_WDN); bf16_t* yw = WSP(bf16_t, WS_YW); const float* lw = WSP(float, WS_LW);
            pg8::Gemm g{act, WDN + (size_t)l * 32 * 1024 * 512, 0, 0, 512}; pg8::MoeOrder S; S.init(rb[32] / 256, G, bid, rb); pg8::EpiDown E{yw, lw, rb};
            pg8::gemm_phase<pg8::EpiDown, pg8::MoeOrder, pg8::APlain, true, true>(lds, g, S, E, pg8::APlain{}, wave); }
        SEAM(pb0 + 2);
        for (int rep_ = 0; rep_ < REPS(8); ++rep_) if (IN(pb0 + 3)) { IDS(); const bool dry = rep_ + 1 < REPS(8);
            const float* gnext = (l == 0) ? KIN(2) + D : KIN(18);
            const float* modn = WSP(float, WS_MOD) + (size_t)16 * 6144; const float* modl = MODL();
            float* outf = KOUT(); bf16_t* xr = (bf16_t*)KOUT(); const bf16_t* yw = WSP(bf16_t, WS_YW); const int* tslot = WSP(int, WS_TSLOT); bf16_t* xn = WSP(bf16_t, WS_XN);
            for (int w0 = (bid * 8 + wave) * 32; w0 < T; w0 += G * 8 * 32) {
                const int b = w0 >> 12;
                f32x4 g2v[4];
#pragma unroll
                for (int j = 0; j < 4; ++j) g2v[j] = *(const f32x4*)(modl + (size_t)b * 6144 + 5120 + 4 * lane + 256 * j);
                ModV mv;
                if (l == 0) { const float* mb = modn + (size_t)b * 6144; mod_load(mv, gnext, mb + 0, mb + 1024, lane); }
                else {
#pragma unroll
                    for (int j = 0; j < 4; ++j) { mv.gp[j] = *(const f32x4*)(gnext + 4 * lane + 256 * j); mv.sh[j] = (f32x4){0.f, 0.f, 0.f, 0.f}; }
                }
                const int slw = tslot[(size_t)w0 * 2 + lane];
                u32x2 xb[4][4], ya[4][4], yb[4][4];
#define R2_LOAD(D_, I_) do { const int s0_ = __builtin_amdgcn_readlane(slw, 2 * (I_)), s1_ = __builtin_amdgcn_readlane(slw, 2 * (I_) + 1); \
                    const size_t r0_ = (size_t)(rb[s0_ >> 16] + (s0_ & 0xffff)), r1_ = (size_t)(rb[s1_ >> 16] + (s1_ & 0xffff)); \
                    _Pragma("unroll") for (int j = 0; j < 4; ++j) { xb[D_][j] = *(const u32x2*)(xr + (size_t)(w0 + (I_)) * XRP + 4 * lane + 256 * j); \
                        ya[D_][j] = ntload((const u32x2*)(yw + r0_ * D + 4 * lane + 256 * j)); yb[D_][j] = ntload((const u32x2*)(yw + r1_ * D + 4 * lane + 256 * j)); } } while (0)
#pragma unroll
                for (int d = 0; d < 4; ++d) R2_LOAD(d, d);
#pragma unroll 1
                for (int i4 = 0; i4 < 32; i4 += 4)
#pragma unroll
                for (int d = 0; d < 4; ++d) {
                    const int i = i4 + d, row = w0 + i;
                    RowV r;
#pragma unroll
                    for (int j = 0; j < 4; ++j) {
                        const u32x2 xw = xb[d][j], a = ya[d][j], c = yb[d][j];
                        f32x4 y; y.x = bflo(a.x) + bflo(c.x); y.y = bfhi(a.x) + bfhi(c.x); y.z = bflo(a.y) + bflo(c.y); y.w = bfhi(a.y) + bfhi(c.y);
                        r.v[j] = (f32x4){bflo(xw.x), bfhi(xw.x), bflo(xw.y), bfhi(xw.y)} + g2v[j] * y;
                    }
                    if (i4 < 28) R2_LOAD(d, i + 4);
                    const float rstd = row_rstd(r);
                    if (dry) { asm volatile("" :: "v"(rstd), "v"(r.v[0].x), "v"(r.v[1].y), "v"(r.v[2].z), "v"(r.v[3].w)); }
                    else if (l == 1) { row_apply(r, rstd, mv); row_store_f32(r, outf + (size_t)row * D, lane); }
                    else { row_store_bf16(r, xr + (size_t)row * XRP, lane); row_apply(r, rstd, mv); row_store_bf16(r, xn + (size_t)row * D, lane); }
                }
#undef R2_LOAD
            }
        }
        SEAM(pb0 + 3);
    }
    { constexpr int l = 1;
        const int pb0 = (l == 0) ? 5 : 13;
#define MODL() (WSP(float, WS_MOD) + (size_t)l * 16 * 6144)
#define CNTL() (WSP(int, WS_CTL) + 64 * l)
        if (l == 1) {
#ifdef STAGGER9
            if (IN(9)) { const unsigned long long t0_ = __builtin_amdgcn_s_memrealtime(); const unsigned long long dl_ = (unsigned long long)(((bid >> 3) & 31) * STAGGER9 / 32);
                while (__builtin_amdgcn_s_memrealtime() - t0_ < dl_) __builtin_amdgcn_s_sleep(16); }
#endif
            for (int rep_ = 0; rep_ < REPS(9); ++rep_) if (IN(9)) { bf16_t* xn = WSP(bf16_t, WS_XN); bf16_t* WAI = WSP(bf16_t, WS_WAI); bf16_t* qkv = WSP(bf16_t, WS_QKV); const float* rope = WSP(float, WS_ROPE);
                pg8::Gemm g{xn, WAI, T, QKVW, 1024}; pg8::StaticOrder S; S.init(T, QKVW, G, bid); pg8::EpiQKV E{qkv, rope, 0};
                pg8::gemm_phase<pg8::EpiQKV, pg8::StaticOrder, pg8::APlain, true, true>(lds, g, S, E, pg8::APlain{}, wave); }
            SEAM(9);
            if (IN(10)) att::attn_phase<false>(lds, WSP(bf16_t, WS_QKV), WSP(float, WS_LSE), WSP(bf16_t, WS_XN), bid, G, wave);
            SEAM(10);
            if (IN(11)) att::attn_phase<true>(lds, WSP(bf16_t, WS_QKV), WSP(float, WS_LSE), WSP(bf16_t, WS_XN), bid, G, wave);
            SEAM(11);
            if (IN(12)) { bf16_t* ob = WSP(bf16_t, WS_XN); bf16_t* WAO = WSP(bf16_t, WS_WAO); bf16_t* xr = (bf16_t*)KOUT();
                pg8::Gemm g{ob, WAO, T, 1024, 512}; pg8::StaticOrder S; S.init(T, 1024, G, bid); pg8::EpiRes<false> E{xr, nullptr, MODL() + 2048};
                pg8::gemm_phase<pg8::EpiRes<false>, pg8::StaticOrder, pg8::APlain, true, true>(lds, g, S, E, pg8::APlain{}, wave); }
            SEAM(12);
        }
        for (int rep_ = 0; rep_ < REPS(5); ++rep_) if (IN(pb0)) { IDS(); const bool dry = rep_ + 1 < REPS(5);
            LAS f32x4* TG = (LAS f32x4*)lds; LAS f32x4* TE = (LAS f32x4*)(lds + 16384);
            LAS int* rec_e = (LAS int*)(lds + 147456); LAS float* rec_w = (LAS float*)(lds + 147456 + 2048); LAS int* rec_rank = (LAS int*)(lds + 147456 + 4096);
            LAS int* hist = (LAS int*)(lds + 147456 + 6144); LAS int* base = (LAS int*)(lds + 147456 + 6144 + 128);
            const float* gff = KIN(3) + l * D; const float* wg = KIN(11) + (size_t)l * D * 4; const float* bg = KIN(12) + l * 4; const float* we = KIN(13) + (size_t)l * 4 * D * 8; const float* be = KIN(14) + l * 32;
            const bf16_t* xr = (const bf16_t*)KOUT(); const float* modl = MODL(); int* cntl = CNTL(); bf16_t* xn = WSP(bf16_t, WS_XN); int* ltok = WSP(int, WS_LTOK); float* lw = WSP(float, WS_LW); int* tslot = WSP(int, WS_TSLOT);
            for (int i = tid; i < 1024; i += 512) { const int ln = i & 63, jc = i >> 6, k = 4 * ln + 256 * (jc >> 2) + (jc & 3); TG[i] = *(const f32x4*)(wg + (size_t)k * 4); }
            for (int i = tid; i < 8192; i += 512) { const int ln = i & 63, jc = (i >> 6) & 15, half = (i >> 10) & 1, gi = i >> 11, k = 4 * ln + 256 * (jc >> 2) + (jc & 3);
                TE[i] = *(const f32x4*)(we + ((size_t)gi * 1024 + k) * 8 + half * 4); }
            __syncthreads();
            const bool h5 = (lane & 32) != 0, h4 = (lane & 16) != 0, h3 = (lane & 8) != 0;
            for (int blk = bid; blk < T / 256; blk += G) {
                if (tid < 32) hist[tid] = 0;
                __syncthreads();
                ModV mv; { const float* mb = modl + (size_t)((blk * 256) >> 12) * 6144; mod_load(mv, gff, mb + 3072, mb + 4096, lane); }
                u32x2 ring[4][4];
#pragma unroll
                for (int d = 0; d < 4; ++d)
#pragma unroll
                    for (int j = 0; j < 4; ++j) ring[d][j] = *(const u32x2*)(xr + (size_t)(blk * 256 + wave * 32 + d) * XRP + 4 * lane + 256 * j);
#pragma unroll 1
                for (int i4 = 0; i4 < 32; i4 += 4)
#pragma unroll
                for (int d = 0; d < 4; ++d) {
                    const int i = i4 + d, rl = wave * 32 + i, row = blk * 256 + rl;
                    RowV r;
#pragma unroll
                    for (int j = 0; j < 4; ++j) { const u32x2 w = ring[d][j]; r.v[j] = (f32x4){bflo(w.x), bfhi(w.x), bflo(w.y), bfhi(w.y)}; }
                    if (i4 < 28) {
#pragma unroll
                        for (int j = 0; j < 4; ++j) ring[d][j] = *(const u32x2*)(xr + (size_t)(row + 4) * XRP + 4 * lane + 256 * j); }
                    const float rstd = row_rstd(r);
                    row_apply(r, rstd, mv);
                    row_store_bf16(r, xn + (size_t)row * D, lane);
                    f32x4 pg = {0.f, 0.f, 0.f, 0.f};
#pragma unroll
                    for (int jc = 0; jc < 16; ++jc) pg += TG[jc * 64 + lane] * r.v[jc >> 2][jc & 3];
                    float gl[4];
                    { float b0 = (h5 ? pg.z : pg.x) + xlane32(h5 ? pg.x : pg.z, h5), b1 = (h5 ? pg.w : pg.y) + xlane32(h5 ? pg.y : pg.w, h5);
                      float c = (h4 ? b1 : b0) + xlane<16>(h4 ? b0 : b1);
                      c += xlane<8>(c); c += xlane<4>(c); c += xlane<2>(c); c += xlane<1>(c);
#pragma unroll
                      for (int o = 0; o < 4; ++o) gl[o] = __int_as_float(__builtin_amdgcn_readlane(__float_as_int(c), 16 * o)) + bg[o]; }
                    int gi = 0; float gm = gl[0];
#pragma unroll
                    for (int o = 1; o < 4; ++o) if (gl[o] > gm) { gm = gl[o]; gi = o; }
                    float gden = 0.f;
#pragma unroll
                    for (int o = 0; o < 4; ++o) gden += __builtin_amdgcn_exp2f((gl[o] - gm) * 1.4426950408889634f);
                    const float grp_p = __builtin_amdgcn_rcpf(gden);
                    f32x4 pa = {0.f, 0.f, 0.f, 0.f}, pb = {0.f, 0.f, 0.f, 0.f};
                    const LAS f32x4* te = TE + gi * 2048 + lane;
#pragma unroll
                    for (int jc = 0; jc < 16; ++jc) { const float hv = r.v[jc >> 2][jc & 3]; pa += te[jc * 64] * hv; pb += te[1024 + jc * 64] * hv; }
                    float el[8];
                    { const f32x4 keep = h5 ? pb : pa, send = h5 ? pa : pb;
                      f32x4 q; q.x = keep.x + xlane32(send.x, h5); q.y = keep.y + xlane32(send.y, h5); q.z = keep.z + xlane32(send.z, h5); q.w = keep.w + xlane32(send.w, h5);
                      const float b0 = (h4 ? q.z : q.x) + xlane<16>(h4 ? q.x : q.z), b1 = (h4 ? q.w : q.y) + xlane<16>(h4 ? q.y : q.w);
                      float c = (h3 ? b1 : b0) + xlane<8>(h3 ? b0 : b1);
                      c += xlane<4>(c); c += xlane<2>(c); c += xlane<1>(c);
#pragma unroll
                      for (int o = 0; o < 8; ++o) el[o] = __int_as_float(__builtin_amdgcn_readlane(__float_as_int(c), 8 * o)) + be[gi * 8 + o]; }
                    int i0 = 0; float m0 = el[0];
#pragma unroll
                    for (int o = 1; o < 8; ++o) if (el[o] > m0) { m0 = el[o]; i0 = o; }
                    int i1 = -1; float m1 = -INFINITY;
#pragma unroll
                    for (int o = 0; o < 8; ++o) if (o != i0 && el[o] > m1) { m1 = el[o]; i1 = o; }
                    const float p1 = __builtin_amdgcn_exp2f((m1 - m0) * 1.4426950408889634f), w0_ = grp_p * __builtin_amdgcn_rcpf(1.0f + p1);
                    if (lane == 0) { rec_e[rl * 2] = gi * 8 + i0; rec_e[rl * 2 + 1] = gi * 8 + i1; rec_w[rl * 2] = w0_; rec_w[rl * 2 + 1] = w0_ * p1; }
                }
                __syncthreads();
                { const int e = rec_e[tid]; rec_rank[tid] = atomicAdd((int*)&hist[e], 1); }
                __syncthreads();
                if (tid < 32) { const int h = hist[tid]; base[tid] = (h && !dry) ? atomicAdd(&cntl[tid], h) : 0; }
                __syncthreads();
                { const int e = rec_e[tid], pos = base[e] + rec_rank[tid], tok = blk * 256 + (tid >> 1);
                  if (!dry) { ltok[(size_t)e * LISTCAP + pos] = tok; lw[(size_t)e * LISTCAP + pos] = rec_w[tid]; tslot[tok * 2 + (tid & 1)] = (e << 16) | pos; } }
                __syncthreads();
            }
        }
        SEAM(pb0);
        if (IN(pb0 + 1) || IN(pb0 + 2) || IN(pb0 + 3)) {
            __syncthreads();
            if (wave == 0 && lane_id() == 0) { const int* cntl = CNTL(); int s = 0;
#pragma unroll 1
                for (int e = 0; e < 32; ++e) { rb[e] = s; s += (__hip_atomic_load(&cntl[e], RLX_AGENT) + 255) & ~255; }
                rb[32] = s; }
            __syncthreads();
        }
        for (int rep_ = 0; rep_ < REPS(6); ++rep_) if (IN(pb0 + 1)) { bf16_t* xn = WSP(bf16_t, WS_XN); bf16_t* WGU = WSP(bf16_t, WS_WGU); bf16_t* act = WSP(bf16_t, WS_ACT); const int* ltok = WSP(int, WS_LTOK); const int* cntl = CNTL();
            pg8::Gemm g{xn, WGU + (size_t)l * 32 * 1024 * 1024, 0, 0, 1024}; pg8::MoeOrder S; S.init(rb[32] / 256, G, bid, rb); pg8::EpiPair<true> E{act, DEXP}; pg8::AGather am{ltok, cntl, rb};
            pg8::gemm_phase<pg8::EpiPair<true>, pg8::MoeOrder, pg8::AGather, true, true>(lds, g, S, E, am, wave); }
        SEAM(pb0 + 1);
        for (int rep_ = 0; rep_ < REPS(7); ++rep_) if (IN(pb0 + 2)) { bf16_t* act = WSP(bf16_t, WS_ACT); bf16_t* WDN = WSP(bf16_t, WS_WDN); bf16_t* yw = WSP(bf16_t, WS_YW); const float* lw = WSP(float, WS_LW);
            pg8::Gemm g{act, WDN + (size_t)l * 32 * 1024 * 512, 0, 0, 512}; pg8::MoeOrder S; S.init(rb[32] / 256, G, bid, rb); pg8::EpiDown E{yw, lw, rb};
            pg8::gemm_phase<pg8::EpiDown, pg8::MoeOrder, pg8::APlain, true, true>(lds, g, S, E, pg8::APlain{}, wave); }
        SEAM(pb0 + 2);
        for (int rep_ = 0; rep_ < REPS(8); ++rep_) if (IN(pb0 + 3)) { IDS(); const bool dry = rep_ + 1 < REPS(8);
            const float* gnext = (l == 0) ? KIN(2) + D : KIN(18);
            const float* modn = WSP(float, WS_MOD) + (size_t)16 * 6144; const float* modl = MODL();
            float* outf = KOUT(); bf16_t* xr = (bf16_t*)KOUT(); const bf16_t* yw = WSP(bf16_t, WS_YW); const int* tslot = WSP(int, WS_TSLOT); bf16_t* xn = WSP(bf16_t, WS_XN);
            for (int w0 = (bid * 8 + wave) * 32; w0 < T; w0 += G * 8 * 32) {
                const int b = w0 >> 12;
                f32x4 g2v[4];
#pragma unroll
                for (int j = 0; j < 4; ++j) g2v[j] = *(const f32x4*)(modl + (size_t)b * 6144 + 5120 + 4 * lane + 256 * j);
                ModV mv;
                if (l == 0) { const float* mb = modn + (size_t)b * 6144; mod_load(mv, gnext, mb + 0, mb + 1024, lane); }
                else {
#pragma unroll
                    for (int j = 0; j < 4; ++j) { mv.gp[j] = *(const f32x4*)(gnext + 4 * lane + 256 * j); mv.sh[j] = (f32x4){0.f, 0.f, 0.f, 0.f}; }
                }
                const int slw = tslot[(size_t)w0 * 2 + lane];
                u32x2 xb[4][4], ya[4][4], yb[4][4];
#define R2_LOAD(D_, I_) do { const int s0_ = __builtin_amdgcn_readlane(slw, 2 * (I_)), s1_ = __builtin_amdgcn_readlane(slw, 2 * (I_) + 1); \
                    const size_t r0_ = (size_t)(rb[s0_ >> 16] + (s0_ & 0xffff)), r1_ = (size_t)(rb[s1_ >> 16] + (s1_ & 0xffff)); \
                    _Pragma("unroll") for (int j = 0; j < 4; ++j) { xb[D_][j] = *(const u32x2*)(xr + (size_t)(w0 + (I_)) * XRP + 4 * lane + 256 * j); \
                        ya[D_][j] = ntload((const u32x2*)(yw + r0_ * D + 4 * lane + 256 * j)); yb[D_][j] = ntload((const u32x2*)(yw + r1_ * D + 4 * lane + 256 * j)); } } while (0)
#pragma unroll
                for (int d = 0; d < 4; ++d) R2_LOAD(d, d);
#pragma unroll 1
                for (int i4 = 0; i4 < 32; i4 += 4)
#pragma unroll
                for (int d = 0; d < 4; ++d) {
                    const int i = i4 + d, row = w0 + i;
                    RowV r;
#pragma unroll
                    for (int j = 0; j < 4; ++j) {
                        const u32x2 xw = xb[d][j], a = ya[d][j], c = yb[d][j];
                        f32x4 y; y.x = bflo(a.x) + bflo(c.x); y.y = bfhi(a.x) + bfhi(c.x); y.z = bflo(a.y) + bflo(c.y); y.w = bfhi(a.y) + bfhi(c.y);
                        r.v[j] = (f32x4){bflo(xw.x), bfhi(xw.x), bflo(xw.y), bfhi(xw.y)} + g2v[j] * y;
                    }
                    if (i4 < 28) R2_LOAD(d, i + 4);
                    const float rstd = row_rstd(r);
                    if (dry) { asm volatile("" :: "v"(rstd), "v"(r.v[0].x), "v"(r.v[1].y), "v"(r.v[2].z), "v"(r.v[3].w)); }
                    else if (l == 1) { row_apply(r, rstd, mv); row_store_f32(r, outf + (size_t)row * D, lane); }
                    else { row_store_bf16(r, xr + (size_t)row * XRP, lane); row_apply(r, rstd, mv); row_store_bf16(r, xn + (size_t)row * D, lane); }
                }
#undef R2_LOAD
            }
        }
        SEAM(pb0 + 3);
    }
#undef IDS
#undef MODL
#undef CNTL
#undef IN
#undef SEAM
#undef GRID_BAR
}

extern "C" void kernel_launch(void* const* d_in, const int* in_sizes, int n_in, void* d_out, int out_size, void* d_ws, size_t ws_size, hipStream_t stream) {
    static int grid = 0;
    if (grid == 0) {
        if (n_in != 19 || out_size != T * D || ws_size < WS_END) { fprintf(stderr, "kernel_launch: unexpected shapes (n_in %d out %d ws %zu)\n", n_in, out_size, ws_size); grid = -1; return; }
        int dev = 0, cus = 0;
        if (hipGetDevice(&dev) != hipSuccess || hipDeviceGetAttribute(&cus, hipDeviceAttributeMultiprocessorCount, dev) != hipSuccess) { grid = -1; return; }
        if (hipFuncSetAttribute((const void*)mk_fwd, hipFuncAttributeMaxDynamicSharedMemorySize, LDS_BYTES) != hipSuccess) { fprintf(stderr, "kernel_launch: hipFuncSetAttribute failed\n"); grid = -1; return; }
        int per_cu = 0;
        if (hipOccupancyMaxActiveBlocksPerMultiprocessor(&per_cu, (const void*)mk_fwd, NWAVES * 64, LDS_BYTES) != hipSuccess || per_cu < 1) fprintf(stderr, "kernel_launch: occupancy query says %d\n", per_cu);
        (void)hipGetLastError();
        grid = cus;
    }
    if (grid < 0) return;
    (void)hipMemsetAsync((char*)d_ws + WS_CTL, 0, CTL_BYTES, stream);
    Args a{};
    for (int i = 0; i < 19; ++i) a.in[i] = (const float*)d_in[i];
    a.out = (float*)d_out; a.ws = (unsigned char*)d_ws;
#if MK_ONE_LAUNCH
    a.ph_lo = 0; a.ph_hi = NPHASE;
    hipLaunchKernelGGL(mk_fwd, dim3(grid), dim3(NWAVES * 64), LDS_BYTES, stream, a);
#else
    for (int p = 0; p < NPHASE; ++p) { a.ph_lo = p; a.ph_hi = p + 1; hipLaunchKernelGGL(mk_fwd, dim3(grid), dim3(NWAVES * 64), LDS_BYTES, stream, a); }
#endif
}
```

```cpp
#include <hip/hip_runtime.h>
#include <stdint.h>
#include <math.h>
#include <cstdio>

#ifndef MK_ONE_LAUNCH
#define MK_ONE_LAUNCH 1
#endif

typedef unsigned short bf16_t;
typedef float f32x4 __attribute__((ext_vector_type(4)));
typedef unsigned u32x2 __attribute__((ext_vector_type(2)));
typedef unsigned u32x4 __attribute__((ext_vector_type(4)));
#define GAS __attribute__((address_space(1)))
#define LAS __attribute__((address_space(3)))
typedef GAS unsigned gu32;
#define RLX_AGENT __ATOMIC_RELAXED, __HIP_MEMORY_SCOPE_AGENT

constexpr int D = 1024, BATCH = 16, SEQ = 4096, T = BATCH * SEQ;
constexpr int NEXP = 32, DEXP = 512, EPG = 8, NGRP = 4;
constexpr int QKVW = 4608;
__host__ __device__ __forceinline__ size_t qkv_block(int typ, int g, int b, int h) { return (size_t)((((typ * 3 + g) * 16 + b) * 8 + h)) * (4096 * 64); }
__host__ __device__ __forceinline__ int qkv_row(int pos, int g) { const int dsh = 2 * g; return ((pos & ((1 << dsh) - 1)) << (12 - dsh)) + (pos >> dsh); }
constexpr int LISTCAP = 65536;
constexpr int PADROWS = 139264;
constexpr float EPS = 1e-6f;
constexpr float QSCALE = 0.125f * 1.4426950408889634f;
constexpr int NWAVES = 8;
constexpr int XRP = 2048;

constexpr size_t MiB = 1u << 20;
constexpr size_t WS_CTL = 0;
constexpr size_t CTL_BYTES = 1 * MiB;
constexpr int CW_BAR = 4096;
constexpr size_t WS_MOD = 1 * MiB;
constexpr size_t WS_ROPE = 3 * MiB;
constexpr size_t WS_LTOK = 4 * MiB;
constexpr size_t WS_LW = 12 * MiB;
constexpr size_t WS_TSLOT = 20 * MiB;
constexpr size_t WS_LSE = 24 * MiB;
constexpr size_t WS_WZ = 32 * MiB;
constexpr size_t WS_WB = 36 * MiB;
constexpr size_t WS_WCO = 38 * MiB;
constexpr size_t WS_WAI = 40 * MiB;
constexpr size_t WS_WAO = 49 * MiB;
constexpr size_t WS_WGU = 64 * MiB;
constexpr size_t WS_WDN = 192 * MiB;
constexpr size_t WS_XN = 256 * MiB;
constexpr size_t WS_BIG = 384 * MiB;
constexpr size_t WS_Z = WS_BIG, WS_YPRE = WS_BIG + 128 * MiB;
constexpr size_t WS_ACT = WS_BIG, WS_YW = WS_BIG + 136 * MiB;
constexpr size_t WS_QKV = WS_BIG;
constexpr size_t WS_END = WS_BIG + 576 * MiB;

constexpr int RING_BYTES = 162816;
constexpr int MISC_OFF = RING_BYTES;
constexpr int LDS_BYTES = RING_BYTES + 1024;

__device__ __forceinline__ unsigned f2bf(float f) { unsigned u = __float_as_uint(f); return (u + 0x7fffu + ((u >> 16) & 1u)) >> 16; }
__device__ __forceinline__ unsigned pk2(float lo, float hi) { return f2bf(lo) | (f2bf(hi) << 16); }
__device__ __forceinline__ float bf2f(unsigned h) { return __uint_as_float(h << 16); }
__device__ __forceinline__ float bflo(unsigned w) { return __uint_as_float(w << 16); }
__device__ __forceinline__ float bfhi(unsigned w) { return __uint_as_float(w & 0xffff0000u); }
template <int M> __device__ __forceinline__ float xlane(float v) {
    return __int_as_float(__builtin_amdgcn_ds_swizzle(__float_as_int(v), (M << 10) | 0x1f));
}
__device__ __forceinline__ float xlane32(float v, bool hi) {
    auto rr = __builtin_amdgcn_permlane32_swap(__float_as_uint(v), __float_as_uint(v), false, false); return __uint_as_float(hi ? rr[0] : rr[1]);
}
__device__ __forceinline__ float wave_sum(float v) {
    v += xlane<1>(v); v += xlane<2>(v); v += xlane<4>(v); v += xlane<8>(v); v += xlane<16>(v);
    auto rr = __builtin_amdgcn_permlane32_swap(__float_as_uint(v), __float_as_uint(v), false, false);
    return __uint_as_float(rr[0]) + __uint_as_float(rr[1]);
}
__device__ __forceinline__ float silu_f(float x) { return x / (1.0f + __expf(-x)); }
#define LDS_WAIT() asm volatile("s_waitcnt lgkmcnt(0)" ::: "memory")
template <class V> __device__ __forceinline__ V ntload(const V* p) { return __builtin_nontemporal_load(p); }
__device__ __forceinline__ int lane_id() { int l; asm volatile("v_mbcnt_lo_u32_b32 %0, -1, 0\n\tv_mbcnt_hi_u32_b32 %0, -1, %0" : "=v"(l)); return l; }

namespace pg8 {
#define PG8_LAS __attribute__((address_space(3)))
typedef unsigned short bf16_t;
typedef short bf16x8 __attribute__((ext_vector_type(8)));
typedef float f32x4 __attribute__((ext_vector_type(4)));
typedef unsigned u32x4 __attribute__((ext_vector_type(4)));
constexpr int BM = 256, BK = 64, HALF = 128, HTB = HALF * BK * 2  , STAGE_BYTES = 8 * HTB, NXCD = 8, WGM = 4;

__host__ __device__ __forceinline__ int lds_byte(int r, int c) { const int st = (r >> 4) * 2 + (c >> 5), rr = r & 15, cc = c & 31, ob = rr * 64 + cc * 2; return st * 1024 + (ob ^ (((ob >> 9) & 1) << 5)); }
__host__ __device__ __forceinline__ void stage_rc(int b, int& R, int& C) { const int st = b / 1024, sb = b % 1024, swz = sb ^ (((sb >> 9) & 1) << 5); R = (st >> 1) * 16 + swz / 64; C = (st & 1) * 32 + (swz % 64) / 2; }
__host__ __device__ __forceinline__ int perm32(int rho) { const int n = rho >> 4, i = rho & 15; return 8 * (i >> 2) + 4 * n + (i & 3); }

struct Unit { int pm, pn, pb; };
struct Gemm { const bf16_t* A; const bf16_t* Bt; int M, N, K; };

struct StaticOrder {
    int nM, nN, nwg, G, c, wgm;
    __host__ __device__ void init(int M, int N, int G_, int c_, int wgm_ = WGM) { nM = M / BM; nN = N / BM; nwg = nM * nN; G = G_; c = c_; wgm = wgm_; }
    __host__ __device__ bool next(int i, Unit& u) const {
        const long L = (long)i * G + c; if (L >= nwg) return false;
        int wgid = (int)L; { const int q = nwg / NXCD, r = nwg % NXCD, xcd = wgid % NXCD, off = wgid / NXCD; wgid = (xcd < r ? xcd * (q + 1) : r * (q + 1) + (xcd - r) * q) + off; }
        const int nig = wgm * nN, gid = wgid / nig, fm = gid * wgm, gsz = (nM - fm) < wgm ? (nM - fm) : wgm;
        u.pm = fm + ((wgid % nig) % gsz); u.pn = (wgid % nig) / gsz; u.pb = u.pn; return true;
    }
    __device__ __forceinline__ void a_ready(const Unit&) const {}
    __device__ __forceinline__ void done(const Unit&) const {}
};


__device__ __forceinline__ unsigned cvt_pk_bf16(float lo, float hi) { unsigned r; asm volatile("v_cvt_pk_bf16_f32 %0, %1, %2" : "=v"(r) : "v"(lo), "v"(hi)); return r; }
typedef float f32x2 __attribute__((ext_vector_type(2)));

template <class Epi, class Sched, class AM, bool ALIGN_EPI = false, bool SP2 = false>
__device__ __forceinline__ void gemm_phase(PG8_LAS unsigned char* lds, const Gemm g, const Sched& S, const Epi& E, const AM& am, const int wid_in) {
    int wid = wid_in; asm volatile("" : "+s"(wid));
    const int lane = lane_id(), tid = wid * 64 + lane, wr = wid >> 2, wc = wid & 3, fr = lane & 15, fq = lane >> 4;
    const int K = g.K, nt = K / BK;
    unsigned voffA[2], voffB[2]; int stR[2], stC[2];
#pragma unroll
    for (int i = 0; i < 2; ++i) { int R, C; stage_rc(tid * 16 + i * 8192, R, C); const int Rb = Epi::PERM ? ((R & ~31) + perm32(R & 31)) : R;
        stR[i] = R; stC[i] = C; voffA[i] = (unsigned)(R * K + C) * 2u; voffB[i] = (unsigned)(Rb * K + C) * 2u; }
    const size_t kstep = (size_t)(BK * 2);
    const size_t hstep = (size_t)HALF * K * 2;
    const size_t tstep = 2 * hstep;
    const unsigned ldsw = (unsigned)wid * 1024u;
    const int aoff = lds_byte(wr * 64 + fr, fq * 8), boff = lds_byte(wc * 32 + fr, fq * 8);
#define PG8_SA(b, h) (((b) * 2 + (h)) * HTB)
#define PG8_SB(b, h) ((4 + (b) * 2 + (h)) * HTB)
#define PG8_STAGE(bufoff, gbase, voff) do { _Pragma("unroll") for (int _i = 0; _i < 2; ++_i) \
        __builtin_amdgcn_global_load_lds((const unsigned*)((const char*)(gbase) + (voff)[_i]), (PG8_LAS unsigned*)(lds + (bufoff) + ldsw + _i * 8192), 16, 0, 0); } while (0)
#define PG8_STAGE_A(b, h, gbase, NX) do { if constexpr (AM::GATHER) { const unsigned so_[2] = {(NX) ? gno[h][0] : gao[h][0], (NX) ? gno[h][1] : gao[h][1]}; PG8_STAGE(PG8_SA(b, h), gbase, so_); } \
        else { PG8_STAGE(PG8_SA(b, h), (gbase) + (h) * hstep, voffA); } } while (0)
#define PG8_LDA(dst, b, h) do { _Pragma("unroll") for (int m = 0; m < 4; ++m) _Pragma("unroll") for (int k = 0; k < 2; ++k) dst[m][k] = *(const PG8_LAS bf16x8*)(lds + PG8_SA(b, h) + aoff + m * 2048 + k * 1024); } while (0)
#define PG8_LDB(dst, b, h) do { _Pragma("unroll") for (int n = 0; n < 2; ++n) _Pragma("unroll") for (int k = 0; k < 2; ++k) dst[n][k] = *(const PG8_LAS bf16x8*)(lds + PG8_SB(b, h) + boff + n * 2048 + k * 1024); } while (0)
#define PG8_MMA(ai, bj, At, Bt) do { __builtin_amdgcn_s_setprio(1); _Pragma("unroll") for (int m = 0; m < 4; ++m) _Pragma("unroll") for (int n = 0; n < 2; ++n) _Pragma("unroll") for (int k = 0; k < 2; ++k) \
        acc[ai][bj][m][n] = __builtin_amdgcn_mfma_f32_16x16x32_bf16(Bt[n][k], At[m][k], acc[ai][bj][m][n], 0, 0, 0); __builtin_amdgcn_s_setprio(0); } while (0)
#define PG8_WAIT_V(n) asm volatile("s_waitcnt vmcnt(" #n ")" ::: "memory")
#define PG8_WAIT_L(n) asm volatile("s_waitcnt lgkmcnt(" #n ")" ::: "memory")
#define PG8_BAR __builtin_amdgcn_s_barrier()
#define PG8_SCHED __builtin_amdgcn_sched_barrier(0)
    Unit cur, nxt; int ui = 0;
    if (!S.next(0, cur)) return;
    f32x4 acc[2][2][4][2];
#pragma unroll
    for (int a = 0; a < 2; ++a)
#pragma unroll
        for (int b = 0; b < 2; ++b)
#pragma unroll
            for (int m = 0; m < 4; ++m)
#pragma unroll
                for (int n = 0; n < 2; ++n) acc[a][b][m][n] = (f32x4){0.f, 0.f, 0.f, 0.f};
    bf16x8 At[4][2], B0[2][2], B1[2][2];
    const char* cA = (const char*)g.A + (AM::GATHER ? (size_t)0 : (size_t)cur.pm * tstep); const char* cB = (const char*)g.Bt + (size_t)cur.pb * tstep;
    unsigned gao[2][2], gno[2][2];
    if constexpr (AM::GATHER) { _Pragma("unroll") for (int h = 0; h < 2; ++h) _Pragma("unroll") for (int i = 0; i < 2; ++i) { gao[h][i] = (unsigned)(am.arow(cur, h * HALF + stR[i]) * K + stC[i]) * 2u; gno[h][i] = gao[h][i]; } }
    else { _Pragma("unroll") for (int h = 0; h < 2; ++h) _Pragma("unroll") for (int i = 0; i < 2; ++i) { gao[h][i] = 0u; gno[h][i] = 0u; } }
    S.a_ready(cur);
    if constexpr (SP2) {
        PG8_STAGE(PG8_SB(0, 0), cB, voffB); PG8_STAGE(PG8_SB(0, 1), cB + hstep, voffB); PG8_STAGE_A(0, 0, cA, false); PG8_STAGE_A(0, 1, cA, false);
        if (wr == 1) PG8_BAR;
        PG8_WAIT_V(2); PG8_BAR;
        PG8_STAGE(PG8_SB(1, 0), cB + kstep, voffB); PG8_STAGE_A(1, 0, cA + kstep, false); PG8_STAGE(PG8_SB(1, 1), cB + hstep + kstep, voffB);
        PG8_WAIT_V(6); PG8_BAR;
    } else {
        PG8_STAGE(PG8_SB(0, 0), cB, voffB); PG8_STAGE_A(0, 0, cA, false); PG8_STAGE(PG8_SB(0, 1), cB + hstep, voffB); PG8_STAGE_A(0, 1, cA, false);
        if (wr == 1) PG8_BAR;
        PG8_WAIT_V(4); PG8_BAR;
        PG8_STAGE(PG8_SB(1, 0), cB + kstep, voffB); PG8_STAGE_A(1, 0, cA + kstep, false); PG8_STAGE(PG8_SB(1, 1), cB + hstep + kstep, voffB);
        PG8_WAIT_V(6); PG8_BAR;
    }
    for (;;) {
        const bool has_next = S.next(ui + 1, nxt);
        const char* nA = has_next ? (const char*)g.A + (AM::GATHER ? (size_t)0 : (size_t)nxt.pm * tstep) : cA; const char* nB = has_next ? (const char*)g.Bt + (size_t)nxt.pb * tstep : cB;
        if constexpr (AM::GATHER) { if (has_next) { _Pragma("unroll") for (int h = 0; h < 2; ++h) _Pragma("unroll") for (int i = 0; i < 2; ++i) gno[h][i] = (unsigned)(am.arow(nxt, h * HALF + stR[i]) * K + stC[i]) * 2u; } }
        for (int t = 0; t < nt; t += 2) {
            const bool last = (t == nt - 2);
            const char* a1 = cA + (size_t)(t + 1) * kstep;
            const char* a2 = last ? nA : cA + (size_t)(t + 2) * kstep; const char* b2 = last ? nB : cB + (size_t)(t + 2) * kstep;
            const char* a3 = a2 + kstep; const char* b3 = b2 + kstep;
            if (last && has_next) S.a_ready(nxt);
            if (false) E.prefetch(cur, tid, (PG8_LAS unsigned*)(lds + 162816 + 512));
            if constexpr (SP2) {
            PG8_LDB(B0, 0, 0); PG8_LDB(B1, 0, 1); PG8_SCHED; PG8_LDA(At, 0, 0); PG8_STAGE_A(1, 1, a1, false);
            PG8_WAIT_V(8); PG8_WAIT_L(0); PG8_BAR; PG8_MMA(0, 0, At, B0); PG8_MMA(0, 1, At, B1); PG8_BAR; PG8_SCHED;
            PG8_LDA(At, 0, 1); PG8_STAGE(PG8_SB(0, 0), b2, voffB); PG8_STAGE(PG8_SB(0, 1), b2 + hstep, voffB); PG8_STAGE_A(0, 0, a2, last);
            PG8_WAIT_V(8); PG8_WAIT_L(0); PG8_BAR; PG8_MMA(1, 0, At, B0); PG8_MMA(1, 1, At, B1); PG8_BAR; PG8_SCHED;
            PG8_LDB(B0, 1, 0); PG8_LDB(B1, 1, 1); PG8_SCHED; PG8_LDA(At, 1, 0); PG8_STAGE_A(0, 1, a2, last);
            PG8_WAIT_V(8); PG8_WAIT_L(0); PG8_BAR; PG8_MMA(0, 0, At, B0); PG8_MMA(0, 1, At, B1); PG8_BAR; PG8_SCHED;
            PG8_LDA(At, 1, 1); PG8_STAGE(PG8_SB(1, 0), b3, voffB); PG8_STAGE(PG8_SB(1, 1), b3 + hstep, voffB); PG8_STAGE_A(1, 0, a3, last);
            PG8_WAIT_V(8); PG8_WAIT_L(0); PG8_BAR; PG8_MMA(1, 0, At, B0); PG8_MMA(1, 1, At, B1); PG8_BAR; PG8_SCHED;
            } else {
            PG8_LDB(B0, 0, 0); PG8_SCHED; PG8_LDA(At, 0, 0); PG8_STAGE_A(1, 1, a1, false);
            PG8_WAIT_L(8); PG8_BAR; PG8_WAIT_L(0); PG8_MMA(0, 0, At, B0); PG8_BAR; PG8_SCHED;
            PG8_LDB(B1, 0, 1); PG8_STAGE(PG8_SB(0, 0), b2, voffB);
            PG8_BAR; PG8_WAIT_L(0); PG8_MMA(0, 1, At, B1); PG8_BAR;
            PG8_LDA(At, 0, 1); PG8_STAGE_A(0, 0, a2, last);
            PG8_BAR; PG8_WAIT_L(0); PG8_MMA(1, 0, At, B0); PG8_BAR; PG8_SCHED;
            PG8_STAGE(PG8_SB(0, 1), b2 + hstep, voffB);
            PG8_WAIT_V(6); PG8_BAR; PG8_MMA(1, 1, At, B1); PG8_BAR;
            PG8_LDB(B0, 1, 0); PG8_SCHED; PG8_LDA(At, 1, 0); PG8_STAGE_A(0, 1, a2, last);
            PG8_WAIT_L(8); PG8_BAR; PG8_WAIT_L(0); PG8_MMA(0, 0, At, B0); PG8_BAR; PG8_SCHED;
            PG8_LDB(B1, 1, 1); PG8_STAGE(PG8_SB(1, 0), b3, voffB);
            PG8_BAR; PG8_WAIT_L(0); PG8_MMA(0, 1, At, B1); PG8_BAR;
            PG8_LDA(At, 1, 1); PG8_STAGE_A(1, 0, a3, last);
            PG8_BAR; PG8_WAIT_L(0); PG8_MMA(1, 0, At, B0); PG8_BAR; PG8_SCHED;
            PG8_STAGE(PG8_SB(1, 1), b3 + hstep, voffB);
            PG8_WAIT_V(6); PG8_BAR; PG8_MMA(1, 1, At, B1); PG8_BAR;
            }
        }
        if constexpr (ALIGN_EPI) { if (wr == 0) PG8_BAR; }
        if constexpr (!Epi::AFTER_DRAIN) { E(acc, cur, wr, wc, fr, fq); S.done(cur); }
        if (!has_next) break;
#pragma unroll
        for (int a = 0; a < 2; ++a)
#pragma unroll
            for (int b = 0; b < 2; ++b)
#pragma unroll
                for (int m = 0; m < 4; ++m)
#pragma unroll
                    for (int n = 0; n < 2; ++n) acc[a][b][m][n] = (f32x4){0.f, 0.f, 0.f, 0.f};
        cur = nxt; cA = nA; cB = nB; ++ui;
        if constexpr (AM::GATHER) { _Pragma("unroll") for (int h = 0; h < 2; ++h) _Pragma("unroll") for (int i = 0; i < 2; ++i) gao[h][i] = gno[h][i]; }
        if constexpr (ALIGN_EPI) { if (wr == 1) PG8_BAR; }
    }
    PG8_WAIT_V(0);
    if constexpr (!ALIGN_EPI) { if (wr == 0) PG8_BAR; }
    PG8_BAR;
    if constexpr (Epi::AFTER_DRAIN) { E.fused(acc, cur, wr, wc, fr, fq, lds, wid, lane); S.done(cur); }
#undef PG8_SA
#undef PG8_SB
#undef PG8_STAGE
#undef PG8_STAGE_A
#undef PG8_LDA
#undef PG8_LDB
#undef PG8_MMA
#undef PG8_WAIT_V
#undef PG8_WAIT_L
#undef PG8_BAR
#undef PG8_SCHED
}

__device__ __forceinline__ u32x4 pack8(const f32x4 v0, const f32x4 v1) { u32x4 w; w.x = cvt_pk_bf16(v0[0], v0[1]); w.y = cvt_pk_bf16(v0[2], v0[3]); w.z = cvt_pk_bf16(v1[0], v1[1]); w.w = cvt_pk_bf16(v1[2], v1[3]); return w; }
__device__ __forceinline__ u32x4 xpose4x16(const u32x4 w, int sa) {
    u32x4 r; r.x = __builtin_amdgcn_ds_bpermute(sa, w.x); r.y = __builtin_amdgcn_ds_bpermute(sa, w.y); r.z = __builtin_amdgcn_ds_bpermute(sa, w.z); r.w = __builtin_amdgcn_ds_bpermute(sa, w.w); return r;
}
#define XPOSE_IDS() const int L_ = fr + 16 * fq, tr_ = L_ >> 2, tq_ = L_ & 3, sa_ = 4 * (tr_ + 16 * tq_)
__device__ __forceinline__ float silu1(float x) { return x * __builtin_amdgcn_rcpf(1.0f + __builtin_amdgcn_exp2f(-1.4426950408889634f * x)); }
template <bool SILU> struct EpiPair {
    static constexpr bool PERM = true, AFTER_DRAIN = false;
    bf16_t* O; int ldc;
    __device__ __forceinline__ void prefetch(const Unit&, int, PG8_LAS unsigned*) const {}
    __device__ __forceinline__ void operator()(const f32x4 (&acc)[2][2][4][2], const Unit& u, int wr, int wc, int fr, int fq) const {
        XPOSE_IDS();
        const int row0 = u.pm * BM + wr * 64 + tr_, ch0 = u.pn * HALF + wc * 32 + 8 * tq_;
#pragma unroll
        for (int ai = 0; ai < 2; ++ai)
#pragma unroll
            for (int m = 0; m < 4; ++m) {
                f32x4 a0 = acc[ai][0][m][0], a1 = acc[ai][0][m][1];
                if (SILU) {
#pragma unroll
                    for (int c = 0; c < 4; ++c) { a0[c] = silu1(a0[c]); a1[c] = silu1(a1[c]); }
                }
                *(u32x4*)(O + (size_t)(row0 + ai * HALF + m * 16) * ldc + ch0) = xpose4x16(pack8(a0 * acc[ai][1][m][0], a1 * acc[ai][1][m][1]), sa_);
            }
    }
};
struct EpiYpre {
    static constexpr bool PERM = true, AFTER_DRAIN = false;
    bf16_t* O; const bf16_t* Z; const float* cw;
    __device__ __forceinline__ void prefetch(const Unit& u, int tid, PG8_LAS unsigned* dummy) const {
#pragma unroll
        for (int i = 0; i < 2; ++i) { const int line = tid + 512 * i, row = line >> 2, seg = line & 3;
            __builtin_amdgcn_global_load_lds((const unsigned*)(Z + (size_t)(u.pm * BM + row) * D + u.pn * BM + seg * 64), dummy, 4, 0, 0); }
    }
    template <typename P> static __device__ __forceinline__ P sadd(P base, unsigned off) { asm volatile("" : "+v"(off)); return base + off; }
    template <int N> static __device__ __forceinline__ u32x4 ror(const u32x4 v) { u32x4 r;
        r.x = (unsigned)__builtin_amdgcn_update_dpp(0, (int)v.x, 0x120 + N, 0xf, 0xf, false); r.y = (unsigned)__builtin_amdgcn_update_dpp(0, (int)v.y, 0x120 + N, 0xf, 0xf, false);
        r.z = (unsigned)__builtin_amdgcn_update_dpp(0, (int)v.z, 0x120 + N, 0xf, 0xf, false); r.w = (unsigned)__builtin_amdgcn_update_dpp(0, (int)v.w, 0x120 + N, 0xf, 0xf, false); return r; }
    static __device__ __forceinline__ u32x4 sel(bool c, const u32x4 a, const u32x4 b) { u32x4 r; r.x = c ? a.x : b.x; r.y = c ? a.y : b.y; r.z = c ? a.z : b.z; r.w = c ? a.w : b.w; return r; }
    __device__ __forceinline__ void operator()(const f32x4 (&acc)[2][2][4][2], const Unit& u, int wr, int wc, int fr, int fq) const {
        XPOSE_IDS();
        const int row0 = u.pm * BM + wr * 64 + fr;
#pragma unroll
        for (int bj = 0; bj < 2; ++bj) {
            const int col0 = u.pn * BM + bj * HALF + wc * 32 + 8 * fq;
            f32x4 w0[2], w1[2], w2[2];
#pragma unroll
            for (int n = 0; n < 2; ++n) { w0[n] = *(const f32x4*)(cw + col0 + 4 * n); w1[n] = *(const f32x4*)(cw + D + col0 + 4 * n); w2[n] = *(const f32x4*)(cw + 2 * D + col0 + 4 * n); }
            u32x4 zc[2][4], zh[2];
#pragma unroll
            for (int ai = 0; ai < 2; ++ai) {
                zh[ai] = (u32x4){0u, 0u, 0u, 0u};
                if (fr >= 14 && row0 + ai * HALF >= 16) zh[ai] = *(const u32x4*)sadd((const char*)Z, (unsigned)((row0 + ai * HALF - 16) * D + col0) * 2u);
#pragma unroll
                for (int m = 0; m < 4; ++m) zc[ai][m] = *(const u32x4*)(sadd((const char*)Z, (unsigned)((row0 + ai * HALF) * D + col0) * 2u) + m * 16 * D * 2);
            }
            asm volatile("" ::: "memory");
#pragma unroll
            for (int ai = 0; ai < 2; ++ai)
#pragma unroll
                for (int m = 0; m < 4; ++m) {
                    const int row = row0 + ai * HALF + m * 16, t = row & (SEQ - 1);
                    const u32x4 cur = zc[ai][m], prv = (m == 0) ? zh[ai] : zc[ai][m - 1];
                    u32x4 z1 = sel(fr >= 1, ror<1>(cur), ror<1>(prv)), z2 = sel(fr >= 2, ror<2>(cur), ror<2>(prv));
                    if (t < 1) z1 = (u32x4){0u, 0u, 0u, 0u};
                    if (t < 2) z2 = (u32x4){0u, 0u, 0u, 0u};
                    const u32x4 z0 = cur;
                    f32x4 v[2];
#pragma unroll
                    for (int n = 0; n < 2; ++n) {
                        f32x4 a, b, c;
                        a[0] = __uint_as_float(z0[2 * n] << 16); a[1] = __uint_as_float(z0[2 * n] & 0xffff0000u); a[2] = __uint_as_float(z0[2 * n + 1] << 16); a[3] = __uint_as_float(z0[2 * n + 1] & 0xffff0000u);
                        b[0] = __uint_as_float(z1[2 * n] << 16); b[1] = __uint_as_float(z1[2 * n] & 0xffff0000u); b[2] = __uint_as_float(z1[2 * n + 1] << 16); b[3] = __uint_as_float(z1[2 * n + 1] & 0xffff0000u);
                        c[0] = __uint_as_float(z2[2 * n] << 16); c[1] = __uint_as_float(z2[2 * n] & 0xffff0000u); c[2] = __uint_as_float(z2[2 * n + 1] << 16); c[3] = __uint_as_float(z2[2 * n + 1] & 0xffff0000u);
                        v[n] = acc[ai][bj][m][n] * (w2[n] * a + w1[n] * b + w0[n] * c);
                    }
                    *(u32x4*)(sadd((char*)O, (unsigned)((row0 - fr + tr_ + ai * HALF) * D + col0 - 8 * fq + 8 * tq_) * 2u) + m * 16 * D * 2) = xpose4x16(pack8(v[0], v[1]), sa_);
                    __builtin_amdgcn_sched_barrier(0);
                }
            asm volatile("" ::: "memory");
        }
    }
};

template <bool RES_F32> struct EpiRes {
    static constexpr bool PERM = true, AFTER_DRAIN = false;
    bf16_t* xr; const float* xin; const float* modg;
    __device__ __forceinline__ void prefetch(const Unit&, int, PG8_LAS unsigned*) const {}
    __device__ __forceinline__ void operator()(const f32x4 (&acc)[2][2][4][2], const Unit& u, int wr, int wc, int fr, int fq) const {
        XPOSE_IDS();
        const int row0 = u.pm * BM + wr * 64 + fr, col0 = u.pn * BM + wc * 32 + 8 * fq;
        const float* gb = modg + (size_t)((u.pm * BM) >> 12) * 6144;
        f32x4 gv[2][2];
#pragma unroll
        for (int bj = 0; bj < 2; ++bj)
#pragma unroll
            for (int n = 0; n < 2; ++n) gv[bj][n] = *(const f32x4*)(gb + col0 + bj * HALF + n * 4);
        if constexpr (!RES_F32) {
            u32x4 rw[2][4][2];
#pragma unroll
            for (int ai = 0; ai < 2; ++ai)
#pragma unroll
                for (int m = 0; m < 4; ++m)
#pragma unroll
                    for (int bj = 0; bj < 2; ++bj) rw[ai][m][bj] = *(const u32x4*)(xr + (size_t)(row0 + ai * HALF + m * 16) * XRP + col0 + bj * HALF);
            asm volatile("" ::: "memory");
#pragma unroll
            for (int ai = 0; ai < 2; ++ai)
#pragma unroll
                for (int m = 0; m < 4; ++m) { const int row = row0 + ai * HALF + m * 16;
#pragma unroll
                    for (int bj = 0; bj < 2; ++bj) { const u32x4 w = rw[ai][m][bj];
                        const f32x4 r0 = {__uint_as_float(w.x << 16), __uint_as_float(w.x & 0xffff0000u), __uint_as_float(w.y << 16), __uint_as_float(w.y & 0xffff0000u)};
                        const f32x4 r1 = {__uint_as_float(w.z << 16), __uint_as_float(w.z & 0xffff0000u), __uint_as_float(w.w << 16), __uint_as_float(w.w & 0xffff0000u)};
                        *(u32x4*)(xr + (size_t)(row - fr + tr_) * XRP + col0 - 8 * fq + 8 * tq_ + bj * HALF) = xpose4x16(pack8(r0 + gv[bj][0] * acc[ai][bj][m][0], r1 + gv[bj][1] * acc[ai][bj][m][1]), sa_); } }
        } else {
#pragma unroll
        for (int ai = 0; ai < 2; ++ai) {
            f32x4 rv[4][2][2];
#pragma unroll
            for (int m = 0; m < 4; ++m) { const int row = row0 + ai * HALF + m * 16;
#pragma unroll
                for (int bj = 0; bj < 2; ++bj) { rv[m][bj][0] = ntload((const f32x4*)(xin + (size_t)row * D + col0 + bj * HALF)); rv[m][bj][1] = ntload((const f32x4*)(xin + (size_t)row * D + col0 + bj * HALF + 4)); } }
#pragma unroll
            for (int m = 0; m < 4; ++m) { const int row = row0 + ai * HALF + m * 16;
#pragma unroll
                for (int bj = 0; bj < 2; ++bj)
                    *(u32x4*)(xr + (size_t)(row - fr + tr_) * XRP + col0 - 8 * fq + 8 * tq_ + bj * HALF) = xpose4x16(pack8(rv[m][bj][0] + gv[bj][0] * acc[ai][bj][m][0], rv[m][bj][1] + gv[bj][1] * acc[ai][bj][m][1]), sa_); }
            asm volatile("" ::: "memory");
        }
        }
    }
};
struct EpiQKV {
    static constexpr bool PERM = true, AFTER_DRAIN = false;
    bf16_t* O; const float* rope; int row_off;
    __device__ __forceinline__ void prefetch(const Unit&, int, PG8_LAS unsigned*) const {}
    __device__ __forceinline__ void operator()(const f32x4 (&acc)[2][2][4][2], const Unit& u, int wr, int wc, int fr, int fq) const {
        XPOSE_IDS();
        const int row0 = u.pm * BM + wr * 64 + fr, col0 = u.pn * BM + wc * 32 + 8 * fq;
        const int typ = (u.pn % 6) >> 1, gq_ = u.pn / 6;
        const bool rl = (typ < 2) && ((wc & 1) == 0) && (fq < 2);
        const float sc = (typ == 0) ? QSCALE : 1.0f;
#pragma unroll
        for (int ai = 0; ai < 2; ++ai)
#pragma unroll
        for (int mp = 0; mp < 2; ++mp) {
            f32x4 csv[2], snv[2];
#pragma unroll
            for (int mm = 0; mm < 2; ++mm) { const int pos = (row0 + ai * HALF + (2 * mp + mm) * 16) & (SEQ - 1);
                csv[mm] = *(const f32x4*)(rope + pos * 8 + 4 * (fq & 1)); snv[mm] = *(const f32x4*)(rope + 4096 * 8 + pos * 8 + 4 * (fq & 1)); }
#pragma unroll
            for (int mm = 0; mm < 2; ++mm) {
                const int m = 2 * mp + mm, row = row0 + ai * HALF + m * 16;
                f32x4 cs = {1.f, 1.f, 1.f, 1.f}, sn = {0.f, 0.f, 0.f, 0.f};
                if (rl) { cs = csv[mm]; sn = snv[mm]; }
#pragma unroll
                for (int bj = 0; bj < 2; ++bj) {
                    const f32x4 x1 = acc[ai][bj][m][0], x2 = acc[ai][bj][m][1];
                    const f32x4 r1 = (x1 * cs - x2 * sn) * sc, r2 = (x2 * cs + x1 * sn) * sc;
                    { const int tok = row_off + row - fr + tr_, hh = 4 * (u.pn & 1) + 2 * bj + (wc >> 1);
                      *(u32x4*)(O + qkv_block(typ, gq_, tok >> 12, hh) + (size_t)qkv_row(tok & (SEQ - 1), gq_) * 64 + 32 * (wc & 1) + 8 * tq_) = xpose4x16(pack8(r1, r2), sa_); }
                }
            }
            asm volatile("" ::: "memory");
        }
    }
};
struct EpiDown {
    static constexpr bool PERM = true, AFTER_DRAIN = false;
    bf16_t* O; const float* lw; const PG8_LAS int* rb;
    __device__ __forceinline__ void prefetch(const Unit&, int, PG8_LAS unsigned*) const {}
    __device__ __forceinline__ void operator()(const f32x4 (&acc)[2][2][4][2], const Unit& u, int wr, int wc, int fr, int fq) const {
        XPOSE_IDS();
        const int row0 = u.pm * BM + wr * 64 + fr, col0 = u.pn * BM + wc * 32 + 8 * fq;
        const int e = u.pb >> 2; const float* wrow = lw + (size_t)e * LISTCAP - rb[e];
        float wv[2][4];
#pragma unroll
        for (int ai = 0; ai < 2; ++ai)
#pragma unroll
            for (int m = 0; m < 4; ++m) wv[ai][m] = wrow[row0 + ai * HALF + m * 16];
#pragma unroll
        for (int ai = 0; ai < 2; ++ai)
#pragma unroll
            for (int m = 0; m < 4; ++m) {
                const int row = row0 + ai * HALF + m * 16; const float w = wv[ai][m];
#pragma unroll
                for (int bj = 0; bj < 2; ++bj) *(u32x4*)(O + (size_t)(row - fr + tr_) * D + col0 - 8 * fq + 8 * tq_ + bj * HALF) = xpose4x16(pack8(acc[ai][bj][m][0] * w, acc[ai][bj][m][1] * w), sa_);
            }
    }
};
struct MoeOrder {
    int nM, nN, nwg, G, c; const PG8_LAS int* rb;
    __device__ void init(int nRT, int G_, int c_, const PG8_LAS int* rb_) { nM = nRT; nN = 4; nwg = nM * nN; G = G_; c = c_; rb = rb_; }
    __device__ bool next(int i, Unit& u) const {
        const long L = (long)i * G + c; if (L >= nwg) return false;
        int wgid = (int)L; { const int q = nwg / NXCD, r = nwg % NXCD, xcd = wgid % NXCD, off = wgid / NXCD; wgid = (xcd < r ? xcd * (q + 1) : r * (q + 1) + (xcd - r) * q) + off; }
        const int nig = WGM * nN, gid = wgid / nig, fm = gid * WGM, gsz = (nM - fm) < WGM ? (nM - fm) : WGM;
        u.pm = fm + ((wgid % nig) % gsz); u.pn = (wgid % nig) / gsz;
        int e = 0; const int r0 = u.pm * BM;
#pragma unroll 1
        while (e < 31 && rb[e + 1] <= r0) ++e;
        u.pb = e * 4 + u.pn; return true;
    }
    __device__ __forceinline__ void a_ready(const Unit&) const {}
    __device__ __forceinline__ void done(const Unit&) const {}
};
struct APlain { static constexpr bool GATHER = false; __device__ __forceinline__ int arow(const Unit&, int) const { return 0; } };
struct AGather {
    static constexpr bool GATHER = true;
    const int* ltok; const int* cnt; const PG8_LAS int* rb;
    __device__ __forceinline__ int arow(const Unit& u, int r) const { const int e = u.pb >> 2, l = u.pm * BM - rb[e] + r; return (l < cnt[e]) ? ltok[(size_t)e * LISTCAP + l] : 0; }
};
}

#define XB_TMO      128
#define XB_XCNT(j)  (256  + 64 * (j))
#define XB_XSUB(j)  (1280 + 64 * (j))
#define XB_XGEN(j)  (2304 + 64 * (j))
#define XB_TOP      3328
#define XB_TOPGEN   3392
#define XCD_BAR_WORDS 3456
#define XB_SPIN_CAP (1u << 18)

__device__ __forceinline__ unsigned xb_ld(unsigned* p)              { return __hip_atomic_load(p, __ATOMIC_RELAXED, __HIP_MEMORY_SCOPE_AGENT); }
__device__ __forceinline__ unsigned xb_add(unsigned* p, unsigned v) { return __hip_atomic_fetch_add(p, v, __ATOMIC_RELAXED, __HIP_MEMORY_SCOPE_AGENT); }
__device__ __forceinline__ unsigned xb_xcc_id() { return (unsigned)__builtin_amdgcn_s_getreg((3 << 11) | 20) & 0xFu; }
#define XB_SPIN(cond, bar) do { unsigned _sp = 0; while (cond) { __builtin_amdgcn_s_sleep(1); \
    if ((++_sp & 255u) == 0u) { if (xb_ld(&(bar)[XB_TMO])) break; if (_sp > XB_SPIN_CAP) { atomicAdd(&(bar)[XB_TMO], 1u); break; } } } } while (0)

struct XcdBarrier {
    unsigned* bar; unsigned x;
    volatile LAS unsigned* st;
};

__device__ __forceinline__ XcdBarrier xcd_barrier_post(unsigned* bar, volatile LAS unsigned* st, int wave) {
    XcdBarrier b; b.bar = bar; b.x = xb_xcc_id(); b.st = st;
    if (wave == 0 && lane_id() == 0) (void)xb_add(&bar[XB_XCNT(b.x)], 1u);
    return b;
}
__device__ __forceinline__ void xcd_barrier_complete(unsigned* bar, unsigned x, unsigned& nloc, unsigned& nx) {
    const unsigned G = gridDim.x * gridDim.y * gridDim.z;
    unsigned sum, cnt, mine, sp = 0u;
    for (;;) {
        sum = 0u; cnt = 0u; mine = 0u;
#pragma unroll
        for (unsigned j = 0; j < 16; ++j) { const unsigned c = xb_ld(&bar[XB_XCNT(j)]); sum += c; cnt += (c > 0u) ? 1u : 0u; mine = (j == x) ? c : mine; }
        if (sum == G) break;
        __builtin_amdgcn_s_sleep(1);
        if ((++sp & 255u) == 0u) { if (xb_ld(&bar[XB_TMO])) break; if (sp > XB_SPIN_CAP) { atomicAdd(&bar[XB_TMO], 1u); break; } }
    }
    nloc = mine > 0u ? mine : 1u; nx = cnt > 0u ? cnt : 1u;
}

__device__ __forceinline__ void xcd_barrier(const XcdBarrier& b, int wave) {
    asm volatile("s_waitcnt vmcnt(0)" ::: "memory");
    __syncthreads();
    if (wave == 0 && lane_id() == 0) {
        unsigned* bar = b.bar;
        __builtin_amdgcn_s_waitcnt(0);
        unsigned nloc = b.st[0], nx = b.st[1];
        if (nloc == 0u) { xcd_barrier_complete(bar, b.x, nloc, nx); b.st[0] = nloc; b.st[1] = nx; }
        const unsigned old = xb_add(&bar[XB_XSUB(b.x)], 1u);
        const unsigned gen = old / nloc;
        if (old + 1u == (gen + 1u) * nloc) {
            __builtin_amdgcn_fence(__ATOMIC_RELEASE, "agent");
            asm volatile("s_waitcnt vmcnt(0)" ::: "memory");
            const unsigned og = xb_add(&bar[XB_TOP], 1u);
            const unsigned tg = og / nx;
            if (og + 1u == (tg + 1u) * nx) xb_add(&bar[XB_TOPGEN], 1u);
            else XB_SPIN(xb_ld(&bar[XB_TOPGEN]) == tg, bar);
            __builtin_amdgcn_fence(__ATOMIC_ACQUIRE, "agent");
            xb_add(&bar[XB_XGEN(b.x)], 1u);
            asm volatile("s_waitcnt vmcnt(0)" ::: "memory");
        } else {
            XB_SPIN(xb_ld(&bar[XB_XGEN(b.x)]) == gen, bar);
            __builtin_amdgcn_fence(__ATOMIC_ACQUIRE, "agent");
            asm volatile("s_waitcnt vmcnt(0)" ::: "memory");
        }
    }
    __syncthreads();
}

struct RowV { f32x4 v[4]; };
__device__ __forceinline__ void row_load(RowV& r, const float* row, int lane) {
#pragma unroll
    for (int j = 0; j < 4; ++j) r.v[j] = ntload((const f32x4*)(row + 4 * lane + 256 * j));
}
__device__ __forceinline__ void row_load_bf16(RowV& r, const bf16_t* row, int lane) {
#pragma unroll
    for (int j = 0; j < 4; ++j) { const u32x2 w = *(const u32x2*)(row + 4 * lane + 256 * j); r.v[j] = (f32x4){bflo(w.x), bfhi(w.x), bflo(w.y), bfhi(w.y)}; }
}
__device__ __forceinline__ float row_rstd(const RowV& r) {
    float s = 0.f;
#pragma unroll
    for (int j = 0; j < 4; ++j) s += (r.v[j].x * r.v[j].x + r.v[j].y * r.v[j].y) + (r.v[j].z * r.v[j].z + r.v[j].w * r.v[j].w);
    s = wave_sum(s);
    return __builtin_amdgcn_rsqf(s * (1.0f / 1024.0f) + EPS);
}
__device__ __forceinline__ void row_modulate(RowV& r, float rstd, const float* g, const float* sh, const float* sc, int lane) {
#pragma unroll
    for (int j = 0; j < 4; ++j) {
        const int o = 4 * lane + 256 * j;
        const f32x4 gg = *(const f32x4*)(g + o), s = *(const f32x4*)(sc + o), h = *(const f32x4*)(sh + o);
        r.v[j] = (r.v[j] * rstd * gg) * (s + 1.0f) + h;
    }
}
struct ModV { f32x4 gp[4], sh[4]; };
__device__ __forceinline__ void mod_load(ModV& m, const float* g, const float* sh, const float* sc, int lane) {
#pragma unroll
    for (int j = 0; j < 4; ++j) { const int o = 4 * lane + 256 * j; m.gp[j] = *(const f32x4*)(g + o) * (*(const f32x4*)(sc + o) + 1.0f); m.sh[j] = *(const f32x4*)(sh + o); }
}
__device__ __forceinline__ void row_apply(RowV& r, float rstd, const ModV& m) {
#pragma unroll
    for (int j = 0; j < 4; ++j) r.v[j] = (r.v[j] * rstd) * m.gp[j] + m.sh[j];
}
__device__ __forceinline__ void row_store_bf16(const RowV& r, bf16_t* out, int lane) {
#pragma unroll
    for (int j = 0; j < 4; ++j) { u32x2 w; w.x = pg8::cvt_pk_bf16(r.v[j].x, r.v[j].y); w.y = pg8::cvt_pk_bf16(r.v[j].z, r.v[j].w); *(u32x2*)(out + 4 * lane + 256 * j) = w; }
}
__device__ __forceinline__ void row_store_f32(const RowV& r, float* out, int lane) {
#pragma unroll
    for (int j = 0; j < 4; ++j) *(f32x4*)(out + 4 * lane + 256 * j) = r.v[j];
}

__device__ __forceinline__ int wmap(int code, int n) {
    if (code == 1) { const int isU = n >> 10, ch = n & 1023; return (ch >> 7) * 256 + isU * 128 + (ch & 127); }
    if (code == 2) { const int typ = (n % 1536) / 512, d = n & 63; return (typ < 2 && d >= 4 && d < 12) ? (d < 8 ? n + 4 : n - 4) : n; }
    if (code == 3) return (n >> 7) * 256 + (n & 127);
    if (code == 4) return (n >> 7) * 256 + 128 + (n & 127);
    return n;
}
struct ConvDesc { const float* src; bf16_t* dst; int ldw, K, code, nloc; };
__device__ __forceinline__ void conv_desc(ConvDesc& d, const float* W, int ldw, int ncol0, bf16_t* WT, int K, int code, int kb, int nb) {
    d.src = W + (size_t)(64 * kb) * ldw + ncol0 + 64 * nb; d.dst = WT + 64 * kb; d.ldw = ldw; d.K = K; d.code = code; d.nloc = 64 * nb;
}
__device__ __forceinline__ void conv_load(f32x4 (&v)[16], const ConvDesc& d, int lane) {
    const float* src = d.src + (size_t)(lane >> 4) * d.ldw + (lane & 15) * 4;
#pragma unroll
    for (int i = 0; i < 16; ++i) v[i] = ntload((const f32x4*)(src + (size_t)(4 * i) * d.ldw));
}
__device__ __forceinline__ void conv_process(const f32x4 (&v)[16], const ConvDesc& d, LAS float* scr, int lane) {
#pragma unroll
    for (int i = 0; i < 16; ++i) { LAS float* p = scr + (4 * i + (lane >> 4)) * 65 + (lane & 15) * 4; p[0] = v[i].x; p[1] = v[i].y; p[2] = v[i].z; p[3] = v[i].w; }
    LDS_WAIT();
    const int c = lane & 7;
#pragma unroll
    for (int j = 0; j < 8; ++j) { const int n = (lane >> 3) + 8 * j; const LAS float* sp = scr + (8 * c) * 65 + n;
        u32x4 o; o.x = pg8::cvt_pk_bf16(sp[0 * 65], sp[1 * 65]); o.y = pg8::cvt_pk_bf16(sp[2 * 65], sp[3 * 65]); o.z = pg8::cvt_pk_bf16(sp[4 * 65], sp[5 * 65]); o.w = pg8::cvt_pk_bf16(sp[6 * 65], sp[7 * 65]);
        *(u32x4*)(d.dst + (size_t)wmap(d.code, d.nloc + n) * d.K + 8 * c) = o; }
    LDS_WAIT();
}
constexpr int NCONV_ITEMS = 512 + 256 + 256 + 1152 + 128 + 64 * 384;

namespace att {
typedef short bf16x8 __attribute__((ext_vector_type(8)));
typedef short s16x4 __attribute__((ext_vector_type(4)));
typedef float f32x16 __attribute__((ext_vector_type(16)));
constexpr int NKEY = 384, KOFF = 0, KCH = NKEY * 16 + 16  , VOFF = 8 * KCH, VDH = (NKEY / 16) * 1024 + 64  , NUNITS = 16 * 3 * 16 * 8;
__device__ __forceinline__ int crow(int r, int hi) { return (r & 3) + 8 * (r >> 2) + 4 * hi; }
__device__ __forceinline__ s16x4 vtr(const LAS unsigned char* p) { return __builtin_bit_cast(s16x4, __builtin_amdgcn_ds_read_tr16_b64_v4i16((LAS s16x4*)p)); }
__device__ __forceinline__ float xhalf_max(float m) { auto rr = __builtin_amdgcn_permlane32_swap(__float_as_uint(m), __float_as_uint(m), false, false); return fmaxf(__uint_as_float(rr[0]), __uint_as_float(rr[1])); }
__device__ __forceinline__ float xhalf_sum(float m) { auto rr = __builtin_amdgcn_permlane32_swap(__float_as_uint(m), __float_as_uint(m), false, false); return __uint_as_float(rr[0]) + __uint_as_float(rr[1]); }

template <typename P> __device__ __forceinline__ P sadd(P base, unsigned off) { asm volatile("" : "+v"(off)); return base + off; }
struct AUnit { int h, g, b, dil, l0, r0; size_t tb; };
template <bool MERGE> __device__ __forceinline__ void adecode(AUnit& u, int idx) {
    const int sb = ((idx >> 4) & 7) * 2 + (idx & 1), bg = idx >> 7; u.b = MERGE ? bg : (bg >> 1);
    u.h = (idx >> 1) & 7; u.g = MERGE ? 2 : (bg & 1); const int dsh = 2 * u.g; u.dil = 1 << dsh;
    const int bps = 16 >> dsh, r = sb / bps; u.l0 = (sb - r * bps) * 256; u.r0 = r << (12 - dsh); u.tb = (size_t)u.b * SEQ + r;
}
__device__ __forceinline__ void aload_kv(u32x4 (&kv)[12], const AUnit& u, const bf16_t* qkv, int wave, int lane) {
    const char* kb = (const char*)(qkv + qkv_block(1, u.g, u.b, u.h) + (size_t)u.r0 * 64); const char* vb = kb + (qkv_block(2, 0, 0, 0) - qkv_block(1, 0, 0, 0)) * 2;
#pragma unroll
    for (int i = 0; i < 6; ++i) {
        int sp = u.l0 - 128 + 48 * wave + 8 * i + (lane >> 3); sp = sp < 0 ? 0 : sp;
        const unsigned ro = (unsigned)sp * 128u + (unsigned)(lane & 7) * 16u;
        kv[i] = *(const u32x4*)sadd(kb, ro); kv[6 + i] = *(const u32x4*)sadd(vb, ro);
    }
}
__device__ __forceinline__ void astore_kv(const u32x4 (&kv)[12], LAS unsigned char* lds, int wave, int lane) {
#pragma unroll
    for (int i = 0; i < 6; ++i) { const int key = 48 * wave + 8 * i + (lane >> 3);
        *(LAS u32x4*)(lds + KOFF + (lane & 7) * KCH + key * 16) = kv[i];
        *(LAS u32x4*)(lds + VOFF + ((lane & 7) >> 2) * VDH + (key >> 4) * 1024 + (key & 15) * 64 + (lane & 3) * 16) = kv[6 + i]; }
}
__device__ __forceinline__ char* aqrow(const AUnit& u, bf16_t* qkv, int wave) {
    return (char*)(qkv + qkv_block(0, u.g, u.b, u.h) + (size_t)(u.r0 + u.l0 + 32 * wave) * 64);
}

template <bool MERGE> __device__ __forceinline__ void attn_phase(LAS unsigned char* lds, bf16_t* qkv, float* lse, bf16_t* ob, int bid, int G, int wave, bool dry = false) {
    constexpr int NU = MERGE ? NUNITS / 3 : 2 * NUNITS / 3;
    const int per = (NU + G - 1) / G;
    const int u_lo = bid * per, u_hi = (u_lo + per < NU) ? u_lo + per : NU;
    asm volatile("" : "+s"(wave));
    const int lane = lane_id(), r32 = lane & 31, hi = lane >> 5;
    const int qt = wave;
    const unsigned qlo = (unsigned)r32 * 128u + (unsigned)hi * 16u;
    u32x4 kv[12]; bf16x8 qn[4];
    AUnit un;
    if (u_lo < u_hi) { adecode<MERGE>(un, u_lo); aload_kv(kv, un, qkv, wave, lane);
        { const char* q = aqrow(un, qkv, wave);
#pragma unroll
            for (int d0 = 0; d0 < 4; ++d0) qn[d0] = *(const bf16x8*)(sadd(q, qlo) + d0 * 32); } }
#pragma unroll 1
    for (int idx = u_lo; idx < u_hi; ++idx) {
        const AUnit u = un;
        const int g = u.g, l0 = u.l0, head = u.h;
        char* qrow = aqrow(u, qkv, wave);
        const size_t tqw = u.tb + (size_t)(l0 + 32 * qt) * u.dil;
        bf16x8 qf[4];
        astore_kv(kv, lds, wave, lane);
#pragma unroll
        for (int d0 = 0; d0 < 4; ++d0) qf[d0] = qn[d0];
        __syncthreads();
        if (idx + 1 < u_hi) { adecode<MERGE>(un, idx + 1); aload_kv(kv, un, qkv, wave, lane);
            { const char* q = aqrow(un, qkv, wave);
#pragma unroll
                for (int d0 = 0; d0 < 4; ++d0) qn[d0] = *(const bf16x8*)(sadd(q, qlo) + d0 * 32); } }
        u32x2 og[MERGE ? 2 : 1][2][4]; float lg0 = 0.f, lg1 = 0.f;
        if constexpr (MERGE) {
            const int pq = (int)(tqw & (SEQ - 1)) + r32 * u.dil; const char* oq0 = (const char*)(qkv + qkv_block(0, 0, u.b, head)); const char* oq1 = (const char*)(qkv + qkv_block(0, 1, u.b, head));
            const unsigned oo0 = (unsigned)qkv_row(pq, 0) * 128u + 8u * hi, oo1 = (unsigned)qkv_row(pq, 1) * 128u + 8u * hi;
#pragma unroll
            for (int gg = 0; gg < 2; ++gg)
#pragma unroll
                for (int d0 = 0; d0 < 2; ++d0)
#pragma unroll
                    for (int rg = 0; rg < 4; ++rg) og[gg][d0][rg] = *(const u32x2*)(sadd(gg ? oq1 : oq0, gg ? oo1 : oo0) + (d0 * 64 + 16 * rg));
            const char* lb = (const char*)(lse + tqw * 24 + head); const unsigned lo_ = (unsigned)(r32 * u.dil) * 96u;
            lg0 = *(const float*)sadd(lb, lo_); lg1 = *(const float*)(sadd(lb, lo_) + 32);
        }
        f32x16 p[5];
        const LAS unsigned char* kb = lds + KOFF + hi * KCH + (qt * 32 + r32) * 16;
#pragma unroll
        for (int j = 0; j < 5; ++j) {
#pragma unroll
            for (int rr = 0; rr < 16; ++rr) p[j][rr] = 0.f;
#pragma unroll
            for (int d0 = 0; d0 < 4; ++d0) {
                const bf16x8 kf = *(const LAS bf16x8*)(kb + j * 512 + d0 * 2 * KCH);
                p[j] = __builtin_amdgcn_mfma_f32_32x32x16_bf16(kf, qf[d0], p[j], 0, 0, 0);
            }
        }
#pragma unroll
        for (int rr = 0; rr < 16; ++rr) { const int c = crow(rr, hi); if (c < r32) p[0][rr] = -INFINITY; if (c > r32) p[4][rr] = -INFINITY; }
        if (l0 == 0) {
#pragma unroll
            for (int j = 0; j < 5; ++j)
#pragma unroll
                for (int rr = 0; rr < 16; ++rr) if (32 * (qt + j) + crow(rr, hi) < 128) p[j][rr] = -INFINITY;
        }
        float m = p[0][0];
#pragma unroll
        for (int j = 0; j < 5; ++j)
#pragma unroll
            for (int rr = 0; rr < 16; ++rr) m = fmaxf(m, p[j][rr]);
        m = xhalf_max(m);
        float l = 0.f;
#pragma unroll
        for (int j = 0; j < 5; ++j)
#pragma unroll
            for (int rr = 0; rr < 16; ++rr) { const float e = __builtin_amdgcn_exp2f(p[j][rr] - m); p[j][rr] = e; l += e; }
        l = xhalf_sum(l);
        f32x16 o[2];
#pragma unroll
        for (int rr = 0; rr < 16; ++rr) { o[0][rr] = 0.f; o[1][rr] = 0.f; }
        const LAS unsigned char* vb = lds + VOFF + ((lane >> 4) & 1) * 32 + (lane & 3) * 8 + (4 * hi + ((lane & 15) >> 2)) * 64 + qt * 2048;
#pragma unroll
        for (int j = 0; j < 5; ++j)
#pragma unroll
            for (int s = 0; s < 2; ++s) {
                u32x4 pw; pw.x = pg8::cvt_pk_bf16(p[j][8 * s + 0], p[j][8 * s + 1]); pw.y = pg8::cvt_pk_bf16(p[j][8 * s + 2], p[j][8 * s + 3]);
                pw.z = pg8::cvt_pk_bf16(p[j][8 * s + 4], p[j][8 * s + 5]); pw.w = pg8::cvt_pk_bf16(p[j][8 * s + 6], p[j][8 * s + 7]);
                const bf16x8 pf = __builtin_bit_cast(bf16x8, pw);
#pragma unroll
                for (int d0 = 0; d0 < 2; ++d0) {
                    const s16x4 vlo = vtr(vb + d0 * VDH + (2 * j + s) * 1024), vhi = vtr(vb + d0 * VDH + (2 * j + s) * 1024 + 512);
                    const bf16x8 vf = {vlo[0], vlo[1], vlo[2], vlo[3], vhi[0], vhi[1], vhi[2], vhi[3]};
                    o[d0] = __builtin_amdgcn_mfma_f32_32x32x16_bf16(vf, pf, o[d0], 0, 0, 0);
                }
            }
        if constexpr (!MERGE) {
            const float inv = 1.0f / l;
#pragma unroll
            for (int d0 = 0; d0 < 2; ++d0)
#pragma unroll
                for (int rg = 0; rg < 4; ++rg) {
                    u32x2 w; w.x = pg8::cvt_pk_bf16(o[d0][4 * rg] * inv, o[d0][4 * rg + 1] * inv); w.y = pg8::cvt_pk_bf16(o[d0][4 * rg + 2] * inv, o[d0][4 * rg + 3] * inv);
                    if (!dry) *(u32x2*)(sadd(qrow, (unsigned)r32 * 128u + 8u * hi) + (d0 * 64 + 16 * rg)) = w; else asm volatile("" :: "v"(w.x), "v"(w.y));
                }
            if (hi == 0 && !dry) *(float*)((char*)(lse + tqw * 24 + g * 8 + head) + (unsigned)(r32 * u.dil) * 96u) = m + __builtin_amdgcn_logf(l);
        } else {
            const float lg2 = m + __builtin_amdgcn_logf(l), mx = fmaxf(lg2, fmaxf(lg0, lg1));
            const float w0 = __builtin_amdgcn_exp2f(lg0 - mx), w1 = __builtin_amdgcn_exp2f(lg1 - mx), w2 = __builtin_amdgcn_exp2f(lg2 - mx);
            const float iw = 1.0f / (w0 + w1 + w2), c0 = w0 * iw, c1 = w1 * iw, c2 = w2 * iw / l;
            char* orow = (char*)(ob + tqw * 512 + head * 64); const unsigned oro = (unsigned)(r32 * u.dil) * 1024u + 8u * hi;
#pragma unroll
            for (int d0 = 0; d0 < 2; ++d0)
#pragma unroll
                for (int rg = 0; rg < 4; ++rg) {
                    const u32x2 a = og[0][d0][rg], b = og[1][d0][rg];
                    u32x2 w; w.x = pg8::cvt_pk_bf16(c0 * bflo(a.x) + c1 * bflo(b.x) + c2 * o[d0][4 * rg], c0 * bfhi(a.x) + c1 * bfhi(b.x) + c2 * o[d0][4 * rg + 1]);
                    w.y = pg8::cvt_pk_bf16(c0 * bflo(a.y) + c1 * bflo(b.y) + c2 * o[d0][4 * rg + 2], c0 * bfhi(a.y) + c1 * bfhi(b.y) + c2 * o[d0][4 * rg + 3]);
                    if (!dry) *(u32x2*)(sadd(orow, oro) + (d0 * 64 + 16 * rg)) = w; else asm volatile("" :: "v"(w.x), "v"(w.y));
                }
        }
        __syncthreads();
    }
}
}

typedef const __attribute__((address_space(4))) unsigned long long* kargp_t;
__device__ __forceinline__ kargp_t karg() { kargp_t p = (kargp_t)__builtin_amdgcn_kernarg_segment_ptr(); asm volatile("" : "+s"(p)); return p; }
#define KIN(i) ((const float*)(GAS const float*)karg()[i])
#define KOUT() ((float*)(GAS float*)karg()[19])
#define KWS() ((unsigned char*)(GAS unsigned char*)karg()[20])
#define WSP(type, off) ((type*)(KWS() + (off)))
struct Args { const float* in[19]; float* out; unsigned char* ws; int ph_lo, ph_hi; };
constexpr int NPHASE = 17;

__global__ void __launch_bounds__(NWAVES * 64, 2) mk_fwd(Args args) {
    extern __shared__ __attribute__((aligned(16))) unsigned char lds_raw[];
    LAS unsigned char* lds = (LAS unsigned char*)lds_raw;
    volatile LAS unsigned* MISC = (volatile LAS unsigned*)(lds + MISC_OFF);
    LAS int* rb = (LAS int*)(lds + MISC_OFF);
    const int wave = __builtin_amdgcn_readfirstlane((int)threadIdx.x >> 6);
#define IDS() const int lane = lane_id(), tid = wave * 64 + lane; (void)tid; (void)lane
    const int G = gridDim.x, bid = blockIdx.x;
    for (int u = threadIdx.x; u < (LDS_BYTES - MISC_OFF) / 4; u += NWAVES * 64) MISC[u] = 0u;
    __syncthreads();
#if MK_ONE_LAUNCH
    XcdBarrier bar = xcd_barrier_post((unsigned*)(KWS() + WS_CTL) + CW_BAR, MISC + 40, wave);
#define GRID_BAR() xcd_barrier(bar, wave)
#else
#define GRID_BAR() do { } while (0)
#endif
#if MK_ONE_LAUNCH
    constexpr int lo = 0, hi = NPHASE; (void)args;
#else
    const int lo = args.ph_lo, hi = args.ph_hi;
#endif
#ifndef PHMASK
#define PHMASK 0xFFFFFFFFu
#endif
#define IN(k) ((((PHMASK) >> (k)) & 1u) && lo <= (k) && (k) < hi)
#ifndef REPMASK
#define REPMASK 0u
#endif
#define REPS(k) ((((REPMASK) >> (k)) & 1u) ? 2 : 1)
#define SEAM(k) do { if (IN(k) && IN((k) + 1)) GRID_BAR(); } while (0)

    for (int rep_ = 0; rep_ < REPS(0); ++rep_) if (IN(0)) { IDS();
        const float* cin = KIN(1); const float* ada_w = KIN(4); const float* ada_b = KIN(5); float* mod = WSP(float, WS_MOD); float* rope = WSP(float, WS_ROPE);
        LAS float* cact = (LAS float*)lds; LAS float* red = cact + 16384;
        if (bid < 192) for (int i = tid; i < 16 * 1024; i += 512) { const float v = cin[i]; cact[i] = v / (1.f + expf(-v)); }
        __syncthreads();
        for (int item = bid; item < 192; item += G) {
            const int l = item / 96, n0 = (item % 96) * 64, kk = lane >> 4, n4 = lane & 15;
            f32x4 acc[16];
#pragma unroll
            for (int b = 0; b < 16; ++b) acc[b] = (f32x4){0.f, 0.f, 0.f, 0.f};
            const float* w = ada_w + (size_t)l * 1024 * 6144 + n0 + n4 * 4;
#pragma unroll 1
            for (int kb = 0; kb < 2; ++kb) {
                const int k0 = wave * 128 + kb * 64 + kk;
                f32x4 wv[16];
#pragma unroll
                for (int u = 0; u < 16; ++u) wv[u] = *(const f32x4*)(w + (size_t)(k0 + 4 * u) * 6144);
#pragma unroll
                for (int u = 0; u < 16; ++u)
#pragma unroll
                    for (int b = 0; b < 16; ++b) acc[b] += wv[u] * cact[b * 1024 + k0 + 4 * u];
            }
            const bool h5 = (lane & 32) != 0;
#pragma unroll
            for (int b = 0; b < 16; ++b)
#pragma unroll
                for (int c = 0; c < 4; ++c) { float v = acc[b][c]; v += xlane<16>(v); v += xlane32(v, h5); acc[b][c] = v; }
            if (lane < 16) {
#pragma unroll
                for (int b = 0; b < 16; ++b) *(LAS f32x4*)(red + (wave * 16 + b) * 64 + n4 * 4) = acc[b];
            }
            __syncthreads();
            for (int i = tid; i < 1024; i += 512) {
                const int b = i >> 6, nn = i & 63; float s = 0.f;
#pragma unroll
                for (int q = 0; q < 8; ++q) s += red[(q * 16 + b) * 64 + nn];
                mod[((size_t)l * 16 + b) * 6144 + n0 + nn] = s + ada_b[l * 6144 + n0 + nn];
            }
            __syncthreads();
        }
        for (int i = bid * 512 + tid; i < 4096 * 8; i += G * 512) {
            const int t = i >> 3, f = i & 7;
            const float inv = powf(500000.0f, -(float)(2 * f) / 16.0f);
            const float ang = (float)t * inv;
            rope[i] = (float)cos((double)ang);
            rope[4096 * 8 + i] = (float)sin((double)ang);
        }
    }
    SEAM(0);
    for (int rep_ = 0; rep_ < REPS(1); ++rep_) if (IN(1)) { IDS();
        {
        LAS float* scr = (LAS float*)(lds + wave * 16640);
        const float* conv_in_w = KIN(6); const float* conv_out_w = KIN(8); const float* attn_in_w = KIN(9); const float* attn_out_w = KIN(10);
        const float* gate_w = KIN(15); const float* up_w = KIN(16); const float* down_w = KIN(17);
        bf16_t* WZ = WSP(bf16_t, WS_WZ); bf16_t* WB = WSP(bf16_t, WS_WB); bf16_t* WCO = WSP(bf16_t, WS_WCO); bf16_t* WAI = WSP(bf16_t, WS_WAI); bf16_t* WAO = WSP(bf16_t, WS_WAO);
        bf16_t* WGU = WSP(bf16_t, WS_WGU); bf16_t* WDN = WSP(bf16_t, WS_WDN);
#define CONV_DECODE(DD, IT) do { int it = (IT); \
            if (it < 512) { conv_desc(DD, conv_in_w, 3072, 1024, WZ, 1024, 1, it / 32, it % 32); break; } it -= 512; \
            if (it < 256) { conv_desc(DD, conv_in_w, 3072, 0, WB, 1024, 0, it / 16, it % 16); break; } it -= 256; \
            if (it < 256) { conv_desc(DD, conv_out_w, 1024, 0, WCO, 1024, 0, it / 16, it % 16); break; } it -= 256; \
            if (it < 1152) { conv_desc(DD, attn_in_w, QKVW, 0, WAI, 1024, 2, it / 72, it % 72); break; } it -= 1152; \
            if (it < 128) { conv_desc(DD, attn_out_w, 1024, 0, WAO, 512, 0, it / 16, it % 16); break; } it -= 128; \
            const int le = it / 384, r = it % 384; \
            if (r < 128) conv_desc(DD, gate_w + (size_t)le * D * DEXP, DEXP, 0, WGU + (size_t)le * 1024 * 1024, 1024, 3, r / 8, r % 8); \
            else if (r < 256) conv_desc(DD, up_w + (size_t)le * D * DEXP, DEXP, 0, WGU + (size_t)le * 1024 * 1024, 1024, 4, (r - 128) / 8, (r - 128) % 8); \
            else conv_desc(DD, down_w + (size_t)le * DEXP * D, D, 0, WDN + (size_t)le * 1024 * 512, 512, 0, (r - 256) / 16, (r - 256) % 16); } while (0)
        {
            const int step = G * NWAVES; int it0 = bid * NWAVES + wave;
            ConvDesc dA, dB; f32x4 vA[16], vB[16];
            if (it0 < NCONV_ITEMS) { CONV_DECODE(dA, it0); conv_load(vA, dA, lane); }
#pragma unroll 1
            for (; it0 < NCONV_ITEMS; it0 += 2 * step) {
                const bool hasB = it0 + step < NCONV_ITEMS, hasA2 = it0 + 2 * step < NCONV_ITEMS;
                if (hasB) { CONV_DECODE(dB, it0 + step); conv_load(vB, dB, lane); }
                conv_process(vA, dA, scr, lane);
                if (hasA2) { CONV_DECODE(dA, it0 + 2 * step); conv_load(vA, dA, lane); }
                if (hasB) conv_process(vB, dB, scr, lane);
            }
        }
#undef CONV_DECODE
        }
        const float* x = KIN(0); const float* norm_mix_g = KIN(2); const float* mod = WSP(float, WS_MOD); bf16_t* xn = WSP(bf16_t, WS_XN);
        for (int w0 = (bid * 8 + wave) * 32; w0 < T; w0 += G * 8 * 32) {
            const float* mb = mod + (size_t)(w0 >> 12) * 6144;
            ModV mv; mod_load(mv, norm_mix_g, mb + 0, mb + 1024, lane);
            RowV ring[4];
#pragma unroll
            for (int d = 0; d < 4; ++d) row_load(ring[d], x + (size_t)(w0 + d) * D, lane);
#pragma unroll 1
            for (int i = 0; i < 32; i += 4) {
#pragma unroll
                for (int d = 0; d < 4; ++d) {
                    const int row = w0 + i + d;
                    RowV r = ring[d];
                    if (i < 28) row_load(ring[d], x + (size_t)(row + 4) * D, lane);
                    const float rstd = row_rstd(r);
                    row_apply(r, rstd, mv);
                    row_store_bf16(r, xn + (size_t)row * D, lane);
                }
            }
        }
    }
    SEAM(1);
    for (int rep_ = 0; rep_ < REPS(2); ++rep_) if (IN(2)) { bf16_t* xn = WSP(bf16_t, WS_XN); bf16_t* WZ = WSP(bf16_t, WS_WZ); bf16_t* zb = WSP(bf16_t, WS_Z);
        pg8::Gemm g{xn, WZ, T, 2048, 1024}; pg8::StaticOrder S; S.init(T, 2048, G, bid); pg8::EpiPair<false> E{zb, D};
        pg8::gemm_phase<pg8::EpiPair<false>, pg8::StaticOrder, pg8::APlain, true, true>(lds, g, S, E, pg8::APlain{}, wave); }
    SEAM(2);
    for (int rep_ = 0; rep_ < REPS(3); ++rep_) if (IN(3)) { bf16_t* xn = WSP(bf16_t, WS_XN); bf16_t* WB = WSP(bf16_t, WS_WB); bf16_t* zb = WSP(bf16_t, WS_Z); bf16_t* ypre = WSP(bf16_t, WS_YPRE); const float* conv_w = KIN(7);
        pg8::Gemm g{xn, WB, T, 1024, 1024}; pg8::StaticOrder S; S.init(T, 1024, G, bid); pg8::EpiYpre E{ypre, zb, conv_w};
        pg8::gemm_phase<pg8::EpiYpre, pg8::StaticOrder, pg8::APlain, true, true>(lds, g, S, E, pg8::APlain{}, wave); }
    SEAM(3);
    for (int rep_ = 0; rep_ < REPS(4); ++rep_) if (IN(4)) { bf16_t* ypre = WSP(bf16_t, WS_YPRE); bf16_t* WCO = WSP(bf16_t, WS_WCO); bf16_t* xr = (bf16_t*)KOUT(); const float* x = KIN(0); const float* mod = WSP(float, WS_MOD);
        pg8::Gemm g{ypre, WCO, T, 1024, 1024}; pg8::StaticOrder S; S.init(T, 1024, G, bid); pg8::EpiRes<true> E{xr, x, mod + 2048};
        pg8::gemm_phase<pg8::EpiRes<true>, pg8::StaticOrder, pg8::APlain, true, true>(lds, g, S, E, pg8::APlain{}, wave); }
    SEAM(4);
    { constexpr int l = 0;
        const int pb0 = (l == 0) ? 5 : 13;
#define MODL() (WSP(float, WS_MOD) + (size_t)l * 16 * 6144)
#define CNTL() (WSP(int, WS_CTL) + 64 * l)
        if (l == 1) {
#ifdef STAGGER9
            if (IN(9)) { const unsigned long long t0_ = __builtin_amdgcn_s_memrealtime(); const unsigned long long dl_ = (unsigned long long)(((bid >> 3) & 31) * STAGGER9 / 32);
                while (__builtin_amdgcn_s_memrealtime() - t0_ < dl_) __builtin_amdgcn_s_sleep(16); }
#endif
            for (int rep_ = 0; rep_ < REPS(9); ++rep_) if (IN(9)) { bf16_t* xn = WSP(bf16_t, WS_XN); bf16_t* WAI = WSP(bf16_t, WS_WAI); bf16_t* qkv = WSP(bf16_t, WS_QKV); const float* rope = WSP(float, WS_ROPE);
                pg8::Gemm g{xn, WAI, T, QKVW, 1024}; pg8::StaticOrder S; S.init(T, QKVW, G, bid, 8); pg8::EpiQKV E{qkv, rope, 0};
                pg8::gemm_phase<pg8::EpiQKV, pg8::StaticOrder, pg8::APlain, true, true>(lds, g, S, E, pg8::APlain{}, wave); }
            SEAM(9);
            if (IN(10)) att::attn_phase<false>(lds, WSP(bf16_t, WS_QKV), WSP(float, WS_LSE), WSP(bf16_t, WS_XN), bid, G, wave);
            SEAM(10);
            if (IN(11)) att::attn_phase<true>(lds, WSP(bf16_t, WS_QKV), WSP(float, WS_LSE), WSP(bf16_t, WS_XN), bid, G, wave);
            SEAM(11);
            if (IN(12)) { bf16_t* ob = WSP(bf16_t, WS_XN); bf16_t* WAO = WSP(bf16_t, WS_WAO); bf16_t* xr = (bf16_t*)KOUT();
                pg8::Gemm g{ob, WAO, T, 1024, 512}; pg8::StaticOrder S; S.init(T, 1024, G, bid); pg8::EpiRes<false> E{xr, nullptr, MODL() + 2048};
                pg8::gemm_phase<pg8::EpiRes<false>, pg8::StaticOrder, pg8::APlain, true, true>(lds, g, S, E, pg8::APlain{}, wave); }
            SEAM(12);
        }
        for (int rep_ = 0; rep_ < REPS(5); ++rep_) if (IN(pb0)) { IDS(); const bool dry = rep_ + 1 < REPS(5);
            LAS f32x4* TG = (LAS f32x4*)lds; LAS f32x4* TE = (LAS f32x4*)(lds + 16384);
            LAS int* rec_e = (LAS int*)(lds + 147456); LAS float* rec_w = (LAS float*)(lds + 147456 + 2048); LAS int* rec_rank = (LAS int*)(lds + 147456 + 4096);
            LAS int* hist = (LAS int*)(lds + 147456 + 6144); LAS int* base = (LAS int*)(lds + 147456 + 6144 + 128);
            const float* gff = KIN(3) + l * D; const float* wg = KIN(11) + (size_t)l * D * 4; const float* bg = KIN(12) + l * 4; const float* we = KIN(13) + (size_t)l * 4 * D * 8; const float* be = KIN(14) + l * 32;
            const bf16_t* xr = (const bf16_t*)KOUT(); const float* modl = MODL(); int* cntl = CNTL(); bf16_t* xn = WSP(bf16_t, WS_XN); int* ltok = WSP(int, WS_LTOK); float* lw = WSP(float, WS_LW); int* tslot = WSP(int, WS_TSLOT);
            for (int i = tid; i < 1024; i += 512) { const int ln = i & 63, jc = i >> 6, k = 4 * ln + 256 * (jc >> 2) + (jc & 3); TG[i] = *(const f32x4*)(wg + (size_t)k * 4); }
            for (int i = tid; i < 8192; i += 512) { const int ln = i & 63, jc = (i >> 6) & 15, half = (i >> 10) & 1, gi = i >> 11, k = 4 * ln + 256 * (jc >> 2) + (jc & 3);
                TE[i] = *(const f32x4*)(we + ((size_t)gi * 1024 + k) * 8 + half * 4); }
            __syncthreads();
            const bool h5 = (lane & 32) != 0, h4 = (lane & 16) != 0, h3 = (lane & 8) != 0;
            for (int blk = bid; blk < T / 256; blk += G) {
                if (tid < 32) hist[tid] = 0;
                __syncthreads();
                ModV mv; { const float* mb = modl + (size_t)((blk * 256) >> 12) * 6144; mod_load(mv, gff, mb + 3072, mb + 4096, lane); }
                u32x2 ring[4][4];
#pragma unroll
                for (int d = 0; d < 4; ++d)
#pragma unroll
                    for (int j = 0; j < 4; ++j) ring[d][j] = *(const u32x2*)(xr + (size_t)(blk * 256 + wave * 32 + d) * XRP + 4 * lane + 256 * j);
#pragma unroll 1
                for (int i4 = 0; i4 < 32; i4 += 4)
#pragma unroll
                for (int d = 0; d < 4; ++d) {
                    const int i = i4 + d, rl = wave * 32 + i, row = blk * 256 + rl;
                    RowV r;
#pragma unroll
                    for (int j = 0; j < 4; ++j) { const u32x2 w = ring[d][j]; r.v[j] = (f32x4){bflo(w.x), bfhi(w.x), bflo(w.y), bfhi(w.y)}; }
                    if (i4 < 28) {
#pragma unroll
                        for (int j = 0; j < 4; ++j) ring[d][j] = *(const u32x2*)(xr + (size_t)(row + 4) * XRP + 4 * lane + 256 * j); }
                    const float rstd = row_rstd(r);
                    row_apply(r, rstd, mv);
                    row_store_bf16(r, xn + (size_t)row * D, lane);
                    f32x4 pg = {0.f, 0.f, 0.f, 0.f};
#pragma unroll
                    for (int jc = 0; jc < 16; ++jc) pg += TG[jc * 64 + lane] * r.v[jc >> 2][jc & 3];
                    float gl[4];
                    { float b0 = (h5 ? pg.z : pg.x) + xlane32(h5 ? pg.x : pg.z, h5), b1 = (h5 ? pg.w : pg.y) + xlane32(h5 ? pg.y : pg.w, h5);
                      float c = (h4 ? b1 : b0) + xlane<16>(h4 ? b0 : b1);
                      c += xlane<8>(c); c += xlane<4>(c); c += xlane<2>(c); c += xlane<1>(c);
#pragma unroll
                      for (int o = 0; o < 4; ++o) gl[o] = __int_as_float(__builtin_amdgcn_readlane(__float_as_int(c), 16 * o)) + bg[o]; }
                    int gi = 0; float gm = gl[0];
#pragma unroll
                    for (int o = 1; o < 4; ++o) if (gl[o] > gm) { gm = gl[o]; gi = o; }
                    float gden = 0.f;
#pragma unroll
                    for (int o = 0; o < 4; ++o) gden += __builtin_amdgcn_exp2f((gl[o] - gm) * 1.4426950408889634f);
                    const float grp_p = __builtin_amdgcn_rcpf(gden);
                    f32x4 pa = {0.f, 0.f, 0.f, 0.f}, pb = {0.f, 0.f, 0.f, 0.f};
                    const LAS f32x4* te = TE + gi * 2048 + lane;
#pragma unroll
                    for (int jc = 0; jc < 16; ++jc) { const float hv = r.v[jc >> 2][jc & 3]; pa += te[jc * 64] * hv; pb += te[1024 + jc * 64] * hv; }
                    float el[8];
                    { const f32x4 keep = h5 ? pb : pa, send = h5 ? pa : pb;
                      f32x4 q; q.x = keep.x + xlane32(send.x, h5); q.y = keep.y + xlane32(send.y, h5); q.z = keep.z + xlane32(send.z, h5); q.w = keep.w + xlane32(send.w, h5);
                      const float b0 = (h4 ? q.z : q.x) + xlane<16>(h4 ? q.x : q.z), b1 = (h4 ? q.w : q.y) + xlane<16>(h4 ? q.y : q.w);
                      float c = (h3 ? b1 : b0) + xlane<8>(h3 ? b0 : b1);
                      c += xlane<4>(c); c += xlane<2>(c); c += xlane<1>(c);
#pragma unroll
                      for (int o = 0; o < 8; ++o) el[o] = __int_as_float(__builtin_amdgcn_readlane(__float_as_int(c), 8 * o)) + be[gi * 8 + o]; }
                    int i0 = 0; float m0 = el[0];
#pragma unroll
                    for (int o = 1; o < 8; ++o) if (el[o] > m0) { m0 = el[o]; i0 = o; }
                    int i1 = -1; float m1 = -INFINITY;
#pragma unroll
                    for (int o = 0; o < 8; ++o) if (o != i0 && el[o] > m1) { m1 = el[o]; i1 = o; }
                    const float p1 = __builtin_amdgcn_exp2f((m1 - m0) * 1.4426950408889634f), w0_ = grp_p * __builtin_amdgcn_rcpf(1.0f + p1);
                    if (lane == 0) { rec_e[rl * 2] = gi * 8 + i0; rec_e[rl * 2 + 1] = gi * 8 + i1; rec_w[rl * 2] = w0_; rec_w[rl * 2 + 1] = w0_ * p1; }
                }
                __syncthreads();
                { const int e = rec_e[tid]; rec_rank[tid] = atomicAdd((int*)&hist[e], 1); }
                __syncthreads();
                if (tid < 32) { const int h = hist[tid]; base[tid] = (h && !dry) ? atomicAdd(&cntl[tid], h) : 0; }
                __syncthreads();
                { const int e = rec_e[tid], pos = base[e] + rec_rank[tid], tok = blk * 256 + (tid >> 1);
                  if (!dry) { ltok[(size_t)e * LISTCAP + pos] = tok; lw[(size_t)e * LISTCAP + pos] = rec_w[tid]; tslot[tok * 2 + (tid & 1)] = (e << 16) | pos; } }
                __syncthreads();
            }
        }
        SEAM(pb0);
        if (IN(pb0 + 1) || IN(pb0 + 2) || IN(pb0 + 3)) {
            __syncthreads();
            if (wave == 0 && lane_id() == 0) { const int* cntl = CNTL(); int s = 0;
#pragma unroll 1
                for (int e = 0; e < 32; ++e) { rb[e] = s; s += (__hip_atomic_load(&cntl[e], RLX_AGENT) + 255) & ~255; }
                rb[32] = s; }
            __syncthreads();
        }
        for (int rep_ = 0; rep_ < REPS(6); ++rep_) if (IN(pb0 + 1)) { bf16_t* xn = WSP(bf16_t, WS_XN); bf16_t* WGU = WSP(bf16_t, WS_WGU); bf16_t* act = WSP(bf16_t, WS_ACT); const int* ltok = WSP(int, WS_LTOK); const int* cntl = CNTL();
            pg8::Gemm g{xn, WGU + (size_t)l * 32 * 1024 * 1024, 0, 0, 1024}; pg8::MoeOrder S; S.init(rb[32] / 256, G, bid, rb); pg8::EpiPair<true> E{act, DEXP}; pg8::AGather am{ltok, cntl, rb};
            pg8::gemm_phase<pg8::EpiPair<true>, pg8::MoeOrder, pg8::AGather, true, true>(lds, g, S, E, am, wave); }
        SEAM(pb0 + 1);
        for (int rep_ = 0; rep_ < REPS(7); ++rep_) if (IN(pb0 + 2)) { bf16_t* act = WSP(bf16_t, WS_ACT); bf16_t* WDN = WSP(bf16_t, WS_WDN); bf16_t* yw = WSP(bf16_t, WS_YW); const float* lw = WSP(float, WS_LW);
            pg8::Gemm g{act, WDN + (size_t)l * 32 * 1024 * 512, 0, 0, 512}; pg8::MoeOrder S; S.init(rb[32] / 256, G, bid, rb); pg8::EpiDown E{yw, lw, rb};
            pg8::gemm_phase<pg8::EpiDown, pg8::MoeOrder, pg8::APlain, true, true>(lds, g, S, E, pg8::APlain{}, wave); }
        SEAM(pb0 + 2);
        for (int rep_ = 0; rep_ < REPS(8); ++rep_) if (IN(pb0 + 3)) { IDS(); const bool dry = rep_ + 1 < REPS(8);
            const float* gnext = (l == 0) ? KIN(2) + D : KIN(18);
            const float* modn = WSP(float, WS_MOD) + (size_t)16 * 6144; const float* modl = MODL();
            float* outf = KOUT(); bf16_t* xr = (bf16_t*)KOUT(); const bf16_t* yw = WSP(bf16_t, WS_YW); const int* tslot = WSP(int, WS_TSLOT); bf16_t* xn = WSP(bf16_t, WS_XN);
            for (int w0 = (bid * 8 + wave) * 32; w0 < T; w0 += G * 8 * 32) {
                const int b = w0 >> 12;
                f32x4 g2v[4];
#pragma unroll
                for (int j = 0; j < 4; ++j) g2v[j] = *(const f32x4*)(modl + (size_t)b * 6144 + 5120 + 4 * lane + 256 * j);
                ModV mv;
                if (l == 0) { const float* mb = modn + (size_t)b * 6144; mod_load(mv, gnext, mb + 0, mb + 1024, lane); }
                else {
#pragma unroll
                    for (int j = 0; j < 4; ++j) { mv.gp[j] = *(const f32x4*)(gnext + 4 * lane + 256 * j); mv.sh[j] = (f32x4){0.f, 0.f, 0.f, 0.f}; }
                }
                const int slw = tslot[(size_t)w0 * 2 + lane];
                u32x2 xb[4][4], ya[4][4], yb[4][4];
#define R2_LOAD(D_, I_) do { const int s0_ = __builtin_amdgcn_readlane(slw, 2 * (I_)), s1_ = __builtin_amdgcn_readlane(slw, 2 * (I_) + 1); \
                    const size_t r0_ = (size_t)(rb[s0_ >> 16] + (s0_ & 0xffff)), r1_ = (size_t)(rb[s1_ >> 16] + (s1_ & 0xffff)); \
                    _Pragma("unroll") for (int j = 0; j < 4; ++j) { xb[D_][j] = *(const u32x2*)(xr + (size_t)(w0 + (I_)) * XRP + 4 * lane + 256 * j); \
                        ya[D_][j] = ntload((const u32x2*)(yw + r0_ * D + 4 * lane + 256 * j)); yb[D_][j] = ntload((const u32x2*)(yw + r1_ * D + 4 * lane + 256 * j)); } } while (0)
#pragma unroll
                for (int d = 0; d < 4; ++d) R2_LOAD(d, d);
#pragma unroll 1
                for (int i4 = 0; i4 < 32; i4 += 4)
#pragma unroll
                for (int d = 0; d < 4; ++d) {
                    const int i = i4 + d, row = w0 + i;
                    RowV r;
#pragma unroll
                    for (int j = 0; j < 4; ++j) {
                        const u32x2 xw = xb[d][j], a = ya[d][j], c = yb[d][j];
                        f32x4 y; y.x = bflo(a.x) + bflo(c.x); y.y = bfhi(a.x) + bfhi(c.x); y.z = bflo(a.y) + bflo(c.y); y.w = bfhi(a.y) + bfhi(c.y);
                        r.v[j] = (f32x4){bflo(xw.x), bfhi(xw.x), bflo(xw.y), bfhi(xw.y)} + g2v[j] * y;
                    }
                    if (i4 < 28) R2_LOAD(d, i + 4);
                    const float rstd = row_rstd(r);
                    if (dry) { asm volatile("" :: "v"(rstd), "v"(r.v[0].x), "v"(r.v[1].y), "v"(r.v[2].z), "v"(r.v[3].w)); }
                    else if (l == 1) { row_apply(r, rstd, mv); row_store_f32(r, outf + (size_t)row * D, lane); }
                    else { row_store_bf16(r, xr + (size_t)row * XRP, lane); row_apply(r, rstd, mv); row_store_bf16(r, xn + (size_t)row * D, lane); }
                }
#undef R2_LOAD
            }
        }
        SEAM(pb0 + 3);
    }
    { constexpr int l = 1;
        const int pb0 = (l == 0) ? 5 : 13;
#define MODL() (WSP(float, WS_MOD) + (size_t)l * 16 * 6144)
#define CNTL() (WSP(int, WS_CTL) + 64 * l)
        if (l == 1) {
#ifdef STAGGER9
            if (IN(9)) { const unsigned long long t0_ = __builtin_amdgcn_s_memrealtime(); const unsigned long long dl_ = (unsigned long long)(((bid >> 3) & 31) * STAGGER9 / 32);
                while (__builtin_amdgcn_s_memrealtime() - t0_ < dl_) __builtin_amdgcn_s_sleep(16); }
#endif
            for (int rep_ = 0; rep_ < REPS(9); ++rep_) if (IN(9)) { bf16_t* xn = WSP(bf16_t, WS_XN); bf16_t* WAI = WSP(bf16_t, WS_WAI); bf16_t* qkv = WSP(bf16_t, WS_QKV); const float* rope = WSP(float, WS_ROPE);
                pg8::Gemm g{xn, WAI, T, QKVW, 1024}; pg8::StaticOrder S; S.init(T, QKVW, G, bid, 8); pg8::EpiQKV E{qkv, rope, 0};
                pg8::gemm_phase<pg8::EpiQKV, pg8::StaticOrder, pg8::APlain, true, true>(lds, g, S, E, pg8::APlain{}, wave); }
            SEAM(9);
            if (IN(10)) att::attn_phase<false>(lds, WSP(bf16_t, WS_QKV), WSP(float, WS_LSE), WSP(bf16_t, WS_XN), bid, G, wave);
            SEAM(10);
            if (IN(11)) att::attn_phase<true>(lds, WSP(bf16_t, WS_QKV), WSP(float, WS_LSE), WSP(bf16_t, WS_XN), bid, G, wave);
            SEAM(11);
            if (IN(12)) { bf16_t* ob = WSP(bf16_t, WS_XN); bf16_t* WAO = WSP(bf16_t, WS_WAO); bf16_t* xr = (bf16_t*)KOUT();
                pg8::Gemm g{ob, WAO, T, 1024, 512}; pg8::StaticOrder S; S.init(T, 1024, G, bid); pg8::EpiRes<false> E{xr, nullptr, MODL() + 2048};
                pg8::gemm_phase<pg8::EpiRes<false>, pg8::StaticOrder, pg8::APlain, true, true>(lds, g, S, E, pg8::APlain{}, wave); }
            SEAM(12);
        }
        for (int rep_ = 0; rep_ < REPS(5); ++rep_) if (IN(pb0)) { IDS(); const bool dry = rep_ + 1 < REPS(5);
            LAS f32x4* TG = (LAS f32x4*)lds; LAS f32x4* TE = (LAS f32x4*)(lds + 16384);
            LAS int* rec_e = (LAS int*)(lds + 147456); LAS float* rec_w = (LAS float*)(lds + 147456 + 2048); LAS int* rec_rank = (LAS int*)(lds + 147456 + 4096);
            LAS int* hist = (LAS int*)(lds + 147456 + 6144); LAS int* base = (LAS int*)(lds + 147456 + 6144 + 128);
            const float* gff = KIN(3) + l * D; const float* wg = KIN(11) + (size_t)l * D * 4; const float* bg = KIN(12) + l * 4; const float* we = KIN(13) + (size_t)l * 4 * D * 8; const float* be = KIN(14) + l * 32;
            const bf16_t* xr = (const bf16_t*)KOUT(); const float* modl = MODL(); int* cntl = CNTL(); bf16_t* xn = WSP(bf16_t, WS_XN); int* ltok = WSP(int, WS_LTOK); float* lw = WSP(float, WS_LW); int* tslot = WSP(int, WS_TSLOT);
            for (int i = tid; i < 1024; i += 512) { const int ln = i & 63, jc = i >> 6, k = 4 * ln + 256 * (jc >> 2) + (jc & 3); TG[i] = *(const f32x4*)(wg + (size_t)k * 4); }
            for (int i = tid; i < 8192; i += 512) { const int ln = i & 63, jc = (i >> 6) & 15, half = (i >> 10) & 1, gi = i >> 11, k = 4 * ln + 256 * (jc >> 2) + (jc & 3);
                TE[i] = *(const f32x4*)(we + ((size_t)gi * 1024 + k) * 8 + half * 4); }
            __syncthreads();
            const bool h5 = (lane & 32) != 0, h4 = (lane & 16) != 0, h3 = (lane & 8) != 0;
            for (int blk = bid; blk < T / 256; blk += G) {
                if (tid < 32) hist[tid] = 0;
                __syncthreads();
                ModV mv; { const float* mb = modl + (size_t)((blk * 256) >> 12) * 6144; mod_load(mv, gff, mb + 3072, mb + 4096, lane); }
                u32x2 ring[4][4];
#pragma unroll
                for (int d = 0; d < 4; ++d)
#pragma unroll
                    for (int j = 0; j < 4; ++j) ring[d][j] = *(const u32x2*)(xr + (size_t)(blk * 256 + wave * 32 + d) * XRP + 4 * lane + 256 * j);
#pragma unroll 1
                for (int i4 = 0; i4 < 32; i4 += 4)
#pragma unroll
                for (int d = 0; d < 4; ++d) {
                    const int i = i4 + d, rl = wave * 32 + i, row = blk * 256 + rl;
                    RowV r;
#pragma unroll
                    for (int j = 0; j < 4; ++j) { const u32x2 w = ring[d][j]; r.v[j] = (f32x4){bflo(w.x), bfhi(w.x), bflo(w.y), bfhi(w.y)}; }
                    if (i4 < 28) {
#pragma unroll
                        for (int j = 0; j < 4; ++j) ring[d][j] = *(const u32x2*)(xr + (size_t)(row + 4) * XRP + 4 * lane + 256 * j); }
                    const float rstd = row_rstd(r);
                    row_apply(r, rstd, mv);
                    row_store_bf16(r, xn + (size_t)row * D, lane);
                    f32x4 pg = {0.f, 0.f, 0.f, 0.f};
#pragma unroll
                    for (int jc = 0; jc < 16; ++jc) pg += TG[jc * 64 + lane] * r.v[jc >> 2][jc & 3];
                    float gl[4];
                    { float b0 = (h5 ? pg.z : pg.x) + xlane32(h5 ? pg.x : pg.z, h5), b1 = (h5 ? pg.w : pg.y) + xlane32(h5 ? pg.y : pg.w, h5);
                      float c = (h4 ? b1 : b0) + xlane<16>(h4 ? b0 : b1);
                      c += xlane<8>(c); c += xlane<4>(c); c += xlane<2>(c); c += xlane<1>(c);
#pragma unroll
                      for (int o = 0; o < 4; ++o) gl[o] = __int_as_float(__builtin_amdgcn_readlane(__float_as_int(c), 16 * o)) + bg[o]; }
                    int gi = 0; float gm = gl[0];
#pragma unroll
                    for (int o = 1; o < 4; ++o) if (gl[o] > gm) { gm = gl[o]; gi = o; }
                    float gden = 0.f;
#pragma unroll
                    for (int o = 0; o < 4; ++o) gden += __builtin_amdgcn_exp2f((gl[o] - gm) * 1.4426950408889634f);
                    const float grp_p = __builtin_amdgcn_rcpf(gden);
                    f32x4 pa = {0.f, 0.f, 0.f, 0.f}, pb = {0.f, 0.f, 0.f, 0.f};
                    const LAS f32x4* te = TE + gi * 2048 + lane;
#pragma unroll
                    for (int jc = 0; jc < 16; ++jc) { const float hv = r.v[jc >> 2][jc & 3]; pa += te[jc * 64] * hv; pb += te[1024 + jc * 64] * hv; }
                    float el[8];
                    { const f32x4 keep = h5 ? pb : pa, send = h5 ? pa : pb;
                      f32x4 q; q.x = keep.x + xlane32(send.x, h5); q.y = keep.y + xlane32(send.y, h5); q.z = keep.z + xlane32(send.z, h5); q.w = keep.w + xlane32(send.w, h5);
                      const float b0 = (h4 ? q.z : q.x) + xlane<16>(h4 ? q.x : q.z), b1 = (h4 ? q.w : q.y) + xlane<16>(h4 ? q.y : q.w);
                      float c = (h3 ? b1 : b0) + xlane<8>(h3 ? b0 : b1);
                      c += xlane<4>(c); c += xlane<2>(c); c += xlane<1>(c);
#pragma unroll
                      for (int o = 0; o < 8; ++o) el[o] = __int_as_float(__builtin_amdgcn_readlane(__float_as_int(c), 8 * o)) + be[gi * 8 + o]; }
                    int i0 = 0; float m0 = el[0];
#pragma unroll
                    for (int o = 1; o < 8; ++o) if (el[o] > m0) { m0 = el[o]; i0 = o; }
                    int i1 = -1; float m1 = -INFINITY;
#pragma unroll
                    for (int o = 0; o < 8; ++o) if (o != i0 && el[o] > m1) { m1 = el[o]; i1 = o; }
                    const float p1 = __builtin_amdgcn_exp2f((m1 - m0) * 1.4426950408889634f), w0_ = grp_p * __builtin_amdgcn_rcpf(1.0f + p1);
                    if (lane == 0) { rec_e[rl * 2] = gi * 8 + i0; rec_e[rl * 2 + 1] = gi * 8 + i1; rec_w[rl * 2] = w0_; rec_w[rl * 2 + 1] = w0_ * p1; }
                }
                __syncthreads();
                { const int e = rec_e[tid]; rec_rank[tid] = atomicAdd((int*)&hist[e], 1); }
                __syncthreads();
                if (tid < 32) { const int h = hist[tid]; base[tid] = (h && !dry) ? atomicAdd(&cntl[tid], h) : 0; }
                __syncthreads();
                { const int e = rec_e[tid], pos = base[e] + rec_rank[tid], tok = blk * 256 + (tid >> 1);
                  if (!dry) { ltok[(size_t)e * LISTCAP + pos] = tok; lw[(size_t)e * LISTCAP + pos] = rec_w[tid]; tslot[tok * 2 + (tid & 1)] = (e << 16) | pos; } }
                __syncthreads();
            }
        }
        SEAM(pb0);
        if (IN(pb0 + 1) || IN(pb0 + 2) || IN(pb0 + 3)) {
            __syncthreads();
            if (wave == 0 && lane_id() == 0) { const int* cntl = CNTL(); int s = 0;
#pragma unroll 1
                for (int e = 0; e < 32; ++e) { rb[e] = s; s += (__hip_atomic_load(&cntl[e], RLX_AGENT) + 255) & ~255; }
                rb[32] = s; }
            __syncthreads();
        }
        for (int rep_ = 0; rep_ < REPS(6); ++rep_) if (IN(pb0 + 1)) { bf16_t* xn = WSP(bf16_t, WS_XN); bf16_t* WGU = WSP(bf16_t, WS_WGU); bf16_t* act = WSP(bf16_t, WS_ACT); const int* ltok = WSP(int, WS_LTOK); const int* cntl = CNTL();
            pg8::Gemm g{xn, WGU + (size_t)l * 32 * 1024 * 1024, 0, 0, 1024}; pg8::MoeOrder S; S.init(rb[32] / 256, G, bid, rb); pg8::EpiPair<true> E{act, DEXP}; pg8::AGather am{ltok, cntl, rb};
            pg8::gemm_phase<pg8::EpiPair<true>, pg8::MoeOrder, pg8::AGather, true, true>(lds, g, S, E, am, wave); }
        SEAM(pb0 + 1);
        for (int rep_ = 0; rep_ < REPS(7); ++rep_) if (IN(pb0 + 2)) { bf16_t* act = WSP(bf16_t, WS_ACT); bf16_t* WDN = WSP(bf16_t, WS_WDN); bf16_t* yw = WSP(bf16_t, WS_YW); const float* lw = WSP(float, WS_LW);
            pg8::Gemm g{act, WDN + (size_t)l * 32 * 1024 * 512, 0, 0, 512}; pg8::MoeOrder S; S.init(rb[32] / 256, G, bid, rb); pg8::EpiDown E{yw, lw, rb};
            pg8::gemm_phase<pg8::EpiDown, pg8::MoeOrder, pg8::APlain, true, true>(lds, g, S, E, pg8::APlain{}, wave); }
        SEAM(pb0 + 2);
        for (int rep_ = 0; rep_ < REPS(8); ++rep_) if (IN(pb0 + 3)) { IDS(); const bool dry = rep_ + 1 < REPS(8);
            const float* gnext = (l == 0) ? KIN(2) + D : KIN(18);
            const float* modn = WSP(float, WS_MOD) + (size_t)16 * 6144; const float* modl = MODL();
            float* outf = KOUT(); bf16_t* xr = (bf16_t*)KOUT(); const bf16_t* yw = WSP(bf16_t, WS_YW); const int* tslot = WSP(int, WS_TSLOT); bf16_t* xn = WSP(bf16_t, WS_XN);
            for (int w0 = (bid * 8 + wave) * 32; w0 < T; w0 += G * 8 * 32) {
                const int b = w0 >> 12;
                f32x4 g2v[4];
#pragma unroll
                for (int j = 0; j < 4; ++j) g2v[j] = *(const f32x4*)(modl + (size_t)b * 6144 + 5120 + 4 * lane + 256 * j);
                ModV mv;
                if (l == 0) { const float* mb = modn + (size_t)b * 6144; mod_load(mv, gnext, mb + 0, mb + 1024, lane); }
                else {
#pragma unroll
                    for (int j = 0; j < 4; ++j) { mv.gp[j] = *(const f32x4*)(gnext + 4 * lane + 256 * j); mv.sh[j] = (f32x4){0.f, 0.f, 0.f, 0.f}; }
                }
                const int slw = tslot[(size_t)w0 * 2 + lane];
                u32x2 xb[4][4], ya[4][4], yb[4][4];
#define R2_LOAD(D_, I_) do { const int s0_ = __builtin_amdgcn_readlane(slw, 2 * (I_)), s1_ = __builtin_amdgcn_readlane(slw, 2 * (I_) + 1); \
                    const size_t r0_ = (size_t)(rb[s0_ >> 16] + (s0_ & 0xffff)), r1_ = (size_t)(rb[s1_ >> 16] + (s1_ & 0xffff)); \
                    _Pragma("unroll") for (int j = 0; j < 4; ++j) { xb[D_][j] = *(const u32x2*)(xr + (size_t)(w0 + (I_)) * XRP + 4 * lane + 256 * j); \
                        ya[D_][j] = ntload((const u32x2*)(yw + r0_ * D + 4 * lane + 256 * j)); yb[D_][j] = ntload((const u32x2*)(yw + r1_ * D + 4 * lane + 256 * j)); } } while (0)
#pragma unroll
                for (int d = 0; d < 4; ++d) R2_LOAD(d, d);
#pragma unroll 1
                for (int i4 = 0; i4 < 32; i4 += 4)
#pragma unroll
                for (int d = 0; d < 4; ++d) {
                    const int i = i4 + d, row = w0 + i;
                    RowV r;
#pragma unroll
                    for (int j = 0; j < 4; ++j) {
                        const u32x2 xw = xb[d][j], a = ya[d][j], c = yb[d][j];
                        f32x4 y; y.x = bflo(a.x) + bflo(c.x); y.y = bfhi(a.x) + bfhi(c.x); y.z = bflo(a.y) + bflo(c.y); y.w = bfhi(a.y) + bfhi(c.y);
                        r.v[j] = (f32x4){bflo(xw.x), bfhi(xw.x), bflo(xw.y), bfhi(xw.y)} + g2v[j] * y;
                    }
                    if (i4 < 28) R2_LOAD(d, i + 4);
                    const float rstd = row_rstd(r);
                    if (dry) { asm volatile("" :: "v"(rstd), "v"(r.v[0].x), "v"(r.v[1].y), "v"(r.v[2].z), "v"(r.v[3].w)); }
                    else if (l == 1) { row_apply(r, rstd, mv); row_store_f32(r, outf + (size_t)row * D, lane); }
                    else { row_store_bf16(r, xr + (size_t)row * XRP, lane); row_apply(r, rstd, mv); row_store_bf16(r, xn + (size_t)row * D, lane); }
                }
#undef R2_LOAD
            }
        }
        SEAM(pb0 + 3);
    }
#undef IDS
#undef MODL
#undef CNTL
#undef IN
#undef SEAM
#undef GRID_BAR
}

extern "C" void kernel_launch(void* const* d_in, const int* in_sizes, int n_in, void* d_out, int out_size, void* d_ws, size_t ws_size, hipStream_t stream) {
    static int grid = 0;
    if (grid == 0) {
        if (n_in != 19 || out_size != T * D || ws_size < WS_END) { fprintf(stderr, "kernel_launch: unexpected shapes (n_in %d out %d ws %zu)\n", n_in, out_size, ws_size); grid = -1; return; }
        int dev = 0, cus = 0;
        if (hipGetDevice(&dev) != hipSuccess || hipDeviceGetAttribute(&cus, hipDeviceAttributeMultiprocessorCount, dev) != hipSuccess) { grid = -1; return; }
        if (hipFuncSetAttribute((const void*)mk_fwd, hipFuncAttributeMaxDynamicSharedMemorySize, LDS_BYTES) != hipSuccess) { fprintf(stderr, "kernel_launch: hipFuncSetAttribute failed\n"); grid = -1; return; }
        int per_cu = 0;
        if (hipOccupancyMaxActiveBlocksPerMultiprocessor(&per_cu, (const void*)mk_fwd, NWAVES * 64, LDS_BYTES) != hipSuccess || per_cu < 1) fprintf(stderr, "kernel_launch: occupancy query says %d\n", per_cu);
        (void)hipGetLastError();
        grid = cus;
    }
    if (grid < 0) return;
    (void)hipMemsetAsync((char*)d_ws + WS_CTL, 0, CTL_BYTES, stream);
    Args a{};
    for (int i = 0; i < 19; ++i) a.in[i] = (const float*)d_in[i];
    a.out = (float*)d_out; a.ws = (unsigned char*)d_ws;
#if MK_ONE_LAUNCH
    a.ph_lo = 0; a.ph_hi = NPHASE;
    hipLaunchKernelGGL(mk_fwd, dim3(grid), dim3(NWAVES * 64), LDS_BYTES, stream, a);
#else
    for (int p = 0; p < NPHASE; ++p) { a.ph_lo = p; a.ph_hi = p + 1; hipLaunchKernelGGL(mk_fwd, dim3(grid), dim3(NWAVES * 64), LDS_BYTES, stream, a); }
#endif
}
```

```cpp
#include <hip/hip_runtime.h>
#include <stdint.h>
#include <math.h>
#include <cstdio>

#ifndef MK_ONE_LAUNCH
#define MK_ONE_LAUNCH 1
#endif

typedef unsigned short bf16_t;
typedef float f32x4 __attribute__((ext_vector_type(4)));
typedef unsigned u32x2 __attribute__((ext_vector_type(2)));
typedef unsigned u32x4 __attribute__((ext_vector_type(4)));
#define GAS __attribute__((address_space(1)))
#define LAS __attribute__((address_space(3)))
typedef GAS unsigned gu32;
#define RLX_AGENT __ATOMIC_RELAXED, __HIP_MEMORY_SCOPE_AGENT

constexpr int D = 1024, BATCH = 16, SEQ = 4096, T = BATCH * SEQ;
constexpr int NEXP = 32, DEXP = 512, EPG = 8, NGRP = 4;
constexpr int QKVW = 4608;
__host__ __device__ __forceinline__ size_t qkv_block(int typ, int g, int b, int h) { return (size_t)((((typ * 3 + g) * 16 + b) * 8 + h)) * (4096 * 64); }
__host__ __device__ __forceinline__ int qkv_row(int pos, int g) { const int dsh = 2 * g; return ((pos & ((1 << dsh) - 1)) << (12 - dsh)) + (pos >> dsh); }
constexpr int LISTCAP = 65536;
constexpr int PADROWS = 139264;
constexpr float EPS = 1e-6f;
constexpr float QSCALE = 0.125f * 1.4426950408889634f;
constexpr int NWAVES = 8;
constexpr int XRP = 2048;

constexpr size_t MiB = 1u << 20;
constexpr size_t WS_CTL = 0;
constexpr size_t CTL_BYTES = 1 * MiB;
constexpr int CW_BAR = 4096;
constexpr size_t WS_MOD = 1 * MiB;
constexpr size_t WS_ROPE = 3 * MiB;
constexpr size_t WS_LTOK = 4 * MiB;
constexpr size_t WS_LW = 12 * MiB;
constexpr size_t WS_TSLOT = 20 * MiB;
constexpr size_t WS_LSE = 24 * MiB;
constexpr size_t WS_WZ = 32 * MiB;
constexpr size_t WS_WB = 36 * MiB;
constexpr size_t WS_WCO = 38 * MiB;
constexpr size_t WS_WAI = 40 * MiB;
constexpr size_t WS_WAO = 49 * MiB;
constexpr size_t WS_WGU = 64 * MiB;
constexpr size_t WS_WDN = 192 * MiB;
constexpr size_t WS_XN = 256 * MiB;
constexpr size_t WS_BIG = 384 * MiB;
constexpr size_t WS_Z = WS_BIG, WS_YPRE = WS_BIG + 128 * MiB;
constexpr size_t WS_ACT = WS_BIG, WS_YW = WS_BIG + 136 * MiB;
constexpr size_t WS_QKV = WS_BIG;
constexpr size_t WS_OB = WS_BIG + 576 * MiB;
constexpr size_t WS_END = WS_OB + 64 * MiB;

constexpr int RING_BYTES = 162816;
constexpr int MISC_OFF = RING_BYTES;
constexpr int LDS_BYTES = RING_BYTES + 1024;

__device__ __forceinline__ unsigned f2bf(float f) { unsigned u = __float_as_uint(f); return (u + 0x7fffu + ((u >> 16) & 1u)) >> 16; }
__device__ __forceinline__ unsigned pk2(float lo, float hi) { return f2bf(lo) | (f2bf(hi) << 16); }
__device__ __forceinline__ float bf2f(unsigned h) { return __uint_as_float(h << 16); }
__device__ __forceinline__ float bflo(unsigned w) { return __uint_as_float(w << 16); }
__device__ __forceinline__ float bfhi(unsigned w) { return __uint_as_float(w & 0xffff0000u); }
template <int M> __device__ __forceinline__ float xlane(float v) {
    return __int_as_float(__builtin_amdgcn_ds_swizzle(__float_as_int(v), (M << 10) | 0x1f));
}
__device__ __forceinline__ float xlane32(float v, bool hi) {
    auto rr = __builtin_amdgcn_permlane32_swap(__float_as_uint(v), __float_as_uint(v), false, false); return __uint_as_float(hi ? rr[0] : rr[1]);
}
__device__ __forceinline__ float wave_sum(float v) {
    v += xlane<1>(v); v += xlane<2>(v); v += xlane<4>(v); v += xlane<8>(v); v += xlane<16>(v);
    auto rr = __builtin_amdgcn_permlane32_swap(__float_as_uint(v), __float_as_uint(v), false, false);
    return __uint_as_float(rr[0]) + __uint_as_float(rr[1]);
}
__device__ __forceinline__ float silu_f(float x) { return x / (1.0f + __expf(-x)); }
#define LDS_WAIT() asm volatile("s_waitcnt lgkmcnt(0)" ::: "memory")
template <class V> __device__ __forceinline__ V ntload(const V* p) { return __builtin_nontemporal_load(p); }
__device__ __forceinline__ int lane_id() { int l; asm volatile("v_mbcnt_lo_u32_b32 %0, -1, 0\n\tv_mbcnt_hi_u32_b32 %0, -1, %0" : "=v"(l)); return l; }

namespace pg8 {
#define PG8_LAS __attribute__((address_space(3)))
typedef unsigned short bf16_t;
typedef short bf16x8 __attribute__((ext_vector_type(8)));
typedef float f32x4 __attribute__((ext_vector_type(4)));
typedef unsigned u32x4 __attribute__((ext_vector_type(4)));
constexpr int BM = 256, BK = 64, HALF = 128, HTB = HALF * BK * 2  , STAGE_BYTES = 8 * HTB, NXCD = 8, WGM = 4;

__host__ __device__ __forceinline__ int lds_byte(int r, int c) { const int st = (r >> 4) * 2 + (c >> 5), rr = r & 15, cc = c & 31, ob = rr * 64 + cc * 2; return st * 1024 + (ob ^ (((ob >> 9) & 1) << 5)); }
__host__ __device__ __forceinline__ void stage_rc(int b, int& R, int& C) { const int st = b / 1024, sb = b % 1024, swz = sb ^ (((sb >> 9) & 1) << 5); R = (st >> 1) * 16 + swz / 64; C = (st & 1) * 32 + (swz % 64) / 2; }
__host__ __device__ __forceinline__ int perm32(int rho) { const int n = rho >> 4, i = rho & 15; return 8 * (i >> 2) + 4 * n + (i & 3); }

struct Unit { int pm, pn, pb; };
struct Gemm { const bf16_t* A; const bf16_t* Bt; int M, N, K; };

struct StaticOrder {
    int nM, nN, nwg, G, c, wgm;
    __host__ __device__ void init(int M, int N, int G_, int c_, int wgm_ = WGM) { nM = M / BM; nN = N / BM; nwg = nM * nN; G = G_; c = c_; wgm = wgm_; }
    __host__ __device__ bool next(int i, Unit& u) const {
        const long L = (long)i * G + c; if (L >= nwg) return false;
        int wgid = (int)L; { const int q = nwg / NXCD, r = nwg % NXCD, xcd = wgid % NXCD, off = wgid / NXCD; wgid = (xcd < r ? xcd * (q + 1) : r * (q + 1) + (xcd - r) * q) + off; }
        const int nig = wgm * nN, gid = wgid / nig, fm = gid * wgm, gsz = (nM - fm) < wgm ? (nM - fm) : wgm;
        u.pm = fm + ((wgid % nig) % gsz); u.pn = (wgid % nig) / gsz; u.pb = u.pn; return true;
    }
    __device__ __forceinline__ void a_ready(const Unit&) const {}
    __device__ __forceinline__ void done(const Unit&) const {}
};


__device__ __forceinline__ unsigned cvt_pk_bf16(float lo, float hi) { unsigned r; asm volatile("v_cvt_pk_bf16_f32 %0, %1, %2" : "=v"(r) : "v"(lo), "v"(hi)); return r; }
typedef float f32x2 __attribute__((ext_vector_type(2)));

template <class Epi, class Sched, class AM, bool ALIGN_EPI = false, bool SP2 = false>
__device__ __forceinline__ void gemm_phase(PG8_LAS unsigned char* lds, const Gemm g, const Sched& S, const Epi& E, const AM& am, const int wid_in) {
    int wid = wid_in; asm volatile("" : "+s"(wid));
    const int lane = lane_id(), tid = wid * 64 + lane, wr = wid >> 2, wc = wid & 3, fr = lane & 15, fq = lane >> 4;
    const int K = g.K, nt = K / BK;
    unsigned voffA[2], voffB[2]; int stR[2], stC[2];
#pragma unroll
    for (int i = 0; i < 2; ++i) { int R, C; stage_rc(tid * 16 + i * 8192, R, C); const int Rb = Epi::PERM ? ((R & ~31) + perm32(R & 31)) : R;
        stR[i] = R; stC[i] = C; voffA[i] = (unsigned)(R * K + C) * 2u; voffB[i] = (unsigned)(Rb * K + C) * 2u; }
    const size_t kstep = (size_t)(BK * 2);
    const size_t hstep = (size_t)HALF * K * 2;
    const size_t tstep = 2 * hstep;
    const unsigned ldsw = (unsigned)wid * 1024u;
    const int aoff = lds_byte(wr * 64 + fr, fq * 8), boff = lds_byte(wc * 32 + fr, fq * 8);
#define PG8_SA(b, h) (((b) * 2 + (h)) * HTB)
#define PG8_SB(b, h) ((4 + (b) * 2 + (h)) * HTB)
#define PG8_STAGE(bufoff, gbase, voff) do { _Pragma("unroll") for (int _i = 0; _i < 2; ++_i) \
        __builtin_amdgcn_global_load_lds((const unsigned*)((const char*)(gbase) + (voff)[_i]), (PG8_LAS unsigned*)(lds + (bufoff) + ldsw + _i * 8192), 16, 0, 0); } while (0)
#define PG8_STAGE_A(b, h, gbase, NX) do { if constexpr (AM::GATHER) { const unsigned so_[2] = {(NX) ? gno[h][0] : gao[h][0], (NX) ? gno[h][1] : gao[h][1]}; PG8_STAGE(PG8_SA(b, h), gbase, so_); } \
        else { PG8_STAGE(PG8_SA(b, h), (gbase) + (h) * hstep, voffA); } } while (0)
#define PG8_LDA(dst, b, h) do { _Pragma("unroll") for (int m = 0; m < 4; ++m) _Pragma("unroll") for (int k = 0; k < 2; ++k) dst[m][k] = *(const PG8_LAS bf16x8*)(lds + PG8_SA(b, h) + aoff + m * 2048 + k * 1024); } while (0)
#define PG8_LDB(dst, b, h) do { _Pragma("unroll") for (int n = 0; n < 2; ++n) _Pragma("unroll") for (int k = 0; k < 2; ++k) dst[n][k] = *(const PG8_LAS bf16x8*)(lds + PG8_SB(b, h) + boff + n * 2048 + k * 1024); } while (0)
#define PG8_MMA(ai, bj, At, Bt) do { __builtin_amdgcn_s_setprio(1); _Pragma("unroll") for (int m = 0; m < 4; ++m) _Pragma("unroll") for (int n = 0; n < 2; ++n) _Pragma("unroll") for (int k = 0; k < 2; ++k) \
        acc[ai][bj][m][n] = __builtin_amdgcn_mfma_f32_16x16x32_bf16(Bt[n][k], At[m][k], acc[ai][bj][m][n], 0, 0, 0); __builtin_amdgcn_s_setprio(0); } while (0)
#define PG8_WAIT_V(n) asm volatile("s_waitcnt vmcnt(" #n ")" ::: "memory")
#define PG8_WAIT_L(n) asm volatile("s_waitcnt lgkmcnt(" #n ")" ::: "memory")
#define PG8_BAR __builtin_amdgcn_s_barrier()
#define PG8_SCHED __builtin_amdgcn_sched_barrier(0)
    Unit cur, nxt; int ui = 0;
    if (!S.next(0, cur)) return;
    f32x4 acc[2][2][4][2];
#pragma unroll
    for (int a = 0; a < 2; ++a)
#pragma unroll
        for (int b = 0; b < 2; ++b)
#pragma unroll
            for (int m = 0; m < 4; ++m)
#pragma unroll
                for (int n = 0; n < 2; ++n) acc[a][b][m][n] = (f32x4){0.f, 0.f, 0.f, 0.f};
    bf16x8 At[4][2], B0[2][2], B1[2][2];
    const char* cA = (const char*)g.A + (AM::GATHER ? (size_t)0 : (size_t)cur.pm * tstep); const char* cB = (const char*)g.Bt + (size_t)cur.pb * tstep;
    unsigned gao[2][2], gno[2][2];
    if constexpr (AM::GATHER) { _Pragma("unroll") for (int h = 0; h < 2; ++h) _Pragma("unroll") for (int i = 0; i < 2; ++i) { gao[h][i] = (unsigned)(am.arow(cur, h * HALF + stR[i]) * K + stC[i]) * 2u; gno[h][i] = gao[h][i]; } }
    else { _Pragma("unroll") for (int h = 0; h < 2; ++h) _Pragma("unroll") for (int i = 0; i < 2; ++i) { gao[h][i] = 0u; gno[h][i] = 0u; } }
    S.a_ready(cur);
    if constexpr (SP2) {
        PG8_STAGE(PG8_SB(0, 0), cB, voffB); PG8_STAGE(PG8_SB(0, 1), cB + hstep, voffB); PG8_STAGE_A(0, 0, cA, false); PG8_STAGE_A(0, 1, cA, false);
        if (wr == 1) PG8_BAR;
        PG8_WAIT_V(2); PG8_BAR;
        PG8_STAGE(PG8_SB(1, 0), cB + kstep, voffB); PG8_STAGE_A(1, 0, cA + kstep, false); PG8_STAGE(PG8_SB(1, 1), cB + hstep + kstep, voffB);
        PG8_WAIT_V(6); PG8_BAR;
    } else {
        PG8_STAGE(PG8_SB(0, 0), cB, voffB); PG8_STAGE_A(0, 0, cA, false); PG8_STAGE(PG8_SB(0, 1), cB + hstep, voffB); PG8_STAGE_A(0, 1, cA, false);
        if (wr == 1) PG8_BAR;
        PG8_WAIT_V(4); PG8_BAR;
        PG8_STAGE(PG8_SB(1, 0), cB + kstep, voffB); PG8_STAGE_A(1, 0, cA + kstep, false); PG8_STAGE(PG8_SB(1, 1), cB + hstep + kstep, voffB);
        PG8_WAIT_V(6); PG8_BAR;
    }
    for (;;) {
        const bool has_next = S.next(ui + 1, nxt);
        const char* nA = has_next ? (const char*)g.A + (AM::GATHER ? (size_t)0 : (size_t)nxt.pm * tstep) : cA; const char* nB = has_next ? (const char*)g.Bt + (size_t)nxt.pb * tstep : cB;
        if constexpr (AM::GATHER) { if (has_next) { _Pragma("unroll") for (int h = 0; h < 2; ++h) _Pragma("unroll") for (int i = 0; i < 2; ++i) gno[h][i] = (unsigned)(am.arow(nxt, h * HALF + stR[i]) * K + stC[i]) * 2u; } }
        for (int t = 0; t < nt; t += 2) {
            const bool last = (t == nt - 2);
            const char* a1 = cA + (size_t)(t + 1) * kstep;
            const char* a2 = last ? nA : cA + (size_t)(t + 2) * kstep; const char* b2 = last ? nB : cB + (size_t)(t + 2) * kstep;
            const char* a3 = a2 + kstep; const char* b3 = b2 + kstep;
            if (last && has_next) S.a_ready(nxt);
            if (false) E.prefetch(cur, tid, (PG8_LAS unsigned*)(lds + 162816 + 512));
            if constexpr (SP2) {
            PG8_LDB(B0, 0, 0); PG8_LDB(B1, 0, 1); PG8_SCHED; PG8_LDA(At, 0, 0); PG8_STAGE_A(1, 1, a1, false);
            PG8_WAIT_V(8); PG8_WAIT_L(0); PG8_BAR; PG8_MMA(0, 0, At, B0); PG8_MMA(0, 1, At, B1); PG8_BAR; PG8_SCHED;
            PG8_LDA(At, 0, 1); PG8_STAGE(PG8_SB(0, 0), b2, voffB); PG8_STAGE(PG8_SB(0, 1), b2 + hstep, voffB); PG8_STAGE_A(0, 0, a2, last);
            PG8_WAIT_V(8); PG8_WAIT_L(0); PG8_BAR; PG8_MMA(1, 0, At, B0); PG8_MMA(1, 1, At, B1); PG8_BAR; PG8_SCHED;
            PG8_LDB(B0, 1, 0); PG8_LDB(B1, 1, 1); PG8_SCHED; PG8_LDA(At, 1, 0); PG8_STAGE_A(0, 1, a2, last);
            PG8_WAIT_V(8); PG8_WAIT_L(0); PG8_BAR; PG8_MMA(0, 0, At, B0); PG8_MMA(0, 1, At, B1); PG8_BAR; PG8_SCHED;
            PG8_LDA(At, 1, 1); PG8_STAGE(PG8_SB(1, 0), b3, voffB); PG8_STAGE(PG8_SB(1, 1), b3 + hstep, voffB); PG8_STAGE_A(1, 0, a3, last);
            PG8_WAIT_V(8); PG8_WAIT_L(0); PG8_BAR; PG8_MMA(1, 0, At, B0); PG8_MMA(1, 1, At, B1); PG8_BAR; PG8_SCHED;
            } else {
            PG8_LDB(B0, 0, 0); PG8_SCHED; PG8_LDA(At, 0, 0); PG8_STAGE_A(1, 1, a1, false);
            PG8_WAIT_L(8); PG8_BAR; PG8_WAIT_L(0); PG8_MMA(0, 0, At, B0); PG8_BAR; PG8_SCHED;
            PG8_LDB(B1, 0, 1); PG8_STAGE(PG8_SB(0, 0), b2, voffB);
            PG8_BAR; PG8_WAIT_L(0); PG8_MMA(0, 1, At, B1); PG8_BAR;
            PG8_LDA(At, 0, 1); PG8_STAGE_A(0, 0, a2, last);
            PG8_BAR; PG8_WAIT_L(0); PG8_MMA(1, 0, At, B0); PG8_BAR; PG8_SCHED;
            PG8_STAGE(PG8_SB(0, 1), b2 + hstep, voffB);
            PG8_WAIT_V(6); PG8_BAR; PG8_MMA(1, 1, At, B1); PG8_BAR;
            PG8_LDB(B0, 1, 0); PG8_SCHED; PG8_LDA(At, 1, 0); PG8_STAGE_A(0, 1, a2, last);
            PG8_WAIT_L(8); PG8_BAR; PG8_WAIT_L(0); PG8_MMA(0, 0, At, B0); PG8_BAR; PG8_SCHED;
            PG8_LDB(B1, 1, 1); PG8_STAGE(PG8_SB(1, 0), b3, voffB);
            PG8_BAR; PG8_WAIT_L(0); PG8_MMA(0, 1, At, B1); PG8_BAR;
            PG8_LDA(At, 1, 1); PG8_STAGE_A(1, 0, a3, last);
            PG8_BAR; PG8_WAIT_L(0); PG8_MMA(1, 0, At, B0); PG8_BAR; PG8_SCHED;
            PG8_STAGE(PG8_SB(1, 1), b3 + hstep, voffB);
            PG8_WAIT_V(6); PG8_BAR; PG8_MMA(1, 1, At, B1); PG8_BAR;
            }
        }
        if constexpr (ALIGN_EPI) { if (wr == 0) PG8_BAR; }
        if constexpr (!Epi::AFTER_DRAIN) { E(acc, cur, wr, wc, fr, fq); S.done(cur); }
        if (!has_next) break;
#pragma unroll
        for (int a = 0; a < 2; ++a)
#pragma unroll
            for (int b = 0; b < 2; ++b)
#pragma unroll
                for (int m = 0; m < 4; ++m)
#pragma unroll
                    for (int n = 0; n < 2; ++n) acc[a][b][m][n] = (f32x4){0.f, 0.f, 0.f, 0.f};
        cur = nxt; cA = nA; cB = nB; ++ui;
        if constexpr (AM::GATHER) { _Pragma("unroll") for (int h = 0; h < 2; ++h) _Pragma("unroll") for (int i = 0; i < 2; ++i) gao[h][i] = gno[h][i]; }
        if constexpr (ALIGN_EPI) { if (wr == 1) PG8_BAR; }
    }
    PG8_WAIT_V(0);
    if constexpr (!ALIGN_EPI) { if (wr == 0) PG8_BAR; }
    PG8_BAR;
    if constexpr (Epi::AFTER_DRAIN) { E.fused(acc, cur, wr, wc, fr, fq, lds, wid, lane); S.done(cur); }
#undef PG8_SA
#undef PG8_SB
#undef PG8_STAGE
#undef PG8_STAGE_A
#undef PG8_LDA
#undef PG8_LDB
#undef PG8_MMA
#undef PG8_WAIT_V
#undef PG8_WAIT_L
#undef PG8_BAR
#undef PG8_SCHED
}

__device__ __forceinline__ u32x4 pack8(const f32x4 v0, const f32x4 v1) { u32x4 w; w.x = cvt_pk_bf16(v0[0], v0[1]); w.y = cvt_pk_bf16(v0[2], v0[3]); w.z = cvt_pk_bf16(v1[0], v1[1]); w.w = cvt_pk_bf16(v1[2], v1[3]); return w; }
__device__ __forceinline__ u32x4 xpose4x16(const u32x4 w, int sa) {
    u32x4 r; r.x = __builtin_amdgcn_ds_bpermute(sa, w.x); r.y = __builtin_amdgcn_ds_bpermute(sa, w.y); r.z = __builtin_amdgcn_ds_bpermute(sa, w.z); r.w = __builtin_amdgcn_ds_bpermute(sa, w.w); return r;
}
#define XPOSE_IDS() const int L_ = fr + 16 * fq, tr_ = L_ >> 2, tq_ = L_ & 3, sa_ = 4 * (tr_ + 16 * tq_)
__device__ __forceinline__ float silu1(float x) { return x * __builtin_amdgcn_rcpf(1.0f + __builtin_amdgcn_exp2f(-1.4426950408889634f * x)); }
template <bool SILU> struct EpiPair {
    static constexpr bool PERM = true, AFTER_DRAIN = false;
    bf16_t* O; int ldc;
    __device__ __forceinline__ void prefetch(const Unit&, int, PG8_LAS unsigned*) const {}
    __device__ __forceinline__ void operator()(const f32x4 (&acc)[2][2][4][2], const Unit& u, int wr, int wc, int fr, int fq) const {
        XPOSE_IDS();
        const int row0 = u.pm * BM + wr * 64 + tr_, ch0 = u.pn * HALF + wc * 32 + 8 * tq_;
#pragma unroll
        for (int ai = 0; ai < 2; ++ai)
#pragma unroll
            for (int m = 0; m < 4; ++m) {
                f32x4 a0 = acc[ai][0][m][0], a1 = acc[ai][0][m][1];
                if (SILU) {
#pragma unroll
                    for (int c = 0; c < 4; ++c) { a0[c] = silu1(a0[c]); a1[c] = silu1(a1[c]); }
                }
                *(u32x4*)(O + (size_t)(row0 + ai * HALF + m * 16) * ldc + ch0) = xpose4x16(pack8(a0 * acc[ai][1][m][0], a1 * acc[ai][1][m][1]), sa_);
            }
    }
};
struct EpiYpre {
    static constexpr bool PERM = true, AFTER_DRAIN = false;
    bf16_t* O; const bf16_t* Z; const float* cw;
    __device__ __forceinline__ void prefetch(const Unit& u, int tid, PG8_LAS unsigned* dummy) const {
#pragma unroll
        for (int i = 0; i < 2; ++i) { const int line = tid + 512 * i, row = line >> 2, seg = line & 3;
            __builtin_amdgcn_global_load_lds((const unsigned*)(Z + (size_t)(u.pm * BM + row) * D + u.pn * BM + seg * 64), dummy, 4, 0, 0); }
    }
    template <typename P> static __device__ __forceinline__ P sadd(P base, unsigned off) { asm volatile("" : "+v"(off)); return base + off; }
    template <int N> static __device__ __forceinline__ u32x4 ror(const u32x4 v) { u32x4 r;
        r.x = (unsigned)__builtin_amdgcn_update_dpp(0, (int)v.x, 0x120 + N, 0xf, 0xf, false); r.y = (unsigned)__builtin_amdgcn_update_dpp(0, (int)v.y, 0x120 + N, 0xf, 0xf, false);
        r.z = (unsigned)__builtin_amdgcn_update_dpp(0, (int)v.z, 0x120 + N, 0xf, 0xf, false); r.w = (unsigned)__builtin_amdgcn_update_dpp(0, (int)v.w, 0x120 + N, 0xf, 0xf, false); return r; }
    static __device__ __forceinline__ u32x4 sel(bool c, const u32x4 a, const u32x4 b) { u32x4 r; r.x = c ? a.x : b.x; r.y = c ? a.y : b.y; r.z = c ? a.z : b.z; r.w = c ? a.w : b.w; return r; }
    __device__ __forceinline__ void operator()(const f32x4 (&acc)[2][2][4][2], const Unit& u, int wr, int wc, int fr, int fq) const {
        XPOSE_IDS();
        const int row0 = u.pm * BM + wr * 64 + fr;
#pragma unroll
        for (int bj = 0; bj < 2; ++bj) {
            const int col0 = u.pn * BM + bj * HALF + wc * 32 + 8 * fq;
            f32x4 w0[2], w1[2], w2[2];
#pragma unroll
            for (int n = 0; n < 2; ++n) { w0[n] = *(const f32x4*)(cw + col0 + 4 * n); w1[n] = *(const f32x4*)(cw + D + col0 + 4 * n); w2[n] = *(const f32x4*)(cw + 2 * D + col0 + 4 * n); }
            u32x4 zc[2][4], zh[2];
#pragma unroll
            for (int ai = 0; ai < 2; ++ai) {
                zh[ai] = (u32x4){0u, 0u, 0u, 0u};
                if (fr >= 14 && row0 + ai * HALF >= 16) zh[ai] = *(const u32x4*)sadd((const char*)Z, (unsigned)((row0 + ai * HALF - 16) * D + col0) * 2u);
#pragma unroll
                for (int m = 0; m < 4; ++m) zc[ai][m] = *(const u32x4*)(sadd((const char*)Z, (unsigned)((row0 + ai * HALF) * D + col0) * 2u) + m * 16 * D * 2);
            }
            asm volatile("" ::: "memory");
#pragma unroll
            for (int ai = 0; ai < 2; ++ai)
#pragma unroll
                for (int m = 0; m < 4; ++m) {
                    const int row = row0 + ai * HALF + m * 16, t = row & (SEQ - 1);
                    const u32x4 cur = zc[ai][m], prv = (m == 0) ? zh[ai] : zc[ai][m - 1];
                    u32x4 z1 = sel(fr >= 1, ror<1>(cur), ror<1>(prv)), z2 = sel(fr >= 2, ror<2>(cur), ror<2>(prv));
                    if (t < 1) z1 = (u32x4){0u, 0u, 0u, 0u};
                    if (t < 2) z2 = (u32x4){0u, 0u, 0u, 0u};
                    const u32x4 z0 = cur;
                    f32x4 v[2];
#pragma unroll
                    for (int n = 0; n < 2; ++n) {
                        f32x4 a, b, c;
                        a[0] = __uint_as_float(z0[2 * n] << 16); a[1] = __uint_as_float(z0[2 * n] & 0xffff0000u); a[2] = __uint_as_float(z0[2 * n + 1] << 16); a[3] = __uint_as_float(z0[2 * n + 1] & 0xffff0000u);
                        b[0] = __uint_as_float(z1[2 * n] << 16); b[1] = __uint_as_float(z1[2 * n] & 0xffff0000u); b[2] = __uint_as_float(z1[2 * n + 1] << 16); b[3] = __uint_as_float(z1[2 * n + 1] & 0xffff0000u);
                        c[0] = __uint_as_float(z2[2 * n] << 16); c[1] = __uint_as_float(z2[2 * n] & 0xffff0000u); c[2] = __uint_as_float(z2[2 * n + 1] << 16); c[3] = __uint_as_float(z2[2 * n + 1] & 0xffff0000u);
                        v[n] = acc[ai][bj][m][n] * (w2[n] * a + w1[n] * b + w0[n] * c);
                    }
                    *(u32x4*)(sadd((char*)O, (unsigned)((row0 - fr + tr_ + ai * HALF) * D + col0 - 8 * fq + 8 * tq_) * 2u) + m * 16 * D * 2) = xpose4x16(pack8(v[0], v[1]), sa_);
                    __builtin_amdgcn_sched_barrier(0);
                }
            asm volatile("" ::: "memory");
        }
    }
};

template <bool RES_F32> struct EpiRes {
    static constexpr bool PERM = true, AFTER_DRAIN = false;
    bf16_t* xr; const float* xin; const float* modg;
    __device__ __forceinline__ void prefetch(const Unit&, int, PG8_LAS unsigned*) const {}
    __device__ __forceinline__ void operator()(const f32x4 (&acc)[2][2][4][2], const Unit& u, int wr, int wc, int fr, int fq) const {
        XPOSE_IDS();
        const int row0 = u.pm * BM + wr * 64 + fr, col0 = u.pn * BM + wc * 32 + 8 * fq;
        const float* gb = modg + (size_t)((u.pm * BM) >> 12) * 6144;
        f32x4 gv[2][2];
#pragma unroll
        for (int bj = 0; bj < 2; ++bj)
#pragma unroll
            for (int n = 0; n < 2; ++n) gv[bj][n] = *(const f32x4*)(gb + col0 + bj * HALF + n * 4);
        if constexpr (!RES_F32) {
            u32x4 rw[2][4][2];
#pragma unroll
            for (int ai = 0; ai < 2; ++ai)
#pragma unroll
                for (int m = 0; m < 4; ++m)
#pragma unroll
                    for (int bj = 0; bj < 2; ++bj) rw[ai][m][bj] = *(const u32x4*)(xr + (size_t)(row0 + ai * HALF + m * 16) * XRP + col0 + bj * HALF);
            asm volatile("" ::: "memory");
#pragma unroll
            for (int ai = 0; ai < 2; ++ai)
#pragma unroll
                for (int m = 0; m < 4; ++m) { const int row = row0 + ai * HALF + m * 16;
#pragma unroll
                    for (int bj = 0; bj < 2; ++bj) { const u32x4 w = rw[ai][m][bj];
                        const f32x4 r0 = {__uint_as_float(w.x << 16), __uint_as_float(w.x & 0xffff0000u), __uint_as_float(w.y << 16), __uint_as_float(w.y & 0xffff0000u)};
                        const f32x4 r1 = {__uint_as_float(w.z << 16), __uint_as_float(w.z & 0xffff0000u), __uint_as_float(w.w << 16), __uint_as_float(w.w & 0xffff0000u)};
                        *(u32x4*)(xr + (size_t)(row - fr + tr_) * XRP + col0 - 8 * fq + 8 * tq_ + bj * HALF) = xpose4x16(pack8(r0 + gv[bj][0] * acc[ai][bj][m][0], r1 + gv[bj][1] * acc[ai][bj][m][1]), sa_); } }
        } else {
#pragma unroll
        for (int ai = 0; ai < 2; ++ai) {
            f32x4 rv[4][2][2];
#pragma unroll
            for (int m = 0; m < 4; ++m) { const int row = row0 + ai * HALF + m * 16;
#pragma unroll
                for (int bj = 0; bj < 2; ++bj) { rv[m][bj][0] = ntload((const f32x4*)(xin + (size_t)row * D + col0 + bj * HALF)); rv[m][bj][1] = ntload((const f32x4*)(xin + (size_t)row * D + col0 + bj * HALF + 4)); } }
#pragma unroll
            for (int m = 0; m < 4; ++m) { const int row = row0 + ai * HALF + m * 16;
#pragma unroll
                for (int bj = 0; bj < 2; ++bj)
                    *(u32x4*)(xr + (size_t)(row - fr + tr_) * XRP + col0 - 8 * fq + 8 * tq_ + bj * HALF) = xpose4x16(pack8(rv[m][bj][0] + gv[bj][0] * acc[ai][bj][m][0], rv[m][bj][1] + gv[bj][1] * acc[ai][bj][m][1]), sa_); }
            asm volatile("" ::: "memory");
        }
        }
    }
};
struct EpiQKV {
    static constexpr bool PERM = true, AFTER_DRAIN = false;
    bf16_t* O; const float* rope; int row_off;
    __device__ __forceinline__ void prefetch(const Unit&, int, PG8_LAS unsigned*) const {}
    __device__ __forceinline__ void operator()(const f32x4 (&acc)[2][2][4][2], const Unit& u, int wr, int wc, int fr, int fq) const {
        XPOSE_IDS();
        const int row0 = u.pm * BM + wr * 64 + fr, col0 = u.pn * BM + wc * 32 + 8 * fq;
        const int typ = (u.pn % 6) >> 1, gq_ = u.pn / 6;
        const bool rl = (typ < 2) && ((wc & 1) == 0) && (fq < 2);
        const float sc = (typ == 0) ? QSCALE : 1.0f;
#pragma unroll
        for (int ai = 0; ai < 2; ++ai)
#pragma unroll
        for (int mp = 0; mp < 2; ++mp) {
            f32x4 csv[2], snv[2];
#pragma unroll
            for (int mm = 0; mm < 2; ++mm) { const int pos = (row0 + ai * HALF + (2 * mp + mm) * 16) & (SEQ - 1);
                csv[mm] = *(const f32x4*)(rope + pos * 8 + 4 * (fq & 1)); snv[mm] = *(const f32x4*)(rope + 4096 * 8 + pos * 8 + 4 * (fq & 1)); }
#pragma unroll
            for (int mm = 0; mm < 2; ++mm) {
                const int m = 2 * mp + mm, row = row0 + ai * HALF + m * 16;
                f32x4 cs = {1.f, 1.f, 1.f, 1.f}, sn = {0.f, 0.f, 0.f, 0.f};
                if (rl) { cs = csv[mm]; sn = snv[mm]; }
#pragma unroll
                for (int bj = 0; bj < 2; ++bj) {
                    const f32x4 x1 = acc[ai][bj][m][0], x2 = acc[ai][bj][m][1];
                    const f32x4 r1 = (x1 * cs - x2 * sn) * sc, r2 = (x2 * cs + x1 * sn) * sc;
                    { const int tok = row_off + row - fr + tr_, hh = 4 * (u.pn & 1) + 2 * bj + (wc >> 1);
                      *(u32x4*)(O + qkv_block(typ, gq_, tok >> 12, hh) + (size_t)qkv_row(tok & (SEQ - 1), gq_) * 64 + 32 * (wc & 1) + 8 * tq_) = xpose4x16(pack8(r1, r2), sa_); }
                }
            }
            asm volatile("" ::: "memory");
        }
    }
};
struct EpiDown {
    static constexpr bool PERM = true, AFTER_DRAIN = false;
    bf16_t* O; const float* lw; const PG8_LAS int* rb;
    __device__ __forceinline__ void prefetch(const Unit&, int, PG8_LAS unsigned*) const {}
    __device__ __forceinline__ void operator()(const f32x4 (&acc)[2][2][4][2], const Unit& u, int wr, int wc, int fr, int fq) const {
        XPOSE_IDS();
        const int row0 = u.pm * BM + wr * 64 + fr, col0 = u.pn * BM + wc * 32 + 8 * fq;
        const int e = u.pb >> 2; const float* wrow = lw + (size_t)e * LISTCAP - rb[e];
        float wv[2][4];
#pragma unroll
        for (int ai = 0; ai < 2; ++ai)
#pragma unroll
            for (int m = 0; m < 4; ++m) wv[ai][m] = wrow[row0 + ai * HALF + m * 16];
#pragma unroll
        for (int ai = 0; ai < 2; ++ai)
#pragma unroll
            for (int m = 0; m < 4; ++m) {
                const int row = row0 + ai * HALF + m * 16; const float w = wv[ai][m];
#pragma unroll
                for (int bj = 0; bj < 2; ++bj) *(u32x4*)(O + (size_t)(row - fr + tr_) * D + col0 - 8 * fq + 8 * tq_ + bj * HALF) = xpose4x16(pack8(acc[ai][bj][m][0] * w, acc[ai][bj][m][1] * w), sa_);
            }
    }
};
struct MoeOrder {
    int nM, nN, nwg, G, c; const PG8_LAS int* rb;
    __device__ void init(int nRT, int G_, int c_, const PG8_LAS int* rb_) { nM = nRT; nN = 4; nwg = nM * nN; G = G_; c = c_; rb = rb_; }
    __device__ bool next(int i, Unit& u) const {
        const long L = (long)i * G + c; if (L >= nwg) return false;
        int wgid = (int)L; { const int q = nwg / NXCD, r = nwg % NXCD, xcd = wgid % NXCD, off = wgid / NXCD; wgid = (xcd < r ? xcd * (q + 1) : r * (q + 1) + (xcd - r) * q) + off; }
        const int nig = WGM * nN, gid = wgid / nig, fm = gid * WGM, gsz = (nM - fm) < WGM ? (nM - fm) : WGM;
        u.pm = fm + ((wgid % nig) % gsz); u.pn = (wgid % nig) / gsz;
        int e = 0; const int r0 = u.pm * BM;
#pragma unroll 1
        while (e < 31 && rb[e + 1] <= r0) ++e;
        u.pb = e * 4 + u.pn; return true;
    }
    __device__ __forceinline__ void a_ready(const Unit&) const {}
    __device__ __forceinline__ void done(const Unit&) const {}
};
struct APlain { static constexpr bool GATHER = false; __device__ __forceinline__ int arow(const Unit&, int) const { return 0; } };
struct AGather {
    static constexpr bool GATHER = true;
    const int* ltok; const int* cnt; const PG8_LAS int* rb;
    __device__ __forceinline__ int arow(const Unit& u, int r) const { const int e = u.pb >> 2, l = u.pm * BM - rb[e] + r; return (l < cnt[e]) ? ltok[(size_t)e * LISTCAP + l] : 0; }
};
}

#define XB_TMO      128
#define XB_XCNT(j)  (256  + 64 * (j))
#define XB_XSUB(j)  (1280 + 64 * (j))
#define XB_XGEN(j)  (2304 + 64 * (j))
#define XB_TOP      3328
#define XB_TOPGEN   3392
#define XCD_BAR_WORDS 3456
#define XB_SPIN_CAP (1u << 18)

__device__ __forceinline__ unsigned xb_ld(unsigned* p)              { return __hip_atomic_load(p, __ATOMIC_RELAXED, __HIP_MEMORY_SCOPE_AGENT); }
__device__ __forceinline__ unsigned xb_add(unsigned* p, unsigned v) { return __hip_atomic_fetch_add(p, v, __ATOMIC_RELAXED, __HIP_MEMORY_SCOPE_AGENT); }
__device__ __forceinline__ unsigned xb_xcc_id() { return (unsigned)__builtin_amdgcn_s_getreg((3 << 11) | 20) & 0xFu; }
#define XB_SPIN(cond, bar) do { unsigned _sp = 0; while (cond) { __builtin_amdgcn_s_sleep(1); \
    if ((++_sp & 255u) == 0u) { if (xb_ld(&(bar)[XB_TMO])) break; if (_sp > XB_SPIN_CAP) { atomicAdd(&(bar)[XB_TMO], 1u); break; } } } } while (0)

struct XcdBarrier {
    unsigned* bar; unsigned x;
    volatile LAS unsigned* st;
};

__device__ __forceinline__ XcdBarrier xcd_barrier_post(unsigned* bar, volatile LAS unsigned* st, int wave) {
    XcdBarrier b; b.bar = bar; b.x = xb_xcc_id(); b.st = st;
    if (wave == 0 && lane_id() == 0) (void)xb_add(&bar[XB_XCNT(b.x)], 1u);
    return b;
}
__device__ __forceinline__ void xcd_barrier_complete(unsigned* bar, unsigned x, unsigned& nloc, unsigned& nx) {
    const unsigned G = gridDim.x * gridDim.y * gridDim.z;
    unsigned sum, cnt, mine, sp = 0u;
    for (;;) {
        sum = 0u; cnt = 0u; mine = 0u;
#pragma unroll
        for (unsigned j = 0; j < 16; ++j) { const unsigned c = xb_ld(&bar[XB_XCNT(j)]); sum += c; cnt += (c > 0u) ? 1u : 0u; mine = (j == x) ? c : mine; }
        if (sum == G) break;
        __builtin_amdgcn_s_sleep(1);
        if ((++sp & 255u) == 0u) { if (xb_ld(&bar[XB_TMO])) break; if (sp > XB_SPIN_CAP) { atomicAdd(&bar[XB_TMO], 1u); break; } }
    }
    nloc = mine > 0u ? mine : 1u; nx = cnt > 0u ? cnt : 1u;
}

__device__ __forceinline__ void xcd_barrier(const XcdBarrier& b, int wave) {
    asm volatile("s_waitcnt vmcnt(0)" ::: "memory");
    __syncthreads();
    if (wave == 0 && lane_id() == 0) {
        unsigned* bar = b.bar;
        __builtin_amdgcn_s_waitcnt(0);
        unsigned nloc = b.st[0], nx = b.st[1];
        if (nloc == 0u) { xcd_barrier_complete(bar, b.x, nloc, nx); b.st[0] = nloc; b.st[1] = nx; }
        const unsigned old = xb_add(&bar[XB_XSUB(b.x)], 1u);
        const unsigned gen = old / nloc;
        if (old + 1u == (gen + 1u) * nloc) {
            __builtin_amdgcn_fence(__ATOMIC_RELEASE, "agent");
            asm volatile("s_waitcnt vmcnt(0)" ::: "memory");
            const unsigned og = xb_add(&bar[XB_TOP], 1u);
            const unsigned tg = og / nx;
            if (og + 1u == (tg + 1u) * nx) xb_add(&bar[XB_TOPGEN], 1u);
            else XB_SPIN(xb_ld(&bar[XB_TOPGEN]) == tg, bar);
            __builtin_amdgcn_fence(__ATOMIC_ACQUIRE, "agent");
            xb_add(&bar[XB_XGEN(b.x)], 1u);
            asm volatile("s_waitcnt vmcnt(0)" ::: "memory");
        } else {
            XB_SPIN(xb_ld(&bar[XB_XGEN(b.x)]) == gen, bar);
            __builtin_amdgcn_fence(__ATOMIC_ACQUIRE, "agent");
            asm volatile("s_waitcnt vmcnt(0)" ::: "memory");
        }
    }
    __syncthreads();
}

#define LG_SUB(g)  (3584 + 64 * (g))
#define LG_GEN(g)  (4160 + 64 * (g))
#define LG_MASK(g) (4736 + 64 * (g))
__device__ __forceinline__ void lg_barrier(const XcdBarrier& b, int wave, unsigned g, unsigned nloc, bool fast) {
    asm volatile("s_waitcnt vmcnt(0)" ::: "memory");
    __syncthreads();
    if (wave == 0 && lane_id() == 0) {
        unsigned* bar = b.bar;
        __builtin_amdgcn_s_waitcnt(0);
        if (!fast) { __builtin_amdgcn_fence(__ATOMIC_RELEASE, "agent"); asm volatile("s_waitcnt vmcnt(0)" ::: "memory"); }
        const unsigned old = xb_add(&bar[LG_SUB(g)], 1u), gen = old / nloc;
        if (old + 1u == (gen + 1u) * nloc) xb_add(&bar[LG_GEN(g)], 1u);
        else XB_SPIN(xb_ld(&bar[LG_GEN(g)]) == gen, bar);
        __builtin_amdgcn_fence(__ATOMIC_ACQUIRE, "agent");
        asm volatile("s_waitcnt vmcnt(0)" ::: "memory");
    }
    __syncthreads();
}

struct RowV { f32x4 v[4]; };
__device__ __forceinline__ void row_load(RowV& r, const float* row, int lane) {
#pragma unroll
    for (int j = 0; j < 4; ++j) r.v[j] = ntload((const f32x4*)(row + 4 * lane + 256 * j));
}
__device__ __forceinline__ void row_load_bf16(RowV& r, const bf16_t* row, int lane) {
#pragma unroll
    for (int j = 0; j < 4; ++j) { const u32x2 w = *(const u32x2*)(row + 4 * lane + 256 * j); r.v[j] = (f32x4){bflo(w.x), bfhi(w.x), bflo(w.y), bfhi(w.y)}; }
}
__device__ __forceinline__ float row_rstd(const RowV& r) {
    float s = 0.f;
#pragma unroll
    for (int j = 0; j < 4; ++j) s += (r.v[j].x * r.v[j].x + r.v[j].y * r.v[j].y) + (r.v[j].z * r.v[j].z + r.v[j].w * r.v[j].w);
    s = wave_sum(s);
    return __builtin_amdgcn_rsqf(s * (1.0f / 1024.0f) + EPS);
}
__device__ __forceinline__ void row_modulate(RowV& r, float rstd, const float* g, const float* sh, const float* sc, int lane) {
#pragma unroll
    for (int j = 0; j < 4; ++j) {
        const int o = 4 * lane + 256 * j;
        const f32x4 gg = *(const f32x4*)(g + o), s = *(const f32x4*)(sc + o), h = *(const f32x4*)(sh + o);
        r.v[j] = (r.v[j] * rstd * gg) * (s + 1.0f) + h;
    }
}
struct ModV { f32x4 gp[4], sh[4]; };
__device__ __forceinline__ void mod_load(ModV& m, const float* g, const float* sh, const float* sc, int lane) {
#pragma unroll
    for (int j = 0; j < 4; ++j) { const int o = 4 * lane + 256 * j; m.gp[j] = *(const f32x4*)(g + o) * (*(const f32x4*)(sc + o) + 1.0f); m.sh[j] = *(const f32x4*)(sh + o); }
}
__device__ __forceinline__ void row_apply(RowV& r, float rstd, const ModV& m) {
#pragma unroll
    for (int j = 0; j < 4; ++j) r.v[j] = (r.v[j] * rstd) * m.gp[j] + m.sh[j];
}
__device__ __forceinline__ void row_store_bf16(const RowV& r, bf16_t* out, int lane) {
#pragma unroll
    for (int j = 0; j < 4; ++j) { u32x2 w; w.x = pg8::cvt_pk_bf16(r.v[j].x, r.v[j].y); w.y = pg8::cvt_pk_bf16(r.v[j].z, r.v[j].w); *(u32x2*)(out + 4 * lane + 256 * j) = w; }
}
__device__ __forceinline__ void row_store_f32(const RowV& r, float* out, int lane) {
#pragma unroll
    for (int j = 0; j < 4; ++j) *(f32x4*)(out + 4 * lane + 256 * j) = r.v[j];
}

__device__ __forceinline__ int wmap(int code, int n) {
    if (code == 1) { const int isU = n >> 10, ch = n & 1023; return (ch >> 7) * 256 + isU * 128 + (ch & 127); }
    if (code == 2) { const int typ = (n % 1536) / 512, d = n & 63; return (typ < 2 && d >= 4 && d < 12) ? (d < 8 ? n + 4 : n - 4) : n; }
    if (code == 3) return (n >> 7) * 256 + (n & 127);
    if (code == 4) return (n >> 7) * 256 + 128 + (n & 127);
    return n;
}
struct ConvDesc { const float* src; bf16_t* dst; int ldw, K, code, nloc; };
__device__ __forceinline__ void conv_desc(ConvDesc& d, const float* W, int ldw, int ncol0, bf16_t* WT, int K, int code, int kb, int nb) {
    d.src = W + (size_t)(64 * kb) * ldw + ncol0 + 64 * nb; d.dst = WT + 64 * kb; d.ldw = ldw; d.K = K; d.code = code; d.nloc = 64 * nb;
}
__device__ __forceinline__ void conv_load(f32x4 (&v)[16], const ConvDesc& d, int lane) {
    const float* src = d.src + (size_t)(lane >> 4) * d.ldw + (lane & 15) * 4;
#pragma unroll
    for (int i = 0; i < 16; ++i) v[i] = ntload((const f32x4*)(src + (size_t)(4 * i) * d.ldw));
}
__device__ __forceinline__ void conv_process(const f32x4 (&v)[16], const ConvDesc& d, LAS float* scr, int lane) {
#pragma unroll
    for (int i = 0; i < 16; ++i) { LAS float* p = scr + (4 * i + (lane >> 4)) * 65 + (lane & 15) * 4; p[0] = v[i].x; p[1] = v[i].y; p[2] = v[i].z; p[3] = v[i].w; }
    LDS_WAIT();
    const int c = lane & 7;
#pragma unroll
    for (int j = 0; j < 8; ++j) { const int n = (lane >> 3) + 8 * j; const LAS float* sp = scr + (8 * c) * 65 + n;
        u32x4 o; o.x = pg8::cvt_pk_bf16(sp[0 * 65], sp[1 * 65]); o.y = pg8::cvt_pk_bf16(sp[2 * 65], sp[3 * 65]); o.z = pg8::cvt_pk_bf16(sp[4 * 65], sp[5 * 65]); o.w = pg8::cvt_pk_bf16(sp[6 * 65], sp[7 * 65]);
        *(u32x4*)(d.dst + (size_t)wmap(d.code, d.nloc + n) * d.K + 8 * c) = o; }
    LDS_WAIT();
}
constexpr int NCONV_ITEMS = 512 + 256 + 256 + 1152 + 128 + 64 * 384;

namespace att {
typedef short bf16x8 __attribute__((ext_vector_type(8)));
typedef short s16x4 __attribute__((ext_vector_type(4)));
typedef float f32x16 __attribute__((ext_vector_type(16)));
constexpr int NKEY = 384, KOFF = 0, KCH = NKEY * 16 + 16  , VOFF = 8 * KCH, VDH = (NKEY / 16) * 1024 + 64  , NUNITS = 16 * 3 * 16 * 8;
__device__ __forceinline__ int crow(int r, int hi) { return (r & 3) + 8 * (r >> 2) + 4 * hi; }
__device__ __forceinline__ s16x4 vtr(const LAS unsigned char* p) { return __builtin_bit_cast(s16x4, __builtin_amdgcn_ds_read_tr16_b64_v4i16((LAS s16x4*)p)); }
__device__ __forceinline__ float xhalf_max(float m) { auto rr = __builtin_amdgcn_permlane32_swap(__float_as_uint(m), __float_as_uint(m), false, false); return fmaxf(__uint_as_float(rr[0]), __uint_as_float(rr[1])); }
__device__ __forceinline__ float xhalf_sum(float m) { auto rr = __builtin_amdgcn_permlane32_swap(__float_as_uint(m), __float_as_uint(m), false, false); return __uint_as_float(rr[0]) + __uint_as_float(rr[1]); }

template <typename P> __device__ __forceinline__ P sadd(P base, unsigned off) { asm volatile("" : "+v"(off)); return base + off; }
struct AUnit { int h, g, b, dil, l0, r0; size_t tb; };
template <bool MERGE> __device__ __forceinline__ void adecode(AUnit& u, int idx) {
    const int sb = ((idx >> 4) & 7) * 2 + (idx & 1), bg = idx >> 7; u.b = MERGE ? bg : (bg >> 1);
    u.h = (idx >> 1) & 7; u.g = MERGE ? 2 : (bg & 1); const int dsh = 2 * u.g; u.dil = 1 << dsh;
    const int bps = 16 >> dsh, r = sb / bps; u.l0 = (sb - r * bps) * 256; u.r0 = r << (12 - dsh); u.tb = (size_t)u.b * SEQ + r;
}
__device__ __forceinline__ void aload_kv(u32x4 (&kv)[12], const AUnit& u, const bf16_t* qkv, int wave, int lane) {
    const char* kb = (const char*)(qkv + qkv_block(1, u.g, u.b, u.h) + (size_t)u.r0 * 64); const char* vb = kb + (qkv_block(2, 0, 0, 0) - qkv_block(1, 0, 0, 0)) * 2;
#pragma unroll
    for (int i = 0; i < 6; ++i) {
        int sp = u.l0 - 128 + 48 * wave + 8 * i + (lane >> 3); sp = sp < 0 ? 0 : sp;
        const unsigned ro = (unsigned)sp * 128u + (unsigned)(lane & 7) * 16u;
        kv[i] = *(const u32x4*)sadd(kb, ro); kv[6 + i] = *(const u32x4*)sadd(vb, ro);
    }
}
__device__ __forceinline__ void astore_kv(const u32x4 (&kv)[12], LAS unsigned char* lds, int wave, int lane) {
#pragma unroll
    for (int i = 0; i < 6; ++i) { const int key = 48 * wave + 8 * i + (lane >> 3);
        *(LAS u32x4*)(lds + KOFF + (lane & 7) * KCH + key * 16) = kv[i];
        *(LAS u32x4*)(lds + VOFF + ((lane & 7) >> 2) * VDH + (key >> 4) * 1024 + (key & 15) * 64 + (lane & 3) * 16) = kv[6 + i]; }
}
__device__ __forceinline__ char* aqrow(const AUnit& u, bf16_t* qkv, int wave) {
    return (char*)(qkv + qkv_block(0, u.g, u.b, u.h) + (size_t)(u.r0 + u.l0 + 32 * wave) * 64);
}

template <bool MERGE> __device__ __forceinline__ void attn_phase(LAS unsigned char* lds, bf16_t* qkv, float* lse, bf16_t* ob, int bid, int G, int wave, bool dry = false) {
    constexpr int NU = MERGE ? NUNITS / 3 : 2 * NUNITS / 3;
    const int per = (NU + G - 1) / G;
    const int u_lo = bid * per, u_hi = (u_lo + per < NU) ? u_lo + per : NU;
    asm volatile("" : "+s"(wave));
    const int lane = lane_id(), r32 = lane & 31, hi = lane >> 5;
    const int qt = wave;
    const unsigned qlo = (unsigned)r32 * 128u + (unsigned)hi * 16u;
    u32x4 kv[12]; bf16x8 qn[4];
    AUnit un;
    if (u_lo < u_hi) { adecode<MERGE>(un, u_lo); aload_kv(kv, un, qkv, wave, lane);
        { const char* q = aqrow(un, qkv, wave);
#pragma unroll
            for (int d0 = 0; d0 < 4; ++d0) qn[d0] = *(const bf16x8*)(sadd(q, qlo) + d0 * 32); } }
#pragma unroll 1
    for (int idx = u_lo; idx < u_hi; ++idx) {
        const AUnit u = un;
        const int g = u.g, l0 = u.l0, head = u.h;
        char* qrow = aqrow(u, qkv, wave);
        const size_t tqw = u.tb + (size_t)(l0 + 32 * qt) * u.dil;
        bf16x8 qf[4];
        astore_kv(kv, lds, wave, lane);
#pragma unroll
        for (int d0 = 0; d0 < 4; ++d0) qf[d0] = qn[d0];
        __syncthreads();
        if (idx + 1 < u_hi) { adecode<MERGE>(un, idx + 1); aload_kv(kv, un, qkv, wave, lane);
            { const char* q = aqrow(un, qkv, wave);
#pragma unroll
                for (int d0 = 0; d0 < 4; ++d0) qn[d0] = *(const bf16x8*)(sadd(q, qlo) + d0 * 32); } }
        u32x2 og[MERGE ? 2 : 1][2][4]; float lg0 = 0.f, lg1 = 0.f;
        if constexpr (MERGE) {
            const int pq = (int)(tqw & (SEQ - 1)) + r32 * u.dil; const char* oq0 = (const char*)(qkv + qkv_block(0, 0, u.b, head)); const char* oq1 = (const char*)(qkv + qkv_block(0, 1, u.b, head));
            const unsigned oo0 = (unsigned)qkv_row(pq, 0) * 128u + 8u * hi, oo1 = (unsigned)qkv_row(pq, 1) * 128u + 8u * hi;
#pragma unroll
            for (int gg = 0; gg < 2; ++gg)
#pragma unroll
                for (int d0 = 0; d0 < 2; ++d0)
#pragma unroll
                    for (int rg = 0; rg < 4; ++rg) og[gg][d0][rg] = *(const u32x2*)(sadd(gg ? oq1 : oq0, gg ? oo1 : oo0) + (d0 * 64 + 16 * rg));
            const char* lb = (const char*)(lse + tqw * 24 + head); const unsigned lo_ = (unsigned)(r32 * u.dil) * 96u;
            lg0 = *(const float*)sadd(lb, lo_); lg1 = *(const float*)(sadd(lb, lo_) + 32);
        }
        f32x16 p[5];
        const LAS unsigned char* kb = lds + KOFF + hi * KCH + (qt * 32 + r32) * 16;
#pragma unroll
        for (int j = 0; j < 5; ++j) {
#pragma unroll
            for (int rr = 0; rr < 16; ++rr) p[j][rr] = 0.f;
#pragma unroll
            for (int d0 = 0; d0 < 4; ++d0) {
                const bf16x8 kf = *(const LAS bf16x8*)(kb + j * 512 + d0 * 2 * KCH);
                p[j] = __builtin_amdgcn_mfma_f32_32x32x16_bf16(kf, qf[d0], p[j], 0, 0, 0);
            }
        }
#pragma unroll
        for (int rr = 0; rr < 16; ++rr) { const int c = crow(rr, hi); if (c < r32) p[0][rr] = -INFINITY; if (c > r32) p[4][rr] = -INFINITY; }
        if (l0 == 0) {
#pragma unroll
            for (int j = 0; j < 5; ++j)
#pragma unroll
                for (int rr = 0; rr < 16; ++rr) if (32 * (qt + j) + crow(rr, hi) < 128) p[j][rr] = -INFINITY;
        }
        float m = p[0][0];
#pragma unroll
        for (int j = 0; j < 5; ++j)
#pragma unroll
            for (int rr = 0; rr < 16; ++rr) m = fmaxf(m, p[j][rr]);
        m = xhalf_max(m);
        float l = 0.f;
#pragma unroll
        for (int j = 0; j < 5; ++j)
#pragma unroll
            for (int rr = 0; rr < 16; ++rr) { const float e = __builtin_amdgcn_exp2f(p[j][rr] - m); p[j][rr] = e; l += e; }
        l = xhalf_sum(l);
        f32x16 o[2];
#pragma unroll
        for (int rr = 0; rr < 16; ++rr) { o[0][rr] = 0.f; o[1][rr] = 0.f; }
        const LAS unsigned char* vb = lds + VOFF + ((lane >> 4) & 1) * 32 + (lane & 3) * 8 + (4 * hi + ((lane & 15) >> 2)) * 64 + qt * 2048;
#pragma unroll
        for (int j = 0; j < 5; ++j)
#pragma unroll
            for (int s = 0; s < 2; ++s) {
                u32x4 pw; pw.x = pg8::cvt_pk_bf16(p[j][8 * s + 0], p[j][8 * s + 1]); pw.y = pg8::cvt_pk_bf16(p[j][8 * s + 2], p[j][8 * s + 3]);
                pw.z = pg8::cvt_pk_bf16(p[j][8 * s + 4], p[j][8 * s + 5]); pw.w = pg8::cvt_pk_bf16(p[j][8 * s + 6], p[j][8 * s + 7]);
                const bf16x8 pf = __builtin_bit_cast(bf16x8, pw);
#pragma unroll
                for (int d0 = 0; d0 < 2; ++d0) {
                    const s16x4 vlo = vtr(vb + d0 * VDH + (2 * j + s) * 1024), vhi = vtr(vb + d0 * VDH + (2 * j + s) * 1024 + 512);
                    const bf16x8 vf = {vlo[0], vlo[1], vlo[2], vlo[3], vhi[0], vhi[1], vhi[2], vhi[3]};
                    o[d0] = __builtin_amdgcn_mfma_f32_32x32x16_bf16(vf, pf, o[d0], 0, 0, 0);
                }
            }
        if constexpr (!MERGE) {
            const float inv = 1.0f / l;
#pragma unroll
            for (int d0 = 0; d0 < 2; ++d0)
#pragma unroll
                for (int rg = 0; rg < 4; ++rg) {
                    u32x2 w; w.x = pg8::cvt_pk_bf16(o[d0][4 * rg] * inv, o[d0][4 * rg + 1] * inv); w.y = pg8::cvt_pk_bf16(o[d0][4 * rg + 2] * inv, o[d0][4 * rg + 3] * inv);
                    if (!dry) *(u32x2*)(sadd(qrow, (unsigned)r32 * 128u + 8u * hi) + (d0 * 64 + 16 * rg)) = w; else asm volatile("" :: "v"(w.x), "v"(w.y));
                }
            if (hi == 0 && !dry) *(float*)((char*)(lse + tqw * 24 + g * 8 + head) + (unsigned)(r32 * u.dil) * 96u) = m + __builtin_amdgcn_logf(l);
        } else {
            const float lg2 = m + __builtin_amdgcn_logf(l), mx = fmaxf(lg2, fmaxf(lg0, lg1));
            const float w0 = __builtin_amdgcn_exp2f(lg0 - mx), w1 = __builtin_amdgcn_exp2f(lg1 - mx), w2 = __builtin_amdgcn_exp2f(lg2 - mx);
            const float iw = 1.0f / (w0 + w1 + w2), c0 = w0 * iw, c1 = w1 * iw, c2 = w2 * iw / l;
            char* orow = (char*)(ob + tqw * 512 + head * 64); const unsigned oro = (unsigned)(r32 * u.dil) * 1024u + 8u * hi;
#pragma unroll
            for (int d0 = 0; d0 < 2; ++d0)
#pragma unroll
                for (int rg = 0; rg < 4; ++rg) {
                    const u32x2 a = og[0][d0][rg], b = og[1][d0][rg];
                    u32x2 w; w.x = pg8::cvt_pk_bf16(c0 * bflo(a.x) + c1 * bflo(b.x) + c2 * o[d0][4 * rg], c0 * bfhi(a.x) + c1 * bfhi(b.x) + c2 * o[d0][4 * rg + 1]);
                    w.y = pg8::cvt_pk_bf16(c0 * bflo(a.y) + c1 * bflo(b.y) + c2 * o[d0][4 * rg + 2], c0 * bfhi(a.y) + c1 * bfhi(b.y) + c2 * o[d0][4 * rg + 3]);
                    if (!dry) *(u32x2*)(sadd(orow, oro) + (d0 * 64 + 16 * rg)) = w; else asm volatile("" :: "v"(w.x), "v"(w.y));
                }
        }
        __syncthreads();
    }
}
}

typedef const __attribute__((address_space(4))) unsigned long long* kargp_t;
__device__ __forceinline__ kargp_t karg() { kargp_t p = (kargp_t)__builtin_amdgcn_kernarg_segment_ptr(); asm volatile("" : "+s"(p)); return p; }
#define KIN(i) ((const float*)(GAS const float*)karg()[i])
#define KOUT() ((float*)(GAS float*)karg()[19])
#define KWS() ((unsigned char*)(GAS unsigned char*)karg()[20])
#define WSP(type, off) ((type*)(KWS() + (off)))
struct Args { const float* in[19]; float* out; unsigned char* ws; int ph_lo, ph_hi; };
constexpr int NPHASE = 17;

__global__ void __launch_bounds__(NWAVES * 64, 2) mk_fwd(Args args) {
    extern __shared__ __attribute__((aligned(16))) unsigned char lds_raw[];
    LAS unsigned char* lds = (LAS unsigned char*)lds_raw;
    volatile LAS unsigned* MISC = (volatile LAS unsigned*)(lds + MISC_OFF);
    LAS int* rb = (LAS int*)(lds + MISC_OFF);
    const int wave = __builtin_amdgcn_readfirstlane((int)threadIdx.x >> 6);
#define IDS() const int lane = lane_id(), tid = wave * 64 + lane; (void)tid; (void)lane
    const int G = gridDim.x, bid = blockIdx.x;
    for (int u = threadIdx.x; u < (LDS_BYTES - MISC_OFF) / 4; u += NWAVES * 64) MISC[u] = 0u;
    __syncthreads();
#if MK_ONE_LAUNCH
    XcdBarrier bar = xcd_barrier_post((unsigned*)(KWS() + WS_CTL) + CW_BAR, MISC + 40, wave);
    if (threadIdx.x == 0) atomicOr(&bar.bar[LG_MASK(bid & 7)], 1u << bar.x);
#define GRID_BAR() xcd_barrier(bar, wave)
#define LOCAL_OK() (G == 256)
#define CBID() (LOCAL_OK() ? ((bid & 7) * 32 + (bid >> 3)) : bid)
#define LOCAL_BAR() do { if (LOCAL_OK()) lg_barrier(bar, wave, (unsigned)(bid & 7), 32u, MISC[42] != 0u); else GRID_BAR(); } while (0)
#else
#define GRID_BAR() do { } while (0)
#define LOCAL_OK() false
#define CBID() bid
#define LOCAL_BAR() do { } while (0)
#endif
#if MK_ONE_LAUNCH
    constexpr int lo = 0, hi = NPHASE; (void)args;
#else
    const int lo = args.ph_lo, hi = args.ph_hi;
#endif
#ifndef PHMASK
#define PHMASK 0xFFFFFFFFu
#endif
#define IN(k) ((((PHMASK) >> (k)) & 1u) && lo <= (k) && (k) < hi)
#ifndef REPMASK
#define REPMASK 0u
#endif
#define REPS(k) ((((REPMASK) >> (k)) & 1u) ? 2 : 1)
#define SEAM(k) do { if (IN(k) && IN((k) + 1)) GRID_BAR(); } while (0)
#define LSEAM(k) do { if (IN(k) && IN((k) + 1)) LOCAL_BAR(); } while (0)

    for (int rep_ = 0; rep_ < REPS(0); ++rep_) if (IN(0)) { IDS();
        const float* cin = KIN(1); const float* ada_w = KIN(4); const float* ada_b = KIN(5); float* mod = WSP(float, WS_MOD); float* rope = WSP(float, WS_ROPE);
        LAS float* cact = (LAS float*)lds; LAS float* red = cact + 16384;
        if (bid < 192) for (int i = tid; i < 16 * 1024; i += 512) { const float v = cin[i]; cact[i] = v / (1.f + expf(-v)); }
        __syncthreads();
        for (int item = bid; item < 192; item += G) {
            const int l = item / 96, n0 = (item % 96) * 64, kk = lane >> 4, n4 = lane & 15;
            f32x4 acc[16];
#pragma unroll
            for (int b = 0; b < 16; ++b) acc[b] = (f32x4){0.f, 0.f, 0.f, 0.f};
            const float* w = ada_w + (size_t)l * 1024 * 6144 + n0 + n4 * 4;
#pragma unroll 1
            for (int kb = 0; kb < 2; ++kb) {
                const int k0 = wave * 128 + kb * 64 + kk;
                f32x4 wv[16];
#pragma unroll
                for (int u = 0; u < 16; ++u) wv[u] = *(const f32x4*)(w + (size_t)(k0 + 4 * u) * 6144);
#pragma unroll
                for (int u = 0; u < 16; ++u)
#pragma unroll
                    for (int b = 0; b < 16; ++b) acc[b] += wv[u] * cact[b * 1024 + k0 + 4 * u];
            }
            const bool h5 = (lane & 32) != 0;
#pragma unroll
            for (int b = 0; b < 16; ++b)
#pragma unroll
                for (int c = 0; c < 4; ++c) { float v = acc[b][c]; v += xlane<16>(v); v += xlane32(v, h5); acc[b][c] = v; }
            if (lane < 16) {
#pragma unroll
                for (int b = 0; b < 16; ++b) *(LAS f32x4*)(red + (wave * 16 + b) * 64 + n4 * 4) = acc[b];
            }
            __syncthreads();
            for (int i = tid; i < 1024; i += 512) {
                const int b = i >> 6, nn = i & 63; float s = 0.f;
#pragma unroll
                for (int q = 0; q < 8; ++q) s += red[(q * 16 + b) * 64 + nn];
                mod[((size_t)l * 16 + b) * 6144 + n0 + nn] = s + ada_b[l * 6144 + n0 + nn];
            }
            __syncthreads();
        }
        for (int i = bid * 512 + tid; i < 4096 * 8; i += G * 512) {
            const int t = i >> 3, f = i & 7;
            const float inv = powf(500000.0f, -(float)(2 * f) / 16.0f);
            const float ang = (float)t * inv;
            rope[i] = (float)cos((double)ang);
            rope[4096 * 8 + i] = (float)sin((double)ang);
        }
    }
    SEAM(0);
    if (threadIdx.x == 0) { const unsigned m_ = xb_ld(&bar.bar[LG_MASK(bid & 7)]); MISC[42] = ((m_ & (m_ - 1u)) == 0u) ? 1u : 0u; }
    __syncthreads();
    for (int rep_ = 0; rep_ < REPS(1); ++rep_) if (IN(1)) { IDS();
        {
        LAS float* scr = (LAS float*)(lds + wave * 16640);
        const float* conv_in_w = KIN(6); const float* conv_out_w = KIN(8); const float* attn_in_w = KIN(9); const float* attn_out_w = KIN(10);
        const float* gate_w = KIN(15); const float* up_w = KIN(16); const float* down_w = KIN(17);
        bf16_t* WZ = WSP(bf16_t, WS_WZ); bf16_t* WB = WSP(bf16_t, WS_WB); bf16_t* WCO = WSP(bf16_t, WS_WCO); bf16_t* WAI = WSP(bf16_t, WS_WAI); bf16_t* WAO = WSP(bf16_t, WS_WAO);
        bf16_t* WGU = WSP(bf16_t, WS_WGU); bf16_t* WDN = WSP(bf16_t, WS_WDN);
#define CONV_DECODE(DD, IT) do { int it = (IT); \
            if (it < 512) { conv_desc(DD, conv_in_w, 3072, 1024, WZ, 1024, 1, it / 32, it % 32); break; } it -= 512; \
            if (it < 256) { conv_desc(DD, conv_in_w, 3072, 0, WB, 1024, 0, it / 16, it % 16); break; } it -= 256; \
            if (it < 256) { conv_desc(DD, conv_out_w, 1024, 0, WCO, 1024, 0, it / 16, it % 16); break; } it -= 256; \
            if (it < 1152) { conv_desc(DD, attn_in_w, QKVW, 0, WAI, 1024, 2, it / 72, it % 72); break; } it -= 1152; \
            if (it < 128) { conv_desc(DD, attn_out_w, 1024, 0, WAO, 512, 0, it / 16, it % 16); break; } it -= 128; \
            const int le = it / 384, r = it % 384; \
            if (r < 128) conv_desc(DD, gate_w + (size_t)le * D * DEXP, DEXP, 0, WGU + (size_t)le * 1024 * 1024, 1024, 3, r / 8, r % 8); \
            else if (r < 256) conv_desc(DD, up_w + (size_t)le * D * DEXP, DEXP, 0, WGU + (size_t)le * 1024 * 1024, 1024, 4, (r - 128) / 8, (r - 128) % 8); \
            else conv_desc(DD, down_w + (size_t)le * DEXP * D, D, 0, WDN + (size_t)le * 1024 * 512, 512, 0, (r - 256) / 16, (r - 256) % 16); } while (0)
        {
            const int step = G * NWAVES; int it0 = bid * NWAVES + wave;
            ConvDesc dA, dB; f32x4 vA[16], vB[16];
            if (it0 < NCONV_ITEMS) { CONV_DECODE(dA, it0); conv_load(vA, dA, lane); }
#pragma unroll 1
            for (; it0 < NCONV_ITEMS; it0 += 2 * step) {
                const bool hasB = it0 + step < NCONV_ITEMS, hasA2 = it0 + 2 * step < NCONV_ITEMS;
                if (hasB) { CONV_DECODE(dB, it0 + step); conv_load(vB, dB, lane); }
                conv_process(vA, dA, scr, lane);
                if (hasA2) { CONV_DECODE(dA, it0 + 2 * step); conv_load(vA, dA, lane); }
                if (hasB) conv_process(vB, dB, scr, lane);
            }
        }
#undef CONV_DECODE
        }
        const float* x = KIN(0); const float* norm_mix_g = KIN(2); const float* mod = WSP(float, WS_MOD); bf16_t* xn = WSP(bf16_t, WS_XN);
        for (int w0 = (bid * 8 + wave) * 32; w0 < T; w0 += G * 8 * 32) {
            const float* mb = mod + (size_t)(w0 >> 12) * 6144;
            ModV mv; mod_load(mv, norm_mix_g, mb + 0, mb + 1024, lane);
            RowV ring[4];
#pragma unroll
            for (int d = 0; d < 4; ++d) row_load(ring[d], x + (size_t)(w0 + d) * D, lane);
#pragma unroll 1
            for (int i = 0; i < 32; i += 4) {
#pragma unroll
                for (int d = 0; d < 4; ++d) {
                    const int row = w0 + i + d;
                    RowV r = ring[d];
                    if (i < 28) row_load(ring[d], x + (size_t)(row + 4) * D, lane);
                    const float rstd = row_rstd(r);
                    row_apply(r, rstd, mv);
                    row_store_bf16(r, xn + (size_t)row * D, lane);
                }
            }
        }
    }
    SEAM(1);
    for (int rep_ = 0; rep_ < REPS(2); ++rep_) if (IN(2)) { bf16_t* xn = WSP(bf16_t, WS_XN); bf16_t* WZ = WSP(bf16_t, WS_WZ); bf16_t* zb = WSP(bf16_t, WS_Z);
        pg8::Gemm g{xn, WZ, T, 2048, 1024}; pg8::StaticOrder S; S.init(T, 2048, G, bid); pg8::EpiPair<false> E{zb, D};
        pg8::gemm_phase<pg8::EpiPair<false>, pg8::StaticOrder, pg8::APlain, true, true>(lds, g, S, E, pg8::APlain{}, wave); }
    LSEAM(2);
    for (int rep_ = 0; rep_ < REPS(3); ++rep_) if (IN(3)) { bf16_t* xn = WSP(bf16_t, WS_XN); bf16_t* WB = WSP(bf16_t, WS_WB); bf16_t* zb = WSP(bf16_t, WS_Z); bf16_t* ypre = WSP(bf16_t, WS_YPRE); const float* conv_w = KIN(7);
        pg8::Gemm g{xn, WB, T, 1024, 1024}; pg8::StaticOrder S; S.init(T, 1024, G, bid); pg8::EpiYpre E{ypre, zb, conv_w};
        pg8::gemm_phase<pg8::EpiYpre, pg8::StaticOrder, pg8::APlain, true, true>(lds, g, S, E, pg8::APlain{}, wave); }
    LSEAM(3);
    for (int rep_ = 0; rep_ < REPS(4); ++rep_) if (IN(4)) { bf16_t* ypre = WSP(bf16_t, WS_YPRE); bf16_t* WCO = WSP(bf16_t, WS_WCO); bf16_t* xr = (bf16_t*)KOUT(); const float* x = KIN(0); const float* mod = WSP(float, WS_MOD);
        pg8::Gemm g{ypre, WCO, T, 1024, 1024}; pg8::StaticOrder S; S.init(T, 1024, G, bid); pg8::EpiRes<true> E{xr, x, mod + 2048};
        pg8::gemm_phase<pg8::EpiRes<true>, pg8::StaticOrder, pg8::APlain, true, true>(lds, g, S, E, pg8::APlain{}, wave); }
    LSEAM(4);
    { constexpr int l = 0;
        const int pb0 = (l == 0) ? 5 : 13;
#define MODL() (WSP(float, WS_MOD) + (size_t)l * 16 * 6144)
#define CNTL() (WSP(int, WS_CTL) + 64 * l)
        if (l == 1) {
#ifdef STAGGER9
            if (IN(9)) { const unsigned long long t0_ = __builtin_amdgcn_s_memrealtime(); const unsigned long long dl_ = (unsigned long long)(((bid >> 3) & 31) * STAGGER9 / 32);
                while (__builtin_amdgcn_s_memrealtime() - t0_ < dl_) __builtin_amdgcn_s_sleep(16); }
#endif
            for (int rep_ = 0; rep_ < REPS(9); ++rep_) if (IN(9)) { bf16_t* xn = WSP(bf16_t, WS_XN); bf16_t* WAI = WSP(bf16_t, WS_WAI); bf16_t* qkv = WSP(bf16_t, WS_QKV); const float* rope = WSP(float, WS_ROPE);
                pg8::Gemm g{xn, WAI, T, QKVW, 1024}; pg8::StaticOrder S; S.init(T, QKVW, G, bid, 8); pg8::EpiQKV E{qkv, rope, 0};
                pg8::gemm_phase<pg8::EpiQKV, pg8::StaticOrder, pg8::APlain, true, true>(lds, g, S, E, pg8::APlain{}, wave); }
            LSEAM(9);
            if (IN(10)) att::attn_phase<false>(lds, WSP(bf16_t, WS_QKV), WSP(float, WS_LSE), WSP(bf16_t, WS_OB), CBID(), G, wave);
            LSEAM(10);
            if (IN(11)) att::attn_phase<true>(lds, WSP(bf16_t, WS_QKV), WSP(float, WS_LSE), WSP(bf16_t, WS_OB), CBID(), G, wave);
            LSEAM(11);
            if (IN(12)) { bf16_t* ob = WSP(bf16_t, WS_OB); bf16_t* WAO = WSP(bf16_t, WS_WAO); bf16_t* xr = (bf16_t*)KOUT();
                pg8::Gemm g{ob, WAO, T, 1024, 512}; pg8::StaticOrder S; S.init(T, 1024, G, bid); pg8::EpiRes<false> E{xr, nullptr, MODL() + 2048};
                pg8::gemm_phase<pg8::EpiRes<false>, pg8::StaticOrder, pg8::APlain, true, true>(lds, g, S, E, pg8::APlain{}, wave); }
            LSEAM(12);
        }
        for (int rep_ = 0; rep_ < REPS(5); ++rep_) if (IN(pb0)) { IDS(); const bool dry = rep_ + 1 < REPS(5);
            LAS f32x4* TG = (LAS f32x4*)lds; LAS f32x4* TE = (LAS f32x4*)(lds + 16384);
            LAS int* rec_e = (LAS int*)(lds + 147456); LAS float* rec_w = (LAS float*)(lds + 147456 + 2048); LAS int* rec_rank = (LAS int*)(lds + 147456 + 4096);
            LAS int* hist = (LAS int*)(lds + 147456 + 6144); LAS int* base = (LAS int*)(lds + 147456 + 6144 + 128);
            const float* gff = KIN(3) + l * D; const float* wg = KIN(11) + (size_t)l * D * 4; const float* bg = KIN(12) + l * 4; const float* we = KIN(13) + (size_t)l * 4 * D * 8; const float* be = KIN(14) + l * 32;
            const bf16_t* xr = (const bf16_t*)KOUT(); const float* modl = MODL(); int* cntl = CNTL(); bf16_t* xn = WSP(bf16_t, WS_XN); int* ltok = WSP(int, WS_LTOK); float* lw = WSP(float, WS_LW); int* tslot = WSP(int, WS_TSLOT);
            for (int i = tid; i < 1024; i += 512) { const int ln = i & 63, jc = i >> 6, k = 4 * ln + 256 * (jc >> 2) + (jc & 3); TG[i] = *(const f32x4*)(wg + (size_t)k * 4); }
            for (int i = tid; i < 8192; i += 512) { const int ln = i & 63, jc = (i >> 6) & 15, half = (i >> 10) & 1, gi = i >> 11, k = 4 * ln + 256 * (jc >> 2) + (jc & 3);
                TE[i] = *(const f32x4*)(we + ((size_t)gi * 1024 + k) * 8 + half * 4); }
            __syncthreads();
            const bool h5 = (lane & 32) != 0, h4 = (lane & 16) != 0, h3 = (lane & 8) != 0;
            for (int blk = CBID(); blk < T / 256; blk += G) {
                if (tid < 32) hist[tid] = 0;
                __syncthreads();
                ModV mv; { const float* mb = modl + (size_t)((blk * 256) >> 12) * 6144; mod_load(mv, gff, mb + 3072, mb + 4096, lane); }
                u32x2 ring[4][4];
#pragma unroll
                for (int d = 0; d < 4; ++d)
#pragma unroll
                    for (int j = 0; j < 4; ++j) ring[d][j] = *(const u32x2*)(xr + (size_t)(blk * 256 + wave * 32 + d) * XRP + 4 * lane + 256 * j);
#pragma unroll 1
                for (int i4 = 0; i4 < 32; i4 += 4)
#pragma unroll
                for (int d = 0; d < 4; ++d) {
                    const int i = i4 + d, rl = wave * 32 + i, row = blk * 256 + rl;
                    RowV r;
#pragma unroll
                    for (int j = 0; j < 4; ++j) { const u32x2 w = ring[d][j]; r.v[j] = (f32x4){bflo(w.x), bfhi(w.x), bflo(w.y), bfhi(w.y)}; }
                    if (i4 < 28) {
#pragma unroll
                        for (int j = 0; j < 4; ++j) ring[d][j] = *(const u32x2*)(xr + (size_t)(row + 4) * XRP + 4 * lane + 256 * j); }
                    const float rstd = row_rstd(r);
                    row_apply(r, rstd, mv);
                    row_store_bf16(r, xn + (size_t)row * D, lane);
                    f32x4 pg = {0.f, 0.f, 0.f, 0.f};
#pragma unroll
                    for (int jc = 0; jc < 16; ++jc) pg += TG[jc * 64 + lane] * r.v[jc >> 2][jc & 3];
                    float gl[4];
                    { float b0 = (h5 ? pg.z : pg.x) + xlane32(h5 ? pg.x : pg.z, h5), b1 = (h5 ? pg.w : pg.y) + xlane32(h5 ? pg.y : pg.w, h5);
                      float c = (h4 ? b1 : b0) + xlane<16>(h4 ? b0 : b1);
                      c += xlane<8>(c); c += xlane<4>(c); c += xlane<2>(c); c += xlane<1>(c);
#pragma unroll
                      for (int o = 0; o < 4; ++o) gl[o] = __int_as_float(__builtin_amdgcn_readlane(__float_as_int(c), 16 * o)) + bg[o]; }
                    int gi = 0; float gm = gl[0];
#pragma unroll
                    for (int o = 1; o < 4; ++o) if (gl[o] > gm) { gm = gl[o]; gi = o; }
                    float gden = 0.f;
#pragma unroll
                    for (int o = 0; o < 4; ++o) gden += __builtin_amdgcn_exp2f((gl[o] - gm) * 1.4426950408889634f);
                    const float grp_p = __builtin_amdgcn_rcpf(gden);
                    f32x4 pa = {0.f, 0.f, 0.f, 0.f}, pb = {0.f, 0.f, 0.f, 0.f};
                    const LAS f32x4* te = TE + gi * 2048 + lane;
#pragma unroll
                    for (int jc = 0; jc < 16; ++jc) { const float hv = r.v[jc >> 2][jc & 3]; pa += te[jc * 64] * hv; pb += te[1024 + jc * 64] * hv; }
                    float el[8];
                    { const f32x4 keep = h5 ? pb : pa, send = h5 ? pa : pb;
                      f32x4 q; q.x = keep.x + xlane32(send.x, h5); q.y = keep.y + xlane32(send.y, h5); q.z = keep.z + xlane32(send.z, h5); q.w = keep.w + xlane32(send.w, h5);
                      const float b0 = (h4 ? q.z : q.x) + xlane<16>(h4 ? q.x : q.z), b1 = (h4 ? q.w : q.y) + xlane<16>(h4 ? q.y : q.w);
                      float c = (h3 ? b1 : b0) + xlane<8>(h3 ? b0 : b1);
                      c += xlane<4>(c); c += xlane<2>(c); c += xlane<1>(c);
#pragma unroll
                      for (int o = 0; o < 8; ++o) el[o] = __int_as_float(__builtin_amdgcn_readlane(__float_as_int(c), 8 * o)) + be[gi * 8 + o]; }
                    int i0 = 0; float m0 = el[0];
#pragma unroll
                    for (int o = 1; o < 8; ++o) if (el[o] > m0) { m0 = el[o]; i0 = o; }
                    int i1 = -1; float m1 = -INFINITY;
#pragma unroll
                    for (int o = 0; o < 8; ++o) if (o != i0 && el[o] > m1) { m1 = el[o]; i1 = o; }
                    const float p1 = __builtin_amdgcn_exp2f((m1 - m0) * 1.4426950408889634f), w0_ = grp_p * __builtin_amdgcn_rcpf(1.0f + p1);
                    if (lane == 0) { rec_e[rl * 2] = gi * 8 + i0; rec_e[rl * 2 + 1] = gi * 8 + i1; rec_w[rl * 2] = w0_; rec_w[rl * 2 + 1] = w0_ * p1; }
                }
                __syncthreads();
                { const int e = rec_e[tid]; rec_rank[tid] = atomicAdd((int*)&hist[e], 1); }
                __syncthreads();
                if (tid < 32) { const int h = hist[tid]; base[tid] = (h && !dry) ? atomicAdd(&cntl[tid], h) : 0; }
                __syncthreads();
                { const int e = rec_e[tid], pos = base[e] + rec_rank[tid], tok = blk * 256 + (tid >> 1);
                  if (!dry) { ltok[(size_t)e * LISTCAP + pos] = tok; lw[(size_t)e * LISTCAP + pos] = rec_w[tid]; tslot[tok * 2 + (tid & 1)] = (e << 16) | pos; } }
                __syncthreads();
            }
        }
        SEAM(pb0);
        if (IN(pb0 + 1) || IN(pb0 + 2) || IN(pb0 + 3)) {
            __syncthreads();
            if (wave == 0 && lane_id() == 0) { const int* cntl = CNTL(); int s = 0;
#pragma unroll 1
                for (int e = 0; e < 32; ++e) { rb[e] = s; s += (__hip_atomic_load(&cntl[e], RLX_AGENT) + 255) & ~255; }
                rb[32] = s; }
            __syncthreads();
        }
        for (int rep_ = 0; rep_ < REPS(6); ++rep_) if (IN(pb0 + 1)) { bf16_t* xn = WSP(bf16_t, WS_XN); bf16_t* WGU = WSP(bf16_t, WS_WGU); bf16_t* act = WSP(bf16_t, WS_ACT); const int* ltok = WSP(int, WS_LTOK); const int* cntl = CNTL();
            pg8::Gemm g{xn, WGU + (size_t)l * 32 * 1024 * 1024, 0, 0, 1024}; pg8::MoeOrder S; S.init(rb[32] / 256, G, bid, rb); pg8::EpiPair<true> E{act, DEXP}; pg8::AGather am{ltok, cntl, rb};
            pg8::gemm_phase<pg8::EpiPair<true>, pg8::MoeOrder, pg8::AGather, true, true>(lds, g, S, E, am, wave); }
        SEAM(pb0 + 1);
        for (int rep_ = 0; rep_ < REPS(7); ++rep_) if (IN(pb0 + 2)) { bf16_t* act = WSP(bf16_t, WS_ACT); bf16_t* WDN = WSP(bf16_t, WS_WDN); bf16_t* yw = WSP(bf16_t, WS_YW); const float* lw = WSP(float, WS_LW);
            pg8::Gemm g{act, WDN + (size_t)l * 32 * 1024 * 512, 0, 0, 512}; pg8::MoeOrder S; S.init(rb[32] / 256, G, bid, rb); pg8::EpiDown E{yw, lw, rb};
            pg8::gemm_phase<pg8::EpiDown, pg8::MoeOrder, pg8::APlain, true, true>(lds, g, S, E, pg8::APlain{}, wave); }
        SEAM(pb0 + 2);
        for (int rep_ = 0; rep_ < REPS(8); ++rep_) if (IN(pb0 + 3)) { IDS(); const bool dry = rep_ + 1 < REPS(8);
            const float* gnext = (l == 0) ? KIN(2) + D : KIN(18);
            const float* modn = WSP(float, WS_MOD) + (size_t)16 * 6144; const float* modl = MODL();
            float* outf = KOUT(); bf16_t* xr = (bf16_t*)KOUT(); const bf16_t* yw = WSP(bf16_t, WS_YW); const int* tslot = WSP(int, WS_TSLOT); bf16_t* xn = WSP(bf16_t, WS_XN);
            for (int w0 = (bid * 8 + wave) * 32; w0 < T; w0 += G * 8 * 32) {
                const int b = w0 >> 12;
                f32x4 g2v[4];
#pragma unroll
                for (int j = 0; j < 4; ++j) g2v[j] = *(const f32x4*)(modl + (size_t)b * 6144 + 5120 + 4 * lane + 256 * j);
                ModV mv;
                if (l == 0) { const float* mb = modn + (size_t)b * 6144; mod_load(mv, gnext, mb + 0, mb + 1024, lane); }
                else {
#pragma unroll
                    for (int j = 0; j < 4; ++j) { mv.gp[j] = *(const f32x4*)(gnext + 4 * lane + 256 * j); mv.sh[j] = (f32x4){0.f, 0.f, 0.f, 0.f}; }
                }
                const int slw = tslot[(size_t)w0 * 2 + lane];
                u32x2 xb[4][4], ya[4][4], yb[4][4];
#define R2_LOAD(D_, I_) do { const int s0_ = __builtin_amdgcn_readlane(slw, 2 * (I_)), s1_ = __builtin_amdgcn_readlane(slw, 2 * (I_) + 1); \
                    const size_t r0_ = (size_t)(rb[s0_ >> 16] + (s0_ & 0xffff)), r1_ = (size_t)(rb[s1_ >> 16] + (s1_ & 0xffff)); \
                    _Pragma("unroll") for (int j = 0; j < 4; ++j) { xb[D_][j] = *(const u32x2*)(xr + (size_t)(w0 + (I_)) * XRP + 4 * lane + 256 * j); \
                        ya[D_][j] = ntload((const u32x2*)(yw + r0_ * D + 4 * lane + 256 * j)); yb[D_][j] = ntload((const u32x2*)(yw + r1_ * D + 4 * lane + 256 * j)); } } while (0)
#pragma unroll
                for (int d = 0; d < 4; ++d) R2_LOAD(d, d);
#pragma unroll 1
                for (int i4 = 0; i4 < 32; i4 += 4)
#pragma unroll
                for (int d = 0; d < 4; ++d) {
                    const int i = i4 + d, row = w0 + i;
                    RowV r;
#pragma unroll
                    for (int j = 0; j < 4; ++j) {
                        const u32x2 xw = xb[d][j], a = ya[d][j], c = yb[d][j];
                        f32x4 y; y.x = bflo(a.x) + bflo(c.x); y.y = bfhi(a.x) + bfhi(c.x); y.z = bflo(a.y) + bflo(c.y); y.w = bfhi(a.y) + bfhi(c.y);
                        r.v[j] = (f32x4){bflo(xw.x), bfhi(xw.x), bflo(xw.y), bfhi(xw.y)} + g2v[j] * y;
                    }
                    if (i4 < 28) R2_LOAD(d, i + 4);
                    const float rstd = row_rstd(r);
                    if (dry) { asm volatile("" :: "v"(rstd), "v"(r.v[0].x), "v"(r.v[1].y), "v"(r.v[2].z), "v"(r.v[3].w)); }
                    else if (l == 1) { row_apply(r, rstd, mv); row_store_f32(r, outf + (size_t)row * D, lane); }
                    else { row_store_bf16(r, xr + (size_t)row * XRP, lane); row_apply(r, rstd, mv); row_store_bf16(r, xn + (size_t)row * D, lane); }
                }
#undef R2_LOAD
            }
        }
        SEAM(pb0 + 3);
    }
    { constexpr int l = 1;
        const int pb0 = (l == 0) ? 5 : 13;
#define MODL() (WSP(float, WS_MOD) + (size_t)l * 16 * 6144)
#define CNTL() (WSP(int, WS_CTL) + 64 * l)
        if (l == 1) {
#ifdef STAGGER9
            if (IN(9)) { const unsigned long long t0_ = __builtin_amdgcn_s_memrealtime(); const unsigned long long dl_ = (unsigned long long)(((bid >> 3) & 31) * STAGGER9 / 32);
                while (__builtin_amdgcn_s_memrealtime() - t0_ < dl_) __builtin_amdgcn_s_sleep(16); }
#endif
            for (int rep_ = 0; rep_ < REPS(9); ++rep_) if (IN(9)) { bf16_t* xn = WSP(bf16_t, WS_XN); bf16_t* WAI = WSP(bf16_t, WS_WAI); bf16_t* qkv = WSP(bf16_t, WS_QKV); const float* rope = WSP(float, WS_ROPE);
                pg8::Gemm g{xn, WAI, T, QKVW, 1024}; pg8::StaticOrder S; S.init(T, QKVW, G, bid, 8); pg8::EpiQKV E{qkv, rope, 0};
                pg8::gemm_phase<pg8::EpiQKV, pg8::StaticOrder, pg8::APlain, true, true>(lds, g, S, E, pg8::APlain{}, wave); }
            LSEAM(9);
            if (IN(10)) att::attn_phase<false>(lds, WSP(bf16_t, WS_QKV), WSP(float, WS_LSE), WSP(bf16_t, WS_OB), CBID(), G, wave);
            LSEAM(10);
            if (IN(11)) att::attn_phase<true>(lds, WSP(bf16_t, WS_QKV), WSP(float, WS_LSE), WSP(bf16_t, WS_OB), CBID(), G, wave);
            LSEAM(11);
            if (IN(12)) { bf16_t* ob = WSP(bf16_t, WS_OB); bf16_t* WAO = WSP(bf16_t, WS_WAO); bf16_t* xr = (bf16_t*)KOUT();
                pg8::Gemm g{ob, WAO, T, 1024, 512}; pg8::StaticOrder S; S.init(T, 1024, G, bid); pg8::EpiRes<false> E{xr, nullptr, MODL() + 2048};
                pg8::gemm_phase<pg8::EpiRes<false>, pg8::StaticOrder, pg8::APlain, true, true>(lds, g, S, E, pg8::APlain{}, wave); }
            LSEAM(12);
        }
        for (int rep_ = 0; rep_ < REPS(5); ++rep_) if (IN(pb0)) { IDS(); const bool dry = rep_ + 1 < REPS(5);
            LAS f32x4* TG = (LAS f32x4*)lds; LAS f32x4* TE = (LAS f32x4*)(lds + 16384);
            LAS int* rec_e = (LAS int*)(lds + 147456); LAS float* rec_w = (LAS float*)(lds + 147456 + 2048); LAS int* rec_rank = (LAS int*)(lds + 147456 + 4096);
            LAS int* hist = (LAS int*)(lds + 147456 + 6144); LAS int* base = (LAS int*)(lds + 147456 + 6144 + 128);
            const float* gff = KIN(3) + l * D; const float* wg = KIN(11) + (size_t)l * D * 4; const float* bg = KIN(12) + l * 4; const float* we = KIN(13) + (size_t)l * 4 * D * 8; const float* be = KIN(14) + l * 32;
            const bf16_t* xr = (const bf16_t*)KOUT(); const float* modl = MODL(); int* cntl = CNTL(); bf16_t* xn = WSP(bf16_t, WS_XN); int* ltok = WSP(int, WS_LTOK); float* lw = WSP(float, WS_LW); int* tslot = WSP(int, WS_TSLOT);
            for (int i = tid; i < 1024; i += 512) { const int ln = i & 63, jc = i >> 6, k = 4 * ln + 256 * (jc >> 2) + (jc & 3); TG[i] = *(const f32x4*)(wg + (size_t)k * 4); }
            for (int i = tid; i < 8192; i += 512) { const int ln = i & 63, jc = (i >> 6) & 15, half = (i >> 10) & 1, gi = i >> 11, k = 4 * ln + 256 * (jc >> 2) + (jc & 3);
                TE[i] = *(const f32x4*)(we + ((size_t)gi * 1024 + k) * 8 + half * 4); }
            __syncthreads();
            const bool h5 = (lane & 32) != 0, h4 = (lane & 16) != 0, h3 = (lane & 8) != 0;
            for (int blk = CBID(); blk < T / 256; blk += G) {
                if (tid < 32) hist[tid] = 0;
                __syncthreads();
                ModV mv; { const float* mb = modl + (size_t)((blk * 256) >> 12) * 6144; mod_load(mv, gff, mb + 3072, mb + 4096, lane); }
                u32x2 ring[4][4];
#pragma unroll
                for (int d = 0; d < 4; ++d)
#pragma unroll
                    for (int j = 0; j < 4; ++j) ring[d][j] = *(const u32x2*)(xr + (size_t)(blk * 256 + wave * 32 + d) * XRP + 4 * lane + 256 * j);
#pragma unroll 1
                for (int i4 = 0; i4 < 32; i4 += 4)
#pragma unroll
                for (int d = 0; d < 4; ++d) {
                    const int i = i4 + d, rl = wave * 32 + i, row = blk * 256 + rl;
                    RowV r;
#pragma unroll
                    for (int j = 0; j < 4; ++j) { const u32x2 w = ring[d][j]; r.v[j] = (f32x4){bflo(w.x), bfhi(w.x), bflo(w.y), bfhi(w.y)}; }
                    if (i4 < 28) {
#pragma unroll
                        for (int j = 0; j < 4; ++j) ring[d][j] = *(const u32x2*)(xr + (size_t)(row + 4) * XRP + 4 * lane + 256 * j); }
                    const float rstd = row_rstd(r);
                    row_apply(r, rstd, mv);
                    row_store_bf16(r, xn + (size_t)row * D, lane);
                    f32x4 pg = {0.f, 0.f, 0.f, 0.f};
#pragma unroll
                    for (int jc = 0; jc < 16; ++jc) pg += TG[jc * 64 + lane] * r.v[jc >> 2][jc & 3];
                    float gl[4];
                    { float b0 = (h5 ? pg.z : pg.x) + xlane32(h5 ? pg.x : pg.z, h5), b1 = (h5 ? pg.w : pg.y) + xlane32(h5 ? pg.y : pg.w, h5);
                      float c = (h4 ? b1 : b0) + xlane<16>(h4 ? b0 : b1);
                      c += xlane<8>(c); c += xlane<4>(c); c += xlane<2>(c); c += xlane<1>(c);
#pragma unroll
                      for (int o = 0; o < 4; ++o) gl[o] = __int_as_float(__builtin_amdgcn_readlane(__float_as_int(c), 16 * o)) + bg[o]; }
                    int gi = 0; float gm = gl[0];
#pragma unroll
                    for (int o = 1; o < 4; ++o) if (gl[o] > gm) { gm = gl[o]; gi = o; }
                    float gden = 0.f;
#pragma unroll
                    for (int o = 0; o < 4; ++o) gden += __builtin_amdgcn_exp2f((gl[o] - gm) * 1.4426950408889634f);
                    const float grp_p = __builtin_amdgcn_rcpf(gden);
                    f32x4 pa = {0.f, 0.f, 0.f, 0.f}, pb = {0.f, 0.f, 0.f, 0.f};
                    const LAS f32x4* te = TE + gi * 2048 + lane;
#pragma unroll
                    for (int jc = 0; jc < 16; ++jc) { const float hv = r.v[jc >> 2][jc & 3]; pa += te[jc * 64] * hv; pb += te[1024 + jc * 64] * hv; }
                    float el[8];
                    { const f32x4 keep = h5 ? pb : pa, send = h5 ? pa : pb;
                      f32x4 q; q.x = keep.x + xlane32(send.x, h5); q.y = keep.y + xlane32(send.y, h5); q.z = keep.z + xlane32(send.z, h5); q.w = keep.w + xlane32(send.w, h5);
                      const float b0 = (h4 ? q.z : q.x) + xlane<16>(h4 ? q.x : q.z), b1 = (h4 ? q.w : q.y) + xlane<16>(h4 ? q.y : q.w);
                      float c = (h3 ? b1 : b0) + xlane<8>(h3 ? b0 : b1);
                      c += xlane<4>(c); c += xlane<2>(c); c += xlane<1>(c);
#pragma unroll
                      for (int o = 0; o < 8; ++o) el[o] = __int_as_float(__builtin_amdgcn_readlane(__float_as_int(c), 8 * o)) + be[gi * 8 + o]; }
                    int i0 = 0; float m0 = el[0];
#pragma unroll
                    for (int o = 1; o < 8; ++o) if (el[o] > m0) { m0 = el[o]; i0 = o; }
                    int i1 = -1; float m1 = -INFINITY;
#pragma unroll
                    for (int o = 0; o < 8; ++o) if (o != i0 && el[o] > m1) { m1 = el[o]; i1 = o; }
                    const float p1 = __builtin_amdgcn_exp2f((m1 - m0) * 1.4426950408889634f), w0_ = grp_p * __builtin_amdgcn_rcpf(1.0f + p1);
                    if (lane == 0) { rec_e[rl * 2] = gi * 8 + i0; rec_e[rl * 2 + 1] = gi * 8 + i1; rec_w[rl * 2] = w0_; rec_w[rl * 2 + 1] = w0_ * p1; }
                }
                __syncthreads();
                { const int e = rec_e[tid]; rec_rank[tid] = atomicAdd((int*)&hist[e], 1); }
                __syncthreads();
                if (tid < 32) { const int h = hist[tid]; base[tid] = (h && !dry) ? atomicAdd(&cntl[tid], h) : 0; }
                __syncthreads();
                { const int e = rec_e[tid], pos = base[e] + rec_rank[tid], tok = blk * 256 + (tid >> 1);
                  if (!dry) { ltok[(size_t)e * LISTCAP + pos] = tok; lw[(size_t)e * LISTCAP + pos] = rec_w[tid]; tslot[tok * 2 + (tid & 1)] = (e << 16) | pos; } }
                __syncthreads();
            }
        }
        SEAM(pb0);
        if (IN(pb0 + 1) || IN(pb0 + 2) || IN(pb0 + 3)) {
            __syncthreads();
            if (wave == 0 && lane_id() == 0) { const int* cntl = CNTL(); int s = 0;
#pragma unroll 1
                for (int e = 0; e < 32; ++e) { rb[e] = s; s += (__hip_atomic_load(&cntl[e], RLX_AGENT) + 255) & ~255; }
                rb[32] = s; }
            __syncthreads();
        }
        for (int rep_ = 0; rep_ < REPS(6); ++rep_) if (IN(pb0 + 1)) { bf16_t* xn = WSP(bf16_t, WS_XN); bf16_t* WGU = WSP(bf16_t, WS_WGU); bf16_t* act = WSP(bf16_t, WS_ACT); const int* ltok = WSP(int, WS_LTOK); const int* cntl = CNTL();
            pg8::Gemm g{xn, WGU + (size_t)l * 32 * 1024 * 1024, 0, 0, 1024}; pg8::MoeOrder S; S.init(rb[32] / 256, G, bid, rb); pg8::EpiPair<true> E{act, DEXP}; pg8::AGather am{ltok, cntl, rb};
            pg8::gemm_phase<pg8::EpiPair<true>, pg8::MoeOrder, pg8::AGather, true, true>(lds, g, S, E, am, wave); }
        SEAM(pb0 + 1);
        for (int rep_ = 0; rep_ < REPS(7); ++rep_) if (IN(pb0 + 2)) { bf16_t* act = WSP(bf16_t, WS_ACT); bf16_t* WDN = WSP(bf16_t, WS_WDN); bf16_t* yw = WSP(bf16_t, WS_YW); const float* lw = WSP(float, WS_LW);
            pg8::Gemm g{act, WDN + (size_t)l * 32 * 1024 * 512, 0, 0, 512}; pg8::MoeOrder S; S.init(rb[32] / 256, G, bid, rb); pg8::EpiDown E{yw, lw, rb};
            pg8::gemm_phase<pg8::EpiDown, pg8::MoeOrder, pg8::APlain, true, true>(lds, g, S, E, pg8::APlain{}, wave); }
        SEAM(pb0 + 2);
        for (int rep_ = 0; rep_ < REPS(8); ++rep_) if (IN(pb0 + 3)) { IDS(); const bool dry = rep_ + 1 < REPS(8);
            const float* gnext = (l == 0) ? KIN(2) + D : KIN(18);
            const float* modn = WSP(float, WS_MOD) + (size_t)16 * 6144; const float* modl = MODL();
            float* outf = KOUT(); bf16_t* xr = (bf16_t*)KOUT(); const bf16_t* yw = WSP(bf16_t, WS_YW); const int* tslot = WSP(int, WS_TSLOT); bf16_t* xn = WSP(bf16_t, WS_XN);
            for (int w0 = (bid * 8 + wave) * 32; w0 < T; w0 += G * 8 * 32) {
                const int b = w0 >> 12;
                f32x4 g2v[4];
#pragma unroll
                for (int j = 0; j < 4; ++j) g2v[j] = *(const f32x4*)(modl + (size_t)b * 6144 + 5120 + 4 * lane + 256 * j);
                ModV mv;
                if (l == 0) { const float* mb = modn + (size_t)b * 6144; mod_load(mv, gnext, mb + 0, mb + 1024, lane); }
                else {
#pragma unroll
                    for (int j = 0; j < 4; ++j) { mv.gp[j] = *(const f32x4*)(gnext + 4 * lane + 256 * j); mv.sh[j] = (f32x4){0.f, 0.f, 0.f, 0.f}; }
                }
                const int slw = tslot[(size_t)w0 * 2 + lane];
                u32x2 xb[4][4], ya[4][4], yb[4][4];
#define R2_LOAD(D_, I_) do { const int s0_ = __builtin_amdgcn_readlane(slw, 2 * (I_)), s1_ = __builtin_amdgcn_readlane(slw, 2 * (I_) + 1); \
                    const size_t r0_ = (size_t)(rb[s0_ >> 16] + (s0_ & 0xffff)), r1_ = (size_t)(rb[s1_ >> 16] + (s1_ & 0xffff)); \
                    _Pragma("unroll") for (int j = 0; j < 4; ++j) { xb[D_][j] = *(const u32x2*)(xr + (size_t)(w0 + (I_)) * XRP + 4 * lane + 256 * j); \
                        ya[D_][j] = ntload((const u32x2*)(yw + r0_ * D + 4 * lane + 256 * j)); yb[D_][j] = ntload((const u32x2*)(yw + r1_ * D + 4 * lane + 256 * j)); } } while (0)
#pragma unroll
                for (int d = 0; d < 4; ++d) R2_LOAD(d, d);
#pragma unroll 1
                for (int i4 = 0; i4 < 32; i4 += 4)
#pragma unroll
                for (int d = 0; d < 4; ++d) {
                    const int i = i4 + d, row = w0 + i;
                    RowV r;
#pragma unroll
                    for (int j = 0; j < 4; ++j) {
                        const u32x2 xw = xb[d][j], a = ya[d][j], c = yb[d][j];
                        f32x4 y; y.x = bflo(a.x) + bflo(c.x); y.y = bfhi(a.x) + bfhi(c.x); y.z = bflo(a.y) + bflo(c.y); y.w = bfhi(a.y) + bfhi(c.y);
                        r.v[j] = (f32x4){bflo(xw.x), bfhi(xw.x), bflo(xw.y), bfhi(xw.y)} + g2v[j] * y;
                    }
                    if (i4 < 28) R2_LOAD(d, i + 4);
                    const float rstd = row_rstd(r);
                    if (dry) { asm volatile("" :: "v"(rstd), "v"(r.v[0].x), "v"(r.v[1].y), "v"(r.v[2].z), "v"(r.v[3].w)); }
                    else if (l == 1) { row_apply(r, rstd, mv); row_store_f32(r, outf + (size_t)row * D, lane); }
                    else { row_store_bf16(r, xr + (size_t)row * XRP, lane); row_apply(r, rstd, mv); row_store_bf16(r, xn + (size_t)row * D, lane); }
                }
#undef R2_LOAD
            }
        }
        SEAM(pb0 + 3);
    }
#undef IDS
#undef MODL
#undef CNTL
#undef IN
#undef SEAM
#undef GRID_BAR
}

extern "C" void kernel_launch(void* const* d_in, const int* in_sizes, int n_in, void* d_out, int out_size, void* d_ws, size_t ws_size, hipStream_t stream) {
    static int grid = 0;
    if (grid == 0) {
        if (n_in != 19 || out_size != T * D || ws_size < WS_END) { fprintf(stderr, "kernel_launch: unexpected shapes (n_in %d out %d ws %zu)\n", n_in, out_size, ws_size); grid = -1; return; }
        int dev = 0, cus = 0;
        if (hipGetDevice(&dev) != hipSuccess || hipDeviceGetAttribute(&cus, hipDeviceAttributeMultiprocessorCount, dev) != hipSuccess) { grid = -1; return; }
        if (hipFuncSetAttribute((const void*)mk_fwd, hipFuncAttributeMaxDynamicSharedMemorySize, LDS_BYTES) != hipSuccess) { fprintf(stderr, "kernel_launch: hipFuncSetAttribute failed\n"); grid = -1; return; }
        int per_cu = 0;
        if (hipOccupancyMaxActiveBlocksPerMultiprocessor(&per_cu, (const void*)mk_fwd, NWAVES * 64, LDS_BYTES) != hipSuccess || per_cu < 1) fprintf(stderr, "kernel_launch: occupancy query says %d\n", per_cu);
        (void)hipGetLastError();
        grid = cus;
    }
    if (grid < 0) return;
    (void)hipMemsetAsync((char*)d_ws + WS_CTL, 0, CTL_BYTES, stream);
    Args a{};
    for (int i = 0; i < 19; ++i) a.in[i] = (const float*)d_in[i];
    a.out = (float*)d_out; a.ws = (unsigned char*)d_ws;
#if MK_ONE_LAUNCH
    a.ph_lo = 0; a.ph_hi = NPHASE;
    hipLaunchKernelGGL(mk_fwd, dim3(grid), dim3(NWAVES * 64), LDS_BYTES, stream, a);
#else
    for (int p = 0; p < NPHASE; ++p) { a.ph_lo = p; a.ph_hi = p + 1; hipLaunchKernelGGL(mk_fwd, dim3(grid), dim3(NWAVES * 64), LDS_BYTES, stream, a); }
#endif
}
```

```cpp
#include <hip/hip_runtime.h>
#include <stdint.h>
#include <math.h>
#include <cstdio>

#ifndef MK_ONE_LAUNCH
#define MK_ONE_LAUNCH 1
#endif

typedef unsigned short bf16_t;
typedef float f32x4 __attribute__((ext_vector_type(4)));
typedef unsigned u32x2 __attribute__((ext_vector_type(2)));
typedef unsigned u32x4 __attribute__((ext_vector_type(4)));
#define GAS __attribute__((address_space(1)))
#define LAS __attribute__((address_space(3)))
typedef GAS unsigned gu32;
#define RLX_AGENT __ATOMIC_RELAXED, __HIP_MEMORY_SCOPE_AGENT

constexpr int D = 1024, BATCH = 16, SEQ = 4096, T = BATCH * SEQ;
constexpr int NEXP = 32, DEXP = 512, EPG = 8, NGRP = 4;
constexpr int QKVW = 4608;
__host__ __device__ __forceinline__ size_t qkv_block(int typ, int g, int b, int h) { return (size_t)((((typ * 3 + g) * 16 + b) * 8 + h)) * (4096 * 64); }
__host__ __device__ __forceinline__ int qkv_row(int pos, int g) { const int dsh = 2 * g; return ((pos & ((1 << dsh) - 1)) << (12 - dsh)) + (pos >> dsh); }
constexpr int LISTCAP = 65536;
constexpr int PADROWS = 139264;
constexpr float EPS = 1e-6f;
constexpr float QSCALE = 0.125f * 1.4426950408889634f;
constexpr int NWAVES = 8;
constexpr int XRP = 2048;

constexpr size_t MiB = 1u << 20;
constexpr size_t WS_CTL = 0;
constexpr size_t CTL_BYTES = 1 * MiB;
constexpr int CW_BAR = 4096;
constexpr size_t WS_MOD = 1 * MiB;
constexpr size_t WS_ROPE = 3 * MiB;
constexpr size_t WS_LTOK = 4 * MiB;
constexpr size_t WS_LW = 12 * MiB;
constexpr size_t WS_TSLOT = 20 * MiB;
constexpr size_t WS_LSE = 24 * MiB;
constexpr size_t WS_WZ = 32 * MiB;
constexpr size_t WS_WB = 36 * MiB;
constexpr size_t WS_WCO = 38 * MiB;
constexpr size_t WS_WAI = 40 * MiB;
constexpr size_t WS_WAO = 49 * MiB;
constexpr size_t WS_WGU = 64 * MiB;
constexpr size_t WS_WDN = 192 * MiB;
constexpr size_t WS_XN = 256 * MiB;
constexpr size_t WS_BIG = 384 * MiB;
constexpr size_t WS_Z = WS_BIG, WS_YPRE = WS_BIG + 128 * MiB;
constexpr size_t WS_ACT = WS_BIG, WS_YW = WS_BIG + 136 * MiB;
constexpr size_t WS_QKV = WS_BIG;
constexpr size_t WS_OB = WS_BIG + 576 * MiB;
constexpr size_t WS_END = WS_OB + 64 * MiB;

constexpr int RING_BYTES = 162816;
constexpr int MISC_OFF = RING_BYTES;
constexpr int LDS_BYTES = RING_BYTES + 1024;

__device__ __forceinline__ unsigned f2bf(float f) { unsigned u = __float_as_uint(f); return (u + 0x7fffu + ((u >> 16) & 1u)) >> 16; }
__device__ __forceinline__ unsigned pk2(float lo, float hi) { return f2bf(lo) | (f2bf(hi) << 16); }
__device__ __forceinline__ float bf2f(unsigned h) { return __uint_as_float(h << 16); }
__device__ __forceinline__ float bflo(unsigned w) { return __uint_as_float(w << 16); }
__device__ __forceinline__ float bfhi(unsigned w) { return __uint_as_float(w & 0xffff0000u); }
template <int M> __device__ __forceinline__ float xlane(float v) {
    return __int_as_float(__builtin_amdgcn_ds_swizzle(__float_as_int(v), (M << 10) | 0x1f));
}
__device__ __forceinline__ float xlane32(float v, bool hi) {
    auto rr = __builtin_amdgcn_permlane32_swap(__float_as_uint(v), __float_as_uint(v), false, false); return __uint_as_float(hi ? rr[0] : rr[1]);
}
__device__ __forceinline__ float wave_sum(float v) {
    v += xlane<1>(v); v += xlane<2>(v); v += xlane<4>(v); v += xlane<8>(v); v += xlane<16>(v);
    auto rr = __builtin_amdgcn_permlane32_swap(__float_as_uint(v), __float_as_uint(v), false, false);
    return __uint_as_float(rr[0]) + __uint_as_float(rr[1]);
}
__device__ __forceinline__ float silu_f(float x) { return x / (1.0f + __expf(-x)); }
#define LDS_WAIT() asm volatile("s_waitcnt lgkmcnt(0)" ::: "memory")
template <class V> __device__ __forceinline__ V ntload(const V* p) { return __builtin_nontemporal_load(p); }
__device__ __forceinline__ int lane_id() { int l; asm volatile("v_mbcnt_lo_u32_b32 %0, -1, 0\n\tv_mbcnt_hi_u32_b32 %0, -1, %0" : "=v"(l)); return l; }

namespace pg8 {
#define PG8_LAS __attribute__((address_space(3)))
typedef unsigned short bf16_t;
typedef short bf16x8 __attribute__((ext_vector_type(8)));
typedef float f32x4 __attribute__((ext_vector_type(4)));
typedef unsigned u32x4 __attribute__((ext_vector_type(4)));
constexpr int BM = 256, BK = 64, HALF = 128, HTB = HALF * BK * 2  , STAGE_BYTES = 8 * HTB, NXCD = 8, WGM = 4;

__host__ __device__ __forceinline__ int lds_byte(int r, int c) { const int st = (r >> 4) * 2 + (c >> 5), rr = r & 15, cc = c & 31, ob = rr * 64 + cc * 2; return st * 1024 + (ob ^ (((ob >> 9) & 1) << 5)); }
__host__ __device__ __forceinline__ void stage_rc(int b, int& R, int& C) { const int st = b / 1024, sb = b % 1024, swz = sb ^ (((sb >> 9) & 1) << 5); R = (st >> 1) * 16 + swz / 64; C = (st & 1) * 32 + (swz % 64) / 2; }
__host__ __device__ __forceinline__ int perm32(int rho) { const int n = rho >> 4, i = rho & 15; return 8 * (i >> 2) + 4 * n + (i & 3); }

struct Unit { int pm, pn, pb; };
struct Gemm { const bf16_t* A; const bf16_t* Bt; int M, N, K; };

struct StaticOrder {
    int nM, nN, nwg, G, c, wgm;
    __host__ __device__ void init(int M, int N, int G_, int c_, int wgm_ = WGM) { nM = M / BM; nN = N / BM; nwg = nM * nN; G = G_; c = c_; wgm = wgm_; }
    __host__ __device__ bool next(int i, Unit& u) const {
        const long L = (long)i * G + c; if (L >= nwg) return false;
        int wgid = (int)L; { const int q = nwg / NXCD, r = nwg % NXCD, xcd = wgid % NXCD, off = wgid / NXCD; wgid = (xcd < r ? xcd * (q + 1) : r * (q + 1) + (xcd - r) * q) + off; }
        const int nig = wgm * nN, gid = wgid / nig, fm = gid * wgm, gsz = (nM - fm) < wgm ? (nM - fm) : wgm;
        u.pm = fm + ((wgid % nig) % gsz); u.pn = (wgid % nig) / gsz; u.pb = u.pn; return true;
    }
    __device__ __forceinline__ void a_ready(const Unit&) const {}
    __device__ __forceinline__ void done(const Unit&) const {}
};


__device__ __forceinline__ unsigned cvt_pk_bf16(float lo, float hi) { unsigned r; asm volatile("v_cvt_pk_bf16_f32 %0, %1, %2" : "=v"(r) : "v"(lo), "v"(hi)); return r; }
typedef float f32x2 __attribute__((ext_vector_type(2)));

template <class Epi, class Sched, class AM, bool ALIGN_EPI = false, bool SP2 = false>
__device__ __forceinline__ void gemm_phase(PG8_LAS unsigned char* lds, const Gemm g, const Sched& S, const Epi& E, const AM& am, const int wid_in) {
    int wid = wid_in; asm volatile("" : "+s"(wid));
    const int lane = lane_id(), tid = wid * 64 + lane, wr = wid >> 2, wc = wid & 3, fr = lane & 15, fq = lane >> 4;
    const int K = g.K, nt = K / BK;
    unsigned voffA[2], voffB[2]; int stR[2], stC[2];
#pragma unroll
    for (int i = 0; i < 2; ++i) { int R, C; stage_rc(tid * 16 + i * 8192, R, C); const int Rb = Epi::PERM ? ((R & ~31) + perm32(R & 31)) : R;
        stR[i] = R; stC[i] = C; voffA[i] = (unsigned)(R * K + C) * 2u; voffB[i] = (unsigned)(Rb * K + C) * 2u; }
    const size_t kstep = (size_t)(BK * 2);
    const size_t hstep = (size_t)HALF * K * 2;
    const size_t tstep = 2 * hstep;
    const unsigned ldsw = (unsigned)wid * 1024u;
    const int aoff = lds_byte(wr * 64 + fr, fq * 8), boff = lds_byte(wc * 32 + fr, fq * 8);
#define PG8_SA(b, h) (((b) * 2 + (h)) * HTB)
#define PG8_SB(b, h) ((4 + (b) * 2 + (h)) * HTB)
#define PG8_STAGE(bufoff, gbase, voff) do { _Pragma("unroll") for (int _i = 0; _i < 2; ++_i) \
        __builtin_amdgcn_global_load_lds((const unsigned*)((const char*)(gbase) + (voff)[_i]), (PG8_LAS unsigned*)(lds + (bufoff) + ldsw + _i * 8192), 16, 0, 0); } while (0)
#define PG8_STAGE_A(b, h, gbase, NX) do { if constexpr (AM::GATHER) { const unsigned so_[2] = {(NX) ? gno[h][0] : gao[h][0], (NX) ? gno[h][1] : gao[h][1]}; PG8_STAGE(PG8_SA(b, h), gbase, so_); } \
        else { PG8_STAGE(PG8_SA(b, h), (gbase) + (h) * hstep, voffA); } } while (0)
#define PG8_LDA(dst, b, h) do { _Pragma("unroll") for (int m = 0; m < 4; ++m) _Pragma("unroll") for (int k = 0; k < 2; ++k) dst[m][k] = *(const PG8_LAS bf16x8*)(lds + PG8_SA(b, h) + aoff + m * 2048 + k * 1024); } while (0)
#define PG8_LDB(dst, b, h) do { _Pragma("unroll") for (int n = 0; n < 2; ++n) _Pragma("unroll") for (int k = 0; k < 2; ++k) dst[n][k] = *(const PG8_LAS bf16x8*)(lds + PG8_SB(b, h) + boff + n * 2048 + k * 1024); } while (0)
#define PG8_MMA(ai, bj, At, Bt) do { __builtin_amdgcn_s_setprio(1); _Pragma("unroll") for (int m = 0; m < 4; ++m) _Pragma("unroll") for (int n = 0; n < 2; ++n) _Pragma("unroll") for (int k = 0; k < 2; ++k) \
        acc[ai][bj][m][n] = __builtin_amdgcn_mfma_f32_16x16x32_bf16(Bt[n][k], At[m][k], acc[ai][bj][m][n], 0, 0, 0); __builtin_amdgcn_s_setprio(0); } while (0)
#define PG8_WAIT_V(n) asm volatile("s_waitcnt vmcnt(" #n ")" ::: "memory")
#define PG8_WAIT_L(n) asm volatile("s_waitcnt lgkmcnt(" #n ")" ::: "memory")
#define PG8_BAR __builtin_amdgcn_s_barrier()
#define PG8_SCHED __builtin_amdgcn_sched_barrier(0)
    Unit cur, nxt; int ui = 0;
    if (!S.next(0, cur)) return;
    f32x4 acc[2][2][4][2];
#pragma unroll
    for (int a = 0; a < 2; ++a)
#pragma unroll
        for (int b = 0; b < 2; ++b)
#pragma unroll
            for (int m = 0; m < 4; ++m)
#pragma unroll
                for (int n = 0; n < 2; ++n) acc[a][b][m][n] = (f32x4){0.f, 0.f, 0.f, 0.f};
    bf16x8 At[4][2], B0[2][2], B1[2][2];
    const char* cA = (const char*)g.A + (AM::GATHER ? (size_t)0 : (size_t)cur.pm * tstep); const char* cB = (const char*)g.Bt + (size_t)cur.pb * tstep;
    unsigned gao[2][2], gno[2][2];
    if constexpr (AM::GATHER) { _Pragma("unroll") for (int h = 0; h < 2; ++h) _Pragma("unroll") for (int i = 0; i < 2; ++i) { gao[h][i] = (unsigned)(am.arow(cur, h * HALF + stR[i]) * K + stC[i]) * 2u; gno[h][i] = gao[h][i]; } }
    else { _Pragma("unroll") for (int h = 0; h < 2; ++h) _Pragma("unroll") for (int i = 0; i < 2; ++i) { gao[h][i] = 0u; gno[h][i] = 0u; } }
    S.a_ready(cur);
    if constexpr (SP2) {
        PG8_STAGE(PG8_SB(0, 0), cB, voffB); PG8_STAGE(PG8_SB(0, 1), cB + hstep, voffB); PG8_STAGE_A(0, 0, cA, false); PG8_STAGE_A(0, 1, cA, false);
        if (wr == 1) PG8_BAR;
        PG8_WAIT_V(2); PG8_BAR;
        PG8_STAGE(PG8_SB(1, 0), cB + kstep, voffB); PG8_STAGE_A(1, 0, cA + kstep, false); PG8_STAGE(PG8_SB(1, 1), cB + hstep + kstep, voffB);
        PG8_WAIT_V(6); PG8_BAR;
    } else {
        PG8_STAGE(PG8_SB(0, 0), cB, voffB); PG8_STAGE_A(0, 0, cA, false); PG8_STAGE(PG8_SB(0, 1), cB + hstep, voffB); PG8_STAGE_A(0, 1, cA, false);
        if (wr == 1) PG8_BAR;
        PG8_WAIT_V(4); PG8_BAR;
        PG8_STAGE(PG8_SB(1, 0), cB + kstep, voffB); PG8_STAGE_A(1, 0, cA + kstep, false); PG8_STAGE(PG8_SB(1, 1), cB + hstep + kstep, voffB);
        PG8_WAIT_V(6); PG8_BAR;
    }
    for (;;) {
        const bool has_next = S.next(ui + 1, nxt);
        const char* nA = has_next ? (const char*)g.A + (AM::GATHER ? (size_t)0 : (size_t)nxt.pm * tstep) : cA; const char* nB = has_next ? (const char*)g.Bt + (size_t)nxt.pb * tstep : cB;
        if constexpr (AM::GATHER) { if (has_next) { _Pragma("unroll") for (int h = 0; h < 2; ++h) _Pragma("unroll") for (int i = 0; i < 2; ++i) gno[h][i] = (unsigned)(am.arow(nxt, h * HALF + stR[i]) * K + stC[i]) * 2u; } }
        for (int t = 0; t < nt; t += 2) {
            const bool last = (t == nt - 2);
            const char* a1 = cA + (size_t)(t + 1) * kstep;
            const char* a2 = last ? nA : cA + (size_t)(t + 2) * kstep; const char* b2 = last ? nB : cB + (size_t)(t + 2) * kstep;
            const char* a3 = a2 + kstep; const char* b3 = b2 + kstep;
            if (last && has_next) S.a_ready(nxt);
            if (false) E.prefetch(cur, tid, (PG8_LAS unsigned*)(lds + 162816 + 512));
            if constexpr (SP2) {
            PG8_LDB(B0, 0, 0); PG8_LDB(B1, 0, 1); PG8_SCHED; PG8_LDA(At, 0, 0); PG8_STAGE_A(1, 1, a1, false);
            PG8_WAIT_V(8); PG8_WAIT_L(0); PG8_BAR; PG8_MMA(0, 0, At, B0); PG8_MMA(0, 1, At, B1); PG8_BAR; PG8_SCHED;
            PG8_LDA(At, 0, 1); PG8_STAGE(PG8_SB(0, 0), b2, voffB); PG8_STAGE(PG8_SB(0, 1), b2 + hstep, voffB); PG8_STAGE_A(0, 0, a2, last);
            PG8_WAIT_V(8); PG8_WAIT_L(0); PG8_BAR; PG8_MMA(1, 0, At, B0); PG8_MMA(1, 1, At, B1); PG8_BAR; PG8_SCHED;
            PG8_LDB(B0, 1, 0); PG8_LDB(B1, 1, 1); PG8_SCHED; PG8_LDA(At, 1, 0); PG8_STAGE_A(0, 1, a2, last);
            PG8_WAIT_V(8); PG8_WAIT_L(0); PG8_BAR; PG8_MMA(0, 0, At, B0); PG8_MMA(0, 1, At, B1); PG8_BAR; PG8_SCHED;
            PG8_LDA(At, 1, 1); PG8_STAGE(PG8_SB(1, 0), b3, voffB); PG8_STAGE(PG8_SB(1, 1), b3 + hstep, voffB); PG8_STAGE_A(1, 0, a3, last);
            PG8_WAIT_V(8); PG8_WAIT_L(0); PG8_BAR; PG8_MMA(1, 0, At, B0); PG8_MMA(1, 1, At, B1); PG8_BAR; PG8_SCHED;
            } else {
            PG8_LDB(B0, 0, 0); PG8_SCHED; PG8_LDA(At, 0, 0); PG8_STAGE_A(1, 1, a1, false);
            PG8_WAIT_L(8); PG8_BAR; PG8_WAIT_L(0); PG8_MMA(0, 0, At, B0); PG8_BAR; PG8_SCHED;
            PG8_LDB(B1, 0, 1); PG8_STAGE(PG8_SB(0, 0), b2, voffB);
            PG8_BAR; PG8_WAIT_L(0); PG8_MMA(0, 1, At, B1); PG8_BAR;
            PG8_LDA(At, 0, 1); PG8_STAGE_A(0, 0, a2, last);
            PG8_BAR; PG8_WAIT_L(0); PG8_MMA(1, 0, At, B0); PG8_BAR; PG8_SCHED;
            PG8_STAGE(PG8_SB(0, 1), b2 + hstep, voffB);
            PG8_WAIT_V(6); PG8_BAR; PG8_MMA(1, 1, At, B1); PG8_BAR;
            PG8_LDB(B0, 1, 0); PG8_SCHED; PG8_LDA(At, 1, 0); PG8_STAGE_A(0, 1, a2, last);
            PG8_WAIT_L(8); PG8_BAR; PG8_WAIT_L(0); PG8_MMA(0, 0, At, B0); PG8_BAR; PG8_SCHED;
            PG8_LDB(B1, 1, 1); PG8_STAGE(PG8_SB(1, 0), b3, voffB);
            PG8_BAR; PG8_WAIT_L(0); PG8_MMA(0, 1, At, B1); PG8_BAR;
            PG8_LDA(At, 1, 1); PG8_STAGE_A(1, 0, a3, last);
            PG8_BAR; PG8_WAIT_L(0); PG8_MMA(1, 0, At, B0); PG8_BAR; PG8_SCHED;
            PG8_STAGE(PG8_SB(1, 1), b3 + hstep, voffB);
            PG8_WAIT_V(6); PG8_BAR; PG8_MMA(1, 1, At, B1); PG8_BAR;
            }
        }
        if constexpr (ALIGN_EPI) { if (wr == 0) PG8_BAR; }
        if constexpr (!Epi::AFTER_DRAIN) { E(acc, cur, wr, wc, fr, fq); S.done(cur); }
        if (!has_next) break;
#pragma unroll
        for (int a = 0; a < 2; ++a)
#pragma unroll
            for (int b = 0; b < 2; ++b)
#pragma unroll
                for (int m = 0; m < 4; ++m)
#pragma unroll
                    for (int n = 0; n < 2; ++n) acc[a][b][m][n] = (f32x4){0.f, 0.f, 0.f, 0.f};
        cur = nxt; cA = nA; cB = nB; ++ui;
        if constexpr (AM::GATHER) { _Pragma("unroll") for (int h = 0; h < 2; ++h) _Pragma("unroll") for (int i = 0; i < 2; ++i) gao[h][i] = gno[h][i]; }
        if constexpr (ALIGN_EPI) { if (wr == 1) PG8_BAR; }
    }
    PG8_WAIT_V(0);
    if constexpr (!ALIGN_EPI) { if (wr == 0) PG8_BAR; }
    PG8_BAR;
    if constexpr (Epi::AFTER_DRAIN) { E.fused(acc, cur, wr, wc, fr, fq, lds, wid, lane); S.done(cur); }
#undef PG8_SA
#undef PG8_SB
#undef PG8_STAGE
#undef PG8_STAGE_A
#undef PG8_LDA
#undef PG8_LDB
#undef PG8_MMA
#undef PG8_WAIT_V
#undef PG8_WAIT_L
#undef PG8_BAR
#undef PG8_SCHED
}

__device__ __forceinline__ u32x4 pack8(const f32x4 v0, const f32x4 v1) { u32x4 w; w.x = cvt_pk_bf16(v0[0], v0[1]); w.y = cvt_pk_bf16(v0[2], v0[3]); w.z = cvt_pk_bf16(v1[0], v1[1]); w.w = cvt_pk_bf16(v1[2], v1[3]); return w; }
__device__ __forceinline__ u32x4 xpose4x16(const u32x4 w, int sa) {
    u32x4 r; r.x = __builtin_amdgcn_ds_bpermute(sa, w.x); r.y = __builtin_amdgcn_ds_bpermute(sa, w.y); r.z = __builtin_amdgcn_ds_bpermute(sa, w.z); r.w = __builtin_amdgcn_ds_bpermute(sa, w.w); return r;
}
#define XPOSE_IDS() const int L_ = fr + 16 * fq, tr_ = L_ >> 2, tq_ = L_ & 3, sa_ = 4 * (tr_ + 16 * tq_)
__device__ __forceinline__ float silu1(float x) { return x * __builtin_amdgcn_rcpf(1.0f + __builtin_amdgcn_exp2f(-1.4426950408889634f * x)); }
template <bool SILU> struct EpiPair {
    static constexpr bool PERM = true, AFTER_DRAIN = false;
    bf16_t* O; int ldc;
    __device__ __forceinline__ void prefetch(const Unit&, int, PG8_LAS unsigned*) const {}
    __device__ __forceinline__ void operator()(const f32x4 (&acc)[2][2][4][2], const Unit& u, int wr, int wc, int fr, int fq) const {
        XPOSE_IDS();
        const int row0 = u.pm * BM + wr * 64 + tr_, ch0 = u.pn * HALF + wc * 32 + 8 * tq_;
#pragma unroll
        for (int ai = 0; ai < 2; ++ai)
#pragma unroll
            for (int m = 0; m < 4; ++m) {
                f32x4 a0 = acc[ai][0][m][0], a1 = acc[ai][0][m][1];
                if (SILU) {
#pragma unroll
                    for (int c = 0; c < 4; ++c) { a0[c] = silu1(a0[c]); a1[c] = silu1(a1[c]); }
                }
                *(u32x4*)(O + (size_t)(row0 + ai * HALF + m * 16) * ldc + ch0) = xpose4x16(pack8(a0 * acc[ai][1][m][0], a1 * acc[ai][1][m][1]), sa_);
            }
    }
};
struct EpiYpre {
    static constexpr bool PERM = true, AFTER_DRAIN = false;
    bf16_t* O; const bf16_t* Z; const float* cw;
    __device__ __forceinline__ void prefetch(const Unit& u, int tid, PG8_LAS unsigned* dummy) const {
#pragma unroll
        for (int i = 0; i < 2; ++i) { const int line = tid + 512 * i, row = line >> 2, seg = line & 3;
            __builtin_amdgcn_global_load_lds((const unsigned*)(Z + (size_t)(u.pm * BM + row) * D + u.pn * BM + seg * 64), dummy, 4, 0, 0); }
    }
    template <typename P> static __device__ __forceinline__ P sadd(P base, unsigned off) { asm volatile("" : "+v"(off)); return base + off; }
    template <int N> static __device__ __forceinline__ u32x4 ror(const u32x4 v) { u32x4 r;
        r.x = (unsigned)__builtin_amdgcn_update_dpp(0, (int)v.x, 0x120 + N, 0xf, 0xf, false); r.y = (unsigned)__builtin_amdgcn_update_dpp(0, (int)v.y, 0x120 + N, 0xf, 0xf, false);
        r.z = (unsigned)__builtin_amdgcn_update_dpp(0, (int)v.z, 0x120 + N, 0xf, 0xf, false); r.w = (unsigned)__builtin_amdgcn_update_dpp(0, (int)v.w, 0x120 + N, 0xf, 0xf, false); return r; }
    static __device__ __forceinline__ u32x4 sel(bool c, const u32x4 a, const u32x4 b) { u32x4 r; r.x = c ? a.x : b.x; r.y = c ? a.y : b.y; r.z = c ? a.z : b.z; r.w = c ? a.w : b.w; return r; }
    __device__ __forceinline__ void operator()(const f32x4 (&acc)[2][2][4][2], const Unit& u, int wr, int wc, int fr, int fq) const {
        XPOSE_IDS();
        const int row0 = u.pm * BM + wr * 64 + fr;
#pragma unroll
        for (int bj = 0; bj < 2; ++bj) {
            const int col0 = u.pn * BM + bj * HALF + wc * 32 + 8 * fq;
            f32x4 w0[2], w1[2], w2[2];
#pragma unroll
            for (int n = 0; n < 2; ++n) { w0[n] = *(const f32x4*)(cw + col0 + 4 * n); w1[n] = *(const f32x4*)(cw + D + col0 + 4 * n); w2[n] = *(const f32x4*)(cw + 2 * D + col0 + 4 * n); }
            u32x4 zc[2][4], zh[2];
#pragma unroll
            for (int ai = 0; ai < 2; ++ai) {
                zh[ai] = (u32x4){0u, 0u, 0u, 0u};
                if (fr >= 14 && row0 + ai * HALF >= 16) zh[ai] = *(const u32x4*)sadd((const char*)Z, (unsigned)((row0 + ai * HALF - 16) * D + col0) * 2u);
#pragma unroll
                for (int m = 0; m < 4; ++m) zc[ai][m] = *(const u32x4*)(sadd((const char*)Z, (unsigned)((row0 + ai * HALF) * D + col0) * 2u) + m * 16 * D * 2);
            }
            asm volatile("" ::: "memory");
#pragma unroll
            for (int ai = 0; ai < 2; ++ai)
#pragma unroll
                for (int m = 0; m < 4; ++m) {
                    const int row = row0 + ai * HALF + m * 16, t = row & (SEQ - 1);
                    const u32x4 cur = zc[ai][m], prv = (m == 0) ? zh[ai] : zc[ai][m - 1];
                    u32x4 z1 = sel(fr >= 1, ror<1>(cur), ror<1>(prv)), z2 = sel(fr >= 2, ror<2>(cur), ror<2>(prv));
                    if (t < 1) z1 = (u32x4){0u, 0u, 0u, 0u};
                    if (t < 2) z2 = (u32x4){0u, 0u, 0u, 0u};
                    const u32x4 z0 = cur;
                    f32x4 v[2];
#pragma unroll
                    for (int n = 0; n < 2; ++n) {
                        f32x4 a, b, c;
                        a[0] = __uint_as_float(z0[2 * n] << 16); a[1] = __uint_as_float(z0[2 * n] & 0xffff0000u); a[2] = __uint_as_float(z0[2 * n + 1] << 16); a[3] = __uint_as_float(z0[2 * n + 1] & 0xffff0000u);
                        b[0] = __uint_as_float(z1[2 * n] << 16); b[1] = __uint_as_float(z1[2 * n] & 0xffff0000u); b[2] = __uint_as_float(z1[2 * n + 1] << 16); b[3] = __uint_as_float(z1[2 * n + 1] & 0xffff0000u);
                        c[0] = __uint_as_float(z2[2 * n] << 16); c[1] = __uint_as_float(z2[2 * n] & 0xffff0000u); c[2] = __uint_as_float(z2[2 * n + 1] << 16); c[3] = __uint_as_float(z2[2 * n + 1] & 0xffff0000u);
                        v[n] = acc[ai][bj][m][n] * (w2[n] * a + w1[n] * b + w0[n] * c);
                    }
                    *(u32x4*)(sadd((char*)O, (unsigned)((row0 - fr + tr_ + ai * HALF) * D + col0 - 8 * fq + 8 * tq_) * 2u) + m * 16 * D * 2) = xpose4x16(pack8(v[0], v[1]), sa_);
                    __builtin_amdgcn_sched_barrier(0);
                }
            asm volatile("" ::: "memory");
        }
    }
};

template <bool RES_F32> struct EpiRes {
    static constexpr bool PERM = true, AFTER_DRAIN = false;
    bf16_t* xr; const float* xin; const float* modg;
    __device__ __forceinline__ void prefetch(const Unit&, int, PG8_LAS unsigned*) const {}
    __device__ __forceinline__ void operator()(const f32x4 (&acc)[2][2][4][2], const Unit& u, int wr, int wc, int fr, int fq) const {
        XPOSE_IDS();
        const int row0 = u.pm * BM + wr * 64 + fr, col0 = u.pn * BM + wc * 32 + 8 * fq;
        const float* gb = modg + (size_t)((u.pm * BM) >> 12) * 6144;
        f32x4 gv[2][2];
#pragma unroll
        for (int bj = 0; bj < 2; ++bj)
#pragma unroll
            for (int n = 0; n < 2; ++n) gv[bj][n] = *(const f32x4*)(gb + col0 + bj * HALF + n * 4);
        if constexpr (!RES_F32) {
            u32x4 rw[2][4][2];
#pragma unroll
            for (int ai = 0; ai < 2; ++ai)
#pragma unroll
                for (int m = 0; m < 4; ++m)
#pragma unroll
                    for (int bj = 0; bj < 2; ++bj) rw[ai][m][bj] = *(const u32x4*)(xr + (size_t)(row0 + ai * HALF + m * 16) * XRP + col0 + bj * HALF);
            asm volatile("" ::: "memory");
#pragma unroll
            for (int ai = 0; ai < 2; ++ai)
#pragma unroll
                for (int m = 0; m < 4; ++m) { const int row = row0 + ai * HALF + m * 16;
#pragma unroll
                    for (int bj = 0; bj < 2; ++bj) { const u32x4 w = rw[ai][m][bj];
                        const f32x4 r0 = {__uint_as_float(w.x << 16), __uint_as_float(w.x & 0xffff0000u), __uint_as_float(w.y << 16), __uint_as_float(w.y & 0xffff0000u)};
                        const f32x4 r1 = {__uint_as_float(w.z << 16), __uint_as_float(w.z & 0xffff0000u), __uint_as_float(w.w << 16), __uint_as_float(w.w & 0xffff0000u)};
                        *(u32x4*)(xr + (size_t)(row - fr + tr_) * XRP + col0 - 8 * fq + 8 * tq_ + bj * HALF) = xpose4x16(pack8(r0 + gv[bj][0] * acc[ai][bj][m][0], r1 + gv[bj][1] * acc[ai][bj][m][1]), sa_); } }
        } else {
#pragma unroll
        for (int ai = 0; ai < 2; ++ai) {
            f32x4 rv[4][2][2];
#pragma unroll
            for (int m = 0; m < 4; ++m) { const int row = row0 + ai * HALF + m * 16;
#pragma unroll
                for (int bj = 0; bj < 2; ++bj) { rv[m][bj][0] = ntload((const f32x4*)(xin + (size_t)row * D + col0 + bj * HALF)); rv[m][bj][1] = ntload((const f32x4*)(xin + (size_t)row * D + col0 + bj * HALF + 4)); } }
#pragma unroll
            for (int m = 0; m < 4; ++m) { const int row = row0 + ai * HALF + m * 16;
#pragma unroll
                for (int bj = 0; bj < 2; ++bj)
                    *(u32x4*)(xr + (size_t)(row - fr + tr_) * XRP + col0 - 8 * fq + 8 * tq_ + bj * HALF) = xpose4x16(pack8(rv[m][bj][0] + gv[bj][0] * acc[ai][bj][m][0], rv[m][bj][1] + gv[bj][1] * acc[ai][bj][m][1]), sa_); }
            asm volatile("" ::: "memory");
        }
        }
    }
};
struct EpiQKV {
    static constexpr bool PERM = true, AFTER_DRAIN = false;
    bf16_t* O; const float* rope; int row_off;
    __device__ __forceinline__ void prefetch(const Unit&, int, PG8_LAS unsigned*) const {}
    __device__ __forceinline__ void operator()(const f32x4 (&acc)[2][2][4][2], const Unit& u, int wr, int wc, int fr, int fq) const {
        XPOSE_IDS();
        const int row0 = u.pm * BM + wr * 64 + fr, col0 = u.pn * BM + wc * 32 + 8 * fq;
        const int typ = (u.pn % 6) >> 1, gq_ = u.pn / 6;
        const bool rl = (typ < 2) && ((wc & 1) == 0) && (fq < 2);
        const float sc = (typ == 0) ? QSCALE : 1.0f;
#pragma unroll
        for (int ai = 0; ai < 2; ++ai)
#pragma unroll
        for (int mp = 0; mp < 2; ++mp) {
            f32x4 csv[2], snv[2];
#pragma unroll
            for (int mm = 0; mm < 2; ++mm) { const int pos = (row0 + ai * HALF + (2 * mp + mm) * 16) & (SEQ - 1);
                csv[mm] = *(const f32x4*)(rope + pos * 8 + 4 * (fq & 1)); snv[mm] = *(const f32x4*)(rope + 4096 * 8 + pos * 8 + 4 * (fq & 1)); }
#pragma unroll
            for (int mm = 0; mm < 2; ++mm) {
                const int m = 2 * mp + mm, row = row0 + ai * HALF + m * 16;
                f32x4 cs = {1.f, 1.f, 1.f, 1.f}, sn = {0.f, 0.f, 0.f, 0.f};
                if (rl) { cs = csv[mm]; sn = snv[mm]; }
#pragma unroll
                for (int bj = 0; bj < 2; ++bj) {
                    const f32x4 x1 = acc[ai][bj][m][0], x2 = acc[ai][bj][m][1];
                    const f32x4 r1 = (x1 * cs - x2 * sn) * sc, r2 = (x2 * cs + x1 * sn) * sc;
                    { const int tok = row_off + row - fr + tr_, hh = 4 * (u.pn & 1) + 2 * bj + (wc >> 1);
                      *(u32x4*)(O + qkv_block(typ, gq_, tok >> 12, hh) + (size_t)qkv_row(tok & (SEQ - 1), gq_) * 64 + 32 * (wc & 1) + 8 * tq_) = xpose4x16(pack8(r1, r2), sa_); }
                }
            }
            asm volatile("" ::: "memory");
        }
    }
};
struct EpiDown {
    static constexpr bool PERM = true, AFTER_DRAIN = false;
    bf16_t* O; const float* lw; const PG8_LAS int* rb;
    __device__ __forceinline__ void prefetch(const Unit&, int, PG8_LAS unsigned*) const {}
    __device__ __forceinline__ void operator()(const f32x4 (&acc)[2][2][4][2], const Unit& u, int wr, int wc, int fr, int fq) const {
        XPOSE_IDS();
        const int row0 = u.pm * BM + wr * 64 + fr, col0 = u.pn * BM + wc * 32 + 8 * fq;
        const int e = u.pb >> 2; const float* wrow = lw + (size_t)e * LISTCAP - rb[e];
        float wv[2][4];
#pragma unroll
        for (int ai = 0; ai < 2; ++ai)
#pragma unroll
            for (int m = 0; m < 4; ++m) wv[ai][m] = wrow[row0 + ai * HALF + m * 16];
#pragma unroll
        for (int ai = 0; ai < 2; ++ai)
#pragma unroll
            for (int m = 0; m < 4; ++m) {
                const int row = row0 + ai * HALF + m * 16; const float w = wv[ai][m];
#pragma unroll
                for (int bj = 0; bj < 2; ++bj) *(u32x4*)(O + (size_t)(row - fr + tr_) * D + col0 - 8 * fq + 8 * tq_ + bj * HALF) = xpose4x16(pack8(acc[ai][bj][m][0] * w, acc[ai][bj][m][1] * w), sa_);
            }
    }
};
struct MoeOrder {
    int nM, nN, nwg, G, c; const PG8_LAS int* rb; bool aligned;
    __device__ void init(int nRT, int G_, int c_, const PG8_LAS int* rb_, bool aligned_ = false) { nM = nRT; nN = 4; nwg = nM * nN; G = G_; c = c_; rb = rb_; aligned = aligned_; }
    __device__ bool next(int i, Unit& u) const {
        const long L = (long)i * G + c; int wgid;
        if (aligned) {
            const int ng = (nM + WGM - 1) / WGM, gq = ng / NXCD, gr = ng % NXCD, xcd = (int)(L % NXCD); const long off = L / NXCD;
            const int g0 = xcd * gq + (xcd < gr ? xcd : gr), g1 = g0 + gq + (xcd < gr ? 1 : 0);
            const long w = (long)g0 * (WGM * 4) + off, wend = (long)g1 * (WGM * 4) < nwg ? (long)g1 * (WGM * 4) : nwg;
            if (w >= wend) return false;
            wgid = (int)w;
        } else {
            if (L >= nwg) return false;
            wgid = (int)L; { const int q = nwg / NXCD, r = nwg % NXCD, xcd = wgid % NXCD, off = wgid / NXCD; wgid = (xcd < r ? xcd * (q + 1) : r * (q + 1) + (xcd - r) * q) + off; }
        }
        const int nig = WGM * nN, gid = wgid / nig, fm = gid * WGM, gsz = (nM - fm) < WGM ? (nM - fm) : WGM;
        u.pm = fm + ((wgid % nig) % gsz); u.pn = (wgid % nig) / gsz;
        int e = 0; const int r0 = u.pm * BM;
#pragma unroll 1
        while (e < 31 && rb[e + 1] <= r0) ++e;
        u.pb = e * 4 + u.pn; return true;
    }
    __device__ __forceinline__ void a_ready(const Unit&) const {}
    __device__ __forceinline__ void done(const Unit&) const {}
};
struct APlain { static constexpr bool GATHER = false; __device__ __forceinline__ int arow(const Unit&, int) const { return 0; } };
struct AGather {
    static constexpr bool GATHER = true;
    const int* ltok; const int* cnt; const PG8_LAS int* rb;
    __device__ __forceinline__ int arow(const Unit& u, int r) const { const int e = u.pb >> 2, l = u.pm * BM - rb[e] + r; return (l < cnt[e]) ? ltok[(size_t)e * LISTCAP + l] : 0; }
};
}

#define XB_TMO      128
#define XB_XCNT(j)  (256  + 64 * (j))
#define XB_XSUB(j)  (1280 + 64 * (j))
#define XB_XGEN(j)  (2304 + 64 * (j))
#define XB_TOP      3328
#define XB_TOPGEN   3392
#define XCD_BAR_WORDS 3456
#define XB_SPIN_CAP (1u << 18)

__device__ __forceinline__ unsigned xb_ld(unsigned* p)              { return __hip_atomic_load(p, __ATOMIC_RELAXED, __HIP_MEMORY_SCOPE_AGENT); }
__device__ __forceinline__ unsigned xb_add(unsigned* p, unsigned v) { return __hip_atomic_fetch_add(p, v, __ATOMIC_RELAXED, __HIP_MEMORY_SCOPE_AGENT); }
__device__ __forceinline__ unsigned xb_xcc_id() { return (unsigned)__builtin_amdgcn_s_getreg((3 << 11) | 20) & 0xFu; }
#define XB_SPIN(cond, bar) do { unsigned _sp = 0; while (cond) { __builtin_amdgcn_s_sleep(1); \
    if ((++_sp & 255u) == 0u) { if (xb_ld(&(bar)[XB_TMO])) break; if (_sp > XB_SPIN_CAP) { atomicAdd(&(bar)[XB_TMO], 1u); break; } } } } while (0)

struct XcdBarrier {
    unsigned* bar; unsigned x;
    volatile LAS unsigned* st;
};

__device__ __forceinline__ XcdBarrier xcd_barrier_post(unsigned* bar, volatile LAS unsigned* st, int wave) {
    XcdBarrier b; b.bar = bar; b.x = xb_xcc_id(); b.st = st;
    if (wave == 0 && lane_id() == 0) (void)xb_add(&bar[XB_XCNT(b.x)], 1u);
    return b;
}
__device__ __forceinline__ void xcd_barrier_complete(unsigned* bar, unsigned x, unsigned& nloc, unsigned& nx) {
    const unsigned G = gridDim.x * gridDim.y * gridDim.z;
    unsigned sum, cnt, mine, sp = 0u;
    for (;;) {
        sum = 0u; cnt = 0u; mine = 0u;
#pragma unroll
        for (unsigned j = 0; j < 16; ++j) { const unsigned c = xb_ld(&bar[XB_XCNT(j)]); sum += c; cnt += (c > 0u) ? 1u : 0u; mine = (j == x) ? c : mine; }
        if (sum == G) break;
        __builtin_amdgcn_s_sleep(1);
        if ((++sp & 255u) == 0u) { if (xb_ld(&bar[XB_TMO])) break; if (sp > XB_SPIN_CAP) { atomicAdd(&bar[XB_TMO], 1u); break; } }
    }
    nloc = mine > 0u ? mine : 1u; nx = cnt > 0u ? cnt : 1u;
}

__device__ __forceinline__ void xcd_barrier(const XcdBarrier& b, int wave) {
    asm volatile("s_waitcnt vmcnt(0)" ::: "memory");
    __syncthreads();
    if (wave == 0 && lane_id() == 0) {
        unsigned* bar = b.bar;
        __builtin_amdgcn_s_waitcnt(0);
        unsigned nloc = b.st[0], nx = b.st[1];
        if (nloc == 0u) { xcd_barrier_complete(bar, b.x, nloc, nx); b.st[0] = nloc; b.st[1] = nx; }
        const unsigned old = xb_add(&bar[XB_XSUB(b.x)], 1u);
        const unsigned gen = old / nloc;
        if (old + 1u == (gen + 1u) * nloc) {
            __builtin_amdgcn_fence(__ATOMIC_RELEASE, "agent");
            asm volatile("s_waitcnt vmcnt(0)" ::: "memory");
            const unsigned og = xb_add(&bar[XB_TOP], 1u);
            const unsigned tg = og / nx;
            if (og + 1u == (tg + 1u) * nx) xb_add(&bar[XB_TOPGEN], 1u);
            else XB_SPIN(xb_ld(&bar[XB_TOPGEN]) == tg, bar);
            __builtin_amdgcn_fence(__ATOMIC_ACQUIRE, "agent");
            xb_add(&bar[XB_XGEN(b.x)], 1u);
            asm volatile("s_waitcnt vmcnt(0)" ::: "memory");
        } else {
            XB_SPIN(xb_ld(&bar[XB_XGEN(b.x)]) == gen, bar);
            __builtin_amdgcn_fence(__ATOMIC_ACQUIRE, "agent");
            asm volatile("s_waitcnt vmcnt(0)" ::: "memory");
        }
    }
    __syncthreads();
}

#define LG_SUB(g)  (3584 + 64 * (g))
#define LG_GEN(g)  (4160 + 64 * (g))
#define LG_MASK(g) (4736 + 64 * (g))
__device__ __forceinline__ void lg_barrier(const XcdBarrier& b, int wave, unsigned g, unsigned nloc, bool fast) {
    asm volatile("s_waitcnt vmcnt(0)" ::: "memory");
    __syncthreads();
    if (wave == 0 && lane_id() == 0) {
        unsigned* bar = b.bar;
        __builtin_amdgcn_s_waitcnt(0);
        if (!fast) { __builtin_amdgcn_fence(__ATOMIC_RELEASE, "agent"); asm volatile("s_waitcnt vmcnt(0)" ::: "memory"); }
        const unsigned old = xb_add(&bar[LG_SUB(g)], 1u), gen = old / nloc;
        if (old + 1u == (gen + 1u) * nloc) xb_add(&bar[LG_GEN(g)], 1u);
        else XB_SPIN(xb_ld(&bar[LG_GEN(g)]) == gen, bar);
        __builtin_amdgcn_fence(__ATOMIC_ACQUIRE, "agent");
        asm volatile("s_waitcnt vmcnt(0)" ::: "memory");
    }
    __syncthreads();
}

struct RowV { f32x4 v[4]; };
__device__ __forceinline__ void row_load(RowV& r, const float* row, int lane) {
#pragma unroll
    for (int j = 0; j < 4; ++j) r.v[j] = ntload((const f32x4*)(row + 4 * lane + 256 * j));
}
__device__ __forceinline__ void row_load_bf16(RowV& r, const bf16_t* row, int lane) {
#pragma unroll
    for (int j = 0; j < 4; ++j) { const u32x2 w = *(const u32x2*)(row + 4 * lane + 256 * j); r.v[j] = (f32x4){bflo(w.x), bfhi(w.x), bflo(w.y), bfhi(w.y)}; }
}
__device__ __forceinline__ float row_rstd(const RowV& r) {
    float s = 0.f;
#pragma unroll
    for (int j = 0; j < 4; ++j) s += (r.v[j].x * r.v[j].x + r.v[j].y * r.v[j].y) + (r.v[j].z * r.v[j].z + r.v[j].w * r.v[j].w);
    s = wave_sum(s);
    return __builtin_amdgcn_rsqf(s * (1.0f / 1024.0f) + EPS);
}
__device__ __forceinline__ void row_modulate(RowV& r, float rstd, const float* g, const float* sh, const float* sc, int lane) {
#pragma unroll
    for (int j = 0; j < 4; ++j) {
        const int o = 4 * lane + 256 * j;
        const f32x4 gg = *(const f32x4*)(g + o), s = *(const f32x4*)(sc + o), h = *(const f32x4*)(sh + o);
        r.v[j] = (r.v[j] * rstd * gg) * (s + 1.0f) + h;
    }
}
struct ModV { f32x4 gp[4], sh[4]; };
__device__ __forceinline__ void mod_load(ModV& m, const float* g, const float* sh, const float* sc, int lane) {
#pragma unroll
    for (int j = 0; j < 4; ++j) { const int o = 4 * lane + 256 * j; m.gp[j] = *(const f32x4*)(g + o) * (*(const f32x4*)(sc + o) + 1.0f); m.sh[j] = *(const f32x4*)(sh + o); }
}
__device__ __forceinline__ void row_apply(RowV& r, float rstd, const ModV& m) {
#pragma unroll
    for (int j = 0; j < 4; ++j) r.v[j] = (r.v[j] * rstd) * m.gp[j] + m.sh[j];
}
__device__ __forceinline__ void row_store_bf16(const RowV& r, bf16_t* out, int lane) {
#pragma unroll
    for (int j = 0; j < 4; ++j) { u32x2 w; w.x = pg8::cvt_pk_bf16(r.v[j].x, r.v[j].y); w.y = pg8::cvt_pk_bf16(r.v[j].z, r.v[j].w); *(u32x2*)(out + 4 * lane + 256 * j) = w; }
}
__device__ __forceinline__ void row_store_f32(const RowV& r, float* out, int lane) {
#pragma unroll
    for (int j = 0; j < 4; ++j) *(f32x4*)(out + 4 * lane + 256 * j) = r.v[j];
}

__device__ __forceinline__ int wmap(int code, int n) {
    if (code == 1) { const int isU = n >> 10, ch = n & 1023; return (ch >> 7) * 256 + isU * 128 + (ch & 127); }
    if (code == 2) { const int typ = (n % 1536) / 512, d = n & 63; return (typ < 2 && d >= 4 && d < 12) ? (d < 8 ? n + 4 : n - 4) : n; }
    if (code == 3) return (n >> 7) * 256 + (n & 127);
    if (code == 4) return (n >> 7) * 256 + 128 + (n & 127);
    return n;
}
struct ConvDesc { const float* src; bf16_t* dst; int ldw, K, code, nloc; };
__device__ __forceinline__ void conv_desc(ConvDesc& d, const float* W, int ldw, int ncol0, bf16_t* WT, int K, int code, int kb, int nb) {
    d.src = W + (size_t)(64 * kb) * ldw + ncol0 + 64 * nb; d.dst = WT + 64 * kb; d.ldw = ldw; d.K = K; d.code = code; d.nloc = 64 * nb;
}
__device__ __forceinline__ void conv_load(f32x4 (&v)[16], const ConvDesc& d, int lane) {
    const float* src = d.src + (size_t)(lane >> 4) * d.ldw + (lane & 15) * 4;
#pragma unroll
    for (int i = 0; i < 16; ++i) v[i] = ntload((const f32x4*)(src + (size_t)(4 * i) * d.ldw));
}
__device__ __forceinline__ void conv_process(const f32x4 (&v)[16], const ConvDesc& d, LAS float* scr, int lane) {
#pragma unroll
    for (int i = 0; i < 16; ++i) { LAS float* p = scr + (4 * i + (lane >> 4)) * 65 + (lane & 15) * 4; p[0] = v[i].x; p[1] = v[i].y; p[2] = v[i].z; p[3] = v[i].w; }
    LDS_WAIT();
    const int c = lane & 7;
#pragma unroll
    for (int j = 0; j < 8; ++j) { const int n = (lane >> 3) + 8 * j; const LAS float* sp = scr + (8 * c) * 65 + n;
        u32x4 o; o.x = pg8::cvt_pk_bf16(sp[0 * 65], sp[1 * 65]); o.y = pg8::cvt_pk_bf16(sp[2 * 65], sp[3 * 65]); o.z = pg8::cvt_pk_bf16(sp[4 * 65], sp[5 * 65]); o.w = pg8::cvt_pk_bf16(sp[6 * 65], sp[7 * 65]);
        *(u32x4*)(d.dst + (size_t)wmap(d.code, d.nloc + n) * d.K + 8 * c) = o; }
    LDS_WAIT();
}
constexpr int NCONV_ITEMS = 512 + 256 + 256 + 1152 + 128 + 64 * 384;

namespace att {
typedef short bf16x8 __attribute__((ext_vector_type(8)));
typedef short s16x4 __attribute__((ext_vector_type(4)));
typedef float f32x16 __attribute__((ext_vector_type(16)));
constexpr int NKEY = 384, KOFF = 0, KCH = NKEY * 16 + 16  , VOFF = 8 * KCH, VDH = (NKEY / 16) * 1024 + 64  , NUNITS = 16 * 3 * 16 * 8;
__device__ __forceinline__ int crow(int r, int hi) { return (r & 3) + 8 * (r >> 2) + 4 * hi; }
__device__ __forceinline__ s16x4 vtr(const LAS unsigned char* p) { return __builtin_bit_cast(s16x4, __builtin_amdgcn_ds_read_tr16_b64_v4i16((LAS s16x4*)p)); }
__device__ __forceinline__ float xhalf_max(float m) { auto rr = __builtin_amdgcn_permlane32_swap(__float_as_uint(m), __float_as_uint(m), false, false); return fmaxf(__uint_as_float(rr[0]), __uint_as_float(rr[1])); }
__device__ __forceinline__ float xhalf_sum(float m) { auto rr = __builtin_amdgcn_permlane32_swap(__float_as_uint(m), __float_as_uint(m), false, false); return __uint_as_float(rr[0]) + __uint_as_float(rr[1]); }

template <typename P> __device__ __forceinline__ P sadd(P base, unsigned off) { asm volatile("" : "+v"(off)); return base + off; }
struct AUnit { int h, g, b, dil, l0, r0; size_t tb; };
template <bool MERGE> __device__ __forceinline__ void adecode(AUnit& u, int idx) {
    const int sb = ((idx >> 4) & 7) * 2 + (idx & 1), bg = idx >> 7; u.b = MERGE ? bg : (bg >> 1);
    u.h = (idx >> 1) & 7; u.g = MERGE ? 2 : (bg & 1); const int dsh = 2 * u.g; u.dil = 1 << dsh;
    const int bps = 16 >> dsh, r = sb / bps; u.l0 = (sb - r * bps) * 256; u.r0 = r << (12 - dsh); u.tb = (size_t)u.b * SEQ + r;
}
__device__ __forceinline__ void aload_kv(u32x4 (&kv)[12], const AUnit& u, const bf16_t* qkv, int wave, int lane) {
    const char* kb = (const char*)(qkv + qkv_block(1, u.g, u.b, u.h) + (size_t)u.r0 * 64); const char* vb = kb + (qkv_block(2, 0, 0, 0) - qkv_block(1, 0, 0, 0)) * 2;
#pragma unroll
    for (int i = 0; i < 6; ++i) {
        int sp = u.l0 - 128 + 48 * wave + 8 * i + (lane >> 3); sp = sp < 0 ? 0 : sp;
        const unsigned ro = (unsigned)sp * 128u + (unsigned)(lane & 7) * 16u;
        kv[i] = *(const u32x4*)sadd(kb, ro); kv[6 + i] = *(const u32x4*)sadd(vb, ro);
    }
}
__device__ __forceinline__ void astore_kv(const u32x4 (&kv)[12], LAS unsigned char* lds, int wave, int lane) {
#pragma unroll
    for (int i = 0; i < 6; ++i) { const int key = 48 * wave + 8 * i + (lane >> 3);
        *(LAS u32x4*)(lds + KOFF + (lane & 7) * KCH + key * 16) = kv[i];
        *(LAS u32x4*)(lds + VOFF + ((lane & 7) >> 2) * VDH + (key >> 4) * 1024 + (key & 15) * 64 + (lane & 3) * 16) = kv[6 + i]; }
}
__device__ __forceinline__ char* aqrow(const AUnit& u, bf16_t* qkv, int wave) {
    return (char*)(qkv + qkv_block(0, u.g, u.b, u.h) + (size_t)(u.r0 + u.l0 + 32 * wave) * 64);
}

template <bool MERGE> __device__ __forceinline__ void attn_phase(LAS unsigned char* lds, bf16_t* qkv, float* lse, bf16_t* ob, int bid, int G, int wave, bool dry = false) {
    constexpr int NU = MERGE ? NUNITS / 3 : 2 * NUNITS / 3;
    const int per = (NU + G - 1) / G;
    const int u_lo = bid * per, u_hi = (u_lo + per < NU) ? u_lo + per : NU;
    asm volatile("" : "+s"(wave));
    const int lane = lane_id(), r32 = lane & 31, hi = lane >> 5;
    const int qt = wave;
    const unsigned qlo = (unsigned)r32 * 128u + (unsigned)hi * 16u;
    u32x4 kv[12]; bf16x8 qn[4];
    AUnit un;
    if (u_lo < u_hi) { adecode<MERGE>(un, u_lo); aload_kv(kv, un, qkv, wave, lane);
        { const char* q = aqrow(un, qkv, wave);
#pragma unroll
            for (int d0 = 0; d0 < 4; ++d0) qn[d0] = *(const bf16x8*)(sadd(q, qlo) + d0 * 32); } }
#pragma unroll 1
    for (int idx = u_lo; idx < u_hi; ++idx) {
        const AUnit u = un;
        const int g = u.g, l0 = u.l0, head = u.h;
        char* qrow = aqrow(u, qkv, wave);
        const size_t tqw = u.tb + (size_t)(l0 + 32 * qt) * u.dil;
        bf16x8 qf[4];
        astore_kv(kv, lds, wave, lane);
#pragma unroll
        for (int d0 = 0; d0 < 4; ++d0) qf[d0] = qn[d0];
        __syncthreads();
        if (idx + 1 < u_hi) { adecode<MERGE>(un, idx + 1); aload_kv(kv, un, qkv, wave, lane);
            { const char* q = aqrow(un, qkv, wave);
#pragma unroll
                for (int d0 = 0; d0 < 4; ++d0) qn[d0] = *(const bf16x8*)(sadd(q, qlo) + d0 * 32); } }
        u32x2 og[MERGE ? 2 : 1][2][4]; float lg0 = 0.f, lg1 = 0.f;
        if constexpr (MERGE) {
            const int pq = (int)(tqw & (SEQ - 1)) + r32 * u.dil; const char* oq0 = (const char*)(qkv + qkv_block(0, 0, u.b, head)); const char* oq1 = (const char*)(qkv + qkv_block(0, 1, u.b, head));
            const unsigned oo0 = (unsigned)qkv_row(pq, 0) * 128u + 8u * hi, oo1 = (unsigned)qkv_row(pq, 1) * 128u + 8u * hi;
#pragma unroll
            for (int gg = 0; gg < 2; ++gg)
#pragma unroll
                for (int d0 = 0; d0 < 2; ++d0)
#pragma unroll
                    for (int rg = 0; rg < 4; ++rg) og[gg][d0][rg] = *(const u32x2*)(sadd(gg ? oq1 : oq0, gg ? oo1 : oo0) + (d0 * 64 + 16 * rg));
            const char* lb = (const char*)(lse + tqw * 24 + head); const unsigned lo_ = (unsigned)(r32 * u.dil) * 96u;
            lg0 = *(const float*)sadd(lb, lo_); lg1 = *(const float*)(sadd(lb, lo_) + 32);
        }
        f32x16 p[5];
        const LAS unsigned char* kb = lds + KOFF + hi * KCH + (qt * 32 + r32) * 16;
#pragma unroll
        for (int j = 0; j < 5; ++j) {
#pragma unroll
            for (int rr = 0; rr < 16; ++rr) p[j][rr] = 0.f;
#pragma unroll
            for (int d0 = 0; d0 < 4; ++d0) {
                const bf16x8 kf = *(const LAS bf16x8*)(kb + j * 512 + d0 * 2 * KCH);
                p[j] = __builtin_amdgcn_mfma_f32_32x32x16_bf16(kf, qf[d0], p[j], 0, 0, 0);
            }
        }
#pragma unroll
        for (int rr = 0; rr < 16; ++rr) { const int c = crow(rr, hi); if (c < r32) p[0][rr] = -INFINITY; if (c > r32) p[4][rr] = -INFINITY; }
        if (l0 == 0) {
#pragma unroll
            for (int j = 0; j < 5; ++j)
#pragma unroll
                for (int rr = 0; rr < 16; ++rr) if (32 * (qt + j) + crow(rr, hi) < 128) p[j][rr] = -INFINITY;
        }
        float m = p[0][0];
#pragma unroll
        for (int j = 0; j < 5; ++j)
#pragma unroll
            for (int rr = 0; rr < 16; ++rr) m = fmaxf(m, p[j][rr]);
        m = xhalf_max(m);
        float l = 0.f;
#pragma unroll
        for (int j = 0; j < 5; ++j)
#pragma unroll
            for (int rr = 0; rr < 16; ++rr) { const float e = __builtin_amdgcn_exp2f(p[j][rr] - m); p[j][rr] = e; l += e; }
        l = xhalf_sum(l);
        f32x16 o[2];
#pragma unroll
        for (int rr = 0; rr < 16; ++rr) { o[0][rr] = 0.f; o[1][rr] = 0.f; }
        const LAS unsigned char* vb = lds + VOFF + ((lane >> 4) & 1) * 32 + (lane & 3) * 8 + (4 * hi + ((lane & 15) >> 2)) * 64 + qt * 2048;
#pragma unroll
        for (int j = 0; j < 5; ++j)
#pragma unroll
            for (int s = 0; s < 2; ++s) {
                u32x4 pw; pw.x = pg8::cvt_pk_bf16(p[j][8 * s + 0], p[j][8 * s + 1]); pw.y = pg8::cvt_pk_bf16(p[j][8 * s + 2], p[j][8 * s + 3]);
                pw.z = pg8::cvt_pk_bf16(p[j][8 * s + 4], p[j][8 * s + 5]); pw.w = pg8::cvt_pk_bf16(p[j][8 * s + 6], p[j][8 * s + 7]);
                const bf16x8 pf = __builtin_bit_cast(bf16x8, pw);
#pragma unroll
                for (int d0 = 0; d0 < 2; ++d0) {
                    const s16x4 vlo = vtr(vb + d0 * VDH + (2 * j + s) * 1024), vhi = vtr(vb + d0 * VDH + (2 * j + s) * 1024 + 512);
                    const bf16x8 vf = {vlo[0], vlo[1], vlo[2], vlo[3], vhi[0], vhi[1], vhi[2], vhi[3]};
                    o[d0] = __builtin_amdgcn_mfma_f32_32x32x16_bf16(vf, pf, o[d0], 0, 0, 0);
                }
            }
        if constexpr (!MERGE) {
            const float inv = 1.0f / l;
#pragma unroll
            for (int d0 = 0; d0 < 2; ++d0)
#pragma unroll
                for (int rg = 0; rg < 4; ++rg) {
                    u32x2 w; w.x = pg8::cvt_pk_bf16(o[d0][4 * rg] * inv, o[d0][4 * rg + 1] * inv); w.y = pg8::cvt_pk_bf16(o[d0][4 * rg + 2] * inv, o[d0][4 * rg + 3] * inv);
                    if (!dry) *(u32x2*)(sadd(qrow, (unsigned)r32 * 128u + 8u * hi) + (d0 * 64 + 16 * rg)) = w; else asm volatile("" :: "v"(w.x), "v"(w.y));
                }
            if (hi == 0 && !dry) *(float*)((char*)(lse + tqw * 24 + g * 8 + head) + (unsigned)(r32 * u.dil) * 96u) = m + __builtin_amdgcn_logf(l);
        } else {
            const float lg2 = m + __builtin_amdgcn_logf(l), mx = fmaxf(lg2, fmaxf(lg0, lg1));
            const float w0 = __builtin_amdgcn_exp2f(lg0 - mx), w1 = __builtin_amdgcn_exp2f(lg1 - mx), w2 = __builtin_amdgcn_exp2f(lg2 - mx);
            const float iw = 1.0f / (w0 + w1 + w2), c0 = w0 * iw, c1 = w1 * iw, c2 = w2 * iw / l;
            char* orow = (char*)(ob + tqw * 512 + head * 64); const unsigned oro = (unsigned)(r32 * u.dil) * 1024u + 8u * hi;
#pragma unroll
            for (int d0 = 0; d0 < 2; ++d0)
#pragma unroll
                for (int rg = 0; rg < 4; ++rg) {
                    const u32x2 a = og[0][d0][rg], b = og[1][d0][rg];
                    u32x2 w; w.x = pg8::cvt_pk_bf16(c0 * bflo(a.x) + c1 * bflo(b.x) + c2 * o[d0][4 * rg], c0 * bfhi(a.x) + c1 * bfhi(b.x) + c2 * o[d0][4 * rg + 1]);
                    w.y = pg8::cvt_pk_bf16(c0 * bflo(a.y) + c1 * bflo(b.y) + c2 * o[d0][4 * rg + 2], c0 * bfhi(a.y) + c1 * bfhi(b.y) + c2 * o[d0][4 * rg + 3]);
                    if (!dry) *(u32x2*)(sadd(orow, oro) + (d0 * 64 + 16 * rg)) = w; else asm volatile("" :: "v"(w.x), "v"(w.y));
                }
        }
        __syncthreads();
    }
}
}

typedef const __attribute__((address_space(4))) unsigned long long* kargp_t;
__device__ __forceinline__ kargp_t karg() { kargp_t p = (kargp_t)__builtin_amdgcn_kernarg_segment_ptr(); asm volatile("" : "+s"(p)); return p; }
#define KIN(i) ((const float*)(GAS const float*)karg()[i])
#define KOUT() ((float*)(GAS float*)karg()[19])
#define KWS() ((unsigned char*)(GAS unsigned char*)karg()[20])
#define WSP(type, off) ((type*)(KWS() + (off)))
struct Args { const float* in[19]; float* out; unsigned char* ws; int ph_lo, ph_hi; };
constexpr int NPHASE = 17;

__global__ void __launch_bounds__(NWAVES * 64, 2) mk_fwd(Args args) {
    extern __shared__ __attribute__((aligned(16))) unsigned char lds_raw[];
    LAS unsigned char* lds = (LAS unsigned char*)lds_raw;
    volatile LAS unsigned* MISC = (volatile LAS unsigned*)(lds + MISC_OFF);
    LAS int* rb = (LAS int*)(lds + MISC_OFF);
    const int wave = __builtin_amdgcn_readfirstlane((int)threadIdx.x >> 6);
#define IDS() const int lane = lane_id(), tid = wave * 64 + lane; (void)tid; (void)lane
    const int G = gridDim.x, bid = blockIdx.x;
    for (int u = threadIdx.x; u < (LDS_BYTES - MISC_OFF) / 4; u += NWAVES * 64) MISC[u] = 0u;
    __syncthreads();
#if MK_ONE_LAUNCH
    XcdBarrier bar = xcd_barrier_post((unsigned*)(KWS() + WS_CTL) + CW_BAR, MISC + 40, wave);
    if (threadIdx.x == 0) atomicOr(&bar.bar[LG_MASK(bid & 7)], 1u << bar.x);
#define GRID_BAR() xcd_barrier(bar, wave)
#define LOCAL_OK() (G == 256)
#define CBID() (LOCAL_OK() ? ((bid & 7) * 32 + (bid >> 3)) : bid)
#define LOCAL_BAR() do { if (LOCAL_OK()) lg_barrier(bar, wave, (unsigned)(bid & 7), 32u, MISC[42] != 0u); else GRID_BAR(); } while (0)
#else
#define GRID_BAR() do { } while (0)
#define LOCAL_OK() false
#define CBID() bid
#define LOCAL_BAR() do { } while (0)
#endif
#if MK_ONE_LAUNCH
    constexpr int lo = 0, hi = NPHASE; (void)args;
#else
    const int lo = args.ph_lo, hi = args.ph_hi;
#endif
#ifndef PHMASK
#define PHMASK 0xFFFFFFFFu
#endif
#define IN(k) ((((PHMASK) >> (k)) & 1u) && lo <= (k) && (k) < hi)
#ifndef REPMASK
#define REPMASK 0u
#endif
#define REPS(k) ((((REPMASK) >> (k)) & 1u) ? 2 : 1)
#define SEAM(k) do { if (IN(k) && IN((k) + 1)) GRID_BAR(); } while (0)
#define LSEAM(k) do { if (IN(k) && IN((k) + 1)) LOCAL_BAR(); } while (0)

    for (int rep_ = 0; rep_ < REPS(0); ++rep_) if (IN(0)) { IDS();
        const float* cin = KIN(1); const float* ada_w = KIN(4); const float* ada_b = KIN(5); float* mod = WSP(float, WS_MOD); float* rope = WSP(float, WS_ROPE);
        LAS float* cact = (LAS float*)lds; LAS float* red = cact + 16384;
        if (bid < 192) for (int i = tid; i < 16 * 1024; i += 512) { const float v = cin[i]; cact[i] = v / (1.f + expf(-v)); }
        __syncthreads();
        for (int item = bid; item < 192; item += G) {
            const int l = item / 96, n0 = (item % 96) * 64, kk = lane >> 4, n4 = lane & 15;
            f32x4 acc[16];
#pragma unroll
            for (int b = 0; b < 16; ++b) acc[b] = (f32x4){0.f, 0.f, 0.f, 0.f};
            const float* w = ada_w + (size_t)l * 1024 * 6144 + n0 + n4 * 4;
#pragma unroll 1
            for (int kb = 0; kb < 2; ++kb) {
                const int k0 = wave * 128 + kb * 64 + kk;
                f32x4 wv[16];
#pragma unroll
                for (int u = 0; u < 16; ++u) wv[u] = *(const f32x4*)(w + (size_t)(k0 + 4 * u) * 6144);
#pragma unroll
                for (int u = 0; u < 16; ++u)
#pragma unroll
                    for (int b = 0; b < 16; ++b) acc[b] += wv[u] * cact[b * 1024 + k0 + 4 * u];
            }
            const bool h5 = (lane & 32) != 0;
#pragma unroll
            for (int b = 0; b < 16; ++b)
#pragma unroll
                for (int c = 0; c < 4; ++c) { float v = acc[b][c]; v += xlane<16>(v); v += xlane32(v, h5); acc[b][c] = v; }
            if (lane < 16) {
#pragma unroll
                for (int b = 0; b < 16; ++b) *(LAS f32x4*)(red + (wave * 16 + b) * 64 + n4 * 4) = acc[b];
            }
            __syncthreads();
            for (int i = tid; i < 1024; i += 512) {
                const int b = i >> 6, nn = i & 63; float s = 0.f;
#pragma unroll
                for (int q = 0; q < 8; ++q) s += red[(q * 16 + b) * 64 + nn];
                mod[((size_t)l * 16 + b) * 6144 + n0 + nn] = s + ada_b[l * 6144 + n0 + nn];
            }
            __syncthreads();
        }
        for (int i = bid * 512 + tid; i < 4096 * 8; i += G * 512) {
            const int t = i >> 3, f = i & 7;
            const float inv = powf(500000.0f, -(float)(2 * f) / 16.0f);
            const float ang = (float)t * inv;
            rope[i] = (float)cos((double)ang);
            rope[4096 * 8 + i] = (float)sin((double)ang);
        }
    }
    SEAM(0);
    if (threadIdx.x == 0) { const unsigned m_ = xb_ld(&bar.bar[LG_MASK(bid & 7)]); MISC[42] = ((m_ & (m_ - 1u)) == 0u) ? 1u : 0u; }
    __syncthreads();
    for (int rep_ = 0; rep_ < REPS(1); ++rep_) if (IN(1)) { IDS();
        {
        LAS float* scr = (LAS float*)(lds + wave * 16640);
        const float* conv_in_w = KIN(6); const float* conv_out_w = KIN(8); const float* attn_in_w = KIN(9); const float* attn_out_w = KIN(10);
        const float* gate_w = KIN(15); const float* up_w = KIN(16); const float* down_w = KIN(17);
        bf16_t* WZ = WSP(bf16_t, WS_WZ); bf16_t* WB = WSP(bf16_t, WS_WB); bf16_t* WCO = WSP(bf16_t, WS_WCO); bf16_t* WAI = WSP(bf16_t, WS_WAI); bf16_t* WAO = WSP(bf16_t, WS_WAO);
        bf16_t* WGU = WSP(bf16_t, WS_WGU); bf16_t* WDN = WSP(bf16_t, WS_WDN);
#define CONV_DECODE(DD, IT) do { int it = (IT); \
            if (it < 512) { conv_desc(DD, conv_in_w, 3072, 1024, WZ, 1024, 1, it / 32, it % 32); break; } it -= 512; \
            if (it < 256) { conv_desc(DD, conv_in_w, 3072, 0, WB, 1024, 0, it / 16, it % 16); break; } it -= 256; \
            if (it < 256) { conv_desc(DD, conv_out_w, 1024, 0, WCO, 1024, 0, it / 16, it % 16); break; } it -= 256; \
            if (it < 1152) { conv_desc(DD, attn_in_w, QKVW, 0, WAI, 1024, 2, it / 72, it % 72); break; } it -= 1152; \
            if (it < 128) { conv_desc(DD, attn_out_w, 1024, 0, WAO, 512, 0, it / 16, it % 16); break; } it -= 128; \
            const int le = it / 384, r = it % 384; \
            if (r < 128) conv_desc(DD, gate_w + (size_t)le * D * DEXP, DEXP, 0, WGU + (size_t)le * 1024 * 1024, 1024, 3, r / 8, r % 8); \
            else if (r < 256) conv_desc(DD, up_w + (size_t)le * D * DEXP, DEXP, 0, WGU + (size_t)le * 1024 * 1024, 1024, 4, (r - 128) / 8, (r - 128) % 8); \
            else conv_desc(DD, down_w + (size_t)le * DEXP * D, D, 0, WDN + (size_t)le * 1024 * 512, 512, 0, (r - 256) / 16, (r - 256) % 16); } while (0)
        {
            const int step = G * NWAVES; int it0 = bid * NWAVES + wave;
            ConvDesc dA, dB; f32x4 vA[16], vB[16];
            if (it0 < NCONV_ITEMS) { CONV_DECODE(dA, it0); conv_load(vA, dA, lane); }
#pragma unroll 1
            for (; it0 < NCONV_ITEMS; it0 += 2 * step) {
                const bool hasB = it0 + step < NCONV_ITEMS, hasA2 = it0 + 2 * step < NCONV_ITEMS;
                if (hasB) { CONV_DECODE(dB, it0 + step); conv_load(vB, dB, lane); }
                conv_process(vA, dA, scr, lane);
                if (hasA2) { CONV_DECODE(dA, it0 + 2 * step); conv_load(vA, dA, lane); }
                if (hasB) conv_process(vB, dB, scr, lane);
            }
        }
#undef CONV_DECODE
        }
        const float* x = KIN(0); const float* norm_mix_g = KIN(2); const float* mod = WSP(float, WS_MOD); bf16_t* xn = WSP(bf16_t, WS_XN);
        for (int w0 = (bid * 8 + wave) * 32; w0 < T; w0 += G * 8 * 32) {
            const float* mb = mod + (size_t)(w0 >> 12) * 6144;
            ModV mv; mod_load(mv, norm_mix_g, mb + 0, mb + 1024, lane);
            RowV ring[4];
#pragma unroll
            for (int d = 0; d < 4; ++d) row_load(ring[d], x + (size_t)(w0 + d) * D, lane);
#pragma unroll 1
            for (int i = 0; i < 32; i += 4) {
#pragma unroll
                for (int d = 0; d < 4; ++d) {
                    const int row = w0 + i + d;
                    RowV r = ring[d];
                    if (i < 28) row_load(ring[d], x + (size_t)(row + 4) * D, lane);
                    const float rstd = row_rstd(r);
                    row_apply(r, rstd, mv);
                    row_store_bf16(r, xn + (size_t)row * D, lane);
                }
            }
        }
    }
    SEAM(1);
    for (int rep_ = 0; rep_ < REPS(2); ++rep_) if (IN(2)) { bf16_t* xn = WSP(bf16_t, WS_XN); bf16_t* WZ = WSP(bf16_t, WS_WZ); bf16_t* zb = WSP(bf16_t, WS_Z);
        pg8::Gemm g{xn, WZ, T, 2048, 1024}; pg8::StaticOrder S; S.init(T, 2048, G, bid); pg8::EpiPair<false> E{zb, D};
        pg8::gemm_phase<pg8::EpiPair<false>, pg8::StaticOrder, pg8::APlain, true, true>(lds, g, S, E, pg8::APlain{}, wave); }
    LSEAM(2);
    for (int rep_ = 0; rep_ < REPS(3); ++rep_) if (IN(3)) { bf16_t* xn = WSP(bf16_t, WS_XN); bf16_t* WB = WSP(bf16_t, WS_WB); bf16_t* zb = WSP(bf16_t, WS_Z); bf16_t* ypre = WSP(bf16_t, WS_YPRE); const float* conv_w = KIN(7);
        pg8::Gemm g{xn, WB, T, 1024, 1024}; pg8::StaticOrder S; S.init(T, 1024, G, bid); pg8::EpiYpre E{ypre, zb, conv_w};
        pg8::gemm_phase<pg8::EpiYpre, pg8::StaticOrder, pg8::APlain, true, true>(lds, g, S, E, pg8::APlain{}, wave); }
    LSEAM(3);
    for (int rep_ = 0; rep_ < REPS(4); ++rep_) if (IN(4)) { bf16_t* ypre = WSP(bf16_t, WS_YPRE); bf16_t* WCO = WSP(bf16_t, WS_WCO); bf16_t* xr = (bf16_t*)KOUT(); const float* x = KIN(0); const float* mod = WSP(float, WS_MOD);
        pg8::Gemm g{ypre, WCO, T, 1024, 1024}; pg8::StaticOrder S; S.init(T, 1024, G, bid); pg8::EpiRes<true> E{xr, x, mod + 2048};
        pg8::gemm_phase<pg8::EpiRes<true>, pg8::StaticOrder, pg8::APlain, true, true>(lds, g, S, E, pg8::APlain{}, wave); }
    LSEAM(4);
    { constexpr int l = 0;
        const int pb0 = (l == 0) ? 5 : 13;
#define MODL() (WSP(float, WS_MOD) + (size_t)l * 16 * 6144)
#define CNTL() (WSP(int, WS_CTL) + 64 * l)
        if (l == 1) {
#ifdef STAGGER9
            if (IN(9)) { const unsigned long long t0_ = __builtin_amdgcn_s_memrealtime(); const unsigned long long dl_ = (unsigned long long)(((bid >> 3) & 31) * STAGGER9 / 32);
                while (__builtin_amdgcn_s_memrealtime() - t0_ < dl_) __builtin_amdgcn_s_sleep(16); }
#endif
            for (int rep_ = 0; rep_ < REPS(9); ++rep_) if (IN(9)) { bf16_t* xn = WSP(bf16_t, WS_XN); bf16_t* WAI = WSP(bf16_t, WS_WAI); bf16_t* qkv = WSP(bf16_t, WS_QKV); const float* rope = WSP(float, WS_ROPE);
                pg8::Gemm g{xn, WAI, T, QKVW, 1024}; pg8::StaticOrder S; S.init(T, QKVW, G, bid, 8); pg8::EpiQKV E{qkv, rope, 0};
                pg8::gemm_phase<pg8::EpiQKV, pg8::StaticOrder, pg8::APlain, true, true>(lds, g, S, E, pg8::APlain{}, wave); }
            LSEAM(9);
            if (IN(10)) att::attn_phase<false>(lds, WSP(bf16_t, WS_QKV), WSP(float, WS_LSE), WSP(bf16_t, WS_OB), CBID(), G, wave);
            LSEAM(10);
            if (IN(11)) att::attn_phase<true>(lds, WSP(bf16_t, WS_QKV), WSP(float, WS_LSE), WSP(bf16_t, WS_OB), CBID(), G, wave);
            LSEAM(11);
            if (IN(12)) { bf16_t* ob = WSP(bf16_t, WS_OB); bf16_t* WAO = WSP(bf16_t, WS_WAO); bf16_t* xr = (bf16_t*)KOUT();
                pg8::Gemm g{ob, WAO, T, 1024, 512}; pg8::StaticOrder S; S.init(T, 1024, G, bid); pg8::EpiRes<false> E{xr, nullptr, MODL() + 2048};
                pg8::gemm_phase<pg8::EpiRes<false>, pg8::StaticOrder, pg8::APlain, true, true>(lds, g, S, E, pg8::APlain{}, wave); }
            LSEAM(12);
        }
        for (int rep_ = 0; rep_ < REPS(5); ++rep_) if (IN(pb0)) { IDS(); const bool dry = rep_ + 1 < REPS(5);
            LAS f32x4* TG = (LAS f32x4*)lds; LAS f32x4* TE = (LAS f32x4*)(lds + 16384);
            LAS int* rec_e = (LAS int*)(lds + 147456); LAS float* rec_w = (LAS float*)(lds + 147456 + 2048); LAS int* rec_rank = (LAS int*)(lds + 147456 + 4096);
            LAS int* hist = (LAS int*)(lds + 147456 + 6144); LAS int* base = (LAS int*)(lds + 147456 + 6144 + 128);
            const float* gff = KIN(3) + l * D; const float* wg = KIN(11) + (size_t)l * D * 4; const float* bg = KIN(12) + l * 4; const float* we = KIN(13) + (size_t)l * 4 * D * 8; const float* be = KIN(14) + l * 32;
            const bf16_t* xr = (const bf16_t*)KOUT(); const float* modl = MODL(); int* cntl = CNTL(); bf16_t* xn = WSP(bf16_t, WS_XN); int* ltok = WSP(int, WS_LTOK); float* lw = WSP(float, WS_LW); int* tslot = WSP(int, WS_TSLOT);
            for (int i = tid; i < 1024; i += 512) { const int ln = i & 63, jc = i >> 6, k = 4 * ln + 256 * (jc >> 2) + (jc & 3); TG[i] = *(const f32x4*)(wg + (size_t)k * 4); }
            for (int i = tid; i < 8192; i += 512) { const int ln = i & 63, jc = (i >> 6) & 15, half = (i >> 10) & 1, gi = i >> 11, k = 4 * ln + 256 * (jc >> 2) + (jc & 3);
                TE[i] = *(const f32x4*)(we + ((size_t)gi * 1024 + k) * 8 + half * 4); }
            __syncthreads();
            const bool h5 = (lane & 32) != 0, h4 = (lane & 16) != 0, h3 = (lane & 8) != 0;
            for (int blk = CBID(); blk < T / 256; blk += G) {
                if (tid < 32) hist[tid] = 0;
                __syncthreads();
                ModV mv; { const float* mb = modl + (size_t)((blk * 256) >> 12) * 6144; mod_load(mv, gff, mb + 3072, mb + 4096, lane); }
                u32x2 ring[4][4];
#pragma unroll
                for (int d = 0; d < 4; ++d)
#pragma unroll
                    for (int j = 0; j < 4; ++j) ring[d][j] = *(const u32x2*)(xr + (size_t)(blk * 256 + wave * 32 + d) * XRP + 4 * lane + 256 * j);
#pragma unroll 1
                for (int i4 = 0; i4 < 32; i4 += 4)
#pragma unroll
                for (int d = 0; d < 4; ++d) {
                    const int i = i4 + d, rl = wave * 32 + i, row = blk * 256 + rl;
                    RowV r;
#pragma unroll
                    for (int j = 0; j < 4; ++j) { const u32x2 w = ring[d][j]; r.v[j] = (f32x4){bflo(w.x), bfhi(w.x), bflo(w.y), bfhi(w.y)}; }
                    if (i4 < 28) {
#pragma unroll
                        for (int j = 0; j < 4; ++j) ring[d][j] = *(const u32x2*)(xr + (size_t)(row + 4) * XRP + 4 * lane + 256 * j); }
                    const float rstd = row_rstd(r);
                    row_apply(r, rstd, mv);
                    row_store_bf16(r, xn + (size_t)row * D, lane);
                    f32x4 pg = {0.f, 0.f, 0.f, 0.f};
#pragma unroll
                    for (int jc = 0; jc < 16; ++jc) pg += TG[jc * 64 + lane] * r.v[jc >> 2][jc & 3];
                    float gl[4];
                    { float b0 = (h5 ? pg.z : pg.x) + xlane32(h5 ? pg.x : pg.z, h5), b1 = (h5 ? pg.w : pg.y) + xlane32(h5 ? pg.y : pg.w, h5);
                      float c = (h4 ? b1 : b0) + xlane<16>(h4 ? b0 : b1);
                      c += xlane<8>(c); c += xlane<4>(c); c += xlane<2>(c); c += xlane<1>(c);
#pragma unroll
                      for (int o = 0; o < 4; ++o) gl[o] = __int_as_float(__builtin_amdgcn_readlane(__float_as_int(c), 16 * o)) + bg[o]; }
                    int gi = 0; float gm = gl[0];
#pragma unroll
                    for (int o = 1; o < 4; ++o) if (gl[o] > gm) { gm = gl[o]; gi = o; }
                    float gden = 0.f;
#pragma unroll
                    for (int o = 0; o < 4; ++o) gden += __builtin_amdgcn_exp2f((gl[o] - gm) * 1.4426950408889634f);
                    const float grp_p = __builtin_amdgcn_rcpf(gden);
                    f32x4 pa = {0.f, 0.f, 0.f, 0.f}, pb = {0.f, 0.f, 0.f, 0.f};
                    const LAS f32x4* te = TE + gi * 2048 + lane;
#pragma unroll
                    for (int jc = 0; jc < 16; ++jc) { const float hv = r.v[jc >> 2][jc & 3]; pa += te[jc * 64] * hv; pb += te[1024 + jc * 64] * hv; }
                    float el[8];
                    { const f32x4 keep = h5 ? pb : pa, send = h5 ? pa : pb;
                      f32x4 q; q.x = keep.x + xlane32(send.x, h5); q.y = keep.y + xlane32(send.y, h5); q.z = keep.z + xlane32(send.z, h5); q.w = keep.w + xlane32(send.w, h5);
                      const float b0 = (h4 ? q.z : q.x) + xlane<16>(h4 ? q.x : q.z), b1 = (h4 ? q.w : q.y) + xlane<16>(h4 ? q.y : q.w);
                      float c = (h3 ? b1 : b0) + xlane<8>(h3 ? b0 : b1);
                      c += xlane<4>(c); c += xlane<2>(c); c += xlane<1>(c);
#pragma unroll
                      for (int o = 0; o < 8; ++o) el[o] = __int_as_float(__builtin_amdgcn_readlane(__float_as_int(c), 8 * o)) + be[gi * 8 + o]; }
                    int i0 = 0; float m0 = el[0];
#pragma unroll
                    for (int o = 1; o < 8; ++o) if (el[o] > m0) { m0 = el[o]; i0 = o; }
                    int i1 = -1; float m1 = -INFINITY;
#pragma unroll
                    for (int o = 0; o < 8; ++o) if (o != i0 && el[o] > m1) { m1 = el[o]; i1 = o; }
                    const float p1 = __builtin_amdgcn_exp2f((m1 - m0) * 1.4426950408889634f), w0_ = grp_p * __builtin_amdgcn_rcpf(1.0f + p1);
                    if (lane == 0) { rec_e[rl * 2] = gi * 8 + i0; rec_e[rl * 2 + 1] = gi * 8 + i1; rec_w[rl * 2] = w0_; rec_w[rl * 2 + 1] = w0_ * p1; }
                }
                __syncthreads();
                { const int e = rec_e[tid]; rec_rank[tid] = atomicAdd((int*)&hist[e], 1); }
                __syncthreads();
                if (tid < 32) { const int h = hist[tid]; base[tid] = (h && !dry) ? atomicAdd(&cntl[tid], h) : 0; }
                __syncthreads();
                { const int e = rec_e[tid], pos = base[e] + rec_rank[tid], tok = blk * 256 + (tid >> 1);
                  if (!dry) { ltok[(size_t)e * LISTCAP + pos] = tok; lw[(size_t)e * LISTCAP + pos] = rec_w[tid]; tslot[tok * 2 + (tid & 1)] = (e << 16) | pos; } }
                __syncthreads();
            }
        }
        SEAM(pb0);
        if (IN(pb0 + 1) || IN(pb0 + 2) || IN(pb0 + 3)) {
            __syncthreads();
            if (wave == 0 && lane_id() == 0) { const int* cntl = CNTL(); int s = 0;
#pragma unroll 1
                for (int e = 0; e < 32; ++e) { rb[e] = s; s += (__hip_atomic_load(&cntl[e], RLX_AGENT) + 255) & ~255; }
                rb[32] = s; }
            __syncthreads();
        }
        for (int rep_ = 0; rep_ < REPS(6); ++rep_) if (IN(pb0 + 1)) { bf16_t* xn = WSP(bf16_t, WS_XN); bf16_t* WGU = WSP(bf16_t, WS_WGU); bf16_t* act = WSP(bf16_t, WS_ACT); const int* ltok = WSP(int, WS_LTOK); const int* cntl = CNTL();
            pg8::Gemm g{xn, WGU + (size_t)l * 32 * 1024 * 1024, 0, 0, 1024}; pg8::MoeOrder S; S.init(rb[32] / 256, G, bid, rb, LOCAL_OK()); pg8::EpiPair<true> E{act, DEXP}; pg8::AGather am{ltok, cntl, rb};
            pg8::gemm_phase<pg8::EpiPair<true>, pg8::MoeOrder, pg8::AGather, true, true>(lds, g, S, E, am, wave); }
        LSEAM(pb0 + 1);
        for (int rep_ = 0; rep_ < REPS(7); ++rep_) if (IN(pb0 + 2)) { bf16_t* act = WSP(bf16_t, WS_ACT); bf16_t* WDN = WSP(bf16_t, WS_WDN); bf16_t* yw = WSP(bf16_t, WS_YW); const float* lw = WSP(float, WS_LW);
            pg8::Gemm g{act, WDN + (size_t)l * 32 * 1024 * 512, 0, 0, 512}; pg8::MoeOrder S; S.init(rb[32] / 256, G, bid, rb, LOCAL_OK()); pg8::EpiDown E{yw, lw, rb};
            pg8::gemm_phase<pg8::EpiDown, pg8::MoeOrder, pg8::APlain, true, true>(lds, g, S, E, pg8::APlain{}, wave); }
        SEAM(pb0 + 2);
        for (int rep_ = 0; rep_ < REPS(8); ++rep_) if (IN(pb0 + 3)) { IDS(); const bool dry = rep_ + 1 < REPS(8);
            const float* gnext = (l == 0) ? KIN(2) + D : KIN(18);
            const float* modn = WSP(float, WS_MOD) + (size_t)16 * 6144; const float* modl = MODL();
            float* outf = KOUT(); bf16_t* xr = (bf16_t*)KOUT(); const bf16_t* yw = WSP(bf16_t, WS_YW); const int* tslot = WSP(int, WS_TSLOT); bf16_t* xn = WSP(bf16_t, WS_XN);
            for (int w0 = (bid * 8 + wave) * 32; w0 < T; w0 += G * 8 * 32) {
                const int b = w0 >> 12;
                f32x4 g2v[4];
#pragma unroll
                for (int j = 0; j < 4; ++j) g2v[j] = *(const f32x4*)(modl + (size_t)b * 6144 + 5120 + 4 * lane + 256 * j);
                ModV mv;
                if (l == 0) { const float* mb = modn + (size_t)b * 6144; mod_load(mv, gnext, mb + 0, mb + 1024, lane); }
                else {
#pragma unroll
                    for (int j = 0; j < 4; ++j) { mv.gp[j] = *(const f32x4*)(gnext + 4 * lane + 256 * j); mv.sh[j] = (f32x4){0.f, 0.f, 0.f, 0.f}; }
                }
                const int slw = tslot[(size_t)w0 * 2 + lane];
                u32x2 xb[4][4], ya[4][4], yb[4][4];
#define R2_LOAD(D_, I_) do { const int s0_ = __builtin_amdgcn_readlane(slw, 2 * (I_)), s1_ = __builtin_amdgcn_readlane(slw, 2 * (I_) + 1); \
                    const size_t r0_ = (size_t)(rb[s0_ >> 16] + (s0_ & 0xffff)), r1_ = (size_t)(rb[s1_ >> 16] + (s1_ & 0xffff)); \
                    _Pragma("unroll") for (int j = 0; j < 4; ++j) { xb[D_][j] = *(const u32x2*)(xr + (size_t)(w0 + (I_)) * XRP + 4 * lane + 256 * j); \
                        ya[D_][j] = ntload((const u32x2*)(yw + r0_ * D + 4 * lane + 256 * j)); yb[D_][j] = ntload((const u32x2*)(yw + r1_ * D + 4 * lane + 256 * j)); } } while (0)
#pragma unroll
                for (int d = 0; d < 4; ++d) R2_LOAD(d, d);
#pragma unroll 1
                for (int i4 = 0; i4 < 32; i4 += 4)
#pragma unroll
                for (int d = 0; d < 4; ++d) {
                    const int i = i4 + d, row = w0 + i;
                    RowV r;
#pragma unroll
                    for (int j = 0; j < 4; ++j) {
                        const u32x2 xw = xb[d][j], a = ya[d][j], c = yb[d][j];
                        f32x4 y; y.x = bflo(a.x) + bflo(c.x); y.y = bfhi(a.x) + bfhi(c.x); y.z = bflo(a.y) + bflo(c.y); y.w = bfhi(a.y) + bfhi(c.y);
                        r.v[j] = (f32x4){bflo(xw.x), bfhi(xw.x), bflo(xw.y), bfhi(xw.y)} + g2v[j] * y;
                    }
                    if (i4 < 28) R2_LOAD(d, i + 4);
                    const float rstd = row_rstd(r);
                    if (dry) { asm volatile("" :: "v"(rstd), "v"(r.v[0].x), "v"(r.v[1].y), "v"(r.v[2].z), "v"(r.v[3].w)); }
                    else if (l == 1) { row_apply(r, rstd, mv); row_store_f32(r, outf + (size_t)row * D, lane); }
                    else { row_store_bf16(r, xr + (size_t)row * XRP, lane); row_apply(r, rstd, mv); row_store_bf16(r, xn + (size_t)row * D, lane); }
                }
#undef R2_LOAD
            }
        }
        SEAM(pb0 + 3);
    }
    { constexpr int l = 1;
        const int pb0 = (l == 0) ? 5 : 13;
#define MODL() (WSP(float, WS_MOD) + (size_t)l * 16 * 6144)
#define CNTL() (WSP(int, WS_CTL) + 64 * l)
        if (l == 1) {
#ifdef STAGGER9
            if (IN(9)) { const unsigned long long t0_ = __builtin_amdgcn_s_memrealtime(); const unsigned long long dl_ = (unsigned long long)(((bid >> 3) & 31) * STAGGER9 / 32);
                while (__builtin_amdgcn_s_memrealtime() - t0_ < dl_) __builtin_amdgcn_s_sleep(16); }
#endif
            for (int rep_ = 0; rep_ < REPS(9); ++rep_) if (IN(9)) { bf16_t* xn = WSP(bf16_t, WS_XN); bf16_t* WAI = WSP(bf16_t, WS_WAI); bf16_t* qkv = WSP(bf16_t, WS_QKV); const float* rope = WSP(float, WS_ROPE);
                pg8::Gemm g{xn, WAI, T, QKVW, 1024}; pg8::StaticOrder S; S.init(T, QKVW, G, bid, 8); pg8::EpiQKV E{qkv, rope, 0};
                pg8::gemm_phase<pg8::EpiQKV, pg8::StaticOrder, pg8::APlain, true, true>(lds, g, S, E, pg8::APlain{}, wave); }
            LSEAM(9);
            if (IN(10)) att::attn_phase<false>(lds, WSP(bf16_t, WS_QKV), WSP(float, WS_LSE), WSP(bf16_t, WS_OB), CBID(), G, wave);
            LSEAM(10);
            if (IN(11)) att::attn_phase<true>(lds, WSP(bf16_t, WS_QKV), WSP(float, WS_LSE), WSP(bf16_t, WS_OB), CBID(), G, wave);
            LSEAM(11);
            if (IN(12)) { bf16_t* ob = WSP(bf16_t, WS_OB); bf16_t* WAO = WSP(bf16_t, WS_WAO); bf16_t* xr = (bf16_t*)KOUT();
                pg8::Gemm g{ob, WAO, T, 1024, 512}; pg8::StaticOrder S; S.init(T, 1024, G, bid); pg8::EpiRes<false> E{xr, nullptr, MODL() + 2048};
                pg8::gemm_phase<pg8::EpiRes<false>, pg8::StaticOrder, pg8::APlain, true, true>(lds, g, S, E, pg8::APlain{}, wave); }
            LSEAM(12);
        }
        for (int rep_ = 0; rep_ < REPS(5); ++rep_) if (IN(pb0)) { IDS(); const bool dry = rep_ + 1 < REPS(5);
            LAS f32x4* TG = (LAS f32x4*)lds; LAS f32x4* TE = (LAS f32x4*)(lds + 16384);
            LAS int* rec_e = (LAS int*)(lds + 147456); LAS float* rec_w = (LAS float*)(lds + 147456 + 2048); LAS int* rec_rank = (LAS int*)(lds + 147456 + 4096);
            LAS int* hist = (LAS int*)(lds + 147456 + 6144); LAS int* base = (LAS int*)(lds + 147456 + 6144 + 128);
            const float* gff = KIN(3) + l * D; const float* wg = KIN(11) + (size_t)l * D * 4; const float* bg = KIN(12) + l * 4; const float* we = KIN(13) + (size_t)l * 4 * D * 8; const float* be = KIN(14) + l * 32;
            const bf16_t* xr = (const bf16_t*)KOUT(); const float* modl = MODL(); int* cntl = CNTL(); bf16_t* xn = WSP(bf16_t, WS_XN); int* ltok = WSP(int, WS_LTOK); float* lw = WSP(float, WS_LW); int* tslot = WSP(int, WS_TSLOT);
            for (int i = tid; i < 1024; i += 512) { const int ln = i & 63, jc = i >> 6, k = 4 * ln + 256 * (jc >> 2) + (jc & 3); TG[i] = *(const f32x4*)(wg + (size_t)k * 4); }
            for (int i = tid; i < 8192; i += 512) { const int ln = i & 63, jc = (i >> 6) & 15, half = (i >> 10) & 1, gi = i >> 11, k = 4 * ln + 256 * (jc >> 2) + (jc & 3);
                TE[i] = *(const f32x4*)(we + ((size_t)gi * 1024 + k) * 8 + half * 4); }
            __syncthreads();
            const bool h5 = (lane & 32) != 0, h4 = (lane & 16) != 0, h3 = (lane & 8) != 0;
            for (int blk = CBID(); blk < T / 256; blk += G) {
                if (tid < 32) hist[tid] = 0;
                __syncthreads();
                ModV mv; { const float* mb = modl + (size_t)((blk * 256) >> 12) * 6144; mod_load(mv, gff, mb + 3072, mb + 4096, lane); }
                u32x2 ring[4][4];
#pragma unroll
                for (int d = 0; d < 4; ++d)
#pragma unroll
                    for (int j = 0; j < 4; ++j) ring[d][j] = *(const u32x2*)(xr + (size_t)(blk * 256 + wave * 32 + d) * XRP + 4 * lane + 256 * j);
#pragma unroll 1
                for (int i4 = 0; i4 < 32; i4 += 4)
#pragma unroll
                for (int d = 0; d < 4; ++d) {
                    const int i = i4 + d, rl = wave * 32 + i, row = blk * 256 + rl;
                    RowV r;
#pragma unroll
                    for (int j = 0; j < 4; ++j) { const u32x2 w = ring[d][j]; r.v[j] = (f32x4){bflo(w.x), bfhi(w.x), bflo(w.y), bfhi(w.y)}; }
                    if (i4 < 28) {
#pragma unroll
                        for (int j = 0; j < 4; ++j) ring[d][j] = *(const u32x2*)(xr + (size_t)(row + 4) * XRP + 4 * lane + 256 * j); }
                    const float rstd = row_rstd(r);
                    row_apply(r, rstd, mv);
                    row_store_bf16(r, xn + (size_t)row * D, lane);
                    f32x4 pg = {0.f, 0.f, 0.f, 0.f};
#pragma unroll
                    for (int jc = 0; jc < 16; ++jc) pg += TG[jc * 64 + lane] * r.v[jc >> 2][jc & 3];
                    float gl[4];
                    { float b0 = (h5 ? pg.z : pg.x) + xlane32(h5 ? pg.x : pg.z, h5), b1 = (h5 ? pg.w : pg.y) + xlane32(h5 ? pg.y : pg.w, h5);
                      float c = (h4 ? b1 : b0) + xlane<16>(h4 ? b0 : b1);
                      c += xlane<8>(c); c += xlane<4>(c); c += xlane<2>(c); c += xlane<1>(c);
#pragma unroll
                      for (int o = 0; o < 4; ++o) gl[o] = __int_as_float(__builtin_amdgcn_readlane(__float_as_int(c), 16 * o)) + bg[o]; }
                    int gi = 0; float gm = gl[0];
#pragma unroll
                    for (int o = 1; o < 4; ++o) if (gl[o] > gm) { gm = gl[o]; gi = o; }
                    float gden = 0.f;
#pragma unroll
                    for (int o = 0; o < 4; ++o) gden += __builtin_amdgcn_exp2f((gl[o] - gm) * 1.4426950408889634f);
                    const float grp_p = __builtin_amdgcn_rcpf(gden);
                    f32x4 pa = {0.f, 0.f, 0.f, 0.f}, pb = {0.f, 0.f, 0.f, 0.f};
                    const LAS f32x4* te = TE + gi * 2048 + lane;
#pragma unroll
                    for (int jc = 0; jc < 16; ++jc) { const float hv = r.v[jc >> 2][jc & 3]; pa += te[jc * 64] * hv; pb += te[1024 + jc * 64] * hv; }
                    float el[8];
                    { const f32x4 keep = h5 ? pb : pa, send = h5 ? pa : pb;
                      f32x4 q; q.x = keep.x + xlane32(send.x, h5); q.y = keep.y + xlane32(send.y, h5); q.z = keep.z + xlane32(send.z, h5); q.w = keep.w + xlane32(send.w, h5);
                      const float b0 = (h4 ? q.z : q.x) + xlane<16>(h4 ? q.x : q.z), b1 = (h4 ? q.w : q.y) + xlane<16>(h4 ? q.y : q.w);
                      float c = (h3 ? b1 : b0) + xlane<8>(h3 ? b0 : b1);
                      c += xlane<4>(c); c += xlane<2>(c); c += xlane<1>(c);
#pragma unroll
                      for (int o = 0; o < 8; ++o) el[o] = __int_as_float(__builtin_amdgcn_readlane(__float_as_int(c), 8 * o)) + be[gi * 8 + o]; }
                    int i0 = 0; float m0 = el[0];
#pragma unroll
                    for (int o = 1; o < 8; ++o) if (el[o] > m0) { m0 = el[o]; i0 = o; }
                    int i1 = -1; float m1 = -INFINITY;
#pragma unroll
                    for (int o = 0; o < 8; ++o) if (o != i0 && el[o] > m1) { m1 = el[o]; i1 = o; }
                    const float p1 = __builtin_amdgcn_exp2f((m1 - m0) * 1.4426950408889634f), w0_ = grp_p * __builtin_amdgcn_rcpf(1.0f + p1);
                    if (lane == 0) { rec_e[rl * 2] = gi * 8 + i0; rec_e[rl * 2 + 1] = gi * 8 + i1; rec_w[rl * 2] = w0_; rec_w[rl * 2 + 1] = w0_ * p1; }
                }
                __syncthreads();
                { const int e = rec_e[tid]; rec_rank[tid] = atomicAdd((int*)&hist[e], 1); }
                __syncthreads();
                if (tid < 32) { const int h = hist[tid]; base[tid] = (h && !dry) ? atomicAdd(&cntl[tid], h) : 0; }
                __syncthreads();
                { const int e = rec_e[tid], pos = base[e] + rec_rank[tid], tok = blk * 256 + (tid >> 1);
                  if (!dry) { ltok[(size_t)e * LISTCAP + pos] = tok; lw[(size_t)e * LISTCAP + pos] = rec_w[tid]; tslot[tok * 2 + (tid & 1)] = (e << 16) | pos; } }
                __syncthreads();
            }
        }
        SEAM(pb0);
        if (IN(pb0 + 1) || IN(pb0 + 2) || IN(pb0 + 3)) {
            __syncthreads();
            if (wave == 0 && lane_id() == 0) { const int* cntl = CNTL(); int s = 0;
#pragma unroll 1
                for (int e = 0; e < 32; ++e) { rb[e] = s; s += (__hip_atomic_load(&cntl[e], RLX_AGENT) + 255) & ~255; }
                rb[32] = s; }
            __syncthreads();
        }
        for (int rep_ = 0; rep_ < REPS(6); ++rep_) if (IN(pb0 + 1)) { bf16_t* xn = WSP(bf16_t, WS_XN); bf16_t* WGU = WSP(bf16_t, WS_WGU); bf16_t* act = WSP(bf16_t, WS_ACT); const int* ltok = WSP(int, WS_LTOK); const int* cntl = CNTL();
            pg8::Gemm g{xn, WGU + (size_t)l * 32 * 1024 * 1024, 0, 0, 1024}; pg8::MoeOrder S; S.init(rb[32] / 256, G, bid, rb, LOCAL_OK()); pg8::EpiPair<true> E{act, DEXP}; pg8::AGather am{ltok, cntl, rb};
            pg8::gemm_phase<pg8::EpiPair<true>, pg8::MoeOrder, pg8::AGather, true, true>(lds, g, S, E, am, wave); }
        LSEAM(pb0 + 1);
        for (int rep_ = 0; rep_ < REPS(7); ++rep_) if (IN(pb0 + 2)) { bf16_t* act = WSP(bf16_t, WS_ACT); bf16_t* WDN = WSP(bf16_t, WS_WDN); bf16_t* yw = WSP(bf16_t, WS_YW); const float* lw = WSP(float, WS_LW);
            pg8::Gemm g{act, WDN + (size_t)l * 32 * 1024 * 512, 0, 0, 512}; pg8::MoeOrder S; S.init(rb[32] / 256, G, bid, rb, LOCAL_OK()); pg8::EpiDown E{yw, lw, rb};
            pg8::gemm_phase<pg8::EpiDown, pg8::MoeOrder, pg8::APlain, true, true>(lds, g, S, E, pg8::APlain{}, wave); }
        SEAM(pb0 + 2);
        for (int rep_ = 0; rep_ < REPS(8); ++rep_) if (IN(pb0 + 3)) { IDS(); const bool dry = rep_ + 1 < REPS(8);
            const float* gnext = (l == 0) ? KIN(2) + D : KIN(18);
            const float* modn = WSP(float, WS_MOD) + (size_t)16 * 6144; const float* modl = MODL();
            float* outf = KOUT(); bf16_t* xr = (bf16_t*)KOUT(); const bf16_t* yw = WSP(bf16_t, WS_YW); const int* tslot = WSP(int, WS_TSLOT); bf16_t* xn = WSP(bf16_t, WS_XN);
            for (int w0 = (bid * 8 + wave) * 32; w0 < T; w0 += G * 8 * 32) {
                const int b = w0 >> 12;
                f32x4 g2v[4];
#pragma unroll
                for (int j = 0; j < 4; ++j) g2v[j] = *(const f32x4*)(modl + (size_t)b * 6144 + 5120 + 4 * lane + 256 * j);
                ModV mv;
                if (l == 0) { const float* mb = modn + (size_t)b * 6144; mod_load(mv, gnext, mb + 0, mb + 1024, lane); }
                else {
#pragma unroll
                    for (int j = 0; j < 4; ++j) { mv.gp[j] = *(const f32x4*)(gnext + 4 * lane + 256 * j); mv.sh[j] = (f32x4){0.f, 0.f, 0.f, 0.f}; }
                }
                const int slw = tslot[(size_t)w0 * 2 + lane];
                u32x2 xb[4][4], ya[4][4], yb[4][4];
#define R2_LOAD(D_, I_) do { const int s0_ = __builtin_amdgcn_readlane(slw, 2 * (I_)), s1_ = __builtin_amdgcn_readlane(slw, 2 * (I_) + 1); \
                    const size_t r0_ = (size_t)(rb[s0_ >> 16] + (s0_ & 0xffff)), r1_ = (size_t)(rb[s1_ >> 16] + (s1_ & 0xffff)); \
                    _Pragma("unroll") for (int j = 0; j < 4; ++j) { xb[D_][j] = *(const u32x2*)(xr + (size_t)(w0 + (I_)) * XRP + 4 * lane + 256 * j); \
                        ya[D_][j] = ntload((const u32x2*)(yw + r0_ * D + 4 * lane + 256 * j)); yb[D_][j] = ntload((const u32x2*)(yw + r1_ * D + 4 * lane + 256 * j)); } } while (0)
#pragma unroll
                for (int d = 0; d < 4; ++d) R2_LOAD(d, d);
#pragma unroll 1
                for (int i4 = 0; i4 < 32; i4 += 4)
#pragma unroll
                for (int d = 0; d < 4; ++d) {
                    const int i = i4 + d, row = w0 + i;
                    RowV r;
#pragma unroll
                    for (int j = 0; j < 4; ++j) {
                        const u32x2 xw = xb[d][j], a = ya[d][j], c = yb[d][j];
                        f32x4 y; y.x = bflo(a.x) + bflo(c.x); y.y = bfhi(a.x) + bfhi(c.x); y.z = bflo(a.y) + bflo(c.y); y.w = bfhi(a.y) + bfhi(c.y);
                        r.v[j] = (f32x4){bflo(xw.x), bfhi(xw.x), bflo(xw.y), bfhi(xw.y)} + g2v[j] * y;
                    }
                    if (i4 < 28) R2_LOAD(d, i + 4);
                    const float rstd = row_rstd(r);
                    if (dry) { asm volatile("" :: "v"(rstd), "v"(r.v[0].x), "v"(r.v[1].y), "v"(r.v[2].z), "v"(r.v[3].w)); }
                    else if (l == 1) { row_apply(r, rstd, mv); row_store_f32(r, outf + (size_t)row * D, lane); }
                    else { row_store_bf16(r, xr + (size_t)row * XRP, lane); row_apply(r, rstd, mv); row_store_bf16(r, xn + (size_t)row * D, lane); }
                }
#undef R2_LOAD
            }
        }
        SEAM(pb0 + 3);
    }
#undef IDS
#undef MODL
#undef CNTL
#undef IN
#undef SEAM
#undef GRID_BAR
}

extern "C" void kernel_launch(void* const* d_in, const int* in_sizes, int n_in, void* d_out, int out_size, void* d_ws, size_t ws_size, hipStream_t stream) {
    static int grid = 0;
    if (grid == 0) {
        if (n_in != 19 || out_size != T * D || ws_size < WS_END) { fprintf(stderr, "kernel_launch: unexpected shapes (n_in %d out %d ws %zu)\n", n_in, out_size, ws_size); grid = -1; return; }
        int dev = 0, cus = 0;
        if (hipGetDevice(&dev) != hipSuccess || hipDeviceGetAttribute(&cus, hipDeviceAttributeMultiprocessorCount, dev) != hipSuccess) { grid = -1; return; }
        if (hipFuncSetAttribute((const void*)mk_fwd, hipFuncAttributeMaxDynamicSharedMemorySize, LDS_BYTES) != hipSuccess) { fprintf(stderr, "kernel_launch: hipFuncSetAttribute failed\n"); grid = -1; return; }
        int per_cu = 0;
        if (hipOccupancyMaxActiveBlocksPerMultiprocessor(&per_cu, (const void*)mk_fwd, NWAVES * 64, LDS_BYTES) != hipSuccess || per_cu < 1) fprintf(stderr, "kernel_launch: occupancy query says %d\n", per_cu);
        (void)hipGetLastError();
        grid = cus;
    }
    if (grid < 0) return;
    (void)hipMemsetAsync((char*)d_ws + WS_CTL, 0, CTL_BYTES, stream);
    Args a{};
    for (int i = 0; i < 19; ++i) a.in[i] = (const float*)d_in[i];
    a.out = (float*)d_out; a.ws = (unsigned char*)d_ws;
#if MK_ONE_LAUNCH
    a.ph_lo = 0; a.ph_hi = NPHASE;
    hipLaunchKernelGGL(mk_fwd, dim3(grid), dim3(NWAVES * 64), LDS_BYTES, stream, a);
#else
    for (int p = 0; p < NPHASE; ++p) { a.ph_lo = p; a.ph_hi = p + 1; hipLaunchKernelGGL(mk_fwd, dim3(grid), dim3(NWAVES * 64), LDS_BYTES, stream, a); }
#endif
}
```

```cpp
#include <hip/hip_runtime.h>
#include <stdint.h>
#include <math.h>
#include <cstdio>

#ifndef MK_ONE_LAUNCH
#define MK_ONE_LAUNCH 1
#endif

typedef unsigned short bf16_t;
typedef float f32x4 __attribute__((ext_vector_type(4)));
typedef unsigned u32x2 __attribute__((ext_vector_type(2)));
typedef unsigned u32x4 __attribute__((ext_vector_type(4)));
#define GAS __attribute__((address_space(1)))
#define LAS __attribute__((address_space(3)))
typedef GAS unsigned gu32;
#define RLX_AGENT __ATOMIC_RELAXED, __HIP_MEMORY_SCOPE_AGENT

constexpr int D = 1024, BATCH = 16, SEQ = 4096, T = BATCH * SEQ;
constexpr int NEXP = 32, DEXP = 512, EPG = 8, NGRP = 4;
constexpr int QKVW = 4608;
__host__ __device__ __forceinline__ size_t qkv_block(int typ, int g, int b, int h) { return (size_t)((((typ * 3 + g) * 16 + b) * 8 + h)) * (4096 * 64); }
__host__ __device__ __forceinline__ int qkv_row(int pos, int g) { const int dsh = 2 * g; return ((pos & ((1 << dsh) - 1)) << (12 - dsh)) + (pos >> dsh); }
constexpr int LISTCAP = 65536;
constexpr int PADROWS = 139264;
constexpr float EPS = 1e-6f;
constexpr float QSCALE = 0.125f * 1.4426950408889634f;
constexpr int NWAVES = 8;
constexpr int CONV_EARLY = 512 + 256 + 256 + 1152 + 128;
constexpr int XRP = 2048;

constexpr size_t MiB = 1u << 20;
constexpr size_t WS_CTL = 0;
constexpr size_t CTL_BYTES = 1 * MiB;
constexpr int CW_BAR = 4096;
constexpr size_t WS_MOD = 1 * MiB;
constexpr size_t WS_ROPE = 3 * MiB;
constexpr size_t WS_LTOK = 4 * MiB;
constexpr size_t WS_LW = 12 * MiB;
constexpr size_t WS_TSLOT = 20 * MiB;
constexpr size_t WS_LSE = 24 * MiB;
constexpr size_t WS_WZ = 32 * MiB;
constexpr size_t WS_WB = 36 * MiB;
constexpr size_t WS_WCO = 38 * MiB;
constexpr size_t WS_WAI = 40 * MiB;
constexpr size_t WS_WAO = 49 * MiB;
constexpr size_t WS_WGU = 64 * MiB;
constexpr size_t WS_WDN = 192 * MiB;
constexpr size_t WS_XN = 256 * MiB;
constexpr size_t WS_BIG = 384 * MiB;
constexpr size_t WS_Z = WS_BIG, WS_YPRE = WS_BIG + 128 * MiB;
constexpr size_t WS_ACT = WS_BIG, WS_YW = WS_BIG + 136 * MiB;
constexpr size_t WS_QKV = WS_BIG;
constexpr size_t WS_OB = WS_BIG + 576 * MiB;
constexpr size_t WS_END = WS_OB + 64 * MiB;

constexpr int RING_BYTES = 162816;
constexpr int MISC_OFF = RING_BYTES;
constexpr int LDS_BYTES = RING_BYTES + 1024;

__device__ __forceinline__ unsigned f2bf(float f) { unsigned u = __float_as_uint(f); return (u + 0x7fffu + ((u >> 16) & 1u)) >> 16; }
__device__ __forceinline__ unsigned pk2(float lo, float hi) { return f2bf(lo) | (f2bf(hi) << 16); }
__device__ __forceinline__ float bf2f(unsigned h) { return __uint_as_float(h << 16); }
__device__ __forceinline__ float bflo(unsigned w) { return __uint_as_float(w << 16); }
__device__ __forceinline__ float bfhi(unsigned w) { return __uint_as_float(w & 0xffff0000u); }
template <int M> __device__ __forceinline__ float xlane(float v) {
    return __int_as_float(__builtin_amdgcn_ds_swizzle(__float_as_int(v), (M << 10) | 0x1f));
}
__device__ __forceinline__ float xlane32(float v, bool hi) {
    auto rr = __builtin_amdgcn_permlane32_swap(__float_as_uint(v), __float_as_uint(v), false, false); return __uint_as_float(hi ? rr[0] : rr[1]);
}
__device__ __forceinline__ float wave_sum(float v) {
    v += xlane<1>(v); v += xlane<2>(v); v += xlane<4>(v); v += xlane<8>(v); v += xlane<16>(v);
    auto rr = __builtin_amdgcn_permlane32_swap(__float_as_uint(v), __float_as_uint(v), false, false);
    return __uint_as_float(rr[0]) + __uint_as_float(rr[1]);
}
__device__ __forceinline__ float silu_f(float x) { return x / (1.0f + __expf(-x)); }
#define LDS_WAIT() asm volatile("s_waitcnt lgkmcnt(0)" ::: "memory")
template <class V> __device__ __forceinline__ V ntload(const V* p) { return __builtin_nontemporal_load(p); }
__device__ __forceinline__ int lane_id() { int l; asm volatile("v_mbcnt_lo_u32_b32 %0, -1, 0\n\tv_mbcnt_hi_u32_b32 %0, -1, %0" : "=v"(l)); return l; }

namespace pg8 {
#define PG8_LAS __attribute__((address_space(3)))
typedef unsigned short bf16_t;
typedef short bf16x8 __attribute__((ext_vector_type(8)));
typedef float f32x4 __attribute__((ext_vector_type(4)));
typedef unsigned u32x4 __attribute__((ext_vector_type(4)));
constexpr int BM = 256, BK = 64, HALF = 128, HTB = HALF * BK * 2  , STAGE_BYTES = 8 * HTB, NXCD = 8, WGM = 4;

__host__ __device__ __forceinline__ int lds_byte(int r, int c) { const int st = (r >> 4) * 2 + (c >> 5), rr = r & 15, cc = c & 31, ob = rr * 64 + cc * 2; return st * 1024 + (ob ^ (((ob >> 9) & 1) << 5)); }
__host__ __device__ __forceinline__ void stage_rc(int b, int& R, int& C) { const int st = b / 1024, sb = b % 1024, swz = sb ^ (((sb >> 9) & 1) << 5); R = (st >> 1) * 16 + swz / 64; C = (st & 1) * 32 + (swz % 64) / 2; }
__host__ __device__ __forceinline__ int perm32(int rho) { const int n = rho >> 4, i = rho & 15; return 8 * (i >> 2) + 4 * n + (i & 3); }

struct Unit { int pm, pn, pb; };
struct Gemm { const bf16_t* A; const bf16_t* Bt; int M, N, K; };

struct StaticOrder {
    int nM, nN, nwg, G, c, wgm;
    __host__ __device__ void init(int M, int N, int G_, int c_, int wgm_ = WGM) { nM = M / BM; nN = N / BM; nwg = nM * nN; G = G_; c = c_; wgm = wgm_; }
    __host__ __device__ bool next(int i, Unit& u) const {
        const long L = (long)i * G + c; if (L >= nwg) return false;
        int wgid = (int)L; { const int q = nwg / NXCD, r = nwg % NXCD, xcd = wgid % NXCD, off = wgid / NXCD; wgid = (xcd < r ? xcd * (q + 1) : r * (q + 1) + (xcd - r) * q) + off; }
        const int nig = wgm * nN, gid = wgid / nig, fm = gid * wgm, gsz = (nM - fm) < wgm ? (nM - fm) : wgm;
        u.pm = fm + ((wgid % nig) % gsz); u.pn = (wgid % nig) / gsz; u.pb = u.pn; return true;
    }
    __device__ __forceinline__ void a_ready(const Unit&) const {}
    __device__ __forceinline__ void done(const Unit&) const {}
};


__device__ __forceinline__ unsigned cvt_pk_bf16(float lo, float hi) { unsigned r; asm volatile("v_cvt_pk_bf16_f32 %0, %1, %2" : "=v"(r) : "v"(lo), "v"(hi)); return r; }
typedef float f32x2 __attribute__((ext_vector_type(2)));

template <class Epi, class Sched, class AM, bool ALIGN_EPI = false, bool SP2 = false>
__device__ __forceinline__ void gemm_phase(PG8_LAS unsigned char* lds, const Gemm g, const Sched& S, const Epi& E, const AM& am, const int wid_in) {
    int wid = wid_in; asm volatile("" : "+s"(wid));
    const int lane = lane_id(), tid = wid * 64 + lane, wr = wid >> 2, wc = wid & 3, fr = lane & 15, fq = lane >> 4;
    const int K = g.K, nt = K / BK;
    unsigned voffA[2], voffB[2]; int stR[2], stC[2];
#pragma unroll
    for (int i = 0; i < 2; ++i) { int R, C; stage_rc(tid * 16 + i * 8192, R, C); const int Rb = Epi::PERM ? ((R & ~31) + perm32(R & 31)) : R;
        stR[i] = R; stC[i] = C; voffA[i] = (unsigned)(R * K + C) * 2u; voffB[i] = (unsigned)(Rb * K + C) * 2u; }
    const size_t kstep = (size_t)(BK * 2);
    const size_t hstep = (size_t)HALF * K * 2;
    const size_t tstep = 2 * hstep;
    const unsigned ldsw = (unsigned)wid * 1024u;
    const int aoff = lds_byte(wr * 64 + fr, fq * 8), boff = lds_byte(wc * 32 + fr, fq * 8);
#define PG8_SA(b, h) (((b) * 2 + (h)) * HTB)
#define PG8_SB(b, h) ((4 + (b) * 2 + (h)) * HTB)
#define PG8_STAGE(bufoff, gbase, voff) do { _Pragma("unroll") for (int _i = 0; _i < 2; ++_i) \
        __builtin_amdgcn_global_load_lds((const unsigned*)((const char*)(gbase) + (voff)[_i]), (PG8_LAS unsigned*)(lds + (bufoff) + ldsw + _i * 8192), 16, 0, 0); } while (0)
#define PG8_STAGE_A(b, h, gbase, NX) do { if constexpr (AM::GATHER) { const unsigned so_[2] = {(NX) ? gno[h][0] : gao[h][0], (NX) ? gno[h][1] : gao[h][1]}; PG8_STAGE(PG8_SA(b, h), gbase, so_); } \
        else { PG8_STAGE(PG8_SA(b, h), (gbase) + (h) * hstep, voffA); } } while (0)
#define PG8_LDA(dst, b, h) do { _Pragma("unroll") for (int m = 0; m < 4; ++m) _Pragma("unroll") for (int k = 0; k < 2; ++k) dst[m][k] = *(const PG8_LAS bf16x8*)(lds + PG8_SA(b, h) + aoff + m * 2048 + k * 1024); } while (0)
#define PG8_LDB(dst, b, h) do { _Pragma("unroll") for (int n = 0; n < 2; ++n) _Pragma("unroll") for (int k = 0; k < 2; ++k) dst[n][k] = *(const PG8_LAS bf16x8*)(lds + PG8_SB(b, h) + boff + n * 2048 + k * 1024); } while (0)
#define PG8_MMA(ai, bj, At, Bt) do { __builtin_amdgcn_s_setprio(1); _Pragma("unroll") for (int m = 0; m < 4; ++m) _Pragma("unroll") for (int n = 0; n < 2; ++n) _Pragma("unroll") for (int k = 0; k < 2; ++k) \
        acc[ai][bj][m][n] = __builtin_amdgcn_mfma_f32_16x16x32_bf16(Bt[n][k], At[m][k], acc[ai][bj][m][n], 0, 0, 0); __builtin_amdgcn_s_setprio(0); } while (0)
#define PG8_WAIT_V(n) asm volatile("s_waitcnt vmcnt(" #n ")" ::: "memory")
#define PG8_WAIT_L(n) asm volatile("s_waitcnt lgkmcnt(" #n ")" ::: "memory")
#define PG8_BAR __builtin_amdgcn_s_barrier()
#define PG8_SCHED __builtin_amdgcn_sched_barrier(0)
    Unit cur, nxt; int ui = 0;
    if (!S.next(0, cur)) return;
    f32x4 acc[2][2][4][2];
#pragma unroll
    for (int a = 0; a < 2; ++a)
#pragma unroll
        for (int b = 0; b < 2; ++b)
#pragma unroll
            for (int m = 0; m < 4; ++m)
#pragma unroll
                for (int n = 0; n < 2; ++n) acc[a][b][m][n] = (f32x4){0.f, 0.f, 0.f, 0.f};
    bf16x8 At[4][2], B0[2][2], B1[2][2];
    const char* cA = (const char*)g.A + (AM::GATHER ? (size_t)0 : (size_t)cur.pm * tstep); const char* cB = (const char*)g.Bt + (size_t)cur.pb * tstep;
    unsigned gao[2][2], gno[2][2];
    if constexpr (AM::GATHER) { _Pragma("unroll") for (int h = 0; h < 2; ++h) _Pragma("unroll") for (int i = 0; i < 2; ++i) { gao[h][i] = (unsigned)(am.arow(cur, h * HALF + stR[i]) * K + stC[i]) * 2u; gno[h][i] = gao[h][i]; } }
    else { _Pragma("unroll") for (int h = 0; h < 2; ++h) _Pragma("unroll") for (int i = 0; i < 2; ++i) { gao[h][i] = 0u; gno[h][i] = 0u; } }
    S.a_ready(cur);
    if constexpr (SP2) {
        PG8_STAGE(PG8_SB(0, 0), cB, voffB); PG8_STAGE(PG8_SB(0, 1), cB + hstep, voffB); PG8_STAGE_A(0, 0, cA, false); PG8_STAGE_A(0, 1, cA, false);
        if (wr == 1) PG8_BAR;
        PG8_WAIT_V(2); PG8_BAR;
        PG8_STAGE(PG8_SB(1, 0), cB + kstep, voffB); PG8_STAGE_A(1, 0, cA + kstep, false); PG8_STAGE(PG8_SB(1, 1), cB + hstep + kstep, voffB);
        PG8_WAIT_V(6); PG8_BAR;
    } else {
        PG8_STAGE(PG8_SB(0, 0), cB, voffB); PG8_STAGE_A(0, 0, cA, false); PG8_STAGE(PG8_SB(0, 1), cB + hstep, voffB); PG8_STAGE_A(0, 1, cA, false);
        if (wr == 1) PG8_BAR;
        PG8_WAIT_V(4); PG8_BAR;
        PG8_STAGE(PG8_SB(1, 0), cB + kstep, voffB); PG8_STAGE_A(1, 0, cA + kstep, false); PG8_STAGE(PG8_SB(1, 1), cB + hstep + kstep, voffB);
        PG8_WAIT_V(6); PG8_BAR;
    }
    for (;;) {
        const bool has_next = S.next(ui + 1, nxt);
        const char* nA = has_next ? (const char*)g.A + (AM::GATHER ? (size_t)0 : (size_t)nxt.pm * tstep) : cA; const char* nB = has_next ? (const char*)g.Bt + (size_t)nxt.pb * tstep : cB;
        if constexpr (AM::GATHER) { if (has_next) { _Pragma("unroll") for (int h = 0; h < 2; ++h) _Pragma("unroll") for (int i = 0; i < 2; ++i) gno[h][i] = (unsigned)(am.arow(nxt, h * HALF + stR[i]) * K + stC[i]) * 2u; } }
        for (int t = 0; t < nt; t += 2) {
            const bool last = (t == nt - 2);
            const char* a1 = cA + (size_t)(t + 1) * kstep;
            const char* a2 = last ? nA : cA + (size_t)(t + 2) * kstep; const char* b2 = last ? nB : cB + (size_t)(t + 2) * kstep;
            const char* a3 = a2 + kstep; const char* b3 = b2 + kstep;
            if (last && has_next) S.a_ready(nxt);
            if (false) E.prefetch(cur, tid, (PG8_LAS unsigned*)(lds + 162816 + 512));
            if constexpr (SP2) {
            PG8_LDB(B0, 0, 0); PG8_LDB(B1, 0, 1); PG8_SCHED; PG8_LDA(At, 0, 0); PG8_STAGE_A(1, 1, a1, false);
            PG8_WAIT_V(8); PG8_WAIT_L(0); PG8_BAR; PG8_MMA(0, 0, At, B0); PG8_MMA(0, 1, At, B1); PG8_BAR; PG8_SCHED;
            PG8_LDA(At, 0, 1); PG8_STAGE(PG8_SB(0, 0), b2, voffB); PG8_STAGE(PG8_SB(0, 1), b2 + hstep, voffB); PG8_STAGE_A(0, 0, a2, last);
            PG8_WAIT_V(8); PG8_WAIT_L(0); PG8_BAR; PG8_MMA(1, 0, At, B0); PG8_MMA(1, 1, At, B1); PG8_BAR; PG8_SCHED;
            PG8_LDB(B0, 1, 0); PG8_LDB(B1, 1, 1); PG8_SCHED; PG8_LDA(At, 1, 0); PG8_STAGE_A(0, 1, a2, last);
            PG8_WAIT_V(8); PG8_WAIT_L(0); PG8_BAR; PG8_MMA(0, 0, At, B0); PG8_MMA(0, 1, At, B1); PG8_BAR; PG8_SCHED;
            PG8_LDA(At, 1, 1); PG8_STAGE(PG8_SB(1, 0), b3, voffB); PG8_STAGE(PG8_SB(1, 1), b3 + hstep, voffB); PG8_STAGE_A(1, 0, a3, last);
            PG8_WAIT_V(8); PG8_WAIT_L(0); PG8_BAR; PG8_MMA(1, 0, At, B0); PG8_MMA(1, 1, At, B1); PG8_BAR; PG8_SCHED;
            } else {
            PG8_LDB(B0, 0, 0); PG8_SCHED; PG8_LDA(At, 0, 0); PG8_STAGE_A(1, 1, a1, false);
            PG8_WAIT_L(8); PG8_BAR; PG8_WAIT_L(0); PG8_MMA(0, 0, At, B0); PG8_BAR; PG8_SCHED;
            PG8_LDB(B1, 0, 1); PG8_STAGE(PG8_SB(0, 0), b2, voffB);
            PG8_BAR; PG8_WAIT_L(0); PG8_MMA(0, 1, At, B1); PG8_BAR;
            PG8_LDA(At, 0, 1); PG8_STAGE_A(0, 0, a2, last);
            PG8_BAR; PG8_WAIT_L(0); PG8_MMA(1, 0, At, B0); PG8_BAR; PG8_SCHED;
            PG8_STAGE(PG8_SB(0, 1), b2 + hstep, voffB);
            PG8_WAIT_V(6); PG8_BAR; PG8_MMA(1, 1, At, B1); PG8_BAR;
            PG8_LDB(B0, 1, 0); PG8_SCHED; PG8_LDA(At, 1, 0); PG8_STAGE_A(0, 1, a2, last);
            PG8_WAIT_L(8); PG8_BAR; PG8_WAIT_L(0); PG8_MMA(0, 0, At, B0); PG8_BAR; PG8_SCHED;
            PG8_LDB(B1, 1, 1); PG8_STAGE(PG8_SB(1, 0), b3, voffB);
            PG8_BAR; PG8_WAIT_L(0); PG8_MMA(0, 1, At, B1); PG8_BAR;
            PG8_LDA(At, 1, 1); PG8_STAGE_A(1, 0, a3, last);
            PG8_BAR; PG8_WAIT_L(0); PG8_MMA(1, 0, At, B0); PG8_BAR; PG8_SCHED;
            PG8_STAGE(PG8_SB(1, 1), b3 + hstep, voffB);
            PG8_WAIT_V(6); PG8_BAR; PG8_MMA(1, 1, At, B1); PG8_BAR;
            }
        }
        if constexpr (ALIGN_EPI) { if (wr == 0) PG8_BAR; }
        if constexpr (!Epi::AFTER_DRAIN) { E(acc, cur, wr, wc, fr, fq); S.done(cur); }
        if (!has_next) break;
#pragma unroll
        for (int a = 0; a < 2; ++a)
#pragma unroll
            for (int b = 0; b < 2; ++b)
#pragma unroll
                for (int m = 0; m < 4; ++m)
#pragma unroll
                    for (int n = 0; n < 2; ++n) acc[a][b][m][n] = (f32x4){0.f, 0.f, 0.f, 0.f};
        cur = nxt; cA = nA; cB = nB; ++ui;
        if constexpr (AM::GATHER) { _Pragma("unroll") for (int h = 0; h < 2; ++h) _Pragma("unroll") for (int i = 0; i < 2; ++i) gao[h][i] = gno[h][i]; }
        if constexpr (ALIGN_EPI) { if (wr == 1) PG8_BAR; }
    }
    PG8_WAIT_V(0);
    if constexpr (!ALIGN_EPI) { if (wr == 0) PG8_BAR; }
    PG8_BAR;
    if constexpr (Epi::AFTER_DRAIN) { E.fused(acc, cur, wr, wc, fr, fq, lds, wid, lane); S.done(cur); }
#undef PG8_SA
#undef PG8_SB
#undef PG8_STAGE
#undef PG8_STAGE_A
#undef PG8_LDA
#undef PG8_LDB
#undef PG8_MMA
#undef PG8_WAIT_V
#undef PG8_WAIT_L
#undef PG8_BAR
#undef PG8_SCHED
}

__device__ __forceinline__ u32x4 pack8(const f32x4 v0, const f32x4 v1) { u32x4 w; w.x = cvt_pk_bf16(v0[0], v0[1]); w.y = cvt_pk_bf16(v0[2], v0[3]); w.z = cvt_pk_bf16(v1[0], v1[1]); w.w = cvt_pk_bf16(v1[2], v1[3]); return w; }
__device__ __forceinline__ u32x4 xpose4x16(const u32x4 w, int sa) {
    u32x4 r; r.x = __builtin_amdgcn_ds_bpermute(sa, w.x); r.y = __builtin_amdgcn_ds_bpermute(sa, w.y); r.z = __builtin_amdgcn_ds_bpermute(sa, w.z); r.w = __builtin_amdgcn_ds_bpermute(sa, w.w); return r;
}
#define XPOSE_IDS() const int L_ = fr + 16 * fq, tr_ = L_ >> 2, tq_ = L_ & 3, sa_ = 4 * (tr_ + 16 * tq_)
__device__ __forceinline__ float silu1(float x) { return x * __builtin_amdgcn_rcpf(1.0f + __builtin_amdgcn_exp2f(-1.4426950408889634f * x)); }
template <bool SILU> struct EpiPair {
    static constexpr bool PERM = true, AFTER_DRAIN = false;
    bf16_t* O; int ldc;
    __device__ __forceinline__ void prefetch(const Unit&, int, PG8_LAS unsigned*) const {}
    __device__ __forceinline__ void operator()(const f32x4 (&acc)[2][2][4][2], const Unit& u, int wr, int wc, int fr, int fq) const {
        XPOSE_IDS();
        const int row0 = u.pm * BM + wr * 64 + tr_, ch0 = u.pn * HALF + wc * 32 + 8 * tq_;
#pragma unroll
        for (int ai = 0; ai < 2; ++ai)
#pragma unroll
            for (int m = 0; m < 4; ++m) {
                f32x4 a0 = acc[ai][0][m][0], a1 = acc[ai][0][m][1];
                if (SILU) {
#pragma unroll
                    for (int c = 0; c < 4; ++c) { a0[c] = silu1(a0[c]); a1[c] = silu1(a1[c]); }
                }
                *(u32x4*)(O + (size_t)(row0 + ai * HALF + m * 16) * ldc + ch0) = xpose4x16(pack8(a0 * acc[ai][1][m][0], a1 * acc[ai][1][m][1]), sa_);
            }
    }
};
struct EpiYpre {
    static constexpr bool PERM = true, AFTER_DRAIN = false;
    bf16_t* O; const bf16_t* Z; const float* cw;
    __device__ __forceinline__ void prefetch(const Unit& u, int tid, PG8_LAS unsigned* dummy) const {
#pragma unroll
        for (int i = 0; i < 2; ++i) { const int line = tid + 512 * i, row = line >> 2, seg = line & 3;
            __builtin_amdgcn_global_load_lds((const unsigned*)(Z + (size_t)(u.pm * BM + row) * D + u.pn * BM + seg * 64), dummy, 4, 0, 0); }
    }
    template <typename P> static __device__ __forceinline__ P sadd(P base, unsigned off) { asm volatile("" : "+v"(off)); return base + off; }
    template <int N> static __device__ __forceinline__ u32x4 ror(const u32x4 v) { u32x4 r;
        r.x = (unsigned)__builtin_amdgcn_update_dpp(0, (int)v.x, 0x120 + N, 0xf, 0xf, false); r.y = (unsigned)__builtin_amdgcn_update_dpp(0, (int)v.y, 0x120 + N, 0xf, 0xf, false);
        r.z = (unsigned)__builtin_amdgcn_update_dpp(0, (int)v.z, 0x120 + N, 0xf, 0xf, false); r.w = (unsigned)__builtin_amdgcn_update_dpp(0, (int)v.w, 0x120 + N, 0xf, 0xf, false); return r; }
    static __device__ __forceinline__ u32x4 sel(bool c, const u32x4 a, const u32x4 b) { u32x4 r; r.x = c ? a.x : b.x; r.y = c ? a.y : b.y; r.z = c ? a.z : b.z; r.w = c ? a.w : b.w; return r; }
    __device__ __forceinline__ void operator()(const f32x4 (&acc)[2][2][4][2], const Unit& u, int wr, int wc, int fr, int fq) const {
        XPOSE_IDS();
        const int row0 = u.pm * BM + wr * 64 + fr;
#pragma unroll
        for (int bj = 0; bj < 2; ++bj) {
            const int col0 = u.pn * BM + bj * HALF + wc * 32 + 8 * fq;
            f32x4 w0[2], w1[2], w2[2];
#pragma unroll
            for (int n = 0; n < 2; ++n) { w0[n] = *(const f32x4*)(cw + col0 + 4 * n); w1[n] = *(const f32x4*)(cw + D + col0 + 4 * n); w2[n] = *(const f32x4*)(cw + 2 * D + col0 + 4 * n); }
            u32x4 zc[2][4], zh[2];
#pragma unroll
            for (int ai = 0; ai < 2; ++ai) {
                zh[ai] = (u32x4){0u, 0u, 0u, 0u};
                if (fr >= 14 && row0 + ai * HALF >= 16) zh[ai] = *(const u32x4*)sadd((const char*)Z, (unsigned)((row0 + ai * HALF - 16) * D + col0) * 2u);
#pragma unroll
                for (int m = 0; m < 4; ++m) zc[ai][m] = *(const u32x4*)(sadd((const char*)Z, (unsigned)((row0 + ai * HALF) * D + col0) * 2u) + m * 16 * D * 2);
            }
            asm volatile("" ::: "memory");
#pragma unroll
            for (int ai = 0; ai < 2; ++ai)
#pragma unroll
                for (int m = 0; m < 4; ++m) {
                    const int row = row0 + ai * HALF + m * 16, t = row & (SEQ - 1);
                    const u32x4 cur = zc[ai][m], prv = (m == 0) ? zh[ai] : zc[ai][m - 1];
                    u32x4 z1 = sel(fr >= 1, ror<1>(cur), ror<1>(prv)), z2 = sel(fr >= 2, ror<2>(cur), ror<2>(prv));
                    if (t < 1) z1 = (u32x4){0u, 0u, 0u, 0u};
                    if (t < 2) z2 = (u32x4){0u, 0u, 0u, 0u};
                    const u32x4 z0 = cur;
                    f32x4 v[2];
#pragma unroll
                    for (int n = 0; n < 2; ++n) {
                        f32x4 a, b, c;
                        a[0] = __uint_as_float(z0[2 * n] << 16); a[1] = __uint_as_float(z0[2 * n] & 0xffff0000u); a[2] = __uint_as_float(z0[2 * n + 1] << 16); a[3] = __uint_as_float(z0[2 * n + 1] & 0xffff0000u);
                        b[0] = __uint_as_float(z1[2 * n] << 16); b[1] = __uint_as_float(z1[2 * n] & 0xffff0000u); b[2] = __uint_as_float(z1[2 * n + 1] << 16); b[3] = __uint_as_float(z1[2 * n + 1] & 0xffff0000u);
                        c[0] = __uint_as_float(z2[2 * n] << 16); c[1] = __uint_as_float(z2[2 * n] & 0xffff0000u); c[2] = __uint_as_float(z2[2 * n + 1] << 16); c[3] = __uint_as_float(z2[2 * n + 1] & 0xffff0000u);
                        v[n] = acc[ai][bj][m][n] * (w2[n] * a + w1[n] * b + w0[n] * c);
                    }
                    *(u32x4*)(sadd((char*)O, (unsigned)((row0 - fr + tr_ + ai * HALF) * D + col0 - 8 * fq + 8 * tq_) * 2u) + m * 16 * D * 2) = xpose4x16(pack8(v[0], v[1]), sa_);
                    __builtin_amdgcn_sched_barrier(0);
                }
            asm volatile("" ::: "memory");
        }
    }
};

template <bool RES_F32> struct EpiRes {
    static constexpr bool PERM = true, AFTER_DRAIN = false;
    bf16_t* xr; const float* xin; const float* modg;
    __device__ __forceinline__ void prefetch(const Unit&, int, PG8_LAS unsigned*) const {}
    __device__ __forceinline__ void operator()(const f32x4 (&acc)[2][2][4][2], const Unit& u, int wr, int wc, int fr, int fq) const {
        XPOSE_IDS();
        const int row0 = u.pm * BM + wr * 64 + fr, col0 = u.pn * BM + wc * 32 + 8 * fq;
        const float* gb = modg + (size_t)((u.pm * BM) >> 12) * 6144;
        f32x4 gv[2][2];
#pragma unroll
        for (int bj = 0; bj < 2; ++bj)
#pragma unroll
            for (int n = 0; n < 2; ++n) gv[bj][n] = *(const f32x4*)(gb + col0 + bj * HALF + n * 4);
        if constexpr (!RES_F32) {
            u32x4 rw[2][4][2];
#pragma unroll
            for (int ai = 0; ai < 2; ++ai)
#pragma unroll
                for (int m = 0; m < 4; ++m)
#pragma unroll
                    for (int bj = 0; bj < 2; ++bj) rw[ai][m][bj] = *(const u32x4*)(xr + (size_t)(row0 + ai * HALF + m * 16) * XRP + col0 + bj * HALF);
            asm volatile("" ::: "memory");
#pragma unroll
            for (int ai = 0; ai < 2; ++ai)
#pragma unroll
                for (int m = 0; m < 4; ++m) { const int row = row0 + ai * HALF + m * 16;
#pragma unroll
                    for (int bj = 0; bj < 2; ++bj) { const u32x4 w = rw[ai][m][bj];
                        const f32x4 r0 = {__uint_as_float(w.x << 16), __uint_as_float(w.x & 0xffff0000u), __uint_as_float(w.y << 16), __uint_as_float(w.y & 0xffff0000u)};
                        const f32x4 r1 = {__uint_as_float(w.z << 16), __uint_as_float(w.z & 0xffff0000u), __uint_as_float(w.w << 16), __uint_as_float(w.w & 0xffff0000u)};
                        *(u32x4*)(xr + (size_t)(row - fr + tr_) * XRP + col0 - 8 * fq + 8 * tq_ + bj * HALF) = xpose4x16(pack8(r0 + gv[bj][0] * acc[ai][bj][m][0], r1 + gv[bj][1] * acc[ai][bj][m][1]), sa_); } }
        } else {
#pragma unroll
        for (int ai = 0; ai < 2; ++ai) {
            f32x4 rv[4][2][2];
#pragma unroll
            for (int m = 0; m < 4; ++m) { const int row = row0 + ai * HALF + m * 16;
#pragma unroll
                for (int bj = 0; bj < 2; ++bj) { rv[m][bj][0] = ntload((const f32x4*)(xin + (size_t)row * D + col0 + bj * HALF)); rv[m][bj][1] = ntload((const f32x4*)(xin + (size_t)row * D + col0 + bj * HALF + 4)); } }
#pragma unroll
            for (int m = 0; m < 4; ++m) { const int row = row0 + ai * HALF + m * 16;
#pragma unroll
                for (int bj = 0; bj < 2; ++bj)
                    *(u32x4*)(xr + (size_t)(row - fr + tr_) * XRP + col0 - 8 * fq + 8 * tq_ + bj * HALF) = xpose4x16(pack8(rv[m][bj][0] + gv[bj][0] * acc[ai][bj][m][0], rv[m][bj][1] + gv[bj][1] * acc[ai][bj][m][1]), sa_); }
            asm volatile("" ::: "memory");
        }
        }
    }
};
struct EpiQKV {
    static constexpr bool PERM = true, AFTER_DRAIN = false;
    bf16_t* O; const float* rope; int row_off;
    __device__ __forceinline__ void prefetch(const Unit&, int, PG8_LAS unsigned*) const {}
    __device__ __forceinline__ void operator()(const f32x4 (&acc)[2][2][4][2], const Unit& u, int wr, int wc, int fr, int fq) const {
        XPOSE_IDS();
        const int row0 = u.pm * BM + wr * 64 + fr, col0 = u.pn * BM + wc * 32 + 8 * fq;
        const int typ = (u.pn % 6) >> 1, gq_ = u.pn / 6;
        const bool rl = (typ < 2) && ((wc & 1) == 0) && (fq < 2);
        const float sc = (typ == 0) ? QSCALE : 1.0f;
#pragma unroll
        for (int ai = 0; ai < 2; ++ai)
#pragma unroll
        for (int mp = 0; mp < 2; ++mp) {
            f32x4 csv[2], snv[2];
#pragma unroll
            for (int mm = 0; mm < 2; ++mm) { const int pos = (row0 + ai * HALF + (2 * mp + mm) * 16) & (SEQ - 1);
                csv[mm] = *(const f32x4*)(rope + pos * 8 + 4 * (fq & 1)); snv[mm] = *(const f32x4*)(rope + 4096 * 8 + pos * 8 + 4 * (fq & 1)); }
#pragma unroll
            for (int mm = 0; mm < 2; ++mm) {
                const int m = 2 * mp + mm, row = row0 + ai * HALF + m * 16;
                f32x4 cs = {1.f, 1.f, 1.f, 1.f}, sn = {0.f, 0.f, 0.f, 0.f};
                if (rl) { cs = csv[mm]; sn = snv[mm]; }
#pragma unroll
                for (int bj = 0; bj < 2; ++bj) {
                    const f32x4 x1 = acc[ai][bj][m][0], x2 = acc[ai][bj][m][1];
                    const f32x4 r1 = (x1 * cs - x2 * sn) * sc, r2 = (x2 * cs + x1 * sn) * sc;
                    { const int tok = row_off + row - fr + tr_, hh = 4 * (u.pn & 1) + 2 * bj + (wc >> 1);
                      *(u32x4*)(O + qkv_block(typ, gq_, tok >> 12, hh) + (size_t)qkv_row(tok & (SEQ - 1), gq_) * 64 + 32 * (wc & 1) + 8 * tq_) = xpose4x16(pack8(r1, r2), sa_); }
                }
            }
            asm volatile("" ::: "memory");
        }
    }
};
struct EpiDown {
    static constexpr bool PERM = true, AFTER_DRAIN = false;
    bf16_t* O; const float* lw; const PG8_LAS int* rb;
    __device__ __forceinline__ void prefetch(const Unit&, int, PG8_LAS unsigned*) const {}
    __device__ __forceinline__ void operator()(const f32x4 (&acc)[2][2][4][2], const Unit& u, int wr, int wc, int fr, int fq) const {
        XPOSE_IDS();
        const int row0 = u.pm * BM + wr * 64 + fr, col0 = u.pn * BM + wc * 32 + 8 * fq;
        const int e = u.pb >> 2; const float* wrow = lw + (size_t)e * LISTCAP - rb[e];
        float wv[2][4];
#pragma unroll
        for (int ai = 0; ai < 2; ++ai)
#pragma unroll
            for (int m = 0; m < 4; ++m) wv[ai][m] = wrow[row0 + ai * HALF + m * 16];
#pragma unroll
        for (int ai = 0; ai < 2; ++ai)
#pragma unroll
            for (int m = 0; m < 4; ++m) {
                const int row = row0 + ai * HALF + m * 16; const float w = wv[ai][m];
#pragma unroll
                for (int bj = 0; bj < 2; ++bj) *(u32x4*)(O + (size_t)(row - fr + tr_) * D + col0 - 8 * fq + 8 * tq_ + bj * HALF) = xpose4x16(pack8(acc[ai][bj][m][0] * w, acc[ai][bj][m][1] * w), sa_);
            }
    }
};
struct MoeOrder {
    int nM, nN, nwg, G, c; const PG8_LAS int* rb; bool aligned;
    __device__ void init(int nRT, int G_, int c_, const PG8_LAS int* rb_, bool aligned_ = false) { nM = nRT; nN = 4; nwg = nM * nN; G = G_; c = c_; rb = rb_; aligned = aligned_; }
    __device__ bool next(int i, Unit& u) const {
        const long L = (long)i * G + c; int wgid;
        if (aligned) {
            const int ng = (nM + WGM - 1) / WGM, gq = ng / NXCD, gr = ng % NXCD, xcd = (int)(L % NXCD); const long off = L / NXCD;
            const int g0 = xcd * gq + (xcd < gr ? xcd : gr), g1 = g0 + gq + (xcd < gr ? 1 : 0);
            const long w = (long)g0 * (WGM * 4) + off, wend = (long)g1 * (WGM * 4) < nwg ? (long)g1 * (WGM * 4) : nwg;
            if (w >= wend) return false;
            wgid = (int)w;
        } else {
            if (L >= nwg) return false;
            wgid = (int)L; { const int q = nwg / NXCD, r = nwg % NXCD, xcd = wgid % NXCD, off = wgid / NXCD; wgid = (xcd < r ? xcd * (q + 1) : r * (q + 1) + (xcd - r) * q) + off; }
        }
        const int nig = WGM * nN, gid = wgid / nig, fm = gid * WGM, gsz = (nM - fm) < WGM ? (nM - fm) : WGM;
        u.pm = fm + ((wgid % nig) % gsz); u.pn = (wgid % nig) / gsz;
        int e = 0; const int r0 = u.pm * BM;
#pragma unroll 1
        while (e < 31 && rb[e + 1] <= r0) ++e;
        u.pb = e * 4 + u.pn; return true;
    }
    __device__ __forceinline__ void a_ready(const Unit&) const {}
    __device__ __forceinline__ void done(const Unit&) const {}
};
struct APlain { static constexpr bool GATHER = false; __device__ __forceinline__ int arow(const Unit&, int) const { return 0; } };
struct AGather {
    static constexpr bool GATHER = true;
    const int* ltok; const int* cnt; const PG8_LAS int* rb;
    __device__ __forceinline__ int arow(const Unit& u, int r) const { const int e = u.pb >> 2, l = u.pm * BM - rb[e] + r; return (l < cnt[e]) ? ltok[(size_t)e * LISTCAP + l] : 0; }
};
}

#define XB_TMO      128
#define XB_XCNT(j)  (256  + 64 * (j))
#define XB_XSUB(j)  (1280 + 64 * (j))
#define XB_XGEN(j)  (2304 + 64 * (j))
#define XB_TOP      3328
#define XB_TOPGEN   3392
#define XCD_BAR_WORDS 3456
#define XB_SPIN_CAP (1u << 18)

__device__ __forceinline__ unsigned xb_ld(unsigned* p)              { return __hip_atomic_load(p, __ATOMIC_RELAXED, __HIP_MEMORY_SCOPE_AGENT); }
__device__ __forceinline__ unsigned xb_add(unsigned* p, unsigned v) { return __hip_atomic_fetch_add(p, v, __ATOMIC_RELAXED, __HIP_MEMORY_SCOPE_AGENT); }
__device__ __forceinline__ unsigned xb_xcc_id() { return (unsigned)__builtin_amdgcn_s_getreg((3 << 11) | 20) & 0xFu; }
#define XB_SPIN(cond, bar) do { unsigned _sp = 0; while (cond) { __builtin_amdgcn_s_sleep(1); \
    if ((++_sp & 255u) == 0u) { if (xb_ld(&(bar)[XB_TMO])) break; if (_sp > XB_SPIN_CAP) { atomicAdd(&(bar)[XB_TMO], 1u); break; } } } } while (0)

struct XcdBarrier {
    unsigned* bar; unsigned x;
    volatile LAS unsigned* st;
};

__device__ __forceinline__ XcdBarrier xcd_barrier_post(unsigned* bar, volatile LAS unsigned* st, int wave) {
    XcdBarrier b; b.bar = bar; b.x = xb_xcc_id(); b.st = st;
    if (wave == 0 && lane_id() == 0) (void)xb_add(&bar[XB_XCNT(b.x)], 1u);
    return b;
}
__device__ __forceinline__ void xcd_barrier_complete(unsigned* bar, unsigned x, unsigned& nloc, unsigned& nx) {
    const unsigned G = gridDim.x * gridDim.y * gridDim.z;
    unsigned sum, cnt, mine, sp = 0u;
    for (;;) {
        sum = 0u; cnt = 0u; mine = 0u;
#pragma unroll
        for (unsigned j = 0; j < 16; ++j) { const unsigned c = xb_ld(&bar[XB_XCNT(j)]); sum += c; cnt += (c > 0u) ? 1u : 0u; mine = (j == x) ? c : mine; }
        if (sum == G) break;
        __builtin_amdgcn_s_sleep(1);
        if ((++sp & 255u) == 0u) { if (xb_ld(&bar[XB_TMO])) break; if (sp > XB_SPIN_CAP) { atomicAdd(&bar[XB_TMO], 1u); break; } }
    }
    nloc = mine > 0u ? mine : 1u; nx = cnt > 0u ? cnt : 1u;
}

__device__ __forceinline__ void xcd_barrier(const XcdBarrier& b, int wave) {
    asm volatile("s_waitcnt vmcnt(0)" ::: "memory");
    __syncthreads();
    if (wave == 0 && lane_id() == 0) {
        unsigned* bar = b.bar;
        __builtin_amdgcn_s_waitcnt(0);
        unsigned nloc = b.st[0], nx = b.st[1];
        if (nloc == 0u) { xcd_barrier_complete(bar, b.x, nloc, nx); b.st[0] = nloc; b.st[1] = nx; }
        const unsigned old = xb_add(&bar[XB_XSUB(b.x)], 1u);
        const unsigned gen = old / nloc;
        if (old + 1u == (gen + 1u) * nloc) {
            __builtin_amdgcn_fence(__ATOMIC_RELEASE, "agent");
            asm volatile("s_waitcnt vmcnt(0)" ::: "memory");
            const unsigned og = xb_add(&bar[XB_TOP], 1u);
            const unsigned tg = og / nx;
            if (og + 1u == (tg + 1u) * nx) xb_add(&bar[XB_TOPGEN], 1u);
            else XB_SPIN(xb_ld(&bar[XB_TOPGEN]) == tg, bar);
            __builtin_amdgcn_fence(__ATOMIC_ACQUIRE, "agent");
            xb_add(&bar[XB_XGEN(b.x)], 1u);
            asm volatile("s_waitcnt vmcnt(0)" ::: "memory");
        } else {
            XB_SPIN(xb_ld(&bar[XB_XGEN(b.x)]) == gen, bar);
            __builtin_amdgcn_fence(__ATOMIC_ACQUIRE, "agent");
            asm volatile("s_waitcnt vmcnt(0)" ::: "memory");
        }
    }
    __syncthreads();
}

#define LG_SUB(g)  (3584 + 64 * (g))
#define LG_GEN(g)  (4160 + 64 * (g))
#define LG_MASK(g) (4736 + 64 * (g))
__device__ __forceinline__ void lg_barrier(const XcdBarrier& b, int wave, unsigned g, unsigned nloc, bool fast) {
    asm volatile("s_waitcnt vmcnt(0)" ::: "memory");
    __syncthreads();
    if (wave == 0 && lane_id() == 0) {
        unsigned* bar = b.bar;
        __builtin_amdgcn_s_waitcnt(0);
        if (!fast) { __builtin_amdgcn_fence(__ATOMIC_RELEASE, "agent"); asm volatile("s_waitcnt vmcnt(0)" ::: "memory"); }
        const unsigned old = xb_add(&bar[LG_SUB(g)], 1u), gen = old / nloc;
        if (old + 1u == (gen + 1u) * nloc) xb_add(&bar[LG_GEN(g)], 1u);
        else XB_SPIN(xb_ld(&bar[LG_GEN(g)]) == gen, bar);
        __builtin_amdgcn_fence(__ATOMIC_ACQUIRE, "agent");
        asm volatile("s_waitcnt vmcnt(0)" ::: "memory");
    }
    __syncthreads();
}

struct RowV { f32x4 v[4]; };
__device__ __forceinline__ void row_load(RowV& r, const float* row, int lane) {
#pragma unroll
    for (int j = 0; j < 4; ++j) r.v[j] = ntload((const f32x4*)(row + 4 * lane + 256 * j));
}
__device__ __forceinline__ void row_load_bf16(RowV& r, const bf16_t* row, int lane) {
#pragma unroll
    for (int j = 0; j < 4; ++j) { const u32x2 w = *(const u32x2*)(row + 4 * lane + 256 * j); r.v[j] = (f32x4){bflo(w.x), bfhi(w.x), bflo(w.y), bfhi(w.y)}; }
}
__device__ __forceinline__ float row_rstd(const RowV& r) {
    float s = 0.f;
#pragma unroll
    for (int j = 0; j < 4; ++j) s += (r.v[j].x * r.v[j].x + r.v[j].y * r.v[j].y) + (r.v[j].z * r.v[j].z + r.v[j].w * r.v[j].w);
    s = wave_sum(s);
    return __builtin_amdgcn_rsqf(s * (1.0f / 1024.0f) + EPS);
}
__device__ __forceinline__ void row_modulate(RowV& r, float rstd, const float* g, const float* sh, const float* sc, int lane) {
#pragma unroll
    for (int j = 0; j < 4; ++j) {
        const int o = 4 * lane + 256 * j;
        const f32x4 gg = *(const f32x4*)(g + o), s = *(const f32x4*)(sc + o), h = *(const f32x4*)(sh + o);
        r.v[j] = (r.v[j] * rstd * gg) * (s + 1.0f) + h;
    }
}
struct ModV { f32x4 gp[4], sh[4]; };
__device__ __forceinline__ void mod_load(ModV& m, const float* g, const float* sh, const float* sc, int lane) {
#pragma unroll
    for (int j = 0; j < 4; ++j) { const int o = 4 * lane + 256 * j; m.gp[j] = *(const f32x4*)(g + o) * (*(const f32x4*)(sc + o) + 1.0f); m.sh[j] = *(const f32x4*)(sh + o); }
}
__device__ __forceinline__ void row_apply(RowV& r, float rstd, const ModV& m) {
#pragma unroll
    for (int j = 0; j < 4; ++j) r.v[j] = (r.v[j] * rstd) * m.gp[j] + m.sh[j];
}
__device__ __forceinline__ void row_store_bf16(const RowV& r, bf16_t* out, int lane) {
#pragma unroll
    for (int j = 0; j < 4; ++j) { u32x2 w; w.x = pg8::cvt_pk_bf16(r.v[j].x, r.v[j].y); w.y = pg8::cvt_pk_bf16(r.v[j].z, r.v[j].w); *(u32x2*)(out + 4 * lane + 256 * j) = w; }
}
__device__ __forceinline__ void row_store_f32(const RowV& r, float* out, int lane) {
#pragma unroll
    for (int j = 0; j < 4; ++j) *(f32x4*)(out + 4 * lane + 256 * j) = r.v[j];
}

__device__ __forceinline__ int wmap(int code, int n) {
    if (code == 1) { const int isU = n >> 10, ch = n & 1023; return (ch >> 7) * 256 + isU * 128 + (ch & 127); }
    if (code == 2) { const int typ = (n % 1536) / 512, d = n & 63; return (typ < 2 && d >= 4 && d < 12) ? (d < 8 ? n + 4 : n - 4) : n; }
    if (code == 3) return (n >> 7) * 256 + (n & 127);
    if (code == 4) return (n >> 7) * 256 + 128 + (n & 127);
    return n;
}
struct ConvDesc { const float* src; bf16_t* dst; int ldw, K, code, nloc; };
__device__ __forceinline__ void conv_desc(ConvDesc& d, const float* W, int ldw, int ncol0, bf16_t* WT, int K, int code, int kb, int nb) {
    d.src = W + (size_t)(64 * kb) * ldw + ncol0 + 64 * nb; d.dst = WT + 64 * kb; d.ldw = ldw; d.K = K; d.code = code; d.nloc = 64 * nb;
}
__device__ __forceinline__ void conv_load(f32x4 (&v)[16], const ConvDesc& d, int lane) {
    const float* src = d.src + (size_t)(lane >> 4) * d.ldw + (lane & 15) * 4;
#pragma unroll
    for (int i = 0; i < 16; ++i) v[i] = ntload((const f32x4*)(src + (size_t)(4 * i) * d.ldw));
}
__device__ __forceinline__ void conv_process(const f32x4 (&v)[16], const ConvDesc& d, LAS float* scr, int lane) {
#pragma unroll
    for (int i = 0; i < 16; ++i) { LAS float* p = scr + (4 * i + (lane >> 4)) * 65 + (lane & 15) * 4; p[0] = v[i].x; p[1] = v[i].y; p[2] = v[i].z; p[3] = v[i].w; }
    LDS_WAIT();
    const int c = lane & 7;
#pragma unroll
    for (int j = 0; j < 8; ++j) { const int n = (lane >> 3) + 8 * j; const LAS float* sp = scr + (8 * c) * 65 + n;
        u32x4 o; o.x = pg8::cvt_pk_bf16(sp[0 * 65], sp[1 * 65]); o.y = pg8::cvt_pk_bf16(sp[2 * 65], sp[3 * 65]); o.z = pg8::cvt_pk_bf16(sp[4 * 65], sp[5 * 65]); o.w = pg8::cvt_pk_bf16(sp[6 * 65], sp[7 * 65]);
        *(u32x4*)(d.dst + (size_t)wmap(d.code, d.nloc + n) * d.K + 8 * c) = o; }
    LDS_WAIT();
}
constexpr int NCONV_ITEMS = 512 + 256 + 256 + 1152 + 128 + 64 * 384;

namespace att {
typedef short bf16x8 __attribute__((ext_vector_type(8)));
typedef short s16x4 __attribute__((ext_vector_type(4)));
typedef float f32x16 __attribute__((ext_vector_type(16)));
constexpr int NKEY = 384, KOFF = 0, KCH = NKEY * 16 + 16  , VOFF = 8 * KCH, VDH = (NKEY / 16) * 1024 + 64  , NUNITS = 16 * 3 * 16 * 8;
__device__ __forceinline__ int crow(int r, int hi) { return (r & 3) + 8 * (r >> 2) + 4 * hi; }
__device__ __forceinline__ s16x4 vtr(const LAS unsigned char* p) { return __builtin_bit_cast(s16x4, __builtin_amdgcn_ds_read_tr16_b64_v4i16((LAS s16x4*)p)); }
__device__ __forceinline__ float xhalf_max(float m) { auto rr = __builtin_amdgcn_permlane32_swap(__float_as_uint(m), __float_as_uint(m), false, false); return fmaxf(__uint_as_float(rr[0]), __uint_as_float(rr[1])); }
__device__ __forceinline__ float xhalf_sum(float m) { auto rr = __builtin_amdgcn_permlane32_swap(__float_as_uint(m), __float_as_uint(m), false, false); return __uint_as_float(rr[0]) + __uint_as_float(rr[1]); }

template <typename P> __device__ __forceinline__ P sadd(P base, unsigned off) { asm volatile("" : "+v"(off)); return base + off; }
struct AUnit { int h, g, b, dil, l0, r0; size_t tb; };
template <bool MERGE> __device__ __forceinline__ void adecode(AUnit& u, int idx) {
    const int sb = ((idx >> 4) & 7) * 2 + (idx & 1), bg = idx >> 7; u.b = MERGE ? bg : (bg >> 1);
    u.h = (idx >> 1) & 7; u.g = MERGE ? 2 : (bg & 1); const int dsh = 2 * u.g; u.dil = 1 << dsh;
    const int bps = 16 >> dsh, r = sb / bps; u.l0 = (sb - r * bps) * 256; u.r0 = r << (12 - dsh); u.tb = (size_t)u.b * SEQ + r;
}
__device__ __forceinline__ void aload_kv(u32x4 (&kv)[12], const AUnit& u, const bf16_t* qkv, int wave, int lane) {
    const char* kb = (const char*)(qkv + qkv_block(1, u.g, u.b, u.h) + (size_t)u.r0 * 64); const char* vb = kb + (qkv_block(2, 0, 0, 0) - qkv_block(1, 0, 0, 0)) * 2;
#pragma unroll
    for (int i = 0; i < 6; ++i) {
        int sp = u.l0 - 128 + 48 * wave + 8 * i + (lane >> 3); sp = sp < 0 ? 0 : sp;
        const unsigned ro = (unsigned)sp * 128u + (unsigned)(lane & 7) * 16u;
        kv[i] = *(const u32x4*)sadd(kb, ro); kv[6 + i] = *(const u32x4*)sadd(vb, ro);
    }
}
__device__ __forceinline__ void astore_kv(const u32x4 (&kv)[12], LAS unsigned char* lds, int wave, int lane) {
#pragma unroll
    for (int i = 0; i < 6; ++i) { const int key = 48 * wave + 8 * i + (lane >> 3);
        *(LAS u32x4*)(lds + KOFF + (lane & 7) * KCH + key * 16) = kv[i];
        *(LAS u32x4*)(lds + VOFF + ((lane & 7) >> 2) * VDH + (key >> 4) * 1024 + (key & 15) * 64 + (lane & 3) * 16) = kv[6 + i]; }
}
__device__ __forceinline__ char* aqrow(const AUnit& u, bf16_t* qkv, int wave) {
    return (char*)(qkv + qkv_block(0, u.g, u.b, u.h) + (size_t)(u.r0 + u.l0 + 32 * wave) * 64);
}

template <bool MERGE> __device__ __forceinline__ void attn_phase(LAS unsigned char* lds, bf16_t* qkv, float* lse, bf16_t* ob, int bid, int G, int wave, bool dry = false) {
    constexpr int NU = MERGE ? NUNITS / 3 : 2 * NUNITS / 3;
    const int per = (NU + G - 1) / G;
    const int u_lo = bid * per, u_hi = (u_lo + per < NU) ? u_lo + per : NU;
    asm volatile("" : "+s"(wave));
    const int lane = lane_id(), r32 = lane & 31, hi = lane >> 5;
    const int qt = wave;
    const unsigned qlo = (unsigned)r32 * 128u + (unsigned)hi * 16u;
    u32x4 kv[12]; bf16x8 qn[4];
    AUnit un;
    if (u_lo < u_hi) { adecode<MERGE>(un, u_lo); aload_kv(kv, un, qkv, wave, lane);
        { const char* q = aqrow(un, qkv, wave);
#pragma unroll
            for (int d0 = 0; d0 < 4; ++d0) qn[d0] = *(const bf16x8*)(sadd(q, qlo) + d0 * 32); } }
#pragma unroll 1
    for (int idx = u_lo; idx < u_hi; ++idx) {
        const AUnit u = un;
        const int g = u.g, l0 = u.l0, head = u.h;
        char* qrow = aqrow(u, qkv, wave);
        const size_t tqw = u.tb + (size_t)(l0 + 32 * qt) * u.dil;
        bf16x8 qf[4];
        astore_kv(kv, lds, wave, lane);
#pragma unroll
        for (int d0 = 0; d0 < 4; ++d0) qf[d0] = qn[d0];
        __syncthreads();
        if (idx + 1 < u_hi) { adecode<MERGE>(un, idx + 1); aload_kv(kv, un, qkv, wave, lane);
            { const char* q = aqrow(un, qkv, wave);
#pragma unroll
                for (int d0 = 0; d0 < 4; ++d0) qn[d0] = *(const bf16x8*)(sadd(q, qlo) + d0 * 32); } }
        u32x2 og[MERGE ? 2 : 1][2][4]; float lg0 = 0.f, lg1 = 0.f;
        if constexpr (MERGE) {
            const int pq = (int)(tqw & (SEQ - 1)) + r32 * u.dil; const char* oq0 = (const char*)(qkv + qkv_block(0, 0, u.b, head)); const char* oq1 = (const char*)(qkv + qkv_block(0, 1, u.b, head));
            const unsigned oo0 = (unsigned)qkv_row(pq, 0) * 128u + 8u * hi, oo1 = (unsigned)qkv_row(pq, 1) * 128u + 8u * hi;
#pragma unroll
            for (int gg = 0; gg < 2; ++gg)
#pragma unroll
                for (int d0 = 0; d0 < 2; ++d0)
#pragma unroll
                    for (int rg = 0; rg < 4; ++rg) og[gg][d0][rg] = *(const u32x2*)(sadd(gg ? oq1 : oq0, gg ? oo1 : oo0) + (d0 * 64 + 16 * rg));
            const char* lb = (const char*)(lse + tqw * 24 + head); const unsigned lo_ = (unsigned)(r32 * u.dil) * 96u;
            lg0 = *(const float*)sadd(lb, lo_); lg1 = *(const float*)(sadd(lb, lo_) + 32);
        }
        f32x16 p[5];
        const LAS unsigned char* kb = lds + KOFF + hi * KCH + (qt * 32 + r32) * 16;
#pragma unroll
        for (int j = 0; j < 5; ++j) {
#pragma unroll
            for (int rr = 0; rr < 16; ++rr) p[j][rr] = 0.f;
#pragma unroll
            for (int d0 = 0; d0 < 4; ++d0) {
                const bf16x8 kf = *(const LAS bf16x8*)(kb + j * 512 + d0 * 2 * KCH);
                p[j] = __builtin_amdgcn_mfma_f32_32x32x16_bf16(kf, qf[d0], p[j], 0, 0, 0);
            }
        }
#pragma unroll
        for (int rr = 0; rr < 16; ++rr) { const int c = crow(rr, hi); if (c < r32) p[0][rr] = -INFINITY; if (c > r32) p[4][rr] = -INFINITY; }
        if (l0 == 0) {
#pragma unroll
            for (int j = 0; j < 5; ++j)
#pragma unroll
                for (int rr = 0; rr < 16; ++rr) if (32 * (qt + j) + crow(rr, hi) < 128) p[j][rr] = -INFINITY;
        }
        float m = p[0][0];
#pragma unroll
        for (int j = 0; j < 5; ++j)
#pragma unroll
            for (int rr = 0; rr < 16; ++rr) m = fmaxf(m, p[j][rr]);
        m = xhalf_max(m);
        float l = 0.f;
#pragma unroll
        for (int j = 0; j < 5; ++j)
#pragma unroll
            for (int rr = 0; rr < 16; ++rr) { const float e = __builtin_amdgcn_exp2f(p[j][rr] - m); p[j][rr] = e; l += e; }
        l = xhalf_sum(l);
        f32x16 o[2];
#pragma unroll
        for (int rr = 0; rr < 16; ++rr) { o[0][rr] = 0.f; o[1][rr] = 0.f; }
        const LAS unsigned char* vb = lds + VOFF + ((lane >> 4) & 1) * 32 + (lane & 3) * 8 + (4 * hi + ((lane & 15) >> 2)) * 64 + qt * 2048;
#pragma unroll
        for (int j = 0; j < 5; ++j)
#pragma unroll
            for (int s = 0; s < 2; ++s) {
                u32x4 pw; pw.x = pg8::cvt_pk_bf16(p[j][8 * s + 0], p[j][8 * s + 1]); pw.y = pg8::cvt_pk_bf16(p[j][8 * s + 2], p[j][8 * s + 3]);
                pw.z = pg8::cvt_pk_bf16(p[j][8 * s + 4], p[j][8 * s + 5]); pw.w = pg8::cvt_pk_bf16(p[j][8 * s + 6], p[j][8 * s + 7]);
                const bf16x8 pf = __builtin_bit_cast(bf16x8, pw);
#pragma unroll
                for (int d0 = 0; d0 < 2; ++d0) {
                    const s16x4 vlo = vtr(vb + d0 * VDH + (2 * j + s) * 1024), vhi = vtr(vb + d0 * VDH + (2 * j + s) * 1024 + 512);
                    const bf16x8 vf = {vlo[0], vlo[1], vlo[2], vlo[3], vhi[0], vhi[1], vhi[2], vhi[3]};
                    o[d0] = __builtin_amdgcn_mfma_f32_32x32x16_bf16(vf, pf, o[d0], 0, 0, 0);
                }
            }
        if constexpr (!MERGE) {
            const float inv = 1.0f / l;
#pragma unroll
            for (int d0 = 0; d0 < 2; ++d0)
#pragma unroll
                for (int rg = 0; rg < 4; ++rg) {
                    u32x2 w; w.x = pg8::cvt_pk_bf16(o[d0][4 * rg] * inv, o[d0][4 * rg + 1] * inv); w.y = pg8::cvt_pk_bf16(o[d0][4 * rg + 2] * inv, o[d0][4 * rg + 3] * inv);
                    if (!dry) *(u32x2*)(sadd(qrow, (unsigned)r32 * 128u + 8u * hi) + (d0 * 64 + 16 * rg)) = w; else asm volatile("" :: "v"(w.x), "v"(w.y));
                }
            if (hi == 0 && !dry) *(float*)((char*)(lse + tqw * 24 + g * 8 + head) + (unsigned)(r32 * u.dil) * 96u) = m + __builtin_amdgcn_logf(l);
        } else {
            const float lg2 = m + __builtin_amdgcn_logf(l), mx = fmaxf(lg2, fmaxf(lg0, lg1));
            const float w0 = __builtin_amdgcn_exp2f(lg0 - mx), w1 = __builtin_amdgcn_exp2f(lg1 - mx), w2 = __builtin_amdgcn_exp2f(lg2 - mx);
            const float iw = 1.0f / (w0 + w1 + w2), c0 = w0 * iw, c1 = w1 * iw, c2 = w2 * iw / l;
            char* orow = (char*)(ob + tqw * 512 + head * 64); const unsigned oro = (unsigned)(r32 * u.dil) * 1024u + 8u * hi;
#pragma unroll
            for (int d0 = 0; d0 < 2; ++d0)
#pragma unroll
                for (int rg = 0; rg < 4; ++rg) {
                    const u32x2 a = og[0][d0][rg], b = og[1][d0][rg];
                    u32x2 w; w.x = pg8::cvt_pk_bf16(c0 * bflo(a.x) + c1 * bflo(b.x) + c2 * o[d0][4 * rg], c0 * bfhi(a.x) + c1 * bfhi(b.x) + c2 * o[d0][4 * rg + 1]);
                    w.y = pg8::cvt_pk_bf16(c0 * bflo(a.y) + c1 * bflo(b.y) + c2 * o[d0][4 * rg + 2], c0 * bfhi(a.y) + c1 * bfhi(b.y) + c2 * o[d0][4 * rg + 3]);
                    if (!dry) *(u32x2*)(sadd(orow, oro) + (d0 * 64 + 16 * rg)) = w; else asm volatile("" :: "v"(w.x), "v"(w.y));
                }
        }
        __syncthreads();
    }
}
}

typedef const __attribute__((address_space(4))) unsigned long long* kargp_t;
__device__ __forceinline__ kargp_t karg() { kargp_t p = (kargp_t)__builtin_amdgcn_kernarg_segment_ptr(); asm volatile("" : "+s"(p)); return p; }
#define KIN(i) ((const float*)(GAS const float*)karg()[i])
#define KOUT() ((float*)(GAS float*)karg()[19])
#define KWS() ((unsigned char*)(GAS unsigned char*)karg()[20])
#define WSP(type, off) ((type*)(KWS() + (off)))
struct Args { const float* in[19]; float* out; unsigned char* ws; int ph_lo, ph_hi; };
constexpr int NPHASE = 17;

__global__ void __launch_bounds__(NWAVES * 64, 2) mk_fwd(Args args) {
    extern __shared__ __attribute__((aligned(16))) unsigned char lds_raw[];
    LAS unsigned char* lds = (LAS unsigned char*)lds_raw;
    volatile LAS unsigned* MISC = (volatile LAS unsigned*)(lds + MISC_OFF);
    LAS int* rb = (LAS int*)(lds + MISC_OFF);
    const int wave = __builtin_amdgcn_readfirstlane((int)threadIdx.x >> 6);
#define IDS() const int lane = lane_id(), tid = wave * 64 + lane; (void)tid; (void)lane
    const int G = gridDim.x, bid = blockIdx.x;
    for (int u = threadIdx.x; u < (LDS_BYTES - MISC_OFF) / 4; u += NWAVES * 64) MISC[u] = 0u;
    __syncthreads();
#if MK_ONE_LAUNCH
    XcdBarrier bar = xcd_barrier_post((unsigned*)(KWS() + WS_CTL) + CW_BAR, MISC + 40, wave);
    if (threadIdx.x == 0) atomicOr(&bar.bar[LG_MASK(bid & 7)], 1u << bar.x);
#define GRID_BAR() xcd_barrier(bar, wave)
#define LOCAL_OK() (G == 256)
#define CBID() (LOCAL_OK() ? ((bid & 7) * 32 + (bid >> 3)) : bid)
#define LOCAL_BAR() do { if (LOCAL_OK()) lg_barrier(bar, wave, (unsigned)(bid & 7), 32u, MISC[42] != 0u); else GRID_BAR(); } while (0)
#else
#define GRID_BAR() do { } while (0)
#define LOCAL_OK() false
#define CBID() bid
#define LOCAL_BAR() do { } while (0)
#endif
#if MK_ONE_LAUNCH
    constexpr int lo = 0, hi = NPHASE; (void)args;
#else
    const int lo = args.ph_lo, hi = args.ph_hi;
#endif
#ifndef PHMASK
#define PHMASK 0xFFFFFFFFu
#endif
#define IN(k) ((((PHMASK) >> (k)) & 1u) && lo <= (k) && (k) < hi)
#ifndef REPMASK
#define REPMASK 0u
#endif
#define REPS(k) ((((REPMASK) >> (k)) & 1u) ? 2 : 1)
#define SEAM(k) do { if (IN(k) && IN((k) + 1)) GRID_BAR(); } while (0)
#define LSEAM(k) do { if (IN(k) && IN((k) + 1)) LOCAL_BAR(); } while (0)

    for (int rep_ = 0; rep_ < REPS(0); ++rep_) if (IN(0)) { IDS();
        const float* cin = KIN(1); const float* ada_w = KIN(4); const float* ada_b = KIN(5); float* mod = WSP(float, WS_MOD); float* rope = WSP(float, WS_ROPE);
        LAS float* cact = (LAS float*)lds; LAS float* red = cact + 16384;
        if (bid < 192) for (int i = tid; i < 16 * 1024; i += 512) { const float v = cin[i]; cact[i] = v / (1.f + expf(-v)); }
        __syncthreads();
        for (int item = bid; item < 192; item += G) {
            const int l = item / 96, n0 = (item % 96) * 64, kk = lane >> 4, n4 = lane & 15;
            f32x4 acc[16];
#pragma unroll
            for (int b = 0; b < 16; ++b) acc[b] = (f32x4){0.f, 0.f, 0.f, 0.f};
            const float* w = ada_w + (size_t)l * 1024 * 6144 + n0 + n4 * 4;
#pragma unroll 1
            for (int kb = 0; kb < 2; ++kb) {
                const int k0 = wave * 128 + kb * 64 + kk;
                f32x4 wv[16];
#pragma unroll
                for (int u = 0; u < 16; ++u) wv[u] = *(const f32x4*)(w + (size_t)(k0 + 4 * u) * 6144);
#pragma unroll
                for (int u = 0; u < 16; ++u)
#pragma unroll
                    for (int b = 0; b < 16; ++b) acc[b] += wv[u] * cact[b * 1024 + k0 + 4 * u];
            }
            const bool h5 = (lane & 32) != 0;
#pragma unroll
            for (int b = 0; b < 16; ++b)
#pragma unroll
                for (int c = 0; c < 4; ++c) { float v = acc[b][c]; v += xlane<16>(v); v += xlane32(v, h5); acc[b][c] = v; }
            if (lane < 16) {
#pragma unroll
                for (int b = 0; b < 16; ++b) *(LAS f32x4*)(red + (wave * 16 + b) * 64 + n4 * 4) = acc[b];
            }
            __syncthreads();
            for (int i = tid; i < 1024; i += 512) {
                const int b = i >> 6, nn = i & 63; float s = 0.f;
#pragma unroll
                for (int q = 0; q < 8; ++q) s += red[(q * 16 + b) * 64 + nn];
                mod[((size_t)l * 16 + b) * 6144 + n0 + nn] = s + ada_b[l * 6144 + n0 + nn];
            }
            __syncthreads();
        }
        for (int i = bid * 512 + tid; i < 4096 * 8; i += G * 512) {
            const int t = i >> 3, f = i & 7;
            const float inv = powf(500000.0f, -(float)(2 * f) / 16.0f);
            const float ang = (float)t * inv;
            rope[i] = (float)cos((double)ang);
            rope[4096 * 8 + i] = (float)sin((double)ang);
        }
        __syncthreads();
        {
        LAS float* scr = (LAS float*)(lds + wave * 16640);
        const float* conv_in_w = KIN(6); const float* conv_out_w = KIN(8); const float* attn_in_w = KIN(9); const float* attn_out_w = KIN(10);
        const float* gate_w = KIN(15); const float* up_w = KIN(16); const float* down_w = KIN(17);
        bf16_t* WZ = WSP(bf16_t, WS_WZ); bf16_t* WB = WSP(bf16_t, WS_WB); bf16_t* WCO = WSP(bf16_t, WS_WCO); bf16_t* WAI = WSP(bf16_t, WS_WAI); bf16_t* WAO = WSP(bf16_t, WS_WAO);
        bf16_t* WGU = WSP(bf16_t, WS_WGU); bf16_t* WDN = WSP(bf16_t, WS_WDN);
#define CONV_DECODE(DD, IT) do { int it = (IT); \
            if (it < 512) { conv_desc(DD, conv_in_w, 3072, 1024, WZ, 1024, 1, it / 32, it % 32); break; } it -= 512; \
            if (it < 256) { conv_desc(DD, conv_in_w, 3072, 0, WB, 1024, 0, it / 16, it % 16); break; } it -= 256; \
            if (it < 256) { conv_desc(DD, conv_out_w, 1024, 0, WCO, 1024, 0, it / 16, it % 16); break; } it -= 256; \
            if (it < 1152) { conv_desc(DD, attn_in_w, QKVW, 0, WAI, 1024, 2, it / 72, it % 72); break; } it -= 1152; \
            if (it < 128) { conv_desc(DD, attn_out_w, 1024, 0, WAO, 512, 0, it / 16, it % 16); break; } it -= 128; \
            const int le = it / 384, r = it % 384; \
            if (r < 128) conv_desc(DD, gate_w + (size_t)le * D * DEXP, DEXP, 0, WGU + (size_t)le * 1024 * 1024, 1024, 3, r / 8, r % 8); \
            else if (r < 256) conv_desc(DD, up_w + (size_t)le * D * DEXP, DEXP, 0, WGU + (size_t)le * 1024 * 1024, 1024, 4, (r - 128) / 8, (r - 128) % 8); \
            else conv_desc(DD, down_w + (size_t)le * DEXP * D, D, 0, WDN + (size_t)le * 1024 * 512, 512, 0, (r - 256) / 16, (r - 256) % 16); } while (0)
        {
            const int step = G * NWAVES; int it0 = bid * NWAVES + wave;
            ConvDesc dA, dB; f32x4 vA[16], vB[16];
            if (it0 < CONV_EARLY) { CONV_DECODE(dA, it0); conv_load(vA, dA, lane); }
#pragma unroll 1
            for (; it0 < CONV_EARLY; it0 += 2 * step) {
                const bool hasB = it0 + step < CONV_EARLY, hasA2 = it0 + 2 * step < CONV_EARLY;
                if (hasB) { CONV_DECODE(dB, it0 + step); conv_load(vB, dB, lane); }
                conv_process(vA, dA, scr, lane);
                if (hasA2) { CONV_DECODE(dA, it0 + 2 * step); conv_load(vA, dA, lane); }
                if (hasB) conv_process(vB, dB, scr, lane);
            }
        }
#undef CONV_DECODE
        }
    }
    SEAM(0);
    if (threadIdx.x == 0) { const unsigned m_ = xb_ld(&bar.bar[LG_MASK(bid & 7)]); MISC[42] = ((m_ & (m_ - 1u)) == 0u) ? 1u : 0u; }
    __syncthreads();
    for (int rep_ = 0; rep_ < REPS(1); ++rep_) if (IN(1)) { IDS();
        {
        LAS float* scr = (LAS float*)(lds + wave * 16640);
        const float* conv_in_w = KIN(6); const float* conv_out_w = KIN(8); const float* attn_in_w = KIN(9); const float* attn_out_w = KIN(10);
        const float* gate_w = KIN(15); const float* up_w = KIN(16); const float* down_w = KIN(17);
        bf16_t* WZ = WSP(bf16_t, WS_WZ); bf16_t* WB = WSP(bf16_t, WS_WB); bf16_t* WCO = WSP(bf16_t, WS_WCO); bf16_t* WAI = WSP(bf16_t, WS_WAI); bf16_t* WAO = WSP(bf16_t, WS_WAO);
        bf16_t* WGU = WSP(bf16_t, WS_WGU); bf16_t* WDN = WSP(bf16_t, WS_WDN);
#define CONV_DECODE(DD, IT) do { int it = (IT); \
            if (it < 512) { conv_desc(DD, conv_in_w, 3072, 1024, WZ, 1024, 1, it / 32, it % 32); break; } it -= 512; \
            if (it < 256) { conv_desc(DD, conv_in_w, 3072, 0, WB, 1024, 0, it / 16, it % 16); break; } it -= 256; \
            if (it < 256) { conv_desc(DD, conv_out_w, 1024, 0, WCO, 1024, 0, it / 16, it % 16); break; } it -= 256; \
            if (it < 1152) { conv_desc(DD, attn_in_w, QKVW, 0, WAI, 1024, 2, it / 72, it % 72); break; } it -= 1152; \
            if (it < 128) { conv_desc(DD, attn_out_w, 1024, 0, WAO, 512, 0, it / 16, it % 16); break; } it -= 128; \
            const int le = it / 384, r = it % 384; \
            if (r < 128) conv_desc(DD, gate_w + (size_t)le * D * DEXP, DEXP, 0, WGU + (size_t)le * 1024 * 1024, 1024, 3, r / 8, r % 8); \
            else if (r < 256) conv_desc(DD, up_w + (size_t)le * D * DEXP, DEXP, 0, WGU + (size_t)le * 1024 * 1024, 1024, 4, (r - 128) / 8, (r - 128) % 8); \
            else conv_desc(DD, down_w + (size_t)le * DEXP * D, D, 0, WDN + (size_t)le * 1024 * 512, 512, 0, (r - 256) / 16, (r - 256) % 16); } while (0)
        {
            const int step = G * NWAVES; int it0 = CONV_EARLY + bid * NWAVES + wave;
            ConvDesc dA, dB; f32x4 vA[16], vB[16];
            if (it0 < NCONV_ITEMS) { CONV_DECODE(dA, it0); conv_load(vA, dA, lane); }
#pragma unroll 1
            for (; it0 < NCONV_ITEMS; it0 += 2 * step) {
                const bool hasB = it0 + step < NCONV_ITEMS, hasA2 = it0 + 2 * step < NCONV_ITEMS;
                if (hasB) { CONV_DECODE(dB, it0 + step); conv_load(vB, dB, lane); }
                conv_process(vA, dA, scr, lane);
                if (hasA2) { CONV_DECODE(dA, it0 + 2 * step); conv_load(vA, dA, lane); }
                if (hasB) conv_process(vB, dB, scr, lane);
            }
        }
#undef CONV_DECODE
        }
        const float* x = KIN(0); const float* norm_mix_g = KIN(2); const float* mod = WSP(float, WS_MOD); bf16_t* xn = WSP(bf16_t, WS_XN);
        for (int w0 = (CBID() * 8 + wave) * 32; w0 < T; w0 += G * 8 * 32) {
            const float* mb = mod + (size_t)(w0 >> 12) * 6144;
            ModV mv; mod_load(mv, norm_mix_g, mb + 0, mb + 1024, lane);
            RowV ring[4];
#pragma unroll
            for (int d = 0; d < 4; ++d) row_load(ring[d], x + (size_t)(w0 + d) * D, lane);
#pragma unroll 1
            for (int i = 0; i < 32; i += 4) {
#pragma unroll
                for (int d = 0; d < 4; ++d) {
                    const int row = w0 + i + d;
                    RowV r = ring[d];
                    if (i < 28) row_load(ring[d], x + (size_t)(row + 4) * D, lane);
                    const float rstd = row_rstd(r);
                    row_apply(r, rstd, mv);
                    row_store_bf16(r, xn + (size_t)row * D, lane);
                }
            }
        }
    }
    LSEAM(1);
    for (int rep_ = 0; rep_ < REPS(2); ++rep_) if (IN(2)) { bf16_t* xn = WSP(bf16_t, WS_XN); bf16_t* WZ = WSP(bf16_t, WS_WZ); bf16_t* zb = WSP(bf16_t, WS_Z);
        pg8::Gemm g{xn, WZ, T, 2048, 1024}; pg8::StaticOrder S; S.init(T, 2048, G, bid); pg8::EpiPair<false> E{zb, D};
        pg8::gemm_phase<pg8::EpiPair<false>, pg8::StaticOrder, pg8::APlain, true, true>(lds, g, S, E, pg8::APlain{}, wave); }
    LSEAM(2);
    for (int rep_ = 0; rep_ < REPS(3); ++rep_) if (IN(3)) { bf16_t* xn = WSP(bf16_t, WS_XN); bf16_t* WB = WSP(bf16_t, WS_WB); bf16_t* zb = WSP(bf16_t, WS_Z); bf16_t* ypre = WSP(bf16_t, WS_YPRE); const float* conv_w = KIN(7);
        pg8::Gemm g{xn, WB, T, 1024, 1024}; pg8::StaticOrder S; S.init(T, 1024, G, bid); pg8::EpiYpre E{ypre, zb, conv_w};
        pg8::gemm_phase<pg8::EpiYpre, pg8::StaticOrder, pg8::APlain, true, true>(lds, g, S, E, pg8::APlain{}, wave); }
    LSEAM(3);
    for (int rep_ = 0; rep_ < REPS(4); ++rep_) if (IN(4)) { bf16_t* ypre = WSP(bf16_t, WS_YPRE); bf16_t* WCO = WSP(bf16_t, WS_WCO); bf16_t* xr = (bf16_t*)KOUT(); const float* x = KIN(0); const float* mod = WSP(float, WS_MOD);
        pg8::Gemm g{ypre, WCO, T, 1024, 1024}; pg8::StaticOrder S; S.init(T, 1024, G, bid); pg8::EpiRes<true> E{xr, x, mod + 2048};
        pg8::gemm_phase<pg8::EpiRes<true>, pg8::StaticOrder, pg8::APlain, true, true>(lds, g, S, E, pg8::APlain{}, wave); }
    LSEAM(4);
    { constexpr int l = 0;
        const int pb0 = (l == 0) ? 5 : 13;
#define MODL() (WSP(float, WS_MOD) + (size_t)l * 16 * 6144)
#define CNTL() (WSP(int, WS_CTL) + 64 * l)
        if (l == 1) {
#ifdef STAGGER9
            if (IN(9)) { const unsigned long long t0_ = __builtin_amdgcn_s_memrealtime(); const unsigned long long dl_ = (unsigned long long)(((bid >> 3) & 31) * STAGGER9 / 32);
                while (__builtin_amdgcn_s_memrealtime() - t0_ < dl_) __builtin_amdgcn_s_sleep(16); }
#endif
            for (int rep_ = 0; rep_ < REPS(9); ++rep_) if (IN(9)) { bf16_t* xn = WSP(bf16_t, WS_XN); bf16_t* WAI = WSP(bf16_t, WS_WAI); bf16_t* qkv = WSP(bf16_t, WS_QKV); const float* rope = WSP(float, WS_ROPE);
                pg8::Gemm g{xn, WAI, T, QKVW, 1024}; pg8::StaticOrder S; S.init(T, QKVW, G, bid, 8); pg8::EpiQKV E{qkv, rope, 0};
                pg8::gemm_phase<pg8::EpiQKV, pg8::StaticOrder, pg8::APlain, true, true>(lds, g, S, E, pg8::APlain{}, wave); }
            LSEAM(9);
            if (IN(10)) att::attn_phase<false>(lds, WSP(bf16_t, WS_QKV), WSP(float, WS_LSE), WSP(bf16_t, WS_OB), CBID(), G, wave);
            LSEAM(10);
            if (IN(11)) att::attn_phase<true>(lds, WSP(bf16_t, WS_QKV), WSP(float, WS_LSE), WSP(bf16_t, WS_OB), CBID(), G, wave);
            LSEAM(11);
            if (IN(12)) { bf16_t* ob = WSP(bf16_t, WS_OB); bf16_t* WAO = WSP(bf16_t, WS_WAO); bf16_t* xr = (bf16_t*)KOUT();
                pg8::Gemm g{ob, WAO, T, 1024, 512}; pg8::StaticOrder S; S.init(T, 1024, G, bid); pg8::EpiRes<false> E{xr, nullptr, MODL() + 2048};
                pg8::gemm_phase<pg8::EpiRes<false>, pg8::StaticOrder, pg8::APlain, true, true>(lds, g, S, E, pg8::APlain{}, wave); }
            LSEAM(12);
        }
        for (int rep_ = 0; rep_ < REPS(5); ++rep_) if (IN(pb0)) { IDS(); const bool dry = rep_ + 1 < REPS(5);
            LAS f32x4* TG = (LAS f32x4*)lds; LAS f32x4* TE = (LAS f32x4*)(lds + 16384);
            LAS int* rec_e = (LAS int*)(lds + 147456); LAS float* rec_w = (LAS float*)(lds + 147456 + 2048); LAS int* rec_rank = (LAS int*)(lds + 147456 + 4096);
            LAS int* hist = (LAS int*)(lds + 147456 + 6144); LAS int* base = (LAS int*)(lds + 147456 + 6144 + 128);
            const float* gff = KIN(3) + l * D; const float* wg = KIN(11) + (size_t)l * D * 4; const float* bg = KIN(12) + l * 4; const float* we = KIN(13) + (size_t)l * 4 * D * 8; const float* be = KIN(14) + l * 32;
            const bf16_t* xr = (const bf16_t*)KOUT(); const float* modl = MODL(); int* cntl = CNTL(); bf16_t* xn = WSP(bf16_t, WS_XN); int* ltok = WSP(int, WS_LTOK); float* lw = WSP(float, WS_LW); int* tslot = WSP(int, WS_TSLOT);
            for (int i = tid; i < 1024; i += 512) { const int ln = i & 63, jc = i >> 6, k = 4 * ln + 256 * (jc >> 2) + (jc & 3); TG[i] = *(const f32x4*)(wg + (size_t)k * 4); }
            for (int i = tid; i < 8192; i += 512) { const int ln = i & 63, jc = (i >> 6) & 15, half = (i >> 10) & 1, gi = i >> 11, k = 4 * ln + 256 * (jc >> 2) + (jc & 3);
                TE[i] = *(const f32x4*)(we + ((size_t)gi * 1024 + k) * 8 + half * 4); }
            __syncthreads();
            const bool h5 = (lane & 32) != 0, h4 = (lane & 16) != 0, h3 = (lane & 8) != 0;
            for (int blk = CBID(); blk < T / 256; blk += G) {
                if (tid < 32) hist[tid] = 0;
                __syncthreads();
                ModV mv; { const float* mb = modl + (size_t)((blk * 256) >> 12) * 6144; mod_load(mv, gff, mb + 3072, mb + 4096, lane); }
                u32x2 ring[4][4];
#pragma unroll
                for (int d = 0; d < 4; ++d)
#pragma unroll
                    for (int j = 0; j < 4; ++j) ring[d][j] = *(const u32x2*)(xr + (size_t)(blk * 256 + wave * 32 + d) * XRP + 4 * lane + 256 * j);
#pragma unroll 1
                for (int i4 = 0; i4 < 32; i4 += 4)
#pragma unroll
                for (int d = 0; d < 4; ++d) {
                    const int i = i4 + d, rl = wave * 32 + i, row = blk * 256 + rl;
                    RowV r;
#pragma unroll
                    for (int j = 0; j < 4; ++j) { const u32x2 w = ring[d][j]; r.v[j] = (f32x4){bflo(w.x), bfhi(w.x), bflo(w.y), bfhi(w.y)}; }
                    if (i4 < 28) {
#pragma unroll
                        for (int j = 0; j < 4; ++j) ring[d][j] = *(const u32x2*)(xr + (size_t)(row + 4) * XRP + 4 * lane + 256 * j); }
                    const float rstd = row_rstd(r);
                    row_apply(r, rstd, mv);
                    row_store_bf16(r, xn + (size_t)row * D, lane);
                    f32x4 pg = {0.f, 0.f, 0.f, 0.f};
#pragma unroll
                    for (int jc = 0; jc < 16; ++jc) pg += TG[jc * 64 + lane] * r.v[jc >> 2][jc & 3];
                    float gl[4];
                    { float b0 = (h5 ? pg.z : pg.x) + xlane32(h5 ? pg.x : pg.z, h5), b1 = (h5 ? pg.w : pg.y) + xlane32(h5 ? pg.y : pg.w, h5);
                      float c = (h4 ? b1 : b0) + xlane<16>(h4 ? b0 : b1);
                      c += xlane<8>(c); c += xlane<4>(c); c += xlane<2>(c); c += xlane<1>(c);
#pragma unroll
                      for (int o = 0; o < 4; ++o) gl[o] = __int_as_float(__builtin_amdgcn_readlane(__float_as_int(c), 16 * o)) + bg[o]; }
                    int gi = 0; float gm = gl[0];
#pragma unroll
                    for (int o = 1; o < 4; ++o) if (gl[o] > gm) { gm = gl[o]; gi = o; }
                    float gden = 0.f;
#pragma unroll
                    for (int o = 0; o < 4; ++o) gden += __builtin_amdgcn_exp2f((gl[o] - gm) * 1.4426950408889634f);
                    const float grp_p = __builtin_amdgcn_rcpf(gden);
                    f32x4 pa = {0.f, 0.f, 0.f, 0.f}, pb = {0.f, 0.f, 0.f, 0.f};
                    const LAS f32x4* te = TE + gi * 2048 + lane;
#pragma unroll
                    for (int jc = 0; jc < 16; ++jc) { const float hv = r.v[jc >> 2][jc & 3]; pa += te[jc * 64] * hv; pb += te[1024 + jc * 64] * hv; }
                    float el[8];
                    { const f32x4 keep = h5 ? pb : pa, send = h5 ? pa : pb;
                      f32x4 q; q.x = keep.x + xlane32(send.x, h5); q.y = keep.y + xlane32(send.y, h5); q.z = keep.z + xlane32(send.z, h5); q.w = keep.w + xlane32(send.w, h5);
                      const float b0 = (h4 ? q.z : q.x) + xlane<16>(h4 ? q.x : q.z), b1 = (h4 ? q.w : q.y) + xlane<16>(h4 ? q.y : q.w);
                      float c = (h3 ? b1 : b0) + xlane<8>(h3 ? b0 : b1);
                      c += xlane<4>(c); c += xlane<2>(c); c += xlane<1>(c);
#pragma unroll
                      for (int o = 0; o < 8; ++o) el[o] = __int_as_float(__builtin_amdgcn_readlane(__float_as_int(c), 8 * o)) + be[gi * 8 + o]; }
                    int i0 = 0; float m0 = el[0];
#pragma unroll
                    for (int o = 1; o < 8; ++o) if (el[o] > m0) { m0 = el[o]; i0 = o; }
                    int i1 = -1; float m1 = -INFINITY;
#pragma unroll
                    for (int o = 0; o < 8; ++o) if (o != i0 && el[o] > m1) { m1 = el[o]; i1 = o; }
                    const float p1 = __builtin_amdgcn_exp2f((m1 - m0) * 1.4426950408889634f), w0_ = grp_p * __builtin_amdgcn_rcpf(1.0f + p1);
                    if (lane == 0) { rec_e[rl * 2] = gi * 8 + i0; rec_e[rl * 2 + 1] = gi * 8 + i1; rec_w[rl * 2] = w0_; rec_w[rl * 2 + 1] = w0_ * p1; }
                }
                __syncthreads();
                { const int e = rec_e[tid]; rec_rank[tid] = atomicAdd((int*)&hist[e], 1); }
                __syncthreads();
                if (tid < 32) { const int h = hist[tid]; base[tid] = (h && !dry) ? atomicAdd(&cntl[tid], h) : 0; }
                __syncthreads();
                { const int e = rec_e[tid], pos = base[e] + rec_rank[tid], tok = blk * 256 + (tid >> 1);
                  if (!dry) { ltok[(size_t)e * LISTCAP + pos] = tok; lw[(size_t)e * LISTCAP + pos] = rec_w[tid]; tslot[tok * 2 + (tid & 1)] = (e << 16) | pos; } }
                __syncthreads();
            }
        }
        SEAM(pb0);
        if (IN(pb0 + 1) || IN(pb0 + 2) || IN(pb0 + 3)) {
            __syncthreads();
            if (wave == 0 && lane_id() == 0) { const int* cntl = CNTL(); int s = 0;
#pragma unroll 1
                for (int e = 0; e < 32; ++e) { rb[e] = s; s += (__hip_atomic_load(&cntl[e], RLX_AGENT) + 255) & ~255; }
                rb[32] = s; }
            __syncthreads();
        }
        for (int rep_ = 0; rep_ < REPS(6); ++rep_) if (IN(pb0 + 1)) { bf16_t* xn = WSP(bf16_t, WS_XN); bf16_t* WGU = WSP(bf16_t, WS_WGU); bf16_t* act = WSP(bf16_t, WS_ACT); const int* ltok = WSP(int, WS_LTOK); const int* cntl = CNTL();
            pg8::Gemm g{xn, WGU + (size_t)l * 32 * 1024 * 1024, 0, 0, 1024}; pg8::MoeOrder S; S.init(rb[32] / 256, G, bid, rb, LOCAL_OK()); pg8::EpiPair<true> E{act, DEXP}; pg8::AGather am{ltok, cntl, rb};
            pg8::gemm_phase<pg8::EpiPair<true>, pg8::MoeOrder, pg8::AGather, true, true>(lds, g, S, E, am, wave); }
        LSEAM(pb0 + 1);
        for (int rep_ = 0; rep_ < REPS(7); ++rep_) if (IN(pb0 + 2)) { bf16_t* act = WSP(bf16_t, WS_ACT); bf16_t* WDN = WSP(bf16_t, WS_WDN); bf16_t* yw = WSP(bf16_t, WS_YW); const float* lw = WSP(float, WS_LW);
            pg8::Gemm g{act, WDN + (size_t)l * 32 * 1024 * 512, 0, 0, 512}; pg8::MoeOrder S; S.init(rb[32] / 256, G, bid, rb, LOCAL_OK()); pg8::EpiDown E{yw, lw, rb};
            pg8::gemm_phase<pg8::EpiDown, pg8::MoeOrder, pg8::APlain, true, true>(lds, g, S, E, pg8::APlain{}, wave); }
        SEAM(pb0 + 2);
        for (int rep_ = 0; rep_ < REPS(8); ++rep_) if (IN(pb0 + 3)) { IDS(); const bool dry = rep_ + 1 < REPS(8);
            const float* gnext = (l == 0) ? KIN(2) + D : KIN(18);
            const float* modn = WSP(float, WS_MOD) + (size_t)16 * 6144; const float* modl = MODL();
            float* outf = KOUT(); bf16_t* xr = (bf16_t*)KOUT(); const bf16_t* yw = WSP(bf16_t, WS_YW); const int* tslot = WSP(int, WS_TSLOT); bf16_t* xn = WSP(bf16_t, WS_XN);
            for (int w0 = (bid * 8 + wave) * 32; w0 < T; w0 += G * 8 * 32) {
                const int b = w0 >> 12;
                f32x4 g2v[4];
#pragma unroll
                for (int j = 0; j < 4; ++j) g2v[j] = *(const f32x4*)(modl + (size_t)b * 6144 + 5120 + 4 * lane + 256 * j);
                ModV mv;
                if (l == 0) { const float* mb = modn + (size_t)b * 6144; mod_load(mv, gnext, mb + 0, mb + 1024, lane); }
                else {
#pragma unroll
                    for (int j = 0; j < 4; ++j) { mv.gp[j] = *(const f32x4*)(gnext + 4 * lane + 256 * j); mv.sh[j] = (f32x4){0.f, 0.f, 0.f, 0.f}; }
                }
                const int slw = tslot[(size_t)w0 * 2 + lane];
                u32x2 xb[4][4], ya[4][4], yb[4][4];
#define R2_LOAD(D_, I_) do { const int s0_ = __builtin_amdgcn_readlane(slw, 2 * (I_)), s1_ = __builtin_amdgcn_readlane(slw, 2 * (I_) + 1); \
                    const size_t r0_ = (size_t)(rb[s0_ >> 16] + (s0_ & 0xffff)), r1_ = (size_t)(rb[s1_ >> 16] + (s1_ & 0xffff)); \
                    _Pragma("unroll") for (int j = 0; j < 4; ++j) { xb[D_][j] = *(const u32x2*)(xr + (size_t)(w0 + (I_)) * XRP + 4 * lane + 256 * j); \
                        ya[D_][j] = ntload((const u32x2*)(yw + r0_ * D + 4 * lane + 256 * j)); yb[D_][j] = ntload((const u32x2*)(yw + r1_ * D + 4 * lane + 256 * j)); } } while (0)
#pragma unroll
                for (int d = 0; d < 4; ++d) R2_LOAD(d, d);
#pragma unroll 1
                for (int i4 = 0; i4 < 32; i4 += 4)
#pragma unroll
                for (int d = 0; d < 4; ++d) {
                    const int i = i4 + d, row = w0 + i;
                    RowV r;
#pragma unroll
                    for (int j = 0; j < 4; ++j) {
                        const u32x2 xw = xb[d][j], a = ya[d][j], c = yb[d][j];
                        f32x4 y; y.x = bflo(a.x) + bflo(c.x); y.y = bfhi(a.x) + bfhi(c.x); y.z = bflo(a.y) + bflo(c.y); y.w = bfhi(a.y) + bfhi(c.y);
                        r.v[j] = (f32x4){bflo(xw.x), bfhi(xw.x), bflo(xw.y), bfhi(xw.y)} + g2v[j] * y;
                    }
                    if (i4 < 28) R2_LOAD(d, i + 4);
                    const float rstd = row_rstd(r);
                    if (dry) { asm volatile("" :: "v"(rstd), "v"(r.v[0].x), "v"(r.v[1].y), "v"(r.v[2].z), "v"(r.v[3].w)); }
                    else if (l == 1) { row_apply(r, rstd, mv); row_store_f32(r, outf + (size_t)row * D, lane); }
                    else { row_store_bf16(r, xr + (size_t)row * XRP, lane); row_apply(r, rstd, mv); row_store_bf16(r, xn + (size_t)row * D, lane); }
                }
#undef R2_LOAD
            }
        }
        SEAM(pb0 + 3);
    }
    { constexpr int l = 1;
        const int pb0 = (l == 0) ? 5 : 13;
#define MODL() (WSP(float, WS_MOD) + (size_t)l * 16 * 6144)
#define CNTL() (WSP(int, WS_CTL) + 64 * l)
        if (l == 1) {
#ifdef STAGGER9
            if (IN(9)) { const unsigned long long t0_ = __builtin_amdgcn_s_memrealtime(); const unsigned long long dl_ = (unsigned long long)(((bid >> 3) & 31) * STAGGER9 / 32);
                while (__builtin_amdgcn_s_memrealtime() - t0_ < dl_) __builtin_amdgcn_s_sleep(16); }
#endif
            for (int rep_ = 0; rep_ < REPS(9); ++rep_) if (IN(9)) { bf16_t* xn = WSP(bf16_t, WS_XN); bf16_t* WAI = WSP(bf16_t, WS_WAI); bf16_t* qkv = WSP(bf16_t, WS_QKV); const float* rope = WSP(float, WS_ROPE);
                pg8::Gemm g{xn, WAI, T, QKVW, 1024}; pg8::StaticOrder S; S.init(T, QKVW, G, bid, 8); pg8::EpiQKV E{qkv, rope, 0};
                pg8::gemm_phase<pg8::EpiQKV, pg8::StaticOrder, pg8::APlain, true, true>(lds, g, S, E, pg8::APlain{}, wave); }
            LSEAM(9);
            if (IN(10)) att::attn_phase<false>(lds, WSP(bf16_t, WS_QKV), WSP(float, WS_LSE), WSP(bf16_t, WS_OB), CBID(), G, wave);
            LSEAM(10);
            if (IN(11)) att::attn_phase<true>(lds, WSP(bf16_t, WS_QKV), WSP(float, WS_LSE), WSP(bf16_t, WS_OB), CBID(), G, wave);
            LSEAM(11);
            if (IN(12)) { bf16_t* ob = WSP(bf16_t, WS_OB); bf16_t* WAO = WSP(bf16_t, WS_WAO); bf16_t* xr = (bf16_t*)KOUT();
                pg8::Gemm g{ob, WAO, T, 1024, 512}; pg8::StaticOrder S; S.init(T, 1024, G, bid); pg8::EpiRes<false> E{xr, nullptr, MODL() + 2048};
                pg8::gemm_phase<pg8::EpiRes<false>, pg8::StaticOrder, pg8::APlain, true, true>(lds, g, S, E, pg8::APlain{}, wave); }
            LSEAM(12);
        }
        for (int rep_ = 0; rep_ < REPS(5); ++rep_) if (IN(pb0)) { IDS(); const bool dry = rep_ + 1 < REPS(5);
            LAS f32x4* TG = (LAS f32x4*)lds; LAS f32x4* TE = (LAS f32x4*)(lds + 16384);
            LAS int* rec_e = (LAS int*)(lds + 147456); LAS float* rec_w = (LAS float*)(lds + 147456 + 2048); LAS int* rec_rank = (LAS int*)(lds + 147456 + 4096);
            LAS int* hist = (LAS int*)(lds + 147456 + 6144); LAS int* base = (LAS int*)(lds + 147456 + 6144 + 128);
            const float* gff = KIN(3) + l * D; const float* wg = KIN(11) + (size_t)l * D * 4; const float* bg = KIN(12) + l * 4; const float* we = KIN(13) + (size_t)l * 4 * D * 8; const float* be = KIN(14) + l * 32;
            const bf16_t* xr = (const bf16_t*)KOUT(); const float* modl = MODL(); int* cntl = CNTL(); bf16_t* xn = WSP(bf16_t, WS_XN); int* ltok = WSP(int, WS_LTOK); float* lw = WSP(float, WS_LW); int* tslot = WSP(int, WS_TSLOT);
            for (int i = tid; i < 1024; i += 512) { const int ln = i & 63, jc = i >> 6, k = 4 * ln + 256 * (jc >> 2) + (jc & 3); TG[i] = *(const f32x4*)(wg + (size_t)k * 4); }
            for (int i = tid; i < 8192; i += 512) { const int ln = i & 63, jc = (i >> 6) & 15, half = (i >> 10) & 1, gi = i >> 11, k = 4 * ln + 256 * (jc >> 2) + (jc & 3);
                TE[i] = *(const f32x4*)(we + ((size_t)gi * 1024 + k) * 8 + half * 4); }
            __syncthreads();
            const bool h5 = (lane & 32) != 0, h4 = (lane & 16) != 0, h3 = (lane & 8) != 0;
            for (int blk = CBID(); blk < T / 256; blk += G) {
                if (tid < 32) hist[tid] = 0;
                __syncthreads();
                ModV mv; { const float* mb = modl + (size_t)((blk * 256) >> 12) * 6144; mod_load(mv, gff, mb + 3072, mb + 4096, lane); }
                u32x2 ring[4][4];
#pragma unroll
                for (int d = 0; d < 4; ++d)
#pragma unroll
                    for (int j = 0; j < 4; ++j) ring[d][j] = *(const u32x2*)(xr + (size_t)(blk * 256 + wave * 32 + d) * XRP + 4 * lane + 256 * j);
#pragma unroll 1
                for (int i4 = 0; i4 < 32; i4 += 4)
#pragma unroll
                for (int d = 0; d < 4; ++d) {
                    const int i = i4 + d, rl = wave * 32 + i, row = blk * 256 + rl;
                    RowV r;
#pragma unroll
                    for (int j = 0; j < 4; ++j) { const u32x2 w = ring[d][j]; r.v[j] = (f32x4){bflo(w.x), bfhi(w.x), bflo(w.y), bfhi(w.y)}; }
                    if (i4 < 28) {
#pragma unroll
                        for (int j = 0; j < 4; ++j) ring[d][j] = *(const u32x2*)(xr + (size_t)(row + 4) * XRP + 4 * lane + 256 * j); }
                    const float rstd = row_rstd(r);
                    row_apply(r, rstd, mv);
                    row_store_bf16(r, xn + (size_t)row * D, lane);
                    f32x4 pg = {0.f, 0.f, 0.f, 0.f};
#pragma unroll
                    for (int jc = 0; jc < 16; ++jc) pg += TG[jc * 64 + lane] * r.v[jc >> 2][jc & 3];
                    float gl[4];
                    { float b0 = (h5 ? pg.z : pg.x) + xlane32(h5 ? pg.x : pg.z, h5), b1 = (h5 ? pg.w : pg.y) + xlane32(h5 ? pg.y : pg.w, h5);
                      float c = (h4 ? b1 : b0) + xlane<16>(h4 ? b0 : b1);
                      c += xlane<8>(c); c += xlane<4>(c); c += xlane<2>(c); c += xlane<1>(c);
#pragma unroll
                      for (int o = 0; o < 4; ++o) gl[o] = __int_as_float(__builtin_amdgcn_readlane(__float_as_int(c), 16 * o)) + bg[o]; }
                    int gi = 0; float gm = gl[0];
#pragma unroll
                    for (int o = 1; o < 4; ++o) if (gl[o] > gm) { gm = gl[o]; gi = o; }
                    float gden = 0.f;
#pragma unroll
                    for (int o = 0; o < 4; ++o) gden += __builtin_amdgcn_exp2f((gl[o] - gm) * 1.4426950408889634f);
                    const float grp_p = __builtin_amdgcn_rcpf(gden);
                    f32x4 pa = {0.f, 0.f, 0.f, 0.f}, pb = {0.f, 0.f, 0.f, 0.f};
                    const LAS f32x4* te = TE + gi * 2048 + lane;
#pragma unroll
                    for (int jc = 0; jc < 16; ++jc) { const float hv = r.v[jc >> 2][jc & 3]; pa += te[jc * 64] * hv; pb += te[1024 + jc * 64] * hv; }
                    float el[8];
                    { const f32x4 keep = h5 ? pb : pa, send = h5 ? pa : pb;
                      f32x4 q; q.x = keep.x + xlane32(send.x, h5); q.y = keep.y + xlane32(send.y, h5); q.z = keep.z + xlane32(send.z, h5); q.w = keep.w + xlane32(send.w, h5);
                      const float b0 = (h4 ? q.z : q.x) + xlane<16>(h4 ? q.x : q.z), b1 = (h4 ? q.w : q.y) + xlane<16>(h4 ? q.y : q.w);
                      float c = (h3 ? b1 : b0) + xlane<8>(h3 ? b0 : b1);
                      c += xlane<4>(c); c += xlane<2>(c); c += xlane<1>(c);
#pragma unroll
                      for (int o = 0; o < 8; ++o) el[o] = __int_as_float(__builtin_amdgcn_readlane(__float_as_int(c), 8 * o)) + be[gi * 8 + o]; }
                    int i0 = 0; float m0 = el[0];
#pragma unroll
                    for (int o = 1; o < 8; ++o) if (el[o] > m0) { m0 = el[o]; i0 = o; }
                    int i1 = -1; float m1 = -INFINITY;
#pragma unroll
                    for (int o = 0; o < 8; ++o) if (o != i0 && el[o] > m1) { m1 = el[o]; i1 = o; }
                    const float p1 = __builtin_amdgcn_exp2f((m1 - m0) * 1.4426950408889634f), w0_ = grp_p * __builtin_amdgcn_rcpf(1.0f + p1);
                    if (lane == 0) { rec_e[rl * 2] = gi * 8 + i0; rec_e[rl * 2 + 1] = gi * 8 + i1; rec_w[rl * 2] = w0_; rec_w[rl * 2 + 1] = w0_ * p1; }
                }
                __syncthreads();
                { const int e = rec_e[tid]; rec_rank[tid] = atomicAdd((int*)&hist[e], 1); }
                __syncthreads();
                if (tid < 32) { const int h = hist[tid]; base[tid] = (h && !dry) ? atomicAdd(&cntl[tid], h) : 0; }
                __syncthreads();
                { const int e = rec_e[tid], pos = base[e] + rec_rank[tid], tok = blk * 256 + (tid >> 1);
                  if (!dry) { ltok[(size_t)e * LISTCAP + pos] = tok; lw[(size_t)e * LISTCAP + pos] = rec_w[tid]; tslot[tok * 2 + (tid & 1)] = (e << 16) | pos; } }
                __syncthreads();
            }
        }
        SEAM(pb0);
        if (IN(pb0 + 1) || IN(pb0 + 2) || IN(pb0 + 3)) {
            __syncthreads();
            if (wave == 0 && lane_id() == 0) { const int* cntl = CNTL(); int s = 0;
#pragma unroll 1
                for (int e = 0; e < 32; ++e) { rb[e] = s; s += (__hip_atomic_load(&cntl[e], RLX_AGENT) + 255) & ~255; }
                rb[32] = s; }
            __syncthreads();
        }
        for (int rep_ = 0; rep_ < REPS(6); ++rep_) if (IN(pb0 + 1)) { bf16_t* xn = WSP(bf16_t, WS_XN); bf16_t* WGU = WSP(bf16_t, WS_WGU); bf16_t* act = WSP(bf16_t, WS_ACT); const int* ltok = WSP(int, WS_LTOK); const int* cntl = CNTL();
            pg8::Gemm g{xn, WGU + (size_t)l * 32 * 1024 * 1024, 0, 0, 1024}; pg8::MoeOrder S; S.init(rb[32] / 256, G, bid, rb, LOCAL_OK()); pg8::EpiPair<true> E{act, DEXP}; pg8::AGather am{ltok, cntl, rb};
            pg8::gemm_phase<pg8::EpiPair<true>, pg8::MoeOrder, pg8::AGather, true, true>(lds, g, S, E, am, wave); }
        LSEAM(pb0 + 1);
        for (int rep_ = 0; rep_ < REPS(7); ++rep_) if (IN(pb0 + 2)) { bf16_t* act = WSP(bf16_t, WS_ACT); bf16_t* WDN = WSP(bf16_t, WS_WDN); bf16_t* yw = WSP(bf16_t, WS_YW); const float* lw = WSP(float, WS_LW);
            pg8::Gemm g{act, WDN + (size_t)l * 32 * 1024 * 512, 0, 0, 512}; pg8::MoeOrder S; S.init(rb[32] / 256, G, bid, rb, LOCAL_OK()); pg8::EpiDown E{yw, lw, rb};
            pg8::gemm_phase<pg8::EpiDown, pg8::MoeOrder, pg8::APlain, true, true>(lds, g, S, E, pg8::APlain{}, wave); }
        SEAM(pb0 + 2);
        for (int rep_ = 0; rep_ < REPS(8); ++rep_) if (IN(pb0 + 3)) { IDS(); const bool dry = rep_ + 1 < REPS(8);
            const float* gnext = (l == 0) ? KIN(2) + D : KIN(18);
            const float* modn = WSP(float, WS_MOD) + (size_t)16 * 6144; const float* modl = MODL();
            float* outf = KOUT(); bf16_t* xr = (bf16_t*)KOUT(); const bf16_t* yw = WSP(bf16_t, WS_YW); const int* tslot = WSP(int, WS_TSLOT); bf16_t* xn = WSP(bf16_t, WS_XN);
            for (int w0 = (bid * 8 + wave) * 32; w0 < T; w0 += G * 8 * 32) {
                const int b = w0 >> 12;
                f32x4 g2v[4];
#pragma unroll
                for (int j = 0; j < 4; ++j) g2v[j] = *(const f32x4*)(modl + (size_t)b * 6144 + 5120 + 4 * lane + 256 * j);
                ModV mv;
                if (l == 0) { const float* mb = modn + (size_t)b * 6144; mod_load(mv, gnext, mb + 0, mb + 1024, lane); }
                else {
#pragma unroll
                    for (int j = 0; j < 4; ++j) { mv.gp[j] = *(const f32x4*)(gnext + 4 * lane + 256 * j); mv.sh[j] = (f32x4){0.f, 0.f, 0.f, 0.f}; }
                }
                const int slw = tslot[(size_t)w0 * 2 + lane];
                u32x2 xb[4][4], ya[4][4], yb[4][4];
#define R2_LOAD(D_, I_) do { const int s0_ = __builtin_amdgcn_readlane(slw, 2 * (I_)), s1_ = __builtin_amdgcn_readlane(slw, 2 * (I_) + 1); \
                    const size_t r0_ = (size_t)(rb[s0_ >> 16] + (s0_ & 0xffff)), r1_ = (size_t)(rb[s1_ >> 16] + (s1_ & 0xffff)); \
                    _Pragma("unroll") for (int j = 0; j < 4; ++j) { xb[D_][j] = *(const u32x2*)(xr + (size_t)(w0 + (I_)) * XRP + 4 * lane + 256 * j); \
                        ya[D_][j] = ntload((const u32x2*)(yw + r0_ * D + 4 * lane + 256 * j)); yb[D_][j] = ntload((const u32x2*)(yw + r1_ * D + 4 * lane + 256 * j)); } } while (0)
#pragma unroll
                for (int d = 0; d < 4; ++d) R2_LOAD(d, d);
#pragma unroll 1
                for (int i4 = 0; i4 < 32; i4 += 4)
#pragma unroll
                for (int d = 0; d < 4; ++d) {
                    const int i = i4 + d, row = w0 + i;
                    RowV r;
#pragma unroll
                    for (int j = 0; j < 4; ++j) {
                        const u32x2 xw = xb[d][j], a = ya[d][j], c = yb[d][j];
                        f32x4 y; y.x = bflo(a.x) + bflo(c.x); y.y = bfhi(a.x) + bfhi(c.x); y.z = bflo(a.y) + bflo(c.y); y.w = bfhi(a.y) + bfhi(c.y);
                        r.v[j] = (f32x4){bflo(xw.x), bfhi(xw.x), bflo(xw.y), bfhi(xw.y)} + g2v[j] * y;
                    }
                    if (i4 < 28) R2_LOAD(d, i + 4);
                    const float rstd = row_rstd(r);
                    if (dry) { asm volatile("" :: "v"(rstd), "v"(r.v[0].x), "v"(r.v[1].y), "v"(r.v[2].z), "v"(r.v[3].w)); }
                    else if (l == 1) { row_apply(r, rstd, mv); row_store_f32(r, outf + (size_t)row * D, lane); }
                    else { row_store_bf16(r, xr + (size_t)row * XRP, lane); row_apply(r, rstd, mv); row_store_bf16(r, xn + (size_t)row * D, lane); }
                }
#undef R2_LOAD
            }
        }
        SEAM(pb0 + 3);
    }
#undef IDS
#undef MODL
#undef CNTL
#undef IN
#undef SEAM
#undef GRID_BAR
}

extern "C" void kernel_launch(void* const* d_in, const int* in_sizes, int n_in, void* d_out, int out_size, void* d_ws, size_t ws_size, hipStream_t stream) {
    static int grid = 0;
    if (grid == 0) {
        if (n_in != 19 || out_size != T * D || ws_size < WS_END) { fprintf(stderr, "kernel_launch: unexpected shapes (n_in %d out %d ws %zu)\n", n_in, out_size, ws_size); grid = -1; return; }
        int dev = 0, cus = 0;
        if (hipGetDevice(&dev) != hipSuccess || hipDeviceGetAttribute(&cus, hipDeviceAttributeMultiprocessorCount, dev) != hipSuccess) { grid = -1; return; }
        if (hipFuncSetAttribute((const void*)mk_fwd, hipFuncAttributeMaxDynamicSharedMemorySize, LDS_BYTES) != hipSuccess) { fprintf(stderr, "kernel_launch: hipFuncSetAttribute failed\n"); grid = -1; return; }
        int per_cu = 0;
        if (hipOccupancyMaxActiveBlocksPerMultiprocessor(&per_cu, (const void*)mk_fwd, NWAVES * 64, LDS_BYTES) != hipSuccess || per_cu < 1) fprintf(stderr, "kernel_launch: occupancy query says %d\n", per_cu);
        (void)hipGetLastError();
        grid = cus;
    }
    if (grid < 0) return;
    (void)hipMemsetAsync((char*)d_ws + WS_CTL, 0, CTL_BYTES, stream);
    Args a{};
    for (int i = 0; i < 19; ++i) a.in[i] = (const float*)d_in[i];
    a.out = (float*)d_out; a.ws = (unsigned char*)d_ws;
#if MK_ONE_LAUNCH
    a.ph_lo = 0; a.ph_hi = NPHASE;
    hipLaunchKernelGGL(mk_fwd, dim3(grid), dim3(NWAVES * 64), LDS_BYTES, stream, a);
#else
    for (int p = 0; p < NPHASE; ++p) { a.ph_lo = p; a.ph_hi = p + 1; hipLaunchKernelGGL(mk_fwd, dim3(grid), dim3(NWAVES * 64), LDS_BYTES, stream, a); }
#endif
}
```

```cpp
#include <hip/hip_runtime.h>
#include <stdint.h>
#include <math.h>
#include <cstdio>

#ifndef MK_ONE_LAUNCH
#define MK_ONE_LAUNCH 1
#endif

typedef unsigned short bf16_t;
typedef float f32x4 __attribute__((ext_vector_type(4)));
typedef unsigned u32x2 __attribute__((ext_vector_type(2)));
typedef unsigned u32x4 __attribute__((ext_vector_type(4)));
#define GAS __attribute__((address_space(1)))
#define LAS __attribute__((address_space(3)))
typedef GAS unsigned gu32;
#define RLX_AGENT __ATOMIC_RELAXED, __HIP_MEMORY_SCOPE_AGENT

constexpr int D = 1024, BATCH = 16, SEQ = 4096, T = BATCH * SEQ;
constexpr int NEXP = 32, DEXP = 512, EPG = 8, NGRP = 4;
constexpr int QKVW = 4608;
__host__ __device__ __forceinline__ size_t qkv_block(int typ, int g, int b, int h) { return (size_t)((((typ * 3 + g) * 16 + b) * 8 + h)) * (4096 * 64); }
__host__ __device__ __forceinline__ int qkv_row(int pos, int g) { const int dsh = 2 * g; return ((pos & ((1 << dsh) - 1)) << (12 - dsh)) + (pos >> dsh); }
constexpr int LISTCAP = 65536;
constexpr int PADROWS = 139264;
constexpr float EPS = 1e-6f;
constexpr float QSCALE = 0.125f * 1.4426950408889634f;
constexpr int NWAVES = 8;
constexpr int CONV_EARLY = 512 + 256 + 256 + 1152 + 128;
constexpr int XRP = 2048;

constexpr size_t MiB = 1u << 20;
constexpr size_t WS_CTL = 0;
constexpr size_t CTL_BYTES = 1 * MiB;
constexpr int CW_BAR = 4096;
constexpr int CW_GATE = 9472;
constexpr size_t WS_MOD = 1 * MiB;
constexpr size_t WS_ROPE = 3 * MiB;
constexpr size_t WS_LTOK = 4 * MiB;
constexpr size_t WS_LW = 12 * MiB;
constexpr size_t WS_TSLOT = 20 * MiB;
constexpr size_t WS_LSE = 24 * MiB;
constexpr size_t WS_RTAB = 50 * MiB;
constexpr size_t RTAB_STRIDE = 98304 + 256;
constexpr size_t WS_WZ = 32 * MiB;
constexpr size_t WS_WB = 36 * MiB;
constexpr size_t WS_WCO = 38 * MiB;
constexpr size_t WS_WAI = 40 * MiB;
constexpr size_t WS_WAO = 49 * MiB;
constexpr size_t WS_WGU = 64 * MiB;
constexpr size_t WS_WDN = 192 * MiB;
constexpr size_t WS_XN = 256 * MiB;
constexpr size_t WS_BIG = 384 * MiB;
constexpr size_t WS_Z = WS_BIG, WS_YPRE = WS_BIG + 128 * MiB;
constexpr size_t WS_ACT = WS_BIG, WS_YW = WS_BIG + 136 * MiB;
constexpr size_t WS_QKV = WS_BIG;
constexpr size_t WS_OB = WS_BIG + 576 * MiB;
constexpr size_t WS_END = WS_OB + 64 * MiB;

constexpr int RING_BYTES = 162816;
constexpr int MISC_OFF = RING_BYTES;
constexpr int LDS_BYTES = RING_BYTES + 1024;

__device__ __forceinline__ unsigned f2bf(float f) { unsigned u = __float_as_uint(f); return (u + 0x7fffu + ((u >> 16) & 1u)) >> 16; }
__device__ __forceinline__ unsigned pk2(float lo, float hi) { return f2bf(lo) | (f2bf(hi) << 16); }
__device__ __forceinline__ float bf2f(unsigned h) { return __uint_as_float(h << 16); }
__device__ __forceinline__ float bflo(unsigned w) { return __uint_as_float(w << 16); }
__device__ __forceinline__ float bfhi(unsigned w) { return __uint_as_float(w & 0xffff0000u); }
template <int M> __device__ __forceinline__ float xlane(float v) {
    return __int_as_float(__builtin_amdgcn_ds_swizzle(__float_as_int(v), (M << 10) | 0x1f));
}
__device__ __forceinline__ float xlane32(float v, bool hi) {
    auto rr = __builtin_amdgcn_permlane32_swap(__float_as_uint(v), __float_as_uint(v), false, false); return __uint_as_float(hi ? rr[0] : rr[1]);
}
__device__ __forceinline__ float wave_sum(float v) {
    v += xlane<1>(v); v += xlane<2>(v); v += xlane<4>(v); v += xlane<8>(v); v += xlane<16>(v);
    auto rr = __builtin_amdgcn_permlane32_swap(__float_as_uint(v), __float_as_uint(v), false, false);
    return __uint_as_float(rr[0]) + __uint_as_float(rr[1]);
}
__device__ __forceinline__ float silu_f(float x) { return x / (1.0f + __expf(-x)); }
#define LDS_WAIT() asm volatile("s_waitcnt lgkmcnt(0)" ::: "memory")
template <class V> __device__ __forceinline__ V ntload(const V* p) { return __builtin_nontemporal_load(p); }
__device__ __forceinline__ int lane_id() { int l; asm volatile("v_mbcnt_lo_u32_b32 %0, -1, 0\n\tv_mbcnt_hi_u32_b32 %0, -1, %0" : "=v"(l)); return l; }

namespace pg8 {
#define PG8_LAS __attribute__((address_space(3)))
typedef unsigned short bf16_t;
typedef short bf16x8 __attribute__((ext_vector_type(8)));
typedef float f32x4 __attribute__((ext_vector_type(4)));
typedef unsigned u32x4 __attribute__((ext_vector_type(4)));
constexpr int BM = 256, BK = 64, HALF = 128, HTB = HALF * BK * 2  , STAGE_BYTES = 8 * HTB, NXCD = 8, WGM = 4;

__host__ __device__ __forceinline__ int lds_byte(int r, int c) { const int st = (r >> 4) * 2 + (c >> 5), rr = r & 15, cc = c & 31, ob = rr * 64 + cc * 2; return st * 1024 + (ob ^ (((ob >> 9) & 1) << 5)); }
__host__ __device__ __forceinline__ void stage_rc(int b, int& R, int& C) { const int st = b / 1024, sb = b % 1024, swz = sb ^ (((sb >> 9) & 1) << 5); R = (st >> 1) * 16 + swz / 64; C = (st & 1) * 32 + (swz % 64) / 2; }
__host__ __device__ __forceinline__ int perm32(int rho) { const int n = rho >> 4, i = rho & 15; return 8 * (i >> 2) + 4 * n + (i & 3); }

struct Unit { int pm, pn, pb; };
struct Gemm { const bf16_t* A; const bf16_t* Bt; int M, N, K; };

struct StaticOrder {
    int nM, nN, nwg, G, c, wgm;
    __host__ __device__ void init(int M, int N, int G_, int c_, int wgm_ = WGM) { nM = M / BM; nN = N / BM; nwg = nM * nN; G = G_; c = c_; wgm = wgm_; }
    __host__ __device__ bool next(int i, Unit& u) const {
        const long L = (long)i * G + c; if (L >= nwg) return false;
        int wgid = (int)L; { const int q = nwg / NXCD, r = nwg % NXCD, xcd = wgid % NXCD, off = wgid / NXCD; wgid = (xcd < r ? xcd * (q + 1) : r * (q + 1) + (xcd - r) * q) + off; }
        const int nig = wgm * nN, gid = wgid / nig, fm = gid * wgm, gsz = (nM - fm) < wgm ? (nM - fm) : wgm;
        u.pm = fm + ((wgid % nig) % gsz); u.pn = (wgid % nig) / gsz; u.pb = u.pn; return true;
    }
    __device__ __forceinline__ void a_ready(const Unit&) const {}
    __device__ __forceinline__ void done(const Unit&) const {}
};


__device__ __forceinline__ unsigned cvt_pk_bf16(float lo, float hi) { unsigned r; asm volatile("v_cvt_pk_bf16_f32 %0, %1, %2" : "=v"(r) : "v"(lo), "v"(hi)); return r; }
typedef float f32x2 __attribute__((ext_vector_type(2)));

template <class Epi, class Sched, class AM, bool ALIGN_EPI = false, bool SP2 = false>
__device__ __forceinline__ void gemm_phase(PG8_LAS unsigned char* lds, const Gemm g, const Sched& S, const Epi& E, const AM& am, const int wid_in) {
    int wid = wid_in; asm volatile("" : "+s"(wid));
    const int lane = lane_id(), tid = wid * 64 + lane, wr = wid >> 2, wc = wid & 3, fr = lane & 15, fq = lane >> 4;
    const int K = g.K, nt = K / BK;
    unsigned voffA[2], voffB[2]; int stR[2], stC[2];
#pragma unroll
    for (int i = 0; i < 2; ++i) { int R, C; stage_rc(tid * 16 + i * 8192, R, C); const int Rb = Epi::PERM ? ((R & ~31) + perm32(R & 31)) : R;
        stR[i] = R; stC[i] = C; voffA[i] = (unsigned)(R * K + C) * 2u; voffB[i] = (unsigned)(Rb * K + C) * 2u; }
    const size_t kstep = (size_t)(BK * 2);
    const size_t hstep = (size_t)HALF * K * 2;
    const size_t tstep = 2 * hstep;
    const unsigned ldsw = (unsigned)wid * 1024u;
    const int aoff = lds_byte(wr * 64 + fr, fq * 8), boff = lds_byte(wc * 32 + fr, fq * 8);
#define PG8_SA(b, h) (((b) * 2 + (h)) * HTB)
#define PG8_SB(b, h) ((4 + (b) * 2 + (h)) * HTB)
#define PG8_STAGE(bufoff, gbase, voff) do { _Pragma("unroll") for (int _i = 0; _i < 2; ++_i) \
        __builtin_amdgcn_global_load_lds((const unsigned*)((const char*)(gbase) + (voff)[_i]), (PG8_LAS unsigned*)(lds + (bufoff) + ldsw + _i * 8192), 16, 0, 0); } while (0)
#define PG8_STAGE_A(b, h, gbase, NX) do { if constexpr (AM::GATHER) { const unsigned so_[2] = {(NX) ? gno[h][0] : gao[h][0], (NX) ? gno[h][1] : gao[h][1]}; PG8_STAGE(PG8_SA(b, h), gbase, so_); } \
        else { PG8_STAGE(PG8_SA(b, h), (gbase) + (h) * hstep, voffA); } } while (0)
#define PG8_LDA(dst, b, h) do { _Pragma("unroll") for (int m = 0; m < 4; ++m) _Pragma("unroll") for (int k = 0; k < 2; ++k) dst[m][k] = *(const PG8_LAS bf16x8*)(lds + PG8_SA(b, h) + aoff + m * 2048 + k * 1024); } while (0)
#define PG8_LDB(dst, b, h) do { _Pragma("unroll") for (int n = 0; n < 2; ++n) _Pragma("unroll") for (int k = 0; k < 2; ++k) dst[n][k] = *(const PG8_LAS bf16x8*)(lds + PG8_SB(b, h) + boff + n * 2048 + k * 1024); } while (0)
#define PG8_MMA(ai, bj, At, Bt) do { __builtin_amdgcn_s_setprio(1); _Pragma("unroll") for (int m = 0; m < 4; ++m) _Pragma("unroll") for (int n = 0; n < 2; ++n) _Pragma("unroll") for (int k = 0; k < 2; ++k) \
        acc[ai][bj][m][n] = __builtin_amdgcn_mfma_f32_16x16x32_bf16(Bt[n][k], At[m][k], acc[ai][bj][m][n], 0, 0, 0); __builtin_amdgcn_s_setprio(0); } while (0)
#define PG8_WAIT_V(n) asm volatile("s_waitcnt vmcnt(" #n ")" ::: "memory")
#define PG8_WAIT_L(n) asm volatile("s_waitcnt lgkmcnt(" #n ")" ::: "memory")
#define PG8_BAR __builtin_amdgcn_s_barrier()
#define PG8_SCHED __builtin_amdgcn_sched_barrier(0)
    Unit cur, nxt; int ui = 0;
    if (!S.next(0, cur)) return;
    f32x4 acc[2][2][4][2];
#pragma unroll
    for (int a = 0; a < 2; ++a)
#pragma unroll
        for (int b = 0; b < 2; ++b)
#pragma unroll
            for (int m = 0; m < 4; ++m)
#pragma unroll
                for (int n = 0; n < 2; ++n) acc[a][b][m][n] = (f32x4){0.f, 0.f, 0.f, 0.f};
    bf16x8 At[4][2], B0[2][2], B1[2][2];
    const char* cA = (const char*)g.A + (AM::GATHER ? (size_t)0 : (size_t)cur.pm * tstep); const char* cB = (const char*)g.Bt + (size_t)cur.pb * tstep;
    unsigned gao[2][2], gno[2][2]; int tkn[2][2] = {{0, 0}, {0, 0}};
    if constexpr (AM::GATHER) { _Pragma("unroll") for (int h = 0; h < 2; ++h) _Pragma("unroll") for (int i = 0; i < 2; ++i) { tkn[h][i] = am.arow(cur, h * HALF + stR[i]); gao[h][i] = (unsigned)(tkn[h][i] * K + stC[i]) * 2u; gno[h][i] = gao[h][i]; } }
    else { _Pragma("unroll") for (int h = 0; h < 2; ++h) _Pragma("unroll") for (int i = 0; i < 2; ++i) { gao[h][i] = 0u; gno[h][i] = 0u; } }
    S.a_ready(cur);
    if constexpr (SP2) {
        PG8_STAGE(PG8_SB(0, 0), cB, voffB); PG8_STAGE(PG8_SB(0, 1), cB + hstep, voffB); PG8_STAGE_A(0, 0, cA, false); PG8_STAGE_A(0, 1, cA, false);
        if (wr == 1) PG8_BAR;
        PG8_WAIT_V(2); PG8_BAR;
        PG8_STAGE(PG8_SB(1, 0), cB + kstep, voffB); PG8_STAGE_A(1, 0, cA + kstep, false); PG8_STAGE(PG8_SB(1, 1), cB + hstep + kstep, voffB);
        PG8_WAIT_V(6); PG8_BAR;
    } else {
        PG8_STAGE(PG8_SB(0, 0), cB, voffB); PG8_STAGE_A(0, 0, cA, false); PG8_STAGE(PG8_SB(0, 1), cB + hstep, voffB); PG8_STAGE_A(0, 1, cA, false);
        if (wr == 1) PG8_BAR;
        PG8_WAIT_V(4); PG8_BAR;
        PG8_STAGE(PG8_SB(1, 0), cB + kstep, voffB); PG8_STAGE_A(1, 0, cA + kstep, false); PG8_STAGE(PG8_SB(1, 1), cB + hstep + kstep, voffB);
        PG8_WAIT_V(6); PG8_BAR;
    }
    for (;;) {
        const bool has_next = S.next(ui + 1, nxt);
        const char* nA = has_next ? (const char*)g.A + (AM::GATHER ? (size_t)0 : (size_t)nxt.pm * tstep) : cA; const char* nB = has_next ? (const char*)g.Bt + (size_t)nxt.pb * tstep : cB;
        if constexpr (AM::GATHER) { if (has_next) { _Pragma("unroll") for (int h = 0; h < 2; ++h) _Pragma("unroll") for (int i = 0; i < 2; ++i) tkn[h][i] = am.arow_async(nxt, h * HALF + stR[i]); } }
        for (int t = 0; t < nt; t += 2) {
            const bool last = (t == nt - 2);
            if constexpr (AM::GATHER) {
                asm volatile("" : "+v"(tkn[0][0]), "+v"(tkn[0][1]), "+v"(tkn[1][0]), "+v"(tkn[1][1]));
                _Pragma("unroll") for (int h = 0; h < 2; ++h) _Pragma("unroll") for (int i = 0; i < 2; ++i) gno[h][i] = (unsigned)(tkn[h][i] * K + stC[i]) * 2u; }
            const char* a1 = cA + (size_t)(t + 1) * kstep;
            const char* a2 = last ? nA : cA + (size_t)(t + 2) * kstep; const char* b2 = last ? nB : cB + (size_t)(t + 2) * kstep;
            const char* a3 = a2 + kstep; const char* b3 = b2 + kstep;
            if (last && has_next) S.a_ready(nxt);
            if (false) E.prefetch(cur, tid, (PG8_LAS unsigned*)(lds + 162816 + 512));
            if constexpr (SP2) {
            PG8_LDB(B0, 0, 0); PG8_LDB(B1, 0, 1); PG8_SCHED; PG8_LDA(At, 0, 0); PG8_STAGE_A(1, 1, a1, false);
            PG8_WAIT_V(8); PG8_WAIT_L(0); PG8_BAR; PG8_MMA(0, 0, At, B0); PG8_MMA(0, 1, At, B1); PG8_BAR; PG8_SCHED;
            PG8_LDA(At, 0, 1); PG8_STAGE(PG8_SB(0, 0), b2, voffB); PG8_STAGE(PG8_SB(0, 1), b2 + hstep, voffB); PG8_STAGE_A(0, 0, a2, last);
            PG8_WAIT_V(8); PG8_WAIT_L(0); PG8_BAR; PG8_MMA(1, 0, At, B0); PG8_MMA(1, 1, At, B1); PG8_BAR; PG8_SCHED;
            PG8_LDB(B0, 1, 0); PG8_LDB(B1, 1, 1); PG8_SCHED; PG8_LDA(At, 1, 0); PG8_STAGE_A(0, 1, a2, last);
            PG8_WAIT_V(8); PG8_WAIT_L(0); PG8_BAR; PG8_MMA(0, 0, At, B0); PG8_MMA(0, 1, At, B1); PG8_BAR; PG8_SCHED;
            PG8_LDA(At, 1, 1); PG8_STAGE(PG8_SB(1, 0), b3, voffB); PG8_STAGE(PG8_SB(1, 1), b3 + hstep, voffB); PG8_STAGE_A(1, 0, a3, last);
            PG8_WAIT_V(8); PG8_WAIT_L(0); PG8_BAR; PG8_MMA(1, 0, At, B0); PG8_MMA(1, 1, At, B1); PG8_BAR; PG8_SCHED;
            } else {
            PG8_LDB(B0, 0, 0); PG8_SCHED; PG8_LDA(At, 0, 0); PG8_STAGE_A(1, 1, a1, false);
            PG8_WAIT_L(8); PG8_BAR; PG8_WAIT_L(0); PG8_MMA(0, 0, At, B0); PG8_BAR; PG8_SCHED;
            PG8_LDB(B1, 0, 1); PG8_STAGE(PG8_SB(0, 0), b2, voffB);
            PG8_BAR; PG8_WAIT_L(0); PG8_MMA(0, 1, At, B1); PG8_BAR;
            PG8_LDA(At, 0, 1); PG8_STAGE_A(0, 0, a2, last);
            PG8_BAR; PG8_WAIT_L(0); PG8_MMA(1, 0, At, B0); PG8_BAR; PG8_SCHED;
            PG8_STAGE(PG8_SB(0, 1), b2 + hstep, voffB);
            PG8_WAIT_V(6); PG8_BAR; PG8_MMA(1, 1, At, B1); PG8_BAR;
            PG8_LDB(B0, 1, 0); PG8_SCHED; PG8_LDA(At, 1, 0); PG8_STAGE_A(0, 1, a2, last);
            PG8_WAIT_L(8); PG8_BAR; PG8_WAIT_L(0); PG8_MMA(0, 0, At, B0); PG8_BAR; PG8_SCHED;
            PG8_LDB(B1, 1, 1); PG8_STAGE(PG8_SB(1, 0), b3, voffB);
            PG8_BAR; PG8_WAIT_L(0); PG8_MMA(0, 1, At, B1); PG8_BAR;
            PG8_LDA(At, 1, 1); PG8_STAGE_A(1, 0, a3, last);
            PG8_BAR; PG8_WAIT_L(0); PG8_MMA(1, 0, At, B0); PG8_BAR; PG8_SCHED;
            PG8_STAGE(PG8_SB(1, 1), b3 + hstep, voffB);
            PG8_WAIT_V(6); PG8_BAR; PG8_MMA(1, 1, At, B1); PG8_BAR;
            }
        }
        if constexpr (ALIGN_EPI) { if (wr == 0) PG8_BAR; }
        if constexpr (Epi::GATED) { if (ui == 0) E.gate_wait(); }
        if constexpr (!Epi::AFTER_DRAIN) { E(acc, cur, wr, wc, fr, fq); S.done(cur); }
        if (!has_next) break;
#pragma unroll
        for (int a = 0; a < 2; ++a)
#pragma unroll
            for (int b = 0; b < 2; ++b)
#pragma unroll
                for (int m = 0; m < 4; ++m)
#pragma unroll
                    for (int n = 0; n < 2; ++n) acc[a][b][m][n] = (f32x4){0.f, 0.f, 0.f, 0.f};
        cur = nxt; cA = nA; cB = nB; ++ui;
        if constexpr (AM::GATHER) { _Pragma("unroll") for (int h = 0; h < 2; ++h) _Pragma("unroll") for (int i = 0; i < 2; ++i) gao[h][i] = gno[h][i]; }
        if constexpr (ALIGN_EPI) { if (wr == 1) PG8_BAR; }
    }
    PG8_WAIT_V(0);
    if constexpr (!ALIGN_EPI) { if (wr == 0) PG8_BAR; }
    PG8_BAR;
    if constexpr (Epi::AFTER_DRAIN) { E.fused(acc, cur, wr, wc, fr, fq, lds, wid, lane); S.done(cur); }
#undef PG8_SA
#undef PG8_SB
#undef PG8_STAGE
#undef PG8_STAGE_A
#undef PG8_LDA
#undef PG8_LDB
#undef PG8_MMA
#undef PG8_WAIT_V
#undef PG8_WAIT_L
#undef PG8_BAR
#undef PG8_SCHED
}

__device__ __forceinline__ u32x4 pack8(const f32x4 v0, const f32x4 v1) { u32x4 w; w.x = cvt_pk_bf16(v0[0], v0[1]); w.y = cvt_pk_bf16(v0[2], v0[3]); w.z = cvt_pk_bf16(v1[0], v1[1]); w.w = cvt_pk_bf16(v1[2], v1[3]); return w; }
__device__ __forceinline__ u32x4 xpose4x16(const u32x4 w, int sa) {
    u32x4 r; r.x = __builtin_amdgcn_ds_bpermute(sa, w.x); r.y = __builtin_amdgcn_ds_bpermute(sa, w.y); r.z = __builtin_amdgcn_ds_bpermute(sa, w.z); r.w = __builtin_amdgcn_ds_bpermute(sa, w.w); return r;
}
#define XPOSE_IDS() const int L_ = fr + 16 * fq, tr_ = L_ >> 2, tq_ = L_ & 3, sa_ = 4 * (tr_ + 16 * tq_)
__device__ __forceinline__ float silu1(float x) { return x * __builtin_amdgcn_rcpf(1.0f + __builtin_amdgcn_exp2f(-1.4426950408889634f * x)); }
template <bool SILU> struct EpiPair {
    static constexpr bool GATED = false;
    static constexpr bool PERM = true, AFTER_DRAIN = false;
    bf16_t* O; int ldc;
    __device__ __forceinline__ void prefetch(const Unit&, int, PG8_LAS unsigned*) const {}
    __device__ __forceinline__ void operator()(const f32x4 (&acc)[2][2][4][2], const Unit& u, int wr, int wc, int fr, int fq) const {
        XPOSE_IDS();
        const int row0 = u.pm * BM + wr * 64 + tr_, ch0 = u.pn * HALF + wc * 32 + 8 * tq_;
#pragma unroll
        for (int ai = 0; ai < 2; ++ai)
#pragma unroll
            for (int m = 0; m < 4; ++m) {
                f32x4 a0 = acc[ai][0][m][0], a1 = acc[ai][0][m][1];
                if (SILU) {
#pragma unroll
                    for (int c = 0; c < 4; ++c) { a0[c] = silu1(a0[c]); a1[c] = silu1(a1[c]); }
                }
                *(u32x4*)(O + (size_t)(row0 + ai * HALF + m * 16) * ldc + ch0) = xpose4x16(pack8(a0 * acc[ai][1][m][0], a1 * acc[ai][1][m][1]), sa_);
            }
    }
};
struct EpiYpre {
    static constexpr bool GATED = false;
    static constexpr bool PERM = true, AFTER_DRAIN = false;
    bf16_t* O; const bf16_t* Z; const float* cw;
    __device__ __forceinline__ void prefetch(const Unit& u, int tid, PG8_LAS unsigned* dummy) const {
#pragma unroll
        for (int i = 0; i < 2; ++i) { const int line = tid + 512 * i, row = line >> 2, seg = line & 3;
            __builtin_amdgcn_global_load_lds((const unsigned*)(Z + (size_t)(u.pm * BM + row) * D + u.pn * BM + seg * 64), dummy, 4, 0, 0); }
    }
    template <typename P> static __device__ __forceinline__ P sadd(P base, unsigned off) { asm volatile("" : "+v"(off)); return base + off; }
    template <int N> static __device__ __forceinline__ u32x4 ror(const u32x4 v) { u32x4 r;
        r.x = (unsigned)__builtin_amdgcn_update_dpp(0, (int)v.x, 0x120 + N, 0xf, 0xf, false); r.y = (unsigned)__builtin_amdgcn_update_dpp(0, (int)v.y, 0x120 + N, 0xf, 0xf, false);
        r.z = (unsigned)__builtin_amdgcn_update_dpp(0, (int)v.z, 0x120 + N, 0xf, 0xf, false); r.w = (unsigned)__builtin_amdgcn_update_dpp(0, (int)v.w, 0x120 + N, 0xf, 0xf, false); return r; }
    static __device__ __forceinline__ u32x4 sel(bool c, const u32x4 a, const u32x4 b) { u32x4 r; r.x = c ? a.x : b.x; r.y = c ? a.y : b.y; r.z = c ? a.z : b.z; r.w = c ? a.w : b.w; return r; }
    __device__ __forceinline__ void operator()(const f32x4 (&acc)[2][2][4][2], const Unit& u, int wr, int wc, int fr, int fq) const {
        XPOSE_IDS();
        const int row0 = u.pm * BM + wr * 64 + fr;
#pragma unroll
        for (int bj = 0; bj < 2; ++bj) {
            const int col0 = u.pn * BM + bj * HALF + wc * 32 + 8 * fq;
            f32x4 w0[2], w1[2], w2[2];
#pragma unroll
            for (int n = 0; n < 2; ++n) { w0[n] = *(const f32x4*)(cw + col0 + 4 * n); w1[n] = *(const f32x4*)(cw + D + col0 + 4 * n); w2[n] = *(const f32x4*)(cw + 2 * D + col0 + 4 * n); }
            u32x4 zc[2][4], zh[2];
#pragma unroll
            for (int ai = 0; ai < 2; ++ai) {
                zh[ai] = (u32x4){0u, 0u, 0u, 0u};
                if (fr >= 14 && row0 + ai * HALF >= 16) zh[ai] = *(const u32x4*)sadd((const char*)Z, (unsigned)((row0 + ai * HALF - 16) * D + col0) * 2u);
#pragma unroll
                for (int m = 0; m < 4; ++m) zc[ai][m] = *(const u32x4*)(sadd((const char*)Z, (unsigned)((row0 + ai * HALF) * D + col0) * 2u) + m * 16 * D * 2);
            }
            asm volatile("" ::: "memory");
#pragma unroll
            for (int ai = 0; ai < 2; ++ai)
#pragma unroll
                for (int m = 0; m < 4; ++m) {
                    const int row = row0 + ai * HALF + m * 16, t = row & (SEQ - 1);
                    const u32x4 cur = zc[ai][m], prv = (m == 0) ? zh[ai] : zc[ai][m - 1];
                    u32x4 z1 = sel(fr >= 1, ror<1>(cur), ror<1>(prv)), z2 = sel(fr >= 2, ror<2>(cur), ror<2>(prv));
                    if (t < 1) z1 = (u32x4){0u, 0u, 0u, 0u};
                    if (t < 2) z2 = (u32x4){0u, 0u, 0u, 0u};
                    const u32x4 z0 = cur;
                    f32x4 v[2];
#pragma unroll
                    for (int n = 0; n < 2; ++n) {
                        f32x4 a, b, c;
                        a[0] = __uint_as_float(z0[2 * n] << 16); a[1] = __uint_as_float(z0[2 * n] & 0xffff0000u); a[2] = __uint_as_float(z0[2 * n + 1] << 16); a[3] = __uint_as_float(z0[2 * n + 1] & 0xffff0000u);
                        b[0] = __uint_as_float(z1[2 * n] << 16); b[1] = __uint_as_float(z1[2 * n] & 0xffff0000u); b[2] = __uint_as_float(z1[2 * n + 1] << 16); b[3] = __uint_as_float(z1[2 * n + 1] & 0xffff0000u);
                        c[0] = __uint_as_float(z2[2 * n] << 16); c[1] = __uint_as_float(z2[2 * n] & 0xffff0000u); c[2] = __uint_as_float(z2[2 * n + 1] << 16); c[3] = __uint_as_float(z2[2 * n + 1] & 0xffff0000u);
                        v[n] = acc[ai][bj][m][n] * (w2[n] * a + w1[n] * b + w0[n] * c);
                    }
                    *(u32x4*)(sadd((char*)O, (unsigned)((row0 - fr + tr_ + ai * HALF) * D + col0 - 8 * fq + 8 * tq_) * 2u) + m * 16 * D * 2) = xpose4x16(pack8(v[0], v[1]), sa_);
                    __builtin_amdgcn_sched_barrier(0);
                }
            asm volatile("" ::: "memory");
        }
    }
};

template <bool RES_F32> struct EpiRes {
    static constexpr bool GATED = false;
    static constexpr bool PERM = true, AFTER_DRAIN = false;
    bf16_t* xr; const float* xin; const float* modg;
    __device__ __forceinline__ void prefetch(const Unit&, int, PG8_LAS unsigned*) const {}
    __device__ __forceinline__ void operator()(const f32x4 (&acc)[2][2][4][2], const Unit& u, int wr, int wc, int fr, int fq) const {
        XPOSE_IDS();
        const int row0 = u.pm * BM + wr * 64 + fr, col0 = u.pn * BM + wc * 32 + 8 * fq;
        const float* gb = modg + (size_t)((u.pm * BM) >> 12) * 6144;
        f32x4 gv[2][2];
#pragma unroll
        for (int bj = 0; bj < 2; ++bj)
#pragma unroll
            for (int n = 0; n < 2; ++n) gv[bj][n] = *(const f32x4*)(gb + col0 + bj * HALF + n * 4);
        if constexpr (!RES_F32) {
            u32x4 rw[2][4][2];
#pragma unroll
            for (int ai = 0; ai < 2; ++ai)
#pragma unroll
                for (int m = 0; m < 4; ++m)
#pragma unroll
                    for (int bj = 0; bj < 2; ++bj) rw[ai][m][bj] = *(const u32x4*)(xr + (size_t)(row0 + ai * HALF + m * 16) * XRP + col0 + bj * HALF);
            asm volatile("" ::: "memory");
#pragma unroll
            for (int ai = 0; ai < 2; ++ai)
#pragma unroll
                for (int m = 0; m < 4; ++m) { const int row = row0 + ai * HALF + m * 16;
#pragma unroll
                    for (int bj = 0; bj < 2; ++bj) { const u32x4 w = rw[ai][m][bj];
                        const f32x4 r0 = {__uint_as_float(w.x << 16), __uint_as_float(w.x & 0xffff0000u), __uint_as_float(w.y << 16), __uint_as_float(w.y & 0xffff0000u)};
                        const f32x4 r1 = {__uint_as_float(w.z << 16), __uint_as_float(w.z & 0xffff0000u), __uint_as_float(w.w << 16), __uint_as_float(w.w & 0xffff0000u)};
                        *(u32x4*)(xr + (size_t)(row - fr + tr_) * XRP + col0 - 8 * fq + 8 * tq_ + bj * HALF) = xpose4x16(pack8(r0 + gv[bj][0] * acc[ai][bj][m][0], r1 + gv[bj][1] * acc[ai][bj][m][1]), sa_); } }
        } else {
#pragma unroll
        for (int ai = 0; ai < 2; ++ai) {
            f32x4 rv[4][2][2];
#pragma unroll
            for (int m = 0; m < 4; ++m) { const int row = row0 + ai * HALF + m * 16;
#pragma unroll
                for (int bj = 0; bj < 2; ++bj) { rv[m][bj][0] = ntload((const f32x4*)(xin + (size_t)row * D + col0 + bj * HALF)); rv[m][bj][1] = ntload((const f32x4*)(xin + (size_t)row * D + col0 + bj * HALF + 4)); } }
#pragma unroll
            for (int m = 0; m < 4; ++m) { const int row = row0 + ai * HALF + m * 16;
#pragma unroll
                for (int bj = 0; bj < 2; ++bj)
                    *(u32x4*)(xr + (size_t)(row - fr + tr_) * XRP + col0 - 8 * fq + 8 * tq_ + bj * HALF) = xpose4x16(pack8(rv[m][bj][0] + gv[bj][0] * acc[ai][bj][m][0], rv[m][bj][1] + gv[bj][1] * acc[ai][bj][m][1]), sa_); }
            asm volatile("" ::: "memory");
        }
        }
    }
};
struct EpiQKV {
    static constexpr bool GATED = true;
    unsigned* gate; unsigned want;
    __device__ __forceinline__ void gate_wait() const {
        unsigned sp = 0u;
        while (__hip_atomic_load(gate, __ATOMIC_RELAXED, __HIP_MEMORY_SCOPE_AGENT) < want) { __builtin_amdgcn_s_sleep(2); if (++sp > (1u << 22)) break; }
    }
    static constexpr bool PERM = true, AFTER_DRAIN = false;
    bf16_t* O; const float* rope; int row_off;
    __device__ __forceinline__ void prefetch(const Unit&, int, PG8_LAS unsigned*) const {}
    __device__ __forceinline__ void operator()(const f32x4 (&acc)[2][2][4][2], const Unit& u, int wr, int wc, int fr, int fq) const {
        XPOSE_IDS();
        const int row0 = u.pm * BM + wr * 64 + fr, col0 = u.pn * BM + wc * 32 + 8 * fq;
        const int typ = (u.pn % 6) >> 1, gq_ = u.pn / 6;
        const bool rl = (typ < 2) && ((wc & 1) == 0) && (fq < 2);
        const float sc = (typ == 0) ? QSCALE : 1.0f;
#pragma unroll
        for (int ai = 0; ai < 2; ++ai)
#pragma unroll
        for (int mp = 0; mp < 2; ++mp) {
            f32x4 csv[2], snv[2];
#pragma unroll
            for (int mm = 0; mm < 2; ++mm) { const int pos = (row0 + ai * HALF + (2 * mp + mm) * 16) & (SEQ - 1);
                csv[mm] = *(const f32x4*)(rope + pos * 8 + 4 * (fq & 1)); snv[mm] = *(const f32x4*)(rope + 4096 * 8 + pos * 8 + 4 * (fq & 1)); }
#pragma unroll
            for (int mm = 0; mm < 2; ++mm) {
                const int m = 2 * mp + mm, row = row0 + ai * HALF + m * 16;
                f32x4 cs = {1.f, 1.f, 1.f, 1.f}, sn = {0.f, 0.f, 0.f, 0.f};
                if (rl) { cs = csv[mm]; sn = snv[mm]; }
#pragma unroll
                for (int bj = 0; bj < 2; ++bj) {
                    const f32x4 x1 = acc[ai][bj][m][0], x2 = acc[ai][bj][m][1];
                    const f32x4 r1 = (x1 * cs - x2 * sn) * sc, r2 = (x2 * cs + x1 * sn) * sc;
                    { const int tok = row_off + row - fr + tr_, hh = 4 * (u.pn & 1) + 2 * bj + (wc >> 1);
                      *(u32x4*)(O + qkv_block(typ, gq_, tok >> 12, hh) + (size_t)qkv_row(tok & (SEQ - 1), gq_) * 64 + 32 * (wc & 1) + 8 * tq_) = xpose4x16(pack8(r1, r2), sa_); }
                }
            }
            asm volatile("" ::: "memory");
        }
    }
};
struct EpiDown {
    static constexpr bool GATED = false;
    static constexpr bool PERM = true, AFTER_DRAIN = false;
    bf16_t* O; const float* lw; const PG8_LAS int* rb;
    __device__ __forceinline__ void prefetch(const Unit&, int, PG8_LAS unsigned*) const {}
    __device__ __forceinline__ void operator()(const f32x4 (&acc)[2][2][4][2], const Unit& u, int wr, int wc, int fr, int fq) const {
        XPOSE_IDS();
        const int row0 = u.pm * BM + wr * 64 + fr, col0 = u.pn * BM + wc * 32 + 8 * fq;
        const int e = u.pb >> 2; const float* wrow = lw + (size_t)e * LISTCAP - rb[e];
        float wv[2][4];
#pragma unroll
        for (int ai = 0; ai < 2; ++ai)
#pragma unroll
            for (int m = 0; m < 4; ++m) wv[ai][m] = wrow[row0 + ai * HALF + m * 16];
#pragma unroll
        for (int ai = 0; ai < 2; ++ai)
#pragma unroll
            for (int m = 0; m < 4; ++m) {
                const int row = row0 + ai * HALF + m * 16; const float w = wv[ai][m];
#pragma unroll
                for (int bj = 0; bj < 2; ++bj) *(u32x4*)(O + (size_t)(row - fr + tr_) * D + col0 - 8 * fq + 8 * tq_ + bj * HALF) = xpose4x16(pack8(acc[ai][bj][m][0] * w, acc[ai][bj][m][1] * w), sa_);
            }
    }
};
struct MoeOrder {
    int nM, nN, nwg, G, c; const PG8_LAS int* rb; bool aligned;
    __device__ void init(int nRT, int G_, int c_, const PG8_LAS int* rb_, bool aligned_ = false) { nM = nRT; nN = 4; nwg = nM * nN; G = G_; c = c_; rb = rb_; aligned = aligned_; }
    __device__ bool next(int i, Unit& u) const {
        const long L = (long)i * G + c; int wgid;
        if (aligned) {
            const int ng = (nM + WGM - 1) / WGM, gq = ng / NXCD, gr = ng % NXCD, xcd = (int)(L % NXCD); const long off = L / NXCD;
            const int g0 = xcd * gq + (xcd < gr ? xcd : gr), g1 = g0 + gq + (xcd < gr ? 1 : 0);
            const long w = (long)g0 * (WGM * 4) + off, wend = (long)g1 * (WGM * 4) < nwg ? (long)g1 * (WGM * 4) : nwg;
            if (w >= wend) return false;
            wgid = (int)w;
        } else {
            if (L >= nwg) return false;
            wgid = (int)L; { const int q = nwg / NXCD, r = nwg % NXCD, xcd = wgid % NXCD, off = wgid / NXCD; wgid = (xcd < r ? xcd * (q + 1) : r * (q + 1) + (xcd - r) * q) + off; }
        }
        const int nig = WGM * nN, gid = wgid / nig, fm = gid * WGM, gsz = (nM - fm) < WGM ? (nM - fm) : WGM;
        u.pm = fm + ((wgid % nig) % gsz); u.pn = (wgid % nig) / gsz;
        int e = 0; const int r0 = u.pm * BM;
#pragma unroll
        for (int st = 16; st >= 1; st >>= 1) if (rb[e + st] <= r0) e += st;
        u.pb = e * 4 + u.pn; return true;
    }
    __device__ __forceinline__ void a_ready(const Unit&) const {}
    __device__ __forceinline__ void done(const Unit&) const {}
};
struct APlain { static constexpr bool GATHER = false; __device__ __forceinline__ int arow(const Unit&, int) const { return 0; } __device__ __forceinline__ int arow_async(const Unit&, int) const { return 0; } };
struct AGather {
    static constexpr bool GATHER = true;
    const int* ltok; const PG8_LAS int* cnt; const PG8_LAS int* rb;
    __device__ __forceinline__ const int* aptr(const Unit& u, int r) const { const int e = u.pb >> 2, l = u.pm * BM - rb[e] + r, li = (l < cnt[e]) ? l : 0; return ltok + (size_t)e * LISTCAP + li; }
    __device__ __forceinline__ int arow(const Unit& u, int r) const { return *aptr(u, r); }
    __device__ __forceinline__ int arow_async(const Unit& u, int r) const { const int* p = aptr(u, r); int t; asm volatile("global_load_dword %0, %1, off" : "=v"(t) : "v"(p) : "memory"); return t; }
};
}

#define XB_TMO      128
#define XB_XCNT(j)  (256  + 64 * (j))
#define XB_XSUB(j)  (1280 + 64 * (j))
#define XB_XGEN(j)  (2304 + 64 * (j))
#define XB_TOP      3328
#define XB_TOPGEN   3392
#define XCD_BAR_WORDS 3456
#define XB_SPIN_CAP (1u << 18)

__device__ __forceinline__ unsigned xb_ld(unsigned* p)              { return __hip_atomic_load(p, __ATOMIC_RELAXED, __HIP_MEMORY_SCOPE_AGENT); }
__device__ __forceinline__ unsigned xb_add(unsigned* p, unsigned v) { return __hip_atomic_fetch_add(p, v, __ATOMIC_RELAXED, __HIP_MEMORY_SCOPE_AGENT); }
__device__ __forceinline__ unsigned xb_xcc_id() { return (unsigned)__builtin_amdgcn_s_getreg((3 << 11) | 20) & 0xFu; }
#define XB_SPIN(cond, bar) do { unsigned _sp = 0; while (cond) { __builtin_amdgcn_s_sleep(1); \
    if ((++_sp & 255u) == 0u) { if (xb_ld(&(bar)[XB_TMO])) break; if (_sp > XB_SPIN_CAP) { atomicAdd(&(bar)[XB_TMO], 1u); break; } } } } while (0)

struct XcdBarrier {
    unsigned* bar; unsigned x;
    volatile LAS unsigned* st;
};

__device__ __forceinline__ XcdBarrier xcd_barrier_post(unsigned* bar, volatile LAS unsigned* st, int wave) {
    XcdBarrier b; b.bar = bar; b.x = xb_xcc_id(); b.st = st;
    if (wave == 0 && lane_id() == 0) (void)xb_add(&bar[XB_XCNT(b.x)], 1u);
    return b;
}
__device__ __forceinline__ void xcd_barrier_complete(unsigned* bar, unsigned x, unsigned& nloc, unsigned& nx) {
    const unsigned G = gridDim.x * gridDim.y * gridDim.z;
    unsigned sum, cnt, mine, sp = 0u;
    for (;;) {
        sum = 0u; cnt = 0u; mine = 0u;
#pragma unroll
        for (unsigned j = 0; j < 16; ++j) { const unsigned c = xb_ld(&bar[XB_XCNT(j)]); sum += c; cnt += (c > 0u) ? 1u : 0u; mine = (j == x) ? c : mine; }
        if (sum == G) break;
        __builtin_amdgcn_s_sleep(1);
        if ((++sp & 255u) == 0u) { if (xb_ld(&bar[XB_TMO])) break; if (sp > XB_SPIN_CAP) { atomicAdd(&bar[XB_TMO], 1u); break; } }
    }
    nloc = mine > 0u ? mine : 1u; nx = cnt > 0u ? cnt : 1u;
}

__device__ __forceinline__ void xcd_barrier(const XcdBarrier& b, int wave) {
    asm volatile("s_waitcnt vmcnt(0)" ::: "memory");
    __syncthreads();
    if (wave == 0 && lane_id() == 0) {
        unsigned* bar = b.bar;
        __builtin_amdgcn_s_waitcnt(0);
        unsigned nloc = b.st[0], nx = b.st[1];
        if (nloc == 0u) { xcd_barrier_complete(bar, b.x, nloc, nx); b.st[0] = nloc; b.st[1] = nx; }
        const unsigned old = xb_add(&bar[XB_XSUB(b.x)], 1u);
        const unsigned gen = old / nloc;
        if (old + 1u == (gen + 1u) * nloc) {
            __builtin_amdgcn_fence(__ATOMIC_RELEASE, "agent");
            asm volatile("s_waitcnt vmcnt(0)" ::: "memory");
            const unsigned og = xb_add(&bar[XB_TOP], 1u);
            const unsigned tg = og / nx;
            if (og + 1u == (tg + 1u) * nx) xb_add(&bar[XB_TOPGEN], 1u);
            else XB_SPIN(xb_ld(&bar[XB_TOPGEN]) == tg, bar);
            __builtin_amdgcn_fence(__ATOMIC_ACQUIRE, "agent");
            xb_add(&bar[XB_XGEN(b.x)], 1u);
            asm volatile("s_waitcnt vmcnt(0)" ::: "memory");
        } else {
            XB_SPIN(xb_ld(&bar[XB_XGEN(b.x)]) == gen, bar);
            __builtin_amdgcn_fence(__ATOMIC_ACQUIRE, "agent");
            asm volatile("s_waitcnt vmcnt(0)" ::: "memory");
        }
    }
    __syncthreads();
}

#define LG_SUB(g)  (3584 + 64 * (g))
#define LG_GEN(g)  (4160 + 64 * (g))
#define LG_MASK(g) (4736 + 64 * (g))
__device__ __forceinline__ void lg_barrier(const XcdBarrier& b, int wave, unsigned g, unsigned nloc, bool fast) {
    asm volatile("s_waitcnt vmcnt(0)" ::: "memory");
    __syncthreads();
    if (wave == 0 && lane_id() == 0) {
        unsigned* bar = b.bar;
        __builtin_amdgcn_s_waitcnt(0);
        if (!fast) { __builtin_amdgcn_fence(__ATOMIC_RELEASE, "agent"); asm volatile("s_waitcnt vmcnt(0)" ::: "memory"); }
        const unsigned old = xb_add(&bar[LG_SUB(g)], 1u), gen = old / nloc;
        if (old + 1u == (gen + 1u) * nloc) xb_add(&bar[LG_GEN(g)], 1u);
        else XB_SPIN(xb_ld(&bar[LG_GEN(g)]) == gen, bar);
        __builtin_amdgcn_fence(__ATOMIC_ACQUIRE, "agent");
        asm volatile("s_waitcnt vmcnt(0)" ::: "memory");
    }
    __syncthreads();
}

struct RowV { f32x4 v[4]; };
__device__ __forceinline__ void row_load(RowV& r, const float* row, int lane) {
#pragma unroll
    for (int j = 0; j < 4; ++j) r.v[j] = ntload((const f32x4*)(row + 4 * lane + 256 * j));
}
__device__ __forceinline__ void row_load_bf16(RowV& r, const bf16_t* row, int lane) {
#pragma unroll
    for (int j = 0; j < 4; ++j) { const u32x2 w = *(const u32x2*)(row + 4 * lane + 256 * j); r.v[j] = (f32x4){bflo(w.x), bfhi(w.x), bflo(w.y), bfhi(w.y)}; }
}
__device__ __forceinline__ float row_rstd(const RowV& r) {
    float s = 0.f;
#pragma unroll
    for (int j = 0; j < 4; ++j) s += (r.v[j].x * r.v[j].x + r.v[j].y * r.v[j].y) + (r.v[j].z * r.v[j].z + r.v[j].w * r.v[j].w);
    s = wave_sum(s);
    return __builtin_amdgcn_rsqf(s * (1.0f / 1024.0f) + EPS);
}
__device__ __forceinline__ void row_modulate(RowV& r, float rstd, const float* g, const float* sh, const float* sc, int lane) {
#pragma unroll
    for (int j = 0; j < 4; ++j) {
        const int o = 4 * lane + 256 * j;
        const f32x4 gg = *(const f32x4*)(g + o), s = *(const f32x4*)(sc + o), h = *(const f32x4*)(sh + o);
        r.v[j] = (r.v[j] * rstd * gg) * (s + 1.0f) + h;
    }
}
struct ModV { f32x4 gp[4], sh[4]; };
__device__ __forceinline__ void mod_load(ModV& m, const float* g, const float* sh, const float* sc, int lane) {
#pragma unroll
    for (int j = 0; j < 4; ++j) { const int o = 4 * lane + 256 * j; m.gp[j] = *(const f32x4*)(g + o) * (*(const f32x4*)(sc + o) + 1.0f); m.sh[j] = *(const f32x4*)(sh + o); }
}
__device__ __forceinline__ void row_apply(RowV& r, float rstd, const ModV& m) {
#pragma unroll
    for (int j = 0; j < 4; ++j) r.v[j] = (r.v[j] * rstd) * m.gp[j] + m.sh[j];
}
__device__ __forceinline__ void row_store_bf16(const RowV& r, bf16_t* out, int lane) {
#pragma unroll
    for (int j = 0; j < 4; ++j) { u32x2 w; w.x = pg8::cvt_pk_bf16(r.v[j].x, r.v[j].y); w.y = pg8::cvt_pk_bf16(r.v[j].z, r.v[j].w); *(u32x2*)(out + 4 * lane + 256 * j) = w; }
}
__device__ __forceinline__ void row_store_f32(const RowV& r, float* out, int lane) {
#pragma unroll
    for (int j = 0; j < 4; ++j) *(f32x4*)(out + 4 * lane + 256 * j) = r.v[j];
}

__device__ __forceinline__ int wmap(int code, int n) {
    if (code == 1) { const int isU = n >> 10, ch = n & 1023; return (ch >> 7) * 256 + isU * 128 + (ch & 127); }
    if (code == 2) { const int typ = (n % 1536) / 512, d = n & 63; return (typ < 2 && d >= 4 && d < 12) ? (d < 8 ? n + 4 : n - 4) : n; }
    if (code == 3) return (n >> 7) * 256 + (n & 127);
    if (code == 4) return (n >> 7) * 256 + 128 + (n & 127);
    return n;
}
struct ConvDesc { const float* src; bf16_t* dst; int ldw, K, code, nloc; };
__device__ __forceinline__ void conv_desc(ConvDesc& d, const float* W, int ldw, int ncol0, bf16_t* WT, int K, int code, int kb, int nb) {
    d.src = W + (size_t)(64 * kb) * ldw + ncol0 + 64 * nb; d.dst = WT + 64 * kb; d.ldw = ldw; d.K = K; d.code = code; d.nloc = 64 * nb;
}
__device__ __forceinline__ void conv_load(f32x4 (&v)[16], const ConvDesc& d, int lane) {
    const float* src = d.src + (size_t)(lane >> 4) * d.ldw + (lane & 15) * 4;
#pragma unroll
    for (int i = 0; i < 16; ++i) v[i] = ntload((const f32x4*)(src + (size_t)(4 * i) * d.ldw));
}
__device__ __forceinline__ void conv_process(const f32x4 (&v)[16], const ConvDesc& d, LAS float* scr, int lane) {
#pragma unroll
    for (int i = 0; i < 16; ++i) { LAS float* p = scr + (4 * i + (lane >> 4)) * 65 + (lane & 15) * 4; p[0] = v[i].x; p[1] = v[i].y; p[2] = v[i].z; p[3] = v[i].w; }
    LDS_WAIT();
    const int c = lane & 7;
#pragma unroll
    for (int j = 0; j < 8; ++j) { const int n = (lane >> 3) + 8 * j; const LAS float* sp = scr + (8 * c) * 65 + n;
        u32x4 o; o.x = pg8::cvt_pk_bf16(sp[0 * 65], sp[1 * 65]); o.y = pg8::cvt_pk_bf16(sp[2 * 65], sp[3 * 65]); o.z = pg8::cvt_pk_bf16(sp[4 * 65], sp[5 * 65]); o.w = pg8::cvt_pk_bf16(sp[6 * 65], sp[7 * 65]);
        *(u32x4*)(d.dst + (size_t)wmap(d.code, d.nloc + n) * d.K + 8 * c) = o; }
    LDS_WAIT();
}
constexpr int NCONV_ITEMS = 512 + 256 + 256 + 1152 + 128 + 64 * 384;

namespace att {
typedef short bf16x8 __attribute__((ext_vector_type(8)));
typedef short s16x4 __attribute__((ext_vector_type(4)));
typedef float f32x16 __attribute__((ext_vector_type(16)));
constexpr int NKEY = 384, KOFF = 0, KCH = NKEY * 16 + 16  , VOFF = 8 * KCH, VDH = (NKEY / 16) * 1024 + 64  , NUNITS = 16 * 3 * 16 * 8;
__device__ __forceinline__ int crow(int r, int hi) { return (r & 3) + 8 * (r >> 2) + 4 * hi; }
__device__ __forceinline__ s16x4 vtr(const LAS unsigned char* p) { return __builtin_bit_cast(s16x4, __builtin_amdgcn_ds_read_tr16_b64_v4i16((LAS s16x4*)p)); }
__device__ __forceinline__ float xhalf_max(float m) { auto rr = __builtin_amdgcn_permlane32_swap(__float_as_uint(m), __float_as_uint(m), false, false); return fmaxf(__uint_as_float(rr[0]), __uint_as_float(rr[1])); }
__device__ __forceinline__ float xhalf_sum(float m) { auto rr = __builtin_amdgcn_permlane32_swap(__float_as_uint(m), __float_as_uint(m), false, false); return __uint_as_float(rr[0]) + __uint_as_float(rr[1]); }

template <typename P> __device__ __forceinline__ P sadd(P base, unsigned off) { asm volatile("" : "+v"(off)); return base + off; }
__device__ __forceinline__ void swap_halves(u32x2& a, u32x2& b) {
    auto rx = __builtin_amdgcn_permlane32_swap(a.x, b.x, false, false); a.x = rx[0]; b.x = rx[1];
    auto ry = __builtin_amdgcn_permlane32_swap(a.y, b.y, false, false); a.y = ry[0]; b.y = ry[1];
}
struct AUnit { int h, g, b, dil, l0, r0; size_t tb; };
template <bool MERGE> __device__ __forceinline__ int aremap(int v, bool lifo) {
    if (!lifo) return v;
    constexpr int PER = MERGE ? 8 : 16, HP = PER / 2, UB = MERGE ? 128 : 256;
    const int cu = v / PER, p = v % PER, g = cu >> 5, j = cu & 31;
    return (2 * g + (p < HP ? 1 : 0)) * UB + j * HP + (p % HP);
}
template <bool MERGE> __device__ __forceinline__ void adecode(AUnit& u, int idx) {
    const int sb = ((idx >> 4) & 7) * 2 + (idx & 1), bg = idx >> 7; u.b = MERGE ? bg : (bg >> 1);
    u.h = (idx >> 1) & 7; u.g = MERGE ? 2 : (bg & 1); const int dsh = 2 * u.g; u.dil = 1 << dsh;
    const int bps = 16 >> dsh, r = sb / bps; u.l0 = (sb - r * bps) * 256; u.r0 = r << (12 - dsh); u.tb = (size_t)u.b * SEQ + r;
}
__device__ __forceinline__ void aload_kv(u32x4 (&kv)[12], const AUnit& u, const bf16_t* qkv, int wave, int lane) {
    const char* kb = (const char*)(qkv + qkv_block(1, u.g, u.b, u.h) + (size_t)u.r0 * 64); const char* vb = kb + (qkv_block(2, 0, 0, 0) - qkv_block(1, 0, 0, 0)) * 2;
#pragma unroll
    for (int i = 0; i < 6; ++i) {
        int sp = u.l0 - 128 + 48 * wave + 8 * i + (lane >> 3); sp = sp < 0 ? 0 : sp;
        const unsigned ro = (unsigned)sp * 128u + (unsigned)(lane & 7) * 16u;
        kv[i] = *(const u32x4*)sadd(kb, ro); kv[6 + i] = *(const u32x4*)sadd(vb, ro);
    }
}
__device__ __forceinline__ void astore_kv(const u32x4 (&kv)[12], LAS unsigned char* lds, int wave, int lane) {
#pragma unroll
    for (int i = 0; i < 6; ++i) { const int key = 48 * wave + 8 * i + (lane >> 3);
        *(LAS u32x4*)(lds + KOFF + (lane & 7) * KCH + key * 16) = kv[i];
        *(LAS u32x4*)(lds + VOFF + ((lane & 7) >> 2) * VDH + (key >> 4) * 1024 + (key & 15) * 64 + (lane & 3) * 16) = kv[6 + i]; }
}
__device__ __forceinline__ char* aqrow(const AUnit& u, bf16_t* qkv, int wave) {
    return (char*)(qkv + qkv_block(0, u.g, u.b, u.h) + (size_t)(u.r0 + u.l0 + 32 * wave) * 64);
}

template <bool MERGE> __device__ __forceinline__ void attn_phase(LAS unsigned char* lds, bf16_t* qkv, float* lse, bf16_t* ob, int bid, int G, int wave, bool lifo, bool dry = false) {
    constexpr int NU = MERGE ? NUNITS / 3 : 2 * NUNITS / 3;
    const int per = (NU + G - 1) / G;
    const int u_lo = bid * per, u_hi = (u_lo + per < NU) ? u_lo + per : NU;
    asm volatile("" : "+s"(wave));
    const int lane = lane_id(), r32 = lane & 31, hi = lane >> 5;
    const int qt = wave;
    const unsigned qlo = (unsigned)r32 * 128u + (unsigned)hi * 16u;
    u32x4 kv[12]; bf16x8 qn[4];
    AUnit un;
    if (u_lo < u_hi) { adecode<MERGE>(un, aremap<MERGE>(u_lo, lifo)); aload_kv(kv, un, qkv, wave, lane);
        { const char* q = aqrow(un, qkv, wave);
#pragma unroll
            for (int d0 = 0; d0 < 4; ++d0) qn[d0] = *(const bf16x8*)(sadd(q, qlo) + d0 * 32); } }
#pragma unroll 1
    for (int idx = u_lo; idx < u_hi; ++idx) {
        const AUnit u = un;
        const int g = u.g, l0 = u.l0, head = u.h;
        char* qrow = aqrow(u, qkv, wave);
        const size_t tqw = u.tb + (size_t)(l0 + 32 * qt) * u.dil;
        bf16x8 qf[4];
        astore_kv(kv, lds, wave, lane);
#pragma unroll
        for (int d0 = 0; d0 < 4; ++d0) qf[d0] = qn[d0];
        __syncthreads();
        if (idx + 1 < u_hi) { adecode<MERGE>(un, aremap<MERGE>(idx + 1, lifo)); aload_kv(kv, un, qkv, wave, lane);
            { const char* q = aqrow(un, qkv, wave);
#pragma unroll
                for (int d0 = 0; d0 < 4; ++d0) qn[d0] = *(const bf16x8*)(sadd(q, qlo) + d0 * 32); } }
        u32x4 og[MERGE ? 2 : 1][2][2]; float lg0 = 0.f, lg1 = 0.f;
        if constexpr (MERGE) {
            const int pq = (int)(tqw & (SEQ - 1)) + r32 * u.dil; const char* oq0 = (const char*)(qkv + qkv_block(0, 0, u.b, head)); const char* oq1 = (const char*)(qkv + qkv_block(0, 1, u.b, head));
            const unsigned oo0 = (unsigned)qkv_row(pq, 0) * 128u + 16u * hi, oo1 = (unsigned)qkv_row(pq, 1) * 128u + 16u * hi;
#pragma unroll
            for (int gg = 0; gg < 2; ++gg)
#pragma unroll
                for (int d0 = 0; d0 < 2; ++d0)
#pragma unroll
                    for (int rp = 0; rp < 2; ++rp) og[gg][d0][rp] = *(const u32x4*)(sadd(gg ? oq1 : oq0, gg ? oo1 : oo0) + (d0 * 64 + 32 * rp));
            const char* lb = (const char*)(lse + tqw * 24 + head); const unsigned lo_ = (unsigned)(r32 * u.dil) * 96u;
            lg0 = *(const float*)sadd(lb, lo_); lg1 = *(const float*)(sadd(lb, lo_) + 32);
        }
        f32x16 p[5];
        const LAS unsigned char* kb = lds + KOFF + hi * KCH + (qt * 32 + r32) * 16;
#pragma unroll
        for (int j = 0; j < 5; ++j) {
#pragma unroll
            for (int rr = 0; rr < 16; ++rr) p[j][rr] = 0.f;
#pragma unroll
            for (int d0 = 0; d0 < 4; ++d0) {
                const bf16x8 kf = *(const LAS bf16x8*)(kb + j * 512 + d0 * 2 * KCH);
                p[j] = __builtin_amdgcn_mfma_f32_32x32x16_bf16(kf, qf[d0], p[j], 0, 0, 0);
            }
        }
#pragma unroll
        for (int rr = 0; rr < 16; ++rr) { const int c = crow(rr, hi); if (c < r32) p[0][rr] = -INFINITY; if (c > r32) p[4][rr] = -INFINITY; }
        if (l0 == 0) {
#pragma unroll
            for (int j = 0; j < 5; ++j)
#pragma unroll
                for (int rr = 0; rr < 16; ++rr) if (32 * (qt + j) + crow(rr, hi) < 128) p[j][rr] = -INFINITY;
        }
        float m = p[0][0];
#pragma unroll
        for (int j = 0; j < 5; ++j)
#pragma unroll
            for (int rr = 0; rr < 16; ++rr) m = fmaxf(m, p[j][rr]);
        m = xhalf_max(m);
        float l = 0.f;
#pragma unroll
        for (int j = 0; j < 5; ++j)
#pragma unroll
            for (int rr = 0; rr < 16; ++rr) { const float e = __builtin_amdgcn_exp2f(p[j][rr] - m); p[j][rr] = e; l += e; }
        l = xhalf_sum(l);
        f32x16 o[2];
#pragma unroll
        for (int rr = 0; rr < 16; ++rr) { o[0][rr] = 0.f; o[1][rr] = 0.f; }
        const LAS unsigned char* vb = lds + VOFF + ((lane >> 4) & 1) * 32 + (lane & 3) * 8 + (4 * hi + ((lane & 15) >> 2)) * 64 + qt * 2048;
#pragma unroll
        for (int j = 0; j < 5; ++j)
#pragma unroll
            for (int s = 0; s < 2; ++s) {
                u32x4 pw; pw.x = pg8::cvt_pk_bf16(p[j][8 * s + 0], p[j][8 * s + 1]); pw.y = pg8::cvt_pk_bf16(p[j][8 * s + 2], p[j][8 * s + 3]);
                pw.z = pg8::cvt_pk_bf16(p[j][8 * s + 4], p[j][8 * s + 5]); pw.w = pg8::cvt_pk_bf16(p[j][8 * s + 6], p[j][8 * s + 7]);
                const bf16x8 pf = __builtin_bit_cast(bf16x8, pw);
#pragma unroll
                for (int d0 = 0; d0 < 2; ++d0) {
                    const s16x4 vlo = vtr(vb + d0 * VDH + (2 * j + s) * 1024), vhi = vtr(vb + d0 * VDH + (2 * j + s) * 1024 + 512);
                    const bf16x8 vf = {vlo[0], vlo[1], vlo[2], vlo[3], vhi[0], vhi[1], vhi[2], vhi[3]};
                    o[d0] = __builtin_amdgcn_mfma_f32_32x32x16_bf16(vf, pf, o[d0], 0, 0, 0);
                }
            }
        if constexpr (!MERGE) {
            const float inv = 1.0f / l;
#pragma unroll
            for (int d0 = 0; d0 < 2; ++d0)
#pragma unroll
                for (int rp = 0; rp < 2; ++rp) {
                    u32x2 w0, w1; const int r0_ = 8 * rp, r1_ = 8 * rp + 4;
                    w0.x = pg8::cvt_pk_bf16(o[d0][r0_] * inv, o[d0][r0_ + 1] * inv); w0.y = pg8::cvt_pk_bf16(o[d0][r0_ + 2] * inv, o[d0][r0_ + 3] * inv);
                    w1.x = pg8::cvt_pk_bf16(o[d0][r1_] * inv, o[d0][r1_ + 1] * inv); w1.y = pg8::cvt_pk_bf16(o[d0][r1_ + 2] * inv, o[d0][r1_ + 3] * inv);
                    swap_halves(w0, w1);
                    const u32x4 w = {w0.x, w0.y, w1.x, w1.y};
                    if (!dry) *(u32x4*)(sadd(qrow, (unsigned)r32 * 128u + 16u * hi) + (d0 * 64 + 32 * rp)) = w; else asm volatile("" :: "v"(w.x), "v"(w.y), "v"(w.z), "v"(w.w));
                }
            if (hi == 0 && !dry) *(float*)((char*)(lse + tqw * 24 + g * 8 + head) + (unsigned)(r32 * u.dil) * 96u) = m + __builtin_amdgcn_logf(l);
        } else {
            const float lg2 = m + __builtin_amdgcn_logf(l), mx = fmaxf(lg2, fmaxf(lg0, lg1));
            const float w0 = __builtin_amdgcn_exp2f(lg0 - mx), w1 = __builtin_amdgcn_exp2f(lg1 - mx), w2 = __builtin_amdgcn_exp2f(lg2 - mx);
            const float iw = 1.0f / (w0 + w1 + w2), c0 = w0 * iw, c1 = w1 * iw, c2 = w2 * iw / l;
            char* orow = (char*)(ob + tqw * 512 + head * 64); const unsigned oro = (unsigned)(r32 * u.dil) * 1024u + 16u * hi;
#pragma unroll
            for (int d0 = 0; d0 < 2; ++d0)
#pragma unroll
                for (int rp = 0; rp < 2; ++rp) {
                    u32x2 a[2], b[2];
                    { const u32x4 v0 = og[0][d0][rp], v1 = og[1][d0][rp]; a[0] = (u32x2){v0.x, v0.y}; a[1] = (u32x2){v0.z, v0.w}; b[0] = (u32x2){v1.x, v1.y}; b[1] = (u32x2){v1.z, v1.w}; }
                    swap_halves(a[0], a[1]); swap_halves(b[0], b[1]);
                    u32x2 wq[2];
#pragma unroll
                    for (int q2 = 0; q2 < 2; ++q2) { const int rr = 8 * rp + 4 * q2;
                        wq[q2].x = pg8::cvt_pk_bf16(c0 * bflo(a[q2].x) + c1 * bflo(b[q2].x) + c2 * o[d0][rr], c0 * bfhi(a[q2].x) + c1 * bfhi(b[q2].x) + c2 * o[d0][rr + 1]);
                        wq[q2].y = pg8::cvt_pk_bf16(c0 * bflo(a[q2].y) + c1 * bflo(b[q2].y) + c2 * o[d0][rr + 2], c0 * bfhi(a[q2].y) + c1 * bfhi(b[q2].y) + c2 * o[d0][rr + 3]); }
                    swap_halves(wq[0], wq[1]);
                    const u32x4 w = {wq[0].x, wq[0].y, wq[1].x, wq[1].y};
                    if (!dry) *(u32x4*)(sadd(orow, oro) + (d0 * 64 + 32 * rp)) = w; else asm volatile("" :: "v"(w.x), "v"(w.y), "v"(w.z), "v"(w.w));
                }
        }
        __syncthreads();
    }
}
}

namespace rt {
typedef _Float16 half8 __attribute__((ext_vector_type(8)));
typedef _Float16 half2 __attribute__((ext_vector_type(2)));
constexpr int TAB = 0, GPO = 98304, SHO = 102400, BIO = 106496, REC = 147456;
__device__ __forceinline__ unsigned pkh(float a, float b) { return __builtin_bit_cast(unsigned, __builtin_amdgcn_cvt_pkrtz(a, b)); }
__device__ __forceinline__ unsigned pkh_rn(float a, float b) { const half2 p = {(_Float16)a, (_Float16)b}; return __builtin_bit_cast(unsigned, p); }
__device__ __forceinline__ float wsrc(const float* wg, const float* we, int nb, int nl, int k) { return nb == 0 ? wg[k * 4 + (nl & 3)] : we[((size_t)(nl >> 2) * 1024 + k) * 8 + (nb == 2 ? 4 : 0) + (nl & 3)]; }
__device__ __forceinline__ float bsrc(const float* bg, const float* be, int nb, int nl) { return nb == 0 ? bg[nl & 3] : be[(nl >> 2) * 8 + (nb == 2 ? 4 : 0) + (nl & 3)]; }

__device__ __forceinline__ void router_build(unsigned char* tabg, const float* gff, const float* mb, const float* wg, const float* bg, const float* we, const float* be, int share, int wave) {
    const int lane = lane_id(), tid = wave * 64 + lane;
    if (tid < 384) { const int idx = share * 384 + tid, ln = idx & 63, nb = (idx >> 6) % 3, s = idx / 192, nl = ln & 15, k0 = 32 * s + 8 * (ln >> 4);
        float v[8];
#pragma unroll
        for (int c = 0; c < 8; ++c) v[c] = wsrc(wg, we, nb, nl, k0 + c) * (gff[k0 + c] * (mb[4096 + k0 + c] + 1.0f));
        u32x4 h; h.x = pkh_rn(v[0], v[1]); h.y = pkh_rn(v[2], v[3]); h.z = pkh_rn(v[4], v[5]); h.w = pkh_rn(v[6], v[7]);
        *(u32x4*)(tabg + (size_t)idx * 16) = h; }
    if (wave < 3) { const int col = share * 3 + wave, nb = col >> 4, nl = col & 15; float p = 0.f;
#pragma unroll
        for (int j = 0; j < 16; ++j) { const int k = lane + 64 * j; p += mb[3072 + k] * wsrc(wg, we, nb, nl, k); }
        p = wave_sum(p);
        if (lane == 0) ((float*)(tabg + 98304))[col] = p + bsrc(bg, be, nb, nl); }
}
__device__ __forceinline__ void router_phase(LAS unsigned char* lds, const bf16_t* xr, bf16_t* xn, const float* gff, const float* modl, const float* wg, const float* bg, const float* we, const float* be,
                                             int* cntl, int* ltok, float* lw, int* tslot, int blk0, int G, int wave, const unsigned char* tabl  ) {
    LAS float* gpL = (LAS float*)(lds + GPO); LAS float* shL = (LAS float*)(lds + SHO); LAS float* biL = (LAS float*)(lds + BIO);
    LAS int* rec_e = (LAS int*)(lds + REC); LAS float* rec_w = (LAS float*)(lds + REC + 2048); LAS int* rec_rank = (LAS int*)(lds + REC + 4096);
    LAS int* hist = (LAS int*)(lds + REC + 6144); LAS int* base = (LAS int*)(lds + REC + 6144 + 128);
#pragma unroll 1
    for (int blk = blk0; blk < T / 256; blk += G) {
        const float* mb = modl + (size_t)((blk * 256) >> 12) * 6144;
        { const int tid = wave * 64 + lane_id();
        for (int k = tid; k < 1024; k += 512) { gpL[k] = gff[k] * (mb[4096 + k] + 1.0f); shL[k] = mb[3072 + k]; }
        if (tid < 32) hist[tid] = 0; }
        __syncthreads();
        if (tabl) {
            const unsigned char* tg = tabl + (size_t)(blk >> 4) * RTAB_STRIDE; const int tid = wave * 64 + lane_id();
#pragma unroll
            for (int i = 0; i < 12; ++i) *(LAS u32x4*)(lds + TAB + (tid + 512 * i) * 16) = *(const u32x4*)(tg + (size_t)(tid + 512 * i) * 16);
            if (tid < 48) biL[tid] = ((const float*)(tg + 98304))[tid];
        } else {
        { const int tid = wave * 64 + lane_id();
#pragma unroll 1
        for (int idx = tid; idx < 32 * 3 * 64; idx += 512) {
            const int ln = idx & 63, nb = (idx >> 6) % 3, s = idx / 192, nl = ln & 15, k0 = 32 * s + 8 * (ln >> 4);
            float v[8];
#pragma unroll
            for (int c = 0; c < 8; ++c) v[c] = wsrc(wg, we, nb, nl, k0 + c) * gpL[k0 + c];
            u32x4 h; h.x = pkh_rn(v[0], v[1]); h.y = pkh_rn(v[2], v[3]); h.z = pkh_rn(v[4], v[5]); h.w = pkh_rn(v[6], v[7]);
            *(LAS u32x4*)(lds + TAB + idx * 16) = h;
        } }
#pragma unroll 1
        for (int col = wave; col < 48; col += 8) { const int lane = lane_id(); const int nb = col >> 4, nl = col & 15; float p = 0.f;
#pragma unroll
            for (int j = 0; j < 16; ++j) { const int k = lane + 64 * j; p += shL[k] * wsrc(wg, we, nb, nl, k); }
            p = wave_sum(p);
            if (lane == 0) biL[col] = p + bsrc(bg, be, nb, nl); }
        }
        __syncthreads();
#pragma unroll 1
        for (int grp = 0; grp < 2; ++grp) {
            const int lane = lane_id(), tl = lane & 15, kq = lane >> 4;
            const int rl = wave * 32 + grp * 16 + tl;
            u32x4 hx[32];
            const int rw0 = blk * 256 + wave * 32 + grp * 16;
            { const char* xp = att::sadd((const char*)(xr + (size_t)rw0 * XRP), (unsigned)(tl * XRP + kq * 8) * 2u);
#pragma unroll
              for (int s = 0; s < 32; ++s) hx[s] = *(const u32x4*)(xp + s * 64); }
            f32x4 a0 = {0.f, 0.f, 0.f, 0.f}, a1 = {0.f, 0.f, 0.f, 0.f}, a2 = {0.f, 0.f, 0.f, 0.f}; float ss = 0.f;
#pragma unroll
            for (int s = 0; s < 32; ++s) {
                const u32x4 w = hx[s];
                const float f0 = bflo(w.x), f1 = bfhi(w.x), f2 = bflo(w.y), f3 = bfhi(w.y), f4 = bflo(w.z), f5 = bfhi(w.z), f6 = bflo(w.w), f7 = bfhi(w.w);
                ss += (f0 * f0 + f1 * f1) + (f2 * f2 + f3 * f3) + (f4 * f4 + f5 * f5) + (f6 * f6 + f7 * f7);
                u32x4 h; h.x = pkh(f0, f1); h.y = pkh(f2, f3); h.z = pkh(f4, f5); h.w = pkh(f6, f7);
                hx[s] = h;
                const half8 xb = __builtin_bit_cast(half8, h);
                const LAS unsigned char* tp = lds + TAB + (s * 192 + lane) * 16;
                a0 = __builtin_amdgcn_mfma_f32_16x16x32_f16(*(const LAS half8*)tp, xb, a0, 0, 0, 0);
                a1 = __builtin_amdgcn_mfma_f32_16x16x32_f16(*(const LAS half8*)(tp + 1024), xb, a1, 0, 0, 0);
                a2 = __builtin_amdgcn_mfma_f32_16x16x32_f16(*(const LAS half8*)(tp + 2048), xb, a2, 0, 0, 0);
                if ((s & 3) == 3) __builtin_amdgcn_sched_barrier(0);
            }
            ss += xlane<16>(ss); ss += xlane32(ss, (lane & 32) != 0);
            const float rstd = __builtin_amdgcn_rsqf(ss * (1.0f / 1024.0f) + EPS);
            float gl[4];
#pragma unroll
            for (int o = 0; o < 4; ++o) gl[o] = rstd * a0[o] + biL[o];
            int gi = 0; float gm = gl[0];
#pragma unroll
            for (int o = 1; o < 4; ++o) if (gl[o] > gm) { gm = gl[o]; gi = o; }
            float gden = 0.f;
#pragma unroll
            for (int o = 0; o < 4; ++o) gden += __builtin_amdgcn_exp2f((gl[o] - gm) * 1.4426950408889634f);
            const float grp_p = __builtin_amdgcn_rcpf(gden);
            float el[8];
#pragma unroll
            for (int o = 0; o < 4; ++o) { el[o] = rstd * a1[o] + biL[16 + 4 * kq + o]; el[4 + o] = rstd * a2[o] + biL[32 + 4 * kq + o]; }
            int i0 = 0; float m0 = el[0];
#pragma unroll
            for (int o = 1; o < 8; ++o) if (el[o] > m0) { m0 = el[o]; i0 = o; }
            int i1 = -1; float m1 = -INFINITY;
#pragma unroll
            for (int o = 0; o < 8; ++o) if (o != i0 && el[o] > m1) { m1 = el[o]; i1 = o; }
            const float p1 = __builtin_amdgcn_exp2f((m1 - m0) * 1.4426950408889634f), w0_ = grp_p * __builtin_amdgcn_rcpf(1.0f + p1);
            if (kq == gi) { rec_e[rl * 2] = gi * 8 + i0; rec_e[rl * 2 + 1] = gi * 8 + i1; rec_w[rl * 2] = w0_; rec_w[rl * 2 + 1] = w0_ * p1; }
            { char* op = att::sadd((char*)(xn + (size_t)rw0 * D), (unsigned)(tl * D + kq * 8) * 2u);
#pragma unroll
              for (int s = 0; s < 32; ++s) {
                const half8 xb = __builtin_bit_cast(half8, hx[s]);
                const LAS float* gq = gpL + 32 * s + 8 * kq; const LAS float* sq = shL + 32 * s + 8 * kq;
                const f32x4 g0 = *(const LAS f32x4*)gq, g1 = *(const LAS f32x4*)(gq + 4), s0 = *(const LAS f32x4*)sq, s1 = *(const LAS f32x4*)(sq + 4);
                f32x4 y0 = {(float)xb[0], (float)xb[1], (float)xb[2], (float)xb[3]}, y1 = {(float)xb[4], (float)xb[5], (float)xb[6], (float)xb[7]};
                y0 = (y0 * rstd) * g0 + s0; y1 = (y1 * rstd) * g1 + s1;
                u32x4 o; o.x = pg8::cvt_pk_bf16(y0.x, y0.y); o.y = pg8::cvt_pk_bf16(y0.z, y0.w); o.z = pg8::cvt_pk_bf16(y1.x, y1.y); o.w = pg8::cvt_pk_bf16(y1.z, y1.w);
                *(u32x4*)(op + s * 64) = o;
                if ((s & 3) == 3) __builtin_amdgcn_sched_barrier(0);
              } }
        }
        __syncthreads();
        { const int tid = wave * 64 + lane_id();
        { const int e = rec_e[tid]; rec_rank[tid] = atomicAdd((int*)&hist[e], 1); }
        __syncthreads();
        if (tid < 32) { const int h = hist[tid]; base[tid] = h ? atomicAdd(&cntl[tid], h) : 0; }
        __syncthreads();
        { const int e = rec_e[tid], pos = base[e] + rec_rank[tid], tok = blk * 256 + (tid >> 1);
          ltok[(size_t)e * LISTCAP + pos] = tok; lw[(size_t)e * LISTCAP + pos] = rec_w[tid]; tslot[tok * 2 + (tid & 1)] = (e << 16) | pos; } }
        __syncthreads();
    }
}
}

typedef const __attribute__((address_space(4))) unsigned long long* kargp_t;
__device__ __forceinline__ kargp_t karg() { kargp_t p = (kargp_t)__builtin_amdgcn_kernarg_segment_ptr(); asm volatile("" : "+s"(p)); return p; }
#define KIN(i) ((const float*)(GAS const float*)karg()[i])
#define KOUT() ((float*)(GAS float*)karg()[19])
#define KWS() ((unsigned char*)(GAS unsigned char*)karg()[20])
#define WSP(type, off) ((type*)(KWS() + (off)))
struct Args { const float* in[19]; float* out; unsigned char* ws; int ph_lo, ph_hi; };
constexpr int NPHASE = 17;

__global__ void __launch_bounds__(NWAVES * 64, 2) mk_fwd(Args args) {
    extern __shared__ __attribute__((aligned(16))) unsigned char lds_raw[];
    LAS unsigned char* lds = (LAS unsigned char*)lds_raw;
    volatile LAS unsigned* MISC = (volatile LAS unsigned*)(lds + MISC_OFF);
    LAS int* rb = (LAS int*)(lds + MISC_OFF);
    const int wave = __builtin_amdgcn_readfirstlane((int)threadIdx.x >> 6);
#define IDS() const int lane = lane_id(), tid = wave * 64 + lane; (void)tid; (void)lane
    const int G = gridDim.x, bid = blockIdx.x;
    for (int u = threadIdx.x; u < (LDS_BYTES - MISC_OFF) / 4; u += NWAVES * 64) MISC[u] = 0u;
    __syncthreads();
#if MK_ONE_LAUNCH
    XcdBarrier bar = xcd_barrier_post((unsigned*)(KWS() + WS_CTL) + CW_BAR, MISC + 40, wave);
    if (threadIdx.x == 0) atomicOr(&bar.bar[LG_MASK(bid & 7)], 1u << bar.x);
#define GRID_BAR() xcd_barrier(bar, wave)
#define LOCAL_OK() (G == 256)
#define CBID() (LOCAL_OK() ? ((bid & 7) * 32 + (bid >> 3)) : bid)
#define LOCAL_BAR() do { if (LOCAL_OK()) lg_barrier(bar, wave, (unsigned)(bid & 7), 32u, MISC[42] != 0u); else GRID_BAR(); } while (0)
#else
#define GRID_BAR() do { } while (0)
#define LOCAL_OK() false
#define CBID() bid
#define LOCAL_BAR() do { } while (0)
#endif
#if MK_ONE_LAUNCH
    constexpr int lo = 0, hi = NPHASE; (void)args;
#else
    const int lo = args.ph_lo, hi = args.ph_hi;
#endif
#ifndef PHMASK
#define PHMASK 0xFFFFFFFFu
#endif
#define IN(k) ((((PHMASK) >> (k)) & 1u) && lo <= (k) && (k) < hi)
#ifndef REPMASK
#define REPMASK 0u
#endif
#define REPS(k) ((((REPMASK) >> (k)) & 1u) ? 2 : 1)
#define SEAM(k) do { if (IN(k) && IN((k) + 1)) GRID_BAR(); } while (0)
#define LSEAM(k) do { if (IN(k) && IN((k) + 1)) LOCAL_BAR(); } while (0)

    for (int rep_ = 0; rep_ < REPS(0); ++rep_) if (IN(0)) { IDS();
        const float* cin = KIN(1); const float* ada_w = KIN(4); const float* ada_b = KIN(5); float* mod = WSP(float, WS_MOD); float* rope = WSP(float, WS_ROPE);
        LAS float* cact = (LAS float*)lds; LAS float* red = cact + 16384;
        if (bid < 192) for (int i = tid; i < 16 * 1024; i += 512) { const float v = cin[i]; cact[i] = v / (1.f + expf(-v)); }
        __syncthreads();
        for (int item = bid; item < 192; item += G) {
            const int l = item / 96, n0 = (item % 96) * 64, kk = lane >> 4, n4 = lane & 15;
            f32x4 acc[16];
#pragma unroll
            for (int b = 0; b < 16; ++b) acc[b] = (f32x4){0.f, 0.f, 0.f, 0.f};
            const float* w = ada_w + (size_t)l * 1024 * 6144 + n0 + n4 * 4;
#pragma unroll 1
            for (int kb = 0; kb < 2; ++kb) {
                const int k0 = wave * 128 + kb * 64 + kk;
                f32x4 wv[16];
#pragma unroll
                for (int u = 0; u < 16; ++u) wv[u] = *(const f32x4*)(w + (size_t)(k0 + 4 * u) * 6144);
#pragma unroll
                for (int u = 0; u < 16; ++u)
#pragma unroll
                    for (int b = 0; b < 16; ++b) acc[b] += wv[u] * cact[b * 1024 + k0 + 4 * u];
            }
            const bool h5 = (lane & 32) != 0;
#pragma unroll
            for (int b = 0; b < 16; ++b)
#pragma unroll
                for (int c = 0; c < 4; ++c) { float v = acc[b][c]; v += xlane<16>(v); v += xlane32(v, h5); acc[b][c] = v; }
            if (lane < 16) {
#pragma unroll
                for (int b = 0; b < 16; ++b) *(LAS f32x4*)(red + (wave * 16 + b) * 64 + n4 * 4) = acc[b];
            }
            __syncthreads();
            for (int i = tid; i < 1024; i += 512) {
                const int b = i >> 6, nn = i & 63; float s = 0.f;
#pragma unroll
                for (int q = 0; q < 8; ++q) s += red[(q * 16 + b) * 64 + nn];
                mod[((size_t)l * 16 + b) * 6144 + n0 + nn] = s + ada_b[l * 6144 + n0 + nn];
            }
            __syncthreads();
        }
        for (int i = bid * 512 + tid; i < 4096 * 8; i += G * 512) {
            const int t = i >> 3, f = i & 7;
            const float inv = powf(500000.0f, -(float)(2 * f) / 16.0f);
            const float ang = (float)t * inv;
            rope[i] = (float)cos((double)ang);
            rope[4096 * 8 + i] = (float)sin((double)ang);
        }
        __syncthreads();
        {
        LAS float* scr = (LAS float*)(lds + wave * 16640);
        const float* conv_in_w = KIN(6); const float* conv_out_w = KIN(8); const float* attn_in_w = KIN(9); const float* attn_out_w = KIN(10);
        const float* gate_w = KIN(15); const float* up_w = KIN(16); const float* down_w = KIN(17);
        bf16_t* WZ = WSP(bf16_t, WS_WZ); bf16_t* WB = WSP(bf16_t, WS_WB); bf16_t* WCO = WSP(bf16_t, WS_WCO); bf16_t* WAI = WSP(bf16_t, WS_WAI); bf16_t* WAO = WSP(bf16_t, WS_WAO);
        bf16_t* WGU = WSP(bf16_t, WS_WGU); bf16_t* WDN = WSP(bf16_t, WS_WDN);
#define CONV_DECODE(DD, IT) do { int it = (IT); \
            if (it < 512) { conv_desc(DD, conv_in_w, 3072, 1024, WZ, 1024, 1, it / 32, it % 32); break; } it -= 512; \
            if (it < 256) { conv_desc(DD, conv_in_w, 3072, 0, WB, 1024, 0, it / 16, it % 16); break; } it -= 256; \
            if (it < 256) { conv_desc(DD, conv_out_w, 1024, 0, WCO, 1024, 0, it / 16, it % 16); break; } it -= 256; \
            if (it < 1152) { conv_desc(DD, attn_in_w, QKVW, 0, WAI, 1024, 2, it / 72, it % 72); break; } it -= 1152; \
            if (it < 128) { conv_desc(DD, attn_out_w, 1024, 0, WAO, 512, 0, it / 16, it % 16); break; } it -= 128; \
            const int le = it / 384, r = it % 384; \
            if (r < 128) conv_desc(DD, gate_w + (size_t)le * D * DEXP, DEXP, 0, WGU + (size_t)le * 1024 * 1024, 1024, 3, r / 8, r % 8); \
            else if (r < 256) conv_desc(DD, up_w + (size_t)le * D * DEXP, DEXP, 0, WGU + (size_t)le * 1024 * 1024, 1024, 4, (r - 128) / 8, (r - 128) % 8); \
            else conv_desc(DD, down_w + (size_t)le * DEXP * D, D, 0, WDN + (size_t)le * 1024 * 512, 512, 0, (r - 256) / 16, (r - 256) % 16); } while (0)
        {
            const int step = G * NWAVES; int it0 = bid * NWAVES + wave;
            ConvDesc dA, dB; f32x4 vA[16], vB[16];
            if (it0 < CONV_EARLY) { CONV_DECODE(dA, it0); conv_load(vA, dA, lane); }
#pragma unroll 1
            for (; it0 < CONV_EARLY; it0 += 2 * step) {
                const bool hasB = it0 + step < CONV_EARLY, hasA2 = it0 + 2 * step < CONV_EARLY;
                if (hasB) { CONV_DECODE(dB, it0 + step); conv_load(vB, dB, lane); }
                conv_process(vA, dA, scr, lane);
                if (hasA2) { CONV_DECODE(dA, it0 + 2 * step); conv_load(vA, dA, lane); }
                if (hasB) conv_process(vB, dB, scr, lane);
            }
        }
#undef CONV_DECODE
        }
    }
    SEAM(0);
    if (threadIdx.x == 0) { const unsigned m_ = xb_ld(&bar.bar[LG_MASK(bid & 7)]); MISC[42] = ((m_ & (m_ - 1u)) == 0u) ? 1u : 0u; }
    __syncthreads();
    for (int rep_ = 0; rep_ < REPS(1); ++rep_) if (IN(1)) { IDS();
        {
        LAS float* scr = (LAS float*)(lds + wave * 16640);
        const float* conv_in_w = KIN(6); const float* conv_out_w = KIN(8); const float* attn_in_w = KIN(9); const float* attn_out_w = KIN(10);
        const float* gate_w = KIN(15); const float* up_w = KIN(16); const float* down_w = KIN(17);
        bf16_t* WZ = WSP(bf16_t, WS_WZ); bf16_t* WB = WSP(bf16_t, WS_WB); bf16_t* WCO = WSP(bf16_t, WS_WCO); bf16_t* WAI = WSP(bf16_t, WS_WAI); bf16_t* WAO = WSP(bf16_t, WS_WAO);
        bf16_t* WGU = WSP(bf16_t, WS_WGU); bf16_t* WDN = WSP(bf16_t, WS_WDN);
#define CONV_DECODE(DD, IT) do { int it = (IT); \
            if (it < 512) { conv_desc(DD, conv_in_w, 3072, 1024, WZ, 1024, 1, it / 32, it % 32); break; } it -= 512; \
            if (it < 256) { conv_desc(DD, conv_in_w, 3072, 0, WB, 1024, 0, it / 16, it % 16); break; } it -= 256; \
            if (it < 256) { conv_desc(DD, conv_out_w, 1024, 0, WCO, 1024, 0, it / 16, it % 16); break; } it -= 256; \
            if (it < 1152) { conv_desc(DD, attn_in_w, QKVW, 0, WAI, 1024, 2, it / 72, it % 72); break; } it -= 1152; \
            if (it < 128) { conv_desc(DD, attn_out_w, 1024, 0, WAO, 512, 0, it / 16, it % 16); break; } it -= 128; \
            const int le = it / 384, r = it % 384; \
            if (r < 128) conv_desc(DD, gate_w + (size_t)le * D * DEXP, DEXP, 0, WGU + (size_t)le * 1024 * 1024, 1024, 3, r / 8, r % 8); \
            else if (r < 256) conv_desc(DD, up_w + (size_t)le * D * DEXP, DEXP, 0, WGU + (size_t)le * 1024 * 1024, 1024, 4, (r - 128) / 8, (r - 128) % 8); \
            else conv_desc(DD, down_w + (size_t)le * DEXP * D, D, 0, WDN + (size_t)le * 1024 * 512, 512, 0, (r - 256) / 16, (r - 256) % 16); } while (0)
        {
            const int step = G * NWAVES; int it0 = CONV_EARLY + bid * NWAVES + wave;
            ConvDesc dA, dB; f32x4 vA[16], vB[16];
            if (it0 < NCONV_ITEMS) { CONV_DECODE(dA, it0); conv_load(vA, dA, lane); }
#pragma unroll 1
            for (; it0 < NCONV_ITEMS; it0 += 2 * step) {
                const bool hasB = it0 + step < NCONV_ITEMS, hasA2 = it0 + 2 * step < NCONV_ITEMS;
                if (hasB) { CONV_DECODE(dB, it0 + step); conv_load(vB, dB, lane); }
                conv_process(vA, dA, scr, lane);
                if (hasA2) { CONV_DECODE(dA, it0 + 2 * step); conv_load(vA, dA, lane); }
                if (hasB) conv_process(vB, dB, scr, lane);
            }
        }
#undef CONV_DECODE
        }
        const float* x = KIN(0); const float* norm_mix_g = KIN(2); const float* mod = WSP(float, WS_MOD); bf16_t* xn = WSP(bf16_t, WS_XN);
        for (int w0 = (CBID() * 8 + wave) * 32; w0 < T; w0 += G * 8 * 32) {
            const float* mb = mod + (size_t)(w0 >> 12) * 6144;
            ModV mv; mod_load(mv, norm_mix_g, mb + 0, mb + 1024, lane);
            RowV ring[4];
#pragma unroll
            for (int d = 0; d < 4; ++d) row_load(ring[d], x + (size_t)(w0 + d) * D, lane);
#pragma unroll 1
            for (int i = 0; i < 32; i += 4) {
#pragma unroll
                for (int d = 0; d < 4; ++d) {
                    const int row = w0 + i + d;
                    RowV r = ring[d];
                    if (i < 28) row_load(ring[d], x + (size_t)(row + 4) * D, lane);
                    const float rstd = row_rstd(r);
                    row_apply(r, rstd, mv);
                    row_store_bf16(r, xn + (size_t)row * D, lane);
                }
            }
        }
    }
    LSEAM(1);
    for (int rep_ = 0; rep_ < REPS(2); ++rep_) if (IN(2)) { bf16_t* xn = WSP(bf16_t, WS_XN); bf16_t* WZ = WSP(bf16_t, WS_WZ); bf16_t* zb = WSP(bf16_t, WS_Z);
        pg8::Gemm g{xn, WZ, T, 2048, 1024}; pg8::StaticOrder S; S.init(T, 2048, G, bid); pg8::EpiPair<false> E{zb, D};
        pg8::gemm_phase<pg8::EpiPair<false>, pg8::StaticOrder, pg8::APlain, true, true>(lds, g, S, E, pg8::APlain{}, wave); }
    LSEAM(2);
    for (int rep_ = 0; rep_ < REPS(3); ++rep_) if (IN(3)) { bf16_t* xn = WSP(bf16_t, WS_XN); bf16_t* WB = WSP(bf16_t, WS_WB); bf16_t* zb = WSP(bf16_t, WS_Z); bf16_t* ypre = WSP(bf16_t, WS_YPRE); const float* conv_w = KIN(7);
        pg8::Gemm g{xn, WB, T, 1024, 1024}; pg8::StaticOrder S; S.init(T, 1024, G, bid); pg8::EpiYpre E{ypre, zb, conv_w};
        pg8::gemm_phase<pg8::EpiYpre, pg8::StaticOrder, pg8::APlain, true, true>(lds, g, S, E, pg8::APlain{}, wave); }
    LSEAM(3);
    for (int rep_ = 0; rep_ < REPS(4); ++rep_) if (IN(4)) { bf16_t* ypre = WSP(bf16_t, WS_YPRE); bf16_t* WCO = WSP(bf16_t, WS_WCO); bf16_t* xr = (bf16_t*)KOUT(); const float* x = KIN(0); const float* mod = WSP(float, WS_MOD);
        pg8::Gemm g{ypre, WCO, T, 1024, 1024}; pg8::StaticOrder S; S.init(T, 1024, G, bid); pg8::EpiRes<true> E{xr, x, mod + 2048};
        pg8::gemm_phase<pg8::EpiRes<true>, pg8::StaticOrder, pg8::APlain, true, true>(lds, g, S, E, pg8::APlain{}, wave); }
    if (LOCAL_OK()) { const int cb_ = CBID(), b_ = cb_ >> 4;
        rt::router_build(KWS() + WS_RTAB + (size_t)(0 * 16 + b_) * RTAB_STRIDE, KIN(3) + 0 * D, WSP(float, WS_MOD) + (size_t)0 * 16 * 6144 + (size_t)b_ * 6144, KIN(11) + (size_t)0 * D * 4, KIN(12) + 0 * 4, KIN(13) + (size_t)0 * 4 * D * 8, KIN(14) + 0 * 32, cb_ & 15, wave); }
    LSEAM(4);
    { constexpr int l = 0;
        const int pb0 = (l == 0) ? 5 : 13;
#define MODL() (WSP(float, WS_MOD) + (size_t)l * 16 * 6144)
#define CNTL() (WSP(int, WS_CTL) + 64 * l)
        if (l == 1) {
#ifdef STAGGER9
            if (IN(9)) { const unsigned long long t0_ = __builtin_amdgcn_s_memrealtime(); const unsigned long long dl_ = (unsigned long long)(((bid >> 3) & 31) * STAGGER9 / 32);
                while (__builtin_amdgcn_s_memrealtime() - t0_ < dl_) __builtin_amdgcn_s_sleep(16); }
#endif
            for (int rep_ = 0; rep_ < REPS(9); ++rep_) if (IN(9)) { bf16_t* xn = WSP(bf16_t, WS_XN); bf16_t* WAI = WSP(bf16_t, WS_WAI); bf16_t* qkv = WSP(bf16_t, WS_QKV); const float* rope = WSP(float, WS_ROPE);
                pg8::Gemm g{xn, WAI, T, QKVW, 1024}; pg8::StaticOrder S; S.init(T, QKVW, G, bid, 8); pg8::EpiQKV E{WSP(unsigned, WS_CTL) + CW_GATE, (unsigned)G, qkv, rope, 0};
                pg8::gemm_phase<pg8::EpiQKV, pg8::StaticOrder, pg8::APlain, true, true>(lds, g, S, E, pg8::APlain{}, wave); }
            LSEAM(9);
            if (IN(10)) att::attn_phase<false>(lds, WSP(bf16_t, WS_QKV), WSP(float, WS_LSE), WSP(bf16_t, WS_OB), CBID(), G, wave, LOCAL_OK());
            LSEAM(10);
            if (IN(11)) att::attn_phase<true>(lds, WSP(bf16_t, WS_QKV), WSP(float, WS_LSE), WSP(bf16_t, WS_OB), CBID(), G, wave, LOCAL_OK());
            LSEAM(11);
            if (IN(12)) { bf16_t* ob = WSP(bf16_t, WS_OB); bf16_t* WAO = WSP(bf16_t, WS_WAO); bf16_t* xr = (bf16_t*)KOUT();
                pg8::Gemm g{ob, WAO, T, 1024, 512}; pg8::StaticOrder S; S.init(T, 1024, G, bid); pg8::EpiRes<false> E{xr, nullptr, MODL() + 2048};
                pg8::gemm_phase<pg8::EpiRes<false>, pg8::StaticOrder, pg8::APlain, true, true>(lds, g, S, E, pg8::APlain{}, wave); }
            if (LOCAL_OK()) { const int cb_ = CBID(), b_ = cb_ >> 4;
        rt::router_build(KWS() + WS_RTAB + (size_t)(1 * 16 + b_) * RTAB_STRIDE, KIN(3) + 1 * D, WSP(float, WS_MOD) + (size_t)1 * 16 * 6144 + (size_t)b_ * 6144, KIN(11) + (size_t)1 * D * 4, KIN(12) + 1 * 4, KIN(13) + (size_t)1 * 4 * D * 8, KIN(14) + 1 * 32, cb_ & 15, wave); }
            LSEAM(12);
        }
        if (IN(pb0)) rt::router_phase(lds, (const bf16_t*)KOUT(), WSP(bf16_t, WS_XN), KIN(3) + l * D, MODL(), KIN(11) + (size_t)l * D * 4, KIN(12) + l * 4, KIN(13) + (size_t)l * 4 * D * 8, KIN(14) + l * 32,
                                      CNTL(), WSP(int, WS_LTOK), WSP(float, WS_LW), WSP(int, WS_TSLOT), CBID(), G, wave, LOCAL_OK() ? (const unsigned char*)(KWS() + WS_RTAB + (size_t)l * 16 * RTAB_STRIDE) : nullptr);
        SEAM(pb0);
        if (IN(pb0 + 1) || IN(pb0 + 2) || IN(pb0 + 3)) {
            __syncthreads();
            if (wave == 0) { const int ln = lane_id(); const int* cntl = CNTL();
                const int raw = (ln < 32) ? __hip_atomic_load(&cntl[ln & 31], RLX_AGENT) : 0; const int c = (raw + 255) & ~255; int s = 0;
                if (ln < 32) rb[48 + ln] = raw;
#pragma unroll
                for (int e = 0; e < 32; ++e) { if (ln == 0) rb[e] = s; s += __builtin_amdgcn_readlane(c, e); }
                if (ln == 0) rb[32] = s; }
            __syncthreads();
        }
        for (int rep_ = 0; rep_ < REPS(6); ++rep_) if (IN(pb0 + 1)) { bf16_t* xn = WSP(bf16_t, WS_XN); bf16_t* WGU = WSP(bf16_t, WS_WGU); bf16_t* act = WSP(bf16_t, WS_ACT); const int* ltok = WSP(int, WS_LTOK); const int* cntl = CNTL();
            pg8::Gemm g{xn, WGU + (size_t)l * 32 * 1024 * 1024, 0, 0, 1024}; pg8::MoeOrder S; S.init(rb[32] / 256, G, bid, rb, LOCAL_OK()); pg8::EpiPair<true> E{act, DEXP}; pg8::AGather am{ltok, rb + 48, rb};
            pg8::gemm_phase<pg8::EpiPair<true>, pg8::MoeOrder, pg8::AGather, true, true>(lds, g, S, E, am, wave); }
        LSEAM(pb0 + 1);
        for (int rep_ = 0; rep_ < REPS(7); ++rep_) if (IN(pb0 + 2)) { bf16_t* act = WSP(bf16_t, WS_ACT); bf16_t* WDN = WSP(bf16_t, WS_WDN); bf16_t* yw = WSP(bf16_t, WS_YW); const float* lw = WSP(float, WS_LW);
            pg8::Gemm g{act, WDN + (size_t)l * 32 * 1024 * 512, 0, 0, 512}; pg8::MoeOrder S; S.init(rb[32] / 256, G, bid, rb, LOCAL_OK()); pg8::EpiDown E{yw, lw, rb};
            pg8::gemm_phase<pg8::EpiDown, pg8::MoeOrder, pg8::APlain, true, true>(lds, g, S, E, pg8::APlain{}, wave); }
        SEAM(pb0 + 2);
        for (int rep_ = 0; rep_ < REPS(8); ++rep_) if (IN(pb0 + 3)) { IDS(); const bool dry = rep_ + 1 < REPS(8);
            const float* gnext = (l == 0) ? KIN(2) + D : KIN(18);
            const float* modn = WSP(float, WS_MOD) + (size_t)16 * 6144; const float* modl = MODL();
            float* outf = KOUT(); bf16_t* xr = (bf16_t*)KOUT(); const bf16_t* yw = WSP(bf16_t, WS_YW); const int* tslot = WSP(int, WS_TSLOT); bf16_t* xn = WSP(bf16_t, WS_XN);
            for (int w0 = (CBID() * 8 + wave) * 32; w0 < T; w0 += G * 8 * 32) {
                const int b = w0 >> 12;
                f32x4 g2v[4];
#pragma unroll
                for (int j = 0; j < 4; ++j) g2v[j] = *(const f32x4*)(modl + (size_t)b * 6144 + 5120 + 4 * lane + 256 * j);
                ModV mv;
                if (l == 0) { const float* mb = modn + (size_t)b * 6144; mod_load(mv, gnext, mb + 0, mb + 1024, lane); }
                else {
#pragma unroll
                    for (int j = 0; j < 4; ++j) { mv.gp[j] = *(const f32x4*)(gnext + 4 * lane + 256 * j); mv.sh[j] = (f32x4){0.f, 0.f, 0.f, 0.f}; }
                }
                const int slw = tslot[(size_t)w0 * 2 + lane];
                u32x2 xb[4][4], ya[4][4], yb[4][4];
#define R2_LOAD(D_, I_) do { const int s0_ = __builtin_amdgcn_readlane(slw, 2 * (I_)), s1_ = __builtin_amdgcn_readlane(slw, 2 * (I_) + 1); \
                    const size_t r0_ = (size_t)(rb[s0_ >> 16] + (s0_ & 0xffff)), r1_ = (size_t)(rb[s1_ >> 16] + (s1_ & 0xffff)); \
                    _Pragma("unroll") for (int j = 0; j < 4; ++j) { xb[D_][j] = *(const u32x2*)(xr + (size_t)(w0 + (I_)) * XRP + 4 * lane + 256 * j); \
                        ya[D_][j] = ntload((const u32x2*)(yw + r0_ * D + 4 * lane + 256 * j)); yb[D_][j] = ntload((const u32x2*)(yw + r1_ * D + 4 * lane + 256 * j)); } } while (0)
#pragma unroll
                for (int d = 0; d < 4; ++d) R2_LOAD(d, d);
#pragma unroll 1
                for (int i4 = 0; i4 < 32; i4 += 4)
#pragma unroll
                for (int d = 0; d < 4; ++d) {
                    const int i = i4 + d, row = w0 + i;
                    RowV r;
#pragma unroll
                    for (int j = 0; j < 4; ++j) {
                        const u32x2 xw = xb[d][j], a = ya[d][j], c = yb[d][j];
                        f32x4 y; y.x = bflo(a.x) + bflo(c.x); y.y = bfhi(a.x) + bfhi(c.x); y.z = bflo(a.y) + bflo(c.y); y.w = bfhi(a.y) + bfhi(c.y);
                        r.v[j] = (f32x4){bflo(xw.x), bfhi(xw.x), bflo(xw.y), bfhi(xw.y)} + g2v[j] * y;
                    }
                    if (i4 < 28) R2_LOAD(d, i + 4);
                    const float rstd = row_rstd(r);
                    if (dry) { asm volatile("" :: "v"(rstd), "v"(r.v[0].x), "v"(r.v[1].y), "v"(r.v[2].z), "v"(r.v[3].w)); }
                    else if (l == 1) { row_apply(r, rstd, mv); row_store_f32(r, outf + (size_t)row * D, lane); }
                    else { row_store_bf16(r, xr + (size_t)row * XRP, lane); row_apply(r, rstd, mv); row_store_bf16(r, xn + (size_t)row * D, lane); }
                }
#undef R2_LOAD
            }
            if (l == 0) {
                __syncthreads();
                if (threadIdx.x == 0) { asm volatile("s_waitcnt vmcnt(0)" ::: "memory"); (void)__hip_atomic_fetch_add(WSP(unsigned, WS_CTL) + CW_GATE, 1u, __ATOMIC_RELAXED, __HIP_MEMORY_SCOPE_AGENT); }
            }
        }
        if (l == 0) LSEAM(pb0 + 3); else SEAM(pb0 + 3);
    }
    { constexpr int l = 1;
        const int pb0 = (l == 0) ? 5 : 13;
#define MODL() (WSP(float, WS_MOD) + (size_t)l * 16 * 6144)
#define CNTL() (WSP(int, WS_CTL) + 64 * l)
        if (l == 1) {
#ifdef STAGGER9
            if (IN(9)) { const unsigned long long t0_ = __builtin_amdgcn_s_memrealtime(); const unsigned long long dl_ = (unsigned long long)(((bid >> 3) & 31) * STAGGER9 / 32);
                while (__builtin_amdgcn_s_memrealtime() - t0_ < dl_) __builtin_amdgcn_s_sleep(16); }
#endif
            for (int rep_ = 0; rep_ < REPS(9); ++rep_) if (IN(9)) { bf16_t* xn = WSP(bf16_t, WS_XN); bf16_t* WAI = WSP(bf16_t, WS_WAI); bf16_t* qkv = WSP(bf16_t, WS_QKV); const float* rope = WSP(float, WS_ROPE);
                pg8::Gemm g{xn, WAI, T, QKVW, 1024}; pg8::StaticOrder S; S.init(T, QKVW, G, bid, 8); pg8::EpiQKV E{WSP(unsigned, WS_CTL) + CW_GATE, (unsigned)G, qkv, rope, 0};
                pg8::gemm_phase<pg8::EpiQKV, pg8::StaticOrder, pg8::APlain, true, true>(lds, g, S, E, pg8::APlain{}, wave); }
            LSEAM(9);
            if (IN(10)) att::attn_phase<false>(lds, WSP(bf16_t, WS_QKV), WSP(float, WS_LSE), WSP(bf16_t, WS_OB), CBID(), G, wave, LOCAL_OK());
            LSEAM(10);
            if (IN(11)) att::attn_phase<true>(lds, WSP(bf16_t, WS_QKV), WSP(float, WS_LSE), WSP(bf16_t, WS_OB), CBID(), G, wave, LOCAL_OK());
            LSEAM(11);
            if (IN(12)) { bf16_t* ob = WSP(bf16_t, WS_OB); bf16_t* WAO = WSP(bf16_t, WS_WAO); bf16_t* xr = (bf16_t*)KOUT();
                pg8::Gemm g{ob, WAO, T, 1024, 512}; pg8::StaticOrder S; S.init(T, 1024, G, bid); pg8::EpiRes<false> E{xr, nullptr, MODL() + 2048};
                pg8::gemm_phase<pg8::EpiRes<false>, pg8::StaticOrder, pg8::APlain, true, true>(lds, g, S, E, pg8::APlain{}, wave); }
            if (LOCAL_OK()) { const int cb_ = CBID(), b_ = cb_ >> 4;
        rt::router_build(KWS() + WS_RTAB + (size_t)(1 * 16 + b_) * RTAB_STRIDE, KIN(3) + 1 * D, WSP(float, WS_MOD) + (size_t)1 * 16 * 6144 + (size_t)b_ * 6144, KIN(11) + (size_t)1 * D * 4, KIN(12) + 1 * 4, KIN(13) + (size_t)1 * 4 * D * 8, KIN(14) + 1 * 32, cb_ & 15, wave); }
            LSEAM(12);
        }
        if (IN(pb0)) rt::router_phase(lds, (const bf16_t*)KOUT(), WSP(bf16_t, WS_XN), KIN(3) + l * D, MODL(), KIN(11) + (size_t)l * D * 4, KIN(12) + l * 4, KIN(13) + (size_t)l * 4 * D * 8, KIN(14) + l * 32,
                                      CNTL(), WSP(int, WS_LTOK), WSP(float, WS_LW), WSP(int, WS_TSLOT), CBID(), G, wave, LOCAL_OK() ? (const unsigned char*)(KWS() + WS_RTAB + (size_t)l * 16 * RTAB_STRIDE) : nullptr);
        SEAM(pb0);
        if (IN(pb0 + 1) || IN(pb0 + 2) || IN(pb0 + 3)) {
            __syncthreads();
            if (wave == 0) { const int ln = lane_id(); const int* cntl = CNTL();
                const int raw = (ln < 32) ? __hip_atomic_load(&cntl[ln & 31], RLX_AGENT) : 0; const int c = (raw + 255) & ~255; int s = 0;
                if (ln < 32) rb[48 + ln] = raw;
#pragma unroll
                for (int e = 0; e < 32; ++e) { if (ln == 0) rb[e] = s; s += __builtin_amdgcn_readlane(c, e); }
                if (ln == 0) rb[32] = s; }
            __syncthreads();
        }
        for (int rep_ = 0; rep_ < REPS(6); ++rep_) if (IN(pb0 + 1)) { bf16_t* xn = WSP(bf16_t, WS_XN); bf16_t* WGU = WSP(bf16_t, WS_WGU); bf16_t* act = WSP(bf16_t, WS_ACT); const int* ltok = WSP(int, WS_LTOK); const int* cntl = CNTL();
            pg8::Gemm g{xn, WGU + (size_t)l * 32 * 1024 * 1024, 0, 0, 1024}; pg8::MoeOrder S; S.init(rb[32] / 256, G, bid, rb, LOCAL_OK()); pg8::EpiPair<true> E{act, DEXP}; pg8::AGather am{ltok, rb + 48, rb};
            pg8::gemm_phase<pg8::EpiPair<true>, pg8::MoeOrder, pg8::AGather, true, true>(lds, g, S, E, am, wave); }
        LSEAM(pb0 + 1);
        for (int rep_ = 0; rep_ < REPS(7); ++rep_) if (IN(pb0 + 2)) { bf16_t* act = WSP(bf16_t, WS_ACT); bf16_t* WDN = WSP(bf16_t, WS_WDN); bf16_t* yw = WSP(bf16_t, WS_YW); const float* lw = WSP(float, WS_LW);
            pg8::Gemm g{act, WDN + (size_t)l * 32 * 1024 * 512, 0, 0, 512}; pg8::MoeOrder S; S.init(rb[32] / 256, G, bid, rb, LOCAL_OK()); pg8::EpiDown E{yw, lw, rb};
            pg8::gemm_phase<pg8::EpiDown, pg8::MoeOrder, pg8::APlain, true, true>(lds, g, S, E, pg8::APlain{}, wave); }
        SEAM(pb0 + 2);
        for (int rep_ = 0; rep_ < REPS(8); ++rep_) if (IN(pb0 + 3)) { IDS(); const bool dry = rep_ + 1 < REPS(8);
            const float* gnext = (l == 0) ? KIN(2) + D : KIN(18);
            const float* modn = WSP(float, WS_MOD) + (size_t)16 * 6144; const float* modl = MODL();
            float* outf = KOUT(); bf16_t* xr = (bf16_t*)KOUT(); const bf16_t* yw = WSP(bf16_t, WS_YW); const int* tslot = WSP(int, WS_TSLOT); bf16_t* xn = WSP(bf16_t, WS_XN);
            for (int w0 = (CBID() * 8 + wave) * 32; w0 < T; w0 += G * 8 * 32) {
                const int b = w0 >> 12;
                f32x4 g2v[4];
#pragma unroll
                for (int j = 0; j < 4; ++j) g2v[j] = *(const f32x4*)(modl + (size_t)b * 6144 + 5120 + 4 * lane + 256 * j);
                ModV mv;
                if (l == 0) { const float* mb = modn + (size_t)b * 6144; mod_load(mv, gnext, mb + 0, mb + 1024, lane); }
                else {
#pragma unroll
                    for (int j = 0; j < 4; ++j) { mv.gp[j] = *(const f32x4*)(gnext + 4 * lane + 256 * j); mv.sh[j] = (f32x4){0.f, 0.f, 0.f, 0.f}; }
                }
                const int slw = tslot[(size_t)w0 * 2 + lane];
                u32x2 xb[4][4], ya[4][4], yb[4][4];
#define R2_LOAD(D_, I_) do { const int s0_ = __builtin_amdgcn_readlane(slw, 2 * (I_)), s1_ = __builtin_amdgcn_readlane(slw, 2 * (I_) + 1); \
                    const size_t r0_ = (size_t)(rb[s0_ >> 16] + (s0_ & 0xffff)), r1_ = (size_t)(rb[s1_ >> 16] + (s1_ & 0xffff)); \
                    _Pragma("unroll") for (int j = 0; j < 4; ++j) { xb[D_][j] = *(const u32x2*)(xr + (size_t)(w0 + (I_)) * XRP + 4 * lane + 256 * j); \
                        ya[D_][j] = ntload((const u32x2*)(yw + r0_ * D + 4 * lane + 256 * j)); yb[D_][j] = ntload((const u32x2*)(yw + r1_ * D + 4 * lane + 256 * j)); } } while (0)
#pragma unroll
                for (int d = 0; d < 4; ++d) R2_LOAD(d, d);
#pragma unroll 1
                for (int i4 = 0; i4 < 32; i4 += 4)
#pragma unroll
                for (int d = 0; d < 4; ++d) {
                    const int i = i4 + d, row = w0 + i;
                    RowV r;
#pragma unroll
                    for (int j = 0; j < 4; ++j) {
                        const u32x2 xw = xb[d][j], a = ya[d][j], c = yb[d][j];
                        f32x4 y; y.x = bflo(a.x) + bflo(c.x); y.y = bfhi(a.x) + bfhi(c.x); y.z = bflo(a.y) + bflo(c.y); y.w = bfhi(a.y) + bfhi(c.y);
                        r.v[j] = (f32x4){bflo(xw.x), bfhi(xw.x), bflo(xw.y), bfhi(xw.y)} + g2v[j] * y;
                    }
                    if (i4 < 28) R2_LOAD(d, i + 4);
                    const float rstd = row_rstd(r);
                    if (dry) { asm volatile("" :: "v"(rstd), "v"(r.v[0].x), "v"(r.v[1].y), "v"(r.v[2].z), "v"(r.v[3].w)); }
                    else if (l == 1) { row_apply(r, rstd, mv); row_store_f32(r, outf + (size_t)row * D, lane); }
                    else { row_store_bf16(r, xr + (size_t)row * XRP, lane); row_apply(r, rstd, mv); row_store_bf16(r, xn + (size_t)row * D, lane); }
                }
#undef R2_LOAD
            }
            if (l == 0) {
                __syncthreads();
                if (threadIdx.x == 0) { asm volatile("s_waitcnt vmcnt(0)" ::: "memory"); (void)__hip_atomic_fetch_add(WSP(unsigned, WS_CTL) + CW_GATE, 1u, __ATOMIC_RELAXED, __HIP_MEMORY_SCOPE_AGENT); }
            }
        }
        if (l == 0) LSEAM(pb0 + 3); else SEAM(pb0 + 3);
    }
#undef IDS
#undef MODL
#undef CNTL
#undef IN
#undef SEAM
#undef GRID_BAR
}

extern "C" void kernel_launch(void* const* d_in, const int* in_sizes, int n_in, void* d_out, int out_size, void* d_ws, size_t ws_size, hipStream_t stream) {
    static int grid = 0;
    if (grid == 0) {
        if (n_in != 19 || out_size != T * D || ws_size < WS_END) { fprintf(stderr, "kernel_launch: unexpected shapes (n_in %d out %d ws %zu)\n", n_in, out_size, ws_size); grid = -1; return; }
        int dev = 0, cus = 0;
        if (hipGetDevice(&dev) != hipSuccess || hipDeviceGetAttribute(&cus, hipDeviceAttributeMultiprocessorCount, dev) != hipSuccess) { grid = -1; return; }
        if (hipFuncSetAttribute((const void*)mk_fwd, hipFuncAttributeMaxDynamicSharedMemorySize, LDS_BYTES) != hipSuccess) { fprintf(stderr, "kernel_launch: hipFuncSetAttribute failed\n"); grid = -1; return; }
        int per_cu = 0;
        if (hipOccupancyMaxActiveBlocksPerMultiprocessor(&per_cu, (const void*)mk_fwd, NWAVES * 64, LDS_BYTES) != hipSuccess || per_cu < 1) fprintf(stderr, "kernel_launch: occupancy query says %d\n", per_cu);
        (void)hipGetLastError();
        grid = cus;
    }
    if (grid < 0) return;
    (void)hipMemsetAsync((char*)d_ws + WS_CTL, 0, CTL_BYTES, stream);
    Args a{};
    for (int i = 0; i < 19; ++i) a.in[i] = (const float*)d_in[i];
    a.out = (float*)d_out; a.ws = (unsigned char*)d_ws;
#if MK_ONE_LAUNCH
    a.ph_lo = 0; a.ph_hi = NPHASE;
    hipLaunchKernelGGL(mk_fwd, dim3(grid), dim3(NWAVES * 64), LDS_BYTES, stream, a);
#else
    for (int p = 0; p < NPHASE; ++p) { a.ph_lo = p; a.ph_hi = p + 1; hipLaunchKernelGGL(mk_fwd, dim3(grid), dim3(NWAVES * 64), LDS_BYTES, stream, a); }
#endif
}
```
